# Optimizing an MI355X kernel written in HIP

```python
import math
import jax, jax.numpy as jnp
from jax import lax
import numpy as np

D_MODEL = 1024
BATCH = 16
SEQ = 256
DEPTH = 2
DEC_BATCH = 2
DEC_SEQ = 4096
PAST_LEN = 256

GRID_W = 64
HY_CH = D_MODEL // 2
FILT_BANDS = 16
FILT_EMB = 1 + 2 * FILT_BANDS
FILT_ORDER = 64
FAST_DECAY_PCT = 0.3
SLOW_DECAY_PCT = 1.5
DECAY_TARGET = 1e-2
MAX_DECAY = math.log(DECAY_TARGET) / FAST_DECAY_PCT
MIN_DECAY = math.log(DECAY_TARGET) / SLOW_DECAY_PCT
SHORT_CONV = 3
MLA_HEADS = 4
QK_NOPE = 128
QK_ROPE = 64
V_HEAD = 128
Q_LORA = D_MODEL // 4
KV_LORA = D_MODEL // 8
ROPE_THETA = 10000.0
Q_BLOCK = 128
FN_GROUPS = 8
FN_GROUP_CH = D_MODEL // FN_GROUPS
D_FF = 4 * D_MODEL
ALPHA = (2 * DEPTH) ** 0.25
BETA = (8 * DEPTH) ** -0.25
LN_EPS = 1e-5
RMS_EPS = 1e-6
W_IN0 = 3 * HY_CH + Q_LORA + KV_LORA + QK_ROPE
MIX_OUT0 = HY_CH + MLA_HEADS * V_HEAD

kernel_name = 'hyena_mla_fnet_diffusion_step'


def layer_norm_plain(x):
    xf = x.astype(jnp.float32)
    mu = jnp.mean(xf, axis=-1, keepdims=True)
    var = jnp.mean(jnp.square(xf - mu), axis=-1, keepdims=True)
    return (xf - mu) * lax.rsqrt(var + LN_EPS)


def layer_norm(x, g, b):
    y = layer_norm_plain(x) * g.astype(jnp.float32) + b.astype(jnp.float32)
    return y.astype(x.dtype)


def rms_norm(x, g):
    xf = x.astype(jnp.float32)
    y = xf * lax.rsqrt(jnp.mean(jnp.square(xf), axis=-1, keepdims=True) + RMS_EPS)
    return (y * g.astype(jnp.float32)).astype(x.dtype)


def modulation(cond, w, b):
    m = jax.nn.silu(cond) @ w + b
    return jnp.split(m[:, None, :], 6, axis=-1)


def adaln(x, shift, scale):
    return (layer_norm_plain(x) * (1.0 + scale.astype(jnp.float32)) + shift.astype(jnp.float32)).astype(x.dtype)


def post_residual(x, out, gate, g, b):
    return layer_norm(ALPHA * x + gate * out, g, b)


def short_conv3(x, w, b):
    xp = jnp.pad(x, ((0, 0), (1, 1), (0, 0)))
    return xp[:, :-2] * w[0] + xp[:, 1:-1] * w[1] + xp[:, 2:] * w[2] + b


def hyena_filters(L, w1, b1, freq, w2, b2, w3):
    f32 = jnp.float32
    t = jnp.linspace(0.0, 1.0, L, dtype=f32)[:, None]
    w_ang = 2.0 * math.pi * jnp.arange(L, dtype=f32) / L
    bands = jnp.linspace(1e-4, FILT_BANDS - 1, FILT_BANDS, dtype=f32)
    ang = w_ang[:, None] * bands[None, :]
    z = jnp.concatenate([t, jnp.cos(ang), -jnp.sin(ang)], axis=-1)
    fr = freq.astype(f32)
    h = jnp.sin(fr * (z @ w1.astype(f32) + b1.astype(f32)))
    h = jnp.sin(fr * (h @ w2.astype(f32) + b2.astype(f32)))
    h = h @ w3.astype(f32)
    deltas = jnp.abs(jnp.linspace(MIN_DECAY, MAX_DECAY, HY_CH, dtype=f32))
    decay = jnp.exp(-t * deltas[None, :])
    h = h.reshape(L, 2, HY_CH) * decay[:, None, :]
    h = h / jnp.sum(jnp.abs(h), axis=(0, 1), keepdims=True)
    return h[:, 0], h[:, 1]


def long_conv_bidir(u, h_fwd, h_bwd, skip):
    L = u.shape[1]
    uf = u.astype(jnp.float32)
    k = jnp.concatenate([h_fwd, jnp.zeros((1, HY_CH), jnp.float32), h_bwd[1:][::-1]], axis=0)
    U = jnp.fft.rfft(uf, n=2 * L, axis=1)
    K = jnp.fft.rfft(k, n=2 * L, axis=0)
    y = jnp.fft.irfft(U * K[None], n=2 * L, axis=1)[:, :L]
    return y + uf * skip.astype(jnp.float32)


def hyena_mixer(p, conv_w, conv_b, hf_w1, hf_b1, hf_freq, hf_w2, hf_b2, hf_w3, hf_skip):
    L = p.shape[1]
    p = short_conv3(p, conv_w, conv_b)
    x0, x1, v = jnp.split(p, 3, axis=-1)
    h_fwd, h_bwd = hyena_filters(L, hf_w1, hf_b1, hf_freq, hf_w2, hf_b2, hf_w3)
    v = long_conv_bidir(v * x1, h_fwd, h_bwd, hf_skip).astype(p.dtype)
    return v * x0


def grid_rope_tables(L):
    rows = L // GRID_W
    f32 = jnp.float32
    row = jnp.repeat(jnp.arange(rows, dtype=f32), GRID_W)
    col = jnp.tile(jnp.arange(GRID_W, dtype=f32), rows)
    half = QK_ROPE // 2
    inv = 1.0 / (ROPE_THETA ** (jnp.arange(0, half, 2, dtype=f32) / half))
    ar = row[:, None] * inv[None, :]
    ac = col[:, None] * inv[None, :]
    ang = jnp.stack([ar, ar, ac, ac], axis=1).reshape(L, QK_ROPE)
    return jnp.cos(ang), jnp.sin(ang)


def apply_rope(x, cos, sin):
    xs = x.reshape(x.shape[:-1] + (2, 2, QK_ROPE // 4))
    x1, x2 = xs[..., 0, :], xs[..., 1, :]
    rot = jnp.stack([-x2, x1], axis=-2).reshape(x.shape)
    return (x * cos + rot * sin).astype(x.dtype)


def block_attention(q, k, v):
    b, lq, h, dk = q.shape
    nb = lq // Q_BLOCK
    scale = 1.0 / math.sqrt(dk)
    qb = q.reshape(b, nb, Q_BLOCK, h, dk).transpose(1, 0, 2, 3, 4)

    def attend(q_blk):
        s = jnp.einsum('bqhd,bkhd->bhqk', q_blk, k).astype(jnp.float32) * scale
        p = jax.nn.softmax(s, axis=-1)
        return jnp.einsum('bhqk,bkhd->bqhd', p.astype(v.dtype), v)

    ob = lax.map(attend, qb)
    return ob.transpose(1, 0, 2, 3, 4).reshape(b, lq, h, v.shape[-1])


def mla_query(q_c, q_norm, q_up):
    b, l, _ = q_c.shape
    q = (rms_norm(q_c, q_norm) @ q_up).reshape(b, l, MLA_HEADS, QK_NOPE + QK_ROPE)
    return q[..., :QK_NOPE], q[..., QK_NOPE:]


def mla_attend(q_nope, q_pe, kv_n, k_pe, kv_up):
    b, lk, _ = kv_n.shape
    kv = (kv_n @ kv_up).reshape(b, lk, MLA_HEADS, QK_NOPE + V_HEAD)
    k_nope, v = kv[..., :QK_NOPE], kv[..., QK_NOPE:]
    k_rope = jnp.broadcast_to(k_pe[:, :, None, :], (b, lk, MLA_HEADS, QK_ROPE)).astype(k_nope.dtype)
    k = jnp.concatenate([k_nope, k_rope], axis=-1)
    q = jnp.concatenate([q_nope, q_pe.astype(q_nope.dtype)], axis=-1)
    o = block_attention(q, k, v)
    return o.reshape(o.shape[0], o.shape[1], MLA_HEADS * V_HEAD)


def ab_front(x, mods, w_in, hyena_p):
    h = adaln(x, mods[0], mods[1])
    z = h @ w_in
    hy, q_c, kv_c, k_pe = jnp.split(z, [3 * HY_CH, 3 * HY_CH + Q_LORA, 3 * HY_CH + Q_LORA + KV_LORA], axis=-1)
    y_hy = hyena_mixer(hy, *hyena_p)
    return y_hy, q_c, kv_c, k_pe


def layer_ab_context(x, mods, w_in, hyena_p, mla_p, w_out, g, b):
    q_norm, q_up, kv_norm, kv_up = mla_p
    y_hy, q_c, kv_c, k_pe = ab_front(x, mods, w_in, hyena_p)
    q_nope, q_pe = mla_query(q_c, q_norm, q_up)
    kv_n = rms_norm(kv_c, kv_norm)
    y_mla = mla_attend(q_nope, q_pe, kv_n, k_pe, kv_up)
    out = jnp.concatenate([y_hy, y_mla.astype(y_hy.dtype)], axis=-1) @ w_out
    return post_residual(x, out, mods[2], g, b), kv_n, k_pe


def layer_ab_latent(x, mods, ctx_ckv, ctx_krope, w_in, hyena_p, mla_p, w_out, g, b):
    q_norm, q_up, kv_norm, kv_up = mla_p
    L = x.shape[1]
    y_hy, q_c, kv_c, k_pe = ab_front(x, mods, w_in, hyena_p)
    cos, sin = grid_rope_tables(L)
    q_nope, q_pe = mla_query(q_c, q_norm, q_up)
    q_pe = apply_rope(q_pe, cos[None, :, None, :], sin[None, :, None, :])
    k_pe = apply_rope(k_pe, cos[None], sin[None])
    kv_n = rms_norm(kv_c, kv_norm)
    kv_all = jnp.concatenate([kv_n, ctx_ckv.astype(kv_n.dtype)], axis=1)
    kpe_all = jnp.concatenate([k_pe, ctx_krope.astype(k_pe.dtype)], axis=1)
    y_mla = mla_attend(q_nope, q_pe, kv_all, kpe_all, kv_up)
    out = jnp.concatenate([y_hy, y_mla.astype(y_hy.dtype)], axis=-1) @ w_out
    return post_residual(x, out, mods[2], g, b)


def fourier_mix(h):
    b, l, d = h.shape
    hg = h.astype(jnp.float32).reshape(b, l, FN_GROUPS, FN_GROUP_CH)
    y = jnp.fft.fft2(hg, axes=(1, 3), norm='ortho').real
    return y.reshape(b, l, d).astype(h.dtype)


def layer_c(x, mods, w_out, g, b):
    h = adaln(x, mods[0], mods[1])
    out = fourier_mix(h) @ w_out
    return post_residual(x, out, mods[2], g, b)


def channel_mixer(x, mods, w1, w2, g, b):
    h = adaln(x, mods[3], mods[4])
    out = jnp.square(jax.nn.relu(h @ w1)) @ w2
    return post_residual(x, out, mods[5], g, b)


def setup_inputs(seed: int = 0) -> dict:
    key = jax.random.key(seed)
    ks = iter(jax.random.split(key, 48))
    f32 = jnp.float32

    def nrm(shape, scale):
        return jax.random.normal(next(ks), shape, f32) * scale

    def gain(n):
        return 1.0 + nrm((n,), 0.02)

    d = D_MODEL
    inp = {}
    inp['x_prompt'] = nrm((BATCH, SEQ, d), 1.0)
    inp['x_sample'] = nrm((DEC_BATCH, DEC_SEQ, d), 1.0)
    inp['cache_l0_ckv'] = nrm((DEC_BATCH, PAST_LEN, KV_LORA), 1.0)
    inp['cache_l0_krope'] = nrm((DEC_BATCH, PAST_LEN, QK_ROPE), 1.0)
    inp['c'] = nrm((DEC_BATCH, d), 1.0)
    inp['c_ctx'] = nrm((d,), 1.0)
    inp['l0_ada_w'] = nrm((d, 6 * d), d ** -0.5)
    inp['l0_ada_b'] = nrm((6 * d,), 0.02)
    inp['l0_w_in'] = nrm((d, W_IN0), d ** -0.5)
    inp['l0_conv_w'] = nrm((SHORT_CONV, 3 * HY_CH), SHORT_CONV ** -0.5)
    inp['l0_conv_b'] = nrm((3 * HY_CH,), 0.02)
    inp['l0_hf_w1'] = nrm((FILT_EMB, FILT_ORDER), FILT_EMB ** -0.5)
    inp['l0_hf_b1'] = nrm((FILT_ORDER,), 0.1)
    inp['l0_hf_freq'] = 1.0 + nrm((FILT_ORDER,), 0.1)
    inp['l0_hf_w2'] = nrm((FILT_ORDER, FILT_ORDER), FILT_ORDER ** -0.5)
    inp['l0_hf_b2'] = nrm((FILT_ORDER,), 0.1)
    inp['l0_hf_w3'] = nrm((FILT_ORDER, 2 * HY_CH), FILT_ORDER ** -0.5)
    inp['l0_hf_skip'] = nrm((HY_CH,), 0.5)
    inp['l0_q_norm'] = gain(Q_LORA)
    inp['l0_q_up'] = nrm((Q_LORA, MLA_HEADS * (QK_NOPE + QK_ROPE)), Q_LORA ** -0.5)
    inp['l0_kv_norm'] = gain(KV_LORA)
    inp['l0_kv_up'] = nrm((KV_LORA, MLA_HEADS * (QK_NOPE + V_HEAD)), KV_LORA ** -0.5)
    inp['l0_w_out'] = nrm((MIX_OUT0, d), BETA * MIX_OUT0 ** -0.5)
    inp['l0_ln1_g'] = gain(d)
    inp['l0_ln1_b'] = nrm((d,), 0.02)
    inp['l0_mlp_w1'] = nrm((d, D_FF), d ** -0.5)
    inp['l0_mlp_w2'] = nrm((D_FF, d), BETA * D_FF ** -0.5)
    inp['l0_ln2_g'] = gain(d)
    inp['l0_ln2_b'] = nrm((d,), 0.02)
    inp['l1_ada_w'] = nrm((d, 6 * d), d ** -0.5)
    inp['l1_ada_b'] = nrm((6 * d,), 0.02)
    inp['l1_w_out'] = nrm((d, d), BETA * d ** -0.5)
    inp['l1_ln1_g'] = gain(d)
    inp['l1_ln1_b'] = nrm((d,), 0.02)
    inp['l1_mlp_w1'] = nrm((d, D_FF), d ** -0.5)
    inp['l1_mlp_w2'] = nrm((D_FF, d), BETA * D_FF ** -0.5)
    inp['l1_ln2_g'] = gain(d)
    inp['l1_ln2_b'] = nrm((d,), 0.02)
    return inp


def reference(x_prompt, x_sample, cache_l0_ckv, cache_l0_krope, c, c_ctx,
              l0_ada_w, l0_ada_b, l0_w_in, l0_conv_w, l0_conv_b,
              l0_hf_w1, l0_hf_b1, l0_hf_freq, l0_hf_w2, l0_hf_b2, l0_hf_w3, l0_hf_skip,
              l0_q_norm, l0_q_up, l0_kv_norm, l0_kv_up, l0_w_out,
              l0_ln1_g, l0_ln1_b, l0_mlp_w1, l0_mlp_w2, l0_ln2_g, l0_ln2_b,
              l1_ada_w, l1_ada_b, l1_w_out, l1_ln1_g, l1_ln1_b,
              l1_mlp_w1, l1_mlp_w2, l1_ln2_g, l1_ln2_b):
    hyena_p = (l0_conv_w, l0_conv_b, l0_hf_w1, l0_hf_b1, l0_hf_freq, l0_hf_w2, l0_hf_b2, l0_hf_w3, l0_hf_skip)
    mla_p = (l0_q_norm, l0_q_up, l0_kv_norm, l0_kv_up)
    ada_w = (l0_ada_w, l1_ada_w)
    ada_b = (l0_ada_b, l1_ada_b)
    ln1 = ((l0_ln1_g, l0_ln1_b), (l1_ln1_g, l1_ln1_b))
    mlp = ((l0_mlp_w1, l0_mlp_w2), (l1_mlp_w1, l1_mlp_w2))
    ln2 = ((l0_ln2_g, l0_ln2_b), (l1_ln2_g, l1_ln2_b))

    xc, xs = x_prompt, x_sample
    ctx_ckv = None
    ctx_krope = None
    for l in range(DEPTH):
        mc = modulation(c_ctx[None, :], ada_w[l], ada_b[l])
        ms = modulation(c, ada_w[l], ada_b[l])
        g1, b1 = ln1[l]
        if l % 2 == 0:
            xc, ctx_ckv, ctx_krope = layer_ab_context(xc, mc, l0_w_in, hyena_p, mla_p, l0_w_out, g1, b1)
            xs = layer_ab_latent(xs, ms, cache_l0_ckv, cache_l0_krope, l0_w_in, hyena_p, mla_p, l0_w_out, g1, b1)
        else:
            xc = layer_c(xc, mc, l1_w_out, g1, b1)
            xs = layer_c(xs, ms, l1_w_out, g1, b1)
        w1, w2 = mlp[l]
        g2, b2 = ln2[l]
        xc = channel_mixer(xc, mc, w1, w2, g2, b2)
        xs = channel_mixer(xs, ms, w1, w2, g2, b2)
    return (xc, xs, ctx_ckv, ctx_krope)
```

```cpp
#include <hip/hip_runtime.h>
#include <hip/hip_bf16.h>
#include <cstdio>
#include <cstdint>
#include <cmath>
namespace pg8 {
#define PG8_LAS __attribute__((address_space(3)))
typedef unsigned short bf16_t;
typedef short bf16x8 __attribute__((ext_vector_type(8)));
typedef float f32x4 __attribute__((ext_vector_type(4)));
typedef unsigned u32x4 __attribute__((ext_vector_type(4)));
constexpr int BM = 256, BK = 64, HALF = 128, HTB = HALF * BK * 2  , STAGE_BYTES = 8 * HTB, NXCD = 8, WGM = 8;

__host__ __device__ __forceinline__ int lds_byte(int r, int c) { const int st = (r >> 4) * 2 + (c >> 5), rr = r & 15, cc = c & 31, ob = rr * 64 + cc * 2; return st * 1024 + (ob ^ (((ob >> 9) & 1) << 5)); }
__host__ __device__ __forceinline__ void stage_rc(int b, int& R, int& C) { const int st = b / 1024, sb = b % 1024, swz = sb ^ (((sb >> 9) & 1) << 5); R = (st >> 1) * 16 + swz / 64; C = (st & 1) * 32 + (swz % 64) / 2; }
__host__ __device__ __forceinline__ int perm32(int rho) { const int n = rho >> 4, i = rho & 15; return 8 * (i >> 2) + 4 * n + (i & 3); }

struct Unit { int pm, pn; };
struct Gemm { const bf16_t* A; const bf16_t* Bt; int M, N, K; };

struct StaticOrder {
    int nM, nN, nwg, G, c;
    __host__ __device__ void init(int M, int N, int G_, int c_) { nM = M / BM; nN = N / BM; nwg = nM * nN; G = G_; c = c_; }
    __host__ __device__ bool next(int i, Unit& u) const {
        const long L = (long)i * G + c; if (L >= nwg) return false;
        int wgid = (int)L; { const int q = nwg / NXCD, r = nwg % NXCD, xcd = wgid % NXCD, off = wgid / NXCD; wgid = (xcd < r ? xcd * (q + 1) : r * (q + 1) + (xcd - r) * q) + off; }
        const int nig = WGM * nN, gid = wgid / nig, fm = gid * WGM, gsz = (nM - fm) < WGM ? (nM - fm) : WGM;
        u.pm = fm + ((wgid % nig) % gsz); u.pn = (wgid % nig) / gsz; return true;
    }
    __device__ __forceinline__ void a_ready(const Unit&) const {}
    __device__ __forceinline__ void done(const Unit&) const {}
};

__device__ __forceinline__ unsigned cvt_pk_bf16(float lo, float hi) { unsigned r; asm volatile("v_cvt_pk_bf16_f32 %0, %1, %2" : "=v"(r) : "v"(lo), "v"(hi)); return r; }
template <class Epi, class Sched, bool ALIGN_EPI = false, bool SP2 = false>
__device__ __forceinline__ void gemm_phase(PG8_LAS unsigned char* lds, const Gemm g, const Sched& S, const Epi& E, const int tid) {
    const int wid = __builtin_amdgcn_readfirstlane(tid >> 6), lane = tid & 63, wr = wid >> 2, wc = wid & 3, fr = lane & 15, fq = lane >> 4;
    const int K = g.K, nt = K / BK;
    unsigned voffA[2], voffB[2];
#pragma unroll
    for (int i = 0; i < 2; ++i) { int R, C; stage_rc(tid * 16 + i * 8192, R, C); const int Rb = Epi::PERM ? ((R & ~31) + perm32(R & 31)) : R;
        voffA[i] = (unsigned)(R * K + C) * 2u; voffB[i] = (unsigned)(Rb * K + C) * 2u; }
    const size_t kstep = (size_t)(BK * 2);
    const size_t hstep = (size_t)HALF * K * 2;
    const size_t tstep = 2 * hstep;
    const unsigned ldsw = (unsigned)wid * 1024u;
    const int aoff = lds_byte(wr * 64 + fr, fq * 8), boff = lds_byte(wc * 32 + fr, fq * 8);
#define PG8_SA(b, h) (((b) * 2 + (h)) * HTB)
#define PG8_SB(b, h) ((4 + (b) * 2 + (h)) * HTB)
#define PG8_STAGE(bufoff, gbase, voff) do { _Pragma("unroll") for (int _i = 0; _i < 2; ++_i) \
        __builtin_amdgcn_global_load_lds((const unsigned*)((const char*)(gbase) + (voff)[_i]), (PG8_LAS unsigned*)(lds + (bufoff) + ldsw + _i * 8192), 16, 0, 0); } while (0)
#define PG8_LDA(dst, b, h) do { _Pragma("unroll") for (int m = 0; m < 4; ++m) _Pragma("unroll") for (int k = 0; k < 2; ++k) dst[m][k] = *(const PG8_LAS bf16x8*)(lds + PG8_SA(b, h) + aoff + m * 2048 + k * 1024); } while (0)
#define PG8_LDB(dst, b, h) do { _Pragma("unroll") for (int n = 0; n < 2; ++n) _Pragma("unroll") for (int k = 0; k < 2; ++k) dst[n][k] = *(const PG8_LAS bf16x8*)(lds + PG8_SB(b, h) + boff + n * 2048 + k * 1024); } while (0)
#define PG8_MMA(ai, bj, At, Bt) do { __builtin_amdgcn_s_setprio(1); _Pragma("unroll") for (int m = 0; m < 4; ++m) _Pragma("unroll") for (int n = 0; n < 2; ++n) _Pragma("unroll") for (int k = 0; k < 2; ++k) \
        acc[ai][bj][m][n] = __builtin_amdgcn_mfma_f32_16x16x32_bf16(Bt[n][k], At[m][k], acc[ai][bj][m][n], 0, 0, 0); __builtin_amdgcn_s_setprio(0); } while (0)
#define PG8_WAIT_V(n) asm volatile("s_waitcnt vmcnt(" #n ")" ::: "memory")
#define PG8_WAIT_L(n) asm volatile("s_waitcnt lgkmcnt(" #n ")" ::: "memory")
#define PG8_BAR __builtin_amdgcn_s_barrier()
#define PG8_SCHED __builtin_amdgcn_sched_barrier(0)
    Unit cur, nxt; int ui = 0;
    if (!S.next(0, cur)) return;
    f32x4 acc[2][2][4][2];
#pragma unroll
    for (int a = 0; a < 2; ++a)
#pragma unroll
        for (int b = 0; b < 2; ++b)
#pragma unroll
            for (int m = 0; m < 4; ++m)
#pragma unroll
                for (int n = 0; n < 2; ++n) acc[a][b][m][n] = (f32x4){0.f, 0.f, 0.f, 0.f};
    bf16x8 At[4][2], B0[2][2], B1[2][2];
    const char* cA = (const char*)g.A + (size_t)cur.pm * tstep; const char* cB = (const char*)g.Bt + (size_t)cur.pn * tstep;
    S.a_ready(cur);
    if constexpr (SP2) {
        PG8_STAGE(PG8_SB(0, 0), cB, voffB); PG8_STAGE(PG8_SB(0, 1), cB + hstep, voffB); PG8_STAGE(PG8_SA(0, 0), cA, voffA); PG8_STAGE(PG8_SA(0, 1), cA + hstep, voffA);
        if (wr == 1) PG8_BAR;
        PG8_WAIT_V(2); PG8_BAR;
        PG8_STAGE(PG8_SB(1, 0), cB + kstep, voffB); PG8_STAGE(PG8_SA(1, 0), cA + kstep, voffA); PG8_STAGE(PG8_SB(1, 1), cB + hstep + kstep, voffB);
        PG8_WAIT_V(6); PG8_BAR;
    } else {
        PG8_STAGE(PG8_SB(0, 0), cB, voffB); PG8_STAGE(PG8_SA(0, 0), cA, voffA); PG8_STAGE(PG8_SB(0, 1), cB + hstep, voffB); PG8_STAGE(PG8_SA(0, 1), cA + hstep, voffA);
        if (wr == 1) PG8_BAR;
        PG8_WAIT_V(4); PG8_BAR;
        PG8_STAGE(PG8_SB(1, 0), cB + kstep, voffB); PG8_STAGE(PG8_SA(1, 0), cA + kstep, voffA); PG8_STAGE(PG8_SB(1, 1), cB + hstep + kstep, voffB);
        PG8_WAIT_V(6); PG8_BAR;
    }
    for (;;) {
        const bool has_next = S.next(ui + 1, nxt);
        const char* nA = has_next ? (const char*)g.A + (size_t)nxt.pm * tstep : cA; const char* nB = has_next ? (const char*)g.Bt + (size_t)nxt.pn * tstep : cB;
        for (int t = 0; t < nt; t += 2) {
            const bool last = (t == nt - 2);
            const char* a1 = cA + (size_t)(t + 1) * kstep;
            const char* a2 = last ? nA : cA + (size_t)(t + 2) * kstep; const char* b2 = last ? nB : cB + (size_t)(t + 2) * kstep;
            const char* a3 = a2 + kstep; const char* b3 = b2 + kstep;
            if (last && has_next) S.a_ready(nxt);
            if constexpr (SP2) {
            PG8_LDB(B0, 0, 0); PG8_LDB(B1, 0, 1); PG8_SCHED; PG8_LDA(At, 0, 0); PG8_STAGE(PG8_SA(1, 1), a1 + hstep, voffA);
            PG8_WAIT_V(8); PG8_WAIT_L(0); PG8_BAR; PG8_MMA(0, 0, At, B0); PG8_MMA(0, 1, At, B1); PG8_BAR; PG8_SCHED;
            PG8_LDA(At, 0, 1); PG8_STAGE(PG8_SB(0, 0), b2, voffB); PG8_STAGE(PG8_SB(0, 1), b2 + hstep, voffB); PG8_STAGE(PG8_SA(0, 0), a2, voffA);
            PG8_WAIT_V(8); PG8_WAIT_L(0); PG8_BAR; PG8_MMA(1, 0, At, B0); PG8_MMA(1, 1, At, B1); PG8_BAR; PG8_SCHED;
            PG8_LDB(B0, 1, 0); PG8_LDB(B1, 1, 1); PG8_SCHED; PG8_LDA(At, 1, 0); PG8_STAGE(PG8_SA(0, 1), a2 + hstep, voffA);
            PG8_WAIT_V(8); PG8_WAIT_L(0); PG8_BAR; PG8_MMA(0, 0, At, B0); PG8_MMA(0, 1, At, B1); PG8_BAR; PG8_SCHED;
            PG8_LDA(At, 1, 1); PG8_STAGE(PG8_SB(1, 0), b3, voffB); PG8_STAGE(PG8_SB(1, 1), b3 + hstep, voffB); PG8_STAGE(PG8_SA(1, 0), a3, voffA);
            PG8_WAIT_V(8); PG8_WAIT_L(0); PG8_BAR; PG8_MMA(1, 0, At, B0); PG8_MMA(1, 1, At, B1); PG8_BAR; PG8_SCHED;
            } else {
            PG8_LDB(B0, 0, 0); PG8_SCHED; PG8_LDA(At, 0, 0); PG8_STAGE(PG8_SA(1, 1), a1 + hstep, voffA);
            PG8_WAIT_L(8); PG8_BAR; PG8_WAIT_L(0); PG8_MMA(0, 0, At, B0); PG8_BAR; PG8_SCHED;
            PG8_LDB(B1, 0, 1); PG8_STAGE(PG8_SB(0, 0), b2, voffB);
            PG8_BAR; PG8_WAIT_L(0); PG8_MMA(0, 1, At, B1); PG8_BAR;
            PG8_LDA(At, 0, 1); PG8_STAGE(PG8_SA(0, 0), a2, voffA);
            PG8_BAR; PG8_WAIT_L(0); PG8_MMA(1, 0, At, B0); PG8_BAR; PG8_SCHED;
            PG8_STAGE(PG8_SB(0, 1), b2 + hstep, voffB);
            PG8_WAIT_V(6); PG8_BAR; PG8_MMA(1, 1, At, B1); PG8_BAR;
            PG8_LDB(B0, 1, 0); PG8_SCHED; PG8_LDA(At, 1, 0); PG8_STAGE(PG8_SA(0, 1), a2 + hstep, voffA);
            PG8_WAIT_L(8); PG8_BAR; PG8_WAIT_L(0); PG8_MMA(0, 0, At, B0); PG8_BAR; PG8_SCHED;
            PG8_LDB(B1, 1, 1); PG8_STAGE(PG8_SB(1, 0), b3, voffB);
            PG8_BAR; PG8_WAIT_L(0); PG8_MMA(0, 1, At, B1); PG8_BAR;
            PG8_LDA(At, 1, 1); PG8_STAGE(PG8_SA(1, 0), a3, voffA);
            PG8_BAR; PG8_WAIT_L(0); PG8_MMA(1, 0, At, B0); PG8_BAR; PG8_SCHED;
            PG8_STAGE(PG8_SB(1, 1), b3 + hstep, voffB);
            PG8_WAIT_V(6); PG8_BAR; PG8_MMA(1, 1, At, B1); PG8_BAR;
            }
        }
        if constexpr (ALIGN_EPI) { if (wr == 0) PG8_BAR; }
        if constexpr (!Epi::AFTER_DRAIN) { E(acc, cur, wr, wc, fr, fq); S.done(cur); }
        if (!has_next) break;
#pragma unroll
        for (int a = 0; a < 2; ++a)
#pragma unroll
            for (int b = 0; b < 2; ++b)
#pragma unroll
                for (int m = 0; m < 4; ++m)
#pragma unroll
                    for (int n = 0; n < 2; ++n) acc[a][b][m][n] = (f32x4){0.f, 0.f, 0.f, 0.f};
        cur = nxt; cA = nA; cB = nB; ++ui;
        if constexpr (ALIGN_EPI) { if (wr == 1) PG8_BAR; }
    }
    PG8_WAIT_V(0);
    if constexpr (!ALIGN_EPI) { if (wr == 0) PG8_BAR; }
    PG8_BAR;
    if constexpr (Epi::AFTER_DRAIN) { E.fused(acc, cur, wr, wc, fr, fq, lds, wid, lane); S.done(cur); }
#undef PG8_SA
#undef PG8_SB
#undef PG8_STAGE
#undef PG8_LDA
#undef PG8_LDB
#undef PG8_MMA
#undef PG8_WAIT_V
#undef PG8_WAIT_L
#undef PG8_BAR
#undef PG8_SCHED
}
}
#ifndef PG8_SP2
#define PG8_SP2 true
#endif
#ifndef PG8_ALIGN
#define PG8_ALIGN true
#endif
#ifndef MK_PER_PHASE
#define MK_PER_PHASE 0
#endif

constexpr int DM = 1024, FF = 4096;
constexpr int LP = 256, BP = 16, LS = 4096, BS = 2, PAST = 256;
constexpr int NP = BP * LP;
constexpr int NSR = BS * LS;
constexpr int MT = NP + NSR;
constexpr int MKV = MT + BS * PAST;
constexpr int LKS = LS + PAST;
constexpr int HY = 512, NH = 4, DQK = 192, DNOPE = 128, DROPE = 64, DVH = 128, QL = 256, KVL = 128;
constexpr int WINP = 2048;
constexpr float LN_EPS = 1e-5f, RMS_EPS = 1e-6f, ALPHA = 1.41421356237309515f;
constexpr int NPHASE = 17;

constexpr int att_shm_bytes = 2 * 16384 + 2 * 24576 + 2048 + 8 * 8 * 1024;
constexpr size_t MiB = 1u << 20, KiB = 1024;
constexpr size_t WS_CTL = 0, CTL_ZERO_BYTES = 1 * MiB;
constexpr size_t WS_MODS = 1 * MiB;
constexpr size_t WS_D256 = 1 * MiB + 256 * KiB;
constexpr size_t WS_H2 = 1 * MiB + 512 * KiB;
constexpr size_t WS_FPART_S = 3 * MiB;
constexpr size_t WS_FPART_P = 3 * MiB + 256 * KiB;
constexpr size_t WS_WIN_T = 4 * MiB, WS_QUP_T = 8 * MiB, WS_KVUP_T = 8 * MiB + 512 * KiB, WS_WOUT0_T = 9 * MiB;
constexpr size_t WS_W1_0 = 11 * MiB, WS_W2_0 = 19 * MiB, WS_W1_1 = 27 * MiB, WS_W2_1 = 35 * MiB, WS_WFOLD_T = 43 * MiB;
constexpr size_t WS_T = 48 * MiB;
constexpr size_t WS_FT_S = 48 * MiB, WS_FT_P = 64 * MiB, WS_UT_S = 65 * MiB, WS_UT_P = 73 * MiB;
constexpr size_t WS_D4096 = 96 * MiB;
constexpr size_t WS_KF_S = 96 * MiB, WS_KF_P = 109 * MiB, WS_V_S = 115 * MiB, WS_V_P = 124 * MiB;
constexpr size_t WS_H = 128 * MiB;
constexpr size_t WS_P = 152 * MiB, WS_ZS = 188 * MiB, WS_QN = 212 * MiB, WS_KVN = 218 * MiB, WS_Q = 225 * MiB, WS_X0 = 243 * MiB;
constexpr size_t WS_HID = 152 * MiB, WS_UV = 152 * MiB;
constexpr size_t WS_END = 256 * MiB;
constexpr int CW_TMO = 0, CW_Q = 64, CW_BAR = 4096;

constexpr int RING_BYTES = 131072, LDSCTL_OFF = 160 * 1024 - 512, MISC_OFF = LDSCTL_OFF + 320, LDS_BYTES = 160 * 1024;
static_assert(att_shm_bytes <= LDSCTL_OFF, "attention scratch fits below the LDS control words");

#define GAS __attribute__((address_space(1)))
#define LAS __attribute__((address_space(3)))
typedef unsigned short bf16;
typedef unsigned v4u __attribute__((ext_vector_type(4)));
typedef unsigned v2u __attribute__((ext_vector_type(2)));
typedef float f32x4 __attribute__((ext_vector_type(4)));
typedef GAS unsigned gu32;
#define RLX_AGENT __ATOMIC_RELAXED, __HIP_MEMORY_SCOPE_AGENT
#define LDS_WAIT() asm volatile("s_waitcnt lgkmcnt(0)" ::: "memory")
__device__ __forceinline__ unsigned f2bf(float f) { unsigned u = __builtin_bit_cast(unsigned, f); return (u + 0x7fffu + ((u >> 16) & 1u)) >> 16; }
__device__ __forceinline__ unsigned pk2(float lo, float hi) { return f2bf(lo) | (f2bf(hi) << 16); }
__device__ __forceinline__ float bf2f(unsigned short b) { return __builtin_bit_cast(float, (unsigned)b << 16); }
__device__ __forceinline__ float wave_sum(float v) {
#pragma unroll
    for (int o = 1; o < 64; o <<= 1) v += __shfl_xor(v, o);
    return v;
}
__device__ __forceinline__ float fsin_rev(float rev) { return __builtin_amdgcn_sinf(__builtin_amdgcn_fractf(rev)); }
__device__ __forceinline__ float fcos_rev(float rev) { return __builtin_amdgcn_cosf(__builtin_amdgcn_fractf(rev)); }
constexpr float INV_2PI = 0.15915494309189535f;
__device__ __forceinline__ float fexp(float x) { return __builtin_amdgcn_exp2f(x * 1.4426950408889634f); }

__device__ __forceinline__ int fresh_lane() { int l; asm volatile("v_mbcnt_lo_u32_b32 %0, -1, 0\n\tv_mbcnt_hi_u32_b32 %0, -1, %0" : "=v"(l)); return l; }
#define XB_TMO      128
#define XB_XCNT(j)  (256  + 64 * (j))
#define XB_XSUB(j)  (1280 + 64 * (j))
#define XB_XGEN(j)  (2304 + 64 * (j))
#define XB_TOP      3328
#define XB_TOPGEN   3392
#define XCD_BAR_WORDS 3456
#define XB_SPIN_CAP (1u << 23)
__device__ __forceinline__ unsigned xb_ld(unsigned* p)              { return __hip_atomic_load(p, __ATOMIC_RELAXED, __HIP_MEMORY_SCOPE_AGENT); }
__device__ __forceinline__ unsigned xb_add(unsigned* p, unsigned v) { return __hip_atomic_fetch_add(p, v, __ATOMIC_RELAXED, __HIP_MEMORY_SCOPE_AGENT); }
__device__ __forceinline__ unsigned xb_xcc_id() { return (unsigned)__builtin_amdgcn_s_getreg((3 << 11) | 20) & 0xFu; }
#define XB_SPIN(cond, bar) do { unsigned _sp = 0; while (cond) { __builtin_amdgcn_s_sleep(1); \
    if ((++_sp & 255u) == 0u) { if (xb_ld(&(bar)[XB_TMO])) break; if (_sp > XB_SPIN_CAP) { atomicAdd(&(bar)[XB_TMO], 1u); break; } } } } while (0)
struct XcdBarrier { unsigned* bar; unsigned x; volatile LAS unsigned* st; };
__device__ __forceinline__ XcdBarrier xcd_barrier_post(unsigned* bar, volatile LAS unsigned* st) {
    XcdBarrier b; b.bar = bar; b.x = xb_xcc_id(); b.st = st;
    if (threadIdx.x == 0) (void)xb_add(&bar[XB_XCNT(b.x)], 1u);
    return b;
}
__device__ __forceinline__ void xcd_barrier_complete(unsigned* bar, unsigned x, unsigned& nloc, unsigned& nx) {
    const unsigned G = gridDim.x * gridDim.y * gridDim.z;
    unsigned sum, cnt, mine, sp = 0u;
    for (;;) {
        sum = 0u; cnt = 0u; mine = 0u;
#pragma unroll
        for (unsigned j = 0; j < 16; ++j) { const unsigned c = xb_ld(&bar[XB_XCNT(j)]); sum += c; cnt += (c > 0u) ? 1u : 0u; mine = (j == x) ? c : mine; }
        if (sum == G) break;
        __builtin_amdgcn_s_sleep(1);
        if ((++sp & 255u) == 0u) { if (xb_ld(&bar[XB_TMO])) break; if (sp > XB_SPIN_CAP) { atomicAdd(&bar[XB_TMO], 1u); break; } }
    }
    nloc = mine > 0u ? mine : 1u; nx = cnt > 0u ? cnt : 1u;
}
__device__ __forceinline__ void xcd_barrier(const XcdBarrier& b) {
    asm volatile("s_waitcnt vmcnt(0)" ::: "memory");
    __syncthreads();
    if (threadIdx.x == 0) {
        unsigned* bar = b.bar;
        __builtin_amdgcn_s_waitcnt(0);
        unsigned nloc = b.st[0], nx = b.st[1];
        if (nloc == 0u) { xcd_barrier_complete(bar, b.x, nloc, nx); b.st[0] = nloc; b.st[1] = nx; }
        const unsigned old = xb_add(&bar[XB_XSUB(b.x)], 1u);
        const unsigned gen = old / nloc;
        if (old + 1u == (gen + 1u) * nloc) {
            __builtin_amdgcn_fence(__ATOMIC_RELEASE, "agent");
            asm volatile("s_waitcnt vmcnt(0)" ::: "memory");
            const unsigned og = xb_add(&bar[XB_TOP], 1u);
            const unsigned tg = og / nx;
            if (og + 1u == (tg + 1u) * nx) xb_add(&bar[XB_TOPGEN], 1u);
            else XB_SPIN(xb_ld(&bar[XB_TOPGEN]) == tg, bar);
            __builtin_amdgcn_fence(__ATOMIC_ACQUIRE, "agent");
            xb_add(&bar[XB_XGEN(b.x)], 1u);
            asm volatile("s_waitcnt vmcnt(0)" ::: "memory");
        } else {
            XB_SPIN(xb_ld(&bar[XB_XGEN(b.x)]) == gen, bar);
            __builtin_amdgcn_fence(__ATOMIC_ACQUIRE, "agent");
            asm volatile("s_waitcnt vmcnt(0)" ::: "memory");
        }
    }
    __syncthreads();
}

struct Args { const float* in[38]; float* out; unsigned char* ws; int ph_lo, ph_hi; };
enum { I_XP = 0, I_XS, I_CKV, I_CKR, I_C, I_CCTX, I_ADA0_W, I_ADA0_B, I_WIN, I_CONVW, I_CONVB, I_HFW1, I_HFB1, I_HFFREQ, I_HFW2, I_HFB2, I_HFW3, I_HFSKIP,
       I_QNORM, I_QUP, I_KVNORM, I_KVUP, I_WOUT0, I_LN1G0, I_LN1B0, I_W1_0, I_W2_0, I_LN2G0, I_LN2B0, I_ADA1_W, I_ADA1_B, I_WOUT1, I_LN1G1, I_LN1B1, I_W1_1, I_W2_1, I_LN2G1, I_LN2B1 };
constexpr size_t OUT_CKV = (size_t)MT * DM, OUT_CKR = OUT_CKV + (size_t)NP * KVL;

__device__ __forceinline__ int req_of_row(int m) { return m < NP ? 0 : 1 + (m - NP) / LS; }

using pg8::f32x4; using pg8::Unit; using pg8::BM; using pg8::HALF; using pg8::cvt_pk_bf16;
typedef unsigned u32x4 __attribute__((ext_vector_type(4)));
__device__ __forceinline__ u32x4 pack8(const f32x4& a, const f32x4& b) { u32x4 w; w.x = cvt_pk_bf16(a[0], a[1]); w.y = cvt_pk_bf16(a[2], a[3]); w.z = cvt_pk_bf16(b[0], b[1]); w.w = cvt_pk_bf16(b[2], b[3]); return w; }

struct EpiWin {
    static constexpr bool PERM = true, AFTER_DRAIN = false;
    bf16* P; float* ZS;
    __device__ __forceinline__ void operator()(const f32x4 (&acc)[2][2][4][2], const Unit& u, int wr, int wc, int fr, int fq) const {
        const int row0 = u.pm * BM + wr * 64 + fr, colt = u.pn * BM + wc * 32 + 8 * fq;
#pragma unroll
        for (int ai = 0; ai < 2; ++ai)
#pragma unroll
            for (int m = 0; m < 4; ++m) { const int row = row0 + ai * HALF + m * 16;
#pragma unroll
                for (int bj = 0; bj < 2; ++bj) { const int col = colt + bj * HALF;
                    if (u.pn < 6) *(u32x4*)(P + (size_t)row * 1536 + col) = pack8(acc[ai][bj][m][0], acc[ai][bj][m][1]);
                    else { float* d = ZS + (size_t)row * 512 + (col - 1536); *(f32x4*)d = acc[ai][bj][m][0]; *(f32x4*)(d + 4) = acc[ai][bj][m][1]; } } }
    }
};
struct EpiQ {
    static constexpr bool PERM = true, AFTER_DRAIN = false;
    bf16* Q;
    __device__ __forceinline__ void operator()(const f32x4 (&acc)[2][2][4][2], const Unit& u, int wr, int wc, int fr, int fq) const {
        const int row0 = u.pm * BM + wr * 64 + fr, colt = u.pn * BM + wc * 32 + 8 * fq;
#pragma unroll
        for (int ai = 0; ai < 2; ++ai)
#pragma unroll
            for (int m = 0; m < 4; ++m) { const int row = row0 + ai * HALF + m * 16;
#pragma unroll
                for (int bj = 0; bj < 2; ++bj) *(u32x4*)(Q + (size_t)row * 768 + colt + bj * HALF) = pack8(acc[ai][bj][m][0], acc[ai][bj][m][1]); }
    }
};
struct EpiKV {
    static constexpr bool PERM = true, AFTER_DRAIN = false;
    bf16 *KFs, *KFp, *Vs, *Vp;
    __device__ __forceinline__ void operator()(const f32x4 (&acc)[2][2][4][2], const Unit& u, int wr, int wc, int fr, int fq) const {
        const int m0 = u.pm * BM; bf16* kf; bf16* vv; int lk, key0, b;
        if (m0 < NP) { b = m0 / LP; key0 = 0; lk = LP; kf = KFp; vv = Vp; }
        else if (m0 < MT) { b = (m0 - NP) / LS; key0 = (m0 - NP) % LS; lk = LKS; kf = KFs; vv = Vs; }
        else { b = (m0 - MT) / PAST; key0 = LS + (m0 - MT) % PAST; lk = LKS; kf = KFs; vv = Vs; }
        const int h = u.pn;
        int rloc = wr * 64 + fr, c8 = wc * 32 + 8 * fq; asm volatile("" : "+v"(rloc), "+v"(c8));
#pragma unroll
        for (int ai = 0; ai < 2; ++ai)
#pragma unroll
            for (int m = 0; m < 4; ++m) { const int key = key0 + rloc + ai * HALF + m * 16; const size_t kr = (size_t)(b * NH + h) * lk + key;
                *(u32x4*)(kf + kr * DQK + c8) = pack8(acc[ai][0][m][0], acc[ai][0][m][1]);
                *(u32x4*)(vv + kr * DVH + c8) = pack8(acc[ai][1][m][0], acc[ai][1][m][1]); }
    }
};
struct EpiRes {
    static constexpr bool PERM = false, AFTER_DRAIN = false;
    const float* xp; const float* xs; const float* gate;
    float* T;
    __device__ __forceinline__ void operator()(const f32x4 (&acc)[2][2][4][2], const Unit& u, int wr, int wc, int fr, int fq) const {
        const int m0 = u.pm * BM, row0 = m0 + wr * 64 + fr, col0 = u.pn * BM + wc * 32 + 4 * fq;
        const float* g = gate + (size_t)req_of_row(m0) * 6144;
        f32x4 gv[2][2];
#pragma unroll
        for (int bj = 0; bj < 2; ++bj)
#pragma unroll
            for (int n = 0; n < 2; ++n) gv[bj][n] = *(const f32x4*)(g + col0 + bj * HALF + n * 16);
#pragma unroll
        for (int ai = 0; ai < 2; ++ai)
#pragma unroll
            for (int m = 0; m < 4; ++m) { const int row = row0 + ai * HALF + m * 16;
                const float* xr = (row < NP) ? xp + (size_t)row * DM : xs + (size_t)(row - NP) * DM;
#pragma unroll
                for (int bj = 0; bj < 2; ++bj)
#pragma unroll
                    for (int n = 0; n < 2; ++n) { const int col = col0 + bj * HALF + n * 16; const f32x4 xv = *(const f32x4*)(xr + col);
                        *(f32x4*)(T + (size_t)row * DM + col) = xv * ALPHA + gv[bj][n] * acc[ai][bj][m][n]; } }
    }
};
struct EpiUp {
    static constexpr bool PERM = true, AFTER_DRAIN = false;
    bf16* H;
    __device__ __forceinline__ void operator()(const f32x4 (&acc)[2][2][4][2], const Unit& u, int wr, int wc, int fr, int fq) const {
        const int row0 = u.pm * BM + wr * 64 + fr, colt = u.pn * BM + wc * 32 + 8 * fq;
#pragma unroll
        for (int ai = 0; ai < 2; ++ai)
#pragma unroll
            for (int m = 0; m < 4; ++m) { const int row = row0 + ai * HALF + m * 16;
#pragma unroll
                for (int bj = 0; bj < 2; ++bj) { f32x4 a = acc[ai][bj][m][0], b = acc[ai][bj][m][1];
#pragma unroll
                    for (int e = 0; e < 4; ++e) { const float x = fmaxf(a[e], 0.f), y = fmaxf(b[e], 0.f); a[e] = x * x; b[e] = y * y; }
                    *(u32x4*)(H + (size_t)row * FF + colt + bj * HALF) = pack8(a, b); } }
    }
};
struct EpiDft {
    static constexpr bool PERM = true, AFTER_DRAIN = false;
    bf16* UV; int L, tokbase;
    __device__ __forceinline__ void operator()(const f32x4 (&acc)[2][2][4][2], const Unit& u, int wr, int wc, int fr, int fq) const {
        const int rho0 = u.pm * BM + wr * 64 + fr, n0 = u.pn * BM + wc * 32 + 8 * fq, hl = L >> 1;
#pragma unroll
        for (int ai = 0; ai < 2; ++ai)
#pragma unroll
            for (int m = 0; m < 4; ++m) { const int rho = rho0 + ai * HALF + m * 16; const int part = rho > hl ? 1 : 0; const int k = part ? rho - hl : rho;
#pragma unroll
                for (int bj = 0; bj < 2; ++bj) { const int n = n0 + bj * HALF, b = n >> 10, c = n & 1023;
                    const f32x4 a0 = acc[ai][bj][m][0], a1 = acc[ai][bj][m][1];
                    bf16* r1 = UV + (size_t)(tokbase + b * L + k) * 2048 + part * 1024 + c;
                    *(u32x4*)r1 = pack8(a0, a1);
                    if (k != 0 && k != hl) { bf16* r2 = UV + (size_t)(tokbase + b * L + (L - k)) * 2048 + part * 1024 + c;
                        *(u32x4*)r2 = part ? pack8(-a0, -a1) : pack8(a0, a1); }
                    else if (part == 0) *(u32x4*)(r1 + 1024) = (u32x4){0u, 0u, 0u, 0u}; } }
    }
};

namespace att {
using bf16x8 = __attribute__((ext_vector_type(8))) short;
using s16x4  = __attribute__((ext_vector_type(4))) short;
using f32x16 = __attribute__((ext_vector_type(16))) float;
constexpr int DK = 192, DV = 128, NW = 8, QBLK = 32, KVBLK = 64;
constexpr float SCALE = 0.07216878364870322f;
constexpr float THR = 8.f;
constexpr int SHM_V = KVBLK * DV * 2, SHM_K = KVBLK * DK * 2, SHM_QR = 2 * SHM_V + 2 * SHM_K + NW * 64 * 4, NQR = 4  , SHM_ATTN = SHM_QR + NW * (12 - NQR) * 1024;
#define KSWZ(row, colB) ((row) * 384 + ((colB) ^ (((row) & 7) << 4)))
#define SBAR() __builtin_amdgcn_sched_barrier(0)
__device__ __forceinline__ int crow(int r, int hi) { return (r & 3) + 8 * (r >> 2) + 4 * hi; }
__device__ __forceinline__ unsigned cvtpk(float lo, float hi) { unsigned r; asm volatile("v_cvt_pk_bf16_f32 %0, %1, %2" : "=v"(r) : "v"(lo), "v"(hi)); return r; }
__device__ __forceinline__ void partialSM(f32x16& p0, f32x16& p1, float& m_reg, float& mn, float& alpha) {
  constexpr float C = SCALE * 1.4426950408889634f;
  float pmax = p0[0];
#pragma unroll
  for (int r = 1; r < 16; ++r) pmax = fmaxf(pmax, p0[r]);
#pragma unroll
  for (int r = 0; r < 16; ++r) pmax = fmaxf(pmax, p1[r]);
  { auto rr = __builtin_amdgcn_permlane32_swap(__float_as_uint(pmax), __float_as_uint(pmax), false, false);
    pmax = fmaxf(__uint_as_float(rr[0]), __uint_as_float(rr[1])); }
  if (__builtin_expect(__all(pmax - m_reg <= THR / SCALE), 1)) { mn = m_reg; alpha = 1.f; }
  else { mn = fmaxf(m_reg, pmax); alpha = __builtin_amdgcn_exp2f((m_reg - mn) * C); m_reg = mn; }
  float mnC = -mn * C;
#pragma unroll
  for (int r = 0; r < 16; ++r) p0[r] = fmaf(p0[r], C, mnC);
#pragma unroll
  for (int r = 0; r < 16; ++r) p1[r] = fmaf(p1[r], C, mnC);
#pragma unroll
  for (int r = 0; r < 16; ++r) p0[r] = __builtin_amdgcn_exp2f(p0[r]);
}
__device__ __forceinline__ void finishSM(f32x16& p0, f32x16& p1, float alpha, float& l_reg, bf16x8& pa0, bf16x8& pa1, bf16x8& pa2, bf16x8& pa3) {
#pragma unroll
  for (int r = 0; r < 16; ++r) p1[r] = __builtin_amdgcn_exp2f(p1[r]);
  float ps = 0;
#pragma unroll
  for (int r = 0; r < 16; ++r) ps += p0[r];
#pragma unroll
  for (int r = 0; r < 16; ++r) ps += p1[r];
  { auto rr = __builtin_amdgcn_permlane32_swap(__float_as_uint(ps), __float_as_uint(ps), false, false);
    ps = __uint_as_float(rr[0]) + __uint_as_float(rr[1]); }
  l_reg = l_reg * alpha + ps;
#define PK4(P, BASE, OUT) do { unsigned a0 = cvtpk(P[BASE + 0], P[BASE + 1]), a1 = cvtpk(P[BASE + 2], P[BASE + 3]);   \
    unsigned b0 = cvtpk(P[BASE + 4], P[BASE + 5]), b1 = cvtpk(P[BASE + 6], P[BASE + 7]);                              \
    auto r0 = __builtin_amdgcn_permlane32_swap(a0, b0, false, false); auto r1 = __builtin_amdgcn_permlane32_swap(a1, b1, false, false); \
    u32x4 w = {r0[0], r1[0], r0[1], r1[1]}; OUT = __builtin_bit_cast(bf16x8, w); } while (0)
  PK4(p0, 0, pa0); PK4(p0, 8, pa1); PK4(p1, 0, pa2); PK4(p1, 8, pa3);
#undef PK4
}
__device__ __forceinline__ void qkt(f32x16& p0, f32x16& p1, const LAS char* Ks, const bf16x8* qr, const LAS char* qrl, int r32, int hi) {
  p0 = f32x16{}; p1 = f32x16{};
#pragma unroll
  for (int d0 = 0; d0 < 12; ++d0) { const int cb = (d0 * 16 + hi * 8) * 2;
    bf16x8 b0 = *reinterpret_cast<const LAS bf16x8*>(Ks + KSWZ(r32, cb));
    bf16x8 b1 = *reinterpret_cast<const LAS bf16x8*>(Ks + KSWZ(32 + r32, cb));
    const bf16x8 qf = d0 < NQR ? qr[d0 < NQR ? d0 : 0] : *reinterpret_cast<const LAS bf16x8*>(qrl + (d0 - NQR) * 1024);
    p0 = __builtin_amdgcn_mfma_f32_32x32x16_bf16(b0, qf, p0, 0, 0, 0);
    p1 = __builtin_amdgcn_mfma_f32_32x32x16_bf16(b1, qf, p1, 0, 0, 0); }
}
__device__ __forceinline__ int v_st(int k, int c) { const int kk = (k & ~0xC) | ((k & 4) << 1) | ((k & 8) >> 1); return ((kk >> 3) * 4 + (c >> 5)) * 512 + ((kk & 7) * 32 + (c & 31)) * 2; }
__device__ __forceinline__ int v_rd_base(int lane) { return ((lane & 3) << 3) | (((lane >> 2) & 3) << 6) | (((lane >> 4) & 1) << 5) | (((lane >> 5) & 1) << 8); }
constexpr int v_rd_off(int d0, int ks, int half) { return d0 * 512 + ks * 4096 + half * 2048; }
template <int OFF> __device__ __forceinline__ s16x4 tr_read(int vb) {
  s16x4 r; asm volatile("ds_read_b64_tr_b16 %0, %1 offset:%2" : "=&v"(r) : "v"(vb), "i"(OFF) : "memory"); return r;
}
template <int D0> __device__ __forceinline__ void pv_one(f32x16& od, int vb, bf16x8 pa0, bf16x8 pa1, bf16x8 pa2, bf16x8 pa3) {
  const s16x4 l0 = tr_read<v_rd_off(D0, 0, 0)>(vb), h0 = tr_read<v_rd_off(D0, 0, 1)>(vb), l1 = tr_read<v_rd_off(D0, 1, 0)>(vb), h1 = tr_read<v_rd_off(D0, 1, 1)>(vb);
  const s16x4 l2 = tr_read<v_rd_off(D0, 2, 0)>(vb), h2 = tr_read<v_rd_off(D0, 2, 1)>(vb), l3 = tr_read<v_rd_off(D0, 3, 0)>(vb), h3 = tr_read<v_rd_off(D0, 3, 1)>(vb);
  asm volatile("s_waitcnt lgkmcnt(0)" ::: "memory"); SBAR();
#define PK(L, H) (bf16x8){L[0], L[1], L[2], L[3], H[0], H[1], H[2], H[3]}
  od = __builtin_amdgcn_mfma_f32_32x32x16_bf16(pa0, PK(l0, h0), od, 0, 0, 0);
  od = __builtin_amdgcn_mfma_f32_32x32x16_bf16(pa1, PK(l1, h1), od, 0, 0, 0);
  od = __builtin_amdgcn_mfma_f32_32x32x16_bf16(pa2, PK(l2, h2), od, 0, 0, 0);
  od = __builtin_amdgcn_mfma_f32_32x32x16_bf16(pa3, PK(l3, h3), od, 0, 0, 0);
#undef PK
}
__device__ __forceinline__ void pv_d0(f32x16* o, int vb, bf16x8 pa0, bf16x8 pa1, bf16x8 pa2, bf16x8 pa3) {
  pv_one<0>(o[0], vb, pa0, pa1, pa2, pa3); pv_one<1>(o[1], vb, pa0, pa1, pa2, pa3); pv_one<2>(o[2], vb, pa0, pa1, pa2, pa3); pv_one<3>(o[3], vb, pa0, pa1, pa2, pa3);
}
constexpr int LDQ = 768, LDK = DK, LDV = DV, LDO = 1024;
__device__ __forceinline__ void attn_dense_body(const bf16* __restrict__ Qb, const bf16* __restrict__ Kh, const bf16* __restrict__ Vh, bf16* __restrict__ Ob, int seq, int pos0, LAS char* lds, const int tid) {
  const int wid = tid >> 6, lane = tid & 63, r32 = lane & 31, hi = lane >> 5;
  LAS char* V_lds = lds; LAS char* K_lds = lds + 2 * SHM_V;
  LAS float* ws = (LAS float*)(lds + 2 * SHM_V + 2 * SHM_K) + wid * 64; LAS float* li_l = ws; LAS float* al_l = ws + 32;
  float m_reg = -1e30f, l_reg = 0; f32x16 o[4] = {}; bf16x8 qr[NQR];
  const LAS char* qrl = lds + SHM_QR + wid * (12 - NQR) * 1024 + lane * 16;
  const bf16* Qw = Qb + (long)(wid * QBLK + r32) * LDQ + hi * 8;
#pragma unroll
  for (int d0 = 0; d0 < NQR; ++d0) qr[d0] = *reinterpret_cast<const bf16x8*>(Qw + d0 * 16);
  LAS char* qw = lds + SHM_QR + wid * (12 - NQR) * 1024 + lane * 16;
#pragma unroll
  for (int d0 = NQR; d0 < 8; ++d0) *(LAS bf16x8*)(qw + (d0 - NQR) * 1024) = *reinterpret_cast<const bf16x8*>(Qw + d0 * 16);
  {
    bf16x8 f0 = *reinterpret_cast<const bf16x8*>(Qw + 128), f1 = *reinterpret_cast<const bf16x8*>(Qw + 144), f2 = *reinterpret_cast<const bf16x8*>(Qw + 160), f3 = *reinterpret_cast<const bf16x8*>(Qw + 176);
    if (pos0 >= 0) { const int pos = pos0 + wid * QBLK + r32; const float pr = (float)(pos >> 6), pc = (float)(pos & 63);
#pragma unroll
      for (int i = 0; i < 8; ++i) { const float inv = __builtin_amdgcn_exp2f(-(float)(8 * hi + i) * (13.287712379549449f / 16.0f));
        { const float rev = pr * inv * INV_2PI, cs = fcos_rev(rev), sn = fsin_rev(rev); const float a = bf2f((unsigned short)f0[i]), b = bf2f((unsigned short)f1[i]);
          f0[i] = (short)f2bf(a * cs - b * sn); f1[i] = (short)f2bf(b * cs + a * sn); }
        { const float rev = pc * inv * INV_2PI, cs = fcos_rev(rev), sn = fsin_rev(rev); const float a = bf2f((unsigned short)f2[i]), b = bf2f((unsigned short)f3[i]);
          f2[i] = (short)f2bf(a * cs - b * sn); f3[i] = (short)f2bf(b * cs + a * sn); } } }
    *(LAS bf16x8*)(qw + (8 - NQR) * 1024) = f0; *(LAS bf16x8*)(qw + (9 - NQR) * 1024) = f1; *(LAS bf16x8*)(qw + (10 - NQR) * 1024) = f2; *(LAS bf16x8*)(qw + (11 - NQR) * 1024) = f3;
  }
  const int sr = tid >> 4, sc = (tid & 15) * 8, vst0 = v_st(sr, sc), vst1 = v_st(32 + sr, sc);
  const int kr = tid >> 3, kc = tid & 7, kgo = kr * LDK + kc * 8, kst = KSWZ(kr, kc * 16);
  const int vb0 = (int)(unsigned)(uintptr_t)V_lds + v_rd_base(lane);
  bf16x8 vs0, vs1, ks0, ks1, ks2;
#define SLOAD(k0) do { vs0 = *reinterpret_cast<const bf16x8*>(&Vh[(long)((k0) + sr) * LDV + sc]); vs1 = *reinterpret_cast<const bf16x8*>(&Vh[(long)((k0) + 32 + sr) * LDV + sc]); \
    ks0 = *reinterpret_cast<const bf16x8*>(&Kh[(long)(k0) * LDK + kgo]); ks1 = *reinterpret_cast<const bf16x8*>(&Kh[(long)(k0) * LDK + kgo + 64]); \
    ks2 = *reinterpret_cast<const bf16x8*>(&Kh[(long)(k0) * LDK + kgo + 128]); } while (0)
#define SWRITE(b) do { *(LAS bf16x8*)(V_lds + (b) * SHM_V + vst0) = vs0; *(LAS bf16x8*)(V_lds + (b) * SHM_V + vst1) = vs1; \
    *(LAS bf16x8*)(K_lds + (b) * SHM_K + kst) = ks0; *(LAS bf16x8*)(K_lds + (b) * SHM_K + kst + 128) = ks1; *(LAS bf16x8*)(K_lds + (b) * SHM_K + kst + 256) = ks2; } while (0)
#define SWAIT() asm volatile("s_waitcnt vmcnt(0)" ::: "memory")
#define RESC(a) do { if (__any((a) < 1.f)) { if (hi == 0) al_l[r32] = (a); asm volatile("s_waitcnt lgkmcnt(0)" ::: "memory"); \
    _Pragma("unroll") for (int d = 0; d < 4; ++d) _Pragma("unroll") for (int r = 0; r < 16; ++r) o[d][r] *= al_l[crow(r, hi)]; } } while (0)
  f32x16 pA0, pA1, pB0, pB1; float mnA, mnB, alA, alB; bf16x8 pa0, pa1, pa2, pa3; const int NT = seq / KVBLK;
  SLOAD(0); SWAIT(); SWRITE(0); __syncthreads();
  qkt(pA0, pA1, K_lds, qr, qrl, r32, hi); partialSM(pA0, pA1, m_reg, mnA, alA);
  SLOAD(KVBLK);
  SWAIT(); SWRITE(1); __syncthreads();
  for (int j = 1; j + 1 < NT; j += 2) {
    SBAR(); qkt(pB0, pB1, K_lds + SHM_K, qr, qrl, r32, hi);
    finishSM(pA0, pA1, alA, l_reg, pa0, pa1, pa2, pa3); SBAR();
    SLOAD((j + 1) * KVBLK); SBAR();
    pv_d0(o, vb0, pa0, pa1, pa2, pa3); partialSM(pB0, pB1, m_reg, mnB, alB);
    __syncthreads(); SWAIT(); SWRITE(0);
    RESC(alB); __syncthreads();
    SBAR(); qkt(pA0, pA1, K_lds, qr, qrl, r32, hi);
    finishSM(pB0, pB1, alB, l_reg, pa0, pa1, pa2, pa3); SBAR();
    SLOAD((j + 2) * KVBLK); SBAR();
    pv_d0(o, vb0 + SHM_V, pa0, pa1, pa2, pa3); partialSM(pA0, pA1, m_reg, mnA, alA);
    __syncthreads(); SWAIT(); SWRITE(1);
    RESC(alA); __syncthreads();
  }
  SBAR(); qkt(pB0, pB1, K_lds + SHM_K, qr, qrl, r32, hi);
  finishSM(pA0, pA1, alA, l_reg, pa0, pa1, pa2, pa3); SBAR();
  pv_d0(o, vb0, pa0, pa1, pa2, pa3); partialSM(pB0, pB1, m_reg, mnB, alB);
  __syncthreads(); RESC(alB);
  finishSM(pB0, pB1, alB, l_reg, pa0, pa1, pa2, pa3); SBAR();
  pv_d0(o, vb0 + SHM_V, pa0, pa1, pa2, pa3);
  if (hi == 0) li_l[r32] = l_reg; asm volatile("s_waitcnt lgkmcnt(0)" ::: "memory");
  float rli[16];
#pragma unroll
  for (int r = 0; r < 16; ++r) rli[r] = __builtin_amdgcn_rcpf(li_l[crow(r, hi)]);
  bf16* Ow = Ob + (long)(wid * QBLK) * LDO;
#pragma unroll
  for (int r = 0; r < 16; ++r) { const int orow = crow(r, hi);
#pragma unroll
    for (int d0 = 0; d0 < 4; ++d0) Ow[(long)orow * LDO + d0 * 32 + r32] = (bf16)f2bf(o[d0][r] * rli[r]); }
  __syncthreads();
#undef SLOAD
#undef SWRITE
#undef SWAIT
#undef RESC
}
#undef KSWZ
#undef SBAR
}
__device__ __forceinline__ void transpose_item(const float* W, int K, int N, bf16* WT, int ldk, LAS float* scr, int item, int lane) {
    const int nblk = N / 32, kb = item / nblk, nb = item % nblk, k0 = 64 * kb, n0 = 32 * nb;
#pragma unroll 8
    for (int i = 0; i < 32; ++i) { const int kk = 2 * i + (lane >> 5); scr[kk * 33 + (lane & 31)] = W[(size_t)(k0 + kk) * N + n0 + (lane & 31)]; }
    LDS_WAIT(); asm volatile("" ::: "memory");
    const int c = lane & 7;
#pragma unroll
    for (int j = 0; j < 4; ++j) { const int n = (lane >> 3) + 8 * j; const LAS float* s = scr + (8 * c) * 33 + n;
        v4u o; o.x = pk2(s[0 * 33], s[1 * 33]); o.y = pk2(s[2 * 33], s[3 * 33]); o.z = pk2(s[4 * 33], s[5 * 33]); o.w = pk2(s[6 * 33], s[7 * 33]);
        *(v4u*)(WT + (size_t)(n0 + n) * ldk + k0 + 8 * c) = o; }
    LDS_WAIT(); asm volatile("" ::: "memory");
}
__device__ __forceinline__ void fold_item(const float* W, bf16* WT, LAS float* scr, const LAS float* tab  , int item, int lane) {
    const int kb = item / 32, nb = item % 32, k0 = 64 * kb, n0 = 32 * nb;
    const int n = n0 + (lane & 31);
    for (int i = 0; i < 32; ++i) { const int kk = 2 * i + (lane >> 5), kp = k0 + kk; const int part = kp >> 10, kq = kp & 1023, g = kq >> 7, cp = kq & 127;
        const float* wcol = W + (size_t)(g * 128) * DM + n; const LAS float* tb = tab + part * 128; float s = 0.f;
#pragma unroll 8
        for (int c = 0; c < 128; ++c) s += tb[(c * cp) & 127] * wcol[(size_t)c * DM];
        scr[kk * 33 + (lane & 31)] = (part ? -s : s) * 0.08838834764831845f; }
    LDS_WAIT(); asm volatile("" ::: "memory");
    const int c = lane & 7;
#pragma unroll
    for (int j = 0; j < 4; ++j) { const int nn = (lane >> 3) + 8 * j; const LAS float* s = scr + (8 * c) * 33 + nn;
        v4u o; o.x = pk2(s[0 * 33], s[1 * 33]); o.y = pk2(s[2 * 33], s[3 * 33]); o.z = pk2(s[4 * 33], s[5 * 33]); o.w = pk2(s[6 * 33], s[7 * 33]);
        *(v4u*)(WT + (size_t)(n0 + nn) * 2048 + k0 + 8 * c) = o; }
    LDS_WAIT(); asm volatile("" ::: "memory");
}
__device__ __forceinline__ void row_stats(const f32x4 (&v)[4], float& mean, float& rstd) {
    float s = 0.f;
#pragma unroll
    for (int j = 0; j < 4; ++j) s += (v[j][0] + v[j][1]) + (v[j][2] + v[j][3]);
    mean = wave_sum(s) * (1.f / DM); float q = 0.f;
#pragma unroll
    for (int j = 0; j < 4; ++j) { const f32x4 d = v[j] - mean; q += (d[0] * d[0] + d[1] * d[1]) + (d[2] * d[2] + d[3] * d[3]); }
    rstd = __builtin_amdgcn_rsqf(wave_sum(q) * (1.f / DM) + LN_EPS);
}
__device__ __forceinline__ void load_row(const float* p, int lane, f32x4 (&v)[4]) {
#pragma unroll
    for (int j = 0; j < 4; ++j) v[j] = ((const f32x4*)p)[lane + 64 * j];
}
__device__ __forceinline__ void adaln_store(const f32x4 (&v)[4], const float* shift, const float* scale, bf16* hrow, int lane) {
    float mean, rstd; row_stats(v, mean, rstd);
#pragma unroll
    for (int j = 0; j < 4; ++j) { const int c = 4 * lane + 256 * j; const f32x4 sc = *(const f32x4*)(scale + c), sh = *(const f32x4*)(shift + c);
        const f32x4 h = (v[j] - mean) * rstd * (sc + 1.0f) + sh;
        v2u w; w.x = pk2(h[0], h[1]); w.y = pk2(h[2], h[3]); *(v2u*)(hrow + c) = w; }
}
__device__ __forceinline__ void ln_affine(f32x4 (&v)[4], const float* g, const float* b, int lane) {
    float mean, rstd; row_stats(v, mean, rstd);
#pragma unroll
    for (int j = 0; j < 4; ++j) { const int c = 4 * lane + 256 * j; v[j] = (v[j] - mean) * rstd * *(const f32x4*)(g + c) + *(const f32x4*)(b + c); }
}
__device__ __forceinline__ void store_row(float* p, int lane, const f32x4 (&v)[4]) {
#pragma unroll
    for (int j = 0; j < 4; ++j) ((f32x4*)p)[lane + 64 * j] = v[j];
}

__global__ void __launch_bounds__(512, 2) fwd_kernel(Args args) {
    extern __shared__ __attribute__((aligned(16))) unsigned char lds_raw[];
    LAS unsigned char* lds = (LAS unsigned char*)lds_raw;
    volatile LAS unsigned* MISC = (volatile LAS unsigned*)(lds + MISC_OFF);
    const int wave = __builtin_amdgcn_readfirstlane((int)threadIdx.x >> 6);
    const int G = gridDim.x; const int bx = blockIdx.x; const int vcu = (G % 8 == 0) ? (bx % 8) * (G / 8) + bx / 8 : bx;
    const int gw = vcu * 8 + wave, NGW = G * 8, NGT = G * 512;
#define FRESH() const int lane = fresh_lane(); const int tid = wave * 64 + lane; const int gt = vcu * 512 + tid; (void)gt
    unsigned char* ws = args.ws;
    gu32* ctl = (gu32*)(ws + WS_CTL);
    float* MODS = (float*)(ws + WS_MODS);
    float* X = args.out;
    float* T = (float*)(ws + WS_T);
    bf16* HB = (bf16*)(ws + WS_H);
    for (int u = threadIdx.x; u < (LDS_BYTES - LDSCTL_OFF) / 4; u += 512) ((LAS unsigned*)(lds + LDSCTL_OFF))[u] = 0u;
    __syncthreads();
    XcdBarrier bar; bar.bar = (unsigned*)(ctl + CW_BAR); bar.x = 0; bar.st = nullptr;
    if (!MK_PER_PHASE) bar = xcd_barrier_post((unsigned*)(ctl + CW_BAR), MISC + 8);
    const int lo = args.ph_lo, hi = args.ph_hi;
#ifndef NO_CONV
#define NO_CONV 0
#endif
#ifndef NO_ATT
#define NO_ATT 0
#endif
#ifndef PHASE_MASK
#define PHASE_MASK 0x1FFFF
#endif
#define IN(k) ((((PHASE_MASK) >> (k)) & 1) && lo <= (k) && (k) < hi)
#define SEAM(k) do { if (IN(k) && IN((k) + 1)) xcd_barrier(bar); } while (0)

    if (IN(0)) {
        FRESH();
        asm volatile("; ==== PHASE 0 ====");
        for (int it = bx; it < 192; it += G) {
            const int layer = it / 96, cb = it % 96, col = cb * 64 + lane;
            LAS float* sil = (LAS float*)lds; LAS float* red = (LAS float*)(lds + 12288);
            for (int i = tid; i < 3072; i += 512) { const int r = i >> 10, k = i & 1023; const float c = (r == 0) ? args.in[I_CCTX][k] : args.in[I_C][(r - 1) * DM + k]; sil[i] = c / (1.f + fexp(-c)); }
            __syncthreads();
            const float* W = args.in[layer ? I_ADA1_W : I_ADA0_W]; float a0 = 0.f, a1 = 0.f, a2 = 0.f;
#pragma unroll 8
            for (int kk = 0; kk < 128; ++kk) { const int k = wave * 128 + kk; const float w = W[(size_t)k * 6144 + col]; a0 += sil[k] * w; a1 += sil[1024 + k] * w; a2 += sil[2048 + k] * w; }
            red[(wave * 3 + 0) * 64 + lane] = a0; red[(wave * 3 + 1) * 64 + lane] = a1; red[(wave * 3 + 2) * 64 + lane] = a2;
            __syncthreads();
            if (tid < 192) { const int r = tid >> 6, l = tid & 63; float s = 0.f;
#pragma unroll
                for (int w = 0; w < 8; ++w) s += red[(w * 3 + r) * 64 + l];
                MODS[(size_t)(layer * 3 + r) * 6144 + cb * 64 + l] = s + args.in[layer ? I_ADA1_B : I_ADA0_B][cb * 64 + l]; }
            __syncthreads();
        }
        {
            LAS float* scr = (LAS float*)(lds + wave * 16384);
            LAS float* tab = (LAS float*)(lds + wave * 16384 + 8704);
            for (int i = lane; i < 256; i += 64) tab[i] = (i < 128) ? fcos_rev((float)i * (1.f / 128.f)) : fsin_rev((float)(i - 128) * (1.f / 128.f));
            LDS_WAIT();
            constexpr int I0 = 992, I1 = 96, I2 = 64, I3 = 512, I4 = 2048, NTR = I0 + I1 + I2 + I3 + 4 * I4, NFOLD = 1024;
            for (int it = gw; it < NTR + NFOLD; it += NGW) {
                int r = it;
                if (r < I0) { transpose_item(args.in[I_WIN], 1024, 1984, (bf16*)(ws + WS_WIN_T), 1024, scr, r, lane); continue; } r -= I0;
                if (r < I1) { transpose_item(args.in[I_QUP], 256, 768, (bf16*)(ws + WS_QUP_T), 256, scr, r, lane); continue; } r -= I1;
                if (r < I2) { transpose_item(args.in[I_KVUP], 128, 1024, (bf16*)(ws + WS_KVUP_T), 256, scr, r, lane); continue; } r -= I2;
                if (r < I3) { transpose_item(args.in[I_WOUT0], 1024, 1024, (bf16*)(ws + WS_WOUT0_T), 1024, scr, r, lane); continue; } r -= I3;
                if (r < I4) { transpose_item(args.in[I_W1_0], 1024, 4096, (bf16*)(ws + WS_W1_0), 1024, scr, r, lane); continue; } r -= I4;
                if (r < I4) { transpose_item(args.in[I_W2_0], 4096, 1024, (bf16*)(ws + WS_W2_0), 4096, scr, r, lane); continue; } r -= I4;
                if (r < I4) { transpose_item(args.in[I_W1_1], 1024, 4096, (bf16*)(ws + WS_W1_1), 1024, scr, r, lane); continue; } r -= I4;
                if (r < I4) { transpose_item(args.in[I_W2_1], 4096, 1024, (bf16*)(ws + WS_W2_1), 4096, scr, r, lane); continue; } r -= I4;
                fold_item(args.in[I_WOUT1], (bf16*)(ws + WS_WFOLD_T), scr, tab, r, lane);
            }
        }
        {
            const v4u z = {0u, 0u, 0u, 0u};
            for (int i = gt; i < 8192 + 16384 + MKV * 16; i += NGT) {
                if (i < 8192) ((v4u*)(ws + WS_WIN_T + (size_t)1984 * 2048))[i] = z;
                else if (i < 8192 + 16384) { const int j = i - 8192; *(v4u*)(ws + WS_KVUP_T + (size_t)(j >> 4) * 512 + 256 + (j & 15) * 16) = z; }
                else { const int j = i - 8192 - 16384; *(v4u*)(ws + WS_KVN + (size_t)(j >> 4) * 512 + 256 + (j & 15) * 16) = z; }
            }
        }
        for (int i = gt; i < 65536; i += NGT) { const int rho = i >> 8, l = i & 255; const int k = rho > 128 ? rho - 128 : rho; const float rev = (float)((k * l) & 255) * (1.f / 256.f);
            ((bf16*)(ws + WS_D256))[i] = (bf16)f2bf((rho > 128 ? __builtin_amdgcn_sinf(rev) : __builtin_amdgcn_cosf(rev)) * 0.0625f); }
        {
            float* H2 = (float*)(ws + WS_H2);
            const float* w1 = args.in[I_HFW1]; const float* w2 = args.in[I_HFW2];
            const float b1 = args.in[I_HFB1][lane], b2 = args.in[I_HFB2][lane], fr = args.in[I_HFFREQ][lane];
            for (int R = gw; R < LS + LP; R += NGW) {
                const int L = R < LS ? LS : LP, l = R < LS ? R : R - LS;
                const float t = (float)l / (float)(L - 1);
                const float wang = (6.283185307179586f * (float)l) / (float)L;
                const int j = lane & 15; const float band = 1e-4f + (float)j * ((15.0f - 1e-4f) / 15.0f);
                const float ang = wang * band, rev = ang * INV_2PI;
                const float zl = (lane < 16) ? fcos_rev(rev) : -fsin_rev(rev);
                float p1 = b1 + t * w1[lane];
#pragma unroll
                for (int i = 0; i < 32; ++i) p1 += __shfl(zl, i) * w1[(1 + i) * 64 + lane];
                const float h1 = sinf(fr * p1);
                float p2 = b2;
#pragma unroll 16
                for (int i = 0; i < 64; ++i) p2 += __shfl(h1, i) * w2[i * 64 + lane];
                H2[(size_t)R * 64 + lane] = sinf(fr * p2);
            }
        }
    }
    SEAM(0);

    if (IN(1)) {
        FRESH();
        asm volatile("; ==== PHASE 1 ====");
        for (int m = gw; m < MT; m += NGW) {
            const float* xr = m < NP ? args.in[I_XP] + (size_t)m * DM : args.in[I_XS] + (size_t)(m - NP) * DM;
            const float* md = MODS + (size_t)req_of_row(m) * 6144;
            f32x4 v[4]; load_row(xr, lane, v); adaln_store(v, md, md + 1024, HB + (size_t)m * DM, lane);
        }
        {
            const float* H2 = (const float*)(ws + WS_H2); const float* w3 = args.in[I_HFW3];
            for (int it = gw; it < 68 * 32; it += NGW) {
                const int lb = it >> 5, cg = it & 31; const bool smp = lb < 64; const int L = smp ? LS : LP; const int l = (smp ? lb : lb - 64) * 64 + lane; const int R = lb * 64 + lane;
                float h2[64];
#pragma unroll
                for (int q = 0; q < 16; ++q) { const f32x4 x = ((const f32x4*)(H2 + (size_t)R * 64))[q]; h2[4 * q] = x[0]; h2[4 * q + 1] = x[1]; h2[4 * q + 2] = x[2]; h2[4 * q + 3] = x[3]; }
                const float t = (float)l / (float)(L - 1);
                float* FT = (float*)(ws + (smp ? WS_FT_S : WS_FT_P)); float* FP = (float*)(ws + (smp ? WS_FPART_S : WS_FPART_P));
                for (int cc = 0; cc < 32; ++cc) {
                    const int col = cg * 32 + cc, ch = col & 511;
                    float a = 0.f;
#pragma unroll
                    for (int o = 0; o < 64; ++o) a += h2[o] * w3[o * 1024 + col];
                    const float delta = fabsf(-3.0701134573253944f + (float)ch * ((-15.350567286626973f + 3.0701134573253944f) / 511.0f));
                    const float val = a * fexp(-t * delta);
                    FT[(size_t)col * L + l] = val;
                    const float s = wave_sum(fabsf(val));
                    if (lane == 0) FP[col * (smp ? 64 : 4) + (smp ? lb : lb - 64)] = s;
                }
            }
        }
    }
    SEAM(1);

    if (IN(2)) {
        FRESH();
        asm volatile("; ==== PHASE 2 ====");
        pg8::Gemm g{HB, (const bf16*)(ws + WS_WIN_T), MT, WINP, DM}; pg8::StaticOrder S; S.init(MT, WINP, G, bx);
        EpiWin E{(bf16*)(ws + WS_P), (float*)(ws + WS_ZS)};
        pg8::gemm_phase<EpiWin, pg8::StaticOrder, PG8_ALIGN, PG8_SP2>(lds, g, S, E, tid);
    }
    SEAM(2);

    if (IN(3)) {
        FRESH();
        asm volatile("; ==== PHASE 3 ====");
        const bf16* P = (const bf16*)(ws + WS_P);
        for (int it = bx; it < MT / 64; it += G) {
            const int m0 = it * 64; const bool smp = m0 >= NP; const int L = smp ? LS : LP; const int l0 = smp ? (m0 - NP) % LS : m0 % LP;
            const int seq = smp ? (m0 - NP) / LS : m0 / LP;
            const int c = tid;
            const float* cw = args.in[I_CONVW]; const float* cb = args.in[I_CONVB];
            float w[3][3], bb[3];
#pragma unroll
            for (int s = 0; s < 3; ++s) { bb[s] = cb[s * 512 + c];
#pragma unroll
                for (int k = 0; k < 3; ++k) w[s][k] = cw[k * 1536 + s * 512 + c]; }
            float prev[3], cur[3], nxt[3];
#pragma unroll
            for (int s = 0; s < 3; ++s) { prev[s] = (l0 > 0) ? bf2f(P[(size_t)(m0 - 1) * 1536 + s * 512 + c]) : 0.f; cur[s] = bf2f(P[(size_t)m0 * 1536 + s * 512 + c]); }
            LAS bf16* ut = (LAS bf16*)lds;
            bf16* X0 = (bf16*)(ws + WS_X0);
            for (int i = 0; i < 64; ++i) {
                const bool has_next = (l0 + i + 1) < L;
#pragma unroll
                for (int s = 0; s < 3; ++s) nxt[s] = has_next ? bf2f(P[(size_t)(m0 + i + 1) * 1536 + s * 512 + c]) : 0.f;
                float y[3];
#pragma unroll
                for (int s = 0; s < 3; ++s) y[s] = prev[s] * w[s][0] + cur[s] * w[s][1] + nxt[s] * w[s][2] + bb[s];
                X0[(size_t)(m0 + i) * 512 + c] = (bf16)f2bf(y[0]);
                ut[c * 68 + i] = (bf16)f2bf(y[2] * y[1]);
#pragma unroll
                for (int s = 0; s < 3; ++s) { prev[s] = cur[s]; cur[s] = nxt[s]; }
            }
            __syncthreads();
            bf16* UT = (bf16*)(ws + (smp ? WS_UT_S : WS_UT_P)) + (size_t)seq * 512 * L + l0;
            for (int q = tid; q < 512 * 16; q += 512) { const int ch = q >> 4, part = q & 15; const v2u v = *(const LAS v2u*)(ut + ch * 68 + part * 4); *(v2u*)(UT + (size_t)ch * L + part * 4) = v; }
            __syncthreads();
        }
        const float* ZS = (const float*)(ws + WS_ZS);
        bf16* QN = (bf16*)(ws + WS_QN); bf16* KVN = (bf16*)(ws + WS_KVN);
        for (int m = gw; m < MKV; m += NGW) {
            if (m < MT) {
                const bool smp = m >= NP; const int b = smp ? (m - NP) / LS : m / LP, key = smp ? (m - NP) % LS : m % LP;
                const f32x4 a0 = ((const f32x4*)(ZS + (size_t)m * 512))[2 * lane], a1 = ((const f32x4*)(ZS + (size_t)m * 512))[2 * lane + 1];
                float x[8] = {a0[0], a0[1], a0[2], a0[3], a1[0], a1[1], a1[2], a1[3]};
                float ss = 0.f;
                if (lane < 48) {
#pragma unroll
                    for (int i = 0; i < 8; ++i) ss += x[i] * x[i]; }
#pragma unroll
                for (int o = 1; o < 32; o <<= 1) ss += __shfl_xor(ss, o);
                if (lane < 32) {
                    const float r = __builtin_amdgcn_rsqf(ss * (1.f / QL) + RMS_EPS); const float* g = args.in[I_QNORM] + 8 * lane;
                    v4u w; w.x = pk2(x[0] * r * g[0], x[1] * r * g[1]); w.y = pk2(x[2] * r * g[2], x[3] * r * g[3]); w.z = pk2(x[4] * r * g[4], x[5] * r * g[5]); w.w = pk2(x[6] * r * g[6], x[7] * r * g[7]);
                    *(v4u*)(QN + (size_t)m * 256 + 8 * lane) = w;
                } else if (lane < 48) {
                    const int c0 = 8 * (lane - 32); const float r = __builtin_amdgcn_rsqf(ss * (1.f / KVL) + RMS_EPS); const float* g = args.in[I_KVNORM] + c0;
                    float y[8];
#pragma unroll
                    for (int i = 0; i < 8; ++i) y[i] = x[i] * r * g[i];
                    v4u w; w.x = pk2(y[0], y[1]); w.y = pk2(y[2], y[3]); w.z = pk2(y[4], y[5]); w.w = pk2(y[6], y[7]);
                    *(v4u*)(KVN + (size_t)m * 256 + c0) = w;
                    if (!smp) { float* o = args.out + OUT_CKV + (size_t)m * KVL + c0; *(f32x4*)o = (f32x4){y[0], y[1], y[2], y[3]}; *(f32x4*)(o + 4) = (f32x4){y[4], y[5], y[6], y[7]}; }
                }
                {
                    float y[8];
                    const int q = lane - 48; const int seg = (q >> 2) & 1; const bool second = (q & 2) != 0; const int j0 = 8 * (q & 1);
                    const float pf = (float)(seg == 0 ? (key >> 6) : (key & 63));
#pragma unroll
                    for (int i = 0; i < 8; ++i) { const float pr = __shfl_xor(x[i], 2);
                        if (smp) { const float inv = __builtin_amdgcn_exp2f(-(float)(j0 + i) * (13.287712379549449f / 16.0f)); const float rev = pf * inv * INV_2PI;
                            y[i] = x[i] * fcos_rev(rev) + (second ? pr : -pr) * fsin_rev(rev); }
                        else y[i] = x[i]; }
                    if (lane >= 48 && lane < 56) {
                        const int kk = 8 * q;
                        if (!smp) { float* o = args.out + OUT_CKR + (size_t)m * DROPE + kk; *(f32x4*)o = (f32x4){y[0], y[1], y[2], y[3]}; *(f32x4*)(o + 4) = (f32x4){y[4], y[5], y[6], y[7]}; }
                        v4u w; w.x = pk2(y[0], y[1]); w.y = pk2(y[2], y[3]); w.z = pk2(y[4], y[5]); w.w = pk2(y[6], y[7]);
                        bf16* kf = (bf16*)(ws + (smp ? WS_KF_S : WS_KF_P)); const int lk = smp ? LKS : LP;
#pragma unroll
                        for (int h = 0; h < NH; ++h) *(v4u*)(kf + ((size_t)(b * NH + h) * lk + key) * DQK + DNOPE + kk) = w;
                    }
                }
            } else {
                const int mm = m - MT, b = mm / PAST, j = mm % PAST;
                if (lane < 16) { const float* s = args.in[I_CKV] + (size_t)mm * KVL + 8 * lane;
                    v4u w; w.x = pk2(s[0], s[1]); w.y = pk2(s[2], s[3]); w.z = pk2(s[4], s[5]); w.w = pk2(s[6], s[7]); *(v4u*)(KVN + (size_t)m * 256 + 8 * lane) = w; }
                else if (lane < 24) { const int kk = 8 * (lane - 16); const float* s = args.in[I_CKR] + (size_t)mm * DROPE + kk;
                    v4u w; w.x = pk2(s[0], s[1]); w.y = pk2(s[2], s[3]); w.z = pk2(s[4], s[5]); w.w = pk2(s[6], s[7]);
                    bf16* kf = (bf16*)(ws + WS_KF_S);
#pragma unroll
                    for (int h = 0; h < NH; ++h) *(v4u*)(kf + ((size_t)(b * NH + h) * LKS + LS + j) * DQK + DNOPE + kk) = w; }
            }
        }
    }
    SEAM(3);

    if (IN(4)) {
        FRESH();
        asm volatile("; ==== PHASE 4 ====");
        { pg8::Gemm g{(const bf16*)(ws + WS_QN), (const bf16*)(ws + WS_QUP_T), MT, 768, 256}; pg8::StaticOrder S; S.init(MT, 768, G, bx);
          EpiQ E{(bf16*)(ws + WS_Q)};
          pg8::gemm_phase<EpiQ, pg8::StaticOrder, PG8_ALIGN, PG8_SP2>(lds, g, S, E, tid); }
        { int bx2 = (bx + 144) % G; asm volatile("" : "+s"(bx2)); const int lane2 = fresh_lane(); const int tid = wave * 64 + lane2;
          pg8::Gemm g{(const bf16*)(ws + WS_KVN), (const bf16*)(ws + WS_KVUP_T), MKV, 1024, 256}; pg8::StaticOrder S; S.init(MKV, 1024, G, bx2);
          EpiKV E{(bf16*)(ws + WS_KF_S), (bf16*)(ws + WS_KF_P), (bf16*)(ws + WS_V_S), (bf16*)(ws + WS_V_P)};
          pg8::gemm_phase<EpiKV, pg8::StaticOrder, PG8_ALIGN, PG8_SP2>(lds, g, S, E, tid); }
    }
    SEAM(4);

    if (IN(5)) {
        FRESH();
        asm volatile("; ==== PHASE 5 ====");
        constexpr int NA_S = BS * NH * (LS / 256), NC_S = HY, NA_P = BP * NH, NC_P = HY, NITEM = NA_S + NC_S + NA_P + NC_P;
        bf16* YM = HB;
        for (;;) {
            if (tid == 0) MISC[0] = __hip_atomic_fetch_add((unsigned*)(ctl + CW_Q), 1u, RLX_AGENT);
            __syncthreads();
            const int it = __builtin_amdgcn_readfirstlane((int)MISC[0]);
            __syncthreads();
            if (it >= NITEM) break;
            const int lane = fresh_lane(); const int tid = wave * 64 + lane;
            const bool isA_S = it < NA_S, isA_P = (it >= NA_S + NC_S) && (it < NA_S + NC_S + NA_P);
            if (isA_S || isA_P) { if (!NO_ATT) {
                int b, h, row0, lk, pos0; const bf16 *kf, *vv;
                if (isA_S) { b = it / (NH * 16); h = (it / 16) % NH; const int qb = it % 16; row0 = NP + b * LS + qb * 256; lk = LKS; pos0 = qb * 256; kf = (const bf16*)(ws + WS_KF_S); vv = (const bf16*)(ws + WS_V_S); }
                else { const int u = it - NA_S - NC_S; b = u / NH; h = u % NH; row0 = b * LP; lk = LP; pos0 = -1; kf = (const bf16*)(ws + WS_KF_P); vv = (const bf16*)(ws + WS_V_P); }
                att::attn_dense_body((const bf16*)(ws + WS_Q) + (size_t)row0 * 768 + h * DQK, kf + (size_t)(b * NH + h) * lk * DQK, vv + (size_t)(b * NH + h) * lk * DVH,
                                     YM + (size_t)row0 * DM + HY + h * DVH, lk, pos0, (LAS char*)lds, tid); }
            } else if (!NO_CONV) {
                const bool smp = it < NA_S + NC_S; const int ch = smp ? it - NA_S : it - NA_S - NC_S - NA_P;
                const int L = smp ? LS : LP, nb = smp ? BS : BP, tokbase = smp ? NP : 0;
                const float* FT = (const float*)(ws + (smp ? WS_FT_S : WS_FT_P)); const float* FP = (const float*)(ws + (smp ? WS_FPART_S : WS_FPART_P));
                const bf16* UT = (const bf16*)(ws + (smp ? WS_UT_S : WS_UT_P));
                LAS float* Gs = (LAS float*)lds;
                LAS float* Us = (LAS float*)(lds + 40960);
                LAS float* red = (LAS float*)(lds + 40960 + 65536);
                const float* hf = FT + (size_t)ch * L; const float* hb = FT + (size_t)(512 + ch) * L;
                for (int e = tid; e < 2 * L - 1; e += 512) { const int d = e - (L - 1); Gs[e + (e >> 4)] = d >= 0 ? hf[d] : hb[-d]; }
                for (int i = tid; i < nb * L; i += 512) { const int b = i / L, l = i % L; Us[i] = bf2f(UT[((size_t)b * 512 + ch) * L + l]); }
                { const int np = smp ? 64 : 4; float s = 0.f; if (tid < 2 * np) s = FP[(tid < np ? ch : 512 + ch) * np + (tid % np)];
                  s = wave_sum(s); if (lane == 0) red[wave] = s; }
                __syncthreads();
                const float inv_norm = 1.f / ((red[0] + red[1]) + (red[2] + red[3]));
                const int tps = L / 16;
                if (tid < nb * tps) {
                    const int b = tid / tps, t0 = (tid % tps) * 16;
                    float y[16];
#pragma unroll
                    for (int i = 0; i < 16; ++i) y[i] = 0.f;
                    const LAS float* ub = Us + b * L;
                    for (int s0 = 0; s0 < L; s0 += 16) {
                        const int base0 = t0 + L - 1 - s0;
                        float W[31];
#pragma unroll
                        for (int j = 0; j < 31; ++j) { const int e = base0 - 15 + j; W[j] = Gs[e + (e >> 4)]; }
#pragma unroll
                        for (int k = 0; k < 16; ++k) { const float uu = ub[s0 + k];
#pragma unroll
                            for (int i = 0; i < 16; ++i) y[i] += W[15 - k + i] * uu; }
                    }
                    const float skip = args.in[I_HFSKIP][ch];
                    const bf16* X0 = (const bf16*)(ws + WS_X0);
#pragma unroll
                    for (int i = 0; i < 16; ++i) { const size_t row = (size_t)tokbase + (size_t)b * L + t0 + i;
                        const float v = y[i] * inv_norm + skip * ub[t0 + i];
                        YM[row * DM + ch] = (bf16)f2bf(v * bf2f(X0[row * 512 + ch])); }
                }
                __syncthreads();
            }
        }
    }
    SEAM(5);

    if (IN(6)) {
        FRESH();
        asm volatile("; ==== PHASE 6 ====");
        pg8::Gemm g{HB, (const bf16*)(ws + WS_WOUT0_T), MT, DM, DM}; pg8::StaticOrder S; S.init(MT, DM, G, bx);
        EpiRes E{args.in[I_XP], args.in[I_XS], MODS + 2 * 1024, T};
        pg8::gemm_phase<EpiRes, pg8::StaticOrder, PG8_ALIGN, PG8_SP2>(lds, g, S, E, tid);
    }
    SEAM(6);

    if (IN(7)) {
        FRESH();
        asm volatile("; ==== PHASE 7 ====");
        for (int m = gw; m < MT; m += NGW) {
            const float* md = MODS + (size_t)req_of_row(m) * 6144;
            f32x4 v[4]; load_row(T + (size_t)m * DM, lane, v); ln_affine(v, args.in[I_LN1G0], args.in[I_LN1B0], lane); store_row(X + (size_t)m * DM, lane, v);
            adaln_store(v, md + 3 * 1024, md + 4 * 1024, HB + (size_t)m * DM, lane);
        }
    }
    SEAM(7);

    if (IN(8)) {
        FRESH();
        asm volatile("; ==== PHASE 8 ====");
        pg8::Gemm g{HB, (const bf16*)(ws + WS_W1_0), MT, FF, DM}; pg8::StaticOrder S; S.init(MT, FF, G, bx);
        EpiUp E{(bf16*)(ws + WS_HID)};
        pg8::gemm_phase<EpiUp, pg8::StaticOrder, PG8_ALIGN, PG8_SP2>(lds, g, S, E, tid);
    }
    SEAM(8);

    if (IN(9)) {
        FRESH();
        asm volatile("; ==== PHASE 9 ====");
        pg8::Gemm g{(const bf16*)(ws + WS_HID), (const bf16*)(ws + WS_W2_0), MT, DM, FF}; pg8::StaticOrder S; S.init(MT, DM, G, bx);
        EpiRes E{X, X + (size_t)NP * DM, MODS + 5 * 1024, T};
        pg8::gemm_phase<EpiRes, pg8::StaticOrder, PG8_ALIGN, PG8_SP2>(lds, g, S, E, tid);
    }
    SEAM(9);

    if (IN(10)) {
        FRESH();
        asm volatile("; ==== PHASE 10 ====");
        const float* MODS1 = MODS + 3 * 6144;
        for (int it = bx; it < MT / 32; it += G) {
            const int m0 = it * 32; const bool smp = m0 >= NP; const int L = smp ? LS : LP; const int l0 = smp ? (m0 - NP) % LS : m0 % LP; const int seq = smp ? (m0 - NP) / LS : m0 / LP;
            LAS bf16* ht = (LAS bf16*)lds;
            const float* md = MODS1 + (size_t)req_of_row(m0) * 6144;
            for (int rr = 0; rr < 4; ++rr) { const int i = wave * 4 + rr, m = m0 + i;
                f32x4 v[4]; load_row(T + (size_t)m * DM, lane, v); ln_affine(v, args.in[I_LN2G0], args.in[I_LN2B0], lane); store_row(X + (size_t)m * DM, lane, v);
                float mean, rstd; row_stats(v, mean, rstd);
#pragma unroll
                for (int j = 0; j < 4; ++j) { const int c = 4 * lane + 256 * j; const f32x4 sc = *(const f32x4*)(md + 1024 + c), sh = *(const f32x4*)(md + c);
                    const f32x4 h = (v[j] - mean) * rstd * (sc + 1.0f) + sh;
#pragma unroll
                    for (int e = 0; e < 4; ++e) ht[(c + e) * 40 + i] = (bf16)f2bf(h[e]); }
            }
            __syncthreads();
            bf16* HT = HB + (smp ? (size_t)NP * DM + (size_t)seq * DM * LS : (size_t)seq * DM * LP) + l0;
            for (int q = tid; q < 1024 * 4; q += 512) { const int c = q >> 2, part = q & 3; const v4u v = *(const LAS v4u*)(ht + c * 40 + part * 8); *(v4u*)(HT + (size_t)c * L + part * 8) = v; }
            __syncthreads();
        }
        for (size_t i = gt; i < (size_t)LS * LS / 8; i += NGT) {
            const int rho = (int)(i >> 9), l8 = (int)(i & 511) * 8; const int k = rho > 2048 ? rho - 2048 : rho; unsigned w[4];
#pragma unroll
            for (int e = 0; e < 8; e += 2) { const float r0 = (float)((k * (l8 + e)) & 4095) * (1.f / 4096.f), r1 = (float)((k * (l8 + e + 1)) & 4095) * (1.f / 4096.f);
                const float a = (rho > 2048 ? __builtin_amdgcn_sinf(r0) : __builtin_amdgcn_cosf(r0)) * 0.015625f, b = (rho > 2048 ? __builtin_amdgcn_sinf(r1) : __builtin_amdgcn_cosf(r1)) * 0.015625f;
                w[e >> 1] = pk2(a, b); }
            ((v4u*)(ws + WS_D4096))[i] = (v4u){w[0], w[1], w[2], w[3]};
        }
    }
    SEAM(10);

    if (IN(11)) {
        FRESH();
        asm volatile("; ==== PHASE 11 ====");
        { pg8::Gemm g{(const bf16*)(ws + WS_D4096), HB + (size_t)NP * DM, LS, BS * DM, LS}; pg8::StaticOrder S; S.init(LS, BS * DM, G, bx);
          EpiDft E{(bf16*)(ws + WS_UV), LS, NP};
          pg8::gemm_phase<EpiDft, pg8::StaticOrder, PG8_ALIGN, PG8_SP2>(lds, g, S, E, tid); }
        { int bx2 = (bx + 128) % G; asm volatile("" : "+s"(bx2)); const int lane2 = fresh_lane(); const int tid = wave * 64 + lane2;
          pg8::Gemm g{(const bf16*)(ws + WS_D256), HB, LP, BP * DM, LP}; pg8::StaticOrder S; S.init(LP, BP * DM, G, bx2);
          EpiDft E{(bf16*)(ws + WS_UV), LP, 0};
          pg8::gemm_phase<EpiDft, pg8::StaticOrder, PG8_ALIGN, PG8_SP2>(lds, g, S, E, tid); }
    }
    SEAM(11);

    if (IN(12)) {
        FRESH();
        asm volatile("; ==== PHASE 12 ====");
        pg8::Gemm g{(const bf16*)(ws + WS_UV), (const bf16*)(ws + WS_WFOLD_T), MT, DM, 2048}; pg8::StaticOrder S; S.init(MT, DM, G, bx);
        EpiRes E{X, X + (size_t)NP * DM, MODS + 3 * 6144 + 2 * 1024, T};
        pg8::gemm_phase<EpiRes, pg8::StaticOrder, PG8_ALIGN, PG8_SP2>(lds, g, S, E, tid);
    }
    SEAM(12);

    if (IN(13)) {
        FRESH();
        asm volatile("; ==== PHASE 13 ====");
        for (int m = gw; m < MT; m += NGW) {
            const float* md = MODS + 3 * 6144 + (size_t)req_of_row(m) * 6144;
            f32x4 v[4]; load_row(T + (size_t)m * DM, lane, v); ln_affine(v, args.in[I_LN1G1], args.in[I_LN1B1], lane); store_row(X + (size_t)m * DM, lane, v);
            adaln_store(v, md + 3 * 1024, md + 4 * 1024, HB + (size_t)m * DM, lane);
        }
    }
    SEAM(13);

    if (IN(14)) {
        FRESH();
        asm volatile("; ==== PHASE 14 ====");
        pg8::Gemm g{HB, (const bf16*)(ws + WS_W1_1), MT, FF, DM}; pg8::StaticOrder S; S.init(MT, FF, G, bx);
        EpiUp E{(bf16*)(ws + WS_HID)};
        pg8::gemm_phase<EpiUp, pg8::StaticOrder, PG8_ALIGN, PG8_SP2>(lds, g, S, E, tid);
    }
    SEAM(14);

    if (IN(15)) {
        FRESH();
        asm volatile("; ==== PHASE 15 ====");
        pg8::Gemm g{(const bf16*)(ws + WS_HID), (const bf16*)(ws + WS_W2_1), MT, DM, FF}; pg8::StaticOrder S; S.init(MT, DM, G, bx);
        EpiRes E{X, X + (size_t)NP * DM, MODS + 3 * 6144 + 5 * 1024, T};
        pg8::gemm_phase<EpiRes, pg8::StaticOrder, PG8_ALIGN, PG8_SP2>(lds, g, S, E, tid);
    }
    SEAM(15);

    if (IN(16)) {
        FRESH();
        asm volatile("; ==== PHASE 16 ====");
        for (int m = gw; m < MT; m += NGW) {
            f32x4 v[4]; load_row(T + (size_t)m * DM, lane, v); ln_affine(v, args.in[I_LN2G1], args.in[I_LN2B1], lane); store_row(X + (size_t)m * DM, lane, v);
        }
    }
#undef IN
#undef SEAM
}

extern "C" void kernel_launch(void* const* d_in, const int* in_sizes, int n_in, void* d_out, int out_size, void* d_ws, size_t ws_size, hipStream_t stream) {
    static int grid = 0;
    if (grid == 0) {
        if (n_in != 38 || ws_size < WS_END) { fprintf(stderr, "kernel_launch: expected 38 inputs and >= %zu bytes of workspace; got %d, %zu\n", (size_t)WS_END, n_in, ws_size); grid = -1; return; }
        int dev = 0, cus = 0;
        if (hipGetDevice(&dev) != hipSuccess || hipDeviceGetAttribute(&cus, hipDeviceAttributeMultiprocessorCount, dev) != hipSuccess) { grid = -1; return; }
        if (hipFuncSetAttribute((const void*)fwd_kernel, hipFuncAttributeMaxDynamicSharedMemorySize, LDS_BYTES) != hipSuccess) { fprintf(stderr, "kernel_launch: hipFuncSetAttribute failed\n"); grid = -1; return; }
        int per_cu = 0;
        if (hipOccupancyMaxActiveBlocksPerMultiprocessor(&per_cu, (const void*)fwd_kernel, 512, LDS_BYTES) != hipSuccess || per_cu < 1) fprintf(stderr, "kernel_launch: occupancy query reports %d\n", per_cu);
        (void)hipGetLastError();
        grid = cus;
    }
    if (grid < 0) return;
    (void)hipMemsetAsync((char*)d_ws + WS_CTL, 0, CTL_ZERO_BYTES, stream);
    Args a{};
    for (int i = 0; i < 38; ++i) a.in[i] = (const float*)d_in[i];
    a.out = (float*)d_out; a.ws = (unsigned char*)d_ws;
#if MK_PER_PHASE
    for (int p = 0; p < NPHASE; ++p) { a.ph_lo = p; a.ph_hi = p + 1; hipLaunchKernelGGL(fwd_kernel, dim3(grid), dim3(512), LDS_BYTES, stream, a); }
#else
    a.ph_lo = 0; a.ph_hi = NPHASE;
    hipLaunchKernelGGL(fwd_kernel, dim3(grid), dim3(512), LDS_BYTES, stream, a);
#endif
    const hipError_t le = hipPeekAtLastError();
    if (le != hipSuccess) fprintf(stderr, "kernel_launch: launch failed: %s\n", hipGetErrorName(le));
}
```

```cpp
#include <hip/hip_runtime.h>
#include <hip/hip_bf16.h>
#include <cstdio>
#include <cstdint>
#include <cmath>
namespace pg8 {
#define PG8_LAS __attribute__((address_space(3)))
typedef unsigned short bf16_t;
typedef short bf16x8 __attribute__((ext_vector_type(8)));
typedef float f32x4 __attribute__((ext_vector_type(4)));
typedef unsigned u32x4 __attribute__((ext_vector_type(4)));
constexpr int BM = 256, BK = 64, HALF = 128, HTB = HALF * BK * 2  , STAGE_BYTES = 8 * HTB, NXCD = 8, WGM = 8;

__host__ __device__ __forceinline__ int lds_byte(int r, int c) { const int st = (r >> 4) * 2 + (c >> 5), rr = r & 15, cc = c & 31, ob = rr * 64 + cc * 2; return st * 1024 + (ob ^ (((ob >> 9) & 1) << 5)); }
__host__ __device__ __forceinline__ void stage_rc(int b, int& R, int& C) { const int st = b / 1024, sb = b % 1024, swz = sb ^ (((sb >> 9) & 1) << 5); R = (st >> 1) * 16 + swz / 64; C = (st & 1) * 32 + (swz % 64) / 2; }
__host__ __device__ __forceinline__ int perm32(int rho) { const int n = rho >> 4, i = rho & 15; return 8 * (i >> 2) + 4 * n + (i & 3); }

struct Unit { int pm, pn; };
struct Gemm { const bf16_t* A; const bf16_t* Bt; int M, N, K; };

struct StaticOrder {
    int nM, nN, nwg, G, c;
    __host__ __device__ void init(int M, int N, int G_, int c_) { nM = M / BM; nN = N / BM; nwg = nM * nN; G = G_; c = c_; }
    __host__ __device__ bool next(int i, Unit& u) const {
        const long L = (long)i * G + c; if (L >= nwg) return false;
        int wgid = (int)L; { const int q = nwg / NXCD, r = nwg % NXCD, xcd = wgid % NXCD, off = wgid / NXCD; wgid = (xcd < r ? xcd * (q + 1) : r * (q + 1) + (xcd - r) * q) + off; }
        const int nig = WGM * nN, gid = wgid / nig, fm = gid * WGM, gsz = (nM - fm) < WGM ? (nM - fm) : WGM;
        u.pm = fm + ((wgid % nig) % gsz); u.pn = (wgid % nig) / gsz; return true;
    }
    __device__ __forceinline__ void a_ready(const Unit&) const {}
    __device__ __forceinline__ void done(const Unit&) const {}
};

__device__ __forceinline__ unsigned cvt_pk_bf16(float lo, float hi) { unsigned r; asm volatile("v_cvt_pk_bf16_f32 %0, %1, %2" : "=v"(r) : "v"(lo), "v"(hi)); return r; }
template <class Epi, class Sched, bool ALIGN_EPI = false, bool SP2 = false>
__device__ __forceinline__ void gemm_phase(PG8_LAS unsigned char* lds, const Gemm g, const Sched& S, const Epi& E, const int tid) {
    const int wid = __builtin_amdgcn_readfirstlane(tid >> 6), lane = tid & 63, wr = wid >> 2, wc = wid & 3, fr = lane & 15, fq = lane >> 4;
    const int K = g.K, nt = K / BK;
    unsigned voffA[2], voffB[2];
#pragma unroll
    for (int i = 0; i < 2; ++i) { int R, C; stage_rc(tid * 16 + i * 8192, R, C); const int Rb = Epi::PERM ? ((R & ~31) + perm32(R & 31)) : R;
        voffA[i] = (unsigned)(R * K + C) * 2u; voffB[i] = (unsigned)(Rb * K + C) * 2u; }
    const size_t kstep = (size_t)(BK * 2);
    const size_t hstep = (size_t)HALF * K * 2;
    const size_t tstep = 2 * hstep;
    const unsigned ldsw = (unsigned)wid * 1024u;
    const int aoff = lds_byte(wr * 64 + fr, fq * 8), boff = lds_byte(wc * 32 + fr, fq * 8);
#define PG8_SA(b, h) (((b) * 2 + (h)) * HTB)
#define PG8_SB(b, h) ((4 + (b) * 2 + (h)) * HTB)
#define PG8_STAGE(bufoff, gbase, voff) do { _Pragma("unroll") for (int _i = 0; _i < 2; ++_i) \
        __builtin_amdgcn_global_load_lds((const unsigned*)((const char*)(gbase) + (voff)[_i]), (PG8_LAS unsigned*)(lds + (bufoff) + ldsw + _i * 8192), 16, 0, 0); } while (0)
#define PG8_LDA(dst, b, h) do { _Pragma("unroll") for (int m = 0; m < 4; ++m) _Pragma("unroll") for (int k = 0; k < 2; ++k) dst[m][k] = *(const PG8_LAS bf16x8*)(lds + PG8_SA(b, h) + aoff + m * 2048 + k * 1024); } while (0)
#define PG8_LDB(dst, b, h) do { _Pragma("unroll") for (int n = 0; n < 2; ++n) _Pragma("unroll") for (int k = 0; k < 2; ++k) dst[n][k] = *(const PG8_LAS bf16x8*)(lds + PG8_SB(b, h) + boff + n * 2048 + k * 1024); } while (0)
#define PG8_MMA(ai, bj, At, Bt) do { __builtin_amdgcn_s_setprio(1); _Pragma("unroll") for (int m = 0; m < 4; ++m) _Pragma("unroll") for (int n = 0; n < 2; ++n) _Pragma("unroll") for (int k = 0; k < 2; ++k) \
        acc[ai][bj][m][n] = __builtin_amdgcn_mfma_f32_16x16x32_bf16(Bt[n][k], At[m][k], acc[ai][bj][m][n], 0, 0, 0); __builtin_amdgcn_s_setprio(0); } while (0)
#define PG8_WAIT_V(n) asm volatile("s_waitcnt vmcnt(" #n ")" ::: "memory")
#define PG8_WAIT_L(n) asm volatile("s_waitcnt lgkmcnt(" #n ")" ::: "memory")
#define PG8_BAR __builtin_amdgcn_s_barrier()
#define PG8_SCHED __builtin_amdgcn_sched_barrier(0)
    Unit cur, nxt; int ui = 0;
    if (!S.next(0, cur)) return;
    f32x4 acc[2][2][4][2];
#pragma unroll
    for (int a = 0; a < 2; ++a)
#pragma unroll
        for (int b = 0; b < 2; ++b)
#pragma unroll
            for (int m = 0; m < 4; ++m)
#pragma unroll
                for (int n = 0; n < 2; ++n) acc[a][b][m][n] = (f32x4){0.f, 0.f, 0.f, 0.f};
    bf16x8 At[4][2], B0[2][2], B1[2][2];
    const char* cA = (const char*)g.A + (size_t)cur.pm * tstep; const char* cB = (const char*)g.Bt + (size_t)cur.pn * tstep;
    S.a_ready(cur);
    if constexpr (SP2) {
        PG8_STAGE(PG8_SB(0, 0), cB, voffB); PG8_STAGE(PG8_SB(0, 1), cB + hstep, voffB); PG8_STAGE(PG8_SA(0, 0), cA, voffA); PG8_STAGE(PG8_SA(0, 1), cA + hstep, voffA);
        if (wr == 1) PG8_BAR;
        PG8_WAIT_V(2); PG8_BAR;
        PG8_STAGE(PG8_SB(1, 0), cB + kstep, voffB); PG8_STAGE(PG8_SA(1, 0), cA + kstep, voffA); PG8_STAGE(PG8_SB(1, 1), cB + hstep + kstep, voffB);
        PG8_WAIT_V(6); PG8_BAR;
    } else {
        PG8_STAGE(PG8_SB(0, 0), cB, voffB); PG8_STAGE(PG8_SA(0, 0), cA, voffA); PG8_STAGE(PG8_SB(0, 1), cB + hstep, voffB); PG8_STAGE(PG8_SA(0, 1), cA + hstep, voffA);
        if (wr == 1) PG8_BAR;
        PG8_WAIT_V(4); PG8_BAR;
        PG8_STAGE(PG8_SB(1, 0), cB + kstep, voffB); PG8_STAGE(PG8_SA(1, 0), cA + kstep, voffA); PG8_STAGE(PG8_SB(1, 1), cB + hstep + kstep, voffB);
        PG8_WAIT_V(6); PG8_BAR;
    }
    for (;;) {
        const bool has_next = S.next(ui + 1, nxt);
        const char* nA = has_next ? (const char*)g.A + (size_t)nxt.pm * tstep : cA; const char* nB = has_next ? (const char*)g.Bt + (size_t)nxt.pn * tstep : cB;
        for (int t = 0; t < nt; t += 2) {
            const bool last = (t == nt - 2);
            const char* a1 = cA + (size_t)(t + 1) * kstep;
            const char* a2 = last ? nA : cA + (size_t)(t + 2) * kstep; const char* b2 = last ? nB : cB + (size_t)(t + 2) * kstep;
            const char* a3 = a2 + kstep; const char* b3 = b2 + kstep;
            if (last && has_next) S.a_ready(nxt);
            if constexpr (SP2) {
            PG8_LDB(B0, 0, 0); PG8_LDB(B1, 0, 1); PG8_SCHED; PG8_LDA(At, 0, 0); PG8_STAGE(PG8_SA(1, 1), a1 + hstep, voffA);
            PG8_WAIT_V(8); PG8_WAIT_L(0); PG8_BAR; PG8_MMA(0, 0, At, B0); PG8_MMA(0, 1, At, B1); PG8_BAR; PG8_SCHED;
            PG8_LDA(At, 0, 1); PG8_STAGE(PG8_SB(0, 0), b2, voffB); PG8_STAGE(PG8_SB(0, 1), b2 + hstep, voffB); PG8_STAGE(PG8_SA(0, 0), a2, voffA);
            PG8_WAIT_V(8); PG8_WAIT_L(0); PG8_BAR; PG8_MMA(1, 0, At, B0); PG8_MMA(1, 1, At, B1); PG8_BAR; PG8_SCHED;
            PG8_LDB(B0, 1, 0); PG8_LDB(B1, 1, 1); PG8_SCHED; PG8_LDA(At, 1, 0); PG8_STAGE(PG8_SA(0, 1), a2 + hstep, voffA);
            PG8_WAIT_V(8); PG8_WAIT_L(0); PG8_BAR; PG8_MMA(0, 0, At, B0); PG8_MMA(0, 1, At, B1); PG8_BAR; PG8_SCHED;
            PG8_LDA(At, 1, 1); PG8_STAGE(PG8_SB(1, 0), b3, voffB); PG8_STAGE(PG8_SB(1, 1), b3 + hstep, voffB); PG8_STAGE(PG8_SA(1, 0), a3, voffA);
            PG8_WAIT_V(8); PG8_WAIT_L(0); PG8_BAR; PG8_MMA(1, 0, At, B0); PG8_MMA(1, 1, At, B1); PG8_BAR; PG8_SCHED;
            } else {
            PG8_LDB(B0, 0, 0); PG8_SCHED; PG8_LDA(At, 0, 0); PG8_STAGE(PG8_SA(1, 1), a1 + hstep, voffA);
            PG8_WAIT_L(8); PG8_BAR; PG8_WAIT_L(0); PG8_MMA(0, 0, At, B0); PG8_BAR; PG8_SCHED;
            PG8_LDB(B1, 0, 1); PG8_STAGE(PG8_SB(0, 0), b2, voffB);
            PG8_BAR; PG8_WAIT_L(0); PG8_MMA(0, 1, At, B1); PG8_BAR;
            PG8_LDA(At, 0, 1); PG8_STAGE(PG8_SA(0, 0), a2, voffA);
            PG8_BAR; PG8_WAIT_L(0); PG8_MMA(1, 0, At, B0); PG8_BAR; PG8_SCHED;
            PG8_STAGE(PG8_SB(0, 1), b2 + hstep, voffB);
            PG8_WAIT_V(6); PG8_BAR; PG8_MMA(1, 1, At, B1); PG8_BAR;
            PG8_LDB(B0, 1, 0); PG8_SCHED; PG8_LDA(At, 1, 0); PG8_STAGE(PG8_SA(0, 1), a2 + hstep, voffA);
            PG8_WAIT_L(8); PG8_BAR; PG8_WAIT_L(0); PG8_MMA(0, 0, At, B0); PG8_BAR; PG8_SCHED;
            PG8_LDB(B1, 1, 1); PG8_STAGE(PG8_SB(1, 0), b3, voffB);
            PG8_BAR; PG8_WAIT_L(0); PG8_MMA(0, 1, At, B1); PG8_BAR;
            PG8_LDA(At, 1, 1); PG8_STAGE(PG8_SA(1, 0), a3, voffA);
            PG8_BAR; PG8_WAIT_L(0); PG8_MMA(1, 0, At, B0); PG8_BAR; PG8_SCHED;
            PG8_STAGE(PG8_SB(1, 1), b3 + hstep, voffB);
            PG8_WAIT_V(6); PG8_BAR; PG8_MMA(1, 1, At, B1); PG8_BAR;
            }
        }
        if constexpr (ALIGN_EPI) { if (wr == 0) PG8_BAR; }
        if constexpr (!Epi::AFTER_DRAIN) { E(acc, cur, wr, wc, fr, fq); S.done(cur); }
        if (!has_next) break;
#pragma unroll
        for (int a = 0; a < 2; ++a)
#pragma unroll
            for (int b = 0; b < 2; ++b)
#pragma unroll
                for (int m = 0; m < 4; ++m)
#pragma unroll
                    for (int n = 0; n < 2; ++n) acc[a][b][m][n] = (f32x4){0.f, 0.f, 0.f, 0.f};
        cur = nxt; cA = nA; cB = nB; ++ui;
        if constexpr (ALIGN_EPI) { if (wr == 1) PG8_BAR; }
    }
    PG8_WAIT_V(0);
    if constexpr (!ALIGN_EPI) { if (wr == 0) PG8_BAR; }
    PG8_BAR;
    if constexpr (Epi::AFTER_DRAIN) { E.fused(acc, cur, wr, wc, fr, fq, lds, wid, lane); S.done(cur); }
#undef PG8_SA
#undef PG8_SB
#undef PG8_STAGE
#undef PG8_LDA
#undef PG8_LDB
#undef PG8_MMA
#undef PG8_WAIT_V
#undef PG8_WAIT_L
#undef PG8_BAR
#undef PG8_SCHED
}
}
#ifndef PG8_SP2
#define PG8_SP2 true
#endif
#ifndef PG8_ALIGN
#define PG8_ALIGN true
#endif
#ifndef MK_PER_PHASE
#define MK_PER_PHASE 0
#endif

constexpr int DM = 1024, FF = 4096;
constexpr int LP = 256, BP = 16, LS = 4096, BS = 2, PAST = 256;
constexpr int NP = BP * LP;
constexpr int NSR = BS * LS;
constexpr int MT = NP + NSR;
constexpr int MKV = MT + BS * PAST;
constexpr int LKS = LS + PAST;
constexpr int HY = 512, NH = 4, DQK = 192, DNOPE = 128, DROPE = 64, DVH = 128, QL = 256, KVL = 128;
constexpr int WINP = 2048;
constexpr float LN_EPS = 1e-5f, RMS_EPS = 1e-6f, ALPHA = 1.41421356237309515f;
constexpr int NPHASE = 17;

constexpr int att_shm_bytes = 2 * 16384 + 2 * 24576 + 2048 + 8 * 8 * 1024;
constexpr size_t MiB = 1u << 20, KiB = 1024;
constexpr size_t WS_CTL = 0, CTL_ZERO_BYTES = 1 * MiB;
constexpr size_t WS_MODS = 1 * MiB;
constexpr size_t WS_D256 = 1 * MiB + 256 * KiB;
constexpr size_t WS_H2 = 1 * MiB + 512 * KiB;
constexpr size_t WS_FPART_S = 3 * MiB;
constexpr size_t WS_FPART_P = 3 * MiB + 256 * KiB;
constexpr size_t WS_WIN_T = 4 * MiB, WS_QUP_T = 8 * MiB, WS_KVUP_T = 8 * MiB + 512 * KiB, WS_WOUT0_T = 9 * MiB;
constexpr size_t WS_W1_0 = 11 * MiB, WS_W2_0 = 19 * MiB, WS_W1_1 = 27 * MiB, WS_W2_1 = 35 * MiB, WS_WFOLD_T = 43 * MiB;
constexpr size_t WS_T = 48 * MiB;
constexpr size_t WS_FT_S = 48 * MiB, WS_FT_P = 64 * MiB, WS_UT_S = 65 * MiB, WS_UT_P = 73 * MiB;
constexpr size_t WS_D4096 = 96 * MiB;
constexpr size_t WS_KF_S = 96 * MiB, WS_KF_P = 109 * MiB, WS_V_S = 115 * MiB, WS_V_P = 124 * MiB;
constexpr size_t WS_H = 128 * MiB;
constexpr size_t WS_P = 152 * MiB, WS_ZS = 188 * MiB, WS_QN = 212 * MiB, WS_KVN = 218 * MiB, WS_Q = 225 * MiB, WS_X0 = 243 * MiB;
constexpr size_t WS_HID = 152 * MiB, WS_UV = 152 * MiB;
constexpr size_t WS_END = 256 * MiB;
constexpr int CW_TMO = 0, CW_Q = 64, CW_BAR = 4096;

constexpr int RING_BYTES = 131072, LDSCTL_OFF = 160 * 1024 - 512, MISC_OFF = LDSCTL_OFF + 320, LDS_BYTES = 160 * 1024;
static_assert(att_shm_bytes <= LDSCTL_OFF, "attention scratch fits below the LDS control words");

#define GAS __attribute__((address_space(1)))
#define LAS __attribute__((address_space(3)))
typedef unsigned short bf16;
typedef unsigned v4u __attribute__((ext_vector_type(4)));
typedef unsigned v2u __attribute__((ext_vector_type(2)));
typedef float f32x4 __attribute__((ext_vector_type(4)));
typedef GAS unsigned gu32;
#define RLX_AGENT __ATOMIC_RELAXED, __HIP_MEMORY_SCOPE_AGENT
#define LDS_WAIT() asm volatile("s_waitcnt lgkmcnt(0)" ::: "memory")
__device__ __forceinline__ unsigned f2bf(float f) { unsigned u = __builtin_bit_cast(unsigned, f); return (u + 0x7fffu + ((u >> 16) & 1u)) >> 16; }
__device__ __forceinline__ unsigned pk2(float lo, float hi) { return f2bf(lo) | (f2bf(hi) << 16); }
__device__ __forceinline__ float bf2f(unsigned short b) { return __builtin_bit_cast(float, (unsigned)b << 16); }
__device__ __forceinline__ float wave_sum(float v) {
#pragma unroll
    for (int o = 1; o < 64; o <<= 1) v += __shfl_xor(v, o);
    return v;
}
__device__ __forceinline__ float fsin_rev(float rev) { return __builtin_amdgcn_sinf(__builtin_amdgcn_fractf(rev)); }
__device__ __forceinline__ float fcos_rev(float rev) { return __builtin_amdgcn_cosf(__builtin_amdgcn_fractf(rev)); }
constexpr float INV_2PI = 0.15915494309189535f;
__device__ __forceinline__ float fexp(float x) { return __builtin_amdgcn_exp2f(x * 1.4426950408889634f); }

__device__ __forceinline__ int fresh_lane() { int l; asm volatile("v_mbcnt_lo_u32_b32 %0, -1, 0\n\tv_mbcnt_hi_u32_b32 %0, -1, %0" : "=v"(l)); return l; }
#define XB_TMO      128
#define XB_XCNT(j)  (256  + 64 * (j))
#define XB_XSUB(j)  (1280 + 64 * (j))
#define XB_XGEN(j)  (2304 + 64 * (j))
#define XB_TOP      3328
#define XB_TOPGEN   3392
#define XCD_BAR_WORDS 3456
#define XB_SPIN_CAP (1u << 23)
__device__ __forceinline__ unsigned xb_ld(unsigned* p)              { return __hip_atomic_load(p, __ATOMIC_RELAXED, __HIP_MEMORY_SCOPE_AGENT); }
__device__ __forceinline__ unsigned xb_add(unsigned* p, unsigned v) { return __hip_atomic_fetch_add(p, v, __ATOMIC_RELAXED, __HIP_MEMORY_SCOPE_AGENT); }
__device__ __forceinline__ unsigned xb_xcc_id() { return (unsigned)__builtin_amdgcn_s_getreg((3 << 11) | 20) & 0xFu; }
#define XB_SPIN(cond, bar) do { unsigned _sp = 0; while (cond) { __builtin_amdgcn_s_sleep(1); \
    if ((++_sp & 255u) == 0u) { if (xb_ld(&(bar)[XB_TMO])) break; if (_sp > XB_SPIN_CAP) { atomicAdd(&(bar)[XB_TMO], 1u); break; } } } } while (0)
struct XcdBarrier { unsigned* bar; unsigned x; volatile LAS unsigned* st; };
__device__ __forceinline__ XcdBarrier xcd_barrier_post(unsigned* bar, volatile LAS unsigned* st) {
    XcdBarrier b; b.bar = bar; b.x = xb_xcc_id(); b.st = st;
    if (threadIdx.x == 0) (void)xb_add(&bar[XB_XCNT(b.x)], 1u);
    return b;
}
__device__ __forceinline__ void xcd_barrier_complete(unsigned* bar, unsigned x, unsigned& nloc, unsigned& nx) {
    const unsigned G = gridDim.x * gridDim.y * gridDim.z;
    unsigned sum, cnt, mine, sp = 0u;
    for (;;) {
        sum = 0u; cnt = 0u; mine = 0u;
#pragma unroll
        for (unsigned j = 0; j < 16; ++j) { const unsigned c = xb_ld(&bar[XB_XCNT(j)]); sum += c; cnt += (c > 0u) ? 1u : 0u; mine = (j == x) ? c : mine; }
        if (sum == G) break;
        __builtin_amdgcn_s_sleep(1);
        if ((++sp & 255u) == 0u) { if (xb_ld(&bar[XB_TMO])) break; if (sp > XB_SPIN_CAP) { atomicAdd(&bar[XB_TMO], 1u); break; } }
    }
    nloc = mine > 0u ? mine : 1u; nx = cnt > 0u ? cnt : 1u;
}
__device__ __forceinline__ void xcd_barrier(const XcdBarrier& b) {
    asm volatile("s_waitcnt vmcnt(0)" ::: "memory");
    __syncthreads();
    if (threadIdx.x == 0) {
        unsigned* bar = b.bar;
        __builtin_amdgcn_s_waitcnt(0);
        unsigned nloc = b.st[0], nx = b.st[1];
        if (nloc == 0u) { xcd_barrier_complete(bar, b.x, nloc, nx); b.st[0] = nloc; b.st[1] = nx; }
        const unsigned old = xb_add(&bar[XB_XSUB(b.x)], 1u);
        const unsigned gen = old / nloc;
        if (old + 1u == (gen + 1u) * nloc) {
            __builtin_amdgcn_fence(__ATOMIC_RELEASE, "agent");
            asm volatile("s_waitcnt vmcnt(0)" ::: "memory");
            const unsigned og = xb_add(&bar[XB_TOP], 1u);
            const unsigned tg = og / nx;
            if (og + 1u == (tg + 1u) * nx) xb_add(&bar[XB_TOPGEN], 1u);
            else XB_SPIN(xb_ld(&bar[XB_TOPGEN]) == tg, bar);
            __builtin_amdgcn_fence(__ATOMIC_ACQUIRE, "agent");
            xb_add(&bar[XB_XGEN(b.x)], 1u);
            asm volatile("s_waitcnt vmcnt(0)" ::: "memory");
        } else {
            XB_SPIN(xb_ld(&bar[XB_XGEN(b.x)]) == gen, bar);
            __builtin_amdgcn_fence(__ATOMIC_ACQUIRE, "agent");
            asm volatile("s_waitcnt vmcnt(0)" ::: "memory");
        }
    }
    __syncthreads();
}

struct Args { const float* in[38]; float* out; unsigned char* ws; int ph_lo, ph_hi, li, pad; };
enum { I_XP = 0, I_XS, I_CKV, I_CKR, I_C, I_CCTX, I_ADA0_W, I_ADA0_B, I_WIN, I_CONVW, I_CONVB, I_HFW1, I_HFB1, I_HFFREQ, I_HFW2, I_HFB2, I_HFW3, I_HFSKIP,
       I_QNORM, I_QUP, I_KVNORM, I_KVUP, I_WOUT0, I_LN1G0, I_LN1B0, I_W1_0, I_W2_0, I_LN2G0, I_LN2B0, I_ADA1_W, I_ADA1_B, I_WOUT1, I_LN1G1, I_LN1B1, I_W1_1, I_W2_1, I_LN2G1, I_LN2B1 };
constexpr size_t OUT_CKV = (size_t)MT * DM, OUT_CKR = OUT_CKV + (size_t)NP * KVL;

__device__ __forceinline__ int req_of_row(int m) { return m < NP ? 0 : 1 + (m - NP) / LS; }

using pg8::f32x4; using pg8::Unit; using pg8::BM; using pg8::HALF; using pg8::cvt_pk_bf16;
typedef unsigned u32x4 __attribute__((ext_vector_type(4)));
__device__ __forceinline__ u32x4 pack8(const f32x4& a, const f32x4& b) { u32x4 w; w.x = cvt_pk_bf16(a[0], a[1]); w.y = cvt_pk_bf16(a[2], a[3]); w.z = cvt_pk_bf16(b[0], b[1]); w.w = cvt_pk_bf16(b[2], b[3]); return w; }

struct EpiWin {
    static constexpr bool PERM = true, AFTER_DRAIN = false;
    bf16* P; float* ZS;
    __device__ __forceinline__ void operator()(const f32x4 (&acc)[2][2][4][2], const Unit& u, int wr, int wc, int fr, int fq) const {
        const int row0 = u.pm * BM + wr * 64 + fr, colt = u.pn * BM + wc * 32 + 8 * fq;
#pragma unroll
        for (int ai = 0; ai < 2; ++ai)
#pragma unroll
            for (int m = 0; m < 4; ++m) { const int row = row0 + ai * HALF + m * 16;
#pragma unroll
                for (int bj = 0; bj < 2; ++bj) { const int col = colt + bj * HALF;
                    if (u.pn < 6) *(u32x4*)(P + (size_t)row * 1536 + col) = pack8(acc[ai][bj][m][0], acc[ai][bj][m][1]);
                    else { float* d = ZS + (size_t)row * 512 + (col - 1536); *(f32x4*)d = acc[ai][bj][m][0]; *(f32x4*)(d + 4) = acc[ai][bj][m][1]; } } }
    }
};
struct EpiQ {
    static constexpr bool PERM = true, AFTER_DRAIN = false;
    bf16* Q;
    __device__ __forceinline__ void operator()(const f32x4 (&acc)[2][2][4][2], const Unit& u, int wr, int wc, int fr, int fq) const {
        const int row0 = u.pm * BM + wr * 64 + fr, colt = u.pn * BM + wc * 32 + 8 * fq;
#pragma unroll
        for (int ai = 0; ai < 2; ++ai)
#pragma unroll
            for (int m = 0; m < 4; ++m) { const int row = row0 + ai * HALF + m * 16;
#pragma unroll
                for (int bj = 0; bj < 2; ++bj) *(u32x4*)(Q + (size_t)row * 768 + colt + bj * HALF) = pack8(acc[ai][bj][m][0], acc[ai][bj][m][1]); }
    }
};
struct EpiKV {
    static constexpr bool PERM = true, AFTER_DRAIN = false;
    bf16 *KFs, *KFp, *Vs, *Vp;
    __device__ __forceinline__ void operator()(const f32x4 (&acc)[2][2][4][2], const Unit& u, int wr, int wc, int fr, int fq) const {
        const int m0 = u.pm * BM; bf16* kf; bf16* vv; int lk, key0, b;
        if (m0 < NP) { b = m0 / LP; key0 = 0; lk = LP; kf = KFp; vv = Vp; }
        else if (m0 < MT) { b = (m0 - NP) / LS; key0 = (m0 - NP) % LS; lk = LKS; kf = KFs; vv = Vs; }
        else { b = (m0 - MT) / PAST; key0 = LS + (m0 - MT) % PAST; lk = LKS; kf = KFs; vv = Vs; }
        const int h = u.pn;
        int rloc = wr * 64 + fr, c8 = wc * 32 + 8 * fq; asm volatile("" : "+v"(rloc), "+v"(c8));
#pragma unroll
        for (int ai = 0; ai < 2; ++ai)
#pragma unroll
            for (int m = 0; m < 4; ++m) { const int key = key0 + rloc + ai * HALF + m * 16; const size_t kr = (size_t)(b * NH + h) * lk + key;
                *(u32x4*)(kf + kr * DQK + c8) = pack8(acc[ai][0][m][0], acc[ai][0][m][1]);
                *(u32x4*)(vv + kr * DVH + c8) = pack8(acc[ai][1][m][0], acc[ai][1][m][1]); }
    }
};
struct EpiRes {
    static constexpr bool PERM = false, AFTER_DRAIN = false;
    const float* xp; const float* xs; const float* gate;
    float* T;
    __device__ __forceinline__ void operator()(const f32x4 (&acc)[2][2][4][2], const Unit& u, int wr, int wc, int fr, int fq) const {
        const int m0 = u.pm * BM, row0 = m0 + wr * 64 + fr, col0 = u.pn * BM + wc * 32 + 4 * fq;
        const float* g = gate + (size_t)req_of_row(m0) * 6144;
        f32x4 gv[2][2];
#pragma unroll
        for (int bj = 0; bj < 2; ++bj)
#pragma unroll
            for (int n = 0; n < 2; ++n) gv[bj][n] = *(const f32x4*)(g + col0 + bj * HALF + n * 16);
#pragma unroll
        for (int ai = 0; ai < 2; ++ai)
#pragma unroll
            for (int m = 0; m < 4; ++m) { const int row = row0 + ai * HALF + m * 16;
                const float* xr = (row < NP) ? xp + (size_t)row * DM : xs + (size_t)(row - NP) * DM;
#pragma unroll
                for (int bj = 0; bj < 2; ++bj)
#pragma unroll
                    for (int n = 0; n < 2; ++n) { const int col = col0 + bj * HALF + n * 16; const f32x4 xv = *(const f32x4*)(xr + col);
                        *(f32x4*)(T + (size_t)row * DM + col) = xv * ALPHA + gv[bj][n] * acc[ai][bj][m][n]; } }
    }
};
struct EpiUp {
    static constexpr bool PERM = true, AFTER_DRAIN = false;
    bf16* H;
    __device__ __forceinline__ void operator()(const f32x4 (&acc)[2][2][4][2], const Unit& u, int wr, int wc, int fr, int fq) const {
        const int row0 = u.pm * BM + wr * 64 + fr, colt = u.pn * BM + wc * 32 + 8 * fq;
#pragma unroll
        for (int ai = 0; ai < 2; ++ai)
#pragma unroll
            for (int m = 0; m < 4; ++m) { const int row = row0 + ai * HALF + m * 16;
#pragma unroll
                for (int bj = 0; bj < 2; ++bj) { f32x4 a = acc[ai][bj][m][0], b = acc[ai][bj][m][1];
#pragma unroll
                    for (int e = 0; e < 4; ++e) { const float x = fmaxf(a[e], 0.f), y = fmaxf(b[e], 0.f); a[e] = x * x; b[e] = y * y; }
                    *(u32x4*)(H + (size_t)row * FF + colt + bj * HALF) = pack8(a, b); } }
    }
};
struct EpiDft {
    static constexpr bool PERM = true, AFTER_DRAIN = false;
    bf16* UV; int L, tokbase;
    __device__ __forceinline__ void operator()(const f32x4 (&acc)[2][2][4][2], const Unit& u, int wr, int wc, int fr, int fq) const {
        const int rho0 = u.pm * BM + wr * 64 + fr, n0 = u.pn * BM + wc * 32 + 8 * fq, hl = L >> 1;
#pragma unroll
        for (int ai = 0; ai < 2; ++ai)
#pragma unroll
            for (int m = 0; m < 4; ++m) { const int rho = rho0 + ai * HALF + m * 16; const int part = rho > hl ? 1 : 0; const int k = part ? rho - hl : rho;
#pragma unroll
                for (int bj = 0; bj < 2; ++bj) { const int n = n0 + bj * HALF, b = n >> 10, c = n & 1023;
                    const f32x4 a0 = acc[ai][bj][m][0], a1 = acc[ai][bj][m][1];
                    bf16* r1 = UV + (size_t)(tokbase + b * L + k) * 2048 + part * 1024 + c;
                    *(u32x4*)r1 = pack8(a0, a1);
                    if (k != 0 && k != hl) { bf16* r2 = UV + (size_t)(tokbase + b * L + (L - k)) * 2048 + part * 1024 + c;
                        *(u32x4*)r2 = part ? pack8(-a0, -a1) : pack8(a0, a1); }
                    else if (part == 0) *(u32x4*)(r1 + 1024) = (u32x4){0u, 0u, 0u, 0u}; } }
    }
};

namespace att {
using bf16x8 = __attribute__((ext_vector_type(8))) short;
using s16x4  = __attribute__((ext_vector_type(4))) short;
using f32x16 = __attribute__((ext_vector_type(16))) float;
constexpr int DK = 192, DV = 128, NW = 8, QBLK = 32, KVBLK = 64;
constexpr float SCALE = 0.07216878364870322f;
constexpr float THR = 8.f;
constexpr int SHM_V = KVBLK * DV * 2, SHM_K = KVBLK * DK * 2, SHM_QR = 2 * SHM_V + 2 * SHM_K + NW * 64 * 4, NQR = 4  , SHM_ATTN = SHM_QR + NW * (12 - NQR) * 1024;
#define KSWZ(row, colB) ((row) * 384 + ((colB) ^ (((row) & 7) << 4)))
#define SBAR() __builtin_amdgcn_sched_barrier(0)
__device__ __forceinline__ int crow(int r, int hi) { return (r & 3) + 8 * (r >> 2) + 4 * hi; }
__device__ __forceinline__ unsigned cvtpk(float lo, float hi) { unsigned r; asm volatile("v_cvt_pk_bf16_f32 %0, %1, %2" : "=v"(r) : "v"(lo), "v"(hi)); return r; }
__device__ __forceinline__ void partialSM(f32x16& p0, f32x16& p1, float& m_reg, float& mn, float& alpha) {
  constexpr float C = SCALE * 1.4426950408889634f;
  float pmax = p0[0];
#pragma unroll
  for (int r = 1; r < 16; ++r) pmax = fmaxf(pmax, p0[r]);
#pragma unroll
  for (int r = 0; r < 16; ++r) pmax = fmaxf(pmax, p1[r]);
  { auto rr = __builtin_amdgcn_permlane32_swap(__float_as_uint(pmax), __float_as_uint(pmax), false, false);
    pmax = fmaxf(__uint_as_float(rr[0]), __uint_as_float(rr[1])); }
  if (__builtin_expect(__all(pmax - m_reg <= THR / SCALE), 1)) { mn = m_reg; alpha = 1.f; }
  else { mn = fmaxf(m_reg, pmax); alpha = __builtin_amdgcn_exp2f((m_reg - mn) * C); m_reg = mn; }
  float mnC = -mn * C;
#pragma unroll
  for (int r = 0; r < 16; ++r) p0[r] = fmaf(p0[r], C, mnC);
#pragma unroll
  for (int r = 0; r < 16; ++r) p1[r] = fmaf(p1[r], C, mnC);
#pragma unroll
  for (int r = 0; r < 16; ++r) p0[r] = __builtin_amdgcn_exp2f(p0[r]);
}
__device__ __forceinline__ void finishSM(f32x16& p0, f32x16& p1, float alpha, float& l_reg, bf16x8& pa0, bf16x8& pa1, bf16x8& pa2, bf16x8& pa3) {
#pragma unroll
  for (int r = 0; r < 16; ++r) p1[r] = __builtin_amdgcn_exp2f(p1[r]);
  float ps = 0;
#pragma unroll
  for (int r = 0; r < 16; ++r) ps += p0[r];
#pragma unroll
  for (int r = 0; r < 16; ++r) ps += p1[r];
  { auto rr = __builtin_amdgcn_permlane32_swap(__float_as_uint(ps), __float_as_uint(ps), false, false);
    ps = __uint_as_float(rr[0]) + __uint_as_float(rr[1]); }
  l_reg = l_reg * alpha + ps;
#define PK4(P, BASE, OUT) do { unsigned a0 = cvtpk(P[BASE + 0], P[BASE + 1]), a1 = cvtpk(P[BASE + 2], P[BASE + 3]);   \
    unsigned b0 = cvtpk(P[BASE + 4], P[BASE + 5]), b1 = cvtpk(P[BASE + 6], P[BASE + 7]);                              \
    auto r0 = __builtin_amdgcn_permlane32_swap(a0, b0, false, false); auto r1 = __builtin_amdgcn_permlane32_swap(a1, b1, false, false); \
    u32x4 w = {r0[0], r1[0], r0[1], r1[1]}; OUT = __builtin_bit_cast(bf16x8, w); } while (0)
  PK4(p0, 0, pa0); PK4(p0, 8, pa1); PK4(p1, 0, pa2); PK4(p1, 8, pa3);
#undef PK4
}
__device__ __forceinline__ void qkt(f32x16& p0, f32x16& p1, const LAS char* Ks, const bf16x8* qr, const LAS char* qrl, int r32, int hi) {
  p0 = f32x16{}; p1 = f32x16{};
#pragma unroll
  for (int d0 = 0; d0 < 12; ++d0) { const int cb = (d0 * 16 + hi * 8) * 2;
    bf16x8 b0 = *reinterpret_cast<const LAS bf16x8*>(Ks + KSWZ(r32, cb));
    bf16x8 b1 = *reinterpret_cast<const LAS bf16x8*>(Ks + KSWZ(32 + r32, cb));
    const bf16x8 qf = d0 < NQR ? qr[d0 < NQR ? d0 : 0] : *reinterpret_cast<const LAS bf16x8*>(qrl + (d0 - NQR) * 1024);
    p0 = __builtin_amdgcn_mfma_f32_32x32x16_bf16(b0, qf, p0, 0, 0, 0);
    p1 = __builtin_amdgcn_mfma_f32_32x32x16_bf16(b1, qf, p1, 0, 0, 0); }
}
__device__ __forceinline__ int v_st(int k, int c) { const int kk = (k & ~0xC) | ((k & 4) << 1) | ((k & 8) >> 1); return ((kk >> 3) * 4 + (c >> 5)) * 512 + ((kk & 7) * 32 + (c & 31)) * 2; }
__device__ __forceinline__ int v_rd_base(int lane) { return ((lane & 3) << 3) | (((lane >> 2) & 3) << 6) | (((lane >> 4) & 1) << 5) | (((lane >> 5) & 1) << 8); }
constexpr int v_rd_off(int d0, int ks, int half) { return d0 * 512 + ks * 4096 + half * 2048; }
template <int OFF> __device__ __forceinline__ s16x4 tr_read(int vb) {
  s16x4 r; asm volatile("ds_read_b64_tr_b16 %0, %1 offset:%2" : "=&v"(r) : "v"(vb), "i"(OFF) : "memory"); return r;
}
template <int D0> __device__ __forceinline__ void pv_one(f32x16& od, int vb, bf16x8 pa0, bf16x8 pa1, bf16x8 pa2, bf16x8 pa3) {
  const s16x4 l0 = tr_read<v_rd_off(D0, 0, 0)>(vb), h0 = tr_read<v_rd_off(D0, 0, 1)>(vb), l1 = tr_read<v_rd_off(D0, 1, 0)>(vb), h1 = tr_read<v_rd_off(D0, 1, 1)>(vb);
  const s16x4 l2 = tr_read<v_rd_off(D0, 2, 0)>(vb), h2 = tr_read<v_rd_off(D0, 2, 1)>(vb), l3 = tr_read<v_rd_off(D0, 3, 0)>(vb), h3 = tr_read<v_rd_off(D0, 3, 1)>(vb);
  asm volatile("s_waitcnt lgkmcnt(0)" ::: "memory"); SBAR();
#define PK(L, H) (bf16x8){L[0], L[1], L[2], L[3], H[0], H[1], H[2], H[3]}
  od = __builtin_amdgcn_mfma_f32_32x32x16_bf16(pa0, PK(l0, h0), od, 0, 0, 0);
  od = __builtin_amdgcn_mfma_f32_32x32x16_bf16(pa1, PK(l1, h1), od, 0, 0, 0);
  od = __builtin_amdgcn_mfma_f32_32x32x16_bf16(pa2, PK(l2, h2), od, 0, 0, 0);
  od = __builtin_amdgcn_mfma_f32_32x32x16_bf16(pa3, PK(l3, h3), od, 0, 0, 0);
#undef PK
}
__device__ __forceinline__ void pv_d0(f32x16* o, int vb, bf16x8 pa0, bf16x8 pa1, bf16x8 pa2, bf16x8 pa3) {
  pv_one<0>(o[0], vb, pa0, pa1, pa2, pa3); pv_one<1>(o[1], vb, pa0, pa1, pa2, pa3); pv_one<2>(o[2], vb, pa0, pa1, pa2, pa3); pv_one<3>(o[3], vb, pa0, pa1, pa2, pa3);
}
constexpr int LDQ = 768, LDK = DK, LDV = DV, LDO = 1024;
__device__ __forceinline__ void attn_dense_body(const bf16* __restrict__ Qb, const bf16* __restrict__ Kh, const bf16* __restrict__ Vh, bf16* __restrict__ Ob, int seq, int pos0, LAS char* lds, const int tid) {
  const int wid = tid >> 6, lane = tid & 63, r32 = lane & 31, hi = lane >> 5;
  LAS char* V_lds = lds; LAS char* K_lds = lds + 2 * SHM_V;
  LAS float* ws = (LAS float*)(lds + 2 * SHM_V + 2 * SHM_K) + wid * 64; LAS float* li_l = ws; LAS float* al_l = ws + 32;
  float m_reg = -1e30f, l_reg = 0; f32x16 o[4] = {}; bf16x8 qr[NQR];
  const LAS char* qrl = lds + SHM_QR + wid * (12 - NQR) * 1024 + lane * 16;
  const bf16* Qw = Qb + (long)(wid * QBLK + r32) * LDQ + hi * 8;
#pragma unroll
  for (int d0 = 0; d0 < NQR; ++d0) qr[d0] = *reinterpret_cast<const bf16x8*>(Qw + d0 * 16);
  LAS char* qw = lds + SHM_QR + wid * (12 - NQR) * 1024 + lane * 16;
#pragma unroll
  for (int d0 = NQR; d0 < 8; ++d0) *(LAS bf16x8*)(qw + (d0 - NQR) * 1024) = *reinterpret_cast<const bf16x8*>(Qw + d0 * 16);
  {
    bf16x8 f0 = *reinterpret_cast<const bf16x8*>(Qw + 128), f1 = *reinterpret_cast<const bf16x8*>(Qw + 144), f2 = *reinterpret_cast<const bf16x8*>(Qw + 160), f3 = *reinterpret_cast<const bf16x8*>(Qw + 176);
    if (pos0 >= 0) { const int pos = pos0 + wid * QBLK + r32; const float pr = (float)(pos >> 6), pc = (float)(pos & 63);
#pragma unroll
      for (int i = 0; i < 8; ++i) { const float inv = __builtin_amdgcn_exp2f(-(float)(8 * hi + i) * (13.287712379549449f / 16.0f));
        { const float rev = pr * inv * INV_2PI, cs = fcos_rev(rev), sn = fsin_rev(rev); const float a = bf2f((unsigned short)f0[i]), b = bf2f((unsigned short)f1[i]);
          f0[i] = (short)f2bf(a * cs - b * sn); f1[i] = (short)f2bf(b * cs + a * sn); }
        { const float rev = pc * inv * INV_2PI, cs = fcos_rev(rev), sn = fsin_rev(rev); const float a = bf2f((unsigned short)f2[i]), b = bf2f((unsigned short)f3[i]);
          f2[i] = (short)f2bf(a * cs - b * sn); f3[i] = (short)f2bf(b * cs + a * sn); } } }
    *(LAS bf16x8*)(qw + (8 - NQR) * 1024) = f0; *(LAS bf16x8*)(qw + (9 - NQR) * 1024) = f1; *(LAS bf16x8*)(qw + (10 - NQR) * 1024) = f2; *(LAS bf16x8*)(qw + (11 - NQR) * 1024) = f3;
  }
  const int sr = tid >> 4, sc = (tid & 15) * 8, vst0 = v_st(sr, sc), vst1 = v_st(32 + sr, sc);
  const int kr = tid >> 3, kc = tid & 7, kgo = kr * LDK + kc * 8, kst = KSWZ(kr, kc * 16);
  const int vb0 = (int)(unsigned)(uintptr_t)V_lds + v_rd_base(lane);
  bf16x8 vs0, vs1, ks0, ks1, ks2;
#define SLOAD(k0) do { vs0 = *reinterpret_cast<const bf16x8*>(&Vh[(long)((k0) + sr) * LDV + sc]); vs1 = *reinterpret_cast<const bf16x8*>(&Vh[(long)((k0) + 32 + sr) * LDV + sc]); \
    ks0 = *reinterpret_cast<const bf16x8*>(&Kh[(long)(k0) * LDK + kgo]); ks1 = *reinterpret_cast<const bf16x8*>(&Kh[(long)(k0) * LDK + kgo + 64]); \
    ks2 = *reinterpret_cast<const bf16x8*>(&Kh[(long)(k0) * LDK + kgo + 128]); } while (0)
#define SWRITE(b) do { *(LAS bf16x8*)(V_lds + (b) * SHM_V + vst0) = vs0; *(LAS bf16x8*)(V_lds + (b) * SHM_V + vst1) = vs1; \
    *(LAS bf16x8*)(K_lds + (b) * SHM_K + kst) = ks0; *(LAS bf16x8*)(K_lds + (b) * SHM_K + kst + 128) = ks1; *(LAS bf16x8*)(K_lds + (b) * SHM_K + kst + 256) = ks2; } while (0)
#define SWAIT() asm volatile("s_waitcnt vmcnt(0)" ::: "memory")
#define RESC(a) do { if (__any((a) < 1.f)) { if (hi == 0) al_l[r32] = (a); asm volatile("s_waitcnt lgkmcnt(0)" ::: "memory"); \
    _Pragma("unroll") for (int d = 0; d < 4; ++d) _Pragma("unroll") for (int r = 0; r < 16; ++r) o[d][r] *= al_l[crow(r, hi)]; } } while (0)
  f32x16 pA0, pA1, pB0, pB1; float mnA, mnB, alA, alB; bf16x8 pa0, pa1, pa2, pa3; const int NT = seq / KVBLK;
  SLOAD(0); SWAIT(); SWRITE(0); __syncthreads();
  qkt(pA0, pA1, K_lds, qr, qrl, r32, hi); partialSM(pA0, pA1, m_reg, mnA, alA);
  SLOAD(KVBLK);
  SWAIT(); SWRITE(1); __syncthreads();
  for (int j = 1; j + 1 < NT; j += 2) {
    SBAR(); qkt(pB0, pB1, K_lds + SHM_K, qr, qrl, r32, hi);
    finishSM(pA0, pA1, alA, l_reg, pa0, pa1, pa2, pa3); SBAR();
    SLOAD((j + 1) * KVBLK); SBAR();
    pv_d0(o, vb0, pa0, pa1, pa2, pa3); partialSM(pB0, pB1, m_reg, mnB, alB);
    __syncthreads(); SWAIT(); SWRITE(0);
    RESC(alB); __syncthreads();
    SBAR(); qkt(pA0, pA1, K_lds, qr, qrl, r32, hi);
    finishSM(pB0, pB1, alB, l_reg, pa0, pa1, pa2, pa3); SBAR();
    SLOAD((j + 2) * KVBLK); SBAR();
    pv_d0(o, vb0 + SHM_V, pa0, pa1, pa2, pa3); partialSM(pA0, pA1, m_reg, mnA, alA);
    __syncthreads(); SWAIT(); SWRITE(1);
    RESC(alA); __syncthreads();
  }
  SBAR(); qkt(pB0, pB1, K_lds + SHM_K, qr, qrl, r32, hi);
  finishSM(pA0, pA1, alA, l_reg, pa0, pa1, pa2, pa3); SBAR();
  pv_d0(o, vb0, pa0, pa1, pa2, pa3); partialSM(pB0, pB1, m_reg, mnB, alB);
  __syncthreads(); RESC(alB);
  finishSM(pB0, pB1, alB, l_reg, pa0, pa1, pa2, pa3); SBAR();
  pv_d0(o, vb0 + SHM_V, pa0, pa1, pa2, pa3);
  if (hi == 0) li_l[r32] = l_reg; asm volatile("s_waitcnt lgkmcnt(0)" ::: "memory");
  float rli[16];
#pragma unroll
  for (int r = 0; r < 16; ++r) rli[r] = __builtin_amdgcn_rcpf(li_l[crow(r, hi)]);
  bf16* Ow = Ob + (long)(wid * QBLK) * LDO;
#pragma unroll
  for (int r = 0; r < 16; ++r) { const int orow = crow(r, hi);
#pragma unroll
    for (int d0 = 0; d0 < 4; ++d0) Ow[(long)orow * LDO + d0 * 32 + r32] = (bf16)f2bf(o[d0][r] * rli[r]); }
  __syncthreads();
#undef SLOAD
#undef SWRITE
#undef SWAIT
#undef RESC
}
#undef KSWZ
#undef SBAR
}
__device__ __forceinline__ void transpose_item(const float* W, int K, int N, bf16* WT, int ldk, LAS float* scr, int item, int lane) {
    const int nblk = N / 32, kb = item / nblk, nb = item % nblk, k0 = 64 * kb, n0 = 32 * nb;
#pragma unroll 8
    for (int i = 0; i < 32; ++i) { const int kk = 2 * i + (lane >> 5); scr[kk * 33 + (lane & 31)] = W[(size_t)(k0 + kk) * N + n0 + (lane & 31)]; }
    LDS_WAIT(); asm volatile("" ::: "memory");
    const int c = lane & 7;
#pragma unroll
    for (int j = 0; j < 4; ++j) { const int n = (lane >> 3) + 8 * j; const LAS float* s = scr + (8 * c) * 33 + n;
        v4u o; o.x = pk2(s[0 * 33], s[1 * 33]); o.y = pk2(s[2 * 33], s[3 * 33]); o.z = pk2(s[4 * 33], s[5 * 33]); o.w = pk2(s[6 * 33], s[7 * 33]);
        *(v4u*)(WT + (size_t)(n0 + n) * ldk + k0 + 8 * c) = o; }
    LDS_WAIT(); asm volatile("" ::: "memory");
}
__device__ __forceinline__ void fold_item(const float* W, bf16* WT, LAS float* scr, const LAS float* tab  , int item, int lane) {
    const int kb = item / 32, nb = item % 32, k0 = 64 * kb, n0 = 32 * nb;
    const int part = k0 >> 10, g = (k0 & 1023) >> 7, cp0 = k0 & 127;
    const float* wcol = W + (size_t)(g * 128) * DM + n0 + (lane & 31);
    float wr[128];
#pragma unroll
    for (int c = 0; c < 128; ++c) wr[c] = wcol[(size_t)c * DM];
    const LAS float* tb = tab + part * 128;
    for (int i = 0; i < 32; ++i) { const int kk = 2 * i + (lane >> 5), cp = cp0 + kk; float s = 0.f; int idx = 0;
#pragma unroll
        for (int c = 0; c < 128; ++c) { s += tb[idx] * wr[c]; idx = (idx + cp) & 127; }
        scr[kk * 33 + (lane & 31)] = (part ? -s : s) * 0.08838834764831845f; }
    LDS_WAIT(); asm volatile("" ::: "memory");
    const int c = lane & 7;
#pragma unroll
    for (int j = 0; j < 4; ++j) { const int nn = (lane >> 3) + 8 * j; const LAS float* s = scr + (8 * c) * 33 + nn;
        v4u o; o.x = pk2(s[0 * 33], s[1 * 33]); o.y = pk2(s[2 * 33], s[3 * 33]); o.z = pk2(s[4 * 33], s[5 * 33]); o.w = pk2(s[6 * 33], s[7 * 33]);
        *(v4u*)(WT + (size_t)(n0 + nn) * 2048 + k0 + 8 * c) = o; }
    LDS_WAIT(); asm volatile("" ::: "memory");
}
__device__ __forceinline__ void row_stats(const f32x4 (&v)[4], float& mean, float& rstd) {
    float s = 0.f;
#pragma unroll
    for (int j = 0; j < 4; ++j) s += (v[j][0] + v[j][1]) + (v[j][2] + v[j][3]);
    mean = wave_sum(s) * (1.f / DM); float q = 0.f;
#pragma unroll
    for (int j = 0; j < 4; ++j) { const f32x4 d = v[j] - mean; q += (d[0] * d[0] + d[1] * d[1]) + (d[2] * d[2] + d[3] * d[3]); }
    rstd = __builtin_amdgcn_rsqf(wave_sum(q) * (1.f / DM) + LN_EPS);
}
__device__ __forceinline__ void load_row(const float* p, int lane, f32x4 (&v)[4]) {
#pragma unroll
    for (int j = 0; j < 4; ++j) v[j] = ((const f32x4*)p)[lane + 64 * j];
}
__device__ __forceinline__ void adaln_store(const f32x4 (&v)[4], const float* shift, const float* scale, bf16* hrow, int lane) {
    float mean, rstd; row_stats(v, mean, rstd);
#pragma unroll
    for (int j = 0; j < 4; ++j) { const int c = 4 * lane + 256 * j; const f32x4 sc = *(const f32x4*)(scale + c), sh = *(const f32x4*)(shift + c);
        const f32x4 h = (v[j] - mean) * rstd * (sc + 1.0f) + sh;
        v2u w; w.x = pk2(h[0], h[1]); w.y = pk2(h[2], h[3]); *(v2u*)(hrow + c) = w; }
}
__device__ __forceinline__ void ln_affine(f32x4 (&v)[4], const float* g, const float* b, int lane) {
    float mean, rstd; row_stats(v, mean, rstd);
#pragma unroll
    for (int j = 0; j < 4; ++j) { const int c = 4 * lane + 256 * j; v[j] = (v[j] - mean) * rstd * *(const f32x4*)(g + c) + *(const f32x4*)(b + c); }
}
__device__ __forceinline__ void store_row(float* p, int lane, const f32x4 (&v)[4]) {
#pragma unroll
    for (int j = 0; j < 4; ++j) ((f32x4*)p)[lane + 64 * j] = v[j];
}

namespace hconv {
using bf16x8 = __attribute__((ext_vector_type(8))) short;
using f32x16 = __attribute__((ext_vector_type(16))) float;
constexpr int UB = 8256;
constexpr int SLOT = 16384 + 2 * UB;
__device__ __forceinline__ int crow(int r, int hi) { return (r & 3) + 8 * (r >> 2) + 4 * hi; }
__device__ __forceinline__ void item(const bf16* __restrict__ GRB, const bf16* __restrict__ UT, const float* __restrict__ FP, const float* __restrict__ skipv, const bf16* __restrict__ X0, bf16* __restrict__ YM,
                                     int ch0, LAS unsigned char* lds, const int tid, const int lane, const int wave) {
    for (int q = tid; q < 4 * 1024; q += 512) { const int ch = q >> 10, i = q & 1023; const v4u v = ((const v4u*)(GRB + (size_t)(ch0 + ch) * 8192))[i]; *(LAS v4u*)(lds + ch * SLOT + 16 * i) = v; }
    for (int q = tid; q < 4 * 1024; q += 512) { const int ch = q >> 10, b = (q >> 9) & 1, i = q & 511; const v4u v = ((const v4u*)(UT + ((size_t)b * HY + ch0 + ch) * LS))[i];
        *(LAS v4u*)(lds + ch * SLOT + 16384 + b * UB + 32 + 16 * i) = v; }
    if (tid < 32) { const int ch = tid >> 3, b = (tid >> 2) & 1, j = tid & 3; const v4u z = {0u, 0u, 0u, 0u};
        *(LAS v4u*)(lds + ch * SLOT + 16384 + b * UB + (j < 2 ? 16 * j : 32 + 8192 + 16 * (j - 2))) = z; }
    __syncthreads();
    {
        const int slot = wave & 3, khalf = wave >> 2;
        const LAS unsigned char* gr = lds + slot * SLOT; const LAS unsigned char* ubuf = gr + 16384;
        const int r = lane & 31, h = lane >> 5, c = r & 15, b = r >> 4, c0 = c & 1, c1 = c >> 1;
        const LAS unsigned char* ap = gr + 992 + 16 * h - 32 * r + khalf * (129 * 32);
        const LAS unsigned char* bp = ubuf + b * UB + 16 * h + 4 * c1 + khalf * (129 * 32);
        const unsigned sh = 16u * (unsigned)c0;
        const int ch = ch0 + slot;
        const float nsum = wave_sum(FP[ch * 64 + lane] + FP[(HY + ch) * 64 + lane]); const float inv_norm = 1.f / nsum; const float skn = skipv[ch] * nsum;
        const LAS bf16* ul = (const LAS bf16*)(ubuf + b * UB + 32);
        f32x16 acc[8];
#pragma unroll
        for (int Q = 0; Q < 8; ++Q)
#pragma unroll
            for (int g = 0; g < 16; ++g) acc[Q][g] = khalf ? 0.f : skn * bf2f(ul[16 * (32 * Q + crow(g, h)) + c]);
        int nks = khalf ? 128 : 129; asm volatile("" : "+s"(nks));
        for (int ks = 0; ks < nks; ++ks) {
            const LAS unsigned* bq = (const LAS unsigned*)bp;
            const unsigned d0 = bq[0], d1 = bq[1], d2 = bq[2], d3 = bq[3], d4 = bq[4];
            u32x4 bw; bw.x = __builtin_amdgcn_alignbit(d1, d0, sh); bw.y = __builtin_amdgcn_alignbit(d2, d1, sh); bw.z = __builtin_amdgcn_alignbit(d3, d2, sh); bw.w = __builtin_amdgcn_alignbit(d4, d3, sh);
            const bf16x8 bf = __builtin_bit_cast(bf16x8, bw);
#pragma unroll
            for (int Q = 0; Q < 8; ++Q) { const bf16x8 af = *(const LAS bf16x8*)(ap + 1024 * (7 - Q)); acc[Q] = __builtin_amdgcn_mfma_f32_32x32x16_bf16(af, bf, acc[Q], 0, 0, 0); }
            ap += 32; bp += 32;
        }
        asm volatile("s_waitcnt lgkmcnt(0)" ::: "memory");
        __syncthreads();
        LAS f32x4* xch = (LAS f32x4*)(lds + slot * SLOT);
        if (khalf) {
#pragma unroll
            for (int Q = 0; Q < 8; ++Q)
#pragma unroll
                for (int g4 = 0; g4 < 4; ++g4) xch[(Q * 4 + g4) * 64 + lane] = (f32x4){acc[Q][4 * g4], acc[Q][4 * g4 + 1], acc[Q][4 * g4 + 2], acc[Q][4 * g4 + 3]};
        }
        __syncthreads();
        if (!khalf) {
#pragma unroll
            for (int Q = 0; Q < 8; ++Q)
#pragma unroll
                for (int g4 = 0; g4 < 4; ++g4) { const f32x4 o = xch[(Q * 4 + g4) * 64 + lane]; acc[Q][4 * g4] += o[0]; acc[Q][4 * g4 + 1] += o[1]; acc[Q][4 * g4 + 2] += o[2]; acc[Q][4 * g4 + 3] += o[3]; }
        }
        asm volatile("s_waitcnt lgkmcnt(0)" ::: "memory");
        __syncthreads();
        if (!khalf) {
            LAS bf16* yl = (LAS bf16*)(lds + slot * SLOT);
#pragma unroll
            for (int Q = 0; Q < 8; ++Q)
#pragma unroll
                for (int g = 0; g < 16; ++g) { const int t = 16 * (32 * Q + crow(g, h)) + c; yl[b * LS + t] = (bf16)f2bf(acc[Q][g] * inv_norm); }
        }
    }
    __syncthreads();
    for (int q = tid; q < 2 * LS; q += 512) { const int b = q >> 12, t = q & (LS - 1); const size_t row = (size_t)NP + (size_t)b * LS + t;
        const v2u xv = *(const v2u*)(X0 + row * HY + ch0);
        const float y0 = bf2f(*(const LAS bf16*)(lds + 0 * SLOT + 2 * q)), y1 = bf2f(*(const LAS bf16*)(lds + 1 * SLOT + 2 * q)), y2 = bf2f(*(const LAS bf16*)(lds + 2 * SLOT + 2 * q)), y3 = bf2f(*(const LAS bf16*)(lds + 3 * SLOT + 2 * q));
        v2u o; o.x = pk2(y0 * bf2f((unsigned short)(xv.x & 0xffffu)), y1 * bf2f((unsigned short)(xv.x >> 16))); o.y = pk2(y2 * bf2f((unsigned short)(xv.y & 0xffffu)), y3 * bf2f((unsigned short)(xv.y >> 16)));
        *(v2u*)(YM + row * DM + ch0) = o; }
    __syncthreads();
}
static_assert(4 * SLOT <= LDSCTL_OFF, "four channel slots fit in LDS");
}

__global__ void __launch_bounds__(512, 2) fwd_kernel(Args args) {
    extern __shared__ __attribute__((aligned(16))) unsigned char lds_raw[];
    LAS unsigned char* lds = (LAS unsigned char*)lds_raw;
    volatile LAS unsigned* MISC = (volatile LAS unsigned*)(lds + MISC_OFF);
    const int wave = __builtin_amdgcn_readfirstlane((int)threadIdx.x >> 6);
    const int G = gridDim.x; const int bx = blockIdx.x; const int vcu = (G % 8 == 0) ? (bx % 8) * (G / 8) + bx / 8 : bx;
    const int gw = vcu * 8 + wave, NGW = G * 8, NGT = G * 512;
#define FRESH() const int lane = fresh_lane(); const int tid = wave * 64 + lane; const int gt = vcu * 512 + tid; (void)gt
    unsigned char* ws = args.ws;
    gu32* ctl = (gu32*)(ws + WS_CTL);
    float* MODS = (float*)(ws + WS_MODS);
    float* X = args.out;
    float* T = (float*)(ws + WS_T);
    bf16* HB = (bf16*)(ws + WS_H);
    for (int u = threadIdx.x; u < (LDS_BYTES - LDSCTL_OFF) / 4; u += 512) ((LAS unsigned*)(lds + LDSCTL_OFF))[u] = 0u;
    __syncthreads();
    XcdBarrier bar; bar.bar = (unsigned*)(ctl + CW_BAR) + args.li * XCD_BAR_WORDS; bar.x = 0; bar.st = nullptr;
    if (!MK_PER_PHASE) bar = xcd_barrier_post((unsigned*)(ctl + CW_BAR) + args.li * XCD_BAR_WORDS, MISC + 8);
    const int lo = args.ph_lo, hi = args.ph_hi;
#ifndef NO_CONV
#define NO_CONV 0
#endif
#ifndef NO_ATT
#define NO_ATT 0
#endif
#ifndef PHASE_MASK
#define PHASE_MASK 0x1FFFF
#endif
#define IN(k) ((((PHASE_MASK) >> (k)) & 1) && lo <= (k) && (k) < hi)
#define SEAM(k) do { if (IN(k) && IN((k) + 1)) xcd_barrier(bar); } while (0)

    if (IN(0)) {
        FRESH();
        asm volatile("; ==== PHASE 0 ====");
        for (int it = bx; it < 192; it += G) {
            const int layer = it / 96, cb = it % 96, col = cb * 64 + lane;
            LAS float* sil = (LAS float*)lds; LAS float* red = (LAS float*)(lds + 12288);
            for (int i = tid; i < 3072; i += 512) { const int r = i >> 10, k = i & 1023; const float c = (r == 0) ? args.in[I_CCTX][k] : args.in[I_C][(r - 1) * DM + k]; sil[i] = c / (1.f + fexp(-c)); }
            __syncthreads();
            const float* W = args.in[layer ? I_ADA1_W : I_ADA0_W]; float a0 = 0.f, a1 = 0.f, a2 = 0.f;
#pragma unroll 8
            for (int kk = 0; kk < 128; ++kk) { const int k = wave * 128 + kk; const float w = W[(size_t)k * 6144 + col]; a0 += sil[k] * w; a1 += sil[1024 + k] * w; a2 += sil[2048 + k] * w; }
            red[(wave * 3 + 0) * 64 + lane] = a0; red[(wave * 3 + 1) * 64 + lane] = a1; red[(wave * 3 + 2) * 64 + lane] = a2;
            __syncthreads();
            if (tid < 192) { const int r = tid >> 6, l = tid & 63; float s = 0.f;
#pragma unroll
                for (int w = 0; w < 8; ++w) s += red[(w * 3 + r) * 64 + l];
                MODS[(size_t)(layer * 3 + r) * 6144 + cb * 64 + l] = s + args.in[layer ? I_ADA1_B : I_ADA0_B][cb * 64 + l]; }
            __syncthreads();
        }
        {
            LAS float* scr = (LAS float*)(lds + wave * 16384);
            LAS float* tab = (LAS float*)(lds + wave * 16384 + 8704);
            for (int i = lane; i < 256; i += 64) tab[i] = (i < 128) ? fcos_rev((float)i * (1.f / 128.f)) : fsin_rev((float)(i - 128) * (1.f / 128.f));
            LDS_WAIT();
            constexpr int I0 = 992, I1 = 96, I2 = 64, I3 = 512, I4 = 2048, NTR = I0 + I1 + I2 + I3 + 4 * I4, NFOLD = 1024;
            for (int it = gw; it < NTR + NFOLD; it += NGW) {
                int r = it;
                if (r < I0) { transpose_item(args.in[I_WIN], 1024, 1984, (bf16*)(ws + WS_WIN_T), 1024, scr, r, lane); continue; } r -= I0;
                if (r < I1) { transpose_item(args.in[I_QUP], 256, 768, (bf16*)(ws + WS_QUP_T), 256, scr, r, lane); continue; } r -= I1;
                if (r < I2) { transpose_item(args.in[I_KVUP], 128, 1024, (bf16*)(ws + WS_KVUP_T), 256, scr, r, lane); continue; } r -= I2;
                if (r < I3) { transpose_item(args.in[I_WOUT0], 1024, 1024, (bf16*)(ws + WS_WOUT0_T), 1024, scr, r, lane); continue; } r -= I3;
                if (r < I4) { transpose_item(args.in[I_W1_0], 1024, 4096, (bf16*)(ws + WS_W1_0), 1024, scr, r, lane); continue; } r -= I4;
                if (r < I4) { transpose_item(args.in[I_W2_0], 4096, 1024, (bf16*)(ws + WS_W2_0), 4096, scr, r, lane); continue; } r -= I4;
                if (r < I4) { transpose_item(args.in[I_W1_1], 1024, 4096, (bf16*)(ws + WS_W1_1), 1024, scr, r, lane); continue; } r -= I4;
                if (r < I4) { transpose_item(args.in[I_W2_1], 4096, 1024, (bf16*)(ws + WS_W2_1), 4096, scr, r, lane); continue; } r -= I4;
                fold_item(args.in[I_WOUT1], (bf16*)(ws + WS_WFOLD_T), scr, tab, r, lane);
            }
        }
        {
            const v4u z = {0u, 0u, 0u, 0u};
            for (int i = gt; i < 8192 + 16384 + MKV * 16; i += NGT) {
                if (i < 8192) ((v4u*)(ws + WS_WIN_T + (size_t)1984 * 2048))[i] = z;
                else if (i < 8192 + 16384) { const int j = i - 8192; *(v4u*)(ws + WS_KVUP_T + (size_t)(j >> 4) * 512 + 256 + (j & 15) * 16) = z; }
                else { const int j = i - 8192 - 16384; *(v4u*)(ws + WS_KVN + (size_t)(j >> 4) * 512 + 256 + (j & 15) * 16) = z; }
            }
        }
        for (int i = gt; i < 65536; i += NGT) { const int rho = i >> 8, l = i & 255; const int k = rho > 128 ? rho - 128 : rho; const float rev = (float)((k * l) & 255) * (1.f / 256.f);
            ((bf16*)(ws + WS_D256))[i] = (bf16)f2bf((rho > 128 ? __builtin_amdgcn_sinf(rev) : __builtin_amdgcn_cosf(rev)) * 0.0625f); }
        {
            float* H2 = (float*)(ws + WS_H2);
            const float* w1 = args.in[I_HFW1]; const float* w2 = args.in[I_HFW2];
            const float b1 = args.in[I_HFB1][lane], b2 = args.in[I_HFB2][lane], fr = args.in[I_HFFREQ][lane];
            for (int R = gw; R < LS + LP; R += NGW) {
                const int L = R < LS ? LS : LP, l = R < LS ? R : R - LS;
                const float t = (float)l / (float)(L - 1);
                const float wang = (6.283185307179586f * (float)l) / (float)L;
                const int j = lane & 15; const float band = 1e-4f + (float)j * ((15.0f - 1e-4f) / 15.0f);
                const float ang = wang * band, rev = ang * INV_2PI;
                const float zl = (lane < 16) ? fcos_rev(rev) : -fsin_rev(rev);
                float p1 = b1 + t * w1[lane];
#pragma unroll
                for (int i = 0; i < 32; ++i) p1 += __shfl(zl, i) * w1[(1 + i) * 64 + lane];
                const float h1 = sinf(fr * p1);
                float p2 = b2;
#pragma unroll 16
                for (int i = 0; i < 64; ++i) p2 += __shfl(h1, i) * w2[i * 64 + lane];
                H2[(size_t)R * 64 + lane] = sinf(fr * p2);
            }
        }
    }
    SEAM(0);

    if (IN(1)) {
        FRESH();
        asm volatile("; ==== PHASE 1 ====");
        for (int m = gw; m < MT; m += NGW) {
            const float* xr = m < NP ? args.in[I_XP] + (size_t)m * DM : args.in[I_XS] + (size_t)(m - NP) * DM;
            const float* md = MODS + (size_t)req_of_row(m) * 6144;
            f32x4 v[4]; load_row(xr, lane, v); adaln_store(v, md, md + 1024, HB + (size_t)m * DM, lane);
        }
        {
            const float* H2 = (const float*)(ws + WS_H2); const float* w3 = args.in[I_HFW3];
            LAS float* w3l = (LAS float*)(lds + wave * 16384);
            for (int it = gw; it < 68 * 32; it += NGW) {
                const int lb = it >> 5, cg = it & 31; const bool smp = lb < 64; const int L = smp ? LS : LP; const int l = (smp ? lb : lb - 64) * 64 + lane; const int R = lb * 64 + lane;
#pragma unroll
                for (int q = 0; q < 32; ++q) { const int o = 2 * q + (lane >> 5); w3l[o * 32 + (lane & 31)] = w3[o * 1024 + cg * 32 + (lane & 31)]; }
                float h2[64];
#pragma unroll
                for (int q = 0; q < 16; ++q) { const f32x4 x = ((const f32x4*)(H2 + (size_t)R * 64))[q]; h2[4 * q] = x[0]; h2[4 * q + 1] = x[1]; h2[4 * q + 2] = x[2]; h2[4 * q + 3] = x[3]; }
                LDS_WAIT(); asm volatile("" ::: "memory");
                const float t = (float)l / (float)(L - 1);
                float* FP = (float*)(ws + (smp ? WS_FPART_S : WS_FPART_P));
                for (int cc = 0; cc < 32; ++cc) {
                    const int col = cg * 32 + cc, ch = col & 511, half = col >> 9;
                    float a = 0.f;
#pragma unroll
                    for (int o = 0; o < 64; ++o) a += h2[o] * w3l[o * 32 + cc];
                    const float delta = fabsf(-3.0701134573253944f + (float)ch * ((-15.350567286626973f + 3.0701134573253944f) / 511.0f));
                    const float val = a * fexp(-t * delta);
                    if (smp) {
                        bf16* GRB = (bf16*)(ws + WS_FT_S) + (size_t)ch * 8192;
                        if (half == 0) GRB[LS - l] = (bf16)f2bf(val); else GRB[l == 0 ? 0 : LS + l] = (bf16)(l == 0 ? 0u : f2bf(val));
                    } else ((float*)(ws + WS_FT_P))[(size_t)col * LP + l] = val;
                    const float sa = wave_sum(fabsf(val));
                    if (lane == 0) FP[col * (smp ? 64 : 4) + (smp ? lb : lb - 64)] = sa;
                }
                LDS_WAIT(); asm volatile("" ::: "memory");
            }
        }
    }
    SEAM(1);

    if (IN(2)) {
        FRESH();
        asm volatile("; ==== PHASE 2 ====");
        pg8::Gemm g{HB, (const bf16*)(ws + WS_WIN_T), MT, WINP, DM}; pg8::StaticOrder S; S.init(MT, WINP, G, bx);
        EpiWin E{(bf16*)(ws + WS_P), (float*)(ws + WS_ZS)};
        pg8::gemm_phase<EpiWin, pg8::StaticOrder, PG8_ALIGN, PG8_SP2>(lds, g, S, E, tid);
    }
    SEAM(2);

    if (IN(3)) {
        FRESH();
        asm volatile("; ==== PHASE 3 ====");
        const bf16* P = (const bf16*)(ws + WS_P);
        for (int it = bx; it < MT / 64; it += G) {
            const int m0 = it * 64; const bool smp = m0 >= NP; const int L = smp ? LS : LP; const int l0 = smp ? (m0 - NP) % LS : m0 % LP;
            const int seq = smp ? (m0 - NP) / LS : m0 / LP;
            const int c = tid;
            const float* cw = args.in[I_CONVW]; const float* cb = args.in[I_CONVB];
            float w[3][3], bb[3];
#pragma unroll
            for (int s = 0; s < 3; ++s) { bb[s] = cb[s * 512 + c];
#pragma unroll
                for (int k = 0; k < 3; ++k) w[s][k] = cw[k * 1536 + s * 512 + c]; }
            float prev[3], cur[3];
#pragma unroll
            for (int s = 0; s < 3; ++s) { prev[s] = (l0 > 0) ? bf2f(P[(size_t)(m0 - 1) * 1536 + s * 512 + c]) : 0.f; cur[s] = bf2f(P[(size_t)m0 * 1536 + s * 512 + c]); }
            LAS bf16* ut = (LAS bf16*)lds;
            bf16* X0 = (bf16*)(ws + WS_X0);
            for (int i0 = 0; i0 < 64; i0 += 8) {
                float nx[8][3];
#pragma unroll
                for (int i = 0; i < 8; ++i) { const bool has_next = (l0 + i0 + i + 1) < L;
#pragma unroll
                    for (int s = 0; s < 3; ++s) { const float v = bf2f(P[(size_t)(m0 + i0 + i + (has_next ? 1 : 0)) * 1536 + s * 512 + c]); nx[i][s] = has_next ? v : 0.f; } }
#pragma unroll
                for (int i = 0; i < 8; ++i) {
                    float y[3];
#pragma unroll
                    for (int s = 0; s < 3; ++s) y[s] = prev[s] * w[s][0] + cur[s] * w[s][1] + nx[i][s] * w[s][2] + bb[s];
                    X0[(size_t)(m0 + i0 + i) * 512 + c] = (bf16)f2bf(y[0]);
                    ut[c * 68 + i0 + i] = (bf16)f2bf(y[2] * y[1]);
#pragma unroll
                    for (int s = 0; s < 3; ++s) { prev[s] = cur[s]; cur[s] = nx[i][s]; }
                }
            }
            __syncthreads();
            bf16* UT = (bf16*)(ws + (smp ? WS_UT_S : WS_UT_P)) + (size_t)seq * 512 * L + l0;
            for (int q = tid; q < 512 * 16; q += 512) { const int ch = q >> 4, part = q & 15; const v2u v = *(const LAS v2u*)(ut + ch * 68 + part * 4); *(v2u*)(UT + (size_t)ch * L + part * 4) = v; }
            __syncthreads();
        }
        const float* ZS = (const float*)(ws + WS_ZS);
        bf16* QN = (bf16*)(ws + WS_QN); bf16* KVN = (bf16*)(ws + WS_KVN);
        for (int m = gw; m < MKV; m += NGW) {
            if (m < MT) {
                const bool smp = m >= NP; const int b = smp ? (m - NP) / LS : m / LP, key = smp ? (m - NP) % LS : m % LP;
                const f32x4 a0 = ((const f32x4*)(ZS + (size_t)m * 512))[2 * lane], a1 = ((const f32x4*)(ZS + (size_t)m * 512))[2 * lane + 1];
                float x[8] = {a0[0], a0[1], a0[2], a0[3], a1[0], a1[1], a1[2], a1[3]};
                float ss = 0.f;
                if (lane < 48) {
#pragma unroll
                    for (int i = 0; i < 8; ++i) ss += x[i] * x[i]; }
#pragma unroll
                for (int o = 1; o < 32; o <<= 1) ss += __shfl_xor(ss, o);
                if (lane < 32) {
                    const float r = __builtin_amdgcn_rsqf(ss * (1.f / QL) + RMS_EPS); const float* g = args.in[I_QNORM] + 8 * lane;
                    v4u w; w.x = pk2(x[0] * r * g[0], x[1] * r * g[1]); w.y = pk2(x[2] * r * g[2], x[3] * r * g[3]); w.z = pk2(x[4] * r * g[4], x[5] * r * g[5]); w.w = pk2(x[6] * r * g[6], x[7] * r * g[7]);
                    *(v4u*)(QN + (size_t)m * 256 + 8 * lane) = w;
                } else if (lane < 48) {
                    const int c0 = 8 * (lane - 32); const float r = __builtin_amdgcn_rsqf(ss * (1.f / KVL) + RMS_EPS); const float* g = args.in[I_KVNORM] + c0;
                    float y[8];
#pragma unroll
                    for (int i = 0; i < 8; ++i) y[i] = x[i] * r * g[i];
                    v4u w; w.x = pk2(y[0], y[1]); w.y = pk2(y[2], y[3]); w.z = pk2(y[4], y[5]); w.w = pk2(y[6], y[7]);
                    *(v4u*)(KVN + (size_t)m * 256 + c0) = w;
                    if (!smp) { float* o = args.out + OUT_CKV + (size_t)m * KVL + c0; *(f32x4*)o = (f32x4){y[0], y[1], y[2], y[3]}; *(f32x4*)(o + 4) = (f32x4){y[4], y[5], y[6], y[7]}; }
                }
                {
                    float y[8];
                    const int q = lane - 48; const int seg = (q >> 2) & 1; const bool second = (q & 2) != 0; const int j0 = 8 * (q & 1);
                    const float pf = (float)(seg == 0 ? (key >> 6) : (key & 63));
#pragma unroll
                    for (int i = 0; i < 8; ++i) { const float pr = __shfl_xor(x[i], 2);
                        if (smp) { const float inv = __builtin_amdgcn_exp2f(-(float)(j0 + i) * (13.287712379549449f / 16.0f)); const float rev = pf * inv * INV_2PI;
                            y[i] = x[i] * fcos_rev(rev) + (second ? pr : -pr) * fsin_rev(rev); }
                        else y[i] = x[i]; }
                    if (lane >= 48 && lane < 56) {
                        const int kk = 8 * q;
                        if (!smp) { float* o = args.out + OUT_CKR + (size_t)m * DROPE + kk; *(f32x4*)o = (f32x4){y[0], y[1], y[2], y[3]}; *(f32x4*)(o + 4) = (f32x4){y[4], y[5], y[6], y[7]}; }
                        v4u w; w.x = pk2(y[0], y[1]); w.y = pk2(y[2], y[3]); w.z = pk2(y[4], y[5]); w.w = pk2(y[6], y[7]);
                        bf16* kf = (bf16*)(ws + (smp ? WS_KF_S : WS_KF_P)); const int lk = smp ? LKS : LP;
#pragma unroll
                        for (int h = 0; h < NH; ++h) *(v4u*)(kf + ((size_t)(b * NH + h) * lk + key) * DQK + DNOPE + kk) = w;
                    }
                }
            } else {
                const int mm = m - MT, b = mm / PAST, j = mm % PAST;
                if (lane < 16) { const float* s = args.in[I_CKV] + (size_t)mm * KVL + 8 * lane;
                    v4u w; w.x = pk2(s[0], s[1]); w.y = pk2(s[2], s[3]); w.z = pk2(s[4], s[5]); w.w = pk2(s[6], s[7]); *(v4u*)(KVN + (size_t)m * 256 + 8 * lane) = w; }
                else if (lane < 24) { const int kk = 8 * (lane - 16); const float* s = args.in[I_CKR] + (size_t)mm * DROPE + kk;
                    v4u w; w.x = pk2(s[0], s[1]); w.y = pk2(s[2], s[3]); w.z = pk2(s[4], s[5]); w.w = pk2(s[6], s[7]);
                    bf16* kf = (bf16*)(ws + WS_KF_S);
#pragma unroll
                    for (int h = 0; h < NH; ++h) *(v4u*)(kf + ((size_t)(b * NH + h) * LKS + LS + j) * DQK + DNOPE + kk) = w; }
            }
        }
    }
    SEAM(3);

    if (IN(4)) {
        FRESH();
        asm volatile("; ==== PHASE 4 ====");
        { pg8::Gemm g{(const bf16*)(ws + WS_QN), (const bf16*)(ws + WS_QUP_T), MT, 768, 256}; pg8::StaticOrder S; S.init(MT, 768, G, bx);
          EpiQ E{(bf16*)(ws + WS_Q)};
          pg8::gemm_phase<EpiQ, pg8::StaticOrder, PG8_ALIGN, PG8_SP2>(lds, g, S, E, tid); }
        { int bx2 = (bx + 144) % G; asm volatile("" : "+s"(bx2)); const int lane2 = fresh_lane(); const int tid = wave * 64 + lane2;
          pg8::Gemm g{(const bf16*)(ws + WS_KVN), (const bf16*)(ws + WS_KVUP_T), MKV, 1024, 256}; pg8::StaticOrder S; S.init(MKV, 1024, G, bx2);
          EpiKV E{(bf16*)(ws + WS_KF_S), (bf16*)(ws + WS_KF_P), (bf16*)(ws + WS_V_S), (bf16*)(ws + WS_V_P)};
          pg8::gemm_phase<EpiKV, pg8::StaticOrder, PG8_ALIGN, PG8_SP2>(lds, g, S, E, tid); }
    }
    SEAM(4);

    if (IN(5)) {
        FRESH();
        asm volatile("; ==== PHASE 5 ====");
        constexpr int NA_S = BS * NH * (LS / 256), NC_S = HY / 4, NA_P = BP * NH, NC_P = HY, NITEM = NA_S + NC_S + NA_P + NC_P;
        bf16* YM = HB;
        for (;;) {
            if (tid == 0) MISC[0] = __hip_atomic_fetch_add((unsigned*)(ctl + CW_Q + 64 * args.li), 1u, RLX_AGENT);
            __syncthreads();
            const int it = __builtin_amdgcn_readfirstlane((int)MISC[0]);
            __syncthreads();
            if (it >= NITEM) break;
            const int lane = fresh_lane(); const int tid = wave * 64 + lane;
            const bool isA_S = it < NA_S, isA_P = (it >= NA_S + NC_S) && (it < NA_S + NC_S + NA_P);
            if (isA_S || isA_P) { if (!NO_ATT) {
                int b, h, row0, lk, pos0; const bf16 *kf, *vv;
                if (isA_S) { b = it / (NH * 16); h = (it / 16) % NH; const int qb = it % 16; row0 = NP + b * LS + qb * 256; lk = LKS; pos0 = qb * 256; kf = (const bf16*)(ws + WS_KF_S); vv = (const bf16*)(ws + WS_V_S); }
                else { const int u = it - NA_S - NC_S; b = u / NH; h = u % NH; row0 = b * LP; lk = LP; pos0 = -1; kf = (const bf16*)(ws + WS_KF_P); vv = (const bf16*)(ws + WS_V_P); }
                att::attn_dense_body((const bf16*)(ws + WS_Q) + (size_t)row0 * 768 + h * DQK, kf + (size_t)(b * NH + h) * lk * DQK, vv + (size_t)(b * NH + h) * lk * DVH,
                                     YM + (size_t)row0 * DM + HY + h * DVH, lk, pos0, (LAS char*)lds, tid); }
            } else if (it < NA_S + NC_S) {
                hconv::item((const bf16*)(ws + WS_FT_S), (const bf16*)(ws + WS_UT_S), (const float*)(ws + WS_FPART_S), args.in[I_HFSKIP], (const bf16*)(ws + WS_X0), YM, (it - NA_S) * 4, lds, tid, lane, wave);
            } else if (!NO_CONV) {
                const bool smp = it < NA_S + NC_S; const int ch = smp ? it - NA_S : it - NA_S - NC_S - NA_P;
                const int L = smp ? LS : LP, nb = smp ? BS : BP, tokbase = smp ? NP : 0;
                const float* FT = (const float*)(ws + (smp ? WS_FT_S : WS_FT_P)); const float* FP = (const float*)(ws + (smp ? WS_FPART_S : WS_FPART_P));
                const bf16* UT = (const bf16*)(ws + (smp ? WS_UT_S : WS_UT_P));
                LAS float* Gs = (LAS float*)lds;
                LAS float* Us = (LAS float*)(lds + 40960);
                LAS float* red = (LAS float*)(lds + 40960 + 65536);
                const float* hf = FT + (size_t)ch * L; const float* hb = FT + (size_t)(512 + ch) * L;
                for (int e = tid; e < 2 * L - 1; e += 512) { const int d = e - (L - 1); Gs[e + (e >> 4)] = d >= 0 ? hf[d] : hb[-d]; }
                for (int i = tid; i < nb * L; i += 512) { const int b = i / L, l = i % L; Us[i] = bf2f(UT[((size_t)b * 512 + ch) * L + l]); }
                { const int np = smp ? 64 : 4; float s = 0.f; if (tid < 2 * np) s = FP[(tid < np ? ch : 512 + ch) * np + (tid % np)];
                  s = wave_sum(s); if (lane == 0) red[wave] = s; }
                __syncthreads();
                const float inv_norm = 1.f / ((red[0] + red[1]) + (red[2] + red[3]));
                const int tps = L / 16;
                if (tid < nb * tps) {
                    const int b = tid / tps, t0 = (tid % tps) * 16;
                    float y[16];
#pragma unroll
                    for (int i = 0; i < 16; ++i) y[i] = 0.f;
                    const LAS float* ub = Us + b * L;
                    for (int s0 = 0; s0 < L; s0 += 16) {
                        const int base0 = t0 + L - 1 - s0;
                        float W[31];
#pragma unroll
                        for (int j = 0; j < 31; ++j) { const int e = base0 - 15 + j; W[j] = Gs[e + (e >> 4)]; }
#pragma unroll
                        for (int k = 0; k < 16; ++k) { const float uu = ub[s0 + k];
#pragma unroll
                            for (int i = 0; i < 16; ++i) y[i] += W[15 - k + i] * uu; }
                    }
                    const float skip = args.in[I_HFSKIP][ch];
                    const bf16* X0 = (const bf16*)(ws + WS_X0);
#pragma unroll
                    for (int i = 0; i < 16; ++i) { const size_t row = (size_t)tokbase + (size_t)b * L + t0 + i;
                        const float v = y[i] * inv_norm + skip * ub[t0 + i];
                        YM[row * DM + ch] = (bf16)f2bf(v * bf2f(X0[row * 512 + ch])); }
                }
                __syncthreads();
            }
        }
    }
    SEAM(5);

    if (IN(6)) {
        FRESH();
        asm volatile("; ==== PHASE 6 ====");
        pg8::Gemm g{HB, (const bf16*)(ws + WS_WOUT0_T), MT, DM, DM}; pg8::StaticOrder S; S.init(MT, DM, G, bx);
        EpiRes E{args.in[I_XP], args.in[I_XS], MODS + 2 * 1024, T};
        pg8::gemm_phase<EpiRes, pg8::StaticOrder, PG8_ALIGN, PG8_SP2>(lds, g, S, E, tid);
    }
    SEAM(6);

    if (IN(7)) {
        FRESH();
        asm volatile("; ==== PHASE 7 ====");
        for (int m = gw; m < MT; m += NGW) {
            const float* md = MODS + (size_t)req_of_row(m) * 6144;
            f32x4 v[4]; load_row(T + (size_t)m * DM, lane, v); ln_affine(v, args.in[I_LN1G0], args.in[I_LN1B0], lane); store_row(X + (size_t)m * DM, lane, v);
            adaln_store(v, md + 3 * 1024, md + 4 * 1024, HB + (size_t)m * DM, lane);
        }
    }
    SEAM(7);

    if (IN(8)) {
        FRESH();
        asm volatile("; ==== PHASE 8 ====");
        pg8::Gemm g{HB, (const bf16*)(ws + WS_W1_0), MT, FF, DM}; pg8::StaticOrder S; S.init(MT, FF, G, bx);
        EpiUp E{(bf16*)(ws + WS_HID)};
        pg8::gemm_phase<EpiUp, pg8::StaticOrder, PG8_ALIGN, PG8_SP2>(lds, g, S, E, tid);
    }
    SEAM(8);

    if (IN(9)) {
        FRESH();
        asm volatile("; ==== PHASE 9 ====");
        pg8::Gemm g{(const bf16*)(ws + WS_HID), (const bf16*)(ws + WS_W2_0), MT, DM, FF}; pg8::StaticOrder S; S.init(MT, DM, G, bx);
        EpiRes E{X, X + (size_t)NP * DM, MODS + 5 * 1024, T};
        pg8::gemm_phase<EpiRes, pg8::StaticOrder, PG8_ALIGN, PG8_SP2>(lds, g, S, E, tid);
    }
    SEAM(9);

    if (IN(10)) {
        FRESH();
        asm volatile("; ==== PHASE 10 ====");
        const float* MODS1 = MODS + 3 * 6144;
        for (int it = bx; it < MT / 32; it += G) {
            const int m0 = it * 32; const bool smp = m0 >= NP; const int L = smp ? LS : LP; const int l0 = smp ? (m0 - NP) % LS : m0 % LP; const int seq = smp ? (m0 - NP) / LS : m0 / LP;
            LAS bf16* ht = (LAS bf16*)lds;
            const float* md = MODS1 + (size_t)req_of_row(m0) * 6144;
            for (int rr = 0; rr < 4; ++rr) { const int i = wave * 4 + rr, m = m0 + i;
                f32x4 v[4]; load_row(T + (size_t)m * DM, lane, v); ln_affine(v, args.in[I_LN2G0], args.in[I_LN2B0], lane); store_row(X + (size_t)m * DM, lane, v);
                float mean, rstd; row_stats(v, mean, rstd);
#pragma unroll
                for (int j = 0; j < 4; ++j) { const int c = 4 * lane + 256 * j; const f32x4 sc = *(const f32x4*)(md + 1024 + c), sh = *(const f32x4*)(md + c);
                    const f32x4 h = (v[j] - mean) * rstd * (sc + 1.0f) + sh;
#pragma unroll
                    for (int e = 0; e < 4; ++e) ht[(c + e) * 40 + i] = (bf16)f2bf(h[e]); }
            }
            __syncthreads();
            bf16* HT = HB + (smp ? (size_t)NP * DM + (size_t)seq * DM * LS : (size_t)seq * DM * LP) + l0;
            for (int q = tid; q < 1024 * 4; q += 512) { const int c = q >> 2, part = q & 3; const v4u v = *(const LAS v4u*)(ht + c * 40 + part * 8); *(v4u*)(HT + (size_t)c * L + part * 8) = v; }
            __syncthreads();
        }
        for (size_t i = gt; i < (size_t)LS * LS / 8; i += NGT) {
            const int rho = (int)(i >> 9), l8 = (int)(i & 511) * 8; const int k = rho > 2048 ? rho - 2048 : rho; unsigned w[4];
#pragma unroll
            for (int e = 0; e < 8; e += 2) { const float r0 = (float)((k * (l8 + e)) & 4095) * (1.f / 4096.f), r1 = (float)((k * (l8 + e + 1)) & 4095) * (1.f / 4096.f);
                const float a = (rho > 2048 ? __builtin_amdgcn_sinf(r0) : __builtin_amdgcn_cosf(r0)) * 0.015625f, b = (rho > 2048 ? __builtin_amdgcn_sinf(r1) : __builtin_amdgcn_cosf(r1)) * 0.015625f;
                w[e >> 1] = pk2(a, b); }
            ((v4u*)(ws + WS_D4096))[i] = (v4u){w[0], w[1], w[2], w[3]};
        }
    }
    SEAM(10);

    if (IN(11)) {
        FRESH();
        asm volatile("; ==== PHASE 11 ====");
        { pg8::Gemm g{(const bf16*)(ws + WS_D4096), HB + (size_t)NP * DM, LS, BS * DM, LS}; pg8::StaticOrder S; S.init(LS, BS * DM, G, bx);
          EpiDft E{(bf16*)(ws + WS_UV), LS, NP};
          pg8::gemm_phase<EpiDft, pg8::StaticOrder, PG8_ALIGN, PG8_SP2>(lds, g, S, E, tid); }
        { int bx2 = (bx + 128) % G; asm volatile("" : "+s"(bx2)); const int lane2 = fresh_lane(); const int tid = wave * 64 + lane2;
          pg8::Gemm g{(const bf16*)(ws + WS_D256), HB, LP, BP * DM, LP}; pg8::StaticOrder S; S.init(LP, BP * DM, G, bx2);
          EpiDft E{(bf16*)(ws + WS_UV), LP, 0};
          pg8::gemm_phase<EpiDft, pg8::StaticOrder, PG8_ALIGN, PG8_SP2>(lds, g, S, E, tid); }
    }
    SEAM(11);

    if (IN(12)) {
        FRESH();
        asm volatile("; ==== PHASE 12 ====");
        pg8::Gemm g{(const bf16*)(ws + WS_UV), (const bf16*)(ws + WS_WFOLD_T), MT, DM, 2048}; pg8::StaticOrder S; S.init(MT, DM, G, bx);
        EpiRes E{X, X + (size_t)NP * DM, MODS + 3 * 6144 + 2 * 1024, T};
        pg8::gemm_phase<EpiRes, pg8::StaticOrder, PG8_ALIGN, PG8_SP2>(lds, g, S, E, tid);
    }
    SEAM(12);

    if (IN(13)) {
        FRESH();
        asm volatile("; ==== PHASE 13 ====");
        for (int m = gw; m < MT; m += NGW) {
            const float* md = MODS + 3 * 6144 + (size_t)req_of_row(m) * 6144;
            f32x4 v[4]; load_row(T + (size_t)m * DM, lane, v); ln_affine(v, args.in[I_LN1G1], args.in[I_LN1B1], lane); store_row(X + (size_t)m * DM, lane, v);
            adaln_store(v, md + 3 * 1024, md + 4 * 1024, HB + (size_t)m * DM, lane);
        }
    }
    SEAM(13);

    if (IN(14)) {
        FRESH();
        asm volatile("; ==== PHASE 14 ====");
        pg8::Gemm g{HB, (const bf16*)(ws + WS_W1_1), MT, FF, DM}; pg8::StaticOrder S; S.init(MT, FF, G, bx);
        EpiUp E{(bf16*)(ws + WS_HID)};
        pg8::gemm_phase<EpiUp, pg8::StaticOrder, PG8_ALIGN, PG8_SP2>(lds, g, S, E, tid);
    }
    SEAM(14);

    if (IN(15)) {
        FRESH();
        asm volatile("; ==== PHASE 15 ====");
        pg8::Gemm g{(const bf16*)(ws + WS_HID), (const bf16*)(ws + WS_W2_1), MT, DM, FF}; pg8::StaticOrder S; S.init(MT, DM, G, bx);
        EpiRes E{X, X + (size_t)NP * DM, MODS + 3 * 6144 + 5 * 1024, T};
        pg8::gemm_phase<EpiRes, pg8::StaticOrder, PG8_ALIGN, PG8_SP2>(lds, g, S, E, tid);
    }
    SEAM(15);

    if (IN(16)) {
        FRESH();
        asm volatile("; ==== PHASE 16 ====");
        for (int m = gw; m < MT; m += NGW) {
            f32x4 v[4]; load_row(T + (size_t)m * DM, lane, v); ln_affine(v, args.in[I_LN2G1], args.in[I_LN2B1], lane); store_row(X + (size_t)m * DM, lane, v);
        }
    }
#undef IN
#undef SEAM
}

extern "C" void kernel_launch(void* const* d_in, const int* in_sizes, int n_in, void* d_out, int out_size, void* d_ws, size_t ws_size, hipStream_t stream) {
    static int grid = 0;
    if (grid == 0) {
        if (n_in != 38 || ws_size < WS_END) { fprintf(stderr, "kernel_launch: expected 38 inputs and >= %zu bytes of workspace; got %d, %zu\n", (size_t)WS_END, n_in, ws_size); grid = -1; return; }
        int dev = 0, cus = 0;
        if (hipGetDevice(&dev) != hipSuccess || hipDeviceGetAttribute(&cus, hipDeviceAttributeMultiprocessorCount, dev) != hipSuccess) { grid = -1; return; }
        if (hipFuncSetAttribute((const void*)fwd_kernel, hipFuncAttributeMaxDynamicSharedMemorySize, LDS_BYTES) != hipSuccess) { fprintf(stderr, "kernel_launch: hipFuncSetAttribute failed\n"); grid = -1; return; }
        int per_cu = 0;
        if (hipOccupancyMaxActiveBlocksPerMultiprocessor(&per_cu, (const void*)fwd_kernel, 512, LDS_BYTES) != hipSuccess || per_cu < 1) fprintf(stderr, "kernel_launch: occupancy query reports %d\n", per_cu);
        (void)hipGetLastError();
        grid = cus;
    }
    if (grid < 0) return;
    (void)hipMemsetAsync((char*)d_ws + WS_CTL, 0, CTL_ZERO_BYTES, stream);
    Args a{};
    for (int i = 0; i < 38; ++i) a.in[i] = (const float*)d_in[i];
    a.out = (float*)d_out; a.ws = (unsigned char*)d_ws;
#if MK_PER_PHASE
    for (int p = 0; p < NPHASE; ++p) { a.ph_lo = p; a.ph_hi = p + 1; a.li = 0; hipLaunchKernelGGL(fwd_kernel, dim3(grid), dim3(512), LDS_BYTES, stream, a); }
#elif defined(PROBE_A)
    a.ph_lo = 0; a.ph_hi = PROBE_B; a.li = 0; hipLaunchKernelGGL(fwd_kernel, dim3(grid), dim3(512), LDS_BYTES, stream, a);
    a.ph_lo = PROBE_A; a.ph_hi = NPHASE; a.li = 1; hipLaunchKernelGGL(fwd_kernel, dim3(grid), dim3(512), LDS_BYTES, stream, a);
#else
    a.ph_lo = 0; a.ph_hi = NPHASE; a.li = 0;
    hipLaunchKernelGGL(fwd_kernel, dim3(grid), dim3(512), LDS_BYTES, stream, a);
#endif
    const hipError_t le = hipPeekAtLastError();
    if (le != hipSuccess) fprintf(stderr, "kernel_launch: launch failed: %s\n", hipGetErrorName(le));
}
```

```cpp
#include <hip/hip_runtime.h>
#include <hip/hip_bf16.h>
#include <cstdio>
#include <cstdint>
#include <cmath>
namespace pg8 {
#define PG8_LAS __attribute__((address_space(3)))
typedef unsigned short bf16_t;
typedef short bf16x8 __attribute__((ext_vector_type(8)));
typedef float f32x4 __attribute__((ext_vector_type(4)));
typedef unsigned u32x4 __attribute__((ext_vector_type(4)));
constexpr int BM = 256, BK = 64, HALF = 128, HTB = HALF * BK * 2  , STAGE_BYTES = 8 * HTB, NXCD = 8, WGM = 8;

__host__ __device__ __forceinline__ int lds_byte(int r, int c) { const int st = (r >> 4) * 2 + (c >> 5), rr = r & 15, cc = c & 31, ob = rr * 64 + cc * 2; return st * 1024 + (ob ^ (((ob >> 9) & 1) << 5)); }
__host__ __device__ __forceinline__ void stage_rc(int b, int& R, int& C) { const int st = b / 1024, sb = b % 1024, swz = sb ^ (((sb >> 9) & 1) << 5); R = (st >> 1) * 16 + swz / 64; C = (st & 1) * 32 + (swz % 64) / 2; }
__host__ __device__ __forceinline__ int perm32(int rho) { const int n = rho >> 4, i = rho & 15; return 8 * (i >> 2) + 4 * n + (i & 3); }

struct Unit { int pm, pn; };
struct Gemm { const bf16_t* A; const bf16_t* Bt; int M, N, K; };

struct StaticOrder {
    int nM, nN, nwg, G, c;
    __host__ __device__ void init(int M, int N, int G_, int c_) { nM = M / BM; nN = N / BM; nwg = nM * nN; G = G_; c = c_; }
    __host__ __device__ bool next(int i, Unit& u) const {
        const long L = (long)i * G + c; if (L >= nwg) return false;
        int wgid = (int)L; { const int q = nwg / NXCD, r = nwg % NXCD, xcd = wgid % NXCD, off = wgid / NXCD; wgid = (xcd < r ? xcd * (q + 1) : r * (q + 1) + (xcd - r) * q) + off; }
        const int nig = WGM * nN, gid = wgid / nig, fm = gid * WGM, gsz = (nM - fm) < WGM ? (nM - fm) : WGM;
        u.pm = fm + ((wgid % nig) % gsz); u.pn = (wgid % nig) / gsz; return true;
    }
    __device__ __forceinline__ void a_ready(const Unit&) const {}
    __device__ __forceinline__ void done(const Unit&) const {}
};

__device__ __forceinline__ unsigned cvt_pk_bf16(float lo, float hi) { unsigned r; asm volatile("v_cvt_pk_bf16_f32 %0, %1, %2" : "=v"(r) : "v"(lo), "v"(hi)); return r; }
template <class Epi, class Sched, bool ALIGN_EPI = false, bool SP2 = false>
__device__ __forceinline__ void gemm_phase(PG8_LAS unsigned char* lds, const Gemm g, const Sched& S, const Epi& E, const int tid) {
    const int wid = __builtin_amdgcn_readfirstlane(tid >> 6), lane = tid & 63, wr = wid >> 2, wc = wid & 3, fr = lane & 15, fq = lane >> 4;
    const int K = g.K, nt = K / BK;
    unsigned voffA[2], voffB[2];
#pragma unroll
    for (int i = 0; i < 2; ++i) { int R, C; stage_rc(tid * 16 + i * 8192, R, C); const int Rb = Epi::PERM ? ((R & ~31) + perm32(R & 31)) : R;
        voffA[i] = (unsigned)(R * K + C) * 2u; voffB[i] = (unsigned)(Rb * K + C) * 2u; }
    const size_t kstep = (size_t)(BK * 2);
    const size_t hstep = (size_t)HALF * K * 2;
    const size_t tstep = 2 * hstep;
    const unsigned ldsw = (unsigned)wid * 1024u;
    const int aoff = lds_byte(wr * 64 + fr, fq * 8), boff = lds_byte(wc * 32 + fr, fq * 8);
#define PG8_SA(b, h) (((b) * 2 + (h)) * HTB)
#define PG8_SB(b, h) ((4 + (b) * 2 + (h)) * HTB)
#define PG8_STAGE(bufoff, gbase, voff) do { _Pragma("unroll") for (int _i = 0; _i < 2; ++_i) \
        __builtin_amdgcn_global_load_lds((const unsigned*)((const char*)(gbase) + (voff)[_i]), (PG8_LAS unsigned*)(lds + (bufoff) + ldsw + _i * 8192), 16, 0, 0); } while (0)
#define PG8_LDA(dst, b, h) do { _Pragma("unroll") for (int m = 0; m < 4; ++m) _Pragma("unroll") for (int k = 0; k < 2; ++k) dst[m][k] = *(const PG8_LAS bf16x8*)(lds + PG8_SA(b, h) + aoff + m * 2048 + k * 1024); } while (0)
#define PG8_LDB(dst, b, h) do { _Pragma("unroll") for (int n = 0; n < 2; ++n) _Pragma("unroll") for (int k = 0; k < 2; ++k) dst[n][k] = *(const PG8_LAS bf16x8*)(lds + PG8_SB(b, h) + boff + n * 2048 + k * 1024); } while (0)
#define PG8_MMA(ai, bj, At, Bt) do { __builtin_amdgcn_s_setprio(1); _Pragma("unroll") for (int m = 0; m < 4; ++m) _Pragma("unroll") for (int n = 0; n < 2; ++n) _Pragma("unroll") for (int k = 0; k < 2; ++k) \
        acc[ai][bj][m][n] = __builtin_amdgcn_mfma_f32_16x16x32_bf16(Bt[n][k], At[m][k], acc[ai][bj][m][n], 0, 0, 0); __builtin_amdgcn_s_setprio(0); } while (0)
#define PG8_WAIT_V(n) asm volatile("s_waitcnt vmcnt(" #n ")" ::: "memory")
#define PG8_WAIT_L(n) asm volatile("s_waitcnt lgkmcnt(" #n ")" ::: "memory")
#define PG8_BAR __builtin_amdgcn_s_barrier()
#define PG8_SCHED __builtin_amdgcn_sched_barrier(0)
    Unit cur, nxt; int ui = 0;
    if (!S.next(0, cur)) return;
    f32x4 acc[2][2][4][2];
#pragma unroll
    for (int a = 0; a < 2; ++a)
#pragma unroll
        for (int b = 0; b < 2; ++b)
#pragma unroll
            for (int m = 0; m < 4; ++m)
#pragma unroll
                for (int n = 0; n < 2; ++n) acc[a][b][m][n] = (f32x4){0.f, 0.f, 0.f, 0.f};
    bf16x8 At[4][2], B0[2][2], B1[2][2];
    const char* cA = (const char*)g.A + (size_t)cur.pm * tstep; const char* cB = (const char*)g.Bt + (size_t)cur.pn * tstep;
    S.a_ready(cur);
    if constexpr (SP2) {
        PG8_STAGE(PG8_SB(0, 0), cB, voffB); PG8_STAGE(PG8_SB(0, 1), cB + hstep, voffB); PG8_STAGE(PG8_SA(0, 0), cA, voffA); PG8_STAGE(PG8_SA(0, 1), cA + hstep, voffA);
        if (wr == 1) PG8_BAR;
        PG8_WAIT_V(2); PG8_BAR;
        PG8_STAGE(PG8_SB(1, 0), cB + kstep, voffB); PG8_STAGE(PG8_SA(1, 0), cA + kstep, voffA); PG8_STAGE(PG8_SB(1, 1), cB + hstep + kstep, voffB);
        PG8_WAIT_V(6); PG8_BAR;
    } else {
        PG8_STAGE(PG8_SB(0, 0), cB, voffB); PG8_STAGE(PG8_SA(0, 0), cA, voffA); PG8_STAGE(PG8_SB(0, 1), cB + hstep, voffB); PG8_STAGE(PG8_SA(0, 1), cA + hstep, voffA);
        if (wr == 1) PG8_BAR;
        PG8_WAIT_V(4); PG8_BAR;
        PG8_STAGE(PG8_SB(1, 0), cB + kstep, voffB); PG8_STAGE(PG8_SA(1, 0), cA + kstep, voffA); PG8_STAGE(PG8_SB(1, 1), cB + hstep + kstep, voffB);
        PG8_WAIT_V(6); PG8_BAR;
    }
    for (;;) {
        const bool has_next = S.next(ui + 1, nxt);
        const char* nA = has_next ? (const char*)g.A + (size_t)nxt.pm * tstep : cA; const char* nB = has_next ? (const char*)g.Bt + (size_t)nxt.pn * tstep : cB;
        for (int t = 0; t < nt; t += 2) {
            const bool last = (t == nt - 2);
            const char* a1 = cA + (size_t)(t + 1) * kstep;
            const char* a2 = last ? nA : cA + (size_t)(t + 2) * kstep; const char* b2 = last ? nB : cB + (size_t)(t + 2) * kstep;
            const char* a3 = a2 + kstep; const char* b3 = b2 + kstep;
            if (last && has_next) S.a_ready(nxt);
            if constexpr (SP2) {
            PG8_LDB(B0, 0, 0); PG8_LDB(B1, 0, 1); PG8_SCHED; PG8_LDA(At, 0, 0); PG8_STAGE(PG8_SA(1, 1), a1 + hstep, voffA);
            PG8_WAIT_V(8); PG8_WAIT_L(0); PG8_BAR; PG8_MMA(0, 0, At, B0); PG8_MMA(0, 1, At, B1); PG8_BAR; PG8_SCHED;
            PG8_LDA(At, 0, 1); PG8_STAGE(PG8_SB(0, 0), b2, voffB); PG8_STAGE(PG8_SB(0, 1), b2 + hstep, voffB); PG8_STAGE(PG8_SA(0, 0), a2, voffA);
            PG8_WAIT_V(8); PG8_WAIT_L(0); PG8_BAR; PG8_MMA(1, 0, At, B0); PG8_MMA(1, 1, At, B1); PG8_BAR; PG8_SCHED;
            PG8_LDB(B0, 1, 0); PG8_LDB(B1, 1, 1); PG8_SCHED; PG8_LDA(At, 1, 0); PG8_STAGE(PG8_SA(0, 1), a2 + hstep, voffA);
            PG8_WAIT_V(8); PG8_WAIT_L(0); PG8_BAR; PG8_MMA(0, 0, At, B0); PG8_MMA(0, 1, At, B1); PG8_BAR; PG8_SCHED;
            PG8_LDA(At, 1, 1); PG8_STAGE(PG8_SB(1, 0), b3, voffB); PG8_STAGE(PG8_SB(1, 1), b3 + hstep, voffB); PG8_STAGE(PG8_SA(1, 0), a3, voffA);
            PG8_WAIT_V(8); PG8_WAIT_L(0); PG8_BAR; PG8_MMA(1, 0, At, B0); PG8_MMA(1, 1, At, B1); PG8_BAR; PG8_SCHED;
            } else {
            PG8_LDB(B0, 0, 0); PG8_SCHED; PG8_LDA(At, 0, 0); PG8_STAGE(PG8_SA(1, 1), a1 + hstep, voffA);
            PG8_WAIT_L(8); PG8_BAR; PG8_WAIT_L(0); PG8_MMA(0, 0, At, B0); PG8_BAR; PG8_SCHED;
            PG8_LDB(B1, 0, 1); PG8_STAGE(PG8_SB(0, 0), b2, voffB);
            PG8_BAR; PG8_WAIT_L(0); PG8_MMA(0, 1, At, B1); PG8_BAR;
            PG8_LDA(At, 0, 1); PG8_STAGE(PG8_SA(0, 0), a2, voffA);
            PG8_BAR; PG8_WAIT_L(0); PG8_MMA(1, 0, At, B0); PG8_BAR; PG8_SCHED;
            PG8_STAGE(PG8_SB(0, 1), b2 + hstep, voffB);
            PG8_WAIT_V(6); PG8_BAR; PG8_MMA(1, 1, At, B1); PG8_BAR;
            PG8_LDB(B0, 1, 0); PG8_SCHED; PG8_LDA(At, 1, 0); PG8_STAGE(PG8_SA(0, 1), a2 + hstep, voffA);
            PG8_WAIT_L(8); PG8_BAR; PG8_WAIT_L(0); PG8_MMA(0, 0, At, B0); PG8_BAR; PG8_SCHED;
            PG8_LDB(B1, 1, 1); PG8_STAGE(PG8_SB(1, 0), b3, voffB);
            PG8_BAR; PG8_WAIT_L(0); PG8_MMA(0, 1, At, B1); PG8_BAR;
            PG8_LDA(At, 1, 1); PG8_STAGE(PG8_SA(1, 0), a3, voffA);
            PG8_BAR; PG8_WAIT_L(0); PG8_MMA(1, 0, At, B0); PG8_BAR; PG8_SCHED;
            PG8_STAGE(PG8_SB(1, 1), b3 + hstep, voffB);
            PG8_WAIT_V(6); PG8_BAR; PG8_MMA(1, 1, At, B1); PG8_BAR;
            }
        }
        if constexpr (ALIGN_EPI) { if (wr == 0) PG8_BAR; }
        if constexpr (!Epi::AFTER_DRAIN) { E(acc, cur, wr, wc, fr, fq); S.done(cur); }
        if (!has_next) break;
#pragma unroll
        for (int a = 0; a < 2; ++a)
#pragma unroll
            for (int b = 0; b < 2; ++b)
#pragma unroll
                for (int m = 0; m < 4; ++m)
#pragma unroll
                    for (int n = 0; n < 2; ++n) acc[a][b][m][n] = (f32x4){0.f, 0.f, 0.f, 0.f};
        cur = nxt; cA = nA; cB = nB; ++ui;
        if constexpr (ALIGN_EPI) { if (wr == 1) PG8_BAR; }
    }
    PG8_WAIT_V(0);
    if constexpr (!ALIGN_EPI) { if (wr == 0) PG8_BAR; }
    PG8_BAR;
    if constexpr (Epi::AFTER_DRAIN) { E.fused(acc, cur, wr, wc, fr, fq, lds, wid, lane); S.done(cur); }
#undef PG8_SA
#undef PG8_SB
#undef PG8_STAGE
#undef PG8_LDA
#undef PG8_LDB
#undef PG8_MMA
#undef PG8_WAIT_V
#undef PG8_WAIT_L
#undef PG8_BAR
#undef PG8_SCHED
}
}
#ifndef PG8_SP2
#define PG8_SP2 true
#endif
#ifndef PG8_ALIGN
#define PG8_ALIGN true
#endif
#ifndef MK_PER_PHASE
#define MK_PER_PHASE 0
#endif

constexpr int DM = 1024, FF = 4096;
constexpr int LP = 256, BP = 16, LS = 4096, BS = 2, PAST = 256;
constexpr int NP = BP * LP;
constexpr int NSR = BS * LS;
constexpr int MT = NP + NSR;
constexpr int MKV = MT + BS * PAST;
constexpr int LKS = LS + PAST;
constexpr int HY = 512, NH = 4, DQK = 192, DNOPE = 128, DROPE = 64, DVH = 128, QL = 256, KVL = 128;
constexpr int WINP = 2048;
constexpr float LN_EPS = 1e-5f, RMS_EPS = 1e-6f, ALPHA = 1.41421356237309515f;
constexpr int NPHASE = 17;

constexpr int att_shm_bytes = 2 * 16384 + 2 * 24576 + 2048 + 8 * 8 * 1024;
constexpr size_t MiB = 1u << 20, KiB = 1024;
constexpr size_t WS_CTL = 0, CTL_ZERO_BYTES = 1 * MiB;
constexpr size_t WS_MODS = 1 * MiB;
constexpr size_t WS_D256 = 1 * MiB + 256 * KiB;
constexpr size_t WS_H2 = 1 * MiB + 512 * KiB;
constexpr size_t WS_FPART_S = 3 * MiB;
constexpr size_t WS_FPART_P = 3 * MiB + 256 * KiB;
constexpr size_t WS_WIN_T = 4 * MiB, WS_QUP_T = 8 * MiB, WS_KVUP_T = 8 * MiB + 512 * KiB, WS_WOUT0_T = 9 * MiB;
constexpr size_t WS_W1_0 = 11 * MiB, WS_W2_0 = 19 * MiB, WS_W1_1 = 27 * MiB, WS_W2_1 = 35 * MiB, WS_WFOLD_T = 43 * MiB;
constexpr size_t WS_T = 48 * MiB;
constexpr size_t WS_FT_S = 48 * MiB, WS_FT_P = 64 * MiB, WS_UT_S = 65 * MiB, WS_UT_P = 73 * MiB;
constexpr size_t WS_W1T = 80 * MiB, WS_CBD = 82 * MiB;
constexpr size_t WS_D4096 = 96 * MiB;
constexpr size_t WS_KF_S = 96 * MiB, WS_KF_P = 109 * MiB, WS_V_S = 115 * MiB, WS_V_P = 124 * MiB;
constexpr size_t WS_H = 128 * MiB;
constexpr size_t WS_P = 152 * MiB, WS_ZS = 188 * MiB, WS_QN = 212 * MiB, WS_KVN = 218 * MiB, WS_Q = 225 * MiB, WS_X0 = 243 * MiB;
constexpr size_t WS_HID = 152 * MiB, WS_UV = 152 * MiB;
constexpr size_t WS_END = 256 * MiB;
constexpr int CW_TMO = 0, CW_Q = 64, CW_BAR = 4096, CW_ATT = 16384;
constexpr size_t WS_APART = 152 * MiB; constexpr int APART_F = 8 * 4 * 16 * 64 + 8 * 128;

constexpr int RING_BYTES = 131072, LDSCTL_OFF = 160 * 1024 - 512, MISC_OFF = LDSCTL_OFF + 320, LDS_BYTES = 160 * 1024;
static_assert(att_shm_bytes <= LDSCTL_OFF, "attention scratch fits below the LDS control words");

#define GAS __attribute__((address_space(1)))
#define LAS __attribute__((address_space(3)))
typedef unsigned short bf16;
typedef unsigned v4u __attribute__((ext_vector_type(4)));
typedef unsigned v2u __attribute__((ext_vector_type(2)));
typedef float f32x4 __attribute__((ext_vector_type(4)));
typedef GAS unsigned gu32;
#define RLX_AGENT __ATOMIC_RELAXED, __HIP_MEMORY_SCOPE_AGENT
#define LDS_WAIT() asm volatile("s_waitcnt lgkmcnt(0)" ::: "memory")
__device__ __forceinline__ unsigned f2bf(float f) { unsigned u = __builtin_bit_cast(unsigned, f); return (u + 0x7fffu + ((u >> 16) & 1u)) >> 16; }
__device__ __forceinline__ unsigned pk2(float lo, float hi) { return f2bf(lo) | (f2bf(hi) << 16); }
__device__ __forceinline__ float bf2f(unsigned short b) { return __builtin_bit_cast(float, (unsigned)b << 16); }
__device__ __forceinline__ float wave_sum(float v) {
#pragma unroll
    for (int o = 1; o < 64; o <<= 1) v += __shfl_xor(v, o);
    return v;
}
__device__ __forceinline__ float fsin_rev(float rev) { return __builtin_amdgcn_sinf(__builtin_amdgcn_fractf(rev)); }
__device__ __forceinline__ float fcos_rev(float rev) { return __builtin_amdgcn_cosf(__builtin_amdgcn_fractf(rev)); }
constexpr float INV_2PI = 0.15915494309189535f;
__device__ __forceinline__ float fexp(float x) { return __builtin_amdgcn_exp2f(x * 1.4426950408889634f); }

__device__ __forceinline__ int fresh_lane() { int l; asm volatile("v_mbcnt_lo_u32_b32 %0, -1, 0\n\tv_mbcnt_hi_u32_b32 %0, -1, %0" : "=v"(l)); return l; }
#define XB_TMO      128
#define XB_XCNT(j)  (256  + 64 * (j))
#define XB_XSUB(j)  (1280 + 64 * (j))
#define XB_XGEN(j)  (2304 + 64 * (j))
#define XB_TOP      3328
#define XB_TOPGEN   3392
#define XCD_BAR_WORDS 3456
#define XB_SPIN_CAP (1u << 23)
__device__ __forceinline__ unsigned xb_ld(unsigned* p)              { return __hip_atomic_load(p, __ATOMIC_RELAXED, __HIP_MEMORY_SCOPE_AGENT); }
__device__ __forceinline__ unsigned xb_add(unsigned* p, unsigned v) { return __hip_atomic_fetch_add(p, v, __ATOMIC_RELAXED, __HIP_MEMORY_SCOPE_AGENT); }
__device__ __forceinline__ unsigned xb_xcc_id() { return (unsigned)__builtin_amdgcn_s_getreg((3 << 11) | 20) & 0xFu; }
#define XB_SPIN(cond, bar) do { unsigned _sp = 0; while (cond) { __builtin_amdgcn_s_sleep(1); \
    if ((++_sp & 255u) == 0u) { if (xb_ld(&(bar)[XB_TMO])) break; if (_sp > XB_SPIN_CAP) { atomicAdd(&(bar)[XB_TMO], 1u); break; } } } } while (0)
struct XcdBarrier { unsigned* bar; unsigned x; volatile LAS unsigned* st; };
__device__ __forceinline__ XcdBarrier xcd_barrier_post(unsigned* bar, volatile LAS unsigned* st) {
    XcdBarrier b; b.bar = bar; b.x = xb_xcc_id(); b.st = st;
    if (threadIdx.x == 0) (void)xb_add(&bar[XB_XCNT(b.x)], 1u);
    return b;
}
__device__ __forceinline__ void xcd_barrier_complete(unsigned* bar, unsigned x, unsigned& nloc, unsigned& nx) {
    const unsigned G = gridDim.x * gridDim.y * gridDim.z;
    unsigned sum, cnt, mine, sp = 0u;
    for (;;) {
        sum = 0u; cnt = 0u; mine = 0u;
#pragma unroll
        for (unsigned j = 0; j < 16; ++j) { const unsigned c = xb_ld(&bar[XB_XCNT(j)]); sum += c; cnt += (c > 0u) ? 1u : 0u; mine = (j == x) ? c : mine; }
        if (sum == G) break;
        __builtin_amdgcn_s_sleep(1);
        if ((++sp & 255u) == 0u) { if (xb_ld(&bar[XB_TMO])) break; if (sp > XB_SPIN_CAP) { atomicAdd(&bar[XB_TMO], 1u); break; } }
    }
    nloc = mine > 0u ? mine : 1u; nx = cnt > 0u ? cnt : 1u;
}
__device__ __forceinline__ void xcd_barrier(const XcdBarrier& b) {
    asm volatile("s_waitcnt vmcnt(0)" ::: "memory");
    __syncthreads();
    if (threadIdx.x == 0) {
        unsigned* bar = b.bar;
        __builtin_amdgcn_s_waitcnt(0);
        unsigned nloc = b.st[0], nx = b.st[1];
        if (nloc == 0u) { xcd_barrier_complete(bar, b.x, nloc, nx); b.st[0] = nloc; b.st[1] = nx; }
        const unsigned old = xb_add(&bar[XB_XSUB(b.x)], 1u);
        const unsigned gen = old / nloc;
        if (old + 1u == (gen + 1u) * nloc) {
            __builtin_amdgcn_fence(__ATOMIC_RELEASE, "agent");
            asm volatile("s_waitcnt vmcnt(0)" ::: "memory");
            const unsigned og = xb_add(&bar[XB_TOP], 1u);
            const unsigned tg = og / nx;
            if (og + 1u == (tg + 1u) * nx) xb_add(&bar[XB_TOPGEN], 1u);
            else XB_SPIN(xb_ld(&bar[XB_TOPGEN]) == tg, bar);
            __builtin_amdgcn_fence(__ATOMIC_ACQUIRE, "agent");
            xb_add(&bar[XB_XGEN(b.x)], 1u);
            asm volatile("s_waitcnt vmcnt(0)" ::: "memory");
        } else {
            XB_SPIN(xb_ld(&bar[XB_XGEN(b.x)]) == gen, bar);
            __builtin_amdgcn_fence(__ATOMIC_ACQUIRE, "agent");
            asm volatile("s_waitcnt vmcnt(0)" ::: "memory");
        }
    }
    __syncthreads();
}

struct Args { const float* in[38]; float* out; unsigned char* ws; int ph_lo, ph_hi, li, pad; };
enum { I_XP = 0, I_XS, I_CKV, I_CKR, I_C, I_CCTX, I_ADA0_W, I_ADA0_B, I_WIN, I_CONVW, I_CONVB, I_HFW1, I_HFB1, I_HFFREQ, I_HFW2, I_HFB2, I_HFW3, I_HFSKIP,
       I_QNORM, I_QUP, I_KVNORM, I_KVUP, I_WOUT0, I_LN1G0, I_LN1B0, I_W1_0, I_W2_0, I_LN2G0, I_LN2B0, I_ADA1_W, I_ADA1_B, I_WOUT1, I_LN1G1, I_LN1B1, I_W1_1, I_W2_1, I_LN2G1, I_LN2B1 };
constexpr size_t OUT_CKV = (size_t)MT * DM, OUT_CKR = OUT_CKV + (size_t)NP * KVL;

__device__ __forceinline__ int req_of_row(int m) { return m < NP ? 0 : 1 + (m - NP) / LS; }

using pg8::f32x4; using pg8::Unit; using pg8::BM; using pg8::HALF; using pg8::cvt_pk_bf16;
typedef unsigned u32x4 __attribute__((ext_vector_type(4)));
__device__ __forceinline__ u32x4 pack8(const f32x4& a, const f32x4& b) { u32x4 w; w.x = cvt_pk_bf16(a[0], a[1]); w.y = cvt_pk_bf16(a[2], a[3]); w.z = cvt_pk_bf16(b[0], b[1]); w.w = cvt_pk_bf16(b[2], b[3]); return w; }

struct EpiWin {
    static constexpr bool PERM = true, AFTER_DRAIN = false;
    bf16* P; float* ZS;
    __device__ __forceinline__ void operator()(const f32x4 (&acc)[2][2][4][2], const Unit& u, int wr, int wc, int fr, int fq) const {
        const int row0 = u.pm * BM + wr * 64 + fr, colt = u.pn * BM + wc * 32 + 8 * fq;
#pragma unroll
        for (int ai = 0; ai < 2; ++ai)
#pragma unroll
            for (int m = 0; m < 4; ++m) { const int row = row0 + ai * HALF + m * 16;
#pragma unroll
                for (int bj = 0; bj < 2; ++bj) { const int col = colt + bj * HALF;
                    if (u.pn < 6) *(u32x4*)(P + (size_t)row * 1536 + col) = pack8(acc[ai][bj][m][0], acc[ai][bj][m][1]);
                    else { float* d = ZS + (size_t)row * 512 + (col - 1536); *(f32x4*)d = acc[ai][bj][m][0]; *(f32x4*)(d + 4) = acc[ai][bj][m][1]; } } }
    }
};
struct EpiStore {
    static constexpr bool PERM = true, AFTER_DRAIN = false;
    bf16* O; int ld;
    __device__ __forceinline__ void operator()(const f32x4 (&acc)[2][2][4][2], const Unit& u, int wr, int wc, int fr, int fq) const {
        const int row0 = u.pm * BM + wr * 64 + fr, colt = u.pn * BM + wc * 32 + 8 * fq;
#pragma unroll
        for (int ai = 0; ai < 2; ++ai)
#pragma unroll
            for (int m = 0; m < 4; ++m) { const int row = row0 + ai * HALF + m * 16;
#pragma unroll
                for (int bj = 0; bj < 2; ++bj) *(u32x4*)(O + (size_t)row * ld + colt + bj * HALF) = pack8(acc[ai][bj][m][0], acc[ai][bj][m][1]); }
    }
};
struct EpiKV {
    static constexpr bool PERM = true, AFTER_DRAIN = false;
    bf16 *KFs, *KFp, *Vs, *Vp;
    __device__ __forceinline__ void operator()(const f32x4 (&acc)[2][2][4][2], const Unit& u, int wr, int wc, int fr, int fq) const {
        const int m0 = u.pm * BM; bf16* kf; bf16* vv; int lk, key0, b;
        if (m0 < NP) { b = m0 / LP; key0 = 0; lk = LP; kf = KFp; vv = Vp; }
        else if (m0 < MT) { b = (m0 - NP) / LS; key0 = (m0 - NP) % LS; lk = LKS; kf = KFs; vv = Vs; }
        else { b = (m0 - MT) / PAST; key0 = LS + (m0 - MT) % PAST; lk = LKS; kf = KFs; vv = Vs; }
        const int h = u.pn;
        int rloc = wr * 64 + fr, c8 = wc * 32 + 8 * fq; asm volatile("" : "+v"(rloc), "+v"(c8));
#pragma unroll
        for (int ai = 0; ai < 2; ++ai)
#pragma unroll
            for (int m = 0; m < 4; ++m) { const int key = key0 + rloc + ai * HALF + m * 16; const size_t kr = (size_t)(b * NH + h) * lk + key;
                *(u32x4*)(kf + kr * DQK + c8) = pack8(acc[ai][0][m][0], acc[ai][0][m][1]);
                *(u32x4*)(vv + kr * DVH + c8) = pack8(acc[ai][1][m][0], acc[ai][1][m][1]); }
    }
};
struct EpiRes {
    static constexpr bool PERM = false, AFTER_DRAIN = false;
    const float* xp; const float* xs; const float* gate;
    float* T;
    __device__ __forceinline__ void operator()(const f32x4 (&acc)[2][2][4][2], const Unit& u, int wr, int wc, int fr, int fq) const {
        const int m0 = u.pm * BM, row0 = m0 + wr * 64 + fr, col0 = u.pn * BM + wc * 32 + 4 * fq;
        const float* g = gate + (size_t)req_of_row(m0) * 6144;
        f32x4 gv[2][2];
#pragma unroll
        for (int bj = 0; bj < 2; ++bj)
#pragma unroll
            for (int n = 0; n < 2; ++n) gv[bj][n] = *(const f32x4*)(g + col0 + bj * HALF + n * 16);
#pragma unroll
        for (int ai = 0; ai < 2; ++ai)
#pragma unroll
            for (int m = 0; m < 4; ++m) { const int row = row0 + ai * HALF + m * 16;
                const float* xr = (row < NP) ? xp + (size_t)row * DM : xs + (size_t)(row - NP) * DM;
#pragma unroll
                for (int bj = 0; bj < 2; ++bj)
#pragma unroll
                    for (int n = 0; n < 2; ++n) { const int col = col0 + bj * HALF + n * 16; const f32x4 xv = *(const f32x4*)(xr + col);
                        *(f32x4*)(T + (size_t)row * DM + col) = xv * ALPHA + gv[bj][n] * acc[ai][bj][m][n]; } }
    }
};
struct EpiUp {
    static constexpr bool PERM = true, AFTER_DRAIN = false;
    bf16* H;
    __device__ __forceinline__ void operator()(const f32x4 (&acc)[2][2][4][2], const Unit& u, int wr, int wc, int fr, int fq) const {
        const int row0 = u.pm * BM + wr * 64 + fr, colt = u.pn * BM + wc * 32 + 8 * fq;
#pragma unroll
        for (int ai = 0; ai < 2; ++ai)
#pragma unroll
            for (int m = 0; m < 4; ++m) { const int row = row0 + ai * HALF + m * 16;
#pragma unroll
                for (int bj = 0; bj < 2; ++bj) { f32x4 a = acc[ai][bj][m][0], b = acc[ai][bj][m][1];
#pragma unroll
                    for (int e = 0; e < 4; ++e) { const float x = fmaxf(a[e], 0.f), y = fmaxf(b[e], 0.f); a[e] = x * x; b[e] = y * y; }
                    *(u32x4*)(H + (size_t)row * FF + colt + bj * HALF) = pack8(a, b); } }
    }
};
struct EpiDft {
    static constexpr bool PERM = true, AFTER_DRAIN = false;
    bf16* UV; int L, tokbase;
    __device__ __forceinline__ void operator()(const f32x4 (&acc)[2][2][4][2], const Unit& u, int wr, int wc, int fr, int fq) const {
        const int rho0 = u.pm * BM + wr * 64 + fr, n0 = u.pn * BM + wc * 32 + 8 * fq, hl = L >> 1;
#pragma unroll
        for (int ai = 0; ai < 2; ++ai)
#pragma unroll
            for (int m = 0; m < 4; ++m) { const int rho = rho0 + ai * HALF + m * 16; const int part = rho > hl ? 1 : 0; const int k = part ? rho - hl : rho;
#pragma unroll
                for (int bj = 0; bj < 2; ++bj) { const int n = n0 + bj * HALF, b = n >> 10, c = n & 1023;
                    const f32x4 a0 = acc[ai][bj][m][0], a1 = acc[ai][bj][m][1];
                    bf16* r1 = UV + (size_t)(tokbase + b * L + k) * 2048 + part * 1024 + c;
                    *(u32x4*)r1 = pack8(a0, a1);
                    if (k != 0 && k != hl) { bf16* r2 = UV + (size_t)(tokbase + b * L + (L - k)) * 2048 + part * 1024 + c;
                        *(u32x4*)r2 = part ? pack8(-a0, -a1) : pack8(a0, a1); }
                    else if (part == 0) *(u32x4*)(r1 + 1024) = (u32x4){0u, 0u, 0u, 0u}; } }
    }
};

namespace att {
using bf16x8 = __attribute__((ext_vector_type(8))) short;
using s16x4  = __attribute__((ext_vector_type(4))) short;
using f32x16 = __attribute__((ext_vector_type(16))) float;
constexpr int DK = 192, DV = 128, NW = 8, QBLK = 32, KVBLK = 64;
constexpr float SCALE = 0.07216878364870322f;
constexpr float THR = 8.f;
constexpr int SHM_V = KVBLK * DV * 2, SHM_K = KVBLK * DK * 2, SHM_QR = 2 * SHM_V + 2 * SHM_K + NW * 64 * 4, NQR = 4  , SHM_ATTN = SHM_QR + NW * (12 - NQR) * 1024;
#define KSWZ(row, colB) ((row) * 384 + ((colB) ^ (((row) & 7) << 4)))
#define SBAR() __builtin_amdgcn_sched_barrier(0)
__device__ __forceinline__ int crow(int r, int hi) { return (r & 3) + 8 * (r >> 2) + 4 * hi; }
__device__ __forceinline__ unsigned cvtpk(float lo, float hi) { unsigned r; asm volatile("v_cvt_pk_bf16_f32 %0, %1, %2" : "=v"(r) : "v"(lo), "v"(hi)); return r; }
__device__ __forceinline__ void partialSM(f32x16& p0, f32x16& p1, float& m_reg, float& mn, float& alpha) {
  constexpr float C = SCALE * 1.4426950408889634f;
  float pmax = p0[0];
#pragma unroll
  for (int r = 1; r < 16; ++r) pmax = fmaxf(pmax, p0[r]);
#pragma unroll
  for (int r = 0; r < 16; ++r) pmax = fmaxf(pmax, p1[r]);
  { auto rr = __builtin_amdgcn_permlane32_swap(__float_as_uint(pmax), __float_as_uint(pmax), false, false);
    pmax = fmaxf(__uint_as_float(rr[0]), __uint_as_float(rr[1])); }
  if (__builtin_expect(__all(pmax - m_reg <= THR / SCALE), 1)) { mn = m_reg; alpha = 1.f; }
  else { mn = fmaxf(m_reg, pmax); alpha = __builtin_amdgcn_exp2f((m_reg - mn) * C); m_reg = mn; }
  float mnC = -mn * C;
#pragma unroll
  for (int r = 0; r < 16; ++r) p0[r] = fmaf(p0[r], C, mnC);
#pragma unroll
  for (int r = 0; r < 16; ++r) p1[r] = fmaf(p1[r], C, mnC);
#pragma unroll
  for (int r = 0; r < 16; ++r) p0[r] = __builtin_amdgcn_exp2f(p0[r]);
}
__device__ __forceinline__ void finishSM(f32x16& p0, f32x16& p1, float alpha, float& l_reg, bf16x8& pa0, bf16x8& pa1, bf16x8& pa2, bf16x8& pa3) {
#pragma unroll
  for (int r = 0; r < 16; ++r) p1[r] = __builtin_amdgcn_exp2f(p1[r]);
  float ps = 0;
#pragma unroll
  for (int r = 0; r < 16; ++r) ps += p0[r];
#pragma unroll
  for (int r = 0; r < 16; ++r) ps += p1[r];
  { auto rr = __builtin_amdgcn_permlane32_swap(__float_as_uint(ps), __float_as_uint(ps), false, false);
    ps = __uint_as_float(rr[0]) + __uint_as_float(rr[1]); }
  l_reg = l_reg * alpha + ps;
#define PK4(P, BASE, OUT) do { unsigned a0 = cvtpk(P[BASE + 0], P[BASE + 1]), a1 = cvtpk(P[BASE + 2], P[BASE + 3]);   \
    unsigned b0 = cvtpk(P[BASE + 4], P[BASE + 5]), b1 = cvtpk(P[BASE + 6], P[BASE + 7]);                              \
    auto r0 = __builtin_amdgcn_permlane32_swap(a0, b0, false, false); auto r1 = __builtin_amdgcn_permlane32_swap(a1, b1, false, false); \
    u32x4 w = {r0[0], r1[0], r0[1], r1[1]}; OUT = __builtin_bit_cast(bf16x8, w); } while (0)
  PK4(p0, 0, pa0); PK4(p0, 8, pa1); PK4(p1, 0, pa2); PK4(p1, 8, pa3);
#undef PK4
}
__device__ __forceinline__ void qkt(f32x16& p0, f32x16& p1, const LAS char* Ks, const bf16x8* qr, const LAS char* qrl, int r32, int hi) {
  p0 = f32x16{}; p1 = f32x16{};
#pragma unroll
  for (int d0 = 0; d0 < 12; ++d0) { const int cb = (d0 * 16 + hi * 8) * 2;
    bf16x8 b0 = *reinterpret_cast<const LAS bf16x8*>(Ks + KSWZ(r32, cb));
    bf16x8 b1 = *reinterpret_cast<const LAS bf16x8*>(Ks + KSWZ(32 + r32, cb));
    const bf16x8 qf = d0 < NQR ? qr[d0 < NQR ? d0 : 0] : *reinterpret_cast<const LAS bf16x8*>(qrl + (d0 - NQR) * 1024);
    p0 = __builtin_amdgcn_mfma_f32_32x32x16_bf16(b0, qf, p0, 0, 0, 0);
    p1 = __builtin_amdgcn_mfma_f32_32x32x16_bf16(b1, qf, p1, 0, 0, 0); }
}
__device__ __forceinline__ int v_st(int k, int c) { const int kk = (k & ~0xC) | ((k & 4) << 1) | ((k & 8) >> 1); return ((kk >> 3) * 4 + (c >> 5)) * 512 + ((kk & 7) * 32 + (c & 31)) * 2; }
__device__ __forceinline__ int v_rd_base(int lane) { return ((lane & 3) << 3) | (((lane >> 2) & 3) << 6) | (((lane >> 4) & 1) << 5) | (((lane >> 5) & 1) << 8); }
constexpr int v_rd_off(int d0, int ks, int half) { return d0 * 512 + ks * 4096 + half * 2048; }
template <int OFF> __device__ __forceinline__ s16x4 tr_read(int vb) {
  s16x4 r; asm volatile("ds_read_b64_tr_b16 %0, %1 offset:%2" : "=&v"(r) : "v"(vb), "i"(OFF) : "memory"); return r;
}
template <int D0> __device__ __forceinline__ void pv_one(f32x16& od, int vb, bf16x8 pa0, bf16x8 pa1, bf16x8 pa2, bf16x8 pa3) {
  const s16x4 l0 = tr_read<v_rd_off(D0, 0, 0)>(vb), h0 = tr_read<v_rd_off(D0, 0, 1)>(vb), l1 = tr_read<v_rd_off(D0, 1, 0)>(vb), h1 = tr_read<v_rd_off(D0, 1, 1)>(vb);
  const s16x4 l2 = tr_read<v_rd_off(D0, 2, 0)>(vb), h2 = tr_read<v_rd_off(D0, 2, 1)>(vb), l3 = tr_read<v_rd_off(D0, 3, 0)>(vb), h3 = tr_read<v_rd_off(D0, 3, 1)>(vb);
  asm volatile("s_waitcnt lgkmcnt(0)" ::: "memory"); SBAR();
#define PK(L, H) (bf16x8){L[0], L[1], L[2], L[3], H[0], H[1], H[2], H[3]}
  od = __builtin_amdgcn_mfma_f32_32x32x16_bf16(pa0, PK(l0, h0), od, 0, 0, 0);
  od = __builtin_amdgcn_mfma_f32_32x32x16_bf16(pa1, PK(l1, h1), od, 0, 0, 0);
  od = __builtin_amdgcn_mfma_f32_32x32x16_bf16(pa2, PK(l2, h2), od, 0, 0, 0);
  od = __builtin_amdgcn_mfma_f32_32x32x16_bf16(pa3, PK(l3, h3), od, 0, 0, 0);
#undef PK
}
__device__ __forceinline__ void pv_d0(f32x16* o, int vb, bf16x8 pa0, bf16x8 pa1, bf16x8 pa2, bf16x8 pa3) {
  pv_one<0>(o[0], vb, pa0, pa1, pa2, pa3); pv_one<1>(o[1], vb, pa0, pa1, pa2, pa3); pv_one<2>(o[2], vb, pa0, pa1, pa2, pa3); pv_one<3>(o[3], vb, pa0, pa1, pa2, pa3);
}
constexpr int LDQ = 768, LDK = DK, LDV = DV, LDO = 1024;
__device__ __forceinline__ void attn_dense_body(const bf16* __restrict__ Qb, const bf16* __restrict__ Kh, const bf16* __restrict__ Vh, bf16* __restrict__ Ob, int seq, int pos0, LAS char* lds, const int tid, float* part, unsigned* cnt, volatile LAS unsigned* misc) {
  const int wid = tid >> 6, lane = tid & 63, r32 = lane & 31, hi = lane >> 5;
  LAS char* V_lds = lds; LAS char* K_lds = lds + 2 * SHM_V;
  LAS float* ws = (LAS float*)(lds + 2 * SHM_V + 2 * SHM_K) + wid * 64; LAS float* li_l = ws; LAS float* al_l = ws + 32;
  float m_reg = -1e30f, l_reg = 0; f32x16 o[4] = {}; bf16x8 qr[NQR];
  const LAS char* qrl = lds + SHM_QR + wid * (12 - NQR) * 1024 + lane * 16;
  const bf16* Qw = Qb + (long)(wid * QBLK + r32) * LDQ + hi * 8;
#pragma unroll
  for (int d0 = 0; d0 < NQR; ++d0) qr[d0] = *reinterpret_cast<const bf16x8*>(Qw + d0 * 16);
  LAS char* qw = lds + SHM_QR + wid * (12 - NQR) * 1024 + lane * 16;
#pragma unroll
  for (int d0 = NQR; d0 < 8; ++d0) *(LAS bf16x8*)(qw + (d0 - NQR) * 1024) = *reinterpret_cast<const bf16x8*>(Qw + d0 * 16);
  {
    bf16x8 f0 = *reinterpret_cast<const bf16x8*>(Qw + 128), f1 = *reinterpret_cast<const bf16x8*>(Qw + 144), f2 = *reinterpret_cast<const bf16x8*>(Qw + 160), f3 = *reinterpret_cast<const bf16x8*>(Qw + 176);
    if (pos0 >= 0) { const int pos = pos0 + wid * QBLK + r32; const float pr = (float)(pos >> 6), pc = (float)(pos & 63);
#pragma unroll
      for (int i = 0; i < 8; ++i) { const float inv = __builtin_amdgcn_exp2f(-(float)(8 * hi + i) * (13.287712379549449f / 16.0f));
        { const float rev = pr * inv * INV_2PI, cs = fcos_rev(rev), sn = fsin_rev(rev); const float a = bf2f((unsigned short)f0[i]), b = bf2f((unsigned short)f1[i]);
          f0[i] = (short)f2bf(a * cs - b * sn); f1[i] = (short)f2bf(b * cs + a * sn); }
        { const float rev = pc * inv * INV_2PI, cs = fcos_rev(rev), sn = fsin_rev(rev); const float a = bf2f((unsigned short)f2[i]), b = bf2f((unsigned short)f3[i]);
          f2[i] = (short)f2bf(a * cs - b * sn); f3[i] = (short)f2bf(b * cs + a * sn); } } }
    *(LAS bf16x8*)(qw + (8 - NQR) * 1024) = f0; *(LAS bf16x8*)(qw + (9 - NQR) * 1024) = f1; *(LAS bf16x8*)(qw + (10 - NQR) * 1024) = f2; *(LAS bf16x8*)(qw + (11 - NQR) * 1024) = f3;
  }
  const int sr = tid >> 4, sc = (tid & 15) * 8, vst0 = v_st(sr, sc), vst1 = v_st(32 + sr, sc);
  const int kr = tid >> 3, kc = tid & 7, kgo = kr * LDK + kc * 8, kst = KSWZ(kr, kc * 16);
  const int vb0 = (int)(unsigned)(uintptr_t)V_lds + v_rd_base(lane);
  bf16x8 vs0, vs1, ks0, ks1, ks2;
#define SLOAD(k0) do { vs0 = *reinterpret_cast<const bf16x8*>(&Vh[(long)((k0) + sr) * LDV + sc]); vs1 = *reinterpret_cast<const bf16x8*>(&Vh[(long)((k0) + 32 + sr) * LDV + sc]); \
    ks0 = *reinterpret_cast<const bf16x8*>(&Kh[(long)(k0) * LDK + kgo]); ks1 = *reinterpret_cast<const bf16x8*>(&Kh[(long)(k0) * LDK + kgo + 64]); \
    ks2 = *reinterpret_cast<const bf16x8*>(&Kh[(long)(k0) * LDK + kgo + 128]); } while (0)
#define SWRITE(b) do { *(LAS bf16x8*)(V_lds + (b) * SHM_V + vst0) = vs0; *(LAS bf16x8*)(V_lds + (b) * SHM_V + vst1) = vs1; \
    *(LAS bf16x8*)(K_lds + (b) * SHM_K + kst) = ks0; *(LAS bf16x8*)(K_lds + (b) * SHM_K + kst + 128) = ks1; *(LAS bf16x8*)(K_lds + (b) * SHM_K + kst + 256) = ks2; } while (0)
#define SWAIT() asm volatile("s_waitcnt vmcnt(0)" ::: "memory")
#define RESC(a) do { if (__any((a) < 1.f)) { if (hi == 0) al_l[r32] = (a); asm volatile("s_waitcnt lgkmcnt(0)" ::: "memory"); \
    _Pragma("unroll") for (int d = 0; d < 4; ++d) _Pragma("unroll") for (int r = 0; r < 16; ++r) o[d][r] *= al_l[crow(r, hi)]; } } while (0)
  f32x16 pA0, pA1, pB0, pB1; float mnA, mnB, alA, alB; bf16x8 pa0, pa1, pa2, pa3; const int NT = seq / KVBLK;
  SLOAD(0); SWAIT(); SWRITE(0); __syncthreads();
  qkt(pA0, pA1, K_lds, qr, qrl, r32, hi); partialSM(pA0, pA1, m_reg, mnA, alA);
  SLOAD(KVBLK);
  SWAIT(); SWRITE(1); __syncthreads();
  for (int j = 1; j + 1 < NT; j += 2) {
    SBAR(); qkt(pB0, pB1, K_lds + SHM_K, qr, qrl, r32, hi);
    finishSM(pA0, pA1, alA, l_reg, pa0, pa1, pa2, pa3); SBAR();
    SLOAD((j + 1) * KVBLK); SBAR();
    pv_d0(o, vb0, pa0, pa1, pa2, pa3); partialSM(pB0, pB1, m_reg, mnB, alB);
    __syncthreads(); SWAIT(); SWRITE(0);
    RESC(alB); __syncthreads();
    SBAR(); qkt(pA0, pA1, K_lds, qr, qrl, r32, hi);
    finishSM(pB0, pB1, alB, l_reg, pa0, pa1, pa2, pa3); SBAR();
    SLOAD((j + 2) * KVBLK); SBAR();
    pv_d0(o, vb0 + SHM_V, pa0, pa1, pa2, pa3); partialSM(pA0, pA1, m_reg, mnA, alA);
    __syncthreads(); SWAIT(); SWRITE(1);
    RESC(alA); __syncthreads();
  }
  SBAR(); qkt(pB0, pB1, K_lds + SHM_K, qr, qrl, r32, hi);
  finishSM(pA0, pA1, alA, l_reg, pa0, pa1, pa2, pa3); SBAR();
  pv_d0(o, vb0, pa0, pa1, pa2, pa3); partialSM(pB0, pB1, m_reg, mnB, alB);
  __syncthreads(); RESC(alB);
  finishSM(pB0, pB1, alB, l_reg, pa0, pa1, pa2, pa3); SBAR();
  pv_d0(o, vb0 + SHM_V, pa0, pa1, pa2, pa3);
  bf16* Ow = Ob + (long)(wid * QBLK) * LDO;
  bool write_out = true; float g1 = 1.f;
  if (part) {
    if (tid == 0) misc[1] = __hip_atomic_fetch_add(cnt, 1u, __ATOMIC_RELAXED, __HIP_MEMORY_SCOPE_AGENT);
    __syncthreads();
    const unsigned ticket = misc[1];
    float* po = part + (size_t)wid * (4 * 16 * 64) + lane; float* pml = part + 8 * 4 * 16 * 64 + wid * 128 + lane;
    if (ticket == 0u) {
#pragma unroll
      for (int d0 = 0; d0 < 4; ++d0)
#pragma unroll
        for (int r = 0; r < 16; ++r) po[(d0 * 16 + r) * 64] = o[d0][r];
      pml[0] = m_reg; pml[64] = l_reg;
      asm volatile("s_waitcnt vmcnt(0)" ::: "memory"); __syncthreads();
      if (tid == 0) { __builtin_amdgcn_fence(__ATOMIC_RELEASE, "agent"); asm volatile("s_waitcnt vmcnt(0)" ::: "memory"); __hip_atomic_store(cnt + 1, 1u, __ATOMIC_RELAXED, __HIP_MEMORY_SCOPE_AGENT); }
      write_out = false;
    } else {
      if (tid == 0) { unsigned sp = 0; while (__hip_atomic_load(cnt + 1, __ATOMIC_RELAXED, __HIP_MEMORY_SCOPE_AGENT) == 0u) { __builtin_amdgcn_s_sleep(2); if (++sp > (1u << 22)) break; }
        __builtin_amdgcn_fence(__ATOMIC_ACQUIRE, "agent"); asm volatile("s_waitcnt vmcnt(0)" ::: "memory"); }
      __syncthreads();
      constexpr float C = SCALE * 1.4426950408889634f;
      const float m2 = pml[0], l2 = pml[64]; const float mn = fmaxf(m_reg, m2);
      const float f1 = __builtin_amdgcn_exp2f((m_reg - mn) * C), f2 = __builtin_amdgcn_exp2f((m2 - mn) * C); const float il = __builtin_amdgcn_rcpf(l_reg * f1 + l2 * f2);
      if (hi == 0) { li_l[r32] = f1 * il; al_l[r32] = f2 * il; } asm volatile("s_waitcnt lgkmcnt(0)" ::: "memory");
#pragma unroll
      for (int r = 0; r < 16; ++r) { const float ga = li_l[crow(r, hi)], gb = al_l[crow(r, hi)];
#pragma unroll
        for (int d0 = 0; d0 < 4; ++d0) o[d0][r] = o[d0][r] * ga + po[(d0 * 16 + r) * 64] * gb; }
      g1 = 0.f;
    }
  }
  if (write_out) {
    if (g1 != 0.f) {
      if (hi == 0) li_l[r32] = l_reg; asm volatile("s_waitcnt lgkmcnt(0)" ::: "memory");
#pragma unroll
      for (int r = 0; r < 16; ++r) { const float rl = __builtin_amdgcn_rcpf(li_l[crow(r, hi)]);
#pragma unroll
        for (int d0 = 0; d0 < 4; ++d0) o[d0][r] *= rl; }
    }
#pragma unroll
    for (int r = 0; r < 16; ++r) { const int orow = crow(r, hi);
#pragma unroll
      for (int d0 = 0; d0 < 4; ++d0) Ow[(long)orow * LDO + d0 * 32 + r32] = (bf16)f2bf(o[d0][r]); }
  }
  __syncthreads();
#undef SLOAD
#undef SWRITE
#undef SWAIT
#undef RESC
}
#undef KSWZ
#undef SBAR
}
__device__ __forceinline__ void transpose_item(const float* W, int K, int N, bf16* WT, int ldk, LAS float* scr, int item, int lane) {
    const int nblk = N / 32, kb = item / nblk, nb = item % nblk, k0 = 64 * kb, n0 = 32 * nb;
#pragma unroll
    for (int i = 0; i < 32; ++i) { const int kk = 2 * i + (lane >> 5); scr[kk * 33 + (lane & 31)] = W[(size_t)(k0 + kk) * N + n0 + (lane & 31)]; }
    LDS_WAIT(); asm volatile("" ::: "memory");
    const int c = lane & 7;
#pragma unroll
    for (int j = 0; j < 4; ++j) { const int n = (lane >> 3) + 8 * j; const LAS float* s = scr + (8 * c) * 33 + n;
        v4u o; o.x = pk2(s[0 * 33], s[1 * 33]); o.y = pk2(s[2 * 33], s[3 * 33]); o.z = pk2(s[4 * 33], s[5 * 33]); o.w = pk2(s[6 * 33], s[7 * 33]);
        *(v4u*)(WT + (size_t)(n0 + n) * ldk + k0 + 8 * c) = o; }
    LDS_WAIT(); asm volatile("" ::: "memory");
}
constexpr int WI_L0 = 992 + 96 + 64 + 512 + 2 * 2048 + 512, WI_ALL = WI_L0 + 2 * 2048;
__device__ __forceinline__ void weight_item(const Args& args, unsigned char* ws, LAS float* scr, int idx, int lane) {
    constexpr int I0 = 992, I1 = 96, I2 = 64, I3 = 512, I4 = 2048;
    int r = idx, K, N, ldk; size_t off; const float* W;
    if (r < I0) { W = args.in[I_WIN]; K = 1024; N = 1984; ldk = 1024; off = WS_WIN_T; }
    else if ((r -= I0) < I1) { W = args.in[I_QUP]; K = 256; N = 768; ldk = 256; off = WS_QUP_T; }
    else if ((r -= I1) < I2) { W = args.in[I_KVUP]; K = 128; N = 1024; ldk = 256; off = WS_KVUP_T; }
    else if ((r -= I2) < I3) { W = args.in[I_WOUT0]; K = 1024; N = 1024; ldk = 1024; off = WS_WOUT0_T; }
    else if ((r -= I3) < I4) { W = args.in[I_W1_0]; K = 1024; N = 4096; ldk = 1024; off = WS_W1_0; }
    else if ((r -= I4) < I4) { W = args.in[I_W2_0]; K = 4096; N = 1024; ldk = 4096; off = WS_W2_0; }
    else if ((r -= I4) < I3) { W = args.in[I_WOUT1]; K = 1024; N = 1024; ldk = 1024; off = WS_W1T; }
    else if ((r -= I3) < I4) { W = args.in[I_W1_1]; K = 1024; N = 4096; ldk = 1024; off = WS_W1_1; }
    else { r -= I4; W = args.in[I_W2_1]; K = 4096; N = 1024; ldk = 4096; off = WS_W2_1; }
    transpose_item(W, K, N, (bf16*)(ws + off), ldk, scr, r, lane);
}
__device__ __forceinline__ void row_stats(const f32x4 (&v)[4], float& mean, float& rstd) {
    float s = 0.f;
#pragma unroll
    for (int j = 0; j < 4; ++j) s += (v[j][0] + v[j][1]) + (v[j][2] + v[j][3]);
    mean = wave_sum(s) * (1.f / DM); float q = 0.f;
#pragma unroll
    for (int j = 0; j < 4; ++j) { const f32x4 d = v[j] - mean; q += (d[0] * d[0] + d[1] * d[1]) + (d[2] * d[2] + d[3] * d[3]); }
    rstd = __builtin_amdgcn_rsqf(wave_sum(q) * (1.f / DM) + LN_EPS);
}
__device__ __forceinline__ void load_row(const float* p, int lane, f32x4 (&v)[4]) {
#pragma unroll
    for (int j = 0; j < 4; ++j) v[j] = ((const f32x4*)p)[lane + 64 * j];
}
__device__ __forceinline__ void adaln_store(const f32x4 (&v)[4], const float* shift, const float* scale, bf16* hrow, int lane) {
    float mean, rstd; row_stats(v, mean, rstd);
#pragma unroll
    for (int j = 0; j < 4; ++j) { const int c = 4 * lane + 256 * j; const f32x4 sc = *(const f32x4*)(scale + c), sh = *(const f32x4*)(shift + c);
        const f32x4 h = (v[j] - mean) * rstd * (sc + 1.0f) + sh;
        v2u w; w.x = pk2(h[0], h[1]); w.y = pk2(h[2], h[3]); *(v2u*)(hrow + c) = w; }
}
__device__ __forceinline__ void ln_affine(f32x4 (&v)[4], const float* g, const float* b, int lane) {
    float mean, rstd; row_stats(v, mean, rstd);
#pragma unroll
    for (int j = 0; j < 4; ++j) { const int c = 4 * lane + 256 * j; v[j] = (v[j] - mean) * rstd * *(const f32x4*)(g + c) + *(const f32x4*)(b + c); }
}
__device__ __forceinline__ void store_row(float* p, int lane, const f32x4 (&v)[4]) {
#pragma unroll
    for (int j = 0; j < 4; ++j) ((f32x4*)p)[lane + 64 * j] = v[j];
}

namespace hconv {
using bf16x8 = __attribute__((ext_vector_type(8))) short;
using f32x16 = __attribute__((ext_vector_type(16))) float;
constexpr int UB = 8256;
constexpr int SLOT = 16384 + 2 * UB;
__device__ __forceinline__ int crow(int r, int hi) { return (r & 3) + 8 * (r >> 2) + 4 * hi; }
__device__ __forceinline__ void item(const bf16* __restrict__ GRB, const bf16* __restrict__ UT, const float* __restrict__ FP, const float* __restrict__ skipv, const bf16* __restrict__ X0, bf16* __restrict__ YM,
                                     int ch0, LAS unsigned char* lds, const int tid, const int lane, const int wave) {
    for (int q = tid; q < 4 * 1024; q += 512) { const int ch = q >> 10, i = q & 1023; const v4u v = ((const v4u*)(GRB + (size_t)(ch0 + ch) * 8192))[i]; *(LAS v4u*)(lds + ch * SLOT + 16 * i) = v; }
    for (int q = tid; q < 4 * 1024; q += 512) { const int ch = q >> 10, b = (q >> 9) & 1, i = q & 511; const v4u v = ((const v4u*)(UT + ((size_t)b * HY + ch0 + ch) * LS))[i];
        *(LAS v4u*)(lds + ch * SLOT + 16384 + b * UB + 32 + 16 * i) = v; }
    if (tid < 32) { const int ch = tid >> 3, b = (tid >> 2) & 1, j = tid & 3; const v4u z = {0u, 0u, 0u, 0u};
        *(LAS v4u*)(lds + ch * SLOT + 16384 + b * UB + (j < 2 ? 16 * j : 32 + 8192 + 16 * (j - 2))) = z; }
    __syncthreads();
    {
        const int slot = wave & 3, khalf = wave >> 2;
        const LAS unsigned char* gr = lds + slot * SLOT; const LAS unsigned char* ubuf = gr + 16384;
        const int r = lane & 31, h = lane >> 5, c = r & 15, b = r >> 4, c0 = c & 1, c1 = c >> 1;
        const LAS unsigned char* ap = gr + 992 + 16 * h - 32 * r + khalf * (129 * 32);
        const LAS unsigned char* bp = ubuf + b * UB + 16 * h + 4 * c1 + khalf * (129 * 32);
        const unsigned sh = 16u * (unsigned)c0;
        const int ch = ch0 + slot;
        const float nsum = wave_sum(FP[ch * 64 + lane] + FP[(HY + ch) * 64 + lane]); const float inv_norm = 1.f / nsum; const float skn = skipv[ch] * nsum;
        const LAS bf16* ul = (const LAS bf16*)(ubuf + b * UB + 32);
        f32x16 acc[8];
#pragma unroll
        for (int Q = 0; Q < 8; ++Q)
#pragma unroll
            for (int g = 0; g < 16; ++g) acc[Q][g] = khalf ? 0.f : skn * bf2f(ul[16 * (32 * Q + crow(g, h)) + c]);
        int nks = khalf ? 128 : 129; asm volatile("" : "+s"(nks));
        for (int ks = 0; ks < nks; ++ks) {
            const LAS unsigned* bq = (const LAS unsigned*)bp;
            const unsigned d0 = bq[0], d1 = bq[1], d2 = bq[2], d3 = bq[3], d4 = bq[4];
            u32x4 bw; bw.x = __builtin_amdgcn_alignbit(d1, d0, sh); bw.y = __builtin_amdgcn_alignbit(d2, d1, sh); bw.z = __builtin_amdgcn_alignbit(d3, d2, sh); bw.w = __builtin_amdgcn_alignbit(d4, d3, sh);
            const bf16x8 bf = __builtin_bit_cast(bf16x8, bw);
#pragma unroll
            for (int Q = 0; Q < 8; ++Q) { const bf16x8 af = *(const LAS bf16x8*)(ap + 1024 * (7 - Q)); acc[Q] = __builtin_amdgcn_mfma_f32_32x32x16_bf16(af, bf, acc[Q], 0, 0, 0); }
            ap += 32; bp += 32;
        }
        asm volatile("s_waitcnt lgkmcnt(0)" ::: "memory");
        __syncthreads();
        LAS f32x4* xch = (LAS f32x4*)(lds + slot * SLOT);
        if (khalf) {
#pragma unroll
            for (int Q = 0; Q < 8; ++Q)
#pragma unroll
                for (int g4 = 0; g4 < 4; ++g4) xch[(Q * 4 + g4) * 64 + lane] = (f32x4){acc[Q][4 * g4], acc[Q][4 * g4 + 1], acc[Q][4 * g4 + 2], acc[Q][4 * g4 + 3]};
        }
        __syncthreads();
        if (!khalf) {
#pragma unroll
            for (int Q = 0; Q < 8; ++Q)
#pragma unroll
                for (int g4 = 0; g4 < 4; ++g4) { const f32x4 o = xch[(Q * 4 + g4) * 64 + lane]; acc[Q][4 * g4] += o[0]; acc[Q][4 * g4 + 1] += o[1]; acc[Q][4 * g4 + 2] += o[2]; acc[Q][4 * g4 + 3] += o[3]; }
        }
        asm volatile("s_waitcnt lgkmcnt(0)" ::: "memory");
        __syncthreads();
        if (!khalf) {
            LAS bf16* yl = (LAS bf16*)(lds + slot * SLOT);
#pragma unroll
            for (int Q = 0; Q < 8; ++Q)
#pragma unroll
                for (int g = 0; g < 16; ++g) { const int t = 16 * (32 * Q + crow(g, h)) + c; yl[b * LS + t] = (bf16)f2bf(acc[Q][g] * inv_norm); }
        }
    }
    __syncthreads();
    for (int q = tid; q < 2 * LS; q += 512) { const int b = q >> 12, t = q & (LS - 1); const size_t row = (size_t)NP + (size_t)b * LS + t;
        const v2u xv = *(const v2u*)(X0 + row * HY + ch0);
        const float y0 = bf2f(*(const LAS bf16*)(lds + 0 * SLOT + 2 * q)), y1 = bf2f(*(const LAS bf16*)(lds + 1 * SLOT + 2 * q)), y2 = bf2f(*(const LAS bf16*)(lds + 2 * SLOT + 2 * q)), y3 = bf2f(*(const LAS bf16*)(lds + 3 * SLOT + 2 * q));
        v2u o; o.x = pk2(y0 * bf2f((unsigned short)(xv.x & 0xffffu)), y1 * bf2f((unsigned short)(xv.x >> 16))); o.y = pk2(y2 * bf2f((unsigned short)(xv.y & 0xffffu)), y3 * bf2f((unsigned short)(xv.y >> 16)));
        *(v2u*)(YM + row * DM + ch0) = o; }
    __syncthreads();
}
static_assert(4 * SLOT <= LDSCTL_OFF, "four channel slots fit in LDS");
}

__global__ void __launch_bounds__(512, 2) fwd_kernel(Args args) {
    extern __shared__ __attribute__((aligned(16))) unsigned char lds_raw[];
    LAS unsigned char* lds = (LAS unsigned char*)lds_raw;
    volatile LAS unsigned* MISC = (volatile LAS unsigned*)(lds + MISC_OFF);
    const int wave = __builtin_amdgcn_readfirstlane((int)threadIdx.x >> 6);
    const int G = gridDim.x; const int bx = blockIdx.x; const int vcu = (G % 8 == 0) ? (bx % 8) * (G / 8) + bx / 8 : bx;
    const int gw = vcu * 8 + wave, NGW = G * 8, NGT = G * 512;
#define FRESH() const int lane = fresh_lane(); const int tid = wave * 64 + lane; const int gt = vcu * 512 + tid; (void)gt
    unsigned char* ws = args.ws;
    gu32* ctl = (gu32*)(ws + WS_CTL);
    float* MODS = (float*)(ws + WS_MODS);
    float* X = args.out;
    float* T = (float*)(ws + WS_T);
    bf16* HB = (bf16*)(ws + WS_H);
    for (int u = threadIdx.x; u < (LDS_BYTES - LDSCTL_OFF) / 4; u += 512) ((LAS unsigned*)(lds + LDSCTL_OFF))[u] = 0u;
    __syncthreads();
    XcdBarrier bar; bar.bar = (unsigned*)(ctl + CW_BAR) + args.li * XCD_BAR_WORDS; bar.x = 0; bar.st = nullptr;
    if (!MK_PER_PHASE) bar = xcd_barrier_post((unsigned*)(ctl + CW_BAR) + args.li * XCD_BAR_WORDS, MISC + 8);
    const int lo = args.ph_lo, hi = args.ph_hi;
#ifndef NO_CONV
#define NO_CONV 0
#endif
#ifndef NO_ATT
#define NO_ATT 0
#endif
#ifndef PHASE_MASK
#define PHASE_MASK 0x1FFFF
#endif
#define IN(k) ((((PHASE_MASK) >> (k)) & 1) && lo <= (k) && (k) < hi)
#define SEAM(k) do { if (IN(k) && IN((k) + 1)) xcd_barrier(bar); } while (0)

    if (IN(0)) {
        FRESH();
        asm volatile("; ==== PHASE 0 ====");
        for (int it = bx; it < 192; it += G) {
            const int layer = it / 96, cb = it % 96, col = cb * 64 + lane;
            LAS float* sil = (LAS float*)lds; LAS float* red = (LAS float*)(lds + 12288);
            for (int i = tid; i < 3072; i += 512) { const int r = i >> 10, k = i & 1023; const float c = (r == 0) ? args.in[I_CCTX][k] : args.in[I_C][(r - 1) * DM + k]; sil[i] = c / (1.f + fexp(-c)); }
            __syncthreads();
            const float* W = args.in[layer ? I_ADA1_W : I_ADA0_W]; float a0 = 0.f, a1 = 0.f, a2 = 0.f;
#pragma unroll 8
            for (int kk = 0; kk < 128; ++kk) { const int k = wave * 128 + kk; const float w = W[(size_t)k * 6144 + col]; a0 += sil[k] * w; a1 += sil[1024 + k] * w; a2 += sil[2048 + k] * w; }
            red[(wave * 3 + 0) * 64 + lane] = a0; red[(wave * 3 + 1) * 64 + lane] = a1; red[(wave * 3 + 2) * 64 + lane] = a2;
            __syncthreads();
            if (tid < 192) { const int r = tid >> 6, l = tid & 63; float s = 0.f;
#pragma unroll
                for (int w = 0; w < 8; ++w) s += red[(w * 3 + r) * 64 + l];
                MODS[(size_t)(layer * 3 + r) * 6144 + cb * 64 + l] = s + args.in[layer ? I_ADA1_B : I_ADA0_B][cb * 64 + l]; }
            __syncthreads();
        }
        {
            LAS float* scr = (LAS float*)(lds + wave * 16384);
            for (int it = gw; it < WI_L0; it += NGW) weight_item(args, ws, scr, it, lane);
        }
        for (int i = gt; i < 2048 * 128; i += NGT) { const int kp = i >> 7, c8 = (i & 127) * 8; const int part = kp >> 10, kq = kp & 1023, g = kq >> 7, cp = kq & 127; unsigned w[4] = {0u, 0u, 0u, 0u};
            if ((c8 >> 7) == g) {
#pragma unroll
                for (int e = 0; e < 8; e += 2) { const float r0 = (float)((cp * ((c8 + e) & 127)) & 127) * (1.f / 128.f), r1 = (float)((cp * ((c8 + e + 1) & 127)) & 127) * (1.f / 128.f);
                    const float a = (part ? -__builtin_amdgcn_sinf(r0) : __builtin_amdgcn_cosf(r0)) * 0.08838834764831845f, b = (part ? -__builtin_amdgcn_sinf(r1) : __builtin_amdgcn_cosf(r1)) * 0.08838834764831845f;
                    w[e >> 1] = pk2(a, b); } }
            ((v4u*)(ws + WS_CBD))[i] = (v4u){w[0], w[1], w[2], w[3]}; }
        {
            const v4u z = {0u, 0u, 0u, 0u};
            for (int i = gt; i < 8192 + 16384 + MKV * 16; i += NGT) {
                if (i < 8192) ((v4u*)(ws + WS_WIN_T + (size_t)1984 * 2048))[i] = z;
                else if (i < 8192 + 16384) { const int j = i - 8192; *(v4u*)(ws + WS_KVUP_T + (size_t)(j >> 4) * 512 + 256 + (j & 15) * 16) = z; }
                else { const int j = i - 8192 - 16384; *(v4u*)(ws + WS_KVN + (size_t)(j >> 4) * 512 + 256 + (j & 15) * 16) = z; }
            }
        }
        for (int i = gt; i < 65536; i += NGT) { const int rho = i >> 8, l = i & 255; const int k = rho > 128 ? rho - 128 : rho; const float rev = (float)((k * l) & 255) * (1.f / 256.f);
            ((bf16*)(ws + WS_D256))[i] = (bf16)f2bf((rho > 128 ? __builtin_amdgcn_sinf(rev) : __builtin_amdgcn_cosf(rev)) * 0.0625f); }
        {
            float* H2 = (float*)(ws + WS_H2);
            const float* w1 = args.in[I_HFW1]; const float* w2 = args.in[I_HFW2];
            const float b1 = args.in[I_HFB1][lane], b2 = args.in[I_HFB2][lane], fr = args.in[I_HFFREQ][lane];
            for (int R = gw; R < LS + LP; R += NGW) {
                const int L = R < LS ? LS : LP, l = R < LS ? R : R - LS;
                const float t = (float)l / (float)(L - 1);
                const float wang = (6.283185307179586f * (float)l) / (float)L;
                const int j = lane & 15; const float band = 1e-4f + (float)j * ((15.0f - 1e-4f) / 15.0f);
                const float ang = wang * band, rev = ang * INV_2PI;
                const float zl = (lane < 16) ? fcos_rev(rev) : -fsin_rev(rev);
                float p1 = b1 + t * w1[lane];
#pragma unroll
                for (int i = 0; i < 32; ++i) p1 += __shfl(zl, i) * w1[(1 + i) * 64 + lane];
                const float h1 = sinf(fr * p1);
                float p2 = b2;
#pragma unroll 16
                for (int i = 0; i < 64; ++i) p2 += __shfl(h1, i) * w2[i * 64 + lane];
                H2[(size_t)R * 64 + lane] = sinf(fr * p2);
            }
        }
    }
    SEAM(0);

    if (IN(1)) {
        FRESH();
        asm volatile("; ==== PHASE 1 ====");
        for (int m = gw; m < MT; m += NGW) {
            const float* xr = m < NP ? args.in[I_XP] + (size_t)m * DM : args.in[I_XS] + (size_t)(m - NP) * DM;
            const float* md = MODS + (size_t)req_of_row(m) * 6144;
            f32x4 v[4]; load_row(xr, lane, v); adaln_store(v, md, md + 1024, HB + (size_t)m * DM, lane);
        }
        {
            const float* H2 = (const float*)(ws + WS_H2); const float* w3 = args.in[I_HFW3];
            LAS float* w3l = (LAS float*)(lds + wave * 16384);
            for (int it = gw; it < 68 * 32; it += NGW) {
                const int lb = it >> 5, cg = it & 31; const bool smp = lb < 64; const int L = smp ? LS : LP; const int l = (smp ? lb : lb - 64) * 64 + lane; const int R = lb * 64 + lane;
#pragma unroll
                for (int q = 0; q < 32; ++q) { const int o = 2 * q + (lane >> 5); w3l[(lane & 31) * 68 + o] = w3[o * 1024 + cg * 32 + (lane & 31)]; }
                float h2[64];
#pragma unroll
                for (int q = 0; q < 16; ++q) { const f32x4 x = ((const f32x4*)(H2 + (size_t)R * 64))[q]; h2[4 * q] = x[0]; h2[4 * q + 1] = x[1]; h2[4 * q + 2] = x[2]; h2[4 * q + 3] = x[3]; }
                LDS_WAIT(); asm volatile("" ::: "memory");
                const float t = (float)l / (float)(L - 1);
                float* FP = (float*)(ws + (smp ? WS_FPART_S : WS_FPART_P));
                for (int cc = 0; cc < 32; ++cc) {
                    const int col = cg * 32 + cc, ch = col & 511, half = col >> 9;
                    float a = 0.f;
#pragma unroll
                    for (int q = 0; q < 16; ++q) { const f32x4 w4 = *(const LAS f32x4*)(w3l + cc * 68 + 4 * q); a += (h2[4 * q] * w4[0] + h2[4 * q + 1] * w4[1]) + (h2[4 * q + 2] * w4[2] + h2[4 * q + 3] * w4[3]); }
                    const float delta = fabsf(-3.0701134573253944f + (float)ch * ((-15.350567286626973f + 3.0701134573253944f) / 511.0f));
                    const float val = a * fexp(-t * delta);
                    if (smp) {
                        bf16* GRB = (bf16*)(ws + WS_FT_S) + (size_t)ch * 8192;
                        if (half == 0) GRB[LS - l] = (bf16)f2bf(val); else GRB[l == 0 ? 0 : LS + l] = (bf16)(l == 0 ? 0u : f2bf(val));
                    } else ((float*)(ws + WS_FT_P))[(size_t)col * LP + l] = val;
                    const float sa = wave_sum(fabsf(val));
                    if (lane == 0) FP[col * (smp ? 64 : 4) + (smp ? lb : lb - 64)] = sa;
                }
                LDS_WAIT(); asm volatile("" ::: "memory");
            }
        }
    }
    SEAM(1);

    if (IN(2)) {
        FRESH();
        asm volatile("; ==== PHASE 2 ====");
        pg8::Gemm g{HB, (const bf16*)(ws + WS_WIN_T), MT, WINP, DM}; pg8::StaticOrder S; S.init(MT, WINP, G, bx);
        EpiWin E{(bf16*)(ws + WS_P), (float*)(ws + WS_ZS)};
        pg8::gemm_phase<EpiWin, pg8::StaticOrder, PG8_ALIGN, PG8_SP2>(lds, g, S, E, tid);
    }
    SEAM(2);

    if (IN(3)) {
        FRESH();
        asm volatile("; ==== PHASE 3 ====");
        const bf16* P = (const bf16*)(ws + WS_P);
        for (int it = bx; it < MT / 64; it += G) {
            const int m0 = it * 64; const bool smp = m0 >= NP; const int L = smp ? LS : LP; const int l0 = smp ? (m0 - NP) % LS : m0 % LP;
            const int seq = smp ? (m0 - NP) / LS : m0 / LP;
            const int c = tid;
            const float* cw = args.in[I_CONVW]; const float* cb = args.in[I_CONVB];
            float w[3][3], bb[3];
#pragma unroll
            for (int s = 0; s < 3; ++s) { bb[s] = cb[s * 512 + c];
#pragma unroll
                for (int k = 0; k < 3; ++k) w[s][k] = cw[k * 1536 + s * 512 + c]; }
            float prev[3], cur[3];
#pragma unroll
            for (int s = 0; s < 3; ++s) { prev[s] = (l0 > 0) ? bf2f(P[(size_t)(m0 - 1) * 1536 + s * 512 + c]) : 0.f; cur[s] = bf2f(P[(size_t)m0 * 1536 + s * 512 + c]); }
            LAS bf16* ut = (LAS bf16*)lds;
            bf16* X0 = (bf16*)(ws + WS_X0);
            for (int i0 = 0; i0 < 64; i0 += 8) {
                float nx[8][3];
#pragma unroll
                for (int i = 0; i < 8; ++i) { const bool has_next = (l0 + i0 + i + 1) < L;
#pragma unroll
                    for (int s = 0; s < 3; ++s) { const float v = bf2f(P[(size_t)(m0 + i0 + i + (has_next ? 1 : 0)) * 1536 + s * 512 + c]); nx[i][s] = has_next ? v : 0.f; } }
#pragma unroll
                for (int i = 0; i < 8; ++i) {
                    float y[3];
#pragma unroll
                    for (int s = 0; s < 3; ++s) y[s] = prev[s] * w[s][0] + cur[s] * w[s][1] + nx[i][s] * w[s][2] + bb[s];
                    X0[(size_t)(m0 + i0 + i) * 512 + c] = (bf16)f2bf(y[0]);
                    ut[c * 68 + i0 + i] = (bf16)f2bf(y[2] * y[1]);
#pragma unroll
                    for (int s = 0; s < 3; ++s) { prev[s] = cur[s]; cur[s] = nx[i][s]; }
                }
            }
            __syncthreads();
            bf16* UT = (bf16*)(ws + (smp ? WS_UT_S : WS_UT_P)) + (size_t)seq * 512 * L + l0;
            for (int q = tid; q < 512 * 16; q += 512) { const int ch = q >> 4, part = q & 15; const v2u v = *(const LAS v2u*)(ut + ch * 68 + part * 4); *(v2u*)(UT + (size_t)ch * L + part * 4) = v; }
            __syncthreads();
        }
        const float* ZS = (const float*)(ws + WS_ZS);
        bf16* QN = (bf16*)(ws + WS_QN); bf16* KVN = (bf16*)(ws + WS_KVN);
        for (int m = gw; m < MKV; m += NGW) {
            if (m < MT) {
                const bool smp = m >= NP; const int b = smp ? (m - NP) / LS : m / LP, key = smp ? (m - NP) % LS : m % LP;
                const f32x4 a0 = ((const f32x4*)(ZS + (size_t)m * 512))[2 * lane], a1 = ((const f32x4*)(ZS + (size_t)m * 512))[2 * lane + 1];
                float x[8] = {a0[0], a0[1], a0[2], a0[3], a1[0], a1[1], a1[2], a1[3]};
                float ss = 0.f;
                if (lane < 48) {
#pragma unroll
                    for (int i = 0; i < 8; ++i) ss += x[i] * x[i]; }
#pragma unroll
                for (int o = 1; o < 32; o <<= 1) ss += __shfl_xor(ss, o);
                if (lane < 32) {
                    const float r = __builtin_amdgcn_rsqf(ss * (1.f / QL) + RMS_EPS); const float* g = args.in[I_QNORM] + 8 * lane;
                    v4u w; w.x = pk2(x[0] * r * g[0], x[1] * r * g[1]); w.y = pk2(x[2] * r * g[2], x[3] * r * g[3]); w.z = pk2(x[4] * r * g[4], x[5] * r * g[5]); w.w = pk2(x[6] * r * g[6], x[7] * r * g[7]);
                    *(v4u*)(QN + (size_t)m * 256 + 8 * lane) = w;
                } else if (lane < 48) {
                    const int c0 = 8 * (lane - 32); const float r = __builtin_amdgcn_rsqf(ss * (1.f / KVL) + RMS_EPS); const float* g = args.in[I_KVNORM] + c0;
                    float y[8];
#pragma unroll
                    for (int i = 0; i < 8; ++i) y[i] = x[i] * r * g[i];
                    v4u w; w.x = pk2(y[0], y[1]); w.y = pk2(y[2], y[3]); w.z = pk2(y[4], y[5]); w.w = pk2(y[6], y[7]);
                    *(v4u*)(KVN + (size_t)m * 256 + c0) = w;
                    if (!smp) { float* o = args.out + OUT_CKV + (size_t)m * KVL + c0; *(f32x4*)o = (f32x4){y[0], y[1], y[2], y[3]}; *(f32x4*)(o + 4) = (f32x4){y[4], y[5], y[6], y[7]}; }
                }
                {
                    float y[8];
                    const int q = lane - 48; const int seg = (q >> 2) & 1; const bool second = (q & 2) != 0; const int j0 = 8 * (q & 1);
                    const float pf = (float)(seg == 0 ? (key >> 6) : (key & 63));
#pragma unroll
                    for (int i = 0; i < 8; ++i) { const float pr = __shfl_xor(x[i], 2);
                        if (smp) { const float inv = __builtin_amdgcn_exp2f(-(float)(j0 + i) * (13.287712379549449f / 16.0f)); const float rev = pf * inv * INV_2PI;
                            y[i] = x[i] * fcos_rev(rev) + (second ? pr : -pr) * fsin_rev(rev); }
                        else y[i] = x[i]; }
                    if (lane >= 48 && lane < 56) {
                        const int kk = 8 * q;
                        if (!smp) { float* o = args.out + OUT_CKR + (size_t)m * DROPE + kk; *(f32x4*)o = (f32x4){y[0], y[1], y[2], y[3]}; *(f32x4*)(o + 4) = (f32x4){y[4], y[5], y[6], y[7]}; }
                        v4u w; w.x = pk2(y[0], y[1]); w.y = pk2(y[2], y[3]); w.z = pk2(y[4], y[5]); w.w = pk2(y[6], y[7]);
                        bf16* kf = (bf16*)(ws + (smp ? WS_KF_S : WS_KF_P)); const int lk = smp ? LKS : LP;
#pragma unroll
                        for (int h = 0; h < NH; ++h) *(v4u*)(kf + ((size_t)(b * NH + h) * lk + key) * DQK + DNOPE + kk) = w;
                    }
                }
            } else {
                const int mm = m - MT, b = mm / PAST, j = mm % PAST;
                if (lane < 16) { const float* s = args.in[I_CKV] + (size_t)mm * KVL + 8 * lane;
                    v4u w; w.x = pk2(s[0], s[1]); w.y = pk2(s[2], s[3]); w.z = pk2(s[4], s[5]); w.w = pk2(s[6], s[7]); *(v4u*)(KVN + (size_t)m * 256 + 8 * lane) = w; }
                else if (lane < 24) { const int kk = 8 * (lane - 16); const float* s = args.in[I_CKR] + (size_t)mm * DROPE + kk;
                    v4u w; w.x = pk2(s[0], s[1]); w.y = pk2(s[2], s[3]); w.z = pk2(s[4], s[5]); w.w = pk2(s[6], s[7]);
                    bf16* kf = (bf16*)(ws + WS_KF_S);
#pragma unroll
                    for (int h = 0; h < NH; ++h) *(v4u*)(kf + ((size_t)(b * NH + h) * LKS + LS + j) * DQK + DNOPE + kk) = w; }
            }
        }
    }
    SEAM(3);

    if (IN(4)) {
        FRESH();
        asm volatile("; ==== PHASE 4 ====");
        int k256 = 256; asm volatile("" : "+s"(k256));
        { pg8::Gemm g{(const bf16*)(ws + WS_QN), (const bf16*)(ws + WS_QUP_T), MT, 768, k256}; pg8::StaticOrder S; S.init(MT, 768, G, bx);
          EpiStore E{(bf16*)(ws + WS_Q), 768};
          pg8::gemm_phase<EpiStore, pg8::StaticOrder, PG8_ALIGN, PG8_SP2>(lds, g, S, E, tid); }
        { int bx2 = (bx + 144) % G; asm volatile("" : "+s"(bx2)); const int lane2 = fresh_lane(); const int tid = wave * 64 + lane2;
          pg8::Gemm g{(const bf16*)(ws + WS_KVN), (const bf16*)(ws + WS_KVUP_T), MKV, 1024, k256}; pg8::StaticOrder S; S.init(MKV, 1024, G, bx2);
          EpiKV E{(bf16*)(ws + WS_KF_S), (bf16*)(ws + WS_KF_P), (bf16*)(ws + WS_V_S), (bf16*)(ws + WS_V_P)};
          pg8::gemm_phase<EpiKV, pg8::StaticOrder, PG8_ALIGN, PG8_SP2>(lds, g, S, E, tid); }
        { int bx3 = (bx + 88) % G; asm volatile("" : "+s"(bx3)); const int lane3 = fresh_lane(); const int tid = wave * 64 + lane3;
          pg8::Gemm g{(const bf16*)(ws + WS_W1T), (const bf16*)(ws + WS_CBD), DM, 2048, DM}; pg8::StaticOrder S; S.init(DM, 2048, G, bx3);
          EpiStore E{(bf16*)(ws + WS_WFOLD_T), 2048};
          pg8::gemm_phase<EpiStore, pg8::StaticOrder, PG8_ALIGN, PG8_SP2>(lds, g, S, E, tid); }
    }
    SEAM(4);

    if (IN(5)) {
        FRESH();
        asm volatile("; ==== PHASE 5 ====");
        constexpr int NA_S = 2 * BS * NH * (LS / 256), NC_S = HY / 4, NA_P = BP * NH, NC_P = HY, NW_T = (WI_ALL - WI_L0) / 8, NITEM = NA_S + NC_S + NA_P + NC_P + NW_T;
        bf16* YM = HB;
        for (;;) {
            if (tid == 0) MISC[0] = __hip_atomic_fetch_add((unsigned*)(ctl + CW_Q + 64 * args.li), 1u, RLX_AGENT);
            __syncthreads();
            const int it = __builtin_amdgcn_readfirstlane((int)MISC[0]);
            __syncthreads();
            if (it >= NITEM) break;
            const int lane = fresh_lane(); const int tid = wave * 64 + lane;
            const bool isA_S = it < NA_S, isA_P = (it >= NA_S + NC_S) && (it < NA_S + NC_S + NA_P);
            if (isA_S || isA_P) { if (!NO_ATT) {
                int b, h, row0, lk, pos0, koff = 0, nkeys; const bf16 *kf, *vv; float* part = nullptr; unsigned* cnt = nullptr;
                if (isA_S) { const int un = it >> 1, half = it & 1; b = un / (NH * 16); h = (un / 16) % NH; const int qb = un % 16; row0 = NP + b * LS + qb * 256; lk = LKS; pos0 = qb * 256; kf = (const bf16*)(ws + WS_KF_S); vv = (const bf16*)(ws + WS_V_S);
                    nkeys = LKS / 2; koff = half * (LKS / 2); part = (float*)(ws + WS_APART) + (size_t)un * APART_F; cnt = (unsigned*)(ctl + CW_ATT + args.li * 8192 + un * 64); }
                else { const int u = it - NA_S - NC_S; b = u / NH; h = u % NH; row0 = b * LP; lk = LP; pos0 = -1; kf = (const bf16*)(ws + WS_KF_P); vv = (const bf16*)(ws + WS_V_P); nkeys = LP; }
                att::attn_dense_body((const bf16*)(ws + WS_Q) + (size_t)row0 * 768 + h * DQK, kf + ((size_t)(b * NH + h) * lk + koff) * DQK, vv + ((size_t)(b * NH + h) * lk + koff) * DVH,
                                     YM + (size_t)row0 * DM + HY + h * DVH, nkeys, pos0, (LAS char*)lds, tid, part, cnt, MISC); }
            } else if (it < NA_S + NC_S) {
                hconv::item((const bf16*)(ws + WS_FT_S), (const bf16*)(ws + WS_UT_S), (const float*)(ws + WS_FPART_S), args.in[I_HFSKIP], (const bf16*)(ws + WS_X0), YM, (it - NA_S) * 4, lds, tid, lane, wave);
            } else if (it >= NA_S + NC_S + NA_P + NC_P) {
                LAS float* scr = (LAS float*)(lds + wave * 16384);
                weight_item(args, ws, scr, WI_L0 + (it - (NA_S + NC_S + NA_P + NC_P)) * 8 + wave, lane);
                __syncthreads();
            } else if (!NO_CONV) {
                const bool smp = it < NA_S + NC_S; const int ch = smp ? it - NA_S : it - NA_S - NC_S - NA_P;
                const int L = smp ? LS : LP, nb = smp ? BS : BP, tokbase = smp ? NP : 0;
                const float* FT = (const float*)(ws + (smp ? WS_FT_S : WS_FT_P)); const float* FP = (const float*)(ws + (smp ? WS_FPART_S : WS_FPART_P));
                const bf16* UT = (const bf16*)(ws + (smp ? WS_UT_S : WS_UT_P));
                LAS float* Gs = (LAS float*)lds;
                LAS float* Us = (LAS float*)(lds + 40960);
                LAS float* red = (LAS float*)(lds + 40960 + 65536);
                const float* hf = FT + (size_t)ch * L; const float* hb = FT + (size_t)(512 + ch) * L;
                for (int e = tid; e < 2 * L - 1; e += 512) { const int d = e - (L - 1); Gs[e + (e >> 4)] = d >= 0 ? hf[d] : hb[-d]; }
                for (int i = tid; i < nb * L; i += 512) { const int b = i / L, l = i % L; Us[i] = bf2f(UT[((size_t)b * 512 + ch) * L + l]); }
                { const int np = smp ? 64 : 4; float s = 0.f; if (tid < 2 * np) s = FP[(tid < np ? ch : 512 + ch) * np + (tid % np)];
                  s = wave_sum(s); if (lane == 0) red[wave] = s; }
                __syncthreads();
                const float inv_norm = 1.f / ((red[0] + red[1]) + (red[2] + red[3]));
                const int tps = L / 16;
                if (tid < nb * tps) {
                    const int b = tid / tps, t0 = (tid % tps) * 16;
                    float y[16];
#pragma unroll
                    for (int i = 0; i < 16; ++i) y[i] = 0.f;
                    const LAS float* ub = Us + b * L;
                    for (int s0 = 0; s0 < L; s0 += 16) {
                        const int base0 = t0 + L - 1 - s0;
                        float W[31];
#pragma unroll
                        for (int j = 0; j < 31; ++j) { const int e = base0 - 15 + j; W[j] = Gs[e + (e >> 4)]; }
#pragma unroll
                        for (int k = 0; k < 16; ++k) { const float uu = ub[s0 + k];
#pragma unroll
                            for (int i = 0; i < 16; ++i) y[i] += W[15 - k + i] * uu; }
                    }
                    const float skip = args.in[I_HFSKIP][ch];
                    const bf16* X0 = (const bf16*)(ws + WS_X0);
#pragma unroll
                    for (int i = 0; i < 16; ++i) { const size_t row = (size_t)tokbase + (size_t)b * L + t0 + i;
                        const float v = y[i] * inv_norm + skip * ub[t0 + i];
                        YM[row * DM + ch] = (bf16)f2bf(v * bf2f(X0[row * 512 + ch])); }
                }
                __syncthreads();
            }
        }
    }
    SEAM(5);

    if (IN(6)) {
        FRESH();
        asm volatile("; ==== PHASE 6 ====");
        pg8::Gemm g{HB, (const bf16*)(ws + WS_WOUT0_T), MT, DM, DM}; pg8::StaticOrder S; S.init(MT, DM, G, bx);
        EpiRes E{args.in[I_XP], args.in[I_XS], MODS + 2 * 1024, T};
        pg8::gemm_phase<EpiRes, pg8::StaticOrder, PG8_ALIGN, PG8_SP2>(lds, g, S, E, tid);
    }
    SEAM(6);

    if (IN(7)) {
        FRESH();
        asm volatile("; ==== PHASE 7 ====");
        for (int m = gw; m < MT; m += NGW) {
            const float* md = MODS + (size_t)req_of_row(m) * 6144;
            f32x4 v[4]; load_row(T + (size_t)m * DM, lane, v); ln_affine(v, args.in[I_LN1G0], args.in[I_LN1B0], lane); store_row(X + (size_t)m * DM, lane, v);
            adaln_store(v, md + 3 * 1024, md + 4 * 1024, HB + (size_t)m * DM, lane);
        }
    }
    SEAM(7);

    if (IN(8)) {
        FRESH();
        asm volatile("; ==== PHASE 8 ====");
        pg8::Gemm g{HB, (const bf16*)(ws + WS_W1_0), MT, FF, DM}; pg8::StaticOrder S; S.init(MT, FF, G, bx);
        EpiUp E{(bf16*)(ws + WS_HID)};
        pg8::gemm_phase<EpiUp, pg8::StaticOrder, PG8_ALIGN, PG8_SP2>(lds, g, S, E, tid);
    }
    SEAM(8);

    if (IN(9)) {
        FRESH();
        asm volatile("; ==== PHASE 9 ====");
        pg8::Gemm g{(const bf16*)(ws + WS_HID), (const bf16*)(ws + WS_W2_0), MT, DM, FF}; pg8::StaticOrder S; S.init(MT, DM, G, bx);
        EpiRes E{X, X + (size_t)NP * DM, MODS + 5 * 1024, T};
        pg8::gemm_phase<EpiRes, pg8::StaticOrder, PG8_ALIGN, PG8_SP2>(lds, g, S, E, tid);
    }
    SEAM(9);

    if (IN(10)) {
        FRESH();
        asm volatile("; ==== PHASE 10 ====");
        const float* MODS1 = MODS + 3 * 6144;
        for (int it = bx; it < MT / 32; it += G) {
            const int m0 = it * 32; const bool smp = m0 >= NP; const int L = smp ? LS : LP; const int l0 = smp ? (m0 - NP) % LS : m0 % LP; const int seq = smp ? (m0 - NP) / LS : m0 / LP;
            LAS bf16* ht = (LAS bf16*)lds;
            const float* md = MODS1 + (size_t)req_of_row(m0) * 6144;
            for (int rr = 0; rr < 4; ++rr) { const int i = wave * 4 + rr, m = m0 + i;
                f32x4 v[4]; load_row(T + (size_t)m * DM, lane, v); ln_affine(v, args.in[I_LN2G0], args.in[I_LN2B0], lane); store_row(X + (size_t)m * DM, lane, v);
                float mean, rstd; row_stats(v, mean, rstd);
#pragma unroll
                for (int j = 0; j < 4; ++j) { const int c = 4 * lane + 256 * j; const f32x4 sc = *(const f32x4*)(md + 1024 + c), sh = *(const f32x4*)(md + c);
                    const f32x4 h = (v[j] - mean) * rstd * (sc + 1.0f) + sh;
#pragma unroll
                    for (int e = 0; e < 4; ++e) ht[(c + e) * 40 + i] = (bf16)f2bf(h[e]); }
            }
            __syncthreads();
            bf16* HT = HB + (smp ? (size_t)NP * DM + (size_t)seq * DM * LS : (size_t)seq * DM * LP) + l0;
            for (int q = tid; q < 1024 * 4; q += 512) { const int c = q >> 2, part = q & 3; const v4u v = *(const LAS v4u*)(ht + c * 40 + part * 8); *(v4u*)(HT + (size_t)c * L + part * 8) = v; }
            __syncthreads();
        }
        for (size_t i = gt; i < (size_t)LS * LS / 8; i += NGT) {
            const int rho = (int)(i >> 9), l8 = (int)(i & 511) * 8; const int k = rho > 2048 ? rho - 2048 : rho; unsigned w[4];
#pragma unroll
            for (int e = 0; e < 8; e += 2) { const float r0 = (float)((k * (l8 + e)) & 4095) * (1.f / 4096.f), r1 = (float)((k * (l8 + e + 1)) & 4095) * (1.f / 4096.f);
                const float a = (rho > 2048 ? __builtin_amdgcn_sinf(r0) : __builtin_amdgcn_cosf(r0)) * 0.015625f, b = (rho > 2048 ? __builtin_amdgcn_sinf(r1) : __builtin_amdgcn_cosf(r1)) * 0.015625f;
                w[e >> 1] = pk2(a, b); }
            ((v4u*)(ws + WS_D4096))[i] = (v4u){w[0], w[1], w[2], w[3]};
        }
    }
    SEAM(10);

    if (IN(11)) {
        FRESH();
        asm volatile("; ==== PHASE 11 ====");
        { pg8::Gemm g{(const bf16*)(ws + WS_D4096), HB + (size_t)NP * DM, LS, BS * DM, LS}; pg8::StaticOrder S; S.init(LS, BS * DM, G, bx);
          EpiDft E{(bf16*)(ws + WS_UV), LS, NP};
          pg8::gemm_phase<EpiDft, pg8::StaticOrder, PG8_ALIGN, PG8_SP2>(lds, g, S, E, tid); }
        { int bx2 = (bx + 128) % G; asm volatile("" : "+s"(bx2)); const int lane2 = fresh_lane(); const int tid = wave * 64 + lane2;
          pg8::Gemm g{(const bf16*)(ws + WS_D256), HB, LP, BP * DM, LP}; pg8::StaticOrder S; S.init(LP, BP * DM, G, bx2);
          EpiDft E{(bf16*)(ws + WS_UV), LP, 0};
          pg8::gemm_phase<EpiDft, pg8::StaticOrder, PG8_ALIGN, PG8_SP2>(lds, g, S, E, tid); }
    }
    SEAM(11);

    if (IN(12)) {
        FRESH();
        asm volatile("; ==== PHASE 12 ====");
        pg8::Gemm g{(const bf16*)(ws + WS_UV), (const bf16*)(ws + WS_WFOLD_T), MT, DM, 2048}; pg8::StaticOrder S; S.init(MT, DM, G, bx);
        EpiRes E{X, X + (size_t)NP * DM, MODS + 3 * 6144 + 2 * 1024, T};
        pg8::gemm_phase<EpiRes, pg8::StaticOrder, PG8_ALIGN, PG8_SP2>(lds, g, S, E, tid);
    }
    SEAM(12);

    if (IN(13)) {
        FRESH();
        asm volatile("; ==== PHASE 13 ====");
        for (int m = gw; m < MT; m += NGW) {
            const float* md = MODS + 3 * 6144 + (size_t)req_of_row(m) * 6144;
            f32x4 v[4]; load_row(T + (size_t)m * DM, lane, v); ln_affine(v, args.in[I_LN1G1], args.in[I_LN1B1], lane); store_row(X + (size_t)m * DM, lane, v);
            adaln_store(v, md + 3 * 1024, md + 4 * 1024, HB + (size_t)m * DM, lane);
        }
    }
    SEAM(13);

    if (IN(14)) {
        FRESH();
        asm volatile("; ==== PHASE 14 ====");
        pg8::Gemm g{HB, (const bf16*)(ws + WS_W1_1), MT, FF, DM}; pg8::StaticOrder S; S.init(MT, FF, G, bx);
        EpiUp E{(bf16*)(ws + WS_HID)};
        pg8::gemm_phase<EpiUp, pg8::StaticOrder, PG8_ALIGN, PG8_SP2>(lds, g, S, E, tid);
    }
    SEAM(14);

    if (IN(15)) {
        FRESH();
        asm volatile("; ==== PHASE 15 ====");
        pg8::Gemm g{(const bf16*)(ws + WS_HID), (const bf16*)(ws + WS_W2_1), MT, DM, FF}; pg8::StaticOrder S; S.init(MT, DM, G, bx);
        EpiRes E{X, X + (size_t)NP * DM, MODS + 3 * 6144 + 5 * 1024, T};
        pg8::gemm_phase<EpiRes, pg8::StaticOrder, PG8_ALIGN, PG8_SP2>(lds, g, S, E, tid);
    }
    SEAM(15);

    if (IN(16)) {
        FRESH();
        asm volatile("; ==== PHASE 16 ====");
        for (int m = gw; m < MT; m += NGW) {
            f32x4 v[4]; load_row(T + (size_t)m * DM, lane, v); ln_affine(v, args.in[I_LN2G1], args.in[I_LN2B1], lane); store_row(X + (size_t)m * DM, lane, v);
        }
    }
#undef IN
#undef SEAM
}

extern "C" void kernel_launch(void* const* d_in, const int* in_sizes, int n_in, void* d_out, int out_size, void* d_ws, size_t ws_size, hipStream_t stream) {
    static int grid = 0;
    if (grid == 0) {
        if (n_in != 38 || ws_size < WS_END) { fprintf(stderr, "kernel_launch: expected 38 inputs and >= %zu bytes of workspace; got %d, %zu\n", (size_t)WS_END, n_in, ws_size); grid = -1; return; }
        int dev = 0, cus = 0;
        if (hipGetDevice(&dev) != hipSuccess || hipDeviceGetAttribute(&cus, hipDeviceAttributeMultiprocessorCount, dev) != hipSuccess) { grid = -1; return; }
        if (hipFuncSetAttribute((const void*)fwd_kernel, hipFuncAttributeMaxDynamicSharedMemorySize, LDS_BYTES) != hipSuccess) { fprintf(stderr, "kernel_launch: hipFuncSetAttribute failed\n"); grid = -1; return; }
        int per_cu = 0;
        if (hipOccupancyMaxActiveBlocksPerMultiprocessor(&per_cu, (const void*)fwd_kernel, 512, LDS_BYTES) != hipSuccess || per_cu < 1) fprintf(stderr, "kernel_launch: occupancy query reports %d\n", per_cu);
        (void)hipGetLastError();
        grid = cus;
    }
    if (grid < 0) return;
    (void)hipMemsetAsync((char*)d_ws + WS_CTL, 0, CTL_ZERO_BYTES, stream);
    Args a{};
    for (int i = 0; i < 38; ++i) a.in[i] = (const float*)d_in[i];
    a.out = (float*)d_out; a.ws = (unsigned char*)d_ws;
#if MK_PER_PHASE
    for (int p = 0; p < NPHASE; ++p) { a.ph_lo = p; a.ph_hi = p + 1; a.li = 0; hipLaunchKernelGGL(fwd_kernel, dim3(grid), dim3(512), LDS_BYTES, stream, a); }
#elif defined(PROBE_A)
    a.ph_lo = 0; a.ph_hi = PROBE_B; a.li = 0; hipLaunchKernelGGL(fwd_kernel, dim3(grid), dim3(512), LDS_BYTES, stream, a);
    a.ph_lo = PROBE_A; a.ph_hi = NPHASE; a.li = 1; hipLaunchKernelGGL(fwd_kernel, dim3(grid), dim3(512), LDS_BYTES, stream, a);
#else
    a.ph_lo = 0; a.ph_hi = NPHASE; a.li = 0;
    hipLaunchKernelGGL(fwd_kernel, dim3(grid), dim3(512), LDS_BYTES, stream, a);
#endif
    const hipError_t le = hipPeekAtLastError();
    if (le != hipSuccess) fprintf(stderr, "kernel_launch: launch failed: %s\n", hipGetErrorName(le));
}
```

```cpp
#include <hip/hip_runtime.h>
#include <hip/hip_bf16.h>
#include <cstdio>
#include <cstdint>
#include <cmath>
namespace pg8 {
#define PG8_LAS __attribute__((address_space(3)))
typedef unsigned short bf16_t;
typedef short bf16x8 __attribute__((ext_vector_type(8)));
typedef float f32x4 __attribute__((ext_vector_type(4)));
typedef unsigned u32x4 __attribute__((ext_vector_type(4)));
constexpr int BM = 256, BK = 64, HALF = 128, HTB = HALF * BK * 2  , STAGE_BYTES = 8 * HTB, NXCD = 8, WGM = 8;

__host__ __device__ __forceinline__ int lds_byte(int r, int c) { const int st = (r >> 4) * 2 + (c >> 5), rr = r & 15, cc = c & 31, ob = rr * 64 + cc * 2; return st * 1024 + (ob ^ (((ob >> 9) & 1) << 5)); }
__host__ __device__ __forceinline__ void stage_rc(int b, int& R, int& C) { const int st = b / 1024, sb = b % 1024, swz = sb ^ (((sb >> 9) & 1) << 5); R = (st >> 1) * 16 + swz / 64; C = (st & 1) * 32 + (swz % 64) / 2; }
__host__ __device__ __forceinline__ int perm32(int rho) { const int n = rho >> 4, i = rho & 15; return 8 * (i >> 2) + 4 * n + (i & 3); }

struct Unit { int pm, pn; int k0, nt, mode, slab, need, tile; };
struct Gemm { const bf16_t* A; const bf16_t* Bt; int M, N, K; };

struct StaticOrder {
    int nM, nN, nwg, G, c;
    __host__ __device__ void init(int M, int N, int G_, int c_) { nM = M / BM; nN = N / BM; nwg = nM * nN; G = G_; c = c_; }
    __host__ __device__ bool next(int i, Unit& u) const {
        const long L = (long)i * G + c; if (L >= nwg) return false;
        int wgid = (int)L; { const int q = nwg / NXCD, r = nwg % NXCD, xcd = wgid % NXCD, off = wgid / NXCD; wgid = (xcd < r ? xcd * (q + 1) : r * (q + 1) + (xcd - r) * q) + off; }
        const int nig = WGM * nN, gid = wgid / nig, fm = gid * WGM, gsz = (nM - fm) < WGM ? (nM - fm) : WGM;
        u.pm = fm + ((wgid % nig) % gsz); u.pn = (wgid % nig) / gsz; u.k0 = 0; u.nt = 0; u.mode = 0; u.slab = 0; u.need = 0; u.tile = 0; return true;
    }
    static constexpr bool SPLIT = false;
    __device__ __forceinline__ void a_ready(const Unit&) const {}
    __device__ __forceinline__ void done(const Unit&) const {}
};

struct SplitOrder {
    static constexpr bool SPLIT = true;
    int nM, nN, NT, per, c, lo, hi, tf, ns, give_last, P; float* slabs; unsigned* cnt;
    __device__ __forceinline__ void init(int M, int N, int K, int G_, int c_, float* slabs_, unsigned* cnt_) {
        nM = M / BM; nN = N / BM; NT = K / BK; c = c_; slabs = slabs_; cnt = cnt_;
        const int TU = nM * nN * NT; per = (TU + G_ - 1) / G_; per += per & 1;
        lo = c * per; hi = lo + per < TU ? lo + per : TU; if (lo >= TU) { lo = 0; hi = 0; }
        tf = lo / NT; ns = hi > lo ? (hi - 1) / NT - tf + 1 : 0; give_last = (hi % NT) != 0 ? 1 : 0;
        int a = per, b = NT; while (b) { const int t = a % b; a = b; b = t; } P = NT / a;
    }
    __device__ __forceinline__ int giver_index(int j) const { return j - j / P; }
    __device__ __forceinline__ bool next(int i, Unit& u) const {
        if (i >= ns) return false;
        int sidx; if (ns == 1) sidx = 0; else if (give_last && i == 0) sidx = ns - 1; else if (i == ns - 1) sidx = 0; else sidx = i - give_last + 1;
        const int T = tf + sidx, tlo = T * NT, thi = tlo + NT; const int a = lo > tlo ? lo : tlo, b = hi < thi ? hi : thi;
        const int nig = WGM * nN, gid = T / nig, fm = gid * WGM, gsz = (nM - fm) < WGM ? (nM - fm) : WGM;
        u.pm = fm + ((T % nig) % gsz); u.pn = (T % nig) / gsz; u.k0 = a - tlo; u.nt = b - a; u.tile = T;
        if (b != thi) { u.mode = 1; u.slab = giver_index(c); u.need = 0; }
        else if (a != tlo) { const int c0 = tlo / per; u.mode = 2; u.slab = giver_index(c0); u.need = c - c0; }
        else { u.mode = 0; u.slab = 0; u.need = 0; }
        return true;
    }
    __device__ __forceinline__ void a_ready(const Unit&) const {}
    __device__ __forceinline__ void done(const Unit&) const {}
};
__device__ __forceinline__ unsigned cvt_pk_bf16(float lo, float hi) { unsigned r; asm volatile("v_cvt_pk_bf16_f32 %0, %1, %2" : "=v"(r) : "v"(lo), "v"(hi)); return r; }
template <class Epi, class Sched, bool ALIGN_EPI = false, bool SP2 = false>
__device__ __forceinline__ void gemm_phase(PG8_LAS unsigned char* lds, const Gemm g, const Sched& S, const Epi& E, const int tid) {
    const int wid = __builtin_amdgcn_readfirstlane(tid >> 6), lane = tid & 63, wr = wid >> 2, wc = wid & 3, fr = lane & 15, fq = lane >> 4;
    const int K = g.K, nt = K / BK;
    unsigned voffA[2], voffB[2];
#pragma unroll
    for (int i = 0; i < 2; ++i) { int R, C; stage_rc(tid * 16 + i * 8192, R, C); const int Rb = Epi::PERM ? ((R & ~31) + perm32(R & 31)) : R;
        voffA[i] = (unsigned)(R * K + C) * 2u; voffB[i] = (unsigned)(Rb * K + C) * 2u; }
    const size_t kstep = (size_t)(BK * 2);
    const size_t hstep = (size_t)HALF * K * 2;
    const size_t tstep = 2 * hstep;
    const unsigned ldsw = (unsigned)wid * 1024u;
    const int aoff = lds_byte(wr * 64 + fr, fq * 8), boff = lds_byte(wc * 32 + fr, fq * 8);
#define PG8_SA(b, h) (((b) * 2 + (h)) * HTB)
#define PG8_SB(b, h) ((4 + (b) * 2 + (h)) * HTB)
#define PG8_STAGE(bufoff, gbase, voff) do { _Pragma("unroll") for (int _i = 0; _i < 2; ++_i) \
        __builtin_amdgcn_global_load_lds((const unsigned*)((const char*)(gbase) + (voff)[_i]), (PG8_LAS unsigned*)(lds + (bufoff) + ldsw + _i * 8192), 16, 0, 0); } while (0)
#define PG8_LDA(dst, b, h) do { _Pragma("unroll") for (int m = 0; m < 4; ++m) _Pragma("unroll") for (int k = 0; k < 2; ++k) dst[m][k] = *(const PG8_LAS bf16x8*)(lds + PG8_SA(b, h) + aoff + m * 2048 + k * 1024); } while (0)
#define PG8_LDB(dst, b, h) do { _Pragma("unroll") for (int n = 0; n < 2; ++n) _Pragma("unroll") for (int k = 0; k < 2; ++k) dst[n][k] = *(const PG8_LAS bf16x8*)(lds + PG8_SB(b, h) + boff + n * 2048 + k * 1024); } while (0)
#define PG8_MMA(ai, bj, At, Bt) do { __builtin_amdgcn_s_setprio(1); _Pragma("unroll") for (int m = 0; m < 4; ++m) _Pragma("unroll") for (int n = 0; n < 2; ++n) _Pragma("unroll") for (int k = 0; k < 2; ++k) \
        acc[ai][bj][m][n] = __builtin_amdgcn_mfma_f32_16x16x32_bf16(Bt[n][k], At[m][k], acc[ai][bj][m][n], 0, 0, 0); __builtin_amdgcn_s_setprio(0); } while (0)
#define PG8_WAIT_V(n) asm volatile("s_waitcnt vmcnt(" #n ")" ::: "memory")
#define PG8_WAIT_L(n) asm volatile("s_waitcnt lgkmcnt(" #n ")" ::: "memory")
#define PG8_BAR __builtin_amdgcn_s_barrier()
#define PG8_SCHED __builtin_amdgcn_sched_barrier(0)
    Unit cur, nxt; int ui = 0;
    if (!S.next(0, cur)) return;
    f32x4 acc[2][2][4][2];
#pragma unroll
    for (int a = 0; a < 2; ++a)
#pragma unroll
        for (int b = 0; b < 2; ++b)
#pragma unroll
            for (int m = 0; m < 4; ++m)
#pragma unroll
                for (int n = 0; n < 2; ++n) acc[a][b][m][n] = (f32x4){0.f, 0.f, 0.f, 0.f};
    bf16x8 At[4][2], B0[2][2], B1[2][2];
    const char* cA = (const char*)g.A + (size_t)cur.pm * tstep + (size_t)cur.k0 * kstep; const char* cB = (const char*)g.Bt + (size_t)cur.pn * tstep + (size_t)cur.k0 * kstep;
    S.a_ready(cur);
    if constexpr (SP2) {
        PG8_STAGE(PG8_SB(0, 0), cB, voffB); PG8_STAGE(PG8_SB(0, 1), cB + hstep, voffB); PG8_STAGE(PG8_SA(0, 0), cA, voffA); PG8_STAGE(PG8_SA(0, 1), cA + hstep, voffA);
        if (wr == 1) PG8_BAR;
        PG8_WAIT_V(2); PG8_BAR;
        PG8_STAGE(PG8_SB(1, 0), cB + kstep, voffB); PG8_STAGE(PG8_SA(1, 0), cA + kstep, voffA); PG8_STAGE(PG8_SB(1, 1), cB + hstep + kstep, voffB);
        PG8_WAIT_V(6); PG8_BAR;
    } else {
        PG8_STAGE(PG8_SB(0, 0), cB, voffB); PG8_STAGE(PG8_SA(0, 0), cA, voffA); PG8_STAGE(PG8_SB(0, 1), cB + hstep, voffB); PG8_STAGE(PG8_SA(0, 1), cA + hstep, voffA);
        if (wr == 1) PG8_BAR;
        PG8_WAIT_V(4); PG8_BAR;
        PG8_STAGE(PG8_SB(1, 0), cB + kstep, voffB); PG8_STAGE(PG8_SA(1, 0), cA + kstep, voffA); PG8_STAGE(PG8_SB(1, 1), cB + hstep + kstep, voffB);
        PG8_WAIT_V(6); PG8_BAR;
    }
    for (;;) {
        const bool has_next = S.next(ui + 1, nxt);
        const char* nA = has_next ? (const char*)g.A + (size_t)nxt.pm * tstep + (size_t)nxt.k0 * kstep : cA; const char* nB = has_next ? (const char*)g.Bt + (size_t)nxt.pn * tstep + (size_t)nxt.k0 * kstep : cB;
        const int ntc = cur.nt ? cur.nt : nt;
        for (int t = 0; t < ntc; t += 2) {
            const bool last = (t == ntc - 2);
            const char* a1 = cA + (size_t)(t + 1) * kstep;
            const char* a2 = last ? nA : cA + (size_t)(t + 2) * kstep; const char* b2 = last ? nB : cB + (size_t)(t + 2) * kstep;
            const char* a3 = a2 + kstep; const char* b3 = b2 + kstep;
            if (last && has_next) S.a_ready(nxt);
            if constexpr (SP2) {
            PG8_LDB(B0, 0, 0); PG8_LDB(B1, 0, 1); PG8_SCHED; PG8_LDA(At, 0, 0); PG8_STAGE(PG8_SA(1, 1), a1 + hstep, voffA);
            PG8_WAIT_V(8); PG8_WAIT_L(0); PG8_BAR; PG8_MMA(0, 0, At, B0); PG8_MMA(0, 1, At, B1); PG8_BAR; PG8_SCHED;
            PG8_LDA(At, 0, 1); PG8_STAGE(PG8_SB(0, 0), b2, voffB); PG8_STAGE(PG8_SB(0, 1), b2 + hstep, voffB); PG8_STAGE(PG8_SA(0, 0), a2, voffA);
            PG8_WAIT_V(8); PG8_WAIT_L(0); PG8_BAR; PG8_MMA(1, 0, At, B0); PG8_MMA(1, 1, At, B1); PG8_BAR; PG8_SCHED;
            PG8_LDB(B0, 1, 0); PG8_LDB(B1, 1, 1); PG8_SCHED; PG8_LDA(At, 1, 0); PG8_STAGE(PG8_SA(0, 1), a2 + hstep, voffA);
            PG8_WAIT_V(8); PG8_WAIT_L(0); PG8_BAR; PG8_MMA(0, 0, At, B0); PG8_MMA(0, 1, At, B1); PG8_BAR; PG8_SCHED;
            PG8_LDA(At, 1, 1); PG8_STAGE(PG8_SB(1, 0), b3, voffB); PG8_STAGE(PG8_SB(1, 1), b3 + hstep, voffB); PG8_STAGE(PG8_SA(1, 0), a3, voffA);
            PG8_WAIT_V(8); PG8_WAIT_L(0); PG8_BAR; PG8_MMA(1, 0, At, B0); PG8_MMA(1, 1, At, B1); PG8_BAR; PG8_SCHED;
            } else {
            PG8_LDB(B0, 0, 0); PG8_SCHED; PG8_LDA(At, 0, 0); PG8_STAGE(PG8_SA(1, 1), a1 + hstep, voffA);
            PG8_WAIT_L(8); PG8_BAR; PG8_WAIT_L(0); PG8_MMA(0, 0, At, B0); PG8_BAR; PG8_SCHED;
            PG8_LDB(B1, 0, 1); PG8_STAGE(PG8_SB(0, 0), b2, voffB);
            PG8_BAR; PG8_WAIT_L(0); PG8_MMA(0, 1, At, B1); PG8_BAR;
            PG8_LDA(At, 0, 1); PG8_STAGE(PG8_SA(0, 0), a2, voffA);
            PG8_BAR; PG8_WAIT_L(0); PG8_MMA(1, 0, At, B0); PG8_BAR; PG8_SCHED;
            PG8_STAGE(PG8_SB(0, 1), b2 + hstep, voffB);
            PG8_WAIT_V(6); PG8_BAR; PG8_MMA(1, 1, At, B1); PG8_BAR;
            PG8_LDB(B0, 1, 0); PG8_SCHED; PG8_LDA(At, 1, 0); PG8_STAGE(PG8_SA(0, 1), a2 + hstep, voffA);
            PG8_WAIT_L(8); PG8_BAR; PG8_WAIT_L(0); PG8_MMA(0, 0, At, B0); PG8_BAR; PG8_SCHED;
            PG8_LDB(B1, 1, 1); PG8_STAGE(PG8_SB(1, 0), b3, voffB);
            PG8_BAR; PG8_WAIT_L(0); PG8_MMA(0, 1, At, B1); PG8_BAR;
            PG8_LDA(At, 1, 1); PG8_STAGE(PG8_SA(1, 0), a3, voffA);
            PG8_BAR; PG8_WAIT_L(0); PG8_MMA(1, 0, At, B0); PG8_BAR; PG8_SCHED;
            PG8_STAGE(PG8_SB(1, 1), b3 + hstep, voffB);
            PG8_WAIT_V(6); PG8_BAR; PG8_MMA(1, 1, At, B1); PG8_BAR;
            }
        }
        if constexpr (ALIGN_EPI) { if (wr == 0) PG8_BAR; }
        if constexpr (!Epi::AFTER_DRAIN) {
            Unit eu = cur; eu.pm = __builtin_amdgcn_readfirstlane(cur.pm); eu.pn = __builtin_amdgcn_readfirstlane(cur.pn); eu.slab = __builtin_amdgcn_readfirstlane(cur.slab); eu.tile = __builtin_amdgcn_readfirstlane(cur.tile);
            eu.need = __builtin_amdgcn_readfirstlane(cur.need); eu.mode = __builtin_amdgcn_readfirstlane(cur.mode);
            asm volatile("" : "+s"(eu.pm), "+s"(eu.pn), "+s"(eu.slab), "+s"(eu.tile), "+s"(eu.need), "+s"(eu.mode));
            if constexpr (Sched::SPLIT) {
                if (eu.mode == 1) {
                    const float* sp = S.slabs + (size_t)eu.slab * 65536 + wid * 8192 + lane * 4;
#pragma unroll
                    for (int a = 0; a < 2; ++a)
#pragma unroll
                        for (int b = 0; b < 2; ++b)
#pragma unroll
                            for (int m = 0; m < 4; ++m)
#pragma unroll
                                for (int n = 0; n < 2; ++n) { const f32x4 v = acc[a][b][m][n]; const float* p = sp + (((a * 2 + b) * 4 + m) * 2 + n) * 256;
                                    asm volatile("global_store_dwordx4 %0, %1, off sc1\n\ts_nop 1" :: "v"(p), "v"(v) : "memory"); }
                    asm volatile("s_waitcnt vmcnt(0)" ::: "memory");
                    if (lane == 0) __hip_atomic_fetch_add(S.cnt + eu.tile * 32, 1u, __ATOMIC_RELAXED, __HIP_MEMORY_SCOPE_AGENT);
                } else if (eu.mode == 2) {
                    unsigned sp_ = 0;
                    while ((unsigned)__builtin_amdgcn_readfirstlane(__hip_atomic_load(S.cnt + eu.tile * 32, __ATOMIC_RELAXED, __HIP_MEMORY_SCOPE_AGENT)) < 8u) { __builtin_amdgcn_s_sleep(8); if (++sp_ > (1u << 20)) break; }
                    __builtin_amdgcn_fence(__ATOMIC_ACQUIRE, "agent");
                    E.template run<true>(acc, eu, wr, wc, fr, fq, S.slabs + (size_t)eu.slab * 65536 + wid * 8192 + lane * 4);
                } else E.template run<false>(acc, eu, wr, wc, fr, fq, nullptr);
            } else E.template run<false>(acc, eu, wr, wc, fr, fq, nullptr);
            S.done(cur); }
        if (!has_next) break;
#pragma unroll
        for (int a = 0; a < 2; ++a)
#pragma unroll
            for (int b = 0; b < 2; ++b)
#pragma unroll
                for (int m = 0; m < 4; ++m)
#pragma unroll
                    for (int n = 0; n < 2; ++n) acc[a][b][m][n] = (f32x4){0.f, 0.f, 0.f, 0.f};
        cur = nxt; cA = nA; cB = nB; ++ui;
        if constexpr (ALIGN_EPI) { if (wr == 1) PG8_BAR; }
    }
    PG8_WAIT_V(0);
    if constexpr (!ALIGN_EPI) { if (wr == 0) PG8_BAR; }
    PG8_BAR;
    if constexpr (Epi::AFTER_DRAIN) { E.fused(acc, cur, wr, wc, fr, fq, lds, wid, lane); S.done(cur); }
#undef PG8_SA
#undef PG8_SB
#undef PG8_STAGE
#undef PG8_LDA
#undef PG8_LDB
#undef PG8_MMA
#undef PG8_WAIT_V
#undef PG8_WAIT_L
#undef PG8_BAR
#undef PG8_SCHED
}
}
#ifndef PG8_SP2
#define PG8_SP2 true
#endif
#ifndef PG8_ALIGN
#define PG8_ALIGN true
#endif
#ifndef MK_PER_PHASE
#define MK_PER_PHASE 0
#endif

constexpr int DM = 1024, FF = 4096;
constexpr int LP = 256, BP = 16, LS = 4096, BS = 2, PAST = 256;
constexpr int NP = BP * LP;
constexpr int NSR = BS * LS;
constexpr int MT = NP + NSR;
constexpr int MKV = MT + BS * PAST;
constexpr int LKS = LS + PAST;
constexpr int HY = 512, NH = 4, DQK = 192, DNOPE = 128, DROPE = 64, DVH = 128, QL = 256, KVL = 128;
constexpr int WINP = 2048;
constexpr float LN_EPS = 1e-5f, RMS_EPS = 1e-6f, ALPHA = 1.41421356237309515f;
constexpr int NPHASE = 17;

constexpr int att_shm_bytes = 2 * 16384 + 2 * 24576 + 2048 + 8 * 8 * 1024;
constexpr size_t MiB = 1u << 20, KiB = 1024;
constexpr size_t WS_CTL = 0, CTL_ZERO_BYTES = 1 * MiB;
constexpr size_t WS_MODS = 1 * MiB;
constexpr size_t WS_D256 = 1 * MiB + 256 * KiB;
constexpr size_t WS_H2 = 1 * MiB + 512 * KiB;
constexpr size_t WS_FPART_S = 3 * MiB;
constexpr size_t WS_FPART_P = 3 * MiB + 256 * KiB;
constexpr size_t WS_WIN_T = 4 * MiB, WS_QUP_T = 8 * MiB, WS_KVUP_T = 8 * MiB + 512 * KiB, WS_WOUT0_T = 9 * MiB;
constexpr size_t WS_W1_0 = 11 * MiB, WS_W2_0 = 19 * MiB, WS_W1_1 = 27 * MiB, WS_W2_1 = 35 * MiB, WS_WFOLD_T = 43 * MiB;
constexpr size_t WS_T = 48 * MiB;
constexpr size_t WS_FT_S = 48 * MiB, WS_FT_P = 64 * MiB, WS_UT_S = 65 * MiB, WS_UT_P = 73 * MiB;
constexpr size_t WS_W1T = 80 * MiB, WS_CBD = 82 * MiB;
constexpr size_t WS_D4096 = 96 * MiB;
constexpr size_t WS_KF_S = 96 * MiB, WS_KF_P = 109 * MiB, WS_V_S = 115 * MiB, WS_V_P = 124 * MiB;
constexpr size_t WS_H = 128 * MiB;
constexpr size_t WS_P = 152 * MiB, WS_ZS = 188 * MiB, WS_QN = 212 * MiB, WS_KVN = 218 * MiB, WS_Q = 225 * MiB, WS_X0 = 243 * MiB;
constexpr size_t WS_HID = 152 * MiB, WS_UV = 152 * MiB;
constexpr size_t WS_END = 256 * MiB;
constexpr int CW_TMO = 0, CW_Q = 64, CW_BAR = 4096, CW_ATT = 16384, CW_SPLIT = 32768;
constexpr size_t WS_APART = 152 * MiB; constexpr int APART_F = 8 * 4 * 16 * 64 + 8 * 128;

constexpr int RING_BYTES = 131072, LDSCTL_OFF = 160 * 1024 - 512, MISC_OFF = LDSCTL_OFF + 320, LDS_BYTES = 160 * 1024;
static_assert(att_shm_bytes <= LDSCTL_OFF, "attention scratch fits below the LDS control words");

#define GAS __attribute__((address_space(1)))
#define LAS __attribute__((address_space(3)))
typedef unsigned short bf16;
typedef unsigned v4u __attribute__((ext_vector_type(4)));
typedef unsigned v2u __attribute__((ext_vector_type(2)));
typedef float f32x4 __attribute__((ext_vector_type(4)));
typedef GAS unsigned gu32;
#define RLX_AGENT __ATOMIC_RELAXED, __HIP_MEMORY_SCOPE_AGENT
#define LDS_WAIT() asm volatile("s_waitcnt lgkmcnt(0)" ::: "memory")
__device__ __forceinline__ unsigned f2bf(float f) { unsigned u = __builtin_bit_cast(unsigned, f); return (u + 0x7fffu + ((u >> 16) & 1u)) >> 16; }
__device__ __forceinline__ unsigned pk2(float lo, float hi) { return f2bf(lo) | (f2bf(hi) << 16); }
__device__ __forceinline__ float bf2f(unsigned short b) { return __builtin_bit_cast(float, (unsigned)b << 16); }
__device__ __forceinline__ float wave_sum(float v) {
#pragma unroll
    for (int o = 1; o < 64; o <<= 1) v += __shfl_xor(v, o);
    return v;
}
__device__ __forceinline__ float fsin_rev(float rev) { return __builtin_amdgcn_sinf(__builtin_amdgcn_fractf(rev)); }
__device__ __forceinline__ float fcos_rev(float rev) { return __builtin_amdgcn_cosf(__builtin_amdgcn_fractf(rev)); }
constexpr float INV_2PI = 0.15915494309189535f;
__device__ __forceinline__ float fexp(float x) { return __builtin_amdgcn_exp2f(x * 1.4426950408889634f); }

__device__ __forceinline__ int fresh_lane() { int l; asm volatile("v_mbcnt_lo_u32_b32 %0, -1, 0\n\tv_mbcnt_hi_u32_b32 %0, -1, %0" : "=v"(l)); return l; }
#define XB_TMO      128
#define XB_XCNT(j)  (256  + 64 * (j))
#define XB_XSUB(j)  (1280 + 64 * (j))
#define XB_XGEN(j)  (2304 + 64 * (j))
#define XB_TOP      3328
#define XB_TOPGEN   3392
#define XCD_BAR_WORDS 3456
#define XB_SPIN_CAP (1u << 23)
__device__ __forceinline__ unsigned xb_ld(unsigned* p)              { return __hip_atomic_load(p, __ATOMIC_RELAXED, __HIP_MEMORY_SCOPE_AGENT); }
__device__ __forceinline__ unsigned xb_add(unsigned* p, unsigned v) { return __hip_atomic_fetch_add(p, v, __ATOMIC_RELAXED, __HIP_MEMORY_SCOPE_AGENT); }
__device__ __forceinline__ unsigned xb_xcc_id() { return (unsigned)__builtin_amdgcn_s_getreg((3 << 11) | 20) & 0xFu; }
#define XB_SPIN(cond, bar) do { unsigned _sp = 0; while (cond) { __builtin_amdgcn_s_sleep(1); \
    if ((++_sp & 255u) == 0u) { if (xb_ld(&(bar)[XB_TMO])) break; if (_sp > XB_SPIN_CAP) { atomicAdd(&(bar)[XB_TMO], 1u); break; } } } } while (0)
struct XcdBarrier { unsigned* bar; unsigned x; volatile LAS unsigned* st; };
__device__ __forceinline__ XcdBarrier xcd_barrier_post(unsigned* bar, volatile LAS unsigned* st) {
    XcdBarrier b; b.bar = bar; b.x = xb_xcc_id(); b.st = st;
    if (threadIdx.x == 0) (void)xb_add(&bar[XB_XCNT(b.x)], 1u);
    return b;
}
__device__ __forceinline__ void xcd_barrier_complete(unsigned* bar, unsigned x, unsigned& nloc, unsigned& nx) {
    const unsigned G = gridDim.x * gridDim.y * gridDim.z;
    unsigned sum, cnt, mine, sp = 0u;
    for (;;) {
        sum = 0u; cnt = 0u; mine = 0u;
#pragma unroll
        for (unsigned j = 0; j < 16; ++j) { const unsigned c = xb_ld(&bar[XB_XCNT(j)]); sum += c; cnt += (c > 0u) ? 1u : 0u; mine = (j == x) ? c : mine; }
        if (sum == G) break;
        __builtin_amdgcn_s_sleep(1);
        if ((++sp & 255u) == 0u) { if (xb_ld(&bar[XB_TMO])) break; if (sp > XB_SPIN_CAP) { atomicAdd(&bar[XB_TMO], 1u); break; } }
    }
    nloc = mine > 0u ? mine : 1u; nx = cnt > 0u ? cnt : 1u;
}
__device__ __forceinline__ void xcd_barrier(const XcdBarrier& b) {
    asm volatile("s_waitcnt vmcnt(0)" ::: "memory");
    __syncthreads();
    if (threadIdx.x == 0) {
        unsigned* bar = b.bar;
        __builtin_amdgcn_s_waitcnt(0);
        unsigned nloc = b.st[0], nx = b.st[1];
        if (nloc == 0u) { xcd_barrier_complete(bar, b.x, nloc, nx); b.st[0] = nloc; b.st[1] = nx; }
        const unsigned old = xb_add(&bar[XB_XSUB(b.x)], 1u);
        const unsigned gen = old / nloc;
        if (old + 1u == (gen + 1u) * nloc) {
            __builtin_amdgcn_fence(__ATOMIC_RELEASE, "agent");
            asm volatile("s_waitcnt vmcnt(0)" ::: "memory");
            const unsigned og = xb_add(&bar[XB_TOP], 1u);
            const unsigned tg = og / nx;
            if (og + 1u == (tg + 1u) * nx) xb_add(&bar[XB_TOPGEN], 1u);
            else XB_SPIN(xb_ld(&bar[XB_TOPGEN]) == tg, bar);
            __builtin_amdgcn_fence(__ATOMIC_ACQUIRE, "agent");
            xb_add(&bar[XB_XGEN(b.x)], 1u);
            asm volatile("s_waitcnt vmcnt(0)" ::: "memory");
        } else {
            XB_SPIN(xb_ld(&bar[XB_XGEN(b.x)]) == gen, bar);
            __builtin_amdgcn_fence(__ATOMIC_ACQUIRE, "agent");
            asm volatile("s_waitcnt vmcnt(0)" ::: "memory");
        }
    }
    __syncthreads();
}

struct Args { const float* in[38]; float* out; unsigned char* ws; int ph_lo, ph_hi, li, mask; };
enum { I_XP = 0, I_XS, I_CKV, I_CKR, I_C, I_CCTX, I_ADA0_W, I_ADA0_B, I_WIN, I_CONVW, I_CONVB, I_HFW1, I_HFB1, I_HFFREQ, I_HFW2, I_HFB2, I_HFW3, I_HFSKIP,
       I_QNORM, I_QUP, I_KVNORM, I_KVUP, I_WOUT0, I_LN1G0, I_LN1B0, I_W1_0, I_W2_0, I_LN2G0, I_LN2B0, I_ADA1_W, I_ADA1_B, I_WOUT1, I_LN1G1, I_LN1B1, I_W1_1, I_W2_1, I_LN2G1, I_LN2B1 };
constexpr size_t OUT_CKV = (size_t)MT * DM, OUT_CKR = OUT_CKV + (size_t)NP * KVL;

__device__ __forceinline__ int req_of_row(int m) { return m < NP ? 0 : 1 + (m - NP) / LS; }

using pg8::f32x4; using pg8::Unit; using pg8::BM; using pg8::HALF; using pg8::cvt_pk_bf16;
typedef unsigned u32x4 __attribute__((ext_vector_type(4)));
__device__ __forceinline__ u32x4 pack8(const f32x4& a, const f32x4& b) { u32x4 w; w.x = cvt_pk_bf16(a[0], a[1]); w.y = cvt_pk_bf16(a[2], a[3]); w.z = cvt_pk_bf16(b[0], b[1]); w.w = cvt_pk_bf16(b[2], b[3]); return w; }

#define SLAB_ADD(v, ai, bj, m, n) do { if constexpr (SL) (v) += *(const f32x4*)(slab + ((((ai) * 2 + (bj)) * 4 + (m)) * 2 + (n)) * 256); } while (0)
struct EpiWin {
    static constexpr bool PERM = true, AFTER_DRAIN = false;
    bf16* P; float* ZS;
    template <bool SL> __device__ __forceinline__ void run(const f32x4 (&acc)[2][2][4][2], const Unit& u, int wr, int wc, int fr, int fq, const float* slab) const {
        const int row0 = u.pm * BM + wr * 64 + fr, colt = u.pn * BM + wc * 32 + 8 * fq;
#pragma unroll
        for (int ai = 0; ai < 2; ++ai)
#pragma unroll
            for (int m = 0; m < 4; ++m) { const int row = row0 + ai * HALF + m * 16;
#pragma unroll
                for (int bj = 0; bj < 2; ++bj) { const int col = colt + bj * HALF; f32x4 a0 = acc[ai][bj][m][0], a1 = acc[ai][bj][m][1]; SLAB_ADD(a0, ai, bj, m, 0); SLAB_ADD(a1, ai, bj, m, 1);
                    if (u.pn < 6) *(u32x4*)(P + (size_t)row * 1536 + col) = pack8(a0, a1);
                    else { float* d = ZS + (size_t)row * 512 + (col - 1536); *(f32x4*)d = a0; *(f32x4*)(d + 4) = a1; } } }
    }
};
struct EpiStore {
    static constexpr bool PERM = true, AFTER_DRAIN = false;
    bf16* O; int ld;
    template <bool SL> __device__ __forceinline__ void run(const f32x4 (&acc)[2][2][4][2], const Unit& u, int wr, int wc, int fr, int fq, const float* slab) const {
        const int row0 = u.pm * BM + wr * 64 + fr, colt = u.pn * BM + wc * 32 + 8 * fq;
#pragma unroll
        for (int ai = 0; ai < 2; ++ai)
#pragma unroll
            for (int m = 0; m < 4; ++m) { const int row = row0 + ai * HALF + m * 16;
#pragma unroll
                for (int bj = 0; bj < 2; ++bj) *(u32x4*)(O + (size_t)row * ld + colt + bj * HALF) = pack8(acc[ai][bj][m][0], acc[ai][bj][m][1]); }
    }
};
struct EpiKV {
    static constexpr bool PERM = true, AFTER_DRAIN = false;
    bf16 *KFs, *KFp, *Vs, *Vp;
    template <bool SL> __device__ __forceinline__ void run(const f32x4 (&acc)[2][2][4][2], const Unit& u, int wr, int wc, int fr, int fq, const float* slab) const {
        const int m0 = u.pm * BM; bf16* kf; bf16* vv; int lk, key0, b;
        if (m0 < NP) { b = m0 / LP; key0 = 0; lk = LP; kf = KFp; vv = Vp; }
        else if (m0 < MT) { b = (m0 - NP) / LS; key0 = (m0 - NP) % LS; lk = LKS; kf = KFs; vv = Vs; }
        else { b = (m0 - MT) / PAST; key0 = LS + (m0 - MT) % PAST; lk = LKS; kf = KFs; vv = Vs; }
        const int h = u.pn;
        int rloc = wr * 64 + fr, c8 = wc * 32 + 8 * fq; asm volatile("" : "+v"(rloc), "+v"(c8));
#pragma unroll
        for (int ai = 0; ai < 2; ++ai)
#pragma unroll
            for (int m = 0; m < 4; ++m) { const int key = key0 + rloc + ai * HALF + m * 16; const size_t kr = (size_t)(b * NH + h) * lk + key;
                *(u32x4*)(kf + kr * DQK + c8) = pack8(acc[ai][0][m][0], acc[ai][0][m][1]);
                *(u32x4*)(vv + kr * DVH + c8) = pack8(acc[ai][1][m][0], acc[ai][1][m][1]); }
    }
};
struct EpiRes {
    static constexpr bool PERM = false, AFTER_DRAIN = false;
    const float* xp; const float* xs; const float* gate;
    float* T;
    template <bool SL> __device__ __forceinline__ void run(const f32x4 (&acc)[2][2][4][2], const Unit& u, int wr, int wc, int fr, int fq, const float* slab) const {
        const int m0 = u.pm * BM, row0 = m0 + wr * 64 + fr, col0 = u.pn * BM + wc * 32 + 4 * fq;
        const float* g = gate + (size_t)req_of_row(m0) * 6144;
        f32x4 gv[2][2];
#pragma unroll
        for (int bj = 0; bj < 2; ++bj)
#pragma unroll
            for (int n = 0; n < 2; ++n) gv[bj][n] = *(const f32x4*)(g + col0 + bj * HALF + n * 16);
#pragma unroll
        for (int ai = 0; ai < 2; ++ai)
#pragma unroll
            for (int m = 0; m < 4; ++m) { const int row = row0 + ai * HALF + m * 16;
                const float* xr = (row < NP) ? xp + (size_t)row * DM : xs + (size_t)(row - NP) * DM;
#pragma unroll
                for (int bj = 0; bj < 2; ++bj)
#pragma unroll
                    for (int n = 0; n < 2; ++n) { const int col = col0 + bj * HALF + n * 16; const f32x4 xv = *(const f32x4*)(xr + col); f32x4 a = acc[ai][bj][m][n]; SLAB_ADD(a, ai, bj, m, n);
                        *(f32x4*)(T + (size_t)row * DM + col) = xv * ALPHA + gv[bj][n] * a; } }
    }
};
struct EpiUp {
    static constexpr bool PERM = true, AFTER_DRAIN = false;
    bf16* H;
    template <bool SL> __device__ __forceinline__ void run(const f32x4 (&acc)[2][2][4][2], const Unit& u, int wr, int wc, int fr, int fq, const float* slab) const {
        const int row0 = u.pm * BM + wr * 64 + fr, colt = u.pn * BM + wc * 32 + 8 * fq;
#pragma unroll
        for (int ai = 0; ai < 2; ++ai)
#pragma unroll
            for (int m = 0; m < 4; ++m) { const int row = row0 + ai * HALF + m * 16;
#pragma unroll
                for (int bj = 0; bj < 2; ++bj) { f32x4 a = acc[ai][bj][m][0], b = acc[ai][bj][m][1];
#pragma unroll
                    for (int e = 0; e < 4; ++e) { const float x = fmaxf(a[e], 0.f), y = fmaxf(b[e], 0.f); a[e] = x * x; b[e] = y * y; }
                    *(u32x4*)(H + (size_t)row * FF + colt + bj * HALF) = pack8(a, b); } }
    }
};
struct EpiDft {
    static constexpr bool PERM = true, AFTER_DRAIN = false;
    bf16* UV; int L, tokbase;
    template <bool SL> __device__ __forceinline__ void run(const f32x4 (&acc)[2][2][4][2], const Unit& u, int wr, int wc, int fr, int fq, const float* slab) const {
        int rl = wr * 64 + fr, cl = wc * 32 + 8 * fq; asm volatile("" : "+v"(rl), "+v"(cl));
        const int rho0 = u.pm * BM + rl, n0 = u.pn * BM + cl, hl = L >> 1;
#pragma unroll
        for (int ai = 0; ai < 2; ++ai)
#pragma unroll
            for (int m = 0; m < 4; ++m) { const int rho = rho0 + ai * HALF + m * 16; const int part = rho > hl ? 1 : 0; const int k = part ? rho - hl : rho;
#pragma unroll
                for (int bj = 0; bj < 2; ++bj) { const int n = n0 + bj * HALF, b = n >> 10, c = n & 1023;
                    f32x4 a0 = acc[ai][bj][m][0], a1 = acc[ai][bj][m][1]; SLAB_ADD(a0, ai, bj, m, 0); SLAB_ADD(a1, ai, bj, m, 1);
                    bf16* r1 = UV + (size_t)(tokbase + b * L + k) * 2048 + part * 1024 + c;
                    *(u32x4*)r1 = pack8(a0, a1);
                    if (k != 0 && k != hl) { bf16* r2 = UV + (size_t)(tokbase + b * L + (L - k)) * 2048 + part * 1024 + c;
                        *(u32x4*)r2 = part ? pack8(-a0, -a1) : pack8(a0, a1); }
                    else if (part == 0) { unsigned zz = 0u; asm volatile("" : "+v"(zz)); *(u32x4*)(r1 + 1024) = (u32x4){zz, zz, zz, zz}; } } }
    }
};

namespace att {
using bf16x8 = __attribute__((ext_vector_type(8))) short;
using s16x4  = __attribute__((ext_vector_type(4))) short;
using f32x16 = __attribute__((ext_vector_type(16))) float;
constexpr int DK = 192, DV = 128, NW = 8, QBLK = 32, KVBLK = 64;
constexpr float SCALE = 0.07216878364870322f;
constexpr float THR = 8.f;
constexpr int SHM_V = KVBLK * DV * 2, SHM_K = KVBLK * DK * 2, SHM_QR = 2 * SHM_V + 2 * SHM_K + NW * 64 * 4, NQR = 4  , SHM_ATTN = SHM_QR + NW * (12 - NQR) * 1024;
#define KSWZ(row, colB) ((row) * 384 + ((colB) ^ (((row) & 7) << 4)))
#define SBAR() __builtin_amdgcn_sched_barrier(0)
__device__ __forceinline__ int crow(int r, int hi) { return (r & 3) + 8 * (r >> 2) + 4 * hi; }
__device__ __forceinline__ unsigned cvtpk(float lo, float hi) { unsigned r; asm volatile("v_cvt_pk_bf16_f32 %0, %1, %2" : "=v"(r) : "v"(lo), "v"(hi)); return r; }
__device__ __forceinline__ void partialSM(f32x16& p0, f32x16& p1, float& m_reg, float& mn, float& alpha) {
  constexpr float C = SCALE * 1.4426950408889634f;
  float pmax = p0[0];
#pragma unroll
  for (int r = 1; r < 16; ++r) pmax = fmaxf(pmax, p0[r]);
#pragma unroll
  for (int r = 0; r < 16; ++r) pmax = fmaxf(pmax, p1[r]);
  { auto rr = __builtin_amdgcn_permlane32_swap(__float_as_uint(pmax), __float_as_uint(pmax), false, false);
    pmax = fmaxf(__uint_as_float(rr[0]), __uint_as_float(rr[1])); }
  if (__builtin_expect(__all(pmax - m_reg <= THR / SCALE), 1)) { mn = m_reg; alpha = 1.f; }
  else { mn = fmaxf(m_reg, pmax); alpha = __builtin_amdgcn_exp2f((m_reg - mn) * C); m_reg = mn; }
  float mnC = -mn * C;
#pragma unroll
  for (int r = 0; r < 16; ++r) p0[r] = fmaf(p0[r], C, mnC);
#pragma unroll
  for (int r = 0; r < 16; ++r) p1[r] = fmaf(p1[r], C, mnC);
#pragma unroll
  for (int r = 0; r < 16; ++r) p0[r] = __builtin_amdgcn_exp2f(p0[r]);
}
__device__ __forceinline__ void finishSM(f32x16& p0, f32x16& p1, float alpha, float& l_reg, bf16x8& pa0, bf16x8& pa1, bf16x8& pa2, bf16x8& pa3) {
#pragma unroll
  for (int r = 0; r < 16; ++r) p1[r] = __builtin_amdgcn_exp2f(p1[r]);
  float ps = 0;
#pragma unroll
  for (int r = 0; r < 16; ++r) ps += p0[r];
#pragma unroll
  for (int r = 0; r < 16; ++r) ps += p1[r];
  { auto rr = __builtin_amdgcn_permlane32_swap(__float_as_uint(ps), __float_as_uint(ps), false, false);
    ps = __uint_as_float(rr[0]) + __uint_as_float(rr[1]); }
  l_reg = l_reg * alpha + ps;
#define PK4(P, BASE, OUT) do { unsigned a0 = cvtpk(P[BASE + 0], P[BASE + 1]), a1 = cvtpk(P[BASE + 2], P[BASE + 3]);   \
    unsigned b0 = cvtpk(P[BASE + 4], P[BASE + 5]), b1 = cvtpk(P[BASE + 6], P[BASE + 7]);                              \
    auto r0 = __builtin_amdgcn_permlane32_swap(a0, b0, false, false); auto r1 = __builtin_amdgcn_permlane32_swap(a1, b1, false, false); \
    u32x4 w = {r0[0], r1[0], r0[1], r1[1]}; OUT = __builtin_bit_cast(bf16x8, w); } while (0)
  PK4(p0, 0, pa0); PK4(p0, 8, pa1); PK4(p1, 0, pa2); PK4(p1, 8, pa3);
#undef PK4
}
__device__ __forceinline__ void qkt(f32x16& p0, f32x16& p1, const LAS char* Ks, const bf16x8* qr, const LAS char* qrl, int r32, int hi) {
  p0 = f32x16{}; p1 = f32x16{};
#pragma unroll
  for (int d0 = 0; d0 < 12; ++d0) { const int cb = (d0 * 16 + hi * 8) * 2;
    bf16x8 b0 = *reinterpret_cast<const LAS bf16x8*>(Ks + KSWZ(r32, cb));
    bf16x8 b1 = *reinterpret_cast<const LAS bf16x8*>(Ks + KSWZ(32 + r32, cb));
    const bf16x8 qf = d0 < NQR ? qr[d0 < NQR ? d0 : 0] : *reinterpret_cast<const LAS bf16x8*>(qrl + (d0 - NQR) * 1024);
    p0 = __builtin_amdgcn_mfma_f32_32x32x16_bf16(b0, qf, p0, 0, 0, 0);
    p1 = __builtin_amdgcn_mfma_f32_32x32x16_bf16(b1, qf, p1, 0, 0, 0); }
}
__device__ __forceinline__ int v_st(int k, int c) { const int kk = (k & ~0xC) | ((k & 4) << 1) | ((k & 8) >> 1); return ((kk >> 3) * 4 + (c >> 5)) * 512 + ((kk & 7) * 32 + (c & 31)) * 2; }
__device__ __forceinline__ int v_rd_base(int lane) { return ((lane & 3) << 3) | (((lane >> 2) & 3) << 6) | (((lane >> 4) & 1) << 5) | (((lane >> 5) & 1) << 8); }
constexpr int v_rd_off(int d0, int ks, int half) { return d0 * 512 + ks * 4096 + half * 2048; }
template <int OFF> __device__ __forceinline__ s16x4 tr_read(int vb) {
  s16x4 r; asm volatile("ds_read_b64_tr_b16 %0, %1 offset:%2" : "=&v"(r) : "v"(vb), "i"(OFF) : "memory"); return r;
}
template <int D0> __device__ __forceinline__ void pv_one(f32x16& od, int vb, bf16x8 pa0, bf16x8 pa1, bf16x8 pa2, bf16x8 pa3) {
  const s16x4 l0 = tr_read<v_rd_off(D0, 0, 0)>(vb), h0 = tr_read<v_rd_off(D0, 0, 1)>(vb), l1 = tr_read<v_rd_off(D0, 1, 0)>(vb), h1 = tr_read<v_rd_off(D0, 1, 1)>(vb);
  const s16x4 l2 = tr_read<v_rd_off(D0, 2, 0)>(vb), h2 = tr_read<v_rd_off(D0, 2, 1)>(vb), l3 = tr_read<v_rd_off(D0, 3, 0)>(vb), h3 = tr_read<v_rd_off(D0, 3, 1)>(vb);
  asm volatile("s_waitcnt lgkmcnt(0)" ::: "memory"); SBAR();
#define PK(L, H) (bf16x8){L[0], L[1], L[2], L[3], H[0], H[1], H[2], H[3]}
  od = __builtin_amdgcn_mfma_f32_32x32x16_bf16(pa0, PK(l0, h0), od, 0, 0, 0);
  od = __builtin_amdgcn_mfma_f32_32x32x16_bf16(pa1, PK(l1, h1), od, 0, 0, 0);
  od = __builtin_amdgcn_mfma_f32_32x32x16_bf16(pa2, PK(l2, h2), od, 0, 0, 0);
  od = __builtin_amdgcn_mfma_f32_32x32x16_bf16(pa3, PK(l3, h3), od, 0, 0, 0);
#undef PK
}
__device__ __forceinline__ void pv_d0(f32x16* o, int vb, bf16x8 pa0, bf16x8 pa1, bf16x8 pa2, bf16x8 pa3) {
  pv_one<0>(o[0], vb, pa0, pa1, pa2, pa3); pv_one<1>(o[1], vb, pa0, pa1, pa2, pa3); pv_one<2>(o[2], vb, pa0, pa1, pa2, pa3); pv_one<3>(o[3], vb, pa0, pa1, pa2, pa3);
}
constexpr int LDQ = 768, LDK = DK, LDV = DV, LDO = 1024;
__device__ __forceinline__ void attn_dense_body(const bf16* __restrict__ Qb, const bf16* __restrict__ Kh, const bf16* __restrict__ Vh, bf16* __restrict__ Ob, int seq, int pos0, LAS char* lds, const int tid, float* part, unsigned* cnt, volatile LAS unsigned* misc) {
  const int wid = tid >> 6, lane = tid & 63, r32 = lane & 31, hi = lane >> 5;
  LAS char* V_lds = lds; LAS char* K_lds = lds + 2 * SHM_V;
  LAS float* ws = (LAS float*)(lds + 2 * SHM_V + 2 * SHM_K) + wid * 64; LAS float* li_l = ws; LAS float* al_l = ws + 32;
  float m_reg = -1e30f, l_reg = 0; f32x16 o[4] = {}; bf16x8 qr[NQR];
  const LAS char* qrl = lds + SHM_QR + wid * (12 - NQR) * 1024 + lane * 16;
  const bf16* Qw = Qb + (long)(wid * QBLK + r32) * LDQ + hi * 8;
#pragma unroll
  for (int d0 = 0; d0 < NQR; ++d0) qr[d0] = *reinterpret_cast<const bf16x8*>(Qw + d0 * 16);
  LAS char* qw = lds + SHM_QR + wid * (12 - NQR) * 1024 + lane * 16;
#pragma unroll
  for (int d0 = NQR; d0 < 8; ++d0) *(LAS bf16x8*)(qw + (d0 - NQR) * 1024) = *reinterpret_cast<const bf16x8*>(Qw + d0 * 16);
  {
    bf16x8 f0 = *reinterpret_cast<const bf16x8*>(Qw + 128), f1 = *reinterpret_cast<const bf16x8*>(Qw + 144), f2 = *reinterpret_cast<const bf16x8*>(Qw + 160), f3 = *reinterpret_cast<const bf16x8*>(Qw + 176);
    if (pos0 >= 0) { const int pos = pos0 + wid * QBLK + r32; const float pr = (float)(pos >> 6), pc = (float)(pos & 63);
#pragma unroll
      for (int i = 0; i < 8; ++i) { const float inv = __builtin_amdgcn_exp2f(-(float)(8 * hi + i) * (13.287712379549449f / 16.0f));
        { const float rev = pr * inv * INV_2PI, cs = fcos_rev(rev), sn = fsin_rev(rev); const float a = bf2f((unsigned short)f0[i]), b = bf2f((unsigned short)f1[i]);
          f0[i] = (short)f2bf(a * cs - b * sn); f1[i] = (short)f2bf(b * cs + a * sn); }
        { const float rev = pc * inv * INV_2PI, cs = fcos_rev(rev), sn = fsin_rev(rev); const float a = bf2f((unsigned short)f2[i]), b = bf2f((unsigned short)f3[i]);
          f2[i] = (short)f2bf(a * cs - b * sn); f3[i] = (short)f2bf(b * cs + a * sn); } } }
    *(LAS bf16x8*)(qw + (8 - NQR) * 1024) = f0; *(LAS bf16x8*)(qw + (9 - NQR) * 1024) = f1; *(LAS bf16x8*)(qw + (10 - NQR) * 1024) = f2; *(LAS bf16x8*)(qw + (11 - NQR) * 1024) = f3;
  }
  const int sr = tid >> 4, sc = (tid & 15) * 8, vst0 = v_st(sr, sc), vst1 = v_st(32 + sr, sc);
  const int kr = tid >> 3, kc = tid & 7, kgo = kr * LDK + kc * 8, kst = KSWZ(kr, kc * 16);
  const int vb0 = (int)(unsigned)(uintptr_t)V_lds + v_rd_base(lane);
  bf16x8 vs0, vs1, ks0, ks1, ks2;
#define SLOAD(k0) do { vs0 = *reinterpret_cast<const bf16x8*>(&Vh[(long)((k0) + sr) * LDV + sc]); vs1 = *reinterpret_cast<const bf16x8*>(&Vh[(long)((k0) + 32 + sr) * LDV + sc]); \
    ks0 = *reinterpret_cast<const bf16x8*>(&Kh[(long)(k0) * LDK + kgo]); ks1 = *reinterpret_cast<const bf16x8*>(&Kh[(long)(k0) * LDK + kgo + 64]); \
    ks2 = *reinterpret_cast<const bf16x8*>(&Kh[(long)(k0) * LDK + kgo + 128]); } while (0)
#define SWRITE(b) do { *(LAS bf16x8*)(V_lds + (b) * SHM_V + vst0) = vs0; *(LAS bf16x8*)(V_lds + (b) * SHM_V + vst1) = vs1; \
    *(LAS bf16x8*)(K_lds + (b) * SHM_K + kst) = ks0; *(LAS bf16x8*)(K_lds + (b) * SHM_K + kst + 128) = ks1; *(LAS bf16x8*)(K_lds + (b) * SHM_K + kst + 256) = ks2; } while (0)
#define SWAIT() asm volatile("s_waitcnt vmcnt(0)" ::: "memory")
#define RESC(a) do { if (__any((a) < 1.f)) { if (hi == 0) al_l[r32] = (a); asm volatile("s_waitcnt lgkmcnt(0)" ::: "memory"); \
    _Pragma("unroll") for (int d = 0; d < 4; ++d) _Pragma("unroll") for (int r = 0; r < 16; ++r) o[d][r] *= al_l[crow(r, hi)]; } } while (0)
  f32x16 pA0, pA1, pB0, pB1; float mnA, mnB, alA, alB; bf16x8 pa0, pa1, pa2, pa3; const int NT = seq / KVBLK;
  SLOAD(0); SWAIT(); SWRITE(0); __syncthreads();
  qkt(pA0, pA1, K_lds, qr, qrl, r32, hi); partialSM(pA0, pA1, m_reg, mnA, alA);
  SLOAD(KVBLK);
  SWAIT(); SWRITE(1); __syncthreads();
  for (int j = 1; j + 1 < NT; j += 2) {
    SBAR(); qkt(pB0, pB1, K_lds + SHM_K, qr, qrl, r32, hi);
    finishSM(pA0, pA1, alA, l_reg, pa0, pa1, pa2, pa3); SBAR();
    SLOAD((j + 1) * KVBLK); SBAR();
    pv_d0(o, vb0, pa0, pa1, pa2, pa3); partialSM(pB0, pB1, m_reg, mnB, alB);
    __syncthreads(); SWAIT(); SWRITE(0);
    RESC(alB); __syncthreads();
    SBAR(); qkt(pA0, pA1, K_lds, qr, qrl, r32, hi);
    finishSM(pB0, pB1, alB, l_reg, pa0, pa1, pa2, pa3); SBAR();
    SLOAD((j + 2) * KVBLK); SBAR();
    pv_d0(o, vb0 + SHM_V, pa0, pa1, pa2, pa3); partialSM(pA0, pA1, m_reg, mnA, alA);
    __syncthreads(); SWAIT(); SWRITE(1);
    RESC(alA); __syncthreads();
  }
  SBAR(); qkt(pB0, pB1, K_lds + SHM_K, qr, qrl, r32, hi);
  finishSM(pA0, pA1, alA, l_reg, pa0, pa1, pa2, pa3); SBAR();
  pv_d0(o, vb0, pa0, pa1, pa2, pa3); partialSM(pB0, pB1, m_reg, mnB, alB);
  __syncthreads(); RESC(alB);
  finishSM(pB0, pB1, alB, l_reg, pa0, pa1, pa2, pa3); SBAR();
  pv_d0(o, vb0 + SHM_V, pa0, pa1, pa2, pa3);
  bf16* Ow = Ob + (long)(wid * QBLK) * LDO;
  bool write_out = true; float g1 = 1.f;
  if (part) {
    if (tid == 0) misc[1] = __hip_atomic_fetch_add(cnt, 1u, __ATOMIC_RELAXED, __HIP_MEMORY_SCOPE_AGENT);
    __syncthreads();
    const unsigned ticket = misc[1];
    float* po = part + (size_t)wid * (4 * 16 * 64) + lane * 4; float* pml = part + 8 * 4 * 16 * 64 + wid * 128 + lane;
    if (ticket == 0u) {
#pragma unroll
      for (int d0 = 0; d0 < 4; ++d0)
#pragma unroll
        for (int r4 = 0; r4 < 4; ++r4) { const f32x4 v = {o[d0][4 * r4], o[d0][4 * r4 + 1], o[d0][4 * r4 + 2], o[d0][4 * r4 + 3]}; const float* p = po + (d0 * 4 + r4) * 256;
          asm volatile("global_store_dwordx4 %0, %1, off sc1\n\ts_nop 1" :: "v"(p), "v"(v) : "memory"); }
      __hip_atomic_store((unsigned*)pml, __float_as_uint(m_reg), __ATOMIC_RELAXED, __HIP_MEMORY_SCOPE_AGENT); __hip_atomic_store((unsigned*)pml + 64, __float_as_uint(l_reg), __ATOMIC_RELAXED, __HIP_MEMORY_SCOPE_AGENT);
      asm volatile("s_waitcnt vmcnt(0)" ::: "memory"); __syncthreads();
      if (tid == 0) __hip_atomic_store(cnt + 1, 1u, __ATOMIC_RELAXED, __HIP_MEMORY_SCOPE_AGENT);
      write_out = false;
    } else {
      if (tid == 0) { unsigned sp = 0; while (__hip_atomic_load(cnt + 1, __ATOMIC_RELAXED, __HIP_MEMORY_SCOPE_AGENT) == 0u) { __builtin_amdgcn_s_sleep(2); if (++sp > (1u << 22)) break; }
        __builtin_amdgcn_fence(__ATOMIC_ACQUIRE, "agent"); asm volatile("s_waitcnt vmcnt(0)" ::: "memory"); }
      __syncthreads();
      constexpr float C = SCALE * 1.4426950408889634f;
      const float m2 = pml[0], l2 = pml[64]; const float mn = fmaxf(m_reg, m2);
      const float f1 = __builtin_amdgcn_exp2f((m_reg - mn) * C), f2 = __builtin_amdgcn_exp2f((m2 - mn) * C); const float il = __builtin_amdgcn_rcpf(l_reg * f1 + l2 * f2);
      if (hi == 0) { li_l[r32] = f1 * il; al_l[r32] = f2 * il; } asm volatile("s_waitcnt lgkmcnt(0)" ::: "memory");
#pragma unroll
      for (int r4 = 0; r4 < 4; ++r4)
#pragma unroll
        for (int d0 = 0; d0 < 4; ++d0) { const f32x4 pv = *(const f32x4*)(po + (d0 * 4 + r4) * 256);
#pragma unroll
          for (int e = 0; e < 4; ++e) { const int r = 4 * r4 + e; o[d0][r] = o[d0][r] * li_l[crow(r, hi)] + pv[e] * al_l[crow(r, hi)]; } }
      g1 = 0.f;
    }
  }
  if (write_out) {
    if (g1 != 0.f) {
      if (hi == 0) li_l[r32] = l_reg; asm volatile("s_waitcnt lgkmcnt(0)" ::: "memory");
#pragma unroll
      for (int r = 0; r < 16; ++r) { const float rl = __builtin_amdgcn_rcpf(li_l[crow(r, hi)]);
#pragma unroll
        for (int d0 = 0; d0 < 4; ++d0) o[d0][r] *= rl; }
    }
#pragma unroll
    for (int r = 0; r < 16; ++r) { const int orow = crow(r, hi);
#pragma unroll
      for (int d0 = 0; d0 < 4; ++d0) Ow[(long)orow * LDO + d0 * 32 + r32] = (bf16)f2bf(o[d0][r]); }
  }
  __syncthreads();
#undef SLOAD
#undef SWRITE
#undef SWAIT
#undef RESC
}
#undef KSWZ
#undef SBAR
}
__device__ __forceinline__ void transpose_item(const float* W, int K, int N, bf16* WT, int ldk, LAS float* scr, int item, int lane) {
    const int nblk = N / 32, kb = item / nblk, nb = item % nblk, k0 = 64 * kb, n0 = 32 * nb;
#pragma unroll
    for (int i = 0; i < 32; ++i) { const int kk = 2 * i + (lane >> 5); scr[kk * 33 + (lane & 31)] = W[(size_t)(k0 + kk) * N + n0 + (lane & 31)]; }
    LDS_WAIT(); asm volatile("" ::: "memory");
    const int c = lane & 7;
#pragma unroll
    for (int j = 0; j < 4; ++j) { const int n = (lane >> 3) + 8 * j; const LAS float* s = scr + (8 * c) * 33 + n;
        v4u o; o.x = pk2(s[0 * 33], s[1 * 33]); o.y = pk2(s[2 * 33], s[3 * 33]); o.z = pk2(s[4 * 33], s[5 * 33]); o.w = pk2(s[6 * 33], s[7 * 33]);
        *(v4u*)(WT + (size_t)(n0 + n) * ldk + k0 + 8 * c) = o; }
    LDS_WAIT(); asm volatile("" ::: "memory");
}
constexpr int WI_L0 = 992 + 96 + 64 + 512 + 2 * 2048 + 512, WI_ALL = WI_L0 + 2 * 2048;
__device__ __forceinline__ void weight_item(const Args& args, unsigned char* ws, LAS float* scr, int idx, int lane) {
    constexpr int I0 = 992, I1 = 96, I2 = 64, I3 = 512, I4 = 2048;
    int r = idx, K, N, ldk; size_t off; const float* W;
    if (r < I0) { W = args.in[I_WIN]; K = 1024; N = 1984; ldk = 1024; off = WS_WIN_T; }
    else if ((r -= I0) < I1) { W = args.in[I_QUP]; K = 256; N = 768; ldk = 256; off = WS_QUP_T; }
    else if ((r -= I1) < I2) { W = args.in[I_KVUP]; K = 128; N = 1024; ldk = 256; off = WS_KVUP_T; }
    else if ((r -= I2) < I3) { W = args.in[I_WOUT0]; K = 1024; N = 1024; ldk = 1024; off = WS_WOUT0_T; }
    else if ((r -= I3) < I4) { W = args.in[I_W1_0]; K = 1024; N = 4096; ldk = 1024; off = WS_W1_0; }
    else if ((r -= I4) < I4) { W = args.in[I_W2_0]; K = 4096; N = 1024; ldk = 4096; off = WS_W2_0; }
    else if ((r -= I4) < I3) { W = args.in[I_WOUT1]; K = 1024; N = 1024; ldk = 1024; off = WS_W1T; }
    else if ((r -= I3) < I4) { W = args.in[I_W1_1]; K = 1024; N = 4096; ldk = 1024; off = WS_W1_1; }
    else { r -= I4; W = args.in[I_W2_1]; K = 4096; N = 1024; ldk = 4096; off = WS_W2_1; }
    transpose_item(W, K, N, (bf16*)(ws + off), ldk, scr, r, lane);
}
__device__ __forceinline__ void row_stats(const f32x4 (&v)[4], float& mean, float& rstd) {
    float s = 0.f;
#pragma unroll
    for (int j = 0; j < 4; ++j) s += (v[j][0] + v[j][1]) + (v[j][2] + v[j][3]);
    mean = wave_sum(s) * (1.f / DM); float q = 0.f;
#pragma unroll
    for (int j = 0; j < 4; ++j) { const f32x4 d = v[j] - mean; q += (d[0] * d[0] + d[1] * d[1]) + (d[2] * d[2] + d[3] * d[3]); }
    rstd = __builtin_amdgcn_rsqf(wave_sum(q) * (1.f / DM) + LN_EPS);
}
__device__ __forceinline__ void load_row(const float* p, int lane, f32x4 (&v)[4]) {
#pragma unroll
    for (int j = 0; j < 4; ++j) v[j] = ((const f32x4*)p)[lane + 64 * j];
}
__device__ __forceinline__ void adaln_store(const f32x4 (&v)[4], const float* shift, const float* scale, bf16* hrow, int lane) {
    float mean, rstd; row_stats(v, mean, rstd);
#pragma unroll
    for (int j = 0; j < 4; ++j) { const int c = 4 * lane + 256 * j; const f32x4 sc = *(const f32x4*)(scale + c), sh = *(const f32x4*)(shift + c);
        const f32x4 h = (v[j] - mean) * rstd * (sc + 1.0f) + sh;
        v2u w; w.x = pk2(h[0], h[1]); w.y = pk2(h[2], h[3]); *(v2u*)(hrow + c) = w; }
}
__device__ __forceinline__ void ln_affine(f32x4 (&v)[4], const float* g, const float* b, int lane) {
    float mean, rstd; row_stats(v, mean, rstd);
#pragma unroll
    for (int j = 0; j < 4; ++j) { const int c = 4 * lane + 256 * j; v[j] = (v[j] - mean) * rstd * *(const f32x4*)(g + c) + *(const f32x4*)(b + c); }
}
__device__ __forceinline__ void store_row(float* p, int lane, const f32x4 (&v)[4]) {
#pragma unroll
    for (int j = 0; j < 4; ++j) ((f32x4*)p)[lane + 64 * j] = v[j];
}

namespace hconv {
using bf16x8 = __attribute__((ext_vector_type(8))) short;
using f32x16 = __attribute__((ext_vector_type(16))) float;
constexpr int UB = 8256;
constexpr int SLOT = 16384 + 2 * UB;
__device__ __forceinline__ int crow(int r, int hi) { return (r & 3) + 8 * (r >> 2) + 4 * hi; }
__device__ __forceinline__ void item(const bf16* __restrict__ GRB, const bf16* __restrict__ UT, const float* __restrict__ FP, const float* __restrict__ skipv, const bf16* __restrict__ X0, bf16* __restrict__ YM,
                                     int ch0, LAS unsigned char* lds, const int tid, const int lane, const int wave) {
    for (int q = tid; q < 4 * 1024; q += 512) { const int ch = q >> 10, i = q & 1023; const v4u v = ((const v4u*)(GRB + (size_t)(ch0 + ch) * 8192))[i]; *(LAS v4u*)(lds + ch * SLOT + 16 * i) = v; }
    for (int q = tid; q < 4 * 1024; q += 512) { const int ch = q >> 10, b = (q >> 9) & 1, i = q & 511; const v4u v = ((const v4u*)(UT + ((size_t)b * HY + ch0 + ch) * LS))[i];
        *(LAS v4u*)(lds + ch * SLOT + 16384 + b * UB + 32 + 16 * i) = v; }
    if (tid < 32) { const int ch = tid >> 3, b = (tid >> 2) & 1, j = tid & 3; const v4u z = {0u, 0u, 0u, 0u};
        *(LAS v4u*)(lds + ch * SLOT + 16384 + b * UB + (j < 2 ? 16 * j : 32 + 8192 + 16 * (j - 2))) = z; }
    __syncthreads();
    v2u x0v[16];
    {
        const int slot = wave & 3, khalf = wave >> 2;
        const LAS unsigned char* gr = lds + slot * SLOT; const LAS unsigned char* ubuf = gr + 16384;
        const int r = lane & 31, h = lane >> 5, c = r & 15, b = r >> 4, c0 = c & 1, c1 = c >> 1;
        const LAS unsigned char* ap = gr + 992 + 16 * h - 32 * r + khalf * (129 * 32);
        const LAS unsigned char* bp = ubuf + b * UB + 16 * h + 4 * c1 + khalf * (129 * 32);
        const unsigned sh = 16u * (unsigned)c0;
        const int ch = ch0 + slot;
        const float nsum = wave_sum(FP[ch * 64 + lane] + FP[(HY + ch) * 64 + lane]); const float inv_norm = 1.f / nsum; const float skn = skipv[ch] * nsum;
        const LAS bf16* ul = (const LAS bf16*)(ubuf + b * UB + 32);
        f32x16 acc[8];
#pragma unroll
        for (int Q = 0; Q < 8; ++Q)
#pragma unroll
            for (int g = 0; g < 16; ++g) acc[Q][g] = khalf ? 0.f : skn * bf2f(ul[16 * (32 * Q + crow(g, h)) + c]);
        int nks = khalf ? 128 : 129; asm volatile("" : "+s"(nks));
        unsigned aa = (unsigned)(uintptr_t)ap, ba = (unsigned)(uintptr_t)bp;
        bf16x8 fa0, fa1, fa2, fa3, fa4, fa5, fa6, fa7, fb0, fb1, fb2, fb3, fb4, fb5, fb6, fb7; v2u da01, da23, db01, db23; unsigned da4, db4;
#define HC_LD(F0, F1, F2, F3, F4, F5, F6, F7, D01, D23, D4) do { \
            asm volatile("ds_read_b128 %0, %1 offset:7168" : "=v"(F0) : "v"(aa)); asm volatile("ds_read_b128 %0, %1 offset:6144" : "=v"(F1) : "v"(aa)); \
            asm volatile("ds_read2_b32 %0, %1 offset1:1" : "=v"(D01) : "v"(ba)); asm volatile("ds_read2_b32 %0, %1 offset0:2 offset1:3" : "=v"(D23) : "v"(ba)); asm volatile("ds_read_b32 %0, %1 offset:16" : "=v"(D4) : "v"(ba)); \
            asm volatile("ds_read_b128 %0, %1 offset:5120" : "=v"(F2) : "v"(aa)); asm volatile("ds_read_b128 %0, %1 offset:4096" : "=v"(F3) : "v"(aa)); \
            asm volatile("ds_read_b128 %0, %1 offset:3072" : "=v"(F4) : "v"(aa)); asm volatile("ds_read_b128 %0, %1 offset:2048" : "=v"(F5) : "v"(aa)); \
            asm volatile("ds_read_b128 %0, %1 offset:1024" : "=v"(F6) : "v"(aa)); asm volatile("ds_read_b128 %0, %1" : "=v"(F7) : "v"(aa)); __builtin_amdgcn_sched_barrier(0); } while (0)
#define HC_WAIT(F0, F1, F2, F3, F4, F5, F6, F7, D01, D23, D4) do { __builtin_amdgcn_sched_barrier(0); asm volatile("s_waitcnt lgkmcnt(0)" : "+v"(F0), "+v"(F1), "+v"(F2), "+v"(F3), "+v"(F4), "+v"(F5), "+v"(F6), "+v"(F7), "+v"(D01), "+v"(D23), "+v"(D4)); \
            __builtin_amdgcn_sched_barrier(0); } while (0)
#define HC_MMA(F0, F1, F2, F3, F4, F5, F6, F7, D01, D23, D4) do { u32x4 bw; bw.x = __builtin_amdgcn_alignbit(D01.y, D01.x, sh); bw.y = __builtin_amdgcn_alignbit(D23.x, D01.y, sh); bw.z = __builtin_amdgcn_alignbit(D23.y, D23.x, sh); \
            bw.w = __builtin_amdgcn_alignbit(D4, D23.y, sh); const bf16x8 bf = __builtin_bit_cast(bf16x8, bw); \
            acc[0] = __builtin_amdgcn_mfma_f32_32x32x16_bf16(F0, bf, acc[0], 0, 0, 0); acc[1] = __builtin_amdgcn_mfma_f32_32x32x16_bf16(F1, bf, acc[1], 0, 0, 0); \
            acc[2] = __builtin_amdgcn_mfma_f32_32x32x16_bf16(F2, bf, acc[2], 0, 0, 0); acc[3] = __builtin_amdgcn_mfma_f32_32x32x16_bf16(F3, bf, acc[3], 0, 0, 0); \
            acc[4] = __builtin_amdgcn_mfma_f32_32x32x16_bf16(F4, bf, acc[4], 0, 0, 0); acc[5] = __builtin_amdgcn_mfma_f32_32x32x16_bf16(F5, bf, acc[5], 0, 0, 0); \
            acc[6] = __builtin_amdgcn_mfma_f32_32x32x16_bf16(F6, bf, acc[6], 0, 0, 0); acc[7] = __builtin_amdgcn_mfma_f32_32x32x16_bf16(F7, bf, acc[7], 0, 0, 0); } while (0)
        HC_LD(fa0, fa1, fa2, fa3, fa4, fa5, fa6, fa7, da01, da23, da4);
        int npair = nks >> 1;
        for (int kp = 0; kp < npair; ++kp) {
            HC_WAIT(fa0, fa1, fa2, fa3, fa4, fa5, fa6, fa7, da01, da23, da4);
            aa += 32; ba += 32; HC_LD(fb0, fb1, fb2, fb3, fb4, fb5, fb6, fb7, db01, db23, db4);
            HC_MMA(fa0, fa1, fa2, fa3, fa4, fa5, fa6, fa7, da01, da23, da4);
            HC_WAIT(fb0, fb1, fb2, fb3, fb4, fb5, fb6, fb7, db01, db23, db4);
            aa += 32; ba += 32; HC_LD(fa0, fa1, fa2, fa3, fa4, fa5, fa6, fa7, da01, da23, da4);
            HC_MMA(fb0, fb1, fb2, fb3, fb4, fb5, fb6, fb7, db01, db23, db4);
        }
        HC_WAIT(fa0, fa1, fa2, fa3, fa4, fa5, fa6, fa7, da01, da23, da4);
        if (nks & 1) HC_MMA(fa0, fa1, fa2, fa3, fa4, fa5, fa6, fa7, da01, da23, da4);
#undef HC_LD
#undef HC_WAIT
#undef HC_MMA
#pragma unroll
        for (int i = 0; i < 16; ++i) { const int q = tid + 512 * i; x0v[i] = *(const v2u*)(X0 + ((size_t)NP + q) * HY + ch0); }
        asm volatile("s_waitcnt lgkmcnt(0)" ::: "memory");
        __syncthreads();
        LAS f32x4* xch = (LAS f32x4*)(lds + slot * SLOT);
        if (khalf) {
#pragma unroll
            for (int Q = 0; Q < 8; ++Q)
#pragma unroll
                for (int g4 = 0; g4 < 4; ++g4) xch[(Q * 4 + g4) * 64 + lane] = (f32x4){acc[Q][4 * g4], acc[Q][4 * g4 + 1], acc[Q][4 * g4 + 2], acc[Q][4 * g4 + 3]};
        }
        __syncthreads();
        if (!khalf) {
#pragma unroll
            for (int Q = 0; Q < 8; ++Q)
#pragma unroll
                for (int g4 = 0; g4 < 4; ++g4) { const f32x4 o = xch[(Q * 4 + g4) * 64 + lane]; acc[Q][4 * g4] += o[0]; acc[Q][4 * g4 + 1] += o[1]; acc[Q][4 * g4 + 2] += o[2]; acc[Q][4 * g4 + 3] += o[3]; }
        }
        asm volatile("s_waitcnt lgkmcnt(0)" ::: "memory");
        __syncthreads();
        if (!khalf) {
            LAS bf16* yl = (LAS bf16*)(lds + slot * SLOT);
#pragma unroll
            for (int Q = 0; Q < 8; ++Q)
#pragma unroll
                for (int g = 0; g < 16; ++g) { const int t = 16 * (32 * Q + crow(g, h)) + c; yl[b * LS + t] = (bf16)f2bf(acc[Q][g] * inv_norm); }
        }
    }
    __syncthreads();
#pragma unroll
    for (int i = 0; i < 16; ++i) { const int q = tid + 512 * i; const size_t row = (size_t)NP + q; const v2u xv = x0v[i];
        const float y0 = bf2f(*(const LAS bf16*)(lds + 0 * SLOT + 2 * q)), y1 = bf2f(*(const LAS bf16*)(lds + 1 * SLOT + 2 * q)), y2 = bf2f(*(const LAS bf16*)(lds + 2 * SLOT + 2 * q)), y3 = bf2f(*(const LAS bf16*)(lds + 3 * SLOT + 2 * q));
        v2u o; o.x = pk2(y0 * bf2f((unsigned short)(xv.x & 0xffffu)), y1 * bf2f((unsigned short)(xv.x >> 16))); o.y = pk2(y2 * bf2f((unsigned short)(xv.y & 0xffffu)), y3 * bf2f((unsigned short)(xv.y >> 16)));
        *(v2u*)(YM + row * DM + ch0) = o; }
    __syncthreads();
}
static_assert(4 * SLOT <= LDSCTL_OFF, "four channel slots fit in LDS");
}

__global__ void __launch_bounds__(512, 2) fwd_kernel(Args args) {
    extern __shared__ __attribute__((aligned(16))) unsigned char lds_raw[];
    LAS unsigned char* lds = (LAS unsigned char*)lds_raw;
    volatile LAS unsigned* MISC = (volatile LAS unsigned*)(lds + MISC_OFF);
    const int wave = __builtin_amdgcn_readfirstlane((int)threadIdx.x >> 6);
    const int G = gridDim.x; const int bx = blockIdx.x; const int vcu = (G % 8 == 0) ? (bx % 8) * (G / 8) + bx / 8 : bx;
    const int gw = vcu * 8 + wave, NGW = G * 8, NGT = G * 512;
#define FRESH() const int lane = fresh_lane(); const int tid = wave * 64 + lane; const int gt = vcu * 512 + tid; (void)gt
    unsigned char* ws = args.ws;
    gu32* ctl = (gu32*)(ws + WS_CTL);
    float* MODS = (float*)(ws + WS_MODS);
    float* X = args.out;
    float* T = (float*)(ws + WS_T);
    bf16* HB = (bf16*)(ws + WS_H);
    for (int u = threadIdx.x; u < (LDS_BYTES - LDSCTL_OFF) / 4; u += 512) ((LAS unsigned*)(lds + LDSCTL_OFF))[u] = 0u;
    __syncthreads();
    XcdBarrier bar; bar.bar = (unsigned*)(ctl + CW_BAR) + args.li * XCD_BAR_WORDS; bar.x = 0; bar.st = nullptr;
    if (!MK_PER_PHASE) bar = xcd_barrier_post((unsigned*)(ctl + CW_BAR) + args.li * XCD_BAR_WORDS, MISC + 8);
    const int lo = args.ph_lo, hi = args.ph_hi;
#ifndef NO_CONV
#define NO_CONV 0
#endif
#ifndef NO_ATT
#define NO_ATT 0
#endif
#ifndef PHASE_MASK
#define PHASE_MASK 0x1FFFF
#endif
#define IN(k) ((((PHASE_MASK) >> (k)) & 1) && lo <= (k) && (k) < hi)
#define SPLIT_CNT(b) ((unsigned*)(ctl + CW_SPLIT + (args.li * 6 + (b)) * 16384))
#define SLABS(mib) ((float*)(ws + (size_t)(mib) * MiB))
#define SEAM(k) do { if (IN(k) && IN((k) + 1)) xcd_barrier(bar); } while (0)

    if (IN(0)) {
        FRESH();
        asm volatile("; ==== PHASE 0 ====");
        for (int it = bx; it < 192; it += G) {
            const int layer = it / 96, cb = it % 96, col = cb * 64 + lane;
            LAS float* sil = (LAS float*)lds; LAS float* red = (LAS float*)(lds + 12288);
            for (int i = tid; i < 3072; i += 512) { const int r = i >> 10, k = i & 1023; const float c = (r == 0) ? args.in[I_CCTX][k] : args.in[I_C][(r - 1) * DM + k]; sil[i] = c / (1.f + fexp(-c)); }
            __syncthreads();
            const float* W = args.in[layer ? I_ADA1_W : I_ADA0_W]; float a0 = 0.f, a1 = 0.f, a2 = 0.f;
#pragma unroll 8
            for (int kk = 0; kk < 128; ++kk) { const int k = wave * 128 + kk; const float w = W[(size_t)k * 6144 + col]; a0 += sil[k] * w; a1 += sil[1024 + k] * w; a2 += sil[2048 + k] * w; }
            red[(wave * 3 + 0) * 64 + lane] = a0; red[(wave * 3 + 1) * 64 + lane] = a1; red[(wave * 3 + 2) * 64 + lane] = a2;
            __syncthreads();
            if (tid < 192) { const int r = tid >> 6, l = tid & 63; float s = 0.f;
#pragma unroll
                for (int w = 0; w < 8; ++w) s += red[(w * 3 + r) * 64 + l];
                MODS[(size_t)(layer * 3 + r) * 6144 + cb * 64 + l] = s + args.in[layer ? I_ADA1_B : I_ADA0_B][cb * 64 + l]; }
            __syncthreads();
        }
        {
            LAS float* scr = (LAS float*)(lds + wave * 16384);
            for (int it = gw; it < WI_L0; it += NGW) weight_item(args, ws, scr, it, lane);
        }
        for (int i = gt; i < 2048 * 128; i += NGT) { const int kp = i >> 7, c8 = (i & 127) * 8; const int part = kp >> 10, kq = kp & 1023, g = kq >> 7, cp = kq & 127; unsigned w[4] = {0u, 0u, 0u, 0u};
            if ((c8 >> 7) == g) {
#pragma unroll
                for (int e = 0; e < 8; e += 2) { const float r0 = (float)((cp * ((c8 + e) & 127)) & 127) * (1.f / 128.f), r1 = (float)((cp * ((c8 + e + 1) & 127)) & 127) * (1.f / 128.f);
                    const float a = (part ? -__builtin_amdgcn_sinf(r0) : __builtin_amdgcn_cosf(r0)) * 0.08838834764831845f, b = (part ? -__builtin_amdgcn_sinf(r1) : __builtin_amdgcn_cosf(r1)) * 0.08838834764831845f;
                    w[e >> 1] = pk2(a, b); } }
            ((v4u*)(ws + WS_CBD))[i] = (v4u){w[0], w[1], w[2], w[3]}; }
        {
            const v4u z = {0u, 0u, 0u, 0u};
            for (int i = gt; i < 8192 + 16384 + MKV * 16; i += NGT) {
                if (i < 8192) ((v4u*)(ws + WS_WIN_T + (size_t)1984 * 2048))[i] = z;
                else if (i < 8192 + 16384) { const int j = i - 8192; *(v4u*)(ws + WS_KVUP_T + (size_t)(j >> 4) * 512 + 256 + (j & 15) * 16) = z; }
                else { const int j = i - 8192 - 16384; *(v4u*)(ws + WS_KVN + (size_t)(j >> 4) * 512 + 256 + (j & 15) * 16) = z; }
            }
        }
        for (int i = gt; i < 65536; i += NGT) { const int rho = i >> 8, l = i & 255; const int k = rho > 128 ? rho - 128 : rho; const float rev = (float)((k * l) & 255) * (1.f / 256.f);
            ((bf16*)(ws + WS_D256))[i] = (bf16)f2bf((rho > 128 ? __builtin_amdgcn_sinf(rev) : __builtin_amdgcn_cosf(rev)) * 0.0625f); }
        {
            float* H2 = (float*)(ws + WS_H2);
            const float* w1 = args.in[I_HFW1]; const float* w2 = args.in[I_HFW2];
            const float b1 = args.in[I_HFB1][lane], b2 = args.in[I_HFB2][lane], fr = args.in[I_HFFREQ][lane];
            for (int R = gw; R < LS + LP; R += NGW) {
                const int L = R < LS ? LS : LP, l = R < LS ? R : R - LS;
                const float t = (float)l / (float)(L - 1);
                const float wang = (6.283185307179586f * (float)l) / (float)L;
                const int j = lane & 15; const float band = 1e-4f + (float)j * ((15.0f - 1e-4f) / 15.0f);
                const float ang = wang * band, rev = ang * INV_2PI;
                const float zl = (lane < 16) ? fcos_rev(rev) : -fsin_rev(rev);
                float p1 = b1 + t * w1[lane];
#pragma unroll
                for (int i = 0; i < 32; ++i) p1 += __shfl(zl, i) * w1[(1 + i) * 64 + lane];
                const float h1 = sinf(fr * p1);
                float p2 = b2;
#pragma unroll 16
                for (int i = 0; i < 64; ++i) p2 += __shfl(h1, i) * w2[i * 64 + lane];
                H2[(size_t)R * 64 + lane] = sinf(fr * p2);
            }
        }
    }
    SEAM(0);

    if (IN(1)) {
        FRESH();
        asm volatile("; ==== PHASE 1 ====");
        for (int m = gw; m < MT; m += NGW) {
            const float* xr = m < NP ? args.in[I_XP] + (size_t)m * DM : args.in[I_XS] + (size_t)(m - NP) * DM;
            const float* md = MODS + (size_t)req_of_row(m) * 6144;
            f32x4 v[4]; load_row(xr, lane, v); adaln_store(v, md, md + 1024, HB + (size_t)m * DM, lane);
        }
        {
            const float* H2 = (const float*)(ws + WS_H2); const float* w3 = args.in[I_HFW3];
            LAS float* w3l = (LAS float*)(lds + wave * 16384);
            for (int it = gw; it < 68 * 32; it += NGW) {
                const int lb = it >> 5, cg = it & 31; const bool smp = lb < 64; const int L = smp ? LS : LP; const int l = (smp ? lb : lb - 64) * 64 + lane; const int R = lb * 64 + lane;
#pragma unroll
                for (int q = 0; q < 32; ++q) { const int o = 2 * q + (lane >> 5); w3l[(lane & 31) * 68 + o] = w3[o * 1024 + cg * 32 + (lane & 31)]; }
                float h2[64];
#pragma unroll
                for (int q = 0; q < 16; ++q) { const f32x4 x = ((const f32x4*)(H2 + (size_t)R * 64))[q]; h2[4 * q] = x[0]; h2[4 * q + 1] = x[1]; h2[4 * q + 2] = x[2]; h2[4 * q + 3] = x[3]; }
                LDS_WAIT(); asm volatile("" ::: "memory");
                const float t = (float)l / (float)(L - 1);
                float* FP = (float*)(ws + (smp ? WS_FPART_S : WS_FPART_P));
                float av[32];
#pragma unroll
                for (int cc = 0; cc < 32; ++cc) {
                    const int col = cg * 32 + cc, ch = col & 511, half = col >> 9;
                    float a = 0.f;
#pragma unroll
                    for (int q = 0; q < 16; ++q) { const f32x4 w4 = *(const LAS f32x4*)(w3l + cc * 68 + 4 * q); a += (h2[4 * q] * w4[0] + h2[4 * q + 1] * w4[1]) + (h2[4 * q + 2] * w4[2] + h2[4 * q + 3] * w4[3]); }
                    const float delta = fabsf(-3.0701134573253944f + (float)ch * ((-15.350567286626973f + 3.0701134573253944f) / 511.0f));
                    const float val = a * fexp(-t * delta);
                    if (smp) {
                        bf16* GRB = (bf16*)(ws + WS_FT_S) + (size_t)ch * 8192;
                        if (half == 0) GRB[LS - l] = (bf16)f2bf(val); else GRB[l == 0 ? 0 : LS + l] = (bf16)(l == 0 ? 0u : f2bf(val));
                    } else ((float*)(ws + WS_FT_P))[(size_t)col * LP + l] = val;
                    av[cc] = fabsf(val);
                }
#pragma unroll
                for (int o = 1; o < 64; o <<= 1) {
#pragma unroll
                    for (int cc = 0; cc < 32; ++cc) av[cc] += __shfl_xor(av[cc], o); }
                if (lane < 32) { float sel = av[0];
#pragma unroll
                    for (int cc = 1; cc < 32; ++cc) sel = (lane == cc) ? av[cc] : sel;
                    FP[(cg * 32 + lane) * (smp ? 64 : 4) + (smp ? lb : lb - 64)] = sel; }
                LDS_WAIT(); asm volatile("" ::: "memory");
            }
        }
    }
    SEAM(1);

    if (IN(2)) {
        FRESH();
        asm volatile("; ==== PHASE 2 ====");
        pg8::Gemm g{HB, (const bf16*)(ws + WS_WIN_T), MT, WINP, DM}; pg8::StaticOrder S; S.init(MT, WINP, G, bx);
        EpiWin E{(bf16*)(ws + WS_P), (float*)(ws + WS_ZS)};
        pg8::gemm_phase<EpiWin, pg8::StaticOrder, PG8_ALIGN, PG8_SP2>(lds, g, S, E, tid);
    }
    SEAM(2);

    if (IN(3)) {
        FRESH();
        asm volatile("; ==== PHASE 3 ====");
        const bf16* P = (const bf16*)(ws + WS_P);
        for (int it = bx; it < MT / 64; it += G) {
            const int m0 = it * 64; const bool smp = m0 >= NP; const int L = smp ? LS : LP; const int l0 = smp ? (m0 - NP) % LS : m0 % LP;
            const int seq = smp ? (m0 - NP) / LS : m0 / LP;
            const int c = tid;
            const float* cw = args.in[I_CONVW]; const float* cb = args.in[I_CONVB];
            float w[3][3], bb[3];
#pragma unroll
            for (int s = 0; s < 3; ++s) { bb[s] = cb[s * 512 + c];
#pragma unroll
                for (int k = 0; k < 3; ++k) w[s][k] = cw[k * 1536 + s * 512 + c]; }
            float prev[3], cur[3];
#pragma unroll
            for (int s = 0; s < 3; ++s) { prev[s] = (l0 > 0) ? bf2f(P[(size_t)(m0 - 1) * 1536 + s * 512 + c]) : 0.f; cur[s] = bf2f(P[(size_t)m0 * 1536 + s * 512 + c]); }
            LAS bf16* ut = (LAS bf16*)lds;
            bf16* X0 = (bf16*)(ws + WS_X0);
            for (int i0 = 0; i0 < 64; i0 += 8) {
                float nx[8][3];
#pragma unroll
                for (int i = 0; i < 8; ++i) { const bool has_next = (l0 + i0 + i + 1) < L;
#pragma unroll
                    for (int s = 0; s < 3; ++s) { const float v = bf2f(P[(size_t)(m0 + i0 + i + (has_next ? 1 : 0)) * 1536 + s * 512 + c]); nx[i][s] = has_next ? v : 0.f; } }
#pragma unroll
                for (int i = 0; i < 8; ++i) {
                    float y[3];
#pragma unroll
                    for (int s = 0; s < 3; ++s) y[s] = prev[s] * w[s][0] + cur[s] * w[s][1] + nx[i][s] * w[s][2] + bb[s];
                    X0[(size_t)(m0 + i0 + i) * 512 + c] = (bf16)f2bf(y[0]);
                    ut[c * 68 + i0 + i] = (bf16)f2bf(y[2] * y[1]);
#pragma unroll
                    for (int s = 0; s < 3; ++s) { prev[s] = cur[s]; cur[s] = nx[i][s]; }
                }
            }
            __syncthreads();
            bf16* UT = (bf16*)(ws + (smp ? WS_UT_S : WS_UT_P)) + (size_t)seq * 512 * L + l0;
            for (int q = tid; q < 512 * 16; q += 512) { const int ch = q >> 4, part = q & 15; const v2u v = *(const LAS v2u*)(ut + ch * 68 + part * 4); *(v2u*)(UT + (size_t)ch * L + part * 4) = v; }
            __syncthreads();
        }
        const float* ZS = (const float*)(ws + WS_ZS);
        bf16* QN = (bf16*)(ws + WS_QN); bf16* KVN = (bf16*)(ws + WS_KVN);
        for (int m = gw; m < MKV; m += NGW) {
            if (m < MT) {
                const bool smp = m >= NP; const int b = smp ? (m - NP) / LS : m / LP, key = smp ? (m - NP) % LS : m % LP;
                const f32x4 a0 = ((const f32x4*)(ZS + (size_t)m * 512))[2 * lane], a1 = ((const f32x4*)(ZS + (size_t)m * 512))[2 * lane + 1];
                float x[8] = {a0[0], a0[1], a0[2], a0[3], a1[0], a1[1], a1[2], a1[3]};
                float ss = 0.f;
                if (lane < 48) {
#pragma unroll
                    for (int i = 0; i < 8; ++i) ss += x[i] * x[i]; }
#pragma unroll
                for (int o = 1; o < 32; o <<= 1) ss += __shfl_xor(ss, o);
                if (lane < 32) {
                    const float r = __builtin_amdgcn_rsqf(ss * (1.f / QL) + RMS_EPS); const float* g = args.in[I_QNORM] + 8 * lane;
                    v4u w; w.x = pk2(x[0] * r * g[0], x[1] * r * g[1]); w.y = pk2(x[2] * r * g[2], x[3] * r * g[3]); w.z = pk2(x[4] * r * g[4], x[5] * r * g[5]); w.w = pk2(x[6] * r * g[6], x[7] * r * g[7]);
                    *(v4u*)(QN + (size_t)m * 256 + 8 * lane) = w;
                } else if (lane < 48) {
                    const int c0 = 8 * (lane - 32); const float r = __builtin_amdgcn_rsqf(ss * (1.f / KVL) + RMS_EPS); const float* g = args.in[I_KVNORM] + c0;
                    float y[8];
#pragma unroll
                    for (int i = 0; i < 8; ++i) y[i] = x[i] * r * g[i];
                    v4u w; w.x = pk2(y[0], y[1]); w.y = pk2(y[2], y[3]); w.z = pk2(y[4], y[5]); w.w = pk2(y[6], y[7]);
                    *(v4u*)(KVN + (size_t)m * 256 + c0) = w;
                    if (!smp) { float* o = args.out + OUT_CKV + (size_t)m * KVL + c0; *(f32x4*)o = (f32x4){y[0], y[1], y[2], y[3]}; *(f32x4*)(o + 4) = (f32x4){y[4], y[5], y[6], y[7]}; }
                }
                {
                    float y[8];
                    const int q = lane - 48; const int seg = (q >> 2) & 1; const bool second = (q & 2) != 0; const int j0 = 8 * (q & 1);
                    const float pf = (float)(seg == 0 ? (key >> 6) : (key & 63));
#pragma unroll
                    for (int i = 0; i < 8; ++i) { const float pr = __shfl_xor(x[i], 2);
                        if (smp) { const float inv = __builtin_amdgcn_exp2f(-(float)(j0 + i) * (13.287712379549449f / 16.0f)); const float rev = pf * inv * INV_2PI;
                            y[i] = x[i] * fcos_rev(rev) + (second ? pr : -pr) * fsin_rev(rev); }
                        else y[i] = x[i]; }
                    if (lane >= 48 && lane < 56) {
                        const int kk = 8 * q;
                        if (!smp) { float* o = args.out + OUT_CKR + (size_t)m * DROPE + kk; *(f32x4*)o = (f32x4){y[0], y[1], y[2], y[3]}; *(f32x4*)(o + 4) = (f32x4){y[4], y[5], y[6], y[7]}; }
                        v4u w; w.x = pk2(y[0], y[1]); w.y = pk2(y[2], y[3]); w.z = pk2(y[4], y[5]); w.w = pk2(y[6], y[7]);
                        bf16* kf = (bf16*)(ws + (smp ? WS_KF_S : WS_KF_P)); const int lk = smp ? LKS : LP;
#pragma unroll
                        for (int h = 0; h < NH; ++h) *(v4u*)(kf + ((size_t)(b * NH + h) * lk + key) * DQK + DNOPE + kk) = w;
                    }
                }
            } else {
                const int mm = m - MT, b = mm / PAST, j = mm % PAST;
                if (lane < 16) { const float* s = args.in[I_CKV] + (size_t)mm * KVL + 8 * lane;
                    v4u w; w.x = pk2(s[0], s[1]); w.y = pk2(s[2], s[3]); w.z = pk2(s[4], s[5]); w.w = pk2(s[6], s[7]); *(v4u*)(KVN + (size_t)m * 256 + 8 * lane) = w; }
                else if (lane < 24) { const int kk = 8 * (lane - 16); const float* s = args.in[I_CKR] + (size_t)mm * DROPE + kk;
                    v4u w; w.x = pk2(s[0], s[1]); w.y = pk2(s[2], s[3]); w.z = pk2(s[4], s[5]); w.w = pk2(s[6], s[7]);
                    bf16* kf = (bf16*)(ws + WS_KF_S);
#pragma unroll
                    for (int h = 0; h < NH; ++h) *(v4u*)(kf + ((size_t)(b * NH + h) * LKS + LS + j) * DQK + DNOPE + kk) = w; }
            }
        }
    }
    SEAM(3);

    if (IN(4)) {
        FRESH();
        asm volatile("; ==== PHASE 4 ====");
        int k256 = 256; asm volatile("" : "+s"(k256));
        { pg8::Gemm g{(const bf16*)(ws + WS_QN), (const bf16*)(ws + WS_QUP_T), MT, 768, k256}; pg8::StaticOrder S; S.init(MT, 768, G, bx);
          EpiStore E{(bf16*)(ws + WS_Q), 768};
          pg8::gemm_phase<EpiStore, pg8::StaticOrder, PG8_ALIGN, PG8_SP2>(lds, g, S, E, tid); }
        { int bx2 = (bx + 144) % G; asm volatile("" : "+s"(bx2)); const int lane2 = fresh_lane(); const int tid = wave * 64 + lane2;
          pg8::Gemm g{(const bf16*)(ws + WS_KVN), (const bf16*)(ws + WS_KVUP_T), MKV, 1024, k256}; pg8::StaticOrder S; S.init(MKV, 1024, G, bx2);
          EpiKV E{(bf16*)(ws + WS_KF_S), (bf16*)(ws + WS_KF_P), (bf16*)(ws + WS_V_S), (bf16*)(ws + WS_V_P)};
          pg8::gemm_phase<EpiKV, pg8::StaticOrder, PG8_ALIGN, PG8_SP2>(lds, g, S, E, tid); }
        { int bx3 = (bx + 88) % G; asm volatile("" : "+s"(bx3)); const int lane3 = fresh_lane(); const int tid = wave * 64 + lane3;
          pg8::Gemm g{(const bf16*)(ws + WS_W1T), (const bf16*)(ws + WS_CBD), DM, 2048, DM}; pg8::StaticOrder S; S.init(DM, 2048, G, bx3);
          EpiStore E{(bf16*)(ws + WS_WFOLD_T), 2048};
          pg8::gemm_phase<EpiStore, pg8::StaticOrder, PG8_ALIGN, PG8_SP2>(lds, g, S, E, tid); }
    }
    SEAM(4);

    if (IN(5)) {
        FRESH();
        asm volatile("; ==== PHASE 5 ====");
        constexpr int NA_S = 2 * BS * NH * (LS / 256), NC_S = HY / 4, NA_P = BP * NH, NC_P = HY / 2, NW_T = (WI_ALL - WI_L0) / 8, NITEM = NA_S + NC_S + NA_P + NC_P + NW_T;
        bf16* YM = HB;
        for (;;) {
            if (tid == 0) MISC[0] = __hip_atomic_fetch_add((unsigned*)(ctl + CW_Q + 64 * args.li), 1u, RLX_AGENT);
            __syncthreads();
            const int it = __builtin_amdgcn_readfirstlane((int)MISC[0]);
            __syncthreads();
            if (it >= NITEM) break;
            { const int cls = it < NA_S ? 0 : it < NA_S + NC_S ? 1 : it < NA_S + NC_S + NA_P ? 2 : it < NA_S + NC_S + NA_P + NC_P ? 3 : 4; if (!((args.mask >> cls) & 1)) continue; }
            const int lane = fresh_lane(); const int tid = wave * 64 + lane;
            const bool isA_S = it < NA_S, isA_P = (it >= NA_S + NC_S) && (it < NA_S + NC_S + NA_P);
            if (isA_S || isA_P) { if (!NO_ATT) {
                int b, h, row0, lk, pos0, koff = 0, nkeys; const bf16 *kf, *vv; float* part = nullptr; unsigned* cnt = nullptr;
                if (isA_S) { const int un = it >> 1, half = it & 1; b = un / (NH * 16); h = (un / 16) % NH; const int qb = un % 16; row0 = NP + b * LS + qb * 256; lk = LKS; pos0 = qb * 256; kf = (const bf16*)(ws + WS_KF_S); vv = (const bf16*)(ws + WS_V_S);
                    nkeys = LKS / 2; koff = half * (LKS / 2); part = (float*)(ws + WS_APART) + (size_t)un * APART_F; cnt = (unsigned*)(ctl + CW_ATT + args.li * 8192 + un * 64); }
                else { const int u = it - NA_S - NC_S; b = u / NH; h = u % NH; row0 = b * LP; lk = LP; pos0 = -1; kf = (const bf16*)(ws + WS_KF_P); vv = (const bf16*)(ws + WS_V_P); nkeys = LP; }
                att::attn_dense_body((const bf16*)(ws + WS_Q) + (size_t)row0 * 768 + h * DQK, kf + ((size_t)(b * NH + h) * lk + koff) * DQK, vv + ((size_t)(b * NH + h) * lk + koff) * DVH,
                                     YM + (size_t)row0 * DM + HY + h * DVH, nkeys, pos0, (LAS char*)lds, tid, part, cnt, MISC); }
            } else if (it < NA_S + NC_S) {
                hconv::item((const bf16*)(ws + WS_FT_S), (const bf16*)(ws + WS_UT_S), (const float*)(ws + WS_FPART_S), args.in[I_HFSKIP], (const bf16*)(ws + WS_X0), YM, (it - NA_S) * 4, lds, tid, lane, wave);
            } else if (it >= NA_S + NC_S + NA_P + NC_P) {
                LAS float* scr = (LAS float*)(lds + wave * 16384);
                weight_item(args, ws, scr, WI_L0 + (it - (NA_S + NC_S + NA_P + NC_P)) * 8 + wave, lane);
                __syncthreads();
            } else if (!NO_CONV) {
                const int ch0 = (it - NA_S - NC_S - NA_P) * 2;
                const float* FT = (const float*)(ws + WS_FT_P); const float* FP = (const float*)(ws + WS_FPART_P);
                const bf16* UT = (const bf16*)(ws + WS_UT_P);
                LAS float* Gs = (LAS float*)lds;
                LAS float* Us = (LAS float*)(lds + 8192);
                for (int q = tid; q < 2 * 512; q += 512) { const int cl = q >> 9, e = q & 511; if (e < 2 * LP - 1) { const int d = e - (LP - 1); const int ch = ch0 + cl;
                    Gs[cl * 576 + e + (e >> 4)] = d >= 0 ? FT[(size_t)ch * LP + d] : FT[(size_t)(512 + ch) * LP - d]; } }
                for (int q = tid; q < 2 * BP * LP / 8; q += 512) { const int cl = q >> 9, b = (q >> 5) & 15, l8 = (q & 31) * 8; const v4u v = *(const v4u*)(UT + ((size_t)b * 512 + ch0 + cl) * LP + l8);
                    LAS float* d = Us + (cl * BP + b) * LP + l8; d[0] = bf2f((unsigned short)(v.x & 0xffffu)); d[1] = bf2f((unsigned short)(v.x >> 16)); d[2] = bf2f((unsigned short)(v.y & 0xffffu)); d[3] = bf2f((unsigned short)(v.y >> 16));
                    d[4] = bf2f((unsigned short)(v.z & 0xffffu)); d[5] = bf2f((unsigned short)(v.z >> 16)); d[6] = bf2f((unsigned short)(v.w & 0xffffu)); d[7] = bf2f((unsigned short)(v.w >> 16)); }
                const int cl = tid >> 8, ch = ch0 + cl, b = (tid >> 4) & 15, t0 = (tid & 15) * 16;
                const float nsum = ((FP[ch * 4] + FP[ch * 4 + 1]) + (FP[ch * 4 + 2] + FP[ch * 4 + 3])) + ((FP[(512 + ch) * 4] + FP[(512 + ch) * 4 + 1]) + (FP[(512 + ch) * 4 + 2] + FP[(512 + ch) * 4 + 3]));
                const float inv_norm = 1.f / nsum, skip = args.in[I_HFSKIP][ch];
                const bf16* X0 = (const bf16*)(ws + WS_X0);
                float x0v[16];
#pragma unroll
                for (int i = 0; i < 16; ++i) x0v[i] = bf2f(X0[((size_t)b * LP + t0 + i) * 512 + ch]);
                __syncthreads();
                {
                    float y[16];
#pragma unroll
                    for (int i = 0; i < 16; ++i) y[i] = 0.f;
                    const LAS float* ub = Us + (cl * BP + b) * LP; const LAS float* gs = Gs + cl * 576;
                    for (int s0 = 0; s0 < LP; s0 += 16) {
                        const int base0 = t0 + LP - 1 - s0;
                        float W[31];
#pragma unroll
                        for (int j = 0; j < 31; ++j) { const int e = base0 - 15 + j; W[j] = gs[e + (e >> 4)]; }
#pragma unroll
                        for (int k = 0; k < 16; ++k) { const float uu = ub[s0 + k];
#pragma unroll
                            for (int i = 0; i < 16; ++i) y[i] += W[15 - k + i] * uu; }
                    }
#pragma unroll
                    for (int i = 0; i < 16; ++i) { const size_t row = (size_t)b * LP + t0 + i;
                        const float v = y[i] * inv_norm + skip * ub[t0 + i];
                        YM[row * DM + ch] = (bf16)f2bf(v * x0v[i]); }
                }
                __syncthreads();
            }
        }
    }
    SEAM(5);

    if (IN(6)) {
        FRESH();
        asm volatile("; ==== PHASE 6 ====");
        pg8::Gemm g{HB, (const bf16*)(ws + WS_WOUT0_T), MT, DM, DM}; pg8::StaticOrder S; S.init(MT, DM, G, bx);
        EpiRes E{args.in[I_XP], args.in[I_XS], MODS + 2 * 1024, T};
        pg8::gemm_phase<EpiRes, pg8::StaticOrder, PG8_ALIGN, PG8_SP2>(lds, g, S, E, tid);
    }
    SEAM(6);

    if (IN(7)) {
        FRESH();
        asm volatile("; ==== PHASE 7 ====");
        for (int m = gw; m < MT; m += NGW) {
            const float* md = MODS + (size_t)req_of_row(m) * 6144;
            f32x4 v[4]; load_row(T + (size_t)m * DM, lane, v); ln_affine(v, args.in[I_LN1G0], args.in[I_LN1B0], lane); store_row(X + (size_t)m * DM, lane, v);
            adaln_store(v, md + 3 * 1024, md + 4 * 1024, HB + (size_t)m * DM, lane);
        }
    }
    SEAM(7);

    if (IN(8)) {
        FRESH();
        asm volatile("; ==== PHASE 8 ====");
        pg8::Gemm g{HB, (const bf16*)(ws + WS_W1_0), MT, FF, DM}; pg8::StaticOrder S; S.init(MT, FF, G, bx);
        EpiUp E{(bf16*)(ws + WS_HID)};
        pg8::gemm_phase<EpiUp, pg8::StaticOrder, PG8_ALIGN, PG8_SP2>(lds, g, S, E, tid);
    }
    SEAM(8);

    if (IN(9)) {
        FRESH();
        asm volatile("; ==== PHASE 9 ====");
        pg8::Gemm g{(const bf16*)(ws + WS_HID), (const bf16*)(ws + WS_W2_0), MT, DM, FF}; pg8::StaticOrder S; S.init(MT, DM, G, bx);
        EpiRes E{X, X + (size_t)NP * DM, MODS + 5 * 1024, T};
        pg8::gemm_phase<EpiRes, pg8::StaticOrder, PG8_ALIGN, PG8_SP2>(lds, g, S, E, tid);
    }
    SEAM(9);

    if (IN(10)) {
        FRESH();
        asm volatile("; ==== PHASE 10 ====");
        const float* MODS1 = MODS + 3 * 6144;
        for (int it = bx; it < MT / 32; it += G) {
            const int m0 = it * 32; const bool smp = m0 >= NP; const int L = smp ? LS : LP; const int l0 = smp ? (m0 - NP) % LS : m0 % LP; const int seq = smp ? (m0 - NP) / LS : m0 / LP;
            LAS bf16* ht = (LAS bf16*)lds;
            const float* md = MODS1 + (size_t)req_of_row(m0) * 6144;
            for (int rr = 0; rr < 4; ++rr) { const int i = wave * 4 + rr, m = m0 + i;
                f32x4 v[4]; load_row(T + (size_t)m * DM, lane, v); ln_affine(v, args.in[I_LN2G0], args.in[I_LN2B0], lane); store_row(X + (size_t)m * DM, lane, v);
                float mean, rstd; row_stats(v, mean, rstd);
#pragma unroll
                for (int j = 0; j < 4; ++j) { const int c = 4 * lane + 256 * j; const f32x4 sc = *(const f32x4*)(md + 1024 + c), sh = *(const f32x4*)(md + c);
                    const f32x4 h = (v[j] - mean) * rstd * (sc + 1.0f) + sh;
#pragma unroll
                    for (int e = 0; e < 4; ++e) ht[(c + e) * 40 + i] = (bf16)f2bf(h[e]); }
            }
            __syncthreads();
            bf16* HT = HB + (smp ? (size_t)NP * DM + (size_t)seq * DM * LS : (size_t)seq * DM * LP) + l0;
            for (int q = tid; q < 1024 * 4; q += 512) { const int c = q >> 2, part = q & 3; const v4u v = *(const LAS v4u*)(ht + c * 40 + part * 8); *(v4u*)(HT + (size_t)c * L + part * 8) = v; }
            __syncthreads();
        }
        for (size_t i = gt; i < (size_t)LS * LS / 8; i += NGT) {
            const int rho = (int)(i >> 9), l8 = (int)(i & 511) * 8; const int k = rho > 2048 ? rho - 2048 : rho; unsigned w[4];
#pragma unroll
            for (int e = 0; e < 8; e += 2) { const float r0 = (float)((k * (l8 + e)) & 4095) * (1.f / 4096.f), r1 = (float)((k * (l8 + e + 1)) & 4095) * (1.f / 4096.f);
                const float a = (rho > 2048 ? __builtin_amdgcn_sinf(r0) : __builtin_amdgcn_cosf(r0)) * 0.015625f, b = (rho > 2048 ? __builtin_amdgcn_sinf(r1) : __builtin_amdgcn_cosf(r1)) * 0.015625f;
                w[e >> 1] = pk2(a, b); }
            ((v4u*)(ws + WS_D4096))[i] = (v4u){w[0], w[1], w[2], w[3]};
        }
    }
    SEAM(10);

    if (IN(11)) {
        FRESH();
        asm volatile("; ==== PHASE 11 ====");
        { pg8::Gemm g{(const bf16*)(ws + WS_D4096), HB + (size_t)NP * DM, LS, BS * DM, LS}; pg8::SplitOrder S; S.init(LS, BS * DM, LS, G, vcu, SLABS(200), SPLIT_CNT(3));
          EpiDft E{(bf16*)(ws + WS_UV), LS, NP};
          pg8::gemm_phase<EpiDft, pg8::SplitOrder, PG8_ALIGN, PG8_SP2>(lds, g, S, E, tid); }
        { int bx2 = (bx + 128) % G; asm volatile("" : "+s"(bx2)); const int lane2 = fresh_lane(); const int tid = wave * 64 + lane2;
          pg8::Gemm g{(const bf16*)(ws + WS_D256), HB, LP, BP * DM, LP}; pg8::StaticOrder S; S.init(LP, BP * DM, G, bx2);
          EpiDft E{(bf16*)(ws + WS_UV), LP, 0};
          pg8::gemm_phase<EpiDft, pg8::StaticOrder, PG8_ALIGN, PG8_SP2>(lds, g, S, E, tid); }
    }
    SEAM(11);

    if (IN(12)) {
        FRESH();
        asm volatile("; ==== PHASE 12 ====");
        pg8::Gemm g{(const bf16*)(ws + WS_UV), (const bf16*)(ws + WS_WFOLD_T), MT, DM, 2048}; pg8::StaticOrder S; S.init(MT, DM, G, bx);
        EpiRes E{X, X + (size_t)NP * DM, MODS + 3 * 6144 + 2 * 1024, T};
        pg8::gemm_phase<EpiRes, pg8::StaticOrder, PG8_ALIGN, PG8_SP2>(lds, g, S, E, tid);
    }
    SEAM(12);

    if (IN(13)) {
        FRESH();
        asm volatile("; ==== PHASE 13 ====");
        for (int m = gw; m < MT; m += NGW) {
            const float* md = MODS + 3 * 6144 + (size_t)req_of_row(m) * 6144;
            f32x4 v[4]; load_row(T + (size_t)m * DM, lane, v); ln_affine(v, args.in[I_LN1G1], args.in[I_LN1B1], lane); store_row(X + (size_t)m * DM, lane, v);
            adaln_store(v, md + 3 * 1024, md + 4 * 1024, HB + (size_t)m * DM, lane);
        }
    }
    SEAM(13);

    if (IN(14)) {
        FRESH();
        asm volatile("; ==== PHASE 14 ====");
        pg8::Gemm g{HB, (const bf16*)(ws + WS_W1_1), MT, FF, DM}; pg8::StaticOrder S; S.init(MT, FF, G, bx);
        EpiUp E{(bf16*)(ws + WS_HID)};
        pg8::gemm_phase<EpiUp, pg8::StaticOrder, PG8_ALIGN, PG8_SP2>(lds, g, S, E, tid);
    }
    SEAM(14);

    if (IN(15)) {
        FRESH();
        asm volatile("; ==== PHASE 15 ====");
        pg8::Gemm g{(const bf16*)(ws + WS_HID), (const bf16*)(ws + WS_W2_1), MT, DM, FF}; pg8::StaticOrder S; S.init(MT, DM, G, bx);
        EpiRes E{X, X + (size_t)NP * DM, MODS + 3 * 6144 + 5 * 1024, T};
        pg8::gemm_phase<EpiRes, pg8::StaticOrder, PG8_ALIGN, PG8_SP2>(lds, g, S, E, tid);
    }
    SEAM(15);

    if (IN(16)) {
        FRESH();
        asm volatile("; ==== PHASE 16 ====");
        for (int m = gw; m < MT; m += NGW) {
            f32x4 v[4]; load_row(T + (size_t)m * DM, lane, v); ln_affine(v, args.in[I_LN2G1], args.in[I_LN2B1], lane); store_row(X + (size_t)m * DM, lane, v);
        }
    }
#undef IN
#undef SEAM
}

extern "C" void kernel_launch(void* const* d_in, const int* in_sizes, int n_in, void* d_out, int out_size, void* d_ws, size_t ws_size, hipStream_t stream) {
    static int grid = 0;
    if (grid == 0) {
        if (n_in != 38 || ws_size < WS_END) { fprintf(stderr, "kernel_launch: expected 38 inputs and >= %zu bytes of workspace; got %d, %zu\n", (size_t)WS_END, n_in, ws_size); grid = -1; return; }
        int dev = 0, cus = 0;
        if (hipGetDevice(&dev) != hipSuccess || hipDeviceGetAttribute(&cus, hipDeviceAttributeMultiprocessorCount, dev) != hipSuccess) { grid = -1; return; }
        if (hipFuncSetAttribute((const void*)fwd_kernel, hipFuncAttributeMaxDynamicSharedMemorySize, LDS_BYTES) != hipSuccess) { fprintf(stderr, "kernel_launch: hipFuncSetAttribute failed\n"); grid = -1; return; }
        int per_cu = 0;
        if (hipOccupancyMaxActiveBlocksPerMultiprocessor(&per_cu, (const void*)fwd_kernel, 512, LDS_BYTES) != hipSuccess || per_cu < 1) fprintf(stderr, "kernel_launch: occupancy query reports %d\n", per_cu);
        (void)hipGetLastError();
        grid = cus;
    }
    if (grid < 0) return;
    (void)hipMemsetAsync((char*)d_ws + WS_CTL, 0, CTL_ZERO_BYTES, stream);
    Args a{};
    for (int i = 0; i < 38; ++i) a.in[i] = (const float*)d_in[i];
    a.out = (float*)d_out; a.ws = (unsigned char*)d_ws;
#if MK_PER_PHASE
    for (int p = 0; p < NPHASE; ++p) { a.ph_lo = p; a.ph_hi = p + 1; a.li = 0; a.mask = 31; hipLaunchKernelGGL(fwd_kernel, dim3(grid), dim3(512), LDS_BYTES, stream, a); }
#elif defined(PROBE_A)
#ifndef PROBE_MASK5
#define PROBE_MASK5 31
#endif
    a.mask = 31; a.ph_lo = 0; a.ph_hi = PROBE_B; a.li = 0; hipLaunchKernelGGL(fwd_kernel, dim3(grid), dim3(512), LDS_BYTES, stream, a);
    a.mask = PROBE_MASK5; a.ph_lo = PROBE_A; a.ph_hi = NPHASE; a.li = 1; hipLaunchKernelGGL(fwd_kernel, dim3(grid), dim3(512), LDS_BYTES, stream, a);
#else
    a.ph_lo = 0; a.ph_hi = NPHASE; a.li = 0; a.mask = 31;
    hipLaunchKernelGGL(fwd_kernel, dim3(grid), dim3(512), LDS_BYTES, stream, a);
#endif
    const hipError_t le = hipPeekAtLastError();
    if (le != hipSuccess) fprintf(stderr, "kernel_launch: launch failed: %s\n", hipGetErrorName(le));
}
```

```cpp
#include <hip/hip_runtime.h>
#include <hip/hip_bf16.h>
#include <cstdio>
#include <cstdint>
#include <cmath>
namespace pg8 {
#define PG8_LAS __attribute__((address_space(3)))
typedef unsigned short bf16_t;
typedef short bf16x8 __attribute__((ext_vector_type(8)));
typedef float f32x4 __attribute__((ext_vector_type(4)));
typedef unsigned u32x4 __attribute__((ext_vector_type(4)));
constexpr int BM = 256, BK = 64, HALF = 128, HTB = HALF * BK * 2  , STAGE_BYTES = 8 * HTB, NXCD = 8, WGM = 8;

__host__ __device__ __forceinline__ int lds_byte(int r, int c) { const int st = (r >> 4) * 2 + (c >> 5), rr = r & 15, cc = c & 31, ob = rr * 64 + cc * 2; return st * 1024 + (ob ^ (((ob >> 9) & 1) << 5)); }
__host__ __device__ __forceinline__ void stage_rc(int b, int& R, int& C) { const int st = b / 1024, sb = b % 1024, swz = sb ^ (((sb >> 9) & 1) << 5); R = (st >> 1) * 16 + swz / 64; C = (st & 1) * 32 + (swz % 64) / 2; }
__host__ __device__ __forceinline__ int perm32(int rho) { const int n = rho >> 4, i = rho & 15; return 8 * (i >> 2) + 4 * n + (i & 3); }

struct Unit { int pm, pn; int k0, nt, mode, slab, need, tile; };
struct Gemm { const bf16_t* A; const bf16_t* Bt; int M, N, K; };

struct StaticOrder {
    int nM, nN, nwg, G, c;
    __host__ __device__ void init(int M, int N, int G_, int c_) { nM = M / BM; nN = N / BM; nwg = nM * nN; G = G_; c = c_; }
    __host__ __device__ bool next(int i, Unit& u) const {
        const long L = (long)i * G + c; if (L >= nwg) return false;
        int wgid = (int)L; { const int q = nwg / NXCD, r = nwg % NXCD, xcd = wgid % NXCD, off = wgid / NXCD; wgid = (xcd < r ? xcd * (q + 1) : r * (q + 1) + (xcd - r) * q) + off; }
        const int nig = WGM * nN, gid = wgid / nig, fm = gid * WGM, gsz = (nM - fm) < WGM ? (nM - fm) : WGM;
        u.pm = fm + ((wgid % nig) % gsz); u.pn = (wgid % nig) / gsz; u.k0 = 0; u.nt = 0; u.mode = 0; u.slab = 0; u.need = 0; u.tile = 0; return true;
    }
    static constexpr bool SPLIT = false;
    __device__ __forceinline__ void a_ready(const Unit&) const {}
    __device__ __forceinline__ void done(const Unit&) const {}
};

struct SplitOrder {
    static constexpr bool SPLIT = true;
    int nM, nN, NT, per, c, lo, hi, tf, ns, give_last, P; float* slabs; unsigned* cnt;
    __device__ __forceinline__ void init(int M, int N, int K, int G_, int c_, float* slabs_, unsigned* cnt_) {
        nM = M / BM; nN = N / BM; NT = K / BK; c = c_; slabs = slabs_; cnt = cnt_;
        const int TU = nM * nN * NT; per = (TU + G_ - 1) / G_; per += per & 1;
        lo = c * per; hi = lo + per < TU ? lo + per : TU; if (lo >= TU) { lo = 0; hi = 0; }
        tf = lo / NT; ns = hi > lo ? (hi - 1) / NT - tf + 1 : 0; give_last = (hi % NT) != 0 ? 1 : 0;
        int a = per, b = NT; while (b) { const int t = a % b; a = b; b = t; } P = NT / a;
    }
    __device__ __forceinline__ int giver_index(int j) const { return j - j / P; }
    __device__ __forceinline__ bool next(int i, Unit& u) const {
        if (i >= ns) return false;
        int sidx; if (ns == 1) sidx = 0; else if (give_last && i == 0) sidx = ns - 1; else if (i == ns - 1) sidx = 0; else sidx = i - give_last + 1;
        const int T = tf + sidx, tlo = T * NT, thi = tlo + NT; const int a = lo > tlo ? lo : tlo, b = hi < thi ? hi : thi;
        const int nig = WGM * nN, gid = T / nig, fm = gid * WGM, gsz = (nM - fm) < WGM ? (nM - fm) : WGM;
        u.pm = fm + ((T % nig) % gsz); u.pn = (T % nig) / gsz; u.k0 = a - tlo; u.nt = b - a; u.tile = T;
        if (b != thi) { u.mode = 1; u.slab = giver_index(c); u.need = 0; }
        else if (a != tlo) { const int c0 = tlo / per; u.mode = 2; u.slab = giver_index(c0); u.need = c - c0; }
        else { u.mode = 0; u.slab = 0; u.need = 0; }
        return true;
    }
    __device__ __forceinline__ void a_ready(const Unit&) const {}
    __device__ __forceinline__ void done(const Unit&) const {}
};
__device__ __forceinline__ unsigned cvt_pk_bf16(float lo, float hi) { unsigned r; asm volatile("v_cvt_pk_bf16_f32 %0, %1, %2" : "=v"(r) : "v"(lo), "v"(hi)); return r; }
template <class Epi, class Sched, bool ALIGN_EPI = false, bool SP2 = false, int MF = 4>
__device__ __forceinline__ void gemm_phase(PG8_LAS unsigned char* lds, const Gemm g, const Sched& S, const Epi& E, const int tid) {
    const int wid = __builtin_amdgcn_readfirstlane(tid >> 6), lane = tid & 63, wr = wid >> 2, wc = wid & 3, fr = lane & 15, fq = lane >> 4;
    const int K = g.K, nt = K / BK;
    unsigned voffA[2], voffB[2];
#pragma unroll
    for (int i = 0; i < 2; ++i) { int R, C; stage_rc(tid * 16 + i * 8192, R, C); const int Rb = Epi::PERM ? ((R & ~31) + perm32(R & 31)) : R;
        voffA[i] = (unsigned)(R * K + C) * 2u; voffB[i] = (unsigned)(Rb * K + C) * 2u; }
    const size_t kstep = (size_t)(BK * 2);
    const size_t hstepB = (size_t)HALF * K * 2, tstepB = 2 * hstepB;
    const size_t hstepA = (size_t)(32 * MF) * K * 2, tstepA = 2 * hstepA;
    const unsigned ldsw = (unsigned)wid * 1024u;
    const int aoff = lds_byte(wr * (16 * MF) + fr, fq * 8), boff = lds_byte(wc * 32 + fr, fq * 8);
#define PG8_SA(b, h) (((b) * 2 + (h)) * HTB)
#define PG8_SB(b, h) ((4 + (b) * 2 + (h)) * HTB)
#define PG8_STAGE(bufoff, gbase, voff) do { _Pragma("unroll") for (int _i = 0; _i < 2; ++_i) \
        __builtin_amdgcn_global_load_lds((const unsigned*)((const char*)(gbase) + (voff)[_i]), (PG8_LAS unsigned*)(lds + (bufoff) + ldsw + _i * 8192), 16, 0, 0); } while (0)
#define PG8_LDA(dst, b, h) do { _Pragma("unroll") for (int m = 0; m < MF; ++m) _Pragma("unroll") for (int k = 0; k < 2; ++k) dst[m][k] = *(const PG8_LAS bf16x8*)(lds + PG8_SA(b, h) + aoff + m * 2048 + k * 1024); } while (0)
#define PG8_LDB(dst, b, h) do { _Pragma("unroll") for (int n = 0; n < 2; ++n) _Pragma("unroll") for (int k = 0; k < 2; ++k) dst[n][k] = *(const PG8_LAS bf16x8*)(lds + PG8_SB(b, h) + boff + n * 2048 + k * 1024); } while (0)
#define PG8_MMA(ai, bj, At, Bt) do { __builtin_amdgcn_s_setprio(1); _Pragma("unroll") for (int m = 0; m < MF; ++m) _Pragma("unroll") for (int n = 0; n < 2; ++n) _Pragma("unroll") for (int k = 0; k < 2; ++k) \
        acc[ai][bj][m][n] = __builtin_amdgcn_mfma_f32_16x16x32_bf16(Bt[n][k], At[m][k], acc[ai][bj][m][n], 0, 0, 0); __builtin_amdgcn_s_setprio(0); } while (0)
#define PG8_WAIT_V(n) asm volatile("s_waitcnt vmcnt(" #n ")" ::: "memory")
#define PG8_WAIT_L(n) asm volatile("s_waitcnt lgkmcnt(" #n ")" ::: "memory")
#define PG8_BAR __builtin_amdgcn_s_barrier()
#define PG8_SCHED __builtin_amdgcn_sched_barrier(0)
    Unit cur, nxt; int ui = 0;
    if (!S.next(0, cur)) return;
    f32x4 acc[2][2][4][2];
#pragma unroll
    for (int a = 0; a < 2; ++a)
#pragma unroll
        for (int b = 0; b < 2; ++b)
#pragma unroll
            for (int m = 0; m < 4; ++m)
#pragma unroll
                for (int n = 0; n < 2; ++n) acc[a][b][m][n] = (f32x4){0.f, 0.f, 0.f, 0.f};
    bf16x8 At[4][2], B0[2][2], B1[2][2];
    const char* cA = (const char*)g.A + (size_t)cur.pm * tstepA + (size_t)cur.k0 * kstep; const char* cB = (const char*)g.Bt + (size_t)cur.pn * tstepB + (size_t)cur.k0 * kstep;
    S.a_ready(cur);
    if constexpr (SP2) {
        PG8_STAGE(PG8_SB(0, 0), cB, voffB); PG8_STAGE(PG8_SB(0, 1), cB + hstepB, voffB); PG8_STAGE(PG8_SA(0, 0), cA, voffA); PG8_STAGE(PG8_SA(0, 1), cA + hstepA, voffA);
        if (wr == 1) PG8_BAR;
        PG8_WAIT_V(2); PG8_BAR;
        PG8_STAGE(PG8_SB(1, 0), cB + kstep, voffB); PG8_STAGE(PG8_SA(1, 0), cA + kstep, voffA); PG8_STAGE(PG8_SB(1, 1), cB + hstepB + kstep, voffB);
        PG8_WAIT_V(6); PG8_BAR;
    } else {
        PG8_STAGE(PG8_SB(0, 0), cB, voffB); PG8_STAGE(PG8_SA(0, 0), cA, voffA); PG8_STAGE(PG8_SB(0, 1), cB + hstepB, voffB); PG8_STAGE(PG8_SA(0, 1), cA + hstepA, voffA);
        if (wr == 1) PG8_BAR;
        PG8_WAIT_V(4); PG8_BAR;
        PG8_STAGE(PG8_SB(1, 0), cB + kstep, voffB); PG8_STAGE(PG8_SA(1, 0), cA + kstep, voffA); PG8_STAGE(PG8_SB(1, 1), cB + hstepB + kstep, voffB);
        PG8_WAIT_V(6); PG8_BAR;
    }
    for (;;) {
        const bool has_next = S.next(ui + 1, nxt);
        const char* nA = has_next ? (const char*)g.A + (size_t)nxt.pm * tstepA + (size_t)nxt.k0 * kstep : cA; const char* nB = has_next ? (const char*)g.Bt + (size_t)nxt.pn * tstepB + (size_t)nxt.k0 * kstep : cB;
        const int ntc = cur.nt ? cur.nt : nt;
        for (int t = 0; t < ntc; t += 2) {
            const bool last = (t == ntc - 2);
            const char* a1 = cA + (size_t)(t + 1) * kstep;
            const char* a2 = last ? nA : cA + (size_t)(t + 2) * kstep; const char* b2 = last ? nB : cB + (size_t)(t + 2) * kstep;
            const char* a3 = a2 + kstep; const char* b3 = b2 + kstep;
            if (last && has_next) S.a_ready(nxt);
            if constexpr (SP2) {
            PG8_LDB(B0, 0, 0); PG8_LDB(B1, 0, 1); PG8_SCHED; PG8_LDA(At, 0, 0); PG8_STAGE(PG8_SA(1, 1), a1 + hstepA, voffA);
            PG8_WAIT_V(8); PG8_WAIT_L(0); PG8_BAR; PG8_MMA(0, 0, At, B0); PG8_MMA(0, 1, At, B1); PG8_BAR; PG8_SCHED;
            PG8_LDA(At, 0, 1); PG8_STAGE(PG8_SB(0, 0), b2, voffB); PG8_STAGE(PG8_SB(0, 1), b2 + hstepB, voffB); PG8_STAGE(PG8_SA(0, 0), a2, voffA);
            PG8_WAIT_V(8); PG8_WAIT_L(0); PG8_BAR; PG8_MMA(1, 0, At, B0); PG8_MMA(1, 1, At, B1); PG8_BAR; PG8_SCHED;
            PG8_LDB(B0, 1, 0); PG8_LDB(B1, 1, 1); PG8_SCHED; PG8_LDA(At, 1, 0); PG8_STAGE(PG8_SA(0, 1), a2 + hstepA, voffA);
            PG8_WAIT_V(8); PG8_WAIT_L(0); PG8_BAR; PG8_MMA(0, 0, At, B0); PG8_MMA(0, 1, At, B1); PG8_BAR; PG8_SCHED;
            PG8_LDA(At, 1, 1); PG8_STAGE(PG8_SB(1, 0), b3, voffB); PG8_STAGE(PG8_SB(1, 1), b3 + hstepB, voffB); PG8_STAGE(PG8_SA(1, 0), a3, voffA);
            PG8_WAIT_V(8); PG8_WAIT_L(0); PG8_BAR; PG8_MMA(1, 0, At, B0); PG8_MMA(1, 1, At, B1); PG8_BAR; PG8_SCHED;
            } else {
            PG8_LDB(B0, 0, 0); PG8_SCHED; PG8_LDA(At, 0, 0); PG8_STAGE(PG8_SA(1, 1), a1 + hstepA, voffA);
            PG8_WAIT_L(8); PG8_BAR; PG8_WAIT_L(0); PG8_MMA(0, 0, At, B0); PG8_BAR; PG8_SCHED;
            PG8_LDB(B1, 0, 1); PG8_STAGE(PG8_SB(0, 0), b2, voffB);
            PG8_BAR; PG8_WAIT_L(0); PG8_MMA(0, 1, At, B1); PG8_BAR;
            PG8_LDA(At, 0, 1); PG8_STAGE(PG8_SA(0, 0), a2, voffA);
            PG8_BAR; PG8_WAIT_L(0); PG8_MMA(1, 0, At, B0); PG8_BAR; PG8_SCHED;
            PG8_STAGE(PG8_SB(0, 1), b2 + hstepB, voffB);
            PG8_WAIT_V(6); PG8_BAR; PG8_MMA(1, 1, At, B1); PG8_BAR;
            PG8_LDB(B0, 1, 0); PG8_SCHED; PG8_LDA(At, 1, 0); PG8_STAGE(PG8_SA(0, 1), a2 + hstepA, voffA);
            PG8_WAIT_L(8); PG8_BAR; PG8_WAIT_L(0); PG8_MMA(0, 0, At, B0); PG8_BAR; PG8_SCHED;
            PG8_LDB(B1, 1, 1); PG8_STAGE(PG8_SB(1, 0), b3, voffB);
            PG8_BAR; PG8_WAIT_L(0); PG8_MMA(0, 1, At, B1); PG8_BAR;
            PG8_LDA(At, 1, 1); PG8_STAGE(PG8_SA(1, 0), a3, voffA);
            PG8_BAR; PG8_WAIT_L(0); PG8_MMA(1, 0, At, B0); PG8_BAR; PG8_SCHED;
            PG8_STAGE(PG8_SB(1, 1), b3 + hstepB, voffB);
            PG8_WAIT_V(6); PG8_BAR; PG8_MMA(1, 1, At, B1); PG8_BAR;
            }
        }
        if constexpr (ALIGN_EPI) { if (wr == 0) PG8_BAR; }
        if constexpr (!Epi::AFTER_DRAIN) {
            Unit eu = cur; eu.pm = __builtin_amdgcn_readfirstlane(cur.pm); eu.pn = __builtin_amdgcn_readfirstlane(cur.pn); eu.slab = __builtin_amdgcn_readfirstlane(cur.slab); eu.tile = __builtin_amdgcn_readfirstlane(cur.tile);
            eu.need = __builtin_amdgcn_readfirstlane(cur.need); eu.mode = __builtin_amdgcn_readfirstlane(cur.mode);
            asm volatile("" : "+s"(eu.pm), "+s"(eu.pn), "+s"(eu.slab), "+s"(eu.tile), "+s"(eu.need), "+s"(eu.mode));
            if constexpr (Sched::SPLIT) {
                if (eu.mode == 1) {
                    const float* sp = S.slabs + (size_t)eu.slab * 65536 + wid * 8192 + lane * 4;
#pragma unroll
                    for (int a = 0; a < 2; ++a)
#pragma unroll
                        for (int b = 0; b < 2; ++b)
#pragma unroll
                            for (int m = 0; m < 4; ++m)
#pragma unroll
                                for (int n = 0; n < 2; ++n) { const f32x4 v = acc[a][b][m][n]; const float* p = sp + (((a * 2 + b) * 4 + m) * 2 + n) * 256;
                                    asm volatile("global_store_dwordx4 %0, %1, off sc1\n\ts_nop 1" :: "v"(p), "v"(v) : "memory"); }
                    asm volatile("s_waitcnt vmcnt(0)" ::: "memory");
                    if (lane == 0) __hip_atomic_fetch_add(S.cnt + eu.tile * 32, 1u, __ATOMIC_RELAXED, __HIP_MEMORY_SCOPE_AGENT);
                } else if (eu.mode == 2) {
                    unsigned sp_ = 0;
                    while ((unsigned)__builtin_amdgcn_readfirstlane(__hip_atomic_load(S.cnt + eu.tile * 32, __ATOMIC_RELAXED, __HIP_MEMORY_SCOPE_AGENT)) < 8u) { __builtin_amdgcn_s_sleep(8); if (++sp_ > (1u << 20)) break; }
                    __builtin_amdgcn_fence(__ATOMIC_ACQUIRE, "agent");
                    E.template run<true>(acc, eu, wr, wc, fr, fq, S.slabs + (size_t)eu.slab * 65536 + wid * 8192 + lane * 4);
                } else E.template run<false>(acc, eu, wr, wc, fr, fq, nullptr);
            } else E.template run<false>(acc, eu, wr, wc, fr, fq, nullptr);
            S.done(cur); }
        if (!has_next) break;
#pragma unroll
        for (int a = 0; a < 2; ++a)
#pragma unroll
            for (int b = 0; b < 2; ++b)
#pragma unroll
                for (int m = 0; m < 4; ++m)
#pragma unroll
                    for (int n = 0; n < 2; ++n) acc[a][b][m][n] = (f32x4){0.f, 0.f, 0.f, 0.f};
        cur = nxt; cA = nA; cB = nB; ++ui;
        if constexpr (ALIGN_EPI) { if (wr == 1) PG8_BAR; }
    }
    PG8_WAIT_V(0);
    if constexpr (!ALIGN_EPI) { if (wr == 0) PG8_BAR; }
    PG8_BAR;
    if constexpr (Epi::AFTER_DRAIN) { E.fused(acc, cur, wr, wc, fr, fq, lds, wid, lane); S.done(cur); }
#undef PG8_SA
#undef PG8_SB
#undef PG8_STAGE
#undef PG8_LDA
#undef PG8_LDB
#undef PG8_MMA
#undef PG8_WAIT_V
#undef PG8_WAIT_L
#undef PG8_BAR
#undef PG8_SCHED
}
}
#ifndef PG8_SP2
#define PG8_SP2 true
#endif
#ifndef PG8_ALIGN
#define PG8_ALIGN true
#endif
#ifndef MK_PER_PHASE
#define MK_PER_PHASE 0
#endif

constexpr int DM = 1024, FF = 4096;
constexpr int LP = 256, BP = 16, LS = 4096, BS = 2, PAST = 256;
constexpr int NP = BP * LP;
constexpr int NSR = BS * LS;
constexpr int MT = NP + NSR;
constexpr int MKV = MT + BS * PAST;
constexpr int LKS = LS + PAST;
constexpr int HY = 512, NH = 4, DQK = 192, DNOPE = 128, DROPE = 64, DVH = 128, QL = 256, KVL = 128;
constexpr int WINP = 2048;
constexpr float LN_EPS = 1e-5f, RMS_EPS = 1e-6f, ALPHA = 1.41421356237309515f;
constexpr int NPHASE = 17;

constexpr int att_shm_bytes = 2 * 16384 + 2 * 24576 + 2048 + 8 * 8 * 1024;
constexpr size_t MiB = 1u << 20, KiB = 1024;
constexpr size_t WS_CTL = 0, CTL_ZERO_BYTES = 1 * MiB;
constexpr size_t WS_MODS = 1 * MiB;
constexpr size_t WS_D256 = 1 * MiB + 256 * KiB;
constexpr size_t WS_H2 = 1 * MiB + 512 * KiB;
constexpr size_t WS_FPART_S = 3 * MiB;
constexpr size_t WS_FPART_P = 3 * MiB + 256 * KiB;
constexpr size_t WS_WIN_T = 4 * MiB, WS_QUP_T = 8 * MiB, WS_KVUP_T = 8 * MiB + 512 * KiB, WS_WOUT0_T = 9 * MiB;
constexpr size_t WS_W1_0 = 11 * MiB, WS_W2_0 = 19 * MiB, WS_W1_1 = 27 * MiB, WS_W2_1 = 35 * MiB, WS_WFOLD_T = 43 * MiB;
constexpr size_t WS_T = 48 * MiB;
constexpr size_t WS_FT_S = 48 * MiB, WS_FT_P = 64 * MiB, WS_UT_S = 65 * MiB, WS_UT_P = 73 * MiB;
constexpr size_t WS_W1T = 80 * MiB, WS_CBD = 82 * MiB;
constexpr size_t WS_D4096 = 96 * MiB;
constexpr size_t WS_KF_S = 96 * MiB, WS_KF_P = 109 * MiB, WS_V_S = 115 * MiB, WS_V_P = 124 * MiB;
constexpr size_t WS_H = 128 * MiB;
constexpr size_t WS_P = 152 * MiB, WS_ZS = 188 * MiB, WS_QN = 212 * MiB, WS_KVN = 218 * MiB, WS_Q = 225 * MiB, WS_X0 = 243 * MiB;
constexpr size_t WS_HID = 152 * MiB, WS_UV = 152 * MiB;
constexpr size_t WS_END = 256 * MiB;
constexpr int CW_TMO = 0, CW_Q = 64, CW_BAR = 4096, CW_ATT = 16384, CW_SPLIT = 32768;
constexpr size_t WS_APART = 152 * MiB; constexpr int APART_F = 8 * 4 * 16 * 64 + 8 * 128;

constexpr int RING_BYTES = 131072, LDSCTL_OFF = 160 * 1024 - 512, MISC_OFF = LDSCTL_OFF + 320, LDS_BYTES = 160 * 1024;
static_assert(att_shm_bytes <= LDSCTL_OFF, "attention scratch fits below the LDS control words");

#define GAS __attribute__((address_space(1)))
#define LAS __attribute__((address_space(3)))
typedef unsigned short bf16;
typedef unsigned v4u __attribute__((ext_vector_type(4)));
typedef unsigned v2u __attribute__((ext_vector_type(2)));
typedef float f32x4 __attribute__((ext_vector_type(4)));
typedef GAS unsigned gu32;
#define RLX_AGENT __ATOMIC_RELAXED, __HIP_MEMORY_SCOPE_AGENT
#define LDS_WAIT() asm volatile("s_waitcnt lgkmcnt(0)" ::: "memory")
__device__ __forceinline__ unsigned f2bf(float f) { unsigned u = __builtin_bit_cast(unsigned, f); return (u + 0x7fffu + ((u >> 16) & 1u)) >> 16; }
__device__ __forceinline__ unsigned pk2(float lo, float hi) { return f2bf(lo) | (f2bf(hi) << 16); }
__device__ __forceinline__ float bf2f(unsigned short b) { return __builtin_bit_cast(float, (unsigned)b << 16); }
__device__ __forceinline__ float wave_sum(float v) {
#pragma unroll
    for (int o = 1; o < 64; o <<= 1) v += __shfl_xor(v, o);
    return v;
}
__device__ __forceinline__ float fsin_rev(float rev) { return __builtin_amdgcn_sinf(__builtin_amdgcn_fractf(rev)); }
__device__ __forceinline__ float fcos_rev(float rev) { return __builtin_amdgcn_cosf(__builtin_amdgcn_fractf(rev)); }
constexpr float INV_2PI = 0.15915494309189535f;
__device__ __forceinline__ float fexp(float x) { return __builtin_amdgcn_exp2f(x * 1.4426950408889634f); }

__device__ __forceinline__ int fresh_lane() { int l; asm volatile("v_mbcnt_lo_u32_b32 %0, -1, 0\n\tv_mbcnt_hi_u32_b32 %0, -1, %0" : "=v"(l)); return l; }
#define XB_TMO      128
#define XB_XCNT(j)  (256  + 64 * (j))
#define XB_XSUB(j)  (1280 + 64 * (j))
#define XB_XGEN(j)  (2304 + 64 * (j))
#define XB_TOP      3328
#define XB_TOPGEN   3392
#define XCD_BAR_WORDS 3456
#define XB_SPIN_CAP (1u << 23)
__device__ __forceinline__ unsigned xb_ld(unsigned* p)              { return __hip_atomic_load(p, __ATOMIC_RELAXED, __HIP_MEMORY_SCOPE_AGENT); }
__device__ __forceinline__ unsigned xb_add(unsigned* p, unsigned v) { return __hip_atomic_fetch_add(p, v, __ATOMIC_RELAXED, __HIP_MEMORY_SCOPE_AGENT); }
__device__ __forceinline__ unsigned xb_xcc_id() { return (unsigned)__builtin_amdgcn_s_getreg((3 << 11) | 20) & 0xFu; }
#define XB_SPIN(cond, bar) do { unsigned _sp = 0; while (cond) { __builtin_amdgcn_s_sleep(1); \
    if ((++_sp & 255u) == 0u) { if (xb_ld(&(bar)[XB_TMO])) break; if (_sp > XB_SPIN_CAP) { atomicAdd(&(bar)[XB_TMO], 1u); break; } } } } while (0)
struct XcdBarrier { unsigned* bar; unsigned x; volatile LAS unsigned* st; };
__device__ __forceinline__ XcdBarrier xcd_barrier_post(unsigned* bar, volatile LAS unsigned* st) {
    XcdBarrier b; b.bar = bar; b.x = xb_xcc_id(); b.st = st;
    if (threadIdx.x == 0) (void)xb_add(&bar[XB_XCNT(b.x)], 1u);
    return b;
}
__device__ __forceinline__ void xcd_barrier_complete(unsigned* bar, unsigned x, unsigned& nloc, unsigned& nx) {
    const unsigned G = gridDim.x * gridDim.y * gridDim.z;
    unsigned sum, cnt, mine, sp = 0u;
    for (;;) {
        sum = 0u; cnt = 0u; mine = 0u;
#pragma unroll
        for (unsigned j = 0; j < 16; ++j) { const unsigned c = xb_ld(&bar[XB_XCNT(j)]); sum += c; cnt += (c > 0u) ? 1u : 0u; mine = (j == x) ? c : mine; }
        if (sum == G) break;
        __builtin_amdgcn_s_sleep(1);
        if ((++sp & 255u) == 0u) { if (xb_ld(&bar[XB_TMO])) break; if (sp > XB_SPIN_CAP) { atomicAdd(&bar[XB_TMO], 1u); break; } }
    }
    nloc = mine > 0u ? mine : 1u; nx = cnt > 0u ? cnt : 1u;
}
__device__ __forceinline__ void xcd_barrier(const XcdBarrier& b) {
    asm volatile("s_waitcnt vmcnt(0)" ::: "memory");
    __syncthreads();
    if (threadIdx.x == 0) {
        unsigned* bar = b.bar;
        __builtin_amdgcn_s_waitcnt(0);
        unsigned nloc = b.st[0], nx = b.st[1];
        if (nloc == 0u) { xcd_barrier_complete(bar, b.x, nloc, nx); b.st[0] = nloc; b.st[1] = nx; }
        const unsigned old = xb_add(&bar[XB_XSUB(b.x)], 1u);
        const unsigned gen = old / nloc;
        if (old + 1u == (gen + 1u) * nloc) {
            __builtin_amdgcn_fence(__ATOMIC_RELEASE, "agent");
            asm volatile("s_waitcnt vmcnt(0)" ::: "memory");
            const unsigned og = xb_add(&bar[XB_TOP], 1u);
            const unsigned tg = og / nx;
            if (og + 1u == (tg + 1u) * nx) xb_add(&bar[XB_TOPGEN], 1u);
            else XB_SPIN(xb_ld(&bar[XB_TOPGEN]) == tg, bar);
            __builtin_amdgcn_fence(__ATOMIC_ACQUIRE, "agent");
            xb_add(&bar[XB_XGEN(b.x)], 1u);
            asm volatile("s_waitcnt vmcnt(0)" ::: "memory");
        } else {
            XB_SPIN(xb_ld(&bar[XB_XGEN(b.x)]) == gen, bar);
            __builtin_amdgcn_fence(__ATOMIC_ACQUIRE, "agent");
            asm volatile("s_waitcnt vmcnt(0)" ::: "memory");
        }
    }
    __syncthreads();
}

struct Args { const float* in[38]; float* out; unsigned char* ws; int ph_lo, ph_hi, li, mask; };
enum { I_XP = 0, I_XS, I_CKV, I_CKR, I_C, I_CCTX, I_ADA0_W, I_ADA0_B, I_WIN, I_CONVW, I_CONVB, I_HFW1, I_HFB1, I_HFFREQ, I_HFW2, I_HFB2, I_HFW3, I_HFSKIP,
       I_QNORM, I_QUP, I_KVNORM, I_KVUP, I_WOUT0, I_LN1G0, I_LN1B0, I_W1_0, I_W2_0, I_LN2G0, I_LN2B0, I_ADA1_W, I_ADA1_B, I_WOUT1, I_LN1G1, I_LN1B1, I_W1_1, I_W2_1, I_LN2G1, I_LN2B1 };
constexpr size_t OUT_CKV = (size_t)MT * DM, OUT_CKR = OUT_CKV + (size_t)NP * KVL;

__device__ __forceinline__ int req_of_row(int m) { return m < NP ? 0 : 1 + (m - NP) / LS; }

using pg8::f32x4; using pg8::Unit; using pg8::BM; using pg8::HALF; using pg8::cvt_pk_bf16;
typedef unsigned u32x4 __attribute__((ext_vector_type(4)));
__device__ __forceinline__ u32x4 pack8(const f32x4& a, const f32x4& b) { u32x4 w; w.x = cvt_pk_bf16(a[0], a[1]); w.y = cvt_pk_bf16(a[2], a[3]); w.z = cvt_pk_bf16(b[0], b[1]); w.w = cvt_pk_bf16(b[2], b[3]); return w; }

#define SLAB_ADD(v, ai, bj, m, n) do { if constexpr (SL) (v) += *(const f32x4*)(slab + ((((ai) * 2 + (bj)) * 4 + (m)) * 2 + (n)) * 256); } while (0)
struct EpiWin {
    static constexpr bool PERM = true, AFTER_DRAIN = false;
    bf16* P; float* ZS;
    template <bool SL> __device__ __forceinline__ void run(const f32x4 (&acc)[2][2][4][2], const Unit& u, int wr, int wc, int fr, int fq, const float* slab) const {
        const int row0 = u.pm * BM + wr * 64 + fr, colt = u.pn * BM + wc * 32 + 8 * fq;
#pragma unroll
        for (int ai = 0; ai < 2; ++ai)
#pragma unroll
            for (int m = 0; m < 4; ++m) { const int row = row0 + ai * HALF + m * 16;
#pragma unroll
                for (int bj = 0; bj < 2; ++bj) { const int col = colt + bj * HALF; f32x4 a0 = acc[ai][bj][m][0], a1 = acc[ai][bj][m][1]; SLAB_ADD(a0, ai, bj, m, 0); SLAB_ADD(a1, ai, bj, m, 1);
                    if (u.pn < 6) *(u32x4*)(P + (size_t)row * 1536 + col) = pack8(a0, a1);
                    else { float* d = ZS + (size_t)row * 512 + (col - 1536); *(f32x4*)d = a0; *(f32x4*)(d + 4) = a1; } } }
    }
};
struct EpiStore {
    static constexpr bool PERM = true, AFTER_DRAIN = false;
    bf16* O; int ld;
    template <bool SL> __device__ __forceinline__ void run(const f32x4 (&acc)[2][2][4][2], const Unit& u, int wr, int wc, int fr, int fq, const float* slab) const {
        const int row0 = u.pm * BM + wr * 64 + fr, colt = u.pn * BM + wc * 32 + 8 * fq;
#pragma unroll
        for (int ai = 0; ai < 2; ++ai)
#pragma unroll
            for (int m = 0; m < 4; ++m) { const int row = row0 + ai * HALF + m * 16;
#pragma unroll
                for (int bj = 0; bj < 2; ++bj) *(u32x4*)(O + (size_t)row * ld + colt + bj * HALF) = pack8(acc[ai][bj][m][0], acc[ai][bj][m][1]); }
    }
};
struct EpiKV {
    static constexpr bool PERM = true, AFTER_DRAIN = false;
    bf16 *KFs, *KFp, *Vs, *Vp;
    template <bool SL> __device__ __forceinline__ void run(const f32x4 (&acc)[2][2][4][2], const Unit& u, int wr, int wc, int fr, int fq, const float* slab) const {
        const int m0 = u.pm * BM; bf16* kf; bf16* vv; int lk, key0, b;
        if (m0 < NP) { b = m0 / LP; key0 = 0; lk = LP; kf = KFp; vv = Vp; }
        else if (m0 < MT) { b = (m0 - NP) / LS; key0 = (m0 - NP) % LS; lk = LKS; kf = KFs; vv = Vs; }
        else { b = (m0 - MT) / PAST; key0 = LS + (m0 - MT) % PAST; lk = LKS; kf = KFs; vv = Vs; }
        const int h = u.pn;
        int rloc = wr * 64 + fr, c8 = wc * 32 + 8 * fq; asm volatile("" : "+v"(rloc), "+v"(c8));
#pragma unroll
        for (int ai = 0; ai < 2; ++ai)
#pragma unroll
            for (int m = 0; m < 4; ++m) { const int key = key0 + rloc + ai * HALF + m * 16; const size_t kr = (size_t)(b * NH + h) * lk + key;
                *(u32x4*)(kf + kr * DQK + c8) = pack8(acc[ai][0][m][0], acc[ai][0][m][1]);
                *(u32x4*)(vv + kr * DVH + c8) = pack8(acc[ai][1][m][0], acc[ai][1][m][1]); }
    }
};
template <int MF = 4> struct EpiRes {
    static constexpr bool PERM = false, AFTER_DRAIN = false;
    const float* xp; const float* xs; const float* gate;
    float* T;
    template <bool SL> __device__ __forceinline__ void run(const f32x4 (&acc)[2][2][4][2], const Unit& u, int wr, int wc, int fr, int fq, const float* slab) const {
        const int m0 = u.pm * (64 * MF), row0 = m0 + wr * (16 * MF) + fr, col0 = u.pn * BM + wc * 32 + 4 * fq;
        const float* g = gate + (size_t)req_of_row(m0) * 6144;
        f32x4 gv[2][2];
        if constexpr (MF == 4) {
#pragma unroll
            for (int bj = 0; bj < 2; ++bj)
#pragma unroll
                for (int n = 0; n < 2; ++n) gv[bj][n] = *(const f32x4*)(g + col0 + bj * HALF + n * 16); }
#pragma unroll
        for (int ai = 0; ai < 2; ++ai)
#pragma unroll
            for (int m = 0; m < MF; ++m) { const int row = row0 + ai * (32 * MF) + m * 16;
                const float* xr = (row < NP) ? xp + (size_t)row * DM : xs + (size_t)(row - NP) * DM;
                const float* gr = gate + (size_t)req_of_row(row) * 6144;
#pragma unroll
                for (int bj = 0; bj < 2; ++bj)
#pragma unroll
                    for (int n = 0; n < 2; ++n) { const int col = col0 + bj * HALF + n * 16; const f32x4 xv = *(const f32x4*)(xr + col); f32x4 a = acc[ai][bj][m][n]; SLAB_ADD(a, ai, bj, m, n);
                        const f32x4 gg = (MF == 4) ? gv[bj][n] : *(const f32x4*)(gr + col);
                        *(f32x4*)(T + (size_t)row * DM + col) = xv * ALPHA + gg * a; } }
    }
};
struct EpiUp {
    static constexpr bool PERM = true, AFTER_DRAIN = false;
    bf16* H;
    template <bool SL> __device__ __forceinline__ void run(const f32x4 (&acc)[2][2][4][2], const Unit& u, int wr, int wc, int fr, int fq, const float* slab) const {
        const int row0 = u.pm * BM + wr * 64 + fr, colt = u.pn * BM + wc * 32 + 8 * fq;
#pragma unroll
        for (int ai = 0; ai < 2; ++ai)
#pragma unroll
            for (int m = 0; m < 4; ++m) { const int row = row0 + ai * HALF + m * 16;
#pragma unroll
                for (int bj = 0; bj < 2; ++bj) { f32x4 a = acc[ai][bj][m][0], b = acc[ai][bj][m][1];
#pragma unroll
                    for (int e = 0; e < 4; ++e) { const float x = fmaxf(a[e], 0.f), y = fmaxf(b[e], 0.f); a[e] = x * x; b[e] = y * y; }
                    *(u32x4*)(H + (size_t)row * FF + colt + bj * HALF) = pack8(a, b); } }
    }
};
struct EpiDft {
    static constexpr bool PERM = true, AFTER_DRAIN = false;
    bf16* UV; int L, tokbase;
    template <bool SL> __device__ __forceinline__ void run(const f32x4 (&acc)[2][2][4][2], const Unit& u, int wr, int wc, int fr, int fq, const float* slab) const {
        int rl = wr * 64 + fr, cl = wc * 32 + 8 * fq; asm volatile("" : "+v"(rl), "+v"(cl));
        const int rho0 = u.pm * BM + rl, n0 = u.pn * BM + cl, hl = L >> 1;
#pragma unroll
        for (int ai = 0; ai < 2; ++ai)
#pragma unroll
            for (int m = 0; m < 4; ++m) { const int rho = rho0 + ai * HALF + m * 16; const int part = rho > hl ? 1 : 0; const int k = part ? rho - hl : rho;
#pragma unroll
                for (int bj = 0; bj < 2; ++bj) { const int n = n0 + bj * HALF, b = n >> 10, c = n & 1023;
                    f32x4 a0 = acc[ai][bj][m][0], a1 = acc[ai][bj][m][1]; SLAB_ADD(a0, ai, bj, m, 0); SLAB_ADD(a1, ai, bj, m, 1);
                    bf16* r1 = UV + (size_t)(tokbase + b * L + k) * 2048 + part * 1024 + c;
                    *(u32x4*)r1 = pack8(a0, a1);
                    if (k != 0 && k != hl) { bf16* r2 = UV + (size_t)(tokbase + b * L + (L - k)) * 2048 + part * 1024 + c;
                        *(u32x4*)r2 = part ? pack8(-a0, -a1) : pack8(a0, a1); }
                    else if (part == 0) { unsigned zz = 0u; asm volatile("" : "+v"(zz)); *(u32x4*)(r1 + 1024) = (u32x4){zz, zz, zz, zz}; } } }
    }
};

namespace att {
using bf16x8 = __attribute__((ext_vector_type(8))) short;
using s16x4  = __attribute__((ext_vector_type(4))) short;
using f32x16 = __attribute__((ext_vector_type(16))) float;
constexpr int DK = 192, DV = 128, NW = 8, QBLK = 32, KVBLK = 64;
constexpr float SCALE = 0.07216878364870322f;
constexpr float THR = 8.f;
constexpr int SHM_V = KVBLK * DV * 2, SHM_K = KVBLK * DK * 2, SHM_QR = 2 * SHM_V + 2 * SHM_K + NW * 64 * 4, NQR = 4  , SHM_ATTN = SHM_QR + NW * (12 - NQR) * 1024;
#define KSWZ(row, colB) ((row) * 384 + ((colB) ^ (((row) & 7) << 4)))
#define SBAR() __builtin_amdgcn_sched_barrier(0)
__device__ __forceinline__ int crow(int r, int hi) { return (r & 3) + 8 * (r >> 2) + 4 * hi; }
__device__ __forceinline__ unsigned cvtpk(float lo, float hi) { unsigned r; asm volatile("v_cvt_pk_bf16_f32 %0, %1, %2" : "=v"(r) : "v"(lo), "v"(hi)); return r; }
__device__ __forceinline__ void partialSM(f32x16& p0, f32x16& p1, float& m_reg, float& mn, float& alpha) {
  constexpr float C = SCALE * 1.4426950408889634f;
  float pmax = p0[0];
#pragma unroll
  for (int r = 1; r < 16; ++r) pmax = fmaxf(pmax, p0[r]);
#pragma unroll
  for (int r = 0; r < 16; ++r) pmax = fmaxf(pmax, p1[r]);
  { auto rr = __builtin_amdgcn_permlane32_swap(__float_as_uint(pmax), __float_as_uint(pmax), false, false);
    pmax = fmaxf(__uint_as_float(rr[0]), __uint_as_float(rr[1])); }
  if (__builtin_expect(__all(pmax - m_reg <= THR / SCALE), 1)) { mn = m_reg; alpha = 1.f; }
  else { mn = fmaxf(m_reg, pmax); alpha = __builtin_amdgcn_exp2f((m_reg - mn) * C); m_reg = mn; }
  float mnC = -mn * C;
#pragma unroll
  for (int r = 0; r < 16; ++r) p0[r] = fmaf(p0[r], C, mnC);
#pragma unroll
  for (int r = 0; r < 16; ++r) p1[r] = fmaf(p1[r], C, mnC);
#pragma unroll
  for (int r = 0; r < 16; ++r) p0[r] = __builtin_amdgcn_exp2f(p0[r]);
}
__device__ __forceinline__ void finishSM(f32x16& p0, f32x16& p1, float alpha, float& l_reg, bf16x8& pa0, bf16x8& pa1, bf16x8& pa2, bf16x8& pa3) {
#pragma unroll
  for (int r = 0; r < 16; ++r) p1[r] = __builtin_amdgcn_exp2f(p1[r]);
  float ps = 0;
#pragma unroll
  for (int r = 0; r < 16; ++r) ps += p0[r];
#pragma unroll
  for (int r = 0; r < 16; ++r) ps += p1[r];
  { auto rr = __builtin_amdgcn_permlane32_swap(__float_as_uint(ps), __float_as_uint(ps), false, false);
    ps = __uint_as_float(rr[0]) + __uint_as_float(rr[1]); }
  l_reg = l_reg * alpha + ps;
#define PK4(P, BASE, OUT) do { unsigned a0 = cvtpk(P[BASE + 0], P[BASE + 1]), a1 = cvtpk(P[BASE + 2], P[BASE + 3]);   \
    unsigned b0 = cvtpk(P[BASE + 4], P[BASE + 5]), b1 = cvtpk(P[BASE + 6], P[BASE + 7]);                              \
    auto r0 = __builtin_amdgcn_permlane32_swap(a0, b0, false, false); auto r1 = __builtin_amdgcn_permlane32_swap(a1, b1, false, false); \
    u32x4 w = {r0[0], r1[0], r0[1], r1[1]}; OUT = __builtin_bit_cast(bf16x8, w); } while (0)
  PK4(p0, 0, pa0); PK4(p0, 8, pa1); PK4(p1, 0, pa2); PK4(p1, 8, pa3);
#undef PK4
}
__device__ __forceinline__ void qkt(f32x16& p0, f32x16& p1, const LAS char* Ks, const bf16x8* qr, const LAS char* qrl, int r32, int hi) {
  p0 = f32x16{}; p1 = f32x16{};
#pragma unroll
  for (int d0 = 0; d0 < 12; ++d0) { const int cb = (d0 * 16 + hi * 8) * 2;
    bf16x8 b0 = *reinterpret_cast<const LAS bf16x8*>(Ks + KSWZ(r32, cb));
    bf16x8 b1 = *reinterpret_cast<const LAS bf16x8*>(Ks + KSWZ(32 + r32, cb));
    const bf16x8 qf = d0 < NQR ? qr[d0 < NQR ? d0 : 0] : *reinterpret_cast<const LAS bf16x8*>(qrl + (d0 - NQR) * 1024);
    p0 = __builtin_amdgcn_mfma_f32_32x32x16_bf16(b0, qf, p0, 0, 0, 0);
    p1 = __builtin_amdgcn_mfma_f32_32x32x16_bf16(b1, qf, p1, 0, 0, 0); }
}
__device__ __forceinline__ int v_st(int k, int c) { const int kk = (k & ~0xC) | ((k & 4) << 1) | ((k & 8) >> 1); return ((kk >> 3) * 4 + (c >> 5)) * 512 + ((kk & 7) * 32 + (c & 31)) * 2; }
__device__ __forceinline__ int v_rd_base(int lane) { return ((lane & 3) << 3) | (((lane >> 2) & 3) << 6) | (((lane >> 4) & 1) << 5) | (((lane >> 5) & 1) << 8); }
constexpr int v_rd_off(int d0, int ks, int half) { return d0 * 512 + ks * 4096 + half * 2048; }
template <int OFF> __device__ __forceinline__ s16x4 tr_read(int vb) {
  s16x4 r; asm volatile("ds_read_b64_tr_b16 %0, %1 offset:%2" : "=&v"(r) : "v"(vb), "i"(OFF) : "memory"); return r;
}
template <int D0> __device__ __forceinline__ void pv_one(f32x16& od, int vb, bf16x8 pa0, bf16x8 pa1, bf16x8 pa2, bf16x8 pa3) {
  const s16x4 l0 = tr_read<v_rd_off(D0, 0, 0)>(vb), h0 = tr_read<v_rd_off(D0, 0, 1)>(vb), l1 = tr_read<v_rd_off(D0, 1, 0)>(vb), h1 = tr_read<v_rd_off(D0, 1, 1)>(vb);
  const s16x4 l2 = tr_read<v_rd_off(D0, 2, 0)>(vb), h2 = tr_read<v_rd_off(D0, 2, 1)>(vb), l3 = tr_read<v_rd_off(D0, 3, 0)>(vb), h3 = tr_read<v_rd_off(D0, 3, 1)>(vb);
  asm volatile("s_waitcnt lgkmcnt(0)" ::: "memory"); SBAR();
#define PK(L, H) (bf16x8){L[0], L[1], L[2], L[3], H[0], H[1], H[2], H[3]}
  od = __builtin_amdgcn_mfma_f32_32x32x16_bf16(pa0, PK(l0, h0), od, 0, 0, 0);
  od = __builtin_amdgcn_mfma_f32_32x32x16_bf16(pa1, PK(l1, h1), od, 0, 0, 0);
  od = __builtin_amdgcn_mfma_f32_32x32x16_bf16(pa2, PK(l2, h2), od, 0, 0, 0);
  od = __builtin_amdgcn_mfma_f32_32x32x16_bf16(pa3, PK(l3, h3), od, 0, 0, 0);
#undef PK
}
__device__ __forceinline__ void pv_d0(f32x16* o, int vb, bf16x8 pa0, bf16x8 pa1, bf16x8 pa2, bf16x8 pa3) {
  pv_one<0>(o[0], vb, pa0, pa1, pa2, pa3); pv_one<1>(o[1], vb, pa0, pa1, pa2, pa3); pv_one<2>(o[2], vb, pa0, pa1, pa2, pa3); pv_one<3>(o[3], vb, pa0, pa1, pa2, pa3);
}
constexpr int LDQ = 768, LDK = DK, LDV = DV, LDO = 1024;
__device__ __forceinline__ void attn_dense_body(const bf16* __restrict__ Qb, const bf16* __restrict__ Kh, const bf16* __restrict__ Vh, bf16* __restrict__ Ob, int seq, int pos0, LAS char* lds, const int tid, float* part, unsigned* cnt, volatile LAS unsigned* misc) {
  const int wid = tid >> 6, lane = tid & 63, r32 = lane & 31, hi = lane >> 5;
  LAS char* V_lds = lds; LAS char* K_lds = lds + 2 * SHM_V;
  LAS float* ws = (LAS float*)(lds + 2 * SHM_V + 2 * SHM_K) + wid * 64; LAS float* li_l = ws; LAS float* al_l = ws + 32;
  float m_reg = -1e30f, l_reg = 0; f32x16 o[4] = {}; bf16x8 qr[NQR];
  const LAS char* qrl = lds + SHM_QR + wid * (12 - NQR) * 1024 + lane * 16;
  const bf16* Qw = Qb + (long)(wid * QBLK + r32) * LDQ + hi * 8;
#pragma unroll
  for (int d0 = 0; d0 < NQR; ++d0) qr[d0] = *reinterpret_cast<const bf16x8*>(Qw + d0 * 16);
  LAS char* qw = lds + SHM_QR + wid * (12 - NQR) * 1024 + lane * 16;
#pragma unroll
  for (int d0 = NQR; d0 < 8; ++d0) *(LAS bf16x8*)(qw + (d0 - NQR) * 1024) = *reinterpret_cast<const bf16x8*>(Qw + d0 * 16);
  {
    bf16x8 f0 = *reinterpret_cast<const bf16x8*>(Qw + 128), f1 = *reinterpret_cast<const bf16x8*>(Qw + 144), f2 = *reinterpret_cast<const bf16x8*>(Qw + 160), f3 = *reinterpret_cast<const bf16x8*>(Qw + 176);
    if (pos0 >= 0) { const int pos = pos0 + wid * QBLK + r32; const float pr = (float)(pos >> 6), pc = (float)(pos & 63);
#pragma unroll
      for (int i = 0; i < 8; ++i) { const float inv = __builtin_amdgcn_exp2f(-(float)(8 * hi + i) * (13.287712379549449f / 16.0f));
        { const float rev = pr * inv * INV_2PI, cs = fcos_rev(rev), sn = fsin_rev(rev); const float a = bf2f((unsigned short)f0[i]), b = bf2f((unsigned short)f1[i]);
          f0[i] = (short)f2bf(a * cs - b * sn); f1[i] = (short)f2bf(b * cs + a * sn); }
        { const float rev = pc * inv * INV_2PI, cs = fcos_rev(rev), sn = fsin_rev(rev); const float a = bf2f((unsigned short)f2[i]), b = bf2f((unsigned short)f3[i]);
          f2[i] = (short)f2bf(a * cs - b * sn); f3[i] = (short)f2bf(b * cs + a * sn); } } }
    *(LAS bf16x8*)(qw + (8 - NQR) * 1024) = f0; *(LAS bf16x8*)(qw + (9 - NQR) * 1024) = f1; *(LAS bf16x8*)(qw + (10 - NQR) * 1024) = f2; *(LAS bf16x8*)(qw + (11 - NQR) * 1024) = f3;
  }
  const int sr = tid >> 4, sc = (tid & 15) * 8, vst0 = v_st(sr, sc), vst1 = v_st(32 + sr, sc);
  const int kr = tid >> 3, kc = tid & 7, kgo = kr * LDK + kc * 8, kst = KSWZ(kr, kc * 16);
  const int vb0 = (int)(unsigned)(uintptr_t)V_lds + v_rd_base(lane);
  bf16x8 vs0, vs1, ks0, ks1, ks2;
#define SLOAD(k0) do { vs0 = *reinterpret_cast<const bf16x8*>(&Vh[(long)((k0) + sr) * LDV + sc]); vs1 = *reinterpret_cast<const bf16x8*>(&Vh[(long)((k0) + 32 + sr) * LDV + sc]); \
    ks0 = *reinterpret_cast<const bf16x8*>(&Kh[(long)(k0) * LDK + kgo]); ks1 = *reinterpret_cast<const bf16x8*>(&Kh[(long)(k0) * LDK + kgo + 64]); \
    ks2 = *reinterpret_cast<const bf16x8*>(&Kh[(long)(k0) * LDK + kgo + 128]); } while (0)
#define SWRITE(b) do { *(LAS bf16x8*)(V_lds + (b) * SHM_V + vst0) = vs0; *(LAS bf16x8*)(V_lds + (b) * SHM_V + vst1) = vs1; \
    *(LAS bf16x8*)(K_lds + (b) * SHM_K + kst) = ks0; *(LAS bf16x8*)(K_lds + (b) * SHM_K + kst + 128) = ks1; *(LAS bf16x8*)(K_lds + (b) * SHM_K + kst + 256) = ks2; } while (0)
#define SWAIT() asm volatile("s_waitcnt vmcnt(0)" ::: "memory")
#define RESC(a) do { if (__any((a) < 1.f)) { if (hi == 0) al_l[r32] = (a); asm volatile("s_waitcnt lgkmcnt(0)" ::: "memory"); \
    _Pragma("unroll") for (int d = 0; d < 4; ++d) _Pragma("unroll") for (int r = 0; r < 16; ++r) o[d][r] *= al_l[crow(r, hi)]; } } while (0)
  f32x16 pA0, pA1, pB0, pB1; float mnA, mnB, alA, alB; bf16x8 pa0, pa1, pa2, pa3; const int NT = seq / KVBLK;
  SLOAD(0); SWAIT(); SWRITE(0); __syncthreads();
  qkt(pA0, pA1, K_lds, qr, qrl, r32, hi); partialSM(pA0, pA1, m_reg, mnA, alA);
  SLOAD(KVBLK);
  SWAIT(); SWRITE(1); __syncthreads();
  for (int j = 1; j + 1 < NT; j += 2) {
    SBAR(); qkt(pB0, pB1, K_lds + SHM_K, qr, qrl, r32, hi);
    finishSM(pA0, pA1, alA, l_reg, pa0, pa1, pa2, pa3); SBAR();
    SLOAD((j + 1) * KVBLK); SBAR();
    pv_d0(o, vb0, pa0, pa1, pa2, pa3); partialSM(pB0, pB1, m_reg, mnB, alB);
    __syncthreads(); SWAIT(); SWRITE(0);
    RESC(alB); __syncthreads();
    SBAR(); qkt(pA0, pA1, K_lds, qr, qrl, r32, hi);
    finishSM(pB0, pB1, alB, l_reg, pa0, pa1, pa2, pa3); SBAR();
    SLOAD((j + 2) * KVBLK); SBAR();
    pv_d0(o, vb0 + SHM_V, pa0, pa1, pa2, pa3); partialSM(pA0, pA1, m_reg, mnA, alA);
    __syncthreads(); SWAIT(); SWRITE(1);
    RESC(alA); __syncthreads();
  }
  SBAR(); qkt(pB0, pB1, K_lds + SHM_K, qr, qrl, r32, hi);
  finishSM(pA0, pA1, alA, l_reg, pa0, pa1, pa2, pa3); SBAR();
  pv_d0(o, vb0, pa0, pa1, pa2, pa3); partialSM(pB0, pB1, m_reg, mnB, alB);
  __syncthreads(); RESC(alB);
  finishSM(pB0, pB1, alB, l_reg, pa0, pa1, pa2, pa3); SBAR();
  pv_d0(o, vb0 + SHM_V, pa0, pa1, pa2, pa3);
  bf16* Ow = Ob + (long)(wid * QBLK) * LDO;
  bool write_out = true; float g1 = 1.f;
  if (part) {
    if (tid == 0) misc[1] = __hip_atomic_fetch_add(cnt, 1u, __ATOMIC_RELAXED, __HIP_MEMORY_SCOPE_AGENT);
    __syncthreads();
    const unsigned ticket = misc[1];
    float* po = part + (size_t)wid * (4 * 16 * 64) + lane * 4; float* pml = part + 8 * 4 * 16 * 64 + wid * 128 + lane;
    if (ticket == 0u) {
#pragma unroll
      for (int d0 = 0; d0 < 4; ++d0)
#pragma unroll
        for (int r4 = 0; r4 < 4; ++r4) { const f32x4 v = {o[d0][4 * r4], o[d0][4 * r4 + 1], o[d0][4 * r4 + 2], o[d0][4 * r4 + 3]}; const float* p = po + (d0 * 4 + r4) * 256;
          asm volatile("global_store_dwordx4 %0, %1, off sc1\n\ts_nop 1" :: "v"(p), "v"(v) : "memory"); }
      __hip_atomic_store((unsigned*)pml, __float_as_uint(m_reg), __ATOMIC_RELAXED, __HIP_MEMORY_SCOPE_AGENT); __hip_atomic_store((unsigned*)pml + 64, __float_as_uint(l_reg), __ATOMIC_RELAXED, __HIP_MEMORY_SCOPE_AGENT);
      asm volatile("s_waitcnt vmcnt(0)" ::: "memory"); __syncthreads();
      if (tid == 0) __hip_atomic_store(cnt + 1, 1u, __ATOMIC_RELAXED, __HIP_MEMORY_SCOPE_AGENT);
      write_out = false;
    } else {
      if (tid == 0) { unsigned sp = 0; while (__hip_atomic_load(cnt + 1, __ATOMIC_RELAXED, __HIP_MEMORY_SCOPE_AGENT) == 0u) { __builtin_amdgcn_s_sleep(2); if (++sp > (1u << 22)) break; }
        __builtin_amdgcn_fence(__ATOMIC_ACQUIRE, "agent"); asm volatile("s_waitcnt vmcnt(0)" ::: "memory"); }
      __syncthreads();
      constexpr float C = SCALE * 1.4426950408889634f;
      const float m2 = pml[0], l2 = pml[64]; const float mn = fmaxf(m_reg, m2);
      const float f1 = __builtin_amdgcn_exp2f((m_reg - mn) * C), f2 = __builtin_amdgcn_exp2f((m2 - mn) * C); const float il = __builtin_amdgcn_rcpf(l_reg * f1 + l2 * f2);
      if (hi == 0) { li_l[r32] = f1 * il; al_l[r32] = f2 * il; } asm volatile("s_waitcnt lgkmcnt(0)" ::: "memory");
#pragma unroll
      for (int r4 = 0; r4 < 4; ++r4)
#pragma unroll
        for (int d0 = 0; d0 < 4; ++d0) { const f32x4 pv = *(const f32x4*)(po + (d0 * 4 + r4) * 256);
#pragma unroll
          for (int e = 0; e < 4; ++e) { const int r = 4 * r4 + e; o[d0][r] = o[d0][r] * li_l[crow(r, hi)] + pv[e] * al_l[crow(r, hi)]; } }
      g1 = 0.f;
    }
  }
  if (write_out) {
    if (g1 != 0.f) {
      if (hi == 0) li_l[r32] = l_reg; asm volatile("s_waitcnt lgkmcnt(0)" ::: "memory");
#pragma unroll
      for (int r = 0; r < 16; ++r) { const float rl = __builtin_amdgcn_rcpf(li_l[crow(r, hi)]);
#pragma unroll
        for (int d0 = 0; d0 < 4; ++d0) o[d0][r] *= rl; }
    }
#pragma unroll
    for (int r = 0; r < 16; ++r) { const int orow = crow(r, hi);
#pragma unroll
      for (int d0 = 0; d0 < 4; ++d0) Ow[(long)orow * LDO + d0 * 32 + r32] = (bf16)f2bf(o[d0][r]); }
  }
  __syncthreads();
#undef SLOAD
#undef SWRITE
#undef SWAIT
#undef RESC
}
#undef KSWZ
#undef SBAR
}
__device__ __forceinline__ void transpose_item(const float* W, int K, int N, bf16* WT, int ldk, LAS float* scr, int item, int lane) {
    const int nblk = N / 32, kb = item / nblk, nb = item % nblk, k0 = 64 * kb, n0 = 32 * nb;
#pragma unroll
    for (int i = 0; i < 32; ++i) { const int kk = 2 * i + (lane >> 5); scr[kk * 33 + (lane & 31)] = W[(size_t)(k0 + kk) * N + n0 + (lane & 31)]; }
    LDS_WAIT(); asm volatile("" ::: "memory");
    const int c = lane & 7;
#pragma unroll
    for (int j = 0; j < 4; ++j) { const int n = (lane >> 3) + 8 * j; const LAS float* s = scr + (8 * c) * 33 + n;
        v4u o; o.x = pk2(s[0 * 33], s[1 * 33]); o.y = pk2(s[2 * 33], s[3 * 33]); o.z = pk2(s[4 * 33], s[5 * 33]); o.w = pk2(s[6 * 33], s[7 * 33]);
        *(v4u*)(WT + (size_t)(n0 + n) * ldk + k0 + 8 * c) = o; }
    LDS_WAIT(); asm volatile("" ::: "memory");
}
constexpr int WI_L0 = 992 + 96 + 64 + 512 + 2 * 2048 + 512, WI_ALL = WI_L0 + 2 * 2048;
__device__ __forceinline__ void weight_item(const Args& args, unsigned char* ws, LAS float* scr, int idx, int lane) {
    constexpr int I0 = 992, I1 = 96, I2 = 64, I3 = 512, I4 = 2048;
    int r = idx, K, N, ldk; size_t off; const float* W;
    if (r < I0) { W = args.in[I_WIN]; K = 1024; N = 1984; ldk = 1024; off = WS_WIN_T; }
    else if ((r -= I0) < I1) { W = args.in[I_QUP]; K = 256; N = 768; ldk = 256; off = WS_QUP_T; }
    else if ((r -= I1) < I2) { W = args.in[I_KVUP]; K = 128; N = 1024; ldk = 256; off = WS_KVUP_T; }
    else if ((r -= I2) < I3) { W = args.in[I_WOUT0]; K = 1024; N = 1024; ldk = 1024; off = WS_WOUT0_T; }
    else if ((r -= I3) < I4) { W = args.in[I_W1_0]; K = 1024; N = 4096; ldk = 1024; off = WS_W1_0; }
    else if ((r -= I4) < I4) { W = args.in[I_W2_0]; K = 4096; N = 1024; ldk = 4096; off = WS_W2_0; }
    else if ((r -= I4) < I3) { W = args.in[I_WOUT1]; K = 1024; N = 1024; ldk = 1024; off = WS_W1T; }
    else if ((r -= I3) < I4) { W = args.in[I_W1_1]; K = 1024; N = 4096; ldk = 1024; off = WS_W1_1; }
    else { r -= I4; W = args.in[I_W2_1]; K = 4096; N = 1024; ldk = 4096; off = WS_W2_1; }
    transpose_item(W, K, N, (bf16*)(ws + off), ldk, scr, r, lane);
}
__device__ __forceinline__ void row_stats(const f32x4 (&v)[4], float& mean, float& rstd) {
    float s = 0.f;
#pragma unroll
    for (int j = 0; j < 4; ++j) s += (v[j][0] + v[j][1]) + (v[j][2] + v[j][3]);
    mean = wave_sum(s) * (1.f / DM); float q = 0.f;
#pragma unroll
    for (int j = 0; j < 4; ++j) { const f32x4 d = v[j] - mean; q += (d[0] * d[0] + d[1] * d[1]) + (d[2] * d[2] + d[3] * d[3]); }
    rstd = __builtin_amdgcn_rsqf(wave_sum(q) * (1.f / DM) + LN_EPS);
}
__device__ __forceinline__ void load_row(const float* p, int lane, f32x4 (&v)[4]) {
#pragma unroll
    for (int j = 0; j < 4; ++j) v[j] = ((const f32x4*)p)[lane + 64 * j];
}
__device__ __forceinline__ void adaln_store(const f32x4 (&v)[4], const float* shift, const float* scale, bf16* hrow, int lane) {
    float mean, rstd; row_stats(v, mean, rstd);
#pragma unroll
    for (int j = 0; j < 4; ++j) { const int c = 4 * lane + 256 * j; const f32x4 sc = *(const f32x4*)(scale + c), sh = *(const f32x4*)(shift + c);
        const f32x4 h = (v[j] - mean) * rstd * (sc + 1.0f) + sh;
        v2u w; w.x = pk2(h[0], h[1]); w.y = pk2(h[2], h[3]); *(v2u*)(hrow + c) = w; }
}
__device__ __forceinline__ void ln_affine(f32x4 (&v)[4], const float* g, const float* b, int lane) {
    float mean, rstd; row_stats(v, mean, rstd);
#pragma unroll
    for (int j = 0; j < 4; ++j) { const int c = 4 * lane + 256 * j; v[j] = (v[j] - mean) * rstd * *(const f32x4*)(g + c) + *(const f32x4*)(b + c); }
}
__device__ __forceinline__ void store_row(float* p, int lane, const f32x4 (&v)[4]) {
#pragma unroll
    for (int j = 0; j < 4; ++j) ((f32x4*)p)[lane + 64 * j] = v[j];
}

namespace hconv {
using bf16x8 = __attribute__((ext_vector_type(8))) short;
using f32x16 = __attribute__((ext_vector_type(16))) float;
constexpr int UB = 8256;
constexpr int SLOT = 16384 + 2 * UB;
__device__ __forceinline__ int crow(int r, int hi) { return (r & 3) + 8 * (r >> 2) + 4 * hi; }
__device__ __forceinline__ void item(const bf16* __restrict__ GRB, const bf16* __restrict__ UT, const float* __restrict__ FP, const float* __restrict__ skipv, const bf16* __restrict__ X0, bf16* __restrict__ YM,
                                     int ch0, LAS unsigned char* lds, const int tid, const int lane, const int wave) {
    for (int q = tid; q < 4 * 1024; q += 512) { const int ch = q >> 10, i = q & 1023; const v4u v = ((const v4u*)(GRB + (size_t)(ch0 + ch) * 8192))[i]; *(LAS v4u*)(lds + ch * SLOT + 16 * i) = v; }
    for (int q = tid; q < 4 * 1024; q += 512) { const int ch = q >> 10, b = (q >> 9) & 1, i = q & 511; const v4u v = ((const v4u*)(UT + ((size_t)b * HY + ch0 + ch) * LS))[i];
        *(LAS v4u*)(lds + ch * SLOT + 16384 + b * UB + 32 + 16 * i) = v; }
    if (tid < 32) { const int ch = tid >> 3, b = (tid >> 2) & 1, j = tid & 3; const v4u z = {0u, 0u, 0u, 0u};
        *(LAS v4u*)(lds + ch * SLOT + 16384 + b * UB + (j < 2 ? 16 * j : 32 + 8192 + 16 * (j - 2))) = z; }
    __syncthreads();
    v2u x0v[16];
    {
        const int slot = wave & 3, khalf = wave >> 2;
        const LAS unsigned char* gr = lds + slot * SLOT; const LAS unsigned char* ubuf = gr + 16384;
        const int r = lane & 31, h = lane >> 5, c = r & 15, b = r >> 4, c0 = c & 1, c1 = c >> 1;
        const LAS unsigned char* ap = gr + 992 + 16 * h - 32 * r + khalf * (129 * 32);
        const LAS unsigned char* bp = ubuf + b * UB + 16 * h + 4 * c1 + khalf * (129 * 32);
        const unsigned sh = 16u * (unsigned)c0;
        const int ch = ch0 + slot;
        const float nsum = wave_sum(FP[ch * 64 + lane] + FP[(HY + ch) * 64 + lane]); const float inv_norm = 1.f / nsum; const float skn = skipv[ch] * nsum;
        const LAS bf16* ul = (const LAS bf16*)(ubuf + b * UB + 32);
        f32x16 acc[8];
#pragma unroll
        for (int Q = 0; Q < 8; ++Q)
#pragma unroll
            for (int g = 0; g < 16; ++g) acc[Q][g] = khalf ? 0.f : skn * bf2f(ul[16 * (32 * Q + crow(g, h)) + c]);
        int nks = khalf ? 128 : 129; asm volatile("" : "+s"(nks));
        unsigned aa = (unsigned)(uintptr_t)ap, ba = (unsigned)(uintptr_t)bp;
        bf16x8 fa0, fa1, fa2, fa3, fa4, fa5, fa6, fa7, fb0, fb1, fb2, fb3, fb4, fb5, fb6, fb7; v2u da01, da23, db01, db23; unsigned da4, db4;
#define HC_LD(F0, F1, F2, F3, F4, F5, F6, F7, D01, D23, D4) do { \
            asm volatile("ds_read_b128 %0, %1 offset:7168" : "=v"(F0) : "v"(aa)); asm volatile("ds_read_b128 %0, %1 offset:6144" : "=v"(F1) : "v"(aa)); \
            asm volatile("ds_read2_b32 %0, %1 offset1:1" : "=v"(D01) : "v"(ba)); asm volatile("ds_read2_b32 %0, %1 offset0:2 offset1:3" : "=v"(D23) : "v"(ba)); asm volatile("ds_read_b32 %0, %1 offset:16" : "=v"(D4) : "v"(ba)); \
            asm volatile("ds_read_b128 %0, %1 offset:5120" : "=v"(F2) : "v"(aa)); asm volatile("ds_read_b128 %0, %1 offset:4096" : "=v"(F3) : "v"(aa)); \
            asm volatile("ds_read_b128 %0, %1 offset:3072" : "=v"(F4) : "v"(aa)); asm volatile("ds_read_b128 %0, %1 offset:2048" : "=v"(F5) : "v"(aa)); \
            asm volatile("ds_read_b128 %0, %1 offset:1024" : "=v"(F6) : "v"(aa)); asm volatile("ds_read_b128 %0, %1" : "=v"(F7) : "v"(aa)); __builtin_amdgcn_sched_barrier(0); } while (0)
#define HC_WAIT(F0, F1, F2, F3, F4, F5, F6, F7, D01, D23, D4) do { __builtin_amdgcn_sched_barrier(0); asm volatile("s_waitcnt lgkmcnt(0)" : "+v"(F0), "+v"(F1), "+v"(F2), "+v"(F3), "+v"(F4), "+v"(F5), "+v"(F6), "+v"(F7), "+v"(D01), "+v"(D23), "+v"(D4)); \
            __builtin_amdgcn_sched_barrier(0); } while (0)
#define HC_MMA(F0, F1, F2, F3, F4, F5, F6, F7, D01, D23, D4) do { u32x4 bw; bw.x = __builtin_amdgcn_alignbit(D01.y, D01.x, sh); bw.y = __builtin_amdgcn_alignbit(D23.x, D01.y, sh); bw.z = __builtin_amdgcn_alignbit(D23.y, D23.x, sh); \
            bw.w = __builtin_amdgcn_alignbit(D4, D23.y, sh); const bf16x8 bf = __builtin_bit_cast(bf16x8, bw); \
            acc[0] = __builtin_amdgcn_mfma_f32_32x32x16_bf16(F0, bf, acc[0], 0, 0, 0); acc[1] = __builtin_amdgcn_mfma_f32_32x32x16_bf16(F1, bf, acc[1], 0, 0, 0); \
            acc[2] = __builtin_amdgcn_mfma_f32_32x32x16_bf16(F2, bf, acc[2], 0, 0, 0); acc[3] = __builtin_amdgcn_mfma_f32_32x32x16_bf16(F3, bf, acc[3], 0, 0, 0); \
            acc[4] = __builtin_amdgcn_mfma_f32_32x32x16_bf16(F4, bf, acc[4], 0, 0, 0); acc[5] = __builtin_amdgcn_mfma_f32_32x32x16_bf16(F5, bf, acc[5], 0, 0, 0); \
            acc[6] = __builtin_amdgcn_mfma_f32_32x32x16_bf16(F6, bf, acc[6], 0, 0, 0); acc[7] = __builtin_amdgcn_mfma_f32_32x32x16_bf16(F7, bf, acc[7], 0, 0, 0); } while (0)
        HC_LD(fa0, fa1, fa2, fa3, fa4, fa5, fa6, fa7, da01, da23, da4);
        int npair = nks >> 1;
        for (int kp = 0; kp < npair; ++kp) {
            HC_WAIT(fa0, fa1, fa2, fa3, fa4, fa5, fa6, fa7, da01, da23, da4);
            aa += 32; ba += 32; HC_LD(fb0, fb1, fb2, fb3, fb4, fb5, fb6, fb7, db01, db23, db4);
            HC_MMA(fa0, fa1, fa2, fa3, fa4, fa5, fa6, fa7, da01, da23, da4);
            HC_WAIT(fb0, fb1, fb2, fb3, fb4, fb5, fb6, fb7, db01, db23, db4);
            aa += 32; ba += 32; HC_LD(fa0, fa1, fa2, fa3, fa4, fa5, fa6, fa7, da01, da23, da4);
            HC_MMA(fb0, fb1, fb2, fb3, fb4, fb5, fb6, fb7, db01, db23, db4);
        }
        HC_WAIT(fa0, fa1, fa2, fa3, fa4, fa5, fa6, fa7, da01, da23, da4);
        if (nks & 1) HC_MMA(fa0, fa1, fa2, fa3, fa4, fa5, fa6, fa7, da01, da23, da4);
#undef HC_LD
#undef HC_WAIT
#undef HC_MMA
#pragma unroll
        for (int i = 0; i < 16; ++i) { const int q = tid + 512 * i; x0v[i] = *(const v2u*)(X0 + ((size_t)NP + q) * HY + ch0); }
        asm volatile("s_waitcnt lgkmcnt(0)" ::: "memory");
        __syncthreads();
        LAS f32x4* xch = (LAS f32x4*)(lds + slot * SLOT);
        if (khalf) {
#pragma unroll
            for (int Q = 0; Q < 8; ++Q)
#pragma unroll
                for (int g4 = 0; g4 < 4; ++g4) xch[(Q * 4 + g4) * 64 + lane] = (f32x4){acc[Q][4 * g4], acc[Q][4 * g4 + 1], acc[Q][4 * g4 + 2], acc[Q][4 * g4 + 3]};
        }
        __syncthreads();
        if (!khalf) {
#pragma unroll
            for (int Q = 0; Q < 8; ++Q)
#pragma unroll
                for (int g4 = 0; g4 < 4; ++g4) { const f32x4 o = xch[(Q * 4 + g4) * 64 + lane]; acc[Q][4 * g4] += o[0]; acc[Q][4 * g4 + 1] += o[1]; acc[Q][4 * g4 + 2] += o[2]; acc[Q][4 * g4 + 3] += o[3]; }
        }
        asm volatile("s_waitcnt lgkmcnt(0)" ::: "memory");
        __syncthreads();
        if (!khalf) {
            LAS bf16* yl = (LAS bf16*)(lds + slot * SLOT);
#pragma unroll
            for (int Q = 0; Q < 8; ++Q)
#pragma unroll
                for (int g = 0; g < 16; ++g) { const int t = 16 * (32 * Q + crow(g, h)) + c; yl[b * LS + t] = (bf16)f2bf(acc[Q][g] * inv_norm); }
        }
    }
    __syncthreads();
#pragma unroll
    for (int i = 0; i < 16; ++i) { const int q = tid + 512 * i; const size_t row = (size_t)NP + q; const v2u xv = x0v[i];
        const float y0 = bf2f(*(const LAS bf16*)(lds + 0 * SLOT + 2 * q)), y1 = bf2f(*(const LAS bf16*)(lds + 1 * SLOT + 2 * q)), y2 = bf2f(*(const LAS bf16*)(lds + 2 * SLOT + 2 * q)), y3 = bf2f(*(const LAS bf16*)(lds + 3 * SLOT + 2 * q));
        v2u o; o.x = pk2(y0 * bf2f((unsigned short)(xv.x & 0xffffu)), y1 * bf2f((unsigned short)(xv.x >> 16))); o.y = pk2(y2 * bf2f((unsigned short)(xv.y & 0xffffu)), y3 * bf2f((unsigned short)(xv.y >> 16)));
        *(v2u*)(YM + row * DM + ch0) = o; }
    __syncthreads();
}
static_assert(4 * SLOT <= LDSCTL_OFF, "four channel slots fit in LDS");
}

__global__ void __launch_bounds__(512, 2) fwd_kernel(Args args) {
    extern __shared__ __attribute__((aligned(16))) unsigned char lds_raw[];
    LAS unsigned char* lds = (LAS unsigned char*)lds_raw;
    volatile LAS unsigned* MISC = (volatile LAS unsigned*)(lds + MISC_OFF);
    const int wave = __builtin_amdgcn_readfirstlane((int)threadIdx.x >> 6);
    const int G = gridDim.x; const int bx = blockIdx.x; const int vcu = (G % 8 == 0) ? (bx % 8) * (G / 8) + bx / 8 : bx;
    const int gw = vcu * 8 + wave, NGW = G * 8, NGT = G * 512;
#define FRESH() const int lane = fresh_lane(); const int tid = wave * 64 + lane; const int gt = vcu * 512 + tid; (void)gt
    unsigned char* ws = args.ws;
    gu32* ctl = (gu32*)(ws + WS_CTL);
    float* MODS = (float*)(ws + WS_MODS);
    float* X = args.out;
    float* T = (float*)(ws + WS_T);
    bf16* HB = (bf16*)(ws + WS_H);
    for (int u = threadIdx.x; u < (LDS_BYTES - LDSCTL_OFF) / 4; u += 512) ((LAS unsigned*)(lds + LDSCTL_OFF))[u] = 0u;
    __syncthreads();
    XcdBarrier bar; bar.bar = (unsigned*)(ctl + CW_BAR) + args.li * XCD_BAR_WORDS; bar.x = 0; bar.st = nullptr;
    if (!MK_PER_PHASE) bar = xcd_barrier_post((unsigned*)(ctl + CW_BAR) + args.li * XCD_BAR_WORDS, MISC + 8);
    const int lo = args.ph_lo, hi = args.ph_hi;
#ifndef NO_CONV
#define NO_CONV 0
#endif
#ifndef NO_ATT
#define NO_ATT 0
#endif
#ifndef PHASE_MASK
#define PHASE_MASK 0x1FFFF
#endif
#define IN(k) ((((PHASE_MASK) >> (k)) & 1) && lo <= (k) && (k) < hi)
#define SPLIT_CNT(b) ((unsigned*)(ctl + CW_SPLIT + (args.li * 6 + (b)) * 16384))
#define SLABS(mib) ((float*)(ws + (size_t)(mib) * MiB))
#define SEAM(k) do { if (IN(k) && IN((k) + 1)) xcd_barrier(bar); } while (0)

    if (IN(0)) {
        FRESH();
        asm volatile("; ==== PHASE 0 ====");
        for (int it = bx; it < 192; it += G) {
            const int layer = it / 96, cb = it % 96, col = cb * 64 + lane;
            LAS float* sil = (LAS float*)lds; LAS float* red = (LAS float*)(lds + 12288);
            for (int i = tid; i < 3072; i += 512) { const int r = i >> 10, k = i & 1023; const float c = (r == 0) ? args.in[I_CCTX][k] : args.in[I_C][(r - 1) * DM + k]; sil[i] = c / (1.f + fexp(-c)); }
            __syncthreads();
            const float* W = args.in[layer ? I_ADA1_W : I_ADA0_W]; float a0 = 0.f, a1 = 0.f, a2 = 0.f;
#pragma unroll 8
            for (int kk = 0; kk < 128; ++kk) { const int k = wave * 128 + kk; const float w = W[(size_t)k * 6144 + col]; a0 += sil[k] * w; a1 += sil[1024 + k] * w; a2 += sil[2048 + k] * w; }
            red[(wave * 3 + 0) * 64 + lane] = a0; red[(wave * 3 + 1) * 64 + lane] = a1; red[(wave * 3 + 2) * 64 + lane] = a2;
            __syncthreads();
            if (tid < 192) { const int r = tid >> 6, l = tid & 63; float s = 0.f;
#pragma unroll
                for (int w = 0; w < 8; ++w) s += red[(w * 3 + r) * 64 + l];
                MODS[(size_t)(layer * 3 + r) * 6144 + cb * 64 + l] = s + args.in[layer ? I_ADA1_B : I_ADA0_B][cb * 64 + l]; }
            __syncthreads();
        }
        {
            LAS float* scr = (LAS float*)(lds + wave * 16384);
            for (int it = gw; it < WI_L0; it += NGW) weight_item(args, ws, scr, it, lane);
        }
        for (int i = gt; i < 2048 * 128; i += NGT) { const int kp = i >> 7, c8 = (i & 127) * 8; const int part = kp >> 10, kq = kp & 1023, g = kq >> 7, cp = kq & 127; unsigned w[4] = {0u, 0u, 0u, 0u};
            if ((c8 >> 7) == g) {
#pragma unroll
                for (int e = 0; e < 8; e += 2) { const float r0 = (float)((cp * ((c8 + e) & 127)) & 127) * (1.f / 128.f), r1 = (float)((cp * ((c8 + e + 1) & 127)) & 127) * (1.f / 128.f);
                    const float a = (part ? -__builtin_amdgcn_sinf(r0) : __builtin_amdgcn_cosf(r0)) * 0.08838834764831845f, b = (part ? -__builtin_amdgcn_sinf(r1) : __builtin_amdgcn_cosf(r1)) * 0.08838834764831845f;
                    w[e >> 1] = pk2(a, b); } }
            ((v4u*)(ws + WS_CBD))[i] = (v4u){w[0], w[1], w[2], w[3]}; }
        {
            const v4u z = {0u, 0u, 0u, 0u};
            for (int i = gt; i < 8192 + 16384 + MKV * 16; i += NGT) {
                if (i < 8192) ((v4u*)(ws + WS_WIN_T + (size_t)1984 * 2048))[i] = z;
                else if (i < 8192 + 16384) { const int j = i - 8192; *(v4u*)(ws + WS_KVUP_T + (size_t)(j >> 4) * 512 + 256 + (j & 15) * 16) = z; }
                else { const int j = i - 8192 - 16384; *(v4u*)(ws + WS_KVN + (size_t)(j >> 4) * 512 + 256 + (j & 15) * 16) = z; }
            }
        }
        for (int i = gt; i < 65536; i += NGT) { const int rho = i >> 8, l = i & 255; const int k = rho > 128 ? rho - 128 : rho; const float rev = (float)((k * l) & 255) * (1.f / 256.f);
            ((bf16*)(ws + WS_D256))[i] = (bf16)f2bf((rho > 128 ? __builtin_amdgcn_sinf(rev) : __builtin_amdgcn_cosf(rev)) * 0.0625f); }
        {
            float* H2 = (float*)(ws + WS_H2);
            const float* w1 = args.in[I_HFW1]; const float* w2 = args.in[I_HFW2];
            const float b1 = args.in[I_HFB1][lane], b2 = args.in[I_HFB2][lane], fr = args.in[I_HFFREQ][lane];
            for (int R = gw; R < LS + LP; R += NGW) {
                const int L = R < LS ? LS : LP, l = R < LS ? R : R - LS;
                const float t = (float)l / (float)(L - 1);
                const float wang = (6.283185307179586f * (float)l) / (float)L;
                const int j = lane & 15; const float band = 1e-4f + (float)j * ((15.0f - 1e-4f) / 15.0f);
                const float ang = wang * band, rev = ang * INV_2PI;
                const float zl = (lane < 16) ? fcos_rev(rev) : -fsin_rev(rev);
                float p1 = b1 + t * w1[lane];
#pragma unroll
                for (int i = 0; i < 32; ++i) p1 += __shfl(zl, i) * w1[(1 + i) * 64 + lane];
                const float h1 = sinf(fr * p1);
                float p2 = b2;
#pragma unroll 16
                for (int i = 0; i < 64; ++i) p2 += __shfl(h1, i) * w2[i * 64 + lane];
                H2[(size_t)R * 64 + lane] = sinf(fr * p2);
            }
        }
    }
    SEAM(0);

    if (IN(1)) {
        FRESH();
        asm volatile("; ==== PHASE 1 ====");
        for (int m = gw; m < MT; m += NGW) {
            const float* xr = m < NP ? args.in[I_XP] + (size_t)m * DM : args.in[I_XS] + (size_t)(m - NP) * DM;
            const float* md = MODS + (size_t)req_of_row(m) * 6144;
            f32x4 v[4]; load_row(xr, lane, v); adaln_store(v, md, md + 1024, HB + (size_t)m * DM, lane);
        }
        {
            const float* H2 = (const float*)(ws + WS_H2); const float* w3 = args.in[I_HFW3];
            LAS float* w3l = (LAS float*)(lds + wave * 16384);
            for (int it = gw; it < 68 * 32; it += NGW) {
                const int lb = it >> 5, cg = it & 31; const bool smp = lb < 64; const int L = smp ? LS : LP; const int l = (smp ? lb : lb - 64) * 64 + lane; const int R = lb * 64 + lane;
#pragma unroll
                for (int q = 0; q < 32; ++q) { const int o = 2 * q + (lane >> 5); w3l[(lane & 31) * 68 + o] = w3[o * 1024 + cg * 32 + (lane & 31)]; }
                float h2[64];
#pragma unroll
                for (int q = 0; q < 16; ++q) { const f32x4 x = ((const f32x4*)(H2 + (size_t)R * 64))[q]; h2[4 * q] = x[0]; h2[4 * q + 1] = x[1]; h2[4 * q + 2] = x[2]; h2[4 * q + 3] = x[3]; }
                LDS_WAIT(); asm volatile("" ::: "memory");
                const float t = (float)l / (float)(L - 1);
                float* FP = (float*)(ws + (smp ? WS_FPART_S : WS_FPART_P));
                float av[32];
#pragma unroll
                for (int cc = 0; cc < 32; ++cc) {
                    const int col = cg * 32 + cc, ch = col & 511, half = col >> 9;
                    float a = 0.f;
#pragma unroll
                    for (int q = 0; q < 16; ++q) { const f32x4 w4 = *(const LAS f32x4*)(w3l + cc * 68 + 4 * q); a += (h2[4 * q] * w4[0] + h2[4 * q + 1] * w4[1]) + (h2[4 * q + 2] * w4[2] + h2[4 * q + 3] * w4[3]); }
                    const float delta = fabsf(-3.0701134573253944f + (float)ch * ((-15.350567286626973f + 3.0701134573253944f) / 511.0f));
                    const float val = a * fexp(-t * delta);
                    if (smp) {
                        bf16* GRB = (bf16*)(ws + WS_FT_S) + (size_t)ch * 8192;
                        if (half == 0) GRB[LS - l] = (bf16)f2bf(val); else GRB[l == 0 ? 0 : LS + l] = (bf16)(l == 0 ? 0u : f2bf(val));
                    } else ((float*)(ws + WS_FT_P))[(size_t)col * LP + l] = val;
                    av[cc] = fabsf(val);
                }
#pragma unroll
                for (int o = 1; o < 64; o <<= 1) {
#pragma unroll
                    for (int cc = 0; cc < 32; ++cc) av[cc] += __shfl_xor(av[cc], o); }
                if (lane < 32) { float sel = av[0];
#pragma unroll
                    for (int cc = 1; cc < 32; ++cc) sel = (lane == cc) ? av[cc] : sel;
                    FP[(cg * 32 + lane) * (smp ? 64 : 4) + (smp ? lb : lb - 64)] = sel; }
                LDS_WAIT(); asm volatile("" ::: "memory");
            }
        }
    }
    SEAM(1);

    if (IN(2)) {
        FRESH();
        asm volatile("; ==== PHASE 2 ====");
        pg8::Gemm g{HB, (const bf16*)(ws + WS_WIN_T), MT, WINP, DM}; pg8::StaticOrder S; S.init(MT, WINP, G, bx);
        EpiWin E{(bf16*)(ws + WS_P), (float*)(ws + WS_ZS)};
        pg8::gemm_phase<EpiWin, pg8::StaticOrder, PG8_ALIGN, PG8_SP2>(lds, g, S, E, tid);
    }
    SEAM(2);

    if (IN(3)) {
        FRESH();
        asm volatile("; ==== PHASE 3 ====");
        const bf16* P = (const bf16*)(ws + WS_P);
        for (int it = bx; it < MT / 64; it += G) {
            const int m0 = it * 64; const bool smp = m0 >= NP; const int L = smp ? LS : LP; const int l0 = smp ? (m0 - NP) % LS : m0 % LP;
            const int seq = smp ? (m0 - NP) / LS : m0 / LP;
            const int c = tid;
            const float* cw = args.in[I_CONVW]; const float* cb = args.in[I_CONVB];
            float w[3][3], bb[3];
#pragma unroll
            for (int s = 0; s < 3; ++s) { bb[s] = cb[s * 512 + c];
#pragma unroll
                for (int k = 0; k < 3; ++k) w[s][k] = cw[k * 1536 + s * 512 + c]; }
            float prev[3], cur[3];
#pragma unroll
            for (int s = 0; s < 3; ++s) { prev[s] = (l0 > 0) ? bf2f(P[(size_t)(m0 - 1) * 1536 + s * 512 + c]) : 0.f; cur[s] = bf2f(P[(size_t)m0 * 1536 + s * 512 + c]); }
            LAS bf16* ut = (LAS bf16*)lds;
            bf16* X0 = (bf16*)(ws + WS_X0);
            for (int i0 = 0; i0 < 64; i0 += 8) {
                float nx[8][3];
#pragma unroll
                for (int i = 0; i < 8; ++i) { const bool has_next = (l0 + i0 + i + 1) < L;
#pragma unroll
                    for (int s = 0; s < 3; ++s) { const float v = bf2f(P[(size_t)(m0 + i0 + i + (has_next ? 1 : 0)) * 1536 + s * 512 + c]); nx[i][s] = has_next ? v : 0.f; } }
#pragma unroll
                for (int i = 0; i < 8; ++i) {
                    float y[3];
#pragma unroll
                    for (int s = 0; s < 3; ++s) y[s] = prev[s] * w[s][0] + cur[s] * w[s][1] + nx[i][s] * w[s][2] + bb[s];
                    X0[(size_t)(m0 + i0 + i) * 512 + c] = (bf16)f2bf(y[0]);
                    ut[c * 68 + i0 + i] = (bf16)f2bf(y[2] * y[1]);
#pragma unroll
                    for (int s = 0; s < 3; ++s) { prev[s] = cur[s]; cur[s] = nx[i][s]; }
                }
            }
            __syncthreads();
            bf16* UT = (bf16*)(ws + (smp ? WS_UT_S : WS_UT_P)) + (size_t)seq * 512 * L + l0;
            for (int q = tid; q < 512 * 16; q += 512) { const int ch = q >> 4, part = q & 15; const v2u v = *(const LAS v2u*)(ut + ch * 68 + part * 4); *(v2u*)(UT + (size_t)ch * L + part * 4) = v; }
            __syncthreads();
        }
        const float* ZS = (const float*)(ws + WS_ZS);
        bf16* QN = (bf16*)(ws + WS_QN); bf16* KVN = (bf16*)(ws + WS_KVN);
        for (int m = gw; m < MKV; m += NGW) {
            if (m < MT) {
                const bool smp = m >= NP; const int b = smp ? (m - NP) / LS : m / LP, key = smp ? (m - NP) % LS : m % LP;
                const f32x4 a0 = ((const f32x4*)(ZS + (size_t)m * 512))[2 * lane], a1 = ((const f32x4*)(ZS + (size_t)m * 512))[2 * lane + 1];
                float x[8] = {a0[0], a0[1], a0[2], a0[3], a1[0], a1[1], a1[2], a1[3]};
                float ss = 0.f;
                if (lane < 48) {
#pragma unroll
                    for (int i = 0; i < 8; ++i) ss += x[i] * x[i]; }
#pragma unroll
                for (int o = 1; o < 32; o <<= 1) ss += __shfl_xor(ss, o);
                if (lane < 32) {
                    const float r = __builtin_amdgcn_rsqf(ss * (1.f / QL) + RMS_EPS); const float* g = args.in[I_QNORM] + 8 * lane;
                    v4u w; w.x = pk2(x[0] * r * g[0], x[1] * r * g[1]); w.y = pk2(x[2] * r * g[2], x[3] * r * g[3]); w.z = pk2(x[4] * r * g[4], x[5] * r * g[5]); w.w = pk2(x[6] * r * g[6], x[7] * r * g[7]);
                    *(v4u*)(QN + (size_t)m * 256 + 8 * lane) = w;
                } else if (lane < 48) {
                    const int c0 = 8 * (lane - 32); const float r = __builtin_amdgcn_rsqf(ss * (1.f / KVL) + RMS_EPS); const float* g = args.in[I_KVNORM] + c0;
                    float y[8];
#pragma unroll
                    for (int i = 0; i < 8; ++i) y[i] = x[i] * r * g[i];
                    v4u w; w.x = pk2(y[0], y[1]); w.y = pk2(y[2], y[3]); w.z = pk2(y[4], y[5]); w.w = pk2(y[6], y[7]);
                    *(v4u*)(KVN + (size_t)m * 256 + c0) = w;
                    if (!smp) { float* o = args.out + OUT_CKV + (size_t)m * KVL + c0; *(f32x4*)o = (f32x4){y[0], y[1], y[2], y[3]}; *(f32x4*)(o + 4) = (f32x4){y[4], y[5], y[6], y[7]}; }
                }
                {
                    float y[8];
                    const int q = lane - 48; const int seg = (q >> 2) & 1; const bool second = (q & 2) != 0; const int j0 = 8 * (q & 1);
                    const float pf = (float)(seg == 0 ? (key >> 6) : (key & 63));
#pragma unroll
                    for (int i = 0; i < 8; ++i) { const float pr = __shfl_xor(x[i], 2);
                        if (smp) { const float inv = __builtin_amdgcn_exp2f(-(float)(j0 + i) * (13.287712379549449f / 16.0f)); const float rev = pf * inv * INV_2PI;
                            y[i] = x[i] * fcos_rev(rev) + (second ? pr : -pr) * fsin_rev(rev); }
                        else y[i] = x[i]; }
                    if (lane >= 48 && lane < 56) {
                        const int kk = 8 * q;
                        if (!smp) { float* o = args.out + OUT_CKR + (size_t)m * DROPE + kk; *(f32x4*)o = (f32x4){y[0], y[1], y[2], y[3]}; *(f32x4*)(o + 4) = (f32x4){y[4], y[5], y[6], y[7]}; }
                        v4u w; w.x = pk2(y[0], y[1]); w.y = pk2(y[2], y[3]); w.z = pk2(y[4], y[5]); w.w = pk2(y[6], y[7]);
                        bf16* kf = (bf16*)(ws + (smp ? WS_KF_S : WS_KF_P)); const int lk = smp ? LKS : LP;
#pragma unroll
                        for (int h = 0; h < NH; ++h) *(v4u*)(kf + ((size_t)(b * NH + h) * lk + key) * DQK + DNOPE + kk) = w;
                    }
                }
            } else {
                const int mm = m - MT, b = mm / PAST, j = mm % PAST;
                if (lane < 16) { const float* s = args.in[I_CKV] + (size_t)mm * KVL + 8 * lane;
                    v4u w; w.x = pk2(s[0], s[1]); w.y = pk2(s[2], s[3]); w.z = pk2(s[4], s[5]); w.w = pk2(s[6], s[7]); *(v4u*)(KVN + (size_t)m * 256 + 8 * lane) = w; }
                else if (lane < 24) { const int kk = 8 * (lane - 16); const float* s = args.in[I_CKR] + (size_t)mm * DROPE + kk;
                    v4u w; w.x = pk2(s[0], s[1]); w.y = pk2(s[2], s[3]); w.z = pk2(s[4], s[5]); w.w = pk2(s[6], s[7]);
                    bf16* kf = (bf16*)(ws + WS_KF_S);
#pragma unroll
                    for (int h = 0; h < NH; ++h) *(v4u*)(kf + ((size_t)(b * NH + h) * LKS + LS + j) * DQK + DNOPE + kk) = w; }
            }
        }
    }
    SEAM(3);

    if (IN(4)) {
        FRESH();
        asm volatile("; ==== PHASE 4 ====");
        int k256 = 256; asm volatile("" : "+s"(k256));
        { pg8::Gemm g{(const bf16*)(ws + WS_QN), (const bf16*)(ws + WS_QUP_T), MT, 768, k256}; pg8::StaticOrder S; S.init(MT, 768, G, bx);
          EpiStore E{(bf16*)(ws + WS_Q), 768};
          pg8::gemm_phase<EpiStore, pg8::StaticOrder, PG8_ALIGN, PG8_SP2>(lds, g, S, E, tid); }
        { int bx2 = (bx + 144) % G; asm volatile("" : "+s"(bx2)); const int lane2 = fresh_lane(); const int tid = wave * 64 + lane2;
          pg8::Gemm g{(const bf16*)(ws + WS_KVN), (const bf16*)(ws + WS_KVUP_T), MKV, 1024, k256}; pg8::StaticOrder S; S.init(MKV, 1024, G, bx2);
          EpiKV E{(bf16*)(ws + WS_KF_S), (bf16*)(ws + WS_KF_P), (bf16*)(ws + WS_V_S), (bf16*)(ws + WS_V_P)};
          pg8::gemm_phase<EpiKV, pg8::StaticOrder, PG8_ALIGN, PG8_SP2>(lds, g, S, E, tid); }
        { int bx3 = (bx + 88) % G; asm volatile("" : "+s"(bx3)); const int lane3 = fresh_lane(); const int tid = wave * 64 + lane3;
          pg8::Gemm g{(const bf16*)(ws + WS_W1T), (const bf16*)(ws + WS_CBD), DM, 2048, DM}; pg8::StaticOrder S; S.init(DM, 2048, G, bx3);
          EpiStore E{(bf16*)(ws + WS_WFOLD_T), 2048};
          pg8::gemm_phase<EpiStore, pg8::StaticOrder, PG8_ALIGN, PG8_SP2>(lds, g, S, E, tid); }
    }
    SEAM(4);

    if (IN(5)) {
        FRESH();
        asm volatile("; ==== PHASE 5 ====");
        constexpr int NA_S = 2 * BS * NH * (LS / 256), NC_S = HY / 4, NA_P = BP * NH, NC_P = HY / 2, NW_T = (WI_ALL - WI_L0) / 8, NITEM = NA_S + NC_S + NA_P + NC_P + NW_T;
        bf16* YM = HB;
        for (;;) {
            if (tid == 0) MISC[0] = __hip_atomic_fetch_add((unsigned*)(ctl + CW_Q + 64 * args.li), 1u, RLX_AGENT);
            __syncthreads();
            const int it = __builtin_amdgcn_readfirstlane((int)MISC[0]);
            __syncthreads();
            if (it >= NITEM) break;
            { const int cls = it < NA_S ? 0 : it < NA_S + NC_S ? 1 : it < NA_S + NC_S + NA_P ? 2 : it < NA_S + NC_S + NA_P + NC_P ? 3 : 4; if (!((args.mask >> cls) & 1)) continue; }
            const int lane = fresh_lane(); const int tid = wave * 64 + lane;
            const bool isA_S = it < NA_S, isA_P = (it >= NA_S + NC_S) && (it < NA_S + NC_S + NA_P);
            if (isA_S || isA_P) { if (!NO_ATT) {
                int b, h, row0, lk, pos0, koff = 0, nkeys; const bf16 *kf, *vv; float* part = nullptr; unsigned* cnt = nullptr;
                if (isA_S) { const int un = it >> 1, half = it & 1; b = un / (NH * 16); h = (un / 16) % NH; const int qb = un % 16; row0 = NP + b * LS + qb * 256; lk = LKS; pos0 = qb * 256; kf = (const bf16*)(ws + WS_KF_S); vv = (const bf16*)(ws + WS_V_S);
                    nkeys = LKS / 2; koff = half * (LKS / 2); part = (float*)(ws + WS_APART) + (size_t)un * APART_F; cnt = (unsigned*)(ctl + CW_ATT + args.li * 8192 + un * 64); }
                else { const int u = it - NA_S - NC_S; b = u / NH; h = u % NH; row0 = b * LP; lk = LP; pos0 = -1; kf = (const bf16*)(ws + WS_KF_P); vv = (const bf16*)(ws + WS_V_P); nkeys = LP; }
                att::attn_dense_body((const bf16*)(ws + WS_Q) + (size_t)row0 * 768 + h * DQK, kf + ((size_t)(b * NH + h) * lk + koff) * DQK, vv + ((size_t)(b * NH + h) * lk + koff) * DVH,
                                     YM + (size_t)row0 * DM + HY + h * DVH, nkeys, pos0, (LAS char*)lds, tid, part, cnt, MISC); }
            } else if (it < NA_S + NC_S) {
                hconv::item((const bf16*)(ws + WS_FT_S), (const bf16*)(ws + WS_UT_S), (const float*)(ws + WS_FPART_S), args.in[I_HFSKIP], (const bf16*)(ws + WS_X0), YM, (it - NA_S) * 4, lds, tid, lane, wave);
            } else if (it >= NA_S + NC_S + NA_P + NC_P) {
                LAS float* scr = (LAS float*)(lds + wave * 16384);
                weight_item(args, ws, scr, WI_L0 + (it - (NA_S + NC_S + NA_P + NC_P)) * 8 + wave, lane);
                __syncthreads();
            } else if (!NO_CONV) {
                const int ch0 = (it - NA_S - NC_S - NA_P) * 2;
                const float* FT = (const float*)(ws + WS_FT_P); const float* FP = (const float*)(ws + WS_FPART_P);
                const bf16* UT = (const bf16*)(ws + WS_UT_P);
                LAS float* Gs = (LAS float*)lds;
                LAS float* Us = (LAS float*)(lds + 8192);
                for (int q = tid; q < 2 * 512; q += 512) { const int cl = q >> 9, e = q & 511; if (e < 2 * LP - 1) { const int d = e - (LP - 1); const int ch = ch0 + cl;
                    Gs[cl * 576 + e + (e >> 4)] = d >= 0 ? FT[(size_t)ch * LP + d] : FT[(size_t)(512 + ch) * LP - d]; } }
                for (int q = tid; q < 2 * BP * LP / 8; q += 512) { const int cl = q >> 9, b = (q >> 5) & 15, l8 = (q & 31) * 8; const v4u v = *(const v4u*)(UT + ((size_t)b * 512 + ch0 + cl) * LP + l8);
                    LAS float* d = Us + (cl * BP + b) * LP + l8; d[0] = bf2f((unsigned short)(v.x & 0xffffu)); d[1] = bf2f((unsigned short)(v.x >> 16)); d[2] = bf2f((unsigned short)(v.y & 0xffffu)); d[3] = bf2f((unsigned short)(v.y >> 16));
                    d[4] = bf2f((unsigned short)(v.z & 0xffffu)); d[5] = bf2f((unsigned short)(v.z >> 16)); d[6] = bf2f((unsigned short)(v.w & 0xffffu)); d[7] = bf2f((unsigned short)(v.w >> 16)); }
                const int cl = tid >> 8, ch = ch0 + cl, b = (tid >> 4) & 15, t0 = (tid & 15) * 16;
                const float nsum = ((FP[ch * 4] + FP[ch * 4 + 1]) + (FP[ch * 4 + 2] + FP[ch * 4 + 3])) + ((FP[(512 + ch) * 4] + FP[(512 + ch) * 4 + 1]) + (FP[(512 + ch) * 4 + 2] + FP[(512 + ch) * 4 + 3]));
                const float inv_norm = 1.f / nsum, skip = args.in[I_HFSKIP][ch];
                const bf16* X0 = (const bf16*)(ws + WS_X0);
                float x0v[16];
#pragma unroll
                for (int i = 0; i < 16; ++i) x0v[i] = bf2f(X0[((size_t)b * LP + t0 + i) * 512 + ch]);
                __syncthreads();
                {
                    float y[16];
#pragma unroll
                    for (int i = 0; i < 16; ++i) y[i] = 0.f;
                    const LAS float* ub = Us + (cl * BP + b) * LP; const LAS float* gs = Gs + cl * 576;
                    for (int s0 = 0; s0 < LP; s0 += 16) {
                        const int base0 = t0 + LP - 1 - s0;
                        float W[31];
#pragma unroll
                        for (int j = 0; j < 31; ++j) { const int e = base0 - 15 + j; W[j] = gs[e + (e >> 4)]; }
#pragma unroll
                        for (int k = 0; k < 16; ++k) { const float uu = ub[s0 + k];
#pragma unroll
                            for (int i = 0; i < 16; ++i) y[i] += W[15 - k + i] * uu; }
                    }
#pragma unroll
                    for (int i = 0; i < 16; ++i) { const size_t row = (size_t)b * LP + t0 + i;
                        const float v = y[i] * inv_norm + skip * ub[t0 + i];
                        YM[row * DM + ch] = (bf16)f2bf(v * x0v[i]); }
                }
                __syncthreads();
            }
        }
    }
    SEAM(5);

    if (IN(6)) {
        FRESH();
        asm volatile("; ==== PHASE 6 ====");
        pg8::Gemm g{HB, (const bf16*)(ws + WS_WOUT0_T), MT, DM, DM}; pg8::StaticOrder S; S.init((MT / 192) * 256, DM, G, bx);
        EpiRes<3> E{args.in[I_XP], args.in[I_XS], MODS + 2 * 1024, T};
        pg8::gemm_phase<EpiRes<3>, pg8::StaticOrder, PG8_ALIGN, PG8_SP2, 3>(lds, g, S, E, tid);
    }
    SEAM(6);

    if (IN(7)) {
        FRESH();
        asm volatile("; ==== PHASE 7 ====");
        for (int m = gw; m < MT; m += NGW) {
            const float* md = MODS + (size_t)req_of_row(m) * 6144;
            f32x4 v[4]; load_row(T + (size_t)m * DM, lane, v); ln_affine(v, args.in[I_LN1G0], args.in[I_LN1B0], lane); store_row(X + (size_t)m * DM, lane, v);
            adaln_store(v, md + 3 * 1024, md + 4 * 1024, HB + (size_t)m * DM, lane);
        }
    }
    SEAM(7);

    if (IN(8)) {
        FRESH();
        asm volatile("; ==== PHASE 8 ====");
        pg8::Gemm g{HB, (const bf16*)(ws + WS_W1_0), MT, FF, DM}; pg8::StaticOrder S; S.init(MT, FF, G, bx);
        EpiUp E{(bf16*)(ws + WS_HID)};
        pg8::gemm_phase<EpiUp, pg8::StaticOrder, PG8_ALIGN, PG8_SP2>(lds, g, S, E, tid);
    }
    SEAM(8);

    if (IN(9)) {
        FRESH();
        asm volatile("; ==== PHASE 9 ====");
        pg8::Gemm g{(const bf16*)(ws + WS_HID), (const bf16*)(ws + WS_W2_0), MT, DM, FF}; pg8::StaticOrder S; S.init((MT / 192) * 256, DM, G, bx);
        EpiRes<3> E{X, X + (size_t)NP * DM, MODS + 5 * 1024, T};
        pg8::gemm_phase<EpiRes<3>, pg8::StaticOrder, PG8_ALIGN, PG8_SP2, 3>(lds, g, S, E, tid);
    }
    SEAM(9);

    if (IN(10)) {
        FRESH();
        asm volatile("; ==== PHASE 10 ====");
        const float* MODS1 = MODS + 3 * 6144;
        for (int it = bx; it < MT / 32; it += G) {
            const int m0 = it * 32; const bool smp = m0 >= NP; const int L = smp ? LS : LP; const int l0 = smp ? (m0 - NP) % LS : m0 % LP; const int seq = smp ? (m0 - NP) / LS : m0 / LP;
            LAS bf16* ht = (LAS bf16*)lds;
            const float* md = MODS1 + (size_t)req_of_row(m0) * 6144;
            for (int rr = 0; rr < 4; ++rr) { const int i = wave * 4 + rr, m = m0 + i;
                f32x4 v[4]; load_row(T + (size_t)m * DM, lane, v); ln_affine(v, args.in[I_LN2G0], args.in[I_LN2B0], lane); store_row(X + (size_t)m * DM, lane, v);
                float mean, rstd; row_stats(v, mean, rstd);
#pragma unroll
                for (int j = 0; j < 4; ++j) { const int c = 4 * lane + 256 * j; const f32x4 sc = *(const f32x4*)(md + 1024 + c), sh = *(const f32x4*)(md + c);
                    const f32x4 h = (v[j] - mean) * rstd * (sc + 1.0f) + sh;
#pragma unroll
                    for (int e = 0; e < 4; ++e) ht[(c + e) * 40 + i] = (bf16)f2bf(h[e]); }
            }
            __syncthreads();
            bf16* HT = HB + (smp ? (size_t)NP * DM + (size_t)seq * DM * LS : (size_t)seq * DM * LP) + l0;
            for (int q = tid; q < 1024 * 4; q += 512) { const int c = q >> 2, part = q & 3; const v4u v = *(const LAS v4u*)(ht + c * 40 + part * 8); *(v4u*)(HT + (size_t)c * L + part * 8) = v; }
            __syncthreads();
        }
        for (size_t i = gt; i < (size_t)LS * LS / 8; i += NGT) {
            const int rho = (int)(i >> 9), l8 = (int)(i & 511) * 8; const int k = rho > 2048 ? rho - 2048 : rho; unsigned w[4];
#pragma unroll
            for (int e = 0; e < 8; e += 2) { const float r0 = (float)((k * (l8 + e)) & 4095) * (1.f / 4096.f), r1 = (float)((k * (l8 + e + 1)) & 4095) * (1.f / 4096.f);
                const float a = (rho > 2048 ? __builtin_amdgcn_sinf(r0) : __builtin_amdgcn_cosf(r0)) * 0.015625f, b = (rho > 2048 ? __builtin_amdgcn_sinf(r1) : __builtin_amdgcn_cosf(r1)) * 0.015625f;
                w[e >> 1] = pk2(a, b); }
            ((v4u*)(ws + WS_D4096))[i] = (v4u){w[0], w[1], w[2], w[3]};
        }
    }
    SEAM(10);

    if (IN(11)) {
        FRESH();
        asm volatile("; ==== PHASE 11 ====");
        { pg8::Gemm g{(const bf16*)(ws + WS_D4096), HB + (size_t)NP * DM, LS, BS * DM, LS}; pg8::SplitOrder S; S.init(LS, BS * DM, LS, G, vcu, SLABS(200), SPLIT_CNT(3));
          EpiDft E{(bf16*)(ws + WS_UV), LS, NP};
          pg8::gemm_phase<EpiDft, pg8::SplitOrder, PG8_ALIGN, PG8_SP2>(lds, g, S, E, tid); }
        { int bx2 = (bx + 128) % G; asm volatile("" : "+s"(bx2)); const int lane2 = fresh_lane(); const int tid = wave * 64 + lane2;
          pg8::Gemm g{(const bf16*)(ws + WS_D256), HB, LP, BP * DM, LP}; pg8::StaticOrder S; S.init(LP, BP * DM, G, bx2);
          EpiDft E{(bf16*)(ws + WS_UV), LP, 0};
          pg8::gemm_phase<EpiDft, pg8::StaticOrder, PG8_ALIGN, PG8_SP2>(lds, g, S, E, tid); }
    }
    SEAM(11);

    if (IN(12)) {
        FRESH();
        asm volatile("; ==== PHASE 12 ====");
        pg8::Gemm g{(const bf16*)(ws + WS_UV), (const bf16*)(ws + WS_WFOLD_T), MT, DM, 2048}; pg8::StaticOrder S; S.init((MT / 192) * 256, DM, G, bx);
        EpiRes<3> E{X, X + (size_t)NP * DM, MODS + 3 * 6144 + 2 * 1024, T};
        pg8::gemm_phase<EpiRes<3>, pg8::StaticOrder, PG8_ALIGN, PG8_SP2, 3>(lds, g, S, E, tid);
    }
    SEAM(12);

    if (IN(13)) {
        FRESH();
        asm volatile("; ==== PHASE 13 ====");
        for (int m = gw; m < MT; m += NGW) {
            const float* md = MODS + 3 * 6144 + (size_t)req_of_row(m) * 6144;
            f32x4 v[4]; load_row(T + (size_t)m * DM, lane, v); ln_affine(v, args.in[I_LN1G1], args.in[I_LN1B1], lane); store_row(X + (size_t)m * DM, lane, v);
            adaln_store(v, md + 3 * 1024, md + 4 * 1024, HB + (size_t)m * DM, lane);
        }
    }
    SEAM(13);

    if (IN(14)) {
        FRESH();
        asm volatile("; ==== PHASE 14 ====");
        pg8::Gemm g{HB, (const bf16*)(ws + WS_W1_1), MT, FF, DM}; pg8::StaticOrder S; S.init(MT, FF, G, bx);
        EpiUp E{(bf16*)(ws + WS_HID)};
        pg8::gemm_phase<EpiUp, pg8::StaticOrder, PG8_ALIGN, PG8_SP2>(lds, g, S, E, tid);
    }
    SEAM(14);

    if (IN(15)) {
        FRESH();
        asm volatile("; ==== PHASE 15 ====");
        pg8::Gemm g{(const bf16*)(ws + WS_HID), (const bf16*)(ws + WS_W2_1), MT, DM, FF}; pg8::StaticOrder S; S.init((MT / 192) * 256, DM, G, bx);
        EpiRes<3> E{X, X + (size_t)NP * DM, MODS + 3 * 6144 + 5 * 1024, T};
        pg8::gemm_phase<EpiRes<3>, pg8::StaticOrder, PG8_ALIGN, PG8_SP2, 3>(lds, g, S, E, tid);
    }
    SEAM(15);

    if (IN(16)) {
        FRESH();
        asm volatile("; ==== PHASE 16 ====");
        for (int m = gw; m < MT; m += NGW) {
            f32x4 v[4]; load_row(T + (size_t)m * DM, lane, v); ln_affine(v, args.in[I_LN2G1], args.in[I_LN2B1], lane); store_row(X + (size_t)m * DM, lane, v);
        }
    }
#undef IN
#undef SEAM
}

extern "C" void kernel_launch(void* const* d_in, const int* in_sizes, int n_in, void* d_out, int out_size, void* d_ws, size_t ws_size, hipStream_t stream) {
    static int grid = 0;
    if (grid == 0) {
        if (n_in != 38 || ws_size < WS_END) { fprintf(stderr, "kernel_launch: expected 38 inputs and >= %zu bytes of workspace; got %d, %zu\n", (size_t)WS_END, n_in, ws_size); grid = -1; return; }
        int dev = 0, cus = 0;
        if (hipGetDevice(&dev) != hipSuccess || hipDeviceGetAttribute(&cus, hipDeviceAttributeMultiprocessorCount, dev) != hipSuccess) { grid = -1; return; }
        if (hipFuncSetAttribute((const void*)fwd_kernel, hipFuncAttributeMaxDynamicSharedMemorySize, LDS_BYTES) != hipSuccess) { fprintf(stderr, "kernel_launch: hipFuncSetAttribute failed\n"); grid = -1; return; }
        int per_cu = 0;
        if (hipOccupancyMaxActiveBlocksPerMultiprocessor(&per_cu, (const void*)fwd_kernel, 512, LDS_BYTES) != hipSuccess || per_cu < 1) fprintf(stderr, "kernel_launch: occupancy query reports %d\n", per_cu);
        (void)hipGetLastError();
        grid = cus;
    }
    if (grid < 0) return;
    (void)hipMemsetAsync((char*)d_ws + WS_CTL, 0, CTL_ZERO_BYTES, stream);
    Args a{};
    for (int i = 0; i < 38; ++i) a.in[i] = (const float*)d_in[i];
    a.out = (float*)d_out; a.ws = (unsigned char*)d_ws;
#if MK_PER_PHASE
    for (int p = 0; p < NPHASE; ++p) { a.ph_lo = p; a.ph_hi = p + 1; a.li = 0; a.mask = 31; hipLaunchKernelGGL(fwd_kernel, dim3(grid), dim3(512), LDS_BYTES, stream, a); }
#elif defined(PROBE_A)
#ifndef PROBE_MASK5
#define PROBE_MASK5 31
#endif
    a.mask = 31; a.ph_lo = 0; a.ph_hi = PROBE_B; a.li = 0; hipLaunchKernelGGL(fwd_kernel, dim3(grid), dim3(512), LDS_BYTES, stream, a);
    a.mask = PROBE_MASK5; a.ph_lo = PROBE_A; a.ph_hi = NPHASE; a.li = 1; hipLaunchKernelGGL(fwd_kernel, dim3(grid), dim3(512), LDS_BYTES, stream, a);
#else
    a.ph_lo = 0; a.ph_hi = NPHASE; a.li = 0; a.mask = 31;
    hipLaunchKernelGGL(fwd_kernel, dim3(grid), dim3(512), LDS_BYTES, stream, a);
#endif
    const hipError_t le = hipPeekAtLastError();
    if (le != hipSuccess) fprintf(stderr, "kernel_launch: launch failed: %s\n", hipGetErrorName(le));
}
```

```cpp
#include <hip/hip_runtime.h>
#include <hip/hip_bf16.h>
#include <cstdio>
#include <cstdint>
#include <cmath>
namespace pg8 {
#define PG8_LAS __attribute__((address_space(3)))
typedef unsigned short bf16_t;
typedef short bf16x8 __attribute__((ext_vector_type(8)));
typedef float f32x4 __attribute__((ext_vector_type(4)));
typedef unsigned u32x4 __attribute__((ext_vector_type(4)));
constexpr int BM = 256, BK = 64, HALF = 128, HTB = HALF * BK * 2  , STAGE_BYTES = 8 * HTB, NXCD = 8, WGM = 8;

__host__ __device__ __forceinline__ int lds_byte(int r, int c) { const int st = (r >> 4) * 2 + (c >> 5), rr = r & 15, cc = c & 31, ob = rr * 64 + cc * 2; return st * 1024 + (ob ^ (((ob >> 9) & 1) << 5)); }
__host__ __device__ __forceinline__ void stage_rc(int b, int& R, int& C) { const int st = b / 1024, sb = b % 1024, swz = sb ^ (((sb >> 9) & 1) << 5); R = (st >> 1) * 16 + swz / 64; C = (st & 1) * 32 + (swz % 64) / 2; }
__host__ __device__ __forceinline__ int perm32(int rho) { const int n = rho >> 4, i = rho & 15; return 8 * (i >> 2) + 4 * n + (i & 3); }

struct Unit { int pm, pn; int k0, nt, mode, slab, need, tile; };
struct Gemm { const bf16_t* A; const bf16_t* Bt; int M, N, K; };

struct StaticOrder {
    int nM, nN, nwg, G, c;
    __host__ __device__ void init(int M, int N, int G_, int c_) { nM = M / BM; nN = N / BM; nwg = nM * nN; G = G_; c = c_; }
    __host__ __device__ bool next(int i, Unit& u) const {
        const long L = (long)i * G + c; if (L >= nwg) return false;
        int wgid = (int)L; { const int q = nwg / NXCD, r = nwg % NXCD, xcd = wgid % NXCD, off = wgid / NXCD; wgid = (xcd < r ? xcd * (q + 1) : r * (q + 1) + (xcd - r) * q) + off; }
        const int nig = WGM * nN, gid = wgid / nig, fm = gid * WGM, gsz = (nM - fm) < WGM ? (nM - fm) : WGM;
        u.pm = fm + ((wgid % nig) % gsz); u.pn = (wgid % nig) / gsz; u.k0 = 0; u.nt = 0; u.mode = 0; u.slab = 0; u.need = 0; u.tile = 0; return true;
    }
    static constexpr bool SPLIT = false;
    __device__ __forceinline__ void a_ready(const Unit&) const {}
    __device__ __forceinline__ void done(const Unit&) const {}
};

struct SplitOrder {
    static constexpr bool SPLIT = true;
    int nM, nN, NT, per, c, lo, hi, tf, ns, give_last, P; float* slabs; unsigned* cnt;
    __device__ __forceinline__ void init(int M, int N, int K, int G_, int c_, float* slabs_, unsigned* cnt_) {
        nM = M / BM; nN = N / BM; NT = K / BK; c = c_; slabs = slabs_; cnt = cnt_;
        const int TU = nM * nN * NT; per = (TU + G_ - 1) / G_; per += per & 1;
        lo = c * per; hi = lo + per < TU ? lo + per : TU; if (lo >= TU) { lo = 0; hi = 0; }
        tf = lo / NT; ns = hi > lo ? (hi - 1) / NT - tf + 1 : 0; give_last = (hi % NT) != 0 ? 1 : 0;
        int a = per, b = NT; while (b) { const int t = a % b; a = b; b = t; } P = NT / a;
    }
    __device__ __forceinline__ int giver_index(int j) const { return j - j / P; }
    __device__ __forceinline__ bool next(int i, Unit& u) const {
        if (i >= ns) return false;
        int sidx; if (ns == 1) sidx = 0; else if (give_last && i == 0) sidx = ns - 1; else if (i == ns - 1) sidx = 0; else sidx = i - give_last + 1;
        const int T = tf + sidx, tlo = T * NT, thi = tlo + NT; const int a = lo > tlo ? lo : tlo, b = hi < thi ? hi : thi;
        const int nig = WGM * nN, gid = T / nig, fm = gid * WGM, gsz = (nM - fm) < WGM ? (nM - fm) : WGM;
        u.pm = fm + ((T % nig) % gsz); u.pn = (T % nig) / gsz; u.k0 = a - tlo; u.nt = b - a; u.tile = T;
        if (b != thi) { u.mode = 1; u.slab = giver_index(c); u.need = 0; }
        else if (a != tlo) { const int c0 = tlo / per; u.mode = 2; u.slab = giver_index(c0); u.need = c - c0; }
        else { u.mode = 0; u.slab = 0; u.need = 0; }
        return true;
    }
    __device__ __forceinline__ void a_ready(const Unit&) const {}
    __device__ __forceinline__ void done(const Unit&) const {}
};
__device__ __forceinline__ unsigned cvt_pk_bf16(float lo, float hi) { unsigned r; asm volatile("v_cvt_pk_bf16_f32 %0, %1, %2" : "=v"(r) : "v"(lo), "v"(hi)); return r; }
template <class Epi, class Sched, bool ALIGN_EPI = false, bool SP2 = false, int MF = 4>
__device__ __forceinline__ void gemm_phase(PG8_LAS unsigned char* lds, const Gemm g, const Sched& S, const Epi& E, const int tid) {
    const int wid = __builtin_amdgcn_readfirstlane(tid >> 6), lane = tid & 63, wr = wid >> 2, wc = wid & 3, fr = lane & 15, fq = lane >> 4;
    const int K = g.K, nt = K / BK;
    unsigned voffA[2], voffB[2];
#pragma unroll
    for (int i = 0; i < 2; ++i) { int R, C; stage_rc(tid * 16 + i * 8192, R, C); const int Rb = Epi::PERM ? ((R & ~31) + perm32(R & 31)) : R;
        voffA[i] = (unsigned)(R * K + C) * 2u; voffB[i] = (unsigned)(Rb * K + C) * 2u; }
    const size_t kstep = (size_t)(BK * 2);
    const size_t hstepB = (size_t)HALF * K * 2, tstepB = 2 * hstepB;
    const size_t hstepA = (size_t)(32 * MF) * K * 2, tstepA = 2 * hstepA;
    const unsigned ldsw = (unsigned)wid * 1024u;
    const int aoff = lds_byte(wr * (16 * MF) + fr, fq * 8), boff = lds_byte(wc * 32 + fr, fq * 8);
#define PG8_SA(b, h) (((b) * 2 + (h)) * HTB)
#define PG8_SB(b, h) ((4 + (b) * 2 + (h)) * HTB)
#define PG8_STAGE(bufoff, gbase, voff) do { _Pragma("unroll") for (int _i = 0; _i < 2; ++_i) \
        __builtin_amdgcn_global_load_lds((const unsigned*)((const char*)(gbase) + (voff)[_i]), (PG8_LAS unsigned*)(lds + (bufoff) + ldsw + _i * 8192), 16, 0, 0); } while (0)
#define PG8_LDA(dst, b, h) do { _Pragma("unroll") for (int m = 0; m < MF; ++m) _Pragma("unroll") for (int k = 0; k < 2; ++k) dst[m][k] = *(const PG8_LAS bf16x8*)(lds + PG8_SA(b, h) + aoff + m * 2048 + k * 1024); } while (0)
#define PG8_LDB(dst, b, h) do { _Pragma("unroll") for (int n = 0; n < 2; ++n) _Pragma("unroll") for (int k = 0; k < 2; ++k) dst[n][k] = *(const PG8_LAS bf16x8*)(lds + PG8_SB(b, h) + boff + n * 2048 + k * 1024); } while (0)
#define PG8_MMA(ai, bj, At, Bt) do { __builtin_amdgcn_s_setprio(1); _Pragma("unroll") for (int m = 0; m < MF; ++m) _Pragma("unroll") for (int n = 0; n < 2; ++n) _Pragma("unroll") for (int k = 0; k < 2; ++k) \
        acc[ai][bj][m][n] = __builtin_amdgcn_mfma_f32_16x16x32_bf16(Bt[n][k], At[m][k], acc[ai][bj][m][n], 0, 0, 0); __builtin_amdgcn_s_setprio(0); } while (0)
#define PG8_WAIT_V(n) asm volatile("s_waitcnt vmcnt(" #n ")" ::: "memory")
#define PG8_WAIT_L(n) asm volatile("s_waitcnt lgkmcnt(" #n ")" ::: "memory")
#define PG8_BAR __builtin_amdgcn_s_barrier()
#define PG8_SCHED __builtin_amdgcn_sched_barrier(0)
    Unit cur, nxt; int ui = 0;
    if (!S.next(0, cur)) return;
    f32x4 acc[2][2][4][2];
#pragma unroll
    for (int a = 0; a < 2; ++a)
#pragma unroll
        for (int b = 0; b < 2; ++b)
#pragma unroll
            for (int m = 0; m < 4; ++m)
#pragma unroll
                for (int n = 0; n < 2; ++n) acc[a][b][m][n] = (f32x4){0.f, 0.f, 0.f, 0.f};
    bf16x8 At[4][2], B0[2][2], B1[2][2];
    const char* cA = (const char*)g.A + (size_t)cur.pm * tstepA + (size_t)cur.k0 * kstep; const char* cB = (const char*)g.Bt + (size_t)cur.pn * tstepB + (size_t)cur.k0 * kstep;
    S.a_ready(cur);
    if constexpr (SP2) {
        PG8_STAGE(PG8_SB(0, 0), cB, voffB); PG8_STAGE(PG8_SB(0, 1), cB + hstepB, voffB); PG8_STAGE(PG8_SA(0, 0), cA, voffA); PG8_STAGE(PG8_SA(0, 1), cA + hstepA, voffA);
        if (wr == 1) PG8_BAR;
        PG8_WAIT_V(2); PG8_BAR;
        PG8_STAGE(PG8_SB(1, 0), cB + kstep, voffB); PG8_STAGE(PG8_SA(1, 0), cA + kstep, voffA); PG8_STAGE(PG8_SB(1, 1), cB + hstepB + kstep, voffB);
        PG8_WAIT_V(6); PG8_BAR;
    } else {
        PG8_STAGE(PG8_SB(0, 0), cB, voffB); PG8_STAGE(PG8_SA(0, 0), cA, voffA); PG8_STAGE(PG8_SB(0, 1), cB + hstepB, voffB); PG8_STAGE(PG8_SA(0, 1), cA + hstepA, voffA);
        if (wr == 1) PG8_BAR;
        PG8_WAIT_V(4); PG8_BAR;
        PG8_STAGE(PG8_SB(1, 0), cB + kstep, voffB); PG8_STAGE(PG8_SA(1, 0), cA + kstep, voffA); PG8_STAGE(PG8_SB(1, 1), cB + hstepB + kstep, voffB);
        PG8_WAIT_V(6); PG8_BAR;
    }
    for (;;) {
        const bool has_next = S.next(ui + 1, nxt);
        const char* nA = has_next ? (const char*)g.A + (size_t)nxt.pm * tstepA + (size_t)nxt.k0 * kstep : cA; const char* nB = has_next ? (const char*)g.Bt + (size_t)nxt.pn * tstepB + (size_t)nxt.k0 * kstep : cB;
        const int ntc = cur.nt ? cur.nt : nt;
        for (int t = 0; t < ntc; t += 2) {
            const bool last = (t == ntc - 2);
            const char* a1 = cA + (size_t)(t + 1) * kstep;
            const char* a2 = last ? nA : cA + (size_t)(t + 2) * kstep; const char* b2 = last ? nB : cB + (size_t)(t + 2) * kstep;
            const char* a3 = a2 + kstep; const char* b3 = b2 + kstep;
            if (last && has_next) S.a_ready(nxt);
            if constexpr (SP2) {
            PG8_LDB(B0, 0, 0); PG8_LDB(B1, 0, 1); PG8_SCHED; PG8_LDA(At, 0, 0); PG8_STAGE(PG8_SA(1, 1), a1 + hstepA, voffA);
            PG8_WAIT_V(8); PG8_WAIT_L(0); PG8_BAR; PG8_MMA(0, 0, At, B0); PG8_MMA(0, 1, At, B1); PG8_BAR; PG8_SCHED;
            PG8_LDA(At, 0, 1); PG8_STAGE(PG8_SB(0, 0), b2, voffB); PG8_STAGE(PG8_SB(0, 1), b2 + hstepB, voffB); PG8_STAGE(PG8_SA(0, 0), a2, voffA);
            PG8_WAIT_V(8); PG8_WAIT_L(0); PG8_BAR; PG8_MMA(1, 0, At, B0); PG8_MMA(1, 1, At, B1); PG8_BAR; PG8_SCHED;
            PG8_LDB(B0, 1, 0); PG8_LDB(B1, 1, 1); PG8_SCHED; PG8_LDA(At, 1, 0); PG8_STAGE(PG8_SA(0, 1), a2 + hstepA, voffA);
            PG8_WAIT_V(8); PG8_WAIT_L(0); PG8_BAR; PG8_MMA(0, 0, At, B0); PG8_MMA(0, 1, At, B1); PG8_BAR; PG8_SCHED;
            PG8_LDA(At, 1, 1); PG8_STAGE(PG8_SB(1, 0), b3, voffB); PG8_STAGE(PG8_SB(1, 1), b3 + hstepB, voffB); PG8_STAGE(PG8_SA(1, 0), a3, voffA);
            PG8_WAIT_V(8); PG8_WAIT_L(0); PG8_BAR; PG8_MMA(1, 0, At, B0); PG8_MMA(1, 1, At, B1); PG8_BAR; PG8_SCHED;
            } else {
            PG8_LDB(B0, 0, 0); PG8_SCHED; PG8_LDA(At, 0, 0); PG8_STAGE(PG8_SA(1, 1), a1 + hstepA, voffA);
            PG8_WAIT_L(8); PG8_BAR; PG8_WAIT_L(0); PG8_MMA(0, 0, At, B0); PG8_BAR; PG8_SCHED;
            PG8_LDB(B1, 0, 1); PG8_STAGE(PG8_SB(0, 0), b2, voffB);
            PG8_BAR; PG8_WAIT_L(0); PG8_MMA(0, 1, At, B1); PG8_BAR;
            PG8_LDA(At, 0, 1); PG8_STAGE(PG8_SA(0, 0), a2, voffA);
            PG8_BAR; PG8_WAIT_L(0); PG8_MMA(1, 0, At, B0); PG8_BAR; PG8_SCHED;
            PG8_STAGE(PG8_SB(0, 1), b2 + hstepB, voffB);
            PG8_WAIT_V(6); PG8_BAR; PG8_MMA(1, 1, At, B1); PG8_BAR;
            PG8_LDB(B0, 1, 0); PG8_SCHED; PG8_LDA(At, 1, 0); PG8_STAGE(PG8_SA(0, 1), a2 + hstepA, voffA);
            PG8_WAIT_L(8); PG8_BAR; PG8_WAIT_L(0); PG8_MMA(0, 0, At, B0); PG8_BAR; PG8_SCHED;
            PG8_LDB(B1, 1, 1); PG8_STAGE(PG8_SB(1, 0), b3, voffB);
            PG8_BAR; PG8_WAIT_L(0); PG8_MMA(0, 1, At, B1); PG8_BAR;
            PG8_LDA(At, 1, 1); PG8_STAGE(PG8_SA(1, 0), a3, voffA);
            PG8_BAR; PG8_WAIT_L(0); PG8_MMA(1, 0, At, B0); PG8_BAR; PG8_SCHED;
            PG8_STAGE(PG8_SB(1, 1), b3 + hstepB, voffB);
            PG8_WAIT_V(6); PG8_BAR; PG8_MMA(1, 1, At, B1); PG8_BAR;
            }
        }
        if constexpr (ALIGN_EPI) { if (wr == 0) PG8_BAR; }
        if constexpr (!Epi::AFTER_DRAIN) {
            Unit eu = cur; eu.pm = __builtin_amdgcn_readfirstlane(cur.pm); eu.pn = __builtin_amdgcn_readfirstlane(cur.pn); eu.slab = __builtin_amdgcn_readfirstlane(cur.slab); eu.tile = __builtin_amdgcn_readfirstlane(cur.tile);
            eu.need = __builtin_amdgcn_readfirstlane(cur.need); eu.mode = __builtin_amdgcn_readfirstlane(cur.mode);
            asm volatile("" : "+s"(eu.pm), "+s"(eu.pn), "+s"(eu.slab), "+s"(eu.tile), "+s"(eu.need), "+s"(eu.mode));
            if constexpr (Sched::SPLIT) {
                if (eu.mode == 1) {
                    const float* sp = S.slabs + (size_t)eu.slab * 65536 + wid * 8192 + lane * 4;
#pragma unroll
                    for (int a = 0; a < 2; ++a)
#pragma unroll
                        for (int b = 0; b < 2; ++b)
#pragma unroll
                            for (int m = 0; m < 4; ++m)
#pragma unroll
                                for (int n = 0; n < 2; ++n) { const f32x4 v = acc[a][b][m][n]; const float* p = sp + (((a * 2 + b) * 4 + m) * 2 + n) * 256;
                                    asm volatile("global_store_dwordx4 %0, %1, off sc1\n\ts_nop 1" :: "v"(p), "v"(v) : "memory"); }
                    asm volatile("s_waitcnt vmcnt(0)" ::: "memory");
                    if (lane == 0) __hip_atomic_fetch_add(S.cnt + eu.tile * 32, 1u, __ATOMIC_RELAXED, __HIP_MEMORY_SCOPE_AGENT);
                } else if (eu.mode == 2) {
                    unsigned sp_ = 0;
                    while ((unsigned)__builtin_amdgcn_readfirstlane(__hip_atomic_load(S.cnt + eu.tile * 32, __ATOMIC_RELAXED, __HIP_MEMORY_SCOPE_AGENT)) < 8u) { __builtin_amdgcn_s_sleep(8); if (++sp_ > (1u << 20)) break; }
                    __builtin_amdgcn_fence(__ATOMIC_ACQUIRE, "agent");
                    E.template run<true>(acc, eu, wr, wc, fr, fq, S.slabs + (size_t)eu.slab * 65536 + wid * 8192 + lane * 4);
                } else E.template run<false>(acc, eu, wr, wc, fr, fq, nullptr);
            } else E.template run<false>(acc, eu, wr, wc, fr, fq, nullptr);
            S.done(cur); }
        if (!has_next) break;
#pragma unroll
        for (int a = 0; a < 2; ++a)
#pragma unroll
            for (int b = 0; b < 2; ++b)
#pragma unroll
                for (int m = 0; m < 4; ++m)
#pragma unroll
                    for (int n = 0; n < 2; ++n) acc[a][b][m][n] = (f32x4){0.f, 0.f, 0.f, 0.f};
        cur = nxt; cA = nA; cB = nB; ++ui;
        if constexpr (ALIGN_EPI) { if (wr == 1) PG8_BAR; }
    }
    PG8_WAIT_V(0);
    if constexpr (!ALIGN_EPI) { if (wr == 0) PG8_BAR; }
    PG8_BAR;
    if constexpr (Epi::AFTER_DRAIN) { E.fused(acc, cur, wr, wc, fr, fq, lds, wid, lane); S.done(cur); }
#undef PG8_SA
#undef PG8_SB
#undef PG8_STAGE
#undef PG8_LDA
#undef PG8_LDB
#undef PG8_MMA
#undef PG8_WAIT_V
#undef PG8_WAIT_L
#undef PG8_BAR
#undef PG8_SCHED
}
}
#ifndef PG8_SP2
#define PG8_SP2 true
#endif
#ifndef PG8_ALIGN
#define PG8_ALIGN true
#endif
#ifndef MK_PER_PHASE
#define MK_PER_PHASE 0
#endif

constexpr int DM = 1024, FF = 4096;
constexpr int LP = 256, BP = 16, LS = 4096, BS = 2, PAST = 256;
constexpr int NP = BP * LP;
constexpr int NSR = BS * LS;
constexpr int MT = NP + NSR;
constexpr int MKV = MT + BS * PAST;
constexpr int LKS = LS + PAST;
constexpr int HY = 512, NH = 4, DQK = 192, DNOPE = 128, DROPE = 64, DVH = 128, QL = 256, KVL = 128;
constexpr int WINP = 2048;
constexpr float LN_EPS = 1e-5f, RMS_EPS = 1e-6f, ALPHA = 1.41421356237309515f;
constexpr int NPHASE = 17;

constexpr int att_shm_bytes = 2 * 16384 + 2 * 24576 + 2048 + 8 * 8 * 1024;
constexpr size_t MiB = 1u << 20, KiB = 1024;
constexpr size_t WS_CTL = 0, CTL_ZERO_BYTES = 1 * MiB;
constexpr size_t WS_MODS = 1 * MiB;
constexpr size_t WS_D256 = 1 * MiB + 256 * KiB;
constexpr size_t WS_H2 = 1 * MiB + 512 * KiB;
constexpr size_t WS_FPART_S = 3 * MiB;
constexpr size_t WS_FPART_P = 3 * MiB + 256 * KiB;
constexpr size_t WS_WIN_T = 4 * MiB, WS_QUP_T = 8 * MiB, WS_KVUP_T = 8 * MiB + 512 * KiB, WS_WOUT0_T = 9 * MiB;
constexpr size_t WS_W1_0 = 11 * MiB, WS_W2_0 = 19 * MiB, WS_W1_1 = 27 * MiB, WS_W2_1 = 35 * MiB, WS_WFOLD_T = 43 * MiB;
constexpr size_t WS_T = 48 * MiB;
constexpr size_t WS_FT_S = 48 * MiB, WS_FT_P = 64 * MiB, WS_UT_S = 65 * MiB, WS_UT_P = 73 * MiB;
constexpr size_t WS_W1T = 80 * MiB, WS_CBD = 82 * MiB;
constexpr size_t WS_D4096 = 96 * MiB;
constexpr size_t WS_KF_S = 96 * MiB, WS_KF_P = 109 * MiB, WS_V_S = 115 * MiB, WS_V_P = 124 * MiB;
constexpr size_t WS_H = 128 * MiB;
constexpr size_t WS_P = 152 * MiB, WS_ZS = 188 * MiB, WS_QN = 212 * MiB, WS_KVN = 218 * MiB, WS_Q = 225 * MiB, WS_X0 = 243 * MiB;
constexpr size_t WS_HID = 152 * MiB, WS_UV = 152 * MiB;
constexpr size_t WS_END = 256 * MiB;
constexpr int CW_TMO = 0, CW_Q = 64, CW_BAR = 4096, CW_ATT = 16384, CW_SPLIT = 32768;
constexpr size_t WS_APART = 152 * MiB; constexpr int APART_F = 8 * 4 * 16 * 64 + 8 * 128;

constexpr int RING_BYTES = 131072, LDSCTL_OFF = 160 * 1024 - 512, MISC_OFF = LDSCTL_OFF + 320, LDS_BYTES = 160 * 1024;
static_assert(att_shm_bytes <= LDSCTL_OFF, "attention scratch fits below the LDS control words");

#define GAS __attribute__((address_space(1)))
#define LAS __attribute__((address_space(3)))
typedef unsigned short bf16;
typedef unsigned v4u __attribute__((ext_vector_type(4)));
typedef unsigned v2u __attribute__((ext_vector_type(2)));
typedef float f32x4 __attribute__((ext_vector_type(4)));
typedef GAS unsigned gu32;
#define RLX_AGENT __ATOMIC_RELAXED, __HIP_MEMORY_SCOPE_AGENT
#define LDS_WAIT() asm volatile("s_waitcnt lgkmcnt(0)" ::: "memory")
__device__ __forceinline__ unsigned f2bf(float f) { unsigned u = __builtin_bit_cast(unsigned, f); return (u + 0x7fffu + ((u >> 16) & 1u)) >> 16; }
__device__ __forceinline__ unsigned pk2(float lo, float hi) { return f2bf(lo) | (f2bf(hi) << 16); }
__device__ __forceinline__ float bf2f(unsigned short b) { return __builtin_bit_cast(float, (unsigned)b << 16); }
__device__ __forceinline__ float wave_sum(float v) {
#pragma unroll
    for (int o = 1; o < 64; o <<= 1) v += __shfl_xor(v, o);
    return v;
}
__device__ __forceinline__ float fsin_rev(float rev) { return __builtin_amdgcn_sinf(__builtin_amdgcn_fractf(rev)); }
__device__ __forceinline__ float fcos_rev(float rev) { return __builtin_amdgcn_cosf(__builtin_amdgcn_fractf(rev)); }
constexpr float INV_2PI = 0.15915494309189535f;
__device__ __forceinline__ float fexp(float x) { return __builtin_amdgcn_exp2f(x * 1.4426950408889634f); }

__device__ __forceinline__ int fresh_lane() { int l; asm volatile("v_mbcnt_lo_u32_b32 %0, -1, 0\n\tv_mbcnt_hi_u32_b32 %0, -1, %0" : "=v"(l)); return l; }
#define XB_TMO      128
#define XB_XCNT(j)  (256  + 64 * (j))
#define XB_XSUB(j)  (1280 + 64 * (j))
#define XB_XGEN(j)  (2304 + 64 * (j))
#define XB_TOP      3328
#define XB_TOPGEN   3392
#define XCD_BAR_WORDS 3456
#define XB_SPIN_CAP (1u << 23)
__device__ __forceinline__ unsigned xb_ld(unsigned* p)              { return __hip_atomic_load(p, __ATOMIC_RELAXED, __HIP_MEMORY_SCOPE_AGENT); }
__device__ __forceinline__ unsigned xb_add(unsigned* p, unsigned v) { return __hip_atomic_fetch_add(p, v, __ATOMIC_RELAXED, __HIP_MEMORY_SCOPE_AGENT); }
__device__ __forceinline__ unsigned xb_xcc_id() { return (unsigned)__builtin_amdgcn_s_getreg((3 << 11) | 20) & 0xFu; }
#define XB_SPIN(cond, bar) do { unsigned _sp = 0; while (cond) { __builtin_amdgcn_s_sleep(1); \
    if ((++_sp & 255u) == 0u) { if (xb_ld(&(bar)[XB_TMO])) break; if (_sp > XB_SPIN_CAP) { atomicAdd(&(bar)[XB_TMO], 1u); break; } } } } while (0)
struct XcdBarrier { unsigned* bar; unsigned x; volatile LAS unsigned* st; };
__device__ __forceinline__ XcdBarrier xcd_barrier_post(unsigned* bar, volatile LAS unsigned* st) {
    XcdBarrier b; b.bar = bar; b.x = xb_xcc_id(); b.st = st;
    if (threadIdx.x == 0) (void)xb_add(&bar[XB_XCNT(b.x)], 1u);
    return b;
}
__device__ __forceinline__ void xcd_barrier_complete(unsigned* bar, unsigned x, unsigned& nloc, unsigned& nx) {
    const unsigned G = gridDim.x * gridDim.y * gridDim.z;
    unsigned sum, cnt, mine, sp = 0u;
    for (;;) {
        sum = 0u; cnt = 0u; mine = 0u;
#pragma unroll
        for (unsigned j = 0; j < 16; ++j) { const unsigned c = xb_ld(&bar[XB_XCNT(j)]); sum += c; cnt += (c > 0u) ? 1u : 0u; mine = (j == x) ? c : mine; }
        if (sum == G) break;
        __builtin_amdgcn_s_sleep(1);
        if ((++sp & 255u) == 0u) { if (xb_ld(&bar[XB_TMO])) break; if (sp > XB_SPIN_CAP) { atomicAdd(&bar[XB_TMO], 1u); break; } }
    }
    nloc = mine > 0u ? mine : 1u; nx = cnt > 0u ? cnt : 1u;
}
__device__ __forceinline__ void xcd_barrier(const XcdBarrier& b) {
    asm volatile("s_waitcnt vmcnt(0)" ::: "memory");
    __syncthreads();
    if (threadIdx.x == 0) {
        unsigned* bar = b.bar;
        __builtin_amdgcn_s_waitcnt(0);
        unsigned nloc = b.st[0], nx = b.st[1];
        if (nloc == 0u) { xcd_barrier_complete(bar, b.x, nloc, nx); b.st[0] = nloc; b.st[1] = nx; }
        const unsigned old = xb_add(&bar[XB_XSUB(b.x)], 1u);
        const unsigned gen = old / nloc;
        if (old + 1u == (gen + 1u) * nloc) {
            __builtin_amdgcn_fence(__ATOMIC_RELEASE, "agent");
            asm volatile("s_waitcnt vmcnt(0)" ::: "memory");
            const unsigned og = xb_add(&bar[XB_TOP], 1u);
            const unsigned tg = og / nx;
            if (og + 1u == (tg + 1u) * nx) xb_add(&bar[XB_TOPGEN], 1u);
            else XB_SPIN(xb_ld(&bar[XB_TOPGEN]) == tg, bar);
            __builtin_amdgcn_fence(__ATOMIC_ACQUIRE, "agent");
            xb_add(&bar[XB_XGEN(b.x)], 1u);
            asm volatile("s_waitcnt vmcnt(0)" ::: "memory");
        } else {
            XB_SPIN(xb_ld(&bar[XB_XGEN(b.x)]) == gen, bar);
            __builtin_amdgcn_fence(__ATOMIC_ACQUIRE, "agent");
            asm volatile("s_waitcnt vmcnt(0)" ::: "memory");
        }
    }
    __syncthreads();
}

struct Args { const float* in[38]; float* out; unsigned char* ws; int ph_lo, ph_hi, li, mask; };
enum { I_XP = 0, I_XS, I_CKV, I_CKR, I_C, I_CCTX, I_ADA0_W, I_ADA0_B, I_WIN, I_CONVW, I_CONVB, I_HFW1, I_HFB1, I_HFFREQ, I_HFW2, I_HFB2, I_HFW3, I_HFSKIP,
       I_QNORM, I_QUP, I_KVNORM, I_KVUP, I_WOUT0, I_LN1G0, I_LN1B0, I_W1_0, I_W2_0, I_LN2G0, I_LN2B0, I_ADA1_W, I_ADA1_B, I_WOUT1, I_LN1G1, I_LN1B1, I_W1_1, I_W2_1, I_LN2G1, I_LN2B1 };
constexpr size_t OUT_CKV = (size_t)MT * DM, OUT_CKR = OUT_CKV + (size_t)NP * KVL;

__device__ __forceinline__ int req_of_row(int m) { return m < NP ? 0 : 1 + (m - NP) / LS; }

using pg8::f32x4; using pg8::Unit; using pg8::BM; using pg8::HALF; using pg8::cvt_pk_bf16;
typedef unsigned u32x4 __attribute__((ext_vector_type(4)));
__device__ __forceinline__ u32x4 pack8(const f32x4& a, const f32x4& b) { u32x4 w; w.x = cvt_pk_bf16(a[0], a[1]); w.y = cvt_pk_bf16(a[2], a[3]); w.z = cvt_pk_bf16(b[0], b[1]); w.w = cvt_pk_bf16(b[2], b[3]); return w; }

#define SLAB_ADD(v, ai, bj, m, n) do { if constexpr (SL) (v) += *(const f32x4*)(slab + ((((ai) * 2 + (bj)) * 4 + (m)) * 2 + (n)) * 256); } while (0)
template <int MF = 4> struct EpiWin {
    static constexpr bool PERM = true, AFTER_DRAIN = false;
    bf16* P; float* ZS;
    template <bool SL> __device__ __forceinline__ void run(const f32x4 (&acc)[2][2][4][2], const Unit& u, int wr, int wc, int fr, int fq, const float* slab) const {
        const int row0 = u.pm * (64 * MF) + wr * (16 * MF) + fr, colt = u.pn * BM + wc * 32 + 8 * fq;
#pragma unroll
        for (int ai = 0; ai < 2; ++ai)
#pragma unroll
            for (int m = 0; m < MF; ++m) { const int row = row0 + ai * (32 * MF) + m * 16;
#pragma unroll
                for (int bj = 0; bj < 2; ++bj) { const int col = colt + bj * HALF; f32x4 a0 = acc[ai][bj][m][0], a1 = acc[ai][bj][m][1]; SLAB_ADD(a0, ai, bj, m, 0); SLAB_ADD(a1, ai, bj, m, 1);
                    if (u.pn < 6) *(u32x4*)(P + (size_t)row * 1536 + col) = pack8(a0, a1);
                    else { float* d = ZS + (size_t)row * 512 + (col - 1536); *(f32x4*)d = a0; *(f32x4*)(d + 4) = a1; } } }
    }
};
struct EpiStore {
    static constexpr bool PERM = true, AFTER_DRAIN = false;
    bf16* O; int ld;
    template <bool SL> __device__ __forceinline__ void run(const f32x4 (&acc)[2][2][4][2], const Unit& u, int wr, int wc, int fr, int fq, const float* slab) const {
        const int row0 = u.pm * BM + wr * 64 + fr, colt = u.pn * BM + wc * 32 + 8 * fq;
#pragma unroll
        for (int ai = 0; ai < 2; ++ai)
#pragma unroll
            for (int m = 0; m < 4; ++m) { const int row = row0 + ai * HALF + m * 16;
#pragma unroll
                for (int bj = 0; bj < 2; ++bj) *(u32x4*)(O + (size_t)row * ld + colt + bj * HALF) = pack8(acc[ai][bj][m][0], acc[ai][bj][m][1]); }
    }
};
struct EpiKV {
    static constexpr bool PERM = true, AFTER_DRAIN = false;
    bf16 *KFs, *KFp, *Vs, *Vp;
    template <bool SL> __device__ __forceinline__ void run(const f32x4 (&acc)[2][2][4][2], const Unit& u, int wr, int wc, int fr, int fq, const float* slab) const {
        const int m0 = u.pm * BM; bf16* kf; bf16* vv; int lk, key0, b;
        if (m0 < NP) { b = m0 / LP; key0 = 0; lk = LP; kf = KFp; vv = Vp; }
        else if (m0 < MT) { b = (m0 - NP) / LS; key0 = (m0 - NP) % LS; lk = LKS; kf = KFs; vv = Vs; }
        else { b = (m0 - MT) / PAST; key0 = LS + (m0 - MT) % PAST; lk = LKS; kf = KFs; vv = Vs; }
        const int h = u.pn;
        int rloc = wr * 64 + fr, c8 = wc * 32 + 8 * fq; asm volatile("" : "+v"(rloc), "+v"(c8));
#pragma unroll
        for (int ai = 0; ai < 2; ++ai)
#pragma unroll
            for (int m = 0; m < 4; ++m) { const int key = key0 + rloc + ai * HALF + m * 16; const size_t kr = (size_t)(b * NH + h) * lk + key;
                *(u32x4*)(kf + kr * DQK + c8) = pack8(acc[ai][0][m][0], acc[ai][0][m][1]);
                *(u32x4*)(vv + kr * DVH + c8) = pack8(acc[ai][1][m][0], acc[ai][1][m][1]); }
    }
};
template <int MF = 4> struct EpiRes {
    static constexpr bool PERM = false, AFTER_DRAIN = false;
    const float* xp; const float* xs; const float* gate;
    bf16* T;
    template <bool SL> __device__ __forceinline__ void run(const f32x4 (&acc)[2][2][4][2], const Unit& u, int wr, int wc, int fr, int fq, const float* slab) const {
        const int m0 = u.pm * (64 * MF), row0 = m0 + wr * (16 * MF) + fr, col0 = u.pn * BM + wc * 32 + 4 * fq;
        const float* g = gate + (size_t)req_of_row(m0) * 6144;
        f32x4 gv[2][2];
        if constexpr (MF == 4) {
#pragma unroll
            for (int bj = 0; bj < 2; ++bj)
#pragma unroll
                for (int n = 0; n < 2; ++n) gv[bj][n] = *(const f32x4*)(g + col0 + bj * HALF + n * 16); }
#pragma unroll
        for (int ai = 0; ai < 2; ++ai)
#pragma unroll
            for (int m = 0; m < MF; ++m) { const int row = row0 + ai * (32 * MF) + m * 16;
                const float* xr = (row < NP) ? xp + (size_t)row * DM : xs + (size_t)(row - NP) * DM;
                const float* gr = gate + (size_t)req_of_row(row) * 6144;
#pragma unroll
                for (int bj = 0; bj < 2; ++bj)
#pragma unroll
                    for (int n = 0; n < 2; ++n) { const int col = col0 + bj * HALF + n * 16; const f32x4 xv = *(const f32x4*)(xr + col); f32x4 a = acc[ai][bj][m][n]; SLAB_ADD(a, ai, bj, m, n);
                        const f32x4 gg = (MF == 4) ? gv[bj][n] : *(const f32x4*)(gr + col);
                        const f32x4 t = xv * ALPHA + gg * a; v2u w; w.x = cvt_pk_bf16(t[0], t[1]); w.y = cvt_pk_bf16(t[2], t[3]); *(v2u*)(T + (size_t)row * DM + col) = w; } }
    }
};
struct EpiUp {
    static constexpr bool PERM = true, AFTER_DRAIN = false;
    bf16* H;
    template <bool SL> __device__ __forceinline__ void run(const f32x4 (&acc)[2][2][4][2], const Unit& u, int wr, int wc, int fr, int fq, const float* slab) const {
        const int row0 = u.pm * BM + wr * 64 + fr, colt = u.pn * BM + wc * 32 + 8 * fq;
#pragma unroll
        for (int ai = 0; ai < 2; ++ai)
#pragma unroll
            for (int m = 0; m < 4; ++m) { const int row = row0 + ai * HALF + m * 16;
#pragma unroll
                for (int bj = 0; bj < 2; ++bj) { f32x4 a = acc[ai][bj][m][0], b = acc[ai][bj][m][1];
#pragma unroll
                    for (int e = 0; e < 4; ++e) { const float x = fmaxf(a[e], 0.f), y = fmaxf(b[e], 0.f); a[e] = x * x; b[e] = y * y; }
                    *(u32x4*)(H + (size_t)row * FF + colt + bj * HALF) = pack8(a, b); } }
    }
};
struct EpiDft {
    static constexpr bool PERM = true, AFTER_DRAIN = false;
    bf16* UV; int L, tokbase;
    template <bool SL> __device__ __forceinline__ void run(const f32x4 (&acc)[2][2][4][2], const Unit& u, int wr, int wc, int fr, int fq, const float* slab) const {
        int rl = wr * 64 + fr, cl = wc * 32 + 8 * fq; asm volatile("" : "+v"(rl), "+v"(cl));
        const int rho0 = u.pm * BM + rl, n0 = u.pn * BM + cl, hl = L >> 1;
#pragma unroll
        for (int ai = 0; ai < 2; ++ai)
#pragma unroll
            for (int m = 0; m < 4; ++m) { const int rho = rho0 + ai * HALF + m * 16; const int part = rho > hl ? 1 : 0; const int k = part ? rho - hl : rho;
#pragma unroll
                for (int bj = 0; bj < 2; ++bj) { const int n = n0 + bj * HALF, b = n >> 10, c = n & 1023;
                    f32x4 a0 = acc[ai][bj][m][0], a1 = acc[ai][bj][m][1]; SLAB_ADD(a0, ai, bj, m, 0); SLAB_ADD(a1, ai, bj, m, 1);
                    bf16* r1 = UV + (size_t)(tokbase + b * L + k) * 2048 + part * 1024 + c;
                    *(u32x4*)r1 = pack8(a0, a1);
                    if (k != 0 && k != hl) { bf16* r2 = UV + (size_t)(tokbase + b * L + (L - k)) * 2048 + part * 1024 + c;
                        *(u32x4*)r2 = part ? pack8(-a0, -a1) : pack8(a0, a1); }
                    else if (part == 0) { unsigned zz = 0u; asm volatile("" : "+v"(zz)); *(u32x4*)(r1 + 1024) = (u32x4){zz, zz, zz, zz}; } } }
    }
};

namespace att {
using bf16x8 = __attribute__((ext_vector_type(8))) short;
using s16x4  = __attribute__((ext_vector_type(4))) short;
using f32x16 = __attribute__((ext_vector_type(16))) float;
constexpr int DK = 192, DV = 128, NW = 8, QBLK = 32, KVBLK = 64;
constexpr float SCALE = 0.07216878364870322f;
constexpr float THR = 8.f;
constexpr int SHM_V = KVBLK * DV * 2, SHM_K = KVBLK * DK * 2, SHM_QR = 2 * SHM_V + 2 * SHM_K + NW * 64 * 4, NQR = 4  , SHM_ATTN = SHM_QR + NW * (12 - NQR) * 1024;
#define KSWZ(row, colB) ((row) * 384 + ((colB) ^ (((row) & 7) << 4)))
#define SBAR() __builtin_amdgcn_sched_barrier(0)
__device__ __forceinline__ int crow(int r, int hi) { return (r & 3) + 8 * (r >> 2) + 4 * hi; }
__device__ __forceinline__ unsigned cvtpk(float lo, float hi) { unsigned r; asm volatile("v_cvt_pk_bf16_f32 %0, %1, %2" : "=v"(r) : "v"(lo), "v"(hi)); return r; }
__device__ __forceinline__ void partialSM(f32x16& p0, f32x16& p1, float& m_reg, float& mn, float& alpha) {
  constexpr float C = SCALE * 1.4426950408889634f;
  float pmax = p0[0];
#pragma unroll
  for (int r = 1; r < 16; ++r) pmax = fmaxf(pmax, p0[r]);
#pragma unroll
  for (int r = 0; r < 16; ++r) pmax = fmaxf(pmax, p1[r]);
  { auto rr = __builtin_amdgcn_permlane32_swap(__float_as_uint(pmax), __float_as_uint(pmax), false, false);
    pmax = fmaxf(__uint_as_float(rr[0]), __uint_as_float(rr[1])); }
  if (__builtin_expect(__all(pmax - m_reg <= THR / SCALE), 1)) { mn = m_reg; alpha = 1.f; }
  else { mn = fmaxf(m_reg, pmax); alpha = __builtin_amdgcn_exp2f((m_reg - mn) * C); m_reg = mn; }
  float mnC = -mn * C;
#pragma unroll
  for (int r = 0; r < 16; ++r) p0[r] = fmaf(p0[r], C, mnC);
#pragma unroll
  for (int r = 0; r < 16; ++r) p1[r] = fmaf(p1[r], C, mnC);
#pragma unroll
  for (int r = 0; r < 16; ++r) p0[r] = __builtin_amdgcn_exp2f(p0[r]);
}
__device__ __forceinline__ void finishSM(f32x16& p0, f32x16& p1, float alpha, float& l_reg, bf16x8& pa0, bf16x8& pa1, bf16x8& pa2, bf16x8& pa3) {
#pragma unroll
  for (int r = 0; r < 16; ++r) p1[r] = __builtin_amdgcn_exp2f(p1[r]);
  float ps = 0;
#pragma unroll
  for (int r = 0; r < 16; ++r) ps += p0[r];
#pragma unroll
  for (int r = 0; r < 16; ++r) ps += p1[r];
  { auto rr = __builtin_amdgcn_permlane32_swap(__float_as_uint(ps), __float_as_uint(ps), false, false);
    ps = __uint_as_float(rr[0]) + __uint_as_float(rr[1]); }
  l_reg = l_reg * alpha + ps;
#define PK4(P, BASE, OUT) do { unsigned a0 = cvtpk(P[BASE + 0], P[BASE + 1]), a1 = cvtpk(P[BASE + 2], P[BASE + 3]);   \
    unsigned b0 = cvtpk(P[BASE + 4], P[BASE + 5]), b1 = cvtpk(P[BASE + 6], P[BASE + 7]);                              \
    auto r0 = __builtin_amdgcn_permlane32_swap(a0, b0, false, false); auto r1 = __builtin_amdgcn_permlane32_swap(a1, b1, false, false); \
    u32x4 w = {r0[0], r1[0], r0[1], r1[1]}; OUT = __builtin_bit_cast(bf16x8, w); } while (0)
  PK4(p0, 0, pa0); PK4(p0, 8, pa1); PK4(p1, 0, pa2); PK4(p1, 8, pa3);
#undef PK4
}
__device__ __forceinline__ void qkt(f32x16& p0, f32x16& p1, const LAS char* Ks, const bf16x8* qr, const LAS char* qrl, int r32, int hi) {
  p0 = f32x16{}; p1 = f32x16{};
#pragma unroll
  for (int d0 = 0; d0 < 12; ++d0) { const int cb = (d0 * 16 + hi * 8) * 2;
    bf16x8 b0 = *reinterpret_cast<const LAS bf16x8*>(Ks + KSWZ(r32, cb));
    bf16x8 b1 = *reinterpret_cast<const LAS bf16x8*>(Ks + KSWZ(32 + r32, cb));
    const bf16x8 qf = d0 < NQR ? qr[d0 < NQR ? d0 : 0] : *reinterpret_cast<const LAS bf16x8*>(qrl + (d0 - NQR) * 1024);
    p0 = __builtin_amdgcn_mfma_f32_32x32x16_bf16(b0, qf, p0, 0, 0, 0);
    p1 = __builtin_amdgcn_mfma_f32_32x32x16_bf16(b1, qf, p1, 0, 0, 0); }
}
__device__ __forceinline__ int v_st(int k, int c) { const int kk = (k & ~0xC) | ((k & 4) << 1) | ((k & 8) >> 1); return ((kk >> 3) * 4 + (c >> 5)) * 512 + ((kk & 7) * 32 + (c & 31)) * 2; }
__device__ __forceinline__ int v_rd_base(int lane) { return ((lane & 3) << 3) | (((lane >> 2) & 3) << 6) | (((lane >> 4) & 1) << 5) | (((lane >> 5) & 1) << 8); }
constexpr int v_rd_off(int d0, int ks, int half) { return d0 * 512 + ks * 4096 + half * 2048; }
template <int OFF> __device__ __forceinline__ s16x4 tr_read(int vb) {
  s16x4 r; asm volatile("ds_read_b64_tr_b16 %0, %1 offset:%2" : "=&v"(r) : "v"(vb), "i"(OFF) : "memory"); return r;
}
template <int D0> __device__ __forceinline__ void pv_one(f32x16& od, int vb, bf16x8 pa0, bf16x8 pa1, bf16x8 pa2, bf16x8 pa3) {
  const s16x4 l0 = tr_read<v_rd_off(D0, 0, 0)>(vb), h0 = tr_read<v_rd_off(D0, 0, 1)>(vb), l1 = tr_read<v_rd_off(D0, 1, 0)>(vb), h1 = tr_read<v_rd_off(D0, 1, 1)>(vb);
  const s16x4 l2 = tr_read<v_rd_off(D0, 2, 0)>(vb), h2 = tr_read<v_rd_off(D0, 2, 1)>(vb), l3 = tr_read<v_rd_off(D0, 3, 0)>(vb), h3 = tr_read<v_rd_off(D0, 3, 1)>(vb);
  asm volatile("s_waitcnt lgkmcnt(0)" ::: "memory"); SBAR();
#define PK(L, H) (bf16x8){L[0], L[1], L[2], L[3], H[0], H[1], H[2], H[3]}
  od = __builtin_amdgcn_mfma_f32_32x32x16_bf16(pa0, PK(l0, h0), od, 0, 0, 0);
  od = __builtin_amdgcn_mfma_f32_32x32x16_bf16(pa1, PK(l1, h1), od, 0, 0, 0);
  od = __builtin_amdgcn_mfma_f32_32x32x16_bf16(pa2, PK(l2, h2), od, 0, 0, 0);
  od = __builtin_amdgcn_mfma_f32_32x32x16_bf16(pa3, PK(l3, h3), od, 0, 0, 0);
#undef PK
}
__device__ __forceinline__ void pv_d0(f32x16* o, int vb, bf16x8 pa0, bf16x8 pa1, bf16x8 pa2, bf16x8 pa3) {
  pv_one<0>(o[0], vb, pa0, pa1, pa2, pa3); pv_one<1>(o[1], vb, pa0, pa1, pa2, pa3); pv_one<2>(o[2], vb, pa0, pa1, pa2, pa3); pv_one<3>(o[3], vb, pa0, pa1, pa2, pa3);
}
constexpr int LDQ = 768, LDK = DK, LDV = DV, LDO = 1024;
__device__ __forceinline__ void attn_dense_body(const bf16* __restrict__ Qb, const bf16* __restrict__ Kh, const bf16* __restrict__ Vh, bf16* __restrict__ Ob, int seq, int pos0, LAS char* lds, const int tid, float* part, unsigned* cnt, volatile LAS unsigned* misc) {
  const int wid = tid >> 6, lane = tid & 63, r32 = lane & 31, hi = lane >> 5;
  LAS char* V_lds = lds; LAS char* K_lds = lds + 2 * SHM_V;
  LAS float* ws = (LAS float*)(lds + 2 * SHM_V + 2 * SHM_K) + wid * 64; LAS float* li_l = ws; LAS float* al_l = ws + 32;
  float m_reg = -1e30f, l_reg = 0; f32x16 o[4] = {}; bf16x8 qr[NQR];
  const LAS char* qrl = lds + SHM_QR + wid * (12 - NQR) * 1024 + lane * 16;
  const bf16* Qw = Qb + (long)(wid * QBLK + r32) * LDQ + hi * 8;
#pragma unroll
  for (int d0 = 0; d0 < NQR; ++d0) qr[d0] = *reinterpret_cast<const bf16x8*>(Qw + d0 * 16);
  LAS char* qw = lds + SHM_QR + wid * (12 - NQR) * 1024 + lane * 16;
#pragma unroll
  for (int d0 = NQR; d0 < 8; ++d0) *(LAS bf16x8*)(qw + (d0 - NQR) * 1024) = *reinterpret_cast<const bf16x8*>(Qw + d0 * 16);
  {
    bf16x8 f0 = *reinterpret_cast<const bf16x8*>(Qw + 128), f1 = *reinterpret_cast<const bf16x8*>(Qw + 144), f2 = *reinterpret_cast<const bf16x8*>(Qw + 160), f3 = *reinterpret_cast<const bf16x8*>(Qw + 176);
    if (pos0 >= 0) { const int pos = pos0 + wid * QBLK + r32; const float pr = (float)(pos >> 6), pc = (float)(pos & 63);
#pragma unroll
      for (int i = 0; i < 8; ++i) { const float inv = __builtin_amdgcn_exp2f(-(float)(8 * hi + i) * (13.287712379549449f / 16.0f));
        { const float rev = pr * inv * INV_2PI, cs = fcos_rev(rev), sn = fsin_rev(rev); const float a = bf2f((unsigned short)f0[i]), b = bf2f((unsigned short)f1[i]);
          f0[i] = (short)f2bf(a * cs - b * sn); f1[i] = (short)f2bf(b * cs + a * sn); }
        { const float rev = pc * inv * INV_2PI, cs = fcos_rev(rev), sn = fsin_rev(rev); const float a = bf2f((unsigned short)f2[i]), b = bf2f((unsigned short)f3[i]);
          f2[i] = (short)f2bf(a * cs - b * sn); f3[i] = (short)f2bf(b * cs + a * sn); } } }
    *(LAS bf16x8*)(qw + (8 - NQR) * 1024) = f0; *(LAS bf16x8*)(qw + (9 - NQR) * 1024) = f1; *(LAS bf16x8*)(qw + (10 - NQR) * 1024) = f2; *(LAS bf16x8*)(qw + (11 - NQR) * 1024) = f3;
  }
  const int sr = tid >> 4, sc = (tid & 15) * 8, vst0 = v_st(sr, sc), vst1 = v_st(32 + sr, sc);
  const int kr = tid >> 3, kc = tid & 7, kgo = kr * LDK + kc * 8, kst = KSWZ(kr, kc * 16);
  const int vb0 = (int)(unsigned)(uintptr_t)V_lds + v_rd_base(lane);
  bf16x8 vs0, vs1, ks0, ks1, ks2;
#define SLOAD(k0) do { vs0 = *reinterpret_cast<const bf16x8*>(&Vh[(long)((k0) + sr) * LDV + sc]); vs1 = *reinterpret_cast<const bf16x8*>(&Vh[(long)((k0) + 32 + sr) * LDV + sc]); \
    ks0 = *reinterpret_cast<const bf16x8*>(&Kh[(long)(k0) * LDK + kgo]); ks1 = *reinterpret_cast<const bf16x8*>(&Kh[(long)(k0) * LDK + kgo + 64]); \
    ks2 = *reinterpret_cast<const bf16x8*>(&Kh[(long)(k0) * LDK + kgo + 128]); } while (0)
#define SWRITE(b) do { *(LAS bf16x8*)(V_lds + (b) * SHM_V + vst0) = vs0; *(LAS bf16x8*)(V_lds + (b) * SHM_V + vst1) = vs1; \
    *(LAS bf16x8*)(K_lds + (b) * SHM_K + kst) = ks0; *(LAS bf16x8*)(K_lds + (b) * SHM_K + kst + 128) = ks1; *(LAS bf16x8*)(K_lds + (b) * SHM_K + kst + 256) = ks2; } while (0)
#define SWAIT() asm volatile("s_waitcnt vmcnt(0)" ::: "memory")
#define RESC(a) do { if (__any((a) < 1.f)) { if (hi == 0) al_l[r32] = (a); asm volatile("s_waitcnt lgkmcnt(0)" ::: "memory"); \
    _Pragma("unroll") for (int d = 0; d < 4; ++d) _Pragma("unroll") for (int r = 0; r < 16; ++r) o[d][r] *= al_l[crow(r, hi)]; } } while (0)
  f32x16 pA0, pA1, pB0, pB1; float mnA, mnB, alA, alB; bf16x8 pa0, pa1, pa2, pa3; const int NT = seq / KVBLK;
  SLOAD(0); SWAIT(); SWRITE(0); __syncthreads();
  qkt(pA0, pA1, K_lds, qr, qrl, r32, hi); partialSM(pA0, pA1, m_reg, mnA, alA);
  SLOAD(KVBLK);
  SWAIT(); SWRITE(1); __syncthreads();
  for (int j = 1; j + 1 < NT; j += 2) {
    SBAR(); qkt(pB0, pB1, K_lds + SHM_K, qr, qrl, r32, hi);
    finishSM(pA0, pA1, alA, l_reg, pa0, pa1, pa2, pa3); SBAR();
    SLOAD((j + 1) * KVBLK); SBAR();
    pv_d0(o, vb0, pa0, pa1, pa2, pa3); partialSM(pB0, pB1, m_reg, mnB, alB);
    __syncthreads(); SWAIT(); SWRITE(0);
    RESC(alB); __syncthreads();
    SBAR(); qkt(pA0, pA1, K_lds, qr, qrl, r32, hi);
    finishSM(pB0, pB1, alB, l_reg, pa0, pa1, pa2, pa3); SBAR();
    SLOAD((j + 2) * KVBLK); SBAR();
    pv_d0(o, vb0 + SHM_V, pa0, pa1, pa2, pa3); partialSM(pA0, pA1, m_reg, mnA, alA);
    __syncthreads(); SWAIT(); SWRITE(1);
    RESC(alA); __syncthreads();
  }
  SBAR(); qkt(pB0, pB1, K_lds + SHM_K, qr, qrl, r32, hi);
  finishSM(pA0, pA1, alA, l_reg, pa0, pa1, pa2, pa3); SBAR();
  pv_d0(o, vb0, pa0, pa1, pa2, pa3); partialSM(pB0, pB1, m_reg, mnB, alB);
  __syncthreads(); RESC(alB);
  finishSM(pB0, pB1, alB, l_reg, pa0, pa1, pa2, pa3); SBAR();
  pv_d0(o, vb0 + SHM_V, pa0, pa1, pa2, pa3);
  bf16* Ow = Ob + (long)(wid * QBLK) * LDO;
  bool write_out = true; float g1 = 1.f;
  if (part) {
    if (tid == 0) misc[1] = __hip_atomic_fetch_add(cnt, 1u, __ATOMIC_RELAXED, __HIP_MEMORY_SCOPE_AGENT);
    __syncthreads();
    const unsigned ticket = misc[1];
    float* po = part + (size_t)wid * (4 * 16 * 64) + lane * 4; float* pml = part + 8 * 4 * 16 * 64 + wid * 128 + lane;
    if (ticket == 0u) {
#pragma unroll
      for (int d0 = 0; d0 < 4; ++d0)
#pragma unroll
        for (int r4 = 0; r4 < 4; ++r4) { const f32x4 v = {o[d0][4 * r4], o[d0][4 * r4 + 1], o[d0][4 * r4 + 2], o[d0][4 * r4 + 3]}; const float* p = po + (d0 * 4 + r4) * 256;
          asm volatile("global_store_dwordx4 %0, %1, off sc1\n\ts_nop 1" :: "v"(p), "v"(v) : "memory"); }
      __hip_atomic_store((unsigned*)pml, __float_as_uint(m_reg), __ATOMIC_RELAXED, __HIP_MEMORY_SCOPE_AGENT); __hip_atomic_store((unsigned*)pml + 64, __float_as_uint(l_reg), __ATOMIC_RELAXED, __HIP_MEMORY_SCOPE_AGENT);
      asm volatile("s_waitcnt vmcnt(0)" ::: "memory"); __syncthreads();
      if (tid == 0) __hip_atomic_store(cnt + 1, 1u, __ATOMIC_RELAXED, __HIP_MEMORY_SCOPE_AGENT);
      write_out = false;
    } else {
      if (tid == 0) { unsigned sp = 0; while (__hip_atomic_load(cnt + 1, __ATOMIC_RELAXED, __HIP_MEMORY_SCOPE_AGENT) == 0u) { __builtin_amdgcn_s_sleep(2); if (++sp > (1u << 22)) break; }
        __builtin_amdgcn_fence(__ATOMIC_ACQUIRE, "agent"); asm volatile("s_waitcnt vmcnt(0)" ::: "memory"); }
      __syncthreads();
      constexpr float C = SCALE * 1.4426950408889634f;
      const float m2 = pml[0], l2 = pml[64]; const float mn = fmaxf(m_reg, m2);
      const float f1 = __builtin_amdgcn_exp2f((m_reg - mn) * C), f2 = __builtin_amdgcn_exp2f((m2 - mn) * C); const float il = __builtin_amdgcn_rcpf(l_reg * f1 + l2 * f2);
      if (hi == 0) { li_l[r32] = f1 * il; al_l[r32] = f2 * il; } asm volatile("s_waitcnt lgkmcnt(0)" ::: "memory");
#pragma unroll
      for (int r4 = 0; r4 < 4; ++r4)
#pragma unroll
        for (int d0 = 0; d0 < 4; ++d0) { const f32x4 pv = *(const f32x4*)(po + (d0 * 4 + r4) * 256);
#pragma unroll
          for (int e = 0; e < 4; ++e) { const int r = 4 * r4 + e; o[d0][r] = o[d0][r] * li_l[crow(r, hi)] + pv[e] * al_l[crow(r, hi)]; } }
      g1 = 0.f;
    }
  }
  if (write_out) {
    if (g1 != 0.f) {
      if (hi == 0) li_l[r32] = l_reg; asm volatile("s_waitcnt lgkmcnt(0)" ::: "memory");
#pragma unroll
      for (int r = 0; r < 16; ++r) { const float rl = __builtin_amdgcn_rcpf(li_l[crow(r, hi)]);
#pragma unroll
        for (int d0 = 0; d0 < 4; ++d0) o[d0][r] *= rl; }
    }
#pragma unroll
    for (int r = 0; r < 16; ++r) { const int orow = crow(r, hi);
#pragma unroll
      for (int d0 = 0; d0 < 4; ++d0) Ow[(long)orow * LDO + d0 * 32 + r32] = (bf16)f2bf(o[d0][r]); }
  }
  __syncthreads();
#undef SLOAD
#undef SWRITE
#undef SWAIT
#undef RESC
}
#undef KSWZ
#undef SBAR
}
__device__ __forceinline__ void transpose_item(const float* W, int K, int N, bf16* WT, int ldk, LAS float* scr, int item, int lane) {
    const int nblk = N / 32, kb = item / nblk, nb = item % nblk, k0 = 64 * kb, n0 = 32 * nb;
#pragma unroll
    for (int i = 0; i < 32; ++i) { const int kk = 2 * i + (lane >> 5); scr[kk * 33 + (lane & 31)] = W[(size_t)(k0 + kk) * N + n0 + (lane & 31)]; }
    LDS_WAIT(); asm volatile("" ::: "memory");
    const int c = lane & 7;
#pragma unroll
    for (int j = 0; j < 4; ++j) { const int n = (lane >> 3) + 8 * j; const LAS float* s = scr + (8 * c) * 33 + n;
        v4u o; o.x = pk2(s[0 * 33], s[1 * 33]); o.y = pk2(s[2 * 33], s[3 * 33]); o.z = pk2(s[4 * 33], s[5 * 33]); o.w = pk2(s[6 * 33], s[7 * 33]);
        *(v4u*)(WT + (size_t)(n0 + n) * ldk + k0 + 8 * c) = o; }
    LDS_WAIT(); asm volatile("" ::: "memory");
}
constexpr int WI_L0 = 992 + 96 + 64 + 512 + 2 * 2048 + 512, WI_ALL = WI_L0 + 2 * 2048;
__device__ __forceinline__ void weight_item(const Args& args, unsigned char* ws, LAS float* scr, int idx, int lane) {
    constexpr int I0 = 992, I1 = 96, I2 = 64, I3 = 512, I4 = 2048;
    int r = idx, K, N, ldk; size_t off; const float* W;
    if (r < I0) { W = args.in[I_WIN]; K = 1024; N = 1984; ldk = 1024; off = WS_WIN_T; }
    else if ((r -= I0) < I1) { W = args.in[I_QUP]; K = 256; N = 768; ldk = 256; off = WS_QUP_T; }
    else if ((r -= I1) < I2) { W = args.in[I_KVUP]; K = 128; N = 1024; ldk = 256; off = WS_KVUP_T; }
    else if ((r -= I2) < I3) { W = args.in[I_WOUT0]; K = 1024; N = 1024; ldk = 1024; off = WS_WOUT0_T; }
    else if ((r -= I3) < I4) { W = args.in[I_W1_0]; K = 1024; N = 4096; ldk = 1024; off = WS_W1_0; }
    else if ((r -= I4) < I4) { W = args.in[I_W2_0]; K = 4096; N = 1024; ldk = 4096; off = WS_W2_0; }
    else if ((r -= I4) < I3) { W = args.in[I_WOUT1]; K = 1024; N = 1024; ldk = 1024; off = WS_W1T; }
    else if ((r -= I3) < I4) { W = args.in[I_W1_1]; K = 1024; N = 4096; ldk = 1024; off = WS_W1_1; }
    else { r -= I4; W = args.in[I_W2_1]; K = 4096; N = 1024; ldk = 4096; off = WS_W2_1; }
    transpose_item(W, K, N, (bf16*)(ws + off), ldk, scr, r, lane);
}
__device__ __forceinline__ void row_stats(const f32x4 (&v)[4], float& mean, float& rstd) {
    float s = 0.f;
#pragma unroll
    for (int j = 0; j < 4; ++j) s += (v[j][0] + v[j][1]) + (v[j][2] + v[j][3]);
    mean = wave_sum(s) * (1.f / DM); float q = 0.f;
#pragma unroll
    for (int j = 0; j < 4; ++j) { const f32x4 d = v[j] - mean; q += (d[0] * d[0] + d[1] * d[1]) + (d[2] * d[2] + d[3] * d[3]); }
    rstd = __builtin_amdgcn_rsqf(wave_sum(q) * (1.f / DM) + LN_EPS);
}
__device__ __forceinline__ void load_row(const bf16* p, int lane, f32x4 (&v)[4]) {
#pragma unroll
    for (int j = 0; j < 4; ++j) { const v2u w = ((const v2u*)p)[lane + 64 * j]; v[j] = (f32x4){bf2f((unsigned short)(w.x & 0xffffu)), bf2f((unsigned short)(w.x >> 16)), bf2f((unsigned short)(w.y & 0xffffu)), bf2f((unsigned short)(w.y >> 16))}; }
}
__device__ __forceinline__ void load_row(const float* p, int lane, f32x4 (&v)[4]) {
#pragma unroll
    for (int j = 0; j < 4; ++j) v[j] = ((const f32x4*)p)[lane + 64 * j];
}
__device__ __forceinline__ void adaln_store(const f32x4 (&v)[4], const float* shift, const float* scale, bf16* hrow, int lane) {
    float mean, rstd; row_stats(v, mean, rstd);
#pragma unroll
    for (int j = 0; j < 4; ++j) { const int c = 4 * lane + 256 * j; const f32x4 sc = *(const f32x4*)(scale + c), sh = *(const f32x4*)(shift + c);
        const f32x4 h = (v[j] - mean) * rstd * (sc + 1.0f) + sh;
        v2u w; w.x = pk2(h[0], h[1]); w.y = pk2(h[2], h[3]); *(v2u*)(hrow + c) = w; }
}
__device__ __forceinline__ void ln_affine(f32x4 (&v)[4], const float* g, const float* b, int lane) {
    float mean, rstd; row_stats(v, mean, rstd);
#pragma unroll
    for (int j = 0; j < 4; ++j) { const int c = 4 * lane + 256 * j; v[j] = (v[j] - mean) * rstd * *(const f32x4*)(g + c) + *(const f32x4*)(b + c); }
}
__device__ __forceinline__ void store_row(float* p, int lane, const f32x4 (&v)[4]) {
#pragma unroll
    for (int j = 0; j < 4; ++j) ((f32x4*)p)[lane + 64 * j] = v[j];
}

namespace hconv {
using bf16x8 = __attribute__((ext_vector_type(8))) short;
using f32x16 = __attribute__((ext_vector_type(16))) float;
constexpr int UB = 8256;
constexpr int SLOT = 16384 + 2 * UB;
__device__ __forceinline__ int crow(int r, int hi) { return (r & 3) + 8 * (r >> 2) + 4 * hi; }
__device__ __forceinline__ void item(const bf16* __restrict__ GRB, const bf16* __restrict__ UT, const float* __restrict__ FP, const float* __restrict__ skipv, const bf16* __restrict__ X0, bf16* __restrict__ YM,
                                     int ch0, LAS unsigned char* lds, const int tid, const int lane, const int wave) {
    for (int q = tid; q < 4 * 1024; q += 512) { const int ch = q >> 10, i = q & 1023; const v4u v = ((const v4u*)(GRB + (size_t)(ch0 + ch) * 8192))[i]; *(LAS v4u*)(lds + ch * SLOT + 16 * i) = v; }
    for (int q = tid; q < 4 * 1024; q += 512) { const int ch = q >> 10, b = (q >> 9) & 1, i = q & 511; const v4u v = ((const v4u*)(UT + ((size_t)b * HY + ch0 + ch) * LS))[i];
        *(LAS v4u*)(lds + ch * SLOT + 16384 + b * UB + 32 + 16 * i) = v; }
    if (tid < 32) { const int ch = tid >> 3, b = (tid >> 2) & 1, j = tid & 3; const v4u z = {0u, 0u, 0u, 0u};
        *(LAS v4u*)(lds + ch * SLOT + 16384 + b * UB + (j < 2 ? 16 * j : 32 + 8192 + 16 * (j - 2))) = z; }
    __syncthreads();
    v2u x0v[16];
    {
        const int slot = wave & 3, khalf = wave >> 2;
        const LAS unsigned char* gr = lds + slot * SLOT; const LAS unsigned char* ubuf = gr + 16384;
        const int r = lane & 31, h = lane >> 5, c = r & 15, b = r >> 4, c0 = c & 1, c1 = c >> 1;
        const LAS unsigned char* ap = gr + 992 + 16 * h - 32 * r + khalf * (129 * 32);
        const LAS unsigned char* bp = ubuf + b * UB + 16 * h + 4 * c1 + khalf * (129 * 32);
        const unsigned sh = 16u * (unsigned)c0;
        const int ch = ch0 + slot;
        const float nsum = wave_sum(FP[ch * 64 + lane] + FP[(HY + ch) * 64 + lane]); const float inv_norm = 1.f / nsum; const float skn = skipv[ch] * nsum;
        const LAS bf16* ul = (const LAS bf16*)(ubuf + b * UB + 32);
        f32x16 acc[8];
#pragma unroll
        for (int Q = 0; Q < 8; ++Q)
#pragma unroll
            for (int g = 0; g < 16; ++g) acc[Q][g] = khalf ? 0.f : skn * bf2f(ul[16 * (32 * Q + crow(g, h)) + c]);
        int nks = khalf ? 128 : 129; asm volatile("" : "+s"(nks));
        unsigned aa = (unsigned)(uintptr_t)ap, ba = (unsigned)(uintptr_t)bp;
        bf16x8 fa0, fa1, fa2, fa3, fa4, fa5, fa6, fa7, fb0, fb1, fb2, fb3, fb4, fb5, fb6, fb7; v2u da01, da23, db01, db23; unsigned da4, db4;
#define HC_LD(F0, F1, F2, F3, F4, F5, F6, F7, D01, D23, D4) do { \
            asm volatile("ds_read_b128 %0, %1 offset:7168" : "=v"(F0) : "v"(aa)); asm volatile("ds_read_b128 %0, %1 offset:6144" : "=v"(F1) : "v"(aa)); \
            asm volatile("ds_read2_b32 %0, %1 offset1:1" : "=v"(D01) : "v"(ba)); asm volatile("ds_read2_b32 %0, %1 offset0:2 offset1:3" : "=v"(D23) : "v"(ba)); asm volatile("ds_read_b32 %0, %1 offset:16" : "=v"(D4) : "v"(ba)); \
            asm volatile("ds_read_b128 %0, %1 offset:5120" : "=v"(F2) : "v"(aa)); asm volatile("ds_read_b128 %0, %1 offset:4096" : "=v"(F3) : "v"(aa)); \
            asm volatile("ds_read_b128 %0, %1 offset:3072" : "=v"(F4) : "v"(aa)); asm volatile("ds_read_b128 %0, %1 offset:2048" : "=v"(F5) : "v"(aa)); \
            asm volatile("ds_read_b128 %0, %1 offset:1024" : "=v"(F6) : "v"(aa)); asm volatile("ds_read_b128 %0, %1" : "=v"(F7) : "v"(aa)); __builtin_amdgcn_sched_barrier(0); } while (0)
#define HC_WAIT(F0, F1, F2, F3, F4, F5, F6, F7, D01, D23, D4) do { __builtin_amdgcn_sched_barrier(0); asm volatile("s_waitcnt lgkmcnt(0)" : "+v"(F0), "+v"(F1), "+v"(F2), "+v"(F3), "+v"(F4), "+v"(F5), "+v"(F6), "+v"(F7), "+v"(D01), "+v"(D23), "+v"(D4)); \
            __builtin_amdgcn_sched_barrier(0); } while (0)
#define HC_MMA(F0, F1, F2, F3, F4, F5, F6, F7, D01, D23, D4) do { u32x4 bw; bw.x = __builtin_amdgcn_alignbit(D01.y, D01.x, sh); bw.y = __builtin_amdgcn_alignbit(D23.x, D01.y, sh); bw.z = __builtin_amdgcn_alignbit(D23.y, D23.x, sh); \
            bw.w = __builtin_amdgcn_alignbit(D4, D23.y, sh); const bf16x8 bf = __builtin_bit_cast(bf16x8, bw); \
            acc[0] = __builtin_amdgcn_mfma_f32_32x32x16_bf16(F0, bf, acc[0], 0, 0, 0); acc[1] = __builtin_amdgcn_mfma_f32_32x32x16_bf16(F1, bf, acc[1], 0, 0, 0); \
            acc[2] = __builtin_amdgcn_mfma_f32_32x32x16_bf16(F2, bf, acc[2], 0, 0, 0); acc[3] = __builtin_amdgcn_mfma_f32_32x32x16_bf16(F3, bf, acc[3], 0, 0, 0); \
            acc[4] = __builtin_amdgcn_mfma_f32_32x32x16_bf16(F4, bf, acc[4], 0, 0, 0); acc[5] = __builtin_amdgcn_mfma_f32_32x32x16_bf16(F5, bf, acc[5], 0, 0, 0); \
            acc[6] = __builtin_amdgcn_mfma_f32_32x32x16_bf16(F6, bf, acc[6], 0, 0, 0); acc[7] = __builtin_amdgcn_mfma_f32_32x32x16_bf16(F7, bf, acc[7], 0, 0, 0); } while (0)
        HC_LD(fa0, fa1, fa2, fa3, fa4, fa5, fa6, fa7, da01, da23, da4);
        int npair = nks >> 1;
        for (int kp = 0; kp < npair; ++kp) {
            HC_WAIT(fa0, fa1, fa2, fa3, fa4, fa5, fa6, fa7, da01, da23, da4);
            aa += 32; ba += 32; HC_LD(fb0, fb1, fb2, fb3, fb4, fb5, fb6, fb7, db01, db23, db4);
            HC_MMA(fa0, fa1, fa2, fa3, fa4, fa5, fa6, fa7, da01, da23, da4);
            HC_WAIT(fb0, fb1, fb2, fb3, fb4, fb5, fb6, fb7, db01, db23, db4);
            aa += 32; ba += 32; HC_LD(fa0, fa1, fa2, fa3, fa4, fa5, fa6, fa7, da01, da23, da4);
            HC_MMA(fb0, fb1, fb2, fb3, fb4, fb5, fb6, fb7, db01, db23, db4);
        }
        HC_WAIT(fa0, fa1, fa2, fa3, fa4, fa5, fa6, fa7, da01, da23, da4);
        if (nks & 1) HC_MMA(fa0, fa1, fa2, fa3, fa4, fa5, fa6, fa7, da01, da23, da4);
#undef HC_LD
#undef HC_WAIT
#undef HC_MMA
#pragma unroll
        for (int i = 0; i < 16; ++i) { const int q = tid + 512 * i; x0v[i] = *(const v2u*)(X0 + ((size_t)NP + q) * HY + ch0); }
        asm volatile("s_waitcnt lgkmcnt(0)" ::: "memory");
        __syncthreads();
        LAS f32x4* xch = (LAS f32x4*)(lds + slot * SLOT);
        if (khalf) {
#pragma unroll
            for (int Q = 0; Q < 8; ++Q)
#pragma unroll
                for (int g4 = 0; g4 < 4; ++g4) xch[(Q * 4 + g4) * 64 + lane] = (f32x4){acc[Q][4 * g4], acc[Q][4 * g4 + 1], acc[Q][4 * g4 + 2], acc[Q][4 * g4 + 3]};
        }
        __syncthreads();
        if (!khalf) {
#pragma unroll
            for (int Q = 0; Q < 8; ++Q)
#pragma unroll
                for (int g4 = 0; g4 < 4; ++g4) { const f32x4 o = xch[(Q * 4 + g4) * 64 + lane]; acc[Q][4 * g4] += o[0]; acc[Q][4 * g4 + 1] += o[1]; acc[Q][4 * g4 + 2] += o[2]; acc[Q][4 * g4 + 3] += o[3]; }
        }
        asm volatile("s_waitcnt lgkmcnt(0)" ::: "memory");
        __syncthreads();
        if (!khalf) {
            LAS bf16* yl = (LAS bf16*)(lds + slot * SLOT);
#pragma unroll
            for (int Q = 0; Q < 8; ++Q)
#pragma unroll
                for (int g = 0; g < 16; ++g) { const int t = 16 * (32 * Q + crow(g, h)) + c; yl[b * LS + t] = (bf16)f2bf(acc[Q][g] * inv_norm); }
        }
    }
    __syncthreads();
#pragma unroll
    for (int i = 0; i < 16; ++i) { const int q = tid + 512 * i; const size_t row = (size_t)NP + q; const v2u xv = x0v[i];
        const float y0 = bf2f(*(const LAS bf16*)(lds + 0 * SLOT + 2 * q)), y1 = bf2f(*(const LAS bf16*)(lds + 1 * SLOT + 2 * q)), y2 = bf2f(*(const LAS bf16*)(lds + 2 * SLOT + 2 * q)), y3 = bf2f(*(const LAS bf16*)(lds + 3 * SLOT + 2 * q));
        v2u o; o.x = pk2(y0 * bf2f((unsigned short)(xv.x & 0xffffu)), y1 * bf2f((unsigned short)(xv.x >> 16))); o.y = pk2(y2 * bf2f((unsigned short)(xv.y & 0xffffu)), y3 * bf2f((unsigned short)(xv.y >> 16)));
        *(v2u*)(YM + row * DM + ch0) = o; }
    __syncthreads();
}
static_assert(4 * SLOT <= LDSCTL_OFF, "four channel slots fit in LDS");
}

__global__ void __launch_bounds__(512, 2) fwd_kernel(Args args) {
    extern __shared__ __attribute__((aligned(16))) unsigned char lds_raw[];
    LAS unsigned char* lds = (LAS unsigned char*)lds_raw;
    volatile LAS unsigned* MISC = (volatile LAS unsigned*)(lds + MISC_OFF);
    const int wave = __builtin_amdgcn_readfirstlane((int)threadIdx.x >> 6);
    const int G = gridDim.x; const int bx = blockIdx.x; const int vcu = (G % 8 == 0) ? (bx % 8) * (G / 8) + bx / 8 : bx;
    const int gw = vcu * 8 + wave, NGW = G * 8, NGT = G * 512;
#define FRESH() const int lane = fresh_lane(); const int tid = wave * 64 + lane; const int gt = vcu * 512 + tid; (void)gt
    unsigned char* ws = args.ws;
    gu32* ctl = (gu32*)(ws + WS_CTL);
    float* MODS = (float*)(ws + WS_MODS);
    float* X = args.out;
    bf16* T = (bf16*)(ws + WS_T);
    bf16* HB = (bf16*)(ws + WS_H);
    for (int u = threadIdx.x; u < (LDS_BYTES - LDSCTL_OFF) / 4; u += 512) ((LAS unsigned*)(lds + LDSCTL_OFF))[u] = 0u;
    __syncthreads();
    XcdBarrier bar; bar.bar = (unsigned*)(ctl + CW_BAR) + args.li * XCD_BAR_WORDS; bar.x = 0; bar.st = nullptr;
    if (!MK_PER_PHASE) bar = xcd_barrier_post((unsigned*)(ctl + CW_BAR) + args.li * XCD_BAR_WORDS, MISC + 8);
    const int lo = args.ph_lo, hi = args.ph_hi;
#ifndef NO_CONV
#define NO_CONV 0
#endif
#ifndef NO_ATT
#define NO_ATT 0
#endif
#ifndef PHASE_MASK
#define PHASE_MASK 0x1FFFF
#endif
#define IN(k) ((((PHASE_MASK) >> (k)) & 1) && lo <= (k) && (k) < hi)
#define SPLIT_CNT(b) ((unsigned*)(ctl + CW_SPLIT + (args.li * 6 + (b)) * 16384))
#define SLABS(mib) ((float*)(ws + (size_t)(mib) * MiB))
#define SEAM(k) do { if (IN(k) && IN((k) + 1)) xcd_barrier(bar); } while (0)

    if (IN(0)) {
        FRESH();
        asm volatile("; ==== PHASE 0 ====");
        for (int it = bx; it < 192; it += G) {
            const int layer = it / 96, cb = it % 96, col = cb * 64 + lane;
            LAS float* sil = (LAS float*)lds; LAS float* red = (LAS float*)(lds + 12288);
            for (int i = tid; i < 3072; i += 512) { const int r = i >> 10, k = i & 1023; const float c = (r == 0) ? args.in[I_CCTX][k] : args.in[I_C][(r - 1) * DM + k]; sil[i] = c / (1.f + fexp(-c)); }
            __syncthreads();
            const float* W = args.in[layer ? I_ADA1_W : I_ADA0_W]; float a0 = 0.f, a1 = 0.f, a2 = 0.f;
#pragma unroll 8
            for (int kk = 0; kk < 128; ++kk) { const int k = wave * 128 + kk; const float w = W[(size_t)k * 6144 + col]; a0 += sil[k] * w; a1 += sil[1024 + k] * w; a2 += sil[2048 + k] * w; }
            red[(wave * 3 + 0) * 64 + lane] = a0; red[(wave * 3 + 1) * 64 + lane] = a1; red[(wave * 3 + 2) * 64 + lane] = a2;
            __syncthreads();
            if (tid < 192) { const int r = tid >> 6, l = tid & 63; float s = 0.f;
#pragma unroll
                for (int w = 0; w < 8; ++w) s += red[(w * 3 + r) * 64 + l];
                MODS[(size_t)(layer * 3 + r) * 6144 + cb * 64 + l] = s + args.in[layer ? I_ADA1_B : I_ADA0_B][cb * 64 + l]; }
            __syncthreads();
        }
        {
            LAS float* scr = (LAS float*)(lds + wave * 16384);
            for (int it = gw; it < WI_L0; it += NGW) weight_item(args, ws, scr, it, lane);
        }
        for (int i = gt; i < 2048 * 128; i += NGT) { const int kp = i >> 7, c8 = (i & 127) * 8; const int part = kp >> 10, kq = kp & 1023, g = kq >> 7, cp = kq & 127; unsigned w[4] = {0u, 0u, 0u, 0u};
            if ((c8 >> 7) == g) {
#pragma unroll
                for (int e = 0; e < 8; e += 2) { const float r0 = (float)((cp * ((c8 + e) & 127)) & 127) * (1.f / 128.f), r1 = (float)((cp * ((c8 + e + 1) & 127)) & 127) * (1.f / 128.f);
                    const float a = (part ? -__builtin_amdgcn_sinf(r0) : __builtin_amdgcn_cosf(r0)) * 0.08838834764831845f, b = (part ? -__builtin_amdgcn_sinf(r1) : __builtin_amdgcn_cosf(r1)) * 0.08838834764831845f;
                    w[e >> 1] = pk2(a, b); } }
            ((v4u*)(ws + WS_CBD))[i] = (v4u){w[0], w[1], w[2], w[3]}; }
        {
            const v4u z = {0u, 0u, 0u, 0u};
            for (int i = gt; i < 8192 + 16384 + MKV * 16; i += NGT) {
                if (i < 8192) ((v4u*)(ws + WS_WIN_T + (size_t)1984 * 2048))[i] = z;
                else if (i < 8192 + 16384) { const int j = i - 8192; *(v4u*)(ws + WS_KVUP_T + (size_t)(j >> 4) * 512 + 256 + (j & 15) * 16) = z; }
                else { const int j = i - 8192 - 16384; *(v4u*)(ws + WS_KVN + (size_t)(j >> 4) * 512 + 256 + (j & 15) * 16) = z; }
            }
        }
        for (int i = gt; i < 65536; i += NGT) { const int rho = i >> 8, l = i & 255; const int k = rho > 128 ? rho - 128 : rho; const float rev = (float)((k * l) & 255) * (1.f / 256.f);
            ((bf16*)(ws + WS_D256))[i] = (bf16)f2bf((rho > 128 ? __builtin_amdgcn_sinf(rev) : __builtin_amdgcn_cosf(rev)) * 0.0625f); }
        {
            float* H2 = (float*)(ws + WS_H2);
            const float* w1 = args.in[I_HFW1]; const float* w2 = args.in[I_HFW2];
            const float b1 = args.in[I_HFB1][lane], b2 = args.in[I_HFB2][lane], fr = args.in[I_HFFREQ][lane];
            for (int R = gw; R < LS + LP; R += NGW) {
                const int L = R < LS ? LS : LP, l = R < LS ? R : R - LS;
                const float t = (float)l / (float)(L - 1);
                const float wang = (6.283185307179586f * (float)l) / (float)L;
                const int j = lane & 15; const float band = 1e-4f + (float)j * ((15.0f - 1e-4f) / 15.0f);
                const float ang = wang * band, rev = ang * INV_2PI;
                const float zl = (lane < 16) ? fcos_rev(rev) : -fsin_rev(rev);
                float p1 = b1 + t * w1[lane];
#pragma unroll
                for (int i = 0; i < 32; ++i) p1 += __shfl(zl, i) * w1[(1 + i) * 64 + lane];
                const float h1 = sinf(fr * p1);
                float p2 = b2;
#pragma unroll 16
                for (int i = 0; i < 64; ++i) p2 += __shfl(h1, i) * w2[i * 64 + lane];
                H2[(size_t)R * 64 + lane] = sinf(fr * p2);
            }
        }
    }
    SEAM(0);

    if (IN(1)) {
        FRESH();
        asm volatile("; ==== PHASE 1 ====");
        for (int m = gw; m < MT; m += NGW) {
            const float* xr = m < NP ? args.in[I_XP] + (size_t)m * DM : args.in[I_XS] + (size_t)(m - NP) * DM;
            const float* md = MODS + (size_t)req_of_row(m) * 6144;
            f32x4 v[4]; load_row(xr, lane, v); adaln_store(v, md, md + 1024, HB + (size_t)m * DM, lane);
        }
        {
            const float* H2 = (const float*)(ws + WS_H2); const float* w3 = args.in[I_HFW3];
            LAS float* w3l = (LAS float*)(lds + wave * 16384);
            for (int it = gw; it < 68 * 32; it += NGW) {
                const int lb = it >> 5, cg = it & 31; const bool smp = lb < 64; const int L = smp ? LS : LP; const int l = (smp ? lb : lb - 64) * 64 + lane; const int R = lb * 64 + lane;
#pragma unroll
                for (int q = 0; q < 32; ++q) { const int o = 2 * q + (lane >> 5); w3l[(lane & 31) * 68 + o] = w3[o * 1024 + cg * 32 + (lane & 31)]; }
                float h2[64];
#pragma unroll
                for (int q = 0; q < 16; ++q) { const f32x4 x = ((const f32x4*)(H2 + (size_t)R * 64))[q]; h2[4 * q] = x[0]; h2[4 * q + 1] = x[1]; h2[4 * q + 2] = x[2]; h2[4 * q + 3] = x[3]; }
                LDS_WAIT(); asm volatile("" ::: "memory");
                const float t = (float)l / (float)(L - 1);
                float* FP = (float*)(ws + (smp ? WS_FPART_S : WS_FPART_P));
                float av[32];
#pragma unroll
                for (int cc = 0; cc < 32; ++cc) {
                    const int col = cg * 32 + cc, ch = col & 511, half = col >> 9;
                    float a = 0.f;
#pragma unroll
                    for (int q = 0; q < 16; ++q) { const f32x4 w4 = *(const LAS f32x4*)(w3l + cc * 68 + 4 * q); a += (h2[4 * q] * w4[0] + h2[4 * q + 1] * w4[1]) + (h2[4 * q + 2] * w4[2] + h2[4 * q + 3] * w4[3]); }
                    const float delta = fabsf(-3.0701134573253944f + (float)ch * ((-15.350567286626973f + 3.0701134573253944f) / 511.0f));
                    const float val = a * fexp(-t * delta);
                    if (smp) {
                        bf16* GRB = (bf16*)(ws + WS_FT_S) + (size_t)ch * 8192;
                        if (half == 0) GRB[LS - l] = (bf16)f2bf(val); else GRB[l == 0 ? 0 : LS + l] = (bf16)(l == 0 ? 0u : f2bf(val));
                    } else ((float*)(ws + WS_FT_P))[(size_t)col * LP + l] = val;
                    av[cc] = fabsf(val);
                }
#pragma unroll
                for (int o = 1; o < 64; o <<= 1) {
#pragma unroll
                    for (int cc = 0; cc < 32; ++cc) av[cc] += __shfl_xor(av[cc], o); }
                if (lane < 32) { float sel = av[0];
#pragma unroll
                    for (int cc = 1; cc < 32; ++cc) sel = (lane == cc) ? av[cc] : sel;
                    FP[(cg * 32 + lane) * (smp ? 64 : 4) + (smp ? lb : lb - 64)] = sel; }
                LDS_WAIT(); asm volatile("" ::: "memory");
            }
        }
    }
    SEAM(1);

    if (IN(2)) {
        FRESH();
        asm volatile("; ==== PHASE 2 ====");
        pg8::Gemm g{HB, (const bf16*)(ws + WS_WIN_T), MT, WINP, DM}; pg8::StaticOrder S; S.init((MT / 192) * 256, WINP, G, bx);
        EpiWin<3> E{(bf16*)(ws + WS_P), (float*)(ws + WS_ZS)};
        pg8::gemm_phase<EpiWin<3>, pg8::StaticOrder, PG8_ALIGN, PG8_SP2, 3>(lds, g, S, E, tid);
    }
    SEAM(2);

    if (IN(3)) {
        FRESH();
        asm volatile("; ==== PHASE 3 ====");
        const bf16* P = (const bf16*)(ws + WS_P);
        for (int it = bx; it < MT / 64; it += G) {
            const int m0 = it * 64; const bool smp = m0 >= NP; const int L = smp ? LS : LP; const int l0 = smp ? (m0 - NP) % LS : m0 % LP;
            const int seq = smp ? (m0 - NP) / LS : m0 / LP;
            const int c = tid;
            const float* cw = args.in[I_CONVW]; const float* cb = args.in[I_CONVB];
            float w[3][3], bb[3];
#pragma unroll
            for (int s = 0; s < 3; ++s) { bb[s] = cb[s * 512 + c];
#pragma unroll
                for (int k = 0; k < 3; ++k) w[s][k] = cw[k * 1536 + s * 512 + c]; }
            float prev[3], cur[3];
#pragma unroll
            for (int s = 0; s < 3; ++s) { prev[s] = (l0 > 0) ? bf2f(P[(size_t)(m0 - 1) * 1536 + s * 512 + c]) : 0.f; cur[s] = bf2f(P[(size_t)m0 * 1536 + s * 512 + c]); }
            LAS bf16* ut = (LAS bf16*)lds;
            bf16* X0 = (bf16*)(ws + WS_X0);
            for (int i0 = 0; i0 < 64; i0 += 8) {
                float nx[8][3];
#pragma unroll
                for (int i = 0; i < 8; ++i) { const bool has_next = (l0 + i0 + i + 1) < L;
#pragma unroll
                    for (int s = 0; s < 3; ++s) { const float v = bf2f(P[(size_t)(m0 + i0 + i + (has_next ? 1 : 0)) * 1536 + s * 512 + c]); nx[i][s] = has_next ? v : 0.f; } }
#pragma unroll
                for (int i = 0; i < 8; ++i) {
                    float y[3];
#pragma unroll
                    for (int s = 0; s < 3; ++s) y[s] = prev[s] * w[s][0] + cur[s] * w[s][1] + nx[i][s] * w[s][2] + bb[s];
                    X0[(size_t)(m0 + i0 + i) * 512 + c] = (bf16)f2bf(y[0]);
                    ut[c * 68 + i0 + i] = (bf16)f2bf(y[2] * y[1]);
#pragma unroll
                    for (int s = 0; s < 3; ++s) { prev[s] = cur[s]; cur[s] = nx[i][s]; }
                }
            }
            __syncthreads();
            bf16* UT = (bf16*)(ws + (smp ? WS_UT_S : WS_UT_P)) + (size_t)seq * 512 * L + l0;
            for (int q = tid; q < 512 * 16; q += 512) { const int ch = q >> 4, part = q & 15; const v2u v = *(const LAS v2u*)(ut + ch * 68 + part * 4); *(v2u*)(UT + (size_t)ch * L + part * 4) = v; }
            __syncthreads();
        }
        const float* ZS = (const float*)(ws + WS_ZS);
        bf16* QN = (bf16*)(ws + WS_QN); bf16* KVN = (bf16*)(ws + WS_KVN);
        for (int m = gw; m < MKV; m += NGW) {
            if (m < MT) {
                const bool smp = m >= NP; const int b = smp ? (m - NP) / LS : m / LP, key = smp ? (m - NP) % LS : m % LP;
                const f32x4 a0 = ((const f32x4*)(ZS + (size_t)m * 512))[2 * lane], a1 = ((const f32x4*)(ZS + (size_t)m * 512))[2 * lane + 1];
                float x[8] = {a0[0], a0[1], a0[2], a0[3], a1[0], a1[1], a1[2], a1[3]};
                float ss = 0.f;
                if (lane < 48) {
#pragma unroll
                    for (int i = 0; i < 8; ++i) ss += x[i] * x[i]; }
#pragma unroll
                for (int o = 1; o < 32; o <<= 1) ss += __shfl_xor(ss, o);
                if (lane < 32) {
                    const float r = __builtin_amdgcn_rsqf(ss * (1.f / QL) + RMS_EPS); const float* g = args.in[I_QNORM] + 8 * lane;
                    v4u w; w.x = pk2(x[0] * r * g[0], x[1] * r * g[1]); w.y = pk2(x[2] * r * g[2], x[3] * r * g[3]); w.z = pk2(x[4] * r * g[4], x[5] * r * g[5]); w.w = pk2(x[6] * r * g[6], x[7] * r * g[7]);
                    *(v4u*)(QN + (size_t)m * 256 + 8 * lane) = w;
                } else if (lane < 48) {
                    const int c0 = 8 * (lane - 32); const float r = __builtin_amdgcn_rsqf(ss * (1.f / KVL) + RMS_EPS); const float* g = args.in[I_KVNORM] + c0;
                    float y[8];
#pragma unroll
                    for (int i = 0; i < 8; ++i) y[i] = x[i] * r * g[i];
                    v4u w; w.x = pk2(y[0], y[1]); w.y = pk2(y[2], y[3]); w.z = pk2(y[4], y[5]); w.w = pk2(y[6], y[7]);
                    *(v4u*)(KVN + (size_t)m * 256 + c0) = w;
                    if (!smp) { float* o = args.out + OUT_CKV + (size_t)m * KVL + c0; *(f32x4*)o = (f32x4){y[0], y[1], y[2], y[3]}; *(f32x4*)(o + 4) = (f32x4){y[4], y[5], y[6], y[7]}; }
                }
                {
                    float y[8];
                    const int q = lane - 48; const int seg = (q >> 2) & 1; const bool second = (q & 2) != 0; const int j0 = 8 * (q & 1);
                    const float pf = (float)(seg == 0 ? (key >> 6) : (key & 63));
#pragma unroll
                    for (int i = 0; i < 8; ++i) { const float pr = __shfl_xor(x[i], 2);
                        if (smp) { const float inv = __builtin_amdgcn_exp2f(-(float)(j0 + i) * (13.287712379549449f / 16.0f)); const float rev = pf * inv * INV_2PI;
                            y[i] = x[i] * fcos_rev(rev) + (second ? pr : -pr) * fsin_rev(rev); }
                        else y[i] = x[i]; }
                    if (lane >= 48 && lane < 56) {
                        const int kk = 8 * q;
                        if (!smp) { float* o = args.out + OUT_CKR + (size_t)m * DROPE + kk; *(f32x4*)o = (f32x4){y[0], y[1], y[2], y[3]}; *(f32x4*)(o + 4) = (f32x4){y[4], y[5], y[6], y[7]}; }
                        v4u w; w.x = pk2(y[0], y[1]); w.y = pk2(y[2], y[3]); w.z = pk2(y[4], y[5]); w.w = pk2(y[6], y[7]);
                        bf16* kf = (bf16*)(ws + (smp ? WS_KF_S : WS_KF_P)); const int lk = smp ? LKS : LP;
#pragma unroll
                        for (int h = 0; h < NH; ++h) *(v4u*)(kf + ((size_t)(b * NH + h) * lk + key) * DQK + DNOPE + kk) = w;
                    }
                }
            } else {
                const int mm = m - MT, b = mm / PAST, j = mm % PAST;
                if (lane < 16) { const float* s = args.in[I_CKV] + (size_t)mm * KVL + 8 * lane;
                    v4u w; w.x = pk2(s[0], s[1]); w.y = pk2(s[2], s[3]); w.z = pk2(s[4], s[5]); w.w = pk2(s[6], s[7]); *(v4u*)(KVN + (size_t)m * 256 + 8 * lane) = w; }
                else if (lane < 24) { const int kk = 8 * (lane - 16); const float* s = args.in[I_CKR] + (size_t)mm * DROPE + kk;
                    v4u w; w.x = pk2(s[0], s[1]); w.y = pk2(s[2], s[3]); w.z = pk2(s[4], s[5]); w.w = pk2(s[6], s[7]);
                    bf16* kf = (bf16*)(ws + WS_KF_S);
#pragma unroll
                    for (int h = 0; h < NH; ++h) *(v4u*)(kf + ((size_t)(b * NH + h) * LKS + LS + j) * DQK + DNOPE + kk) = w; }
            }
        }
    }
    SEAM(3);

    if (IN(4)) {
        FRESH();
        asm volatile("; ==== PHASE 4 ====");
        int k256 = 256; asm volatile("" : "+s"(k256));
        { pg8::Gemm g{(const bf16*)(ws + WS_QN), (const bf16*)(ws + WS_QUP_T), MT, 768, k256}; pg8::StaticOrder S; S.init(MT, 768, G, bx);
          EpiStore E{(bf16*)(ws + WS_Q), 768};
          pg8::gemm_phase<EpiStore, pg8::StaticOrder, PG8_ALIGN, PG8_SP2>(lds, g, S, E, tid); }
        { int bx2 = (bx + 144) % G; asm volatile("" : "+s"(bx2)); const int lane2 = fresh_lane(); const int tid = wave * 64 + lane2;
          pg8::Gemm g{(const bf16*)(ws + WS_KVN), (const bf16*)(ws + WS_KVUP_T), MKV, 1024, k256}; pg8::StaticOrder S; S.init(MKV, 1024, G, bx2);
          EpiKV E{(bf16*)(ws + WS_KF_S), (bf16*)(ws + WS_KF_P), (bf16*)(ws + WS_V_S), (bf16*)(ws + WS_V_P)};
          pg8::gemm_phase<EpiKV, pg8::StaticOrder, PG8_ALIGN, PG8_SP2>(lds, g, S, E, tid); }
        { int bx3 = (bx + 88) % G; asm volatile("" : "+s"(bx3)); const int lane3 = fresh_lane(); const int tid = wave * 64 + lane3;
          pg8::Gemm g{(const bf16*)(ws + WS_W1T), (const bf16*)(ws + WS_CBD), DM, 2048, DM}; pg8::StaticOrder S; S.init(DM, 2048, G, bx3);
          EpiStore E{(bf16*)(ws + WS_WFOLD_T), 2048};
          pg8::gemm_phase<EpiStore, pg8::StaticOrder, PG8_ALIGN, PG8_SP2>(lds, g, S, E, tid); }
    }
    SEAM(4);

    if (IN(5)) {
        FRESH();
        asm volatile("; ==== PHASE 5 ====");
        constexpr int NA_S = 2 * BS * NH * (LS / 256), NC_S = HY / 4, NA_P = BP * NH, NC_P = HY / 2, NW_T = (WI_ALL - WI_L0) / 8, NITEM = NA_S + NC_S + NA_P + NC_P + NW_T;
        bf16* YM = HB;
        for (;;) {
            if (tid == 0) MISC[0] = __hip_atomic_fetch_add((unsigned*)(ctl + CW_Q + 64 * args.li), 1u, RLX_AGENT);
            __syncthreads();
            const int it = __builtin_amdgcn_readfirstlane((int)MISC[0]);
            __syncthreads();
            if (it >= NITEM) break;
            { const int cls = it < NA_S ? 0 : it < NA_S + NC_S ? 1 : it < NA_S + NC_S + NA_P ? 2 : it < NA_S + NC_S + NA_P + NC_P ? 3 : 4; if (!((args.mask >> cls) & 1)) continue; }
            const int lane = fresh_lane(); const int tid = wave * 64 + lane;
            const bool isA_S = it < NA_S, isA_P = (it >= NA_S + NC_S) && (it < NA_S + NC_S + NA_P);
            if (isA_S || isA_P) { if (!NO_ATT) {
                int b, h, row0, lk, pos0, koff = 0, nkeys; const bf16 *kf, *vv; float* part = nullptr; unsigned* cnt = nullptr;
                if (isA_S) { const int un = it >> 1, half = it & 1; b = un / (NH * 16); h = (un / 16) % NH; const int qb = un % 16; row0 = NP + b * LS + qb * 256; lk = LKS; pos0 = qb * 256; kf = (const bf16*)(ws + WS_KF_S); vv = (const bf16*)(ws + WS_V_S);
                    nkeys = LKS / 2; koff = half * (LKS / 2); part = (float*)(ws + WS_APART) + (size_t)un * APART_F; cnt = (unsigned*)(ctl + CW_ATT + args.li * 8192 + un * 64); }
                else { const int u = it - NA_S - NC_S; b = u / NH; h = u % NH; row0 = b * LP; lk = LP; pos0 = -1; kf = (const bf16*)(ws + WS_KF_P); vv = (const bf16*)(ws + WS_V_P); nkeys = LP; }
                att::attn_dense_body((const bf16*)(ws + WS_Q) + (size_t)row0 * 768 + h * DQK, kf + ((size_t)(b * NH + h) * lk + koff) * DQK, vv + ((size_t)(b * NH + h) * lk + koff) * DVH,
                                     YM + (size_t)row0 * DM + HY + h * DVH, nkeys, pos0, (LAS char*)lds, tid, part, cnt, MISC); }
            } else if (it < NA_S + NC_S) {
                hconv::item((const bf16*)(ws + WS_FT_S), (const bf16*)(ws + WS_UT_S), (const float*)(ws + WS_FPART_S), args.in[I_HFSKIP], (const bf16*)(ws + WS_X0), YM, (it - NA_S) * 4, lds, tid, lane, wave);
            } else if (it >= NA_S + NC_S + NA_P + NC_P) {
                LAS float* scr = (LAS float*)(lds + wave * 16384);
                weight_item(args, ws, scr, WI_L0 + (it - (NA_S + NC_S + NA_P + NC_P)) * 8 + wave, lane);
                __syncthreads();
            } else if (!NO_CONV) {
                const int ch0 = (it - NA_S - NC_S - NA_P) * 2;
                const float* FT = (const float*)(ws + WS_FT_P); const float* FP = (const float*)(ws + WS_FPART_P);
                const bf16* UT = (const bf16*)(ws + WS_UT_P);
                LAS float* Gs = (LAS float*)lds;
                LAS float* Us = (LAS float*)(lds + 8192);
                for (int q = tid; q < 2 * 512; q += 512) { const int cl = q >> 9, e = q & 511; if (e < 2 * LP - 1) { const int d = e - (LP - 1); const int ch = ch0 + cl;
                    Gs[cl * 576 + e + (e >> 4)] = d >= 0 ? FT[(size_t)ch * LP + d] : FT[(size_t)(512 + ch) * LP - d]; } }
                for (int q = tid; q < 2 * BP * LP / 8; q += 512) { const int cl = q >> 9, b = (q >> 5) & 15, l8 = (q & 31) * 8; const v4u v = *(const v4u*)(UT + ((size_t)b * 512 + ch0 + cl) * LP + l8);
                    LAS float* d = Us + (cl * BP + b) * LP + l8; d[0] = bf2f((unsigned short)(v.x & 0xffffu)); d[1] = bf2f((unsigned short)(v.x >> 16)); d[2] = bf2f((unsigned short)(v.y & 0xffffu)); d[3] = bf2f((unsigned short)(v.y >> 16));
                    d[4] = bf2f((unsigned short)(v.z & 0xffffu)); d[5] = bf2f((unsigned short)(v.z >> 16)); d[6] = bf2f((unsigned short)(v.w & 0xffffu)); d[7] = bf2f((unsigned short)(v.w >> 16)); }
                const int cl = tid >> 8, ch = ch0 + cl, b = (tid >> 4) & 15, t0 = (tid & 15) * 16;
                const float nsum = ((FP[ch * 4] + FP[ch * 4 + 1]) + (FP[ch * 4 + 2] + FP[ch * 4 + 3])) + ((FP[(512 + ch) * 4] + FP[(512 + ch) * 4 + 1]) + (FP[(512 + ch) * 4 + 2] + FP[(512 + ch) * 4 + 3]));
                const float inv_norm = 1.f / nsum, skip = args.in[I_HFSKIP][ch];
                const bf16* X0 = (const bf16*)(ws + WS_X0);
                float x0v[16];
#pragma unroll
                for (int i = 0; i < 16; ++i) x0v[i] = bf2f(X0[((size_t)b * LP + t0 + i) * 512 + ch]);
                __syncthreads();
                {
                    float y[16];
#pragma unroll
                    for (int i = 0; i < 16; ++i) y[i] = 0.f;
                    const LAS float* ub = Us + (cl * BP + b) * LP; const LAS float* gs = Gs + cl * 576;
                    for (int s0 = 0; s0 < LP; s0 += 16) {
                        const int base0 = t0 + LP - 1 - s0;
                        float W[31];
#pragma unroll
                        for (int j = 0; j < 31; ++j) { const int e = base0 - 15 + j; W[j] = gs[e + (e >> 4)]; }
#pragma unroll
                        for (int k = 0; k < 16; ++k) { const float uu = ub[s0 + k];
#pragma unroll
                            for (int i = 0; i < 16; ++i) y[i] += W[15 - k + i] * uu; }
                    }
#pragma unroll
                    for (int i = 0; i < 16; ++i) { const size_t row = (size_t)b * LP + t0 + i;
                        const float v = y[i] * inv_norm + skip * ub[t0 + i];
                        YM[row * DM + ch] = (bf16)f2bf(v * x0v[i]); }
                }
                __syncthreads();
            }
        }
    }
    SEAM(5);

    if (IN(6)) {
        FRESH();
        asm volatile("; ==== PHASE 6 ====");
        pg8::Gemm g{HB, (const bf16*)(ws + WS_WOUT0_T), MT, DM, DM}; pg8::StaticOrder S; S.init((MT / 192) * 256, DM, G, bx);
        EpiRes<3> E{args.in[I_XP], args.in[I_XS], MODS + 2 * 1024, T};
        pg8::gemm_phase<EpiRes<3>, pg8::StaticOrder, PG8_ALIGN, PG8_SP2, 3>(lds, g, S, E, tid);
    }
    SEAM(6);

    if (IN(7)) {
        FRESH();
        asm volatile("; ==== PHASE 7 ====");
        for (int m = gw; m < MT; m += NGW) {
            const float* md = MODS + (size_t)req_of_row(m) * 6144;
            f32x4 v[4]; load_row(T + (size_t)m * DM, lane, v); ln_affine(v, args.in[I_LN1G0], args.in[I_LN1B0], lane); store_row(X + (size_t)m * DM, lane, v);
            adaln_store(v, md + 3 * 1024, md + 4 * 1024, HB + (size_t)m * DM, lane);
        }
    }
    SEAM(7);

    if (IN(8)) {
        FRESH();
        asm volatile("; ==== PHASE 8 ====");
        pg8::Gemm g{HB, (const bf16*)(ws + WS_W1_0), MT, FF, DM}; pg8::StaticOrder S; S.init(MT, FF, G, bx);
        EpiUp E{(bf16*)(ws + WS_HID)};
        pg8::gemm_phase<EpiUp, pg8::StaticOrder, PG8_ALIGN, PG8_SP2>(lds, g, S, E, tid);
    }
    SEAM(8);

    if (IN(9)) {
        FRESH();
        asm volatile("; ==== PHASE 9 ====");
        pg8::Gemm g{(const bf16*)(ws + WS_HID), (const bf16*)(ws + WS_W2_0), MT, DM, FF}; pg8::StaticOrder S; S.init((MT / 192) * 256, DM, G, bx);
        EpiRes<3> E{X, X + (size_t)NP * DM, MODS + 5 * 1024, T};
        pg8::gemm_phase<EpiRes<3>, pg8::StaticOrder, PG8_ALIGN, PG8_SP2, 3>(lds, g, S, E, tid);
    }
    SEAM(9);

    if (IN(10)) {
        FRESH();
        asm volatile("; ==== PHASE 10 ====");
        const float* MODS1 = MODS + 3 * 6144;
        for (int it = bx; it < MT / 32; it += G) {
            const int m0 = it * 32; const bool smp = m0 >= NP; const int L = smp ? LS : LP; const int l0 = smp ? (m0 - NP) % LS : m0 % LP; const int seq = smp ? (m0 - NP) / LS : m0 / LP;
            LAS bf16* ht = (LAS bf16*)lds;
            const float* md = MODS1 + (size_t)req_of_row(m0) * 6144;
            for (int rr = 0; rr < 4; ++rr) { const int i = wave * 4 + rr, m = m0 + i;
                f32x4 v[4]; load_row(T + (size_t)m * DM, lane, v); ln_affine(v, args.in[I_LN2G0], args.in[I_LN2B0], lane); store_row(X + (size_t)m * DM, lane, v);
                float mean, rstd; row_stats(v, mean, rstd);
#pragma unroll
                for (int j = 0; j < 4; ++j) { const int c = 4 * lane + 256 * j; const f32x4 sc = *(const f32x4*)(md + 1024 + c), sh = *(const f32x4*)(md + c);
                    const f32x4 h = (v[j] - mean) * rstd * (sc + 1.0f) + sh;
#pragma unroll
                    for (int e = 0; e < 4; ++e) ht[(c + e) * 40 + i] = (bf16)f2bf(h[e]); }
            }
            __syncthreads();
            bf16* HT = HB + (smp ? (size_t)NP * DM + (size_t)seq * DM * LS : (size_t)seq * DM * LP) + l0;
            for (int q = tid; q < 1024 * 4; q += 512) { const int c = q >> 2, part = q & 3; const v4u v = *(const LAS v4u*)(ht + c * 40 + part * 8); *(v4u*)(HT + (size_t)c * L + part * 8) = v; }
            __syncthreads();
        }
        for (size_t i = gt; i < (size_t)LS * LS / 8; i += NGT) {
            const int rho = (int)(i >> 9), l8 = (int)(i & 511) * 8; const int k = rho > 2048 ? rho - 2048 : rho; unsigned w[4];
#pragma unroll
            for (int e = 0; e < 8; e += 2) { const float r0 = (float)((k * (l8 + e)) & 4095) * (1.f / 4096.f), r1 = (float)((k * (l8 + e + 1)) & 4095) * (1.f / 4096.f);
                const float a = (rho > 2048 ? __builtin_amdgcn_sinf(r0) : __builtin_amdgcn_cosf(r0)) * 0.015625f, b = (rho > 2048 ? __builtin_amdgcn_sinf(r1) : __builtin_amdgcn_cosf(r1)) * 0.015625f;
                w[e >> 1] = pk2(a, b); }
            ((v4u*)(ws + WS_D4096))[i] = (v4u){w[0], w[1], w[2], w[3]};
        }
    }
    SEAM(10);

    if (IN(11)) {
        FRESH();
        asm volatile("; ==== PHASE 11 ====");
        { pg8::Gemm g{(const bf16*)(ws + WS_D4096), HB + (size_t)NP * DM, LS, BS * DM, LS}; pg8::SplitOrder S; S.init(LS, BS * DM, LS, G, vcu, SLABS(200), SPLIT_CNT(3));
          EpiDft E{(bf16*)(ws + WS_UV), LS, NP};
          pg8::gemm_phase<EpiDft, pg8::SplitOrder, PG8_ALIGN, PG8_SP2>(lds, g, S, E, tid); }
        { int bx2 = (bx + 128) % G; asm volatile("" : "+s"(bx2)); const int lane2 = fresh_lane(); const int tid = wave * 64 + lane2;
          pg8::Gemm g{(const bf16*)(ws + WS_D256), HB, LP, BP * DM, LP}; pg8::StaticOrder S; S.init(LP, BP * DM, G, bx2);
          EpiDft E{(bf16*)(ws + WS_UV), LP, 0};
          pg8::gemm_phase<EpiDft, pg8::StaticOrder, PG8_ALIGN, PG8_SP2>(lds, g, S, E, tid); }
    }
    SEAM(11);

    if (IN(12)) {
        FRESH();
        asm volatile("; ==== PHASE 12 ====");
        pg8::Gemm g{(const bf16*)(ws + WS_UV), (const bf16*)(ws + WS_WFOLD_T), MT, DM, 2048}; pg8::StaticOrder S; S.init((MT / 192) * 256, DM, G, bx);
        EpiRes<3> E{X, X + (size_t)NP * DM, MODS + 3 * 6144 + 2 * 1024, T};
        pg8::gemm_phase<EpiRes<3>, pg8::StaticOrder, PG8_ALIGN, PG8_SP2, 3>(lds, g, S, E, tid);
    }
    SEAM(12);

    if (IN(13)) {
        FRESH();
        asm volatile("; ==== PHASE 13 ====");
        for (int m = gw; m < MT; m += NGW) {
            const float* md = MODS + 3 * 6144 + (size_t)req_of_row(m) * 6144;
            f32x4 v[4]; load_row(T + (size_t)m * DM, lane, v); ln_affine(v, args.in[I_LN1G1], args.in[I_LN1B1], lane); store_row(X + (size_t)m * DM, lane, v);
            adaln_store(v, md + 3 * 1024, md + 4 * 1024, HB + (size_t)m * DM, lane);
        }
    }
    SEAM(13);

    if (IN(14)) {
        FRESH();
        asm volatile("; ==== PHASE 14 ====");
        pg8::Gemm g{HB, (const bf16*)(ws + WS_W1_1), MT, FF, DM}; pg8::StaticOrder S; S.init(MT, FF, G, bx);
        EpiUp E{(bf16*)(ws + WS_HID)};
        pg8::gemm_phase<EpiUp, pg8::StaticOrder, PG8_ALIGN, PG8_SP2>(lds, g, S, E, tid);
    }
    SEAM(14);

    if (IN(15)) {
        FRESH();
        asm volatile("; ==== PHASE 15 ====");
        pg8::Gemm g{(const bf16*)(ws + WS_HID), (const bf16*)(ws + WS_W2_1), MT, DM, FF}; pg8::StaticOrder S; S.init((MT / 192) * 256, DM, G, bx);
        EpiRes<3> E{X, X + (size_t)NP * DM, MODS + 3 * 6144 + 5 * 1024, T};
        pg8::gemm_phase<EpiRes<3>, pg8::StaticOrder, PG8_ALIGN, PG8_SP2, 3>(lds, g, S, E, tid);
    }
    SEAM(15);

    if (IN(16)) {
        FRESH();
        asm volatile("; ==== PHASE 16 ====");
        for (int m = gw; m < MT; m += NGW) {
            f32x4 v[4]; load_row(T + (size_t)m * DM, lane, v); ln_affine(v, args.in[I_LN2G1], args.in[I_LN2B1], lane); store_row(X + (size_t)m * DM, lane, v);
        }
    }
#undef IN
#undef SEAM
}

extern "C" void kernel_launch(void* const* d_in, const int* in_sizes, int n_in, void* d_out, int out_size, void* d_ws, size_t ws_size, hipStream_t stream) {
    static int grid = 0;
    if (grid == 0) {
        if (n_in != 38 || ws_size < WS_END) { fprintf(stderr, "kernel_launch: expected 38 inputs and >= %zu bytes of workspace; got %d, %zu\n", (size_t)WS_END, n_in, ws_size); grid = -1; return; }
        int dev = 0, cus = 0;
        if (hipGetDevice(&dev) != hipSuccess || hipDeviceGetAttribute(&cus, hipDeviceAttributeMultiprocessorCount, dev) != hipSuccess) { grid = -1; return; }
        if (hipFuncSetAttribute((const void*)fwd_kernel, hipFuncAttributeMaxDynamicSharedMemorySize, LDS_BYTES) != hipSuccess) { fprintf(stderr, "kernel_launch: hipFuncSetAttribute failed\n"); grid = -1; return; }
        int per_cu = 0;
        if (hipOccupancyMaxActiveBlocksPerMultiprocessor(&per_cu, (const void*)fwd_kernel, 512, LDS_BYTES) != hipSuccess || per_cu < 1) fprintf(stderr, "kernel_launch: occupancy query reports %d\n", per_cu);
        (void)hipGetLastError();
        grid = cus;
    }
    if (grid < 0) return;
    (void)hipMemsetAsync((char*)d_ws + WS_CTL, 0, CTL_ZERO_BYTES, stream);
    Args a{};
    for (int i = 0; i < 38; ++i) a.in[i] = (const float*)d_in[i];
    a.out = (float*)d_out; a.ws = (unsigned char*)d_ws;
#if MK_PER_PHASE
    for (int p = 0; p < NPHASE; ++p) { a.ph_lo = p; a.ph_hi = p + 1; a.li = 0; a.mask = 31; hipLaunchKernelGGL(fwd_kernel, dim3(grid), dim3(512), LDS_BYTES, stream, a); }
#elif defined(PROBE_A)
#ifndef PROBE_MASK5
#define PROBE_MASK5 31
#endif
    a.mask = 31; a.ph_lo = 0; a.ph_hi = PROBE_B; a.li = 0; hipLaunchKernelGGL(fwd_kernel, dim3(grid), dim3(512), LDS_BYTES, stream, a);
    a.mask = PROBE_MASK5; a.ph_lo = PROBE_A; a.ph_hi = NPHASE; a.li = 1; hipLaunchKernelGGL(fwd_kernel, dim3(grid), dim3(512), LDS_BYTES, stream, a);
#else
    a.ph_lo = 0; a.ph_hi = NPHASE; a.li = 0; a.mask = 31;
    hipLaunchKernelGGL(fwd_kernel, dim3(grid), dim3(512), LDS_BYTES, stream, a);
#endif
    const hipError_t le = hipPeekAtLastError();
    if (le != hipSuccess) fprintf(stderr, "kernel_launch: launch failed: %s\n", hipGetErrorName(le));
}
```

```cpp
#include <hip/hip_runtime.h>
#include <hip/hip_bf16.h>
#include <cstdio>
#include <cstdint>
#include <cmath>
namespace pg8 {
#define PG8_LAS __attribute__((address_space(3)))
typedef unsigned short bf16_t;
typedef short bf16x8 __attribute__((ext_vector_type(8)));
typedef float f32x4 __attribute__((ext_vector_type(4)));
typedef unsigned u32x4 __attribute__((ext_vector_type(4)));
constexpr int BM = 256, BK = 64, HALF = 128, HTB = HALF * BK * 2  , STAGE_BYTES = 8 * HTB, NXCD = 8, WGM = 8;

__host__ __device__ __forceinline__ int lds_byte(int r, int c) { const int st = (r >> 4) * 2 + (c >> 5), rr = r & 15, cc = c & 31, ob = rr * 64 + cc * 2; return st * 1024 + (ob ^ (((ob >> 9) & 1) << 5)); }
__host__ __device__ __forceinline__ void stage_rc(int b, int& R, int& C) { const int st = b / 1024, sb = b % 1024, swz = sb ^ (((sb >> 9) & 1) << 5); R = (st >> 1) * 16 + swz / 64; C = (st & 1) * 32 + (swz % 64) / 2; }
__host__ __device__ __forceinline__ int perm32(int rho) { const int n = rho >> 4, i = rho & 15; return 8 * (i >> 2) + 4 * n + (i & 3); }

struct Unit { int pm, pn; int k0, nt, mode, slab, need, tile; };
struct Gemm { const bf16_t* A; const bf16_t* Bt; int M, N, K; };

struct StaticOrder {
    int nM, nN, nwg, G, c;
    __host__ __device__ void init(int M, int N, int G_, int c_) { nM = M / BM; nN = N / BM; nwg = nM * nN; G = G_; c = c_; }
    __host__ __device__ bool next(int i, Unit& u) const {
        const long L = (long)i * G + c; if (L >= nwg) return false;
        int wgid = (int)L; { const int q = nwg / NXCD, r = nwg % NXCD, xcd = wgid % NXCD, off = wgid / NXCD; wgid = (xcd < r ? xcd * (q + 1) : r * (q + 1) + (xcd - r) * q) + off; }
        const int nig = WGM * nN, gid = wgid / nig, fm = gid * WGM, gsz = (nM - fm) < WGM ? (nM - fm) : WGM;
        u.pm = fm + ((wgid % nig) % gsz); u.pn = (wgid % nig) / gsz; u.k0 = 0; u.nt = 0; u.mode = 0; u.slab = 0; u.need = 0; u.tile = 0; return true;
    }
    static constexpr bool SPLIT = false;
    __device__ __forceinline__ void a_ready(const Unit&) const {}
    __device__ __forceinline__ void done(const Unit&) const {}
};

struct SplitOrder {
    static constexpr bool SPLIT = true;
    int nM, nN, NT, per, c, lo, hi, tf, ns, give_last, P; float* slabs; unsigned* cnt;
    __device__ __forceinline__ void init(int M, int N, int K, int G_, int c_, float* slabs_, unsigned* cnt_) {
        nM = M / BM; nN = N / BM; NT = K / BK; c = c_; slabs = slabs_; cnt = cnt_;
        const int TU = nM * nN * NT; per = (TU + G_ - 1) / G_; per += per & 1;
        lo = c * per; hi = lo + per < TU ? lo + per : TU; if (lo >= TU) { lo = 0; hi = 0; }
        tf = lo / NT; ns = hi > lo ? (hi - 1) / NT - tf + 1 : 0; give_last = (hi % NT) != 0 ? 1 : 0;
        int a = per, b = NT; while (b) { const int t = a % b; a = b; b = t; } P = NT / a;
    }
    __device__ __forceinline__ int giver_index(int j) const { return j - j / P; }
    __device__ __forceinline__ bool next(int i, Unit& u) const {
        if (i >= ns) return false;
        int sidx; if (ns == 1) sidx = 0; else if (give_last && i == 0) sidx = ns - 1; else if (i == ns - 1) sidx = 0; else sidx = i - give_last + 1;
        const int T = tf + sidx, tlo = T * NT, thi = tlo + NT; const int a = lo > tlo ? lo : tlo, b = hi < thi ? hi : thi;
        const int nig = WGM * nN, gid = T / nig, fm = gid * WGM, gsz = (nM - fm) < WGM ? (nM - fm) : WGM;
        u.pm = fm + ((T % nig) % gsz); u.pn = (T % nig) / gsz; u.k0 = a - tlo; u.nt = b - a; u.tile = T;
        if (b != thi) { u.mode = 1; u.slab = giver_index(c); u.need = 0; }
        else if (a != tlo) { const int c0 = tlo / per; u.mode = 2; u.slab = giver_index(c0); u.need = c - c0; }
        else { u.mode = 0; u.slab = 0; u.need = 0; }
        return true;
    }
    __device__ __forceinline__ void a_ready(const Unit&) const {}
    __device__ __forceinline__ void done(const Unit&) const {}
};
__device__ __forceinline__ unsigned cvt_pk_bf16(float lo, float hi) { unsigned r; asm volatile("v_cvt_pk_bf16_f32 %0, %1, %2" : "=v"(r) : "v"(lo), "v"(hi)); return r; }
template <class Epi, class Sched, bool ALIGN_EPI = false, bool SP2 = false, int MF = 4>
__device__ __forceinline__ void gemm_phase(PG8_LAS unsigned char* lds, const Gemm g, const Sched& S, const Epi& E, const int tid) {
    const int wid = __builtin_amdgcn_readfirstlane(tid >> 6), lane = tid & 63, wr = wid >> 2, wc = wid & 3, fr = lane & 15, fq = lane >> 4;
    const int K = g.K, nt = K / BK;
    unsigned voffA[2], voffB[2];
#pragma unroll
    for (int i = 0; i < 2; ++i) { int R, C; stage_rc(tid * 16 + i * 8192, R, C); const int Rb = Epi::PERM ? ((R & ~31) + perm32(R & 31)) : R;
        voffA[i] = (unsigned)(R * K + C) * 2u; voffB[i] = (unsigned)(Rb * K + C) * 2u; }
    const size_t kstep = (size_t)(BK * 2);
    const size_t hstepB = (size_t)HALF * K * 2, tstepB = 2 * hstepB;
    const size_t hstepA = (size_t)(32 * MF) * K * 2, tstepA = 2 * hstepA;
    const unsigned ldsw = (unsigned)wid * 1024u;
    const int aoff = lds_byte(wr * (16 * MF) + fr, fq * 8), boff = lds_byte(wc * 32 + fr, fq * 8);
#define PG8_SA(b, h) (((b) * 2 + (h)) * HTB)
#define PG8_SB(b, h) ((4 + (b) * 2 + (h)) * HTB)
#define PG8_STAGE(bufoff, gbase, voff) do { _Pragma("unroll") for (int _i = 0; _i < 2; ++_i) \
        __builtin_amdgcn_global_load_lds((const unsigned*)((const char*)(gbase) + (voff)[_i]), (PG8_LAS unsigned*)(lds + (bufoff) + ldsw + _i * 8192), 16, 0, 0); } while (0)
#define PG8_LDA(dst, b, h) do { _Pragma("unroll") for (int m = 0; m < MF; ++m) _Pragma("unroll") for (int k = 0; k < 2; ++k) dst[m][k] = *(const PG8_LAS bf16x8*)(lds + PG8_SA(b, h) + aoff + m * 2048 + k * 1024); } while (0)
#define PG8_LDB(dst, b, h) do { _Pragma("unroll") for (int n = 0; n < 2; ++n) _Pragma("unroll") for (int k = 0; k < 2; ++k) dst[n][k] = *(const PG8_LAS bf16x8*)(lds + PG8_SB(b, h) + boff + n * 2048 + k * 1024); } while (0)
#define PG8_MMA(ai, bj, At, Bt) do { __builtin_amdgcn_s_setprio(1); _Pragma("unroll") for (int m = 0; m < MF; ++m) _Pragma("unroll") for (int n = 0; n < 2; ++n) _Pragma("unroll") for (int k = 0; k < 2; ++k) \
        acc[ai][bj][m][n] = __builtin_amdgcn_mfma_f32_16x16x32_bf16(Bt[n][k], At[m][k], acc[ai][bj][m][n], 0, 0, 0); __builtin_amdgcn_s_setprio(0); } while (0)
#define PG8_WAIT_V(n) asm volatile("s_waitcnt vmcnt(" #n ")" ::: "memory")
#define PG8_WAIT_L(n) asm volatile("s_waitcnt lgkmcnt(" #n ")" ::: "memory")
#define PG8_BAR __builtin_amdgcn_s_barrier()
#define PG8_SCHED __builtin_amdgcn_sched_barrier(0)
    Unit cur, nxt; int ui = 0;
    if (!S.next(0, cur)) return;
    f32x4 acc[2][2][4][2];
#pragma unroll
    for (int a = 0; a < 2; ++a)
#pragma unroll
        for (int b = 0; b < 2; ++b)
#pragma unroll
            for (int m = 0; m < 4; ++m)
#pragma unroll
                for (int n = 0; n < 2; ++n) acc[a][b][m][n] = (f32x4){0.f, 0.f, 0.f, 0.f};
    bf16x8 At[4][2], B0[2][2], B1[2][2];
    const char* cA = (const char*)g.A + (size_t)cur.pm * tstepA + (size_t)cur.k0 * kstep; const char* cB = (const char*)g.Bt + (size_t)cur.pn * tstepB + (size_t)cur.k0 * kstep;
    S.a_ready(cur);
    if constexpr (SP2) {
        PG8_STAGE(PG8_SB(0, 0), cB, voffB); PG8_STAGE(PG8_SB(0, 1), cB + hstepB, voffB); PG8_STAGE(PG8_SA(0, 0), cA, voffA); PG8_STAGE(PG8_SA(0, 1), cA + hstepA, voffA);
        if (wr == 1) PG8_BAR;
        PG8_WAIT_V(2); PG8_BAR;
        PG8_STAGE(PG8_SB(1, 0), cB + kstep, voffB); PG8_STAGE(PG8_SA(1, 0), cA + kstep, voffA); PG8_STAGE(PG8_SB(1, 1), cB + hstepB + kstep, voffB);
        PG8_WAIT_V(6); PG8_BAR;
    } else {
        PG8_STAGE(PG8_SB(0, 0), cB, voffB); PG8_STAGE(PG8_SA(0, 0), cA, voffA); PG8_STAGE(PG8_SB(0, 1), cB + hstepB, voffB); PG8_STAGE(PG8_SA(0, 1), cA + hstepA, voffA);
        if (wr == 1) PG8_BAR;
        PG8_WAIT_V(4); PG8_BAR;
        PG8_STAGE(PG8_SB(1, 0), cB + kstep, voffB); PG8_STAGE(PG8_SA(1, 0), cA + kstep, voffA); PG8_STAGE(PG8_SB(1, 1), cB + hstepB + kstep, voffB);
        PG8_WAIT_V(6); PG8_BAR;
    }
    for (;;) {
        const bool has_next = S.next(ui + 1, nxt);
        const char* nA = has_next ? (const char*)g.A + (size_t)nxt.pm * tstepA + (size_t)nxt.k0 * kstep : cA; const char* nB = has_next ? (const char*)g.Bt + (size_t)nxt.pn * tstepB + (size_t)nxt.k0 * kstep : cB;
        const int ntc = cur.nt ? cur.nt : nt;
        for (int t = 0; t < ntc; t += 2) {
            const bool last = (t == ntc - 2);
            const char* a1 = cA + (size_t)(t + 1) * kstep;
            const char* a2 = last ? nA : cA + (size_t)(t + 2) * kstep; const char* b2 = last ? nB : cB + (size_t)(t + 2) * kstep;
            const char* a3 = a2 + kstep; const char* b3 = b2 + kstep;
            if (last && has_next) S.a_ready(nxt);
            if constexpr (SP2) {
            PG8_LDB(B0, 0, 0); PG8_LDB(B1, 0, 1); PG8_SCHED; PG8_LDA(At, 0, 0); PG8_STAGE(PG8_SA(1, 1), a1 + hstepA, voffA);
            PG8_WAIT_V(8); PG8_WAIT_L(0); PG8_BAR; PG8_MMA(0, 0, At, B0); PG8_MMA(0, 1, At, B1); PG8_BAR; PG8_SCHED;
            PG8_LDA(At, 0, 1); PG8_STAGE(PG8_SB(0, 0), b2, voffB); PG8_STAGE(PG8_SB(0, 1), b2 + hstepB, voffB); PG8_STAGE(PG8_SA(0, 0), a2, voffA);
            PG8_WAIT_V(8); PG8_WAIT_L(0); PG8_BAR; PG8_MMA(1, 0, At, B0); PG8_MMA(1, 1, At, B1); PG8_BAR; PG8_SCHED;
            PG8_LDB(B0, 1, 0); PG8_LDB(B1, 1, 1); PG8_SCHED; PG8_LDA(At, 1, 0); PG8_STAGE(PG8_SA(0, 1), a2 + hstepA, voffA);
            PG8_WAIT_V(8); PG8_WAIT_L(0); PG8_BAR; PG8_MMA(0, 0, At, B0); PG8_MMA(0, 1, At, B1); PG8_BAR; PG8_SCHED;
            PG8_LDA(At, 1, 1); PG8_STAGE(PG8_SB(1, 0), b3, voffB); PG8_STAGE(PG8_SB(1, 1), b3 + hstepB, voffB); PG8_STAGE(PG8_SA(1, 0), a3, voffA);
            PG8_WAIT_V(8); PG8_WAIT_L(0); PG8_BAR; PG8_MMA(1, 0, At, B0); PG8_MMA(1, 1, At, B1); PG8_BAR; PG8_SCHED;
            } else {
            PG8_LDB(B0, 0, 0); PG8_SCHED; PG8_LDA(At, 0, 0); PG8_STAGE(PG8_SA(1, 1), a1 + hstepA, voffA);
            PG8_WAIT_L(8); PG8_BAR; PG8_WAIT_L(0); PG8_MMA(0, 0, At, B0); PG8_BAR; PG8_SCHED;
            PG8_LDB(B1, 0, 1); PG8_STAGE(PG8_SB(0, 0), b2, voffB);
            PG8_BAR; PG8_WAIT_L(0); PG8_MMA(0, 1, At, B1); PG8_BAR;
            PG8_LDA(At, 0, 1); PG8_STAGE(PG8_SA(0, 0), a2, voffA);
            PG8_BAR; PG8_WAIT_L(0); PG8_MMA(1, 0, At, B0); PG8_BAR; PG8_SCHED;
            PG8_STAGE(PG8_SB(0, 1), b2 + hstepB, voffB);
            PG8_WAIT_V(6); PG8_BAR; PG8_MMA(1, 1, At, B1); PG8_BAR;
            PG8_LDB(B0, 1, 0); PG8_SCHED; PG8_LDA(At, 1, 0); PG8_STAGE(PG8_SA(0, 1), a2 + hstepA, voffA);
            PG8_WAIT_L(8); PG8_BAR; PG8_WAIT_L(0); PG8_MMA(0, 0, At, B0); PG8_BAR; PG8_SCHED;
            PG8_LDB(B1, 1, 1); PG8_STAGE(PG8_SB(1, 0), b3, voffB);
            PG8_BAR; PG8_WAIT_L(0); PG8_MMA(0, 1, At, B1); PG8_BAR;
            PG8_LDA(At, 1, 1); PG8_STAGE(PG8_SA(1, 0), a3, voffA);
            PG8_BAR; PG8_WAIT_L(0); PG8_MMA(1, 0, At, B0); PG8_BAR; PG8_SCHED;
            PG8_STAGE(PG8_SB(1, 1), b3 + hstepB, voffB);
            PG8_WAIT_V(6); PG8_BAR; PG8_MMA(1, 1, At, B1); PG8_BAR;
            }
        }
        if constexpr (ALIGN_EPI) { if (wr == 0) PG8_BAR; }
        if constexpr (!Epi::AFTER_DRAIN) {
            Unit eu = cur; eu.pm = __builtin_amdgcn_readfirstlane(cur.pm); eu.pn = __builtin_amdgcn_readfirstlane(cur.pn); eu.slab = __builtin_amdgcn_readfirstlane(cur.slab); eu.tile = __builtin_amdgcn_readfirstlane(cur.tile);
            eu.need = __builtin_amdgcn_readfirstlane(cur.need); eu.mode = __builtin_amdgcn_readfirstlane(cur.mode);
            asm volatile("" : "+s"(eu.pm), "+s"(eu.pn), "+s"(eu.slab), "+s"(eu.tile), "+s"(eu.need), "+s"(eu.mode));
            if constexpr (Sched::SPLIT) {
                if (eu.mode == 1) {
                    const float* sp = S.slabs + (size_t)eu.slab * 65536 + wid * 8192 + lane * 4;
#pragma unroll
                    for (int a = 0; a < 2; ++a)
#pragma unroll
                        for (int b = 0; b < 2; ++b)
#pragma unroll
                            for (int m = 0; m < 4; ++m)
#pragma unroll
                                for (int n = 0; n < 2; ++n) { const f32x4 v = acc[a][b][m][n]; const float* p = sp + (((a * 2 + b) * 4 + m) * 2 + n) * 256;
                                    asm volatile("global_store_dwordx4 %0, %1, off sc1\n\ts_nop 1" :: "v"(p), "v"(v) : "memory"); }
                    asm volatile("s_waitcnt vmcnt(0)" ::: "memory");
                    if (lane == 0) __hip_atomic_fetch_add(S.cnt + eu.tile * 32, 1u, __ATOMIC_RELAXED, __HIP_MEMORY_SCOPE_AGENT);
                } else if (eu.mode == 2) {
                    unsigned sp_ = 0;
                    while ((unsigned)__builtin_amdgcn_readfirstlane(__hip_atomic_load(S.cnt + eu.tile * 32, __ATOMIC_RELAXED, __HIP_MEMORY_SCOPE_AGENT)) < 8u) { __builtin_amdgcn_s_sleep(8); if (++sp_ > (1u << 20)) break; }
                    __builtin_amdgcn_fence(__ATOMIC_ACQUIRE, "agent");
                    E.template run<true>(acc, eu, wr, wc, fr, fq, S.slabs + (size_t)eu.slab * 65536 + wid * 8192 + lane * 4);
                } else E.template run<false>(acc, eu, wr, wc, fr, fq, nullptr);
            } else E.template run<false>(acc, eu, wr, wc, fr, fq, nullptr);
            S.done(cur); }
        if (!has_next) break;
#pragma unroll
        for (int a = 0; a < 2; ++a)
#pragma unroll
            for (int b = 0; b < 2; ++b)
#pragma unroll
                for (int m = 0; m < 4; ++m)
#pragma unroll
                    for (int n = 0; n < 2; ++n) acc[a][b][m][n] = (f32x4){0.f, 0.f, 0.f, 0.f};
        cur = nxt; cA = nA; cB = nB; ++ui;
        if constexpr (ALIGN_EPI) { if (wr == 1) PG8_BAR; }
    }
    PG8_WAIT_V(0);
    if constexpr (!ALIGN_EPI) { if (wr == 0) PG8_BAR; }
    PG8_BAR;
    if constexpr (Epi::AFTER_DRAIN) { E.fused(acc, cur, wr, wc, fr, fq, lds, wid, lane); S.done(cur); }
#undef PG8_SA
#undef PG8_SB
#undef PG8_STAGE
#undef PG8_LDA
#undef PG8_LDB
#undef PG8_MMA
#undef PG8_WAIT_V
#undef PG8_WAIT_L
#undef PG8_BAR
#undef PG8_SCHED
}
}
#ifndef PG8_SP2
#define PG8_SP2 true
#endif
#ifndef PG8_ALIGN
#define PG8_ALIGN true
#endif
#ifndef MK_PER_PHASE
#define MK_PER_PHASE 0
#endif

constexpr int DM = 1024, FF = 4096;
constexpr int LP = 256, BP = 16, LS = 4096, BS = 2, PAST = 256;
constexpr int NP = BP * LP;
constexpr int NSR = BS * LS;
constexpr int MT = NP + NSR;
constexpr int MKV = MT + BS * PAST;
constexpr int LKS = LS + PAST;
constexpr int HY = 512, NH = 4, DQK = 192, DNOPE = 128, DROPE = 64, DVH = 128, QL = 256, KVL = 128;
constexpr int WINP = 2048;
constexpr float LN_EPS = 1e-5f, RMS_EPS = 1e-6f, ALPHA = 1.41421356237309515f;
constexpr int NPHASE = 17;

constexpr int att_shm_bytes = 2 * 16384 + 2 * 24576 + 2048 + 8 * 8 * 1024;
constexpr size_t MiB = 1u << 20, KiB = 1024;
constexpr size_t WS_CTL = 0, CTL_ZERO_BYTES = 1 * MiB;
constexpr size_t WS_MODS = 1 * MiB;
constexpr size_t WS_D256 = 1 * MiB + 256 * KiB;
constexpr size_t WS_H2 = 1 * MiB + 512 * KiB;
constexpr size_t WS_FPART_S = 3 * MiB;
constexpr size_t WS_FPART_P = 3 * MiB + 256 * KiB;
constexpr size_t WS_STATS = 3 * MiB + 512 * KiB;
constexpr size_t WS_WIN_T = 4 * MiB, WS_QUP_T = 8 * MiB, WS_KVUP_T = 8 * MiB + 512 * KiB, WS_WOUT0_T = 9 * MiB;
constexpr size_t WS_W1_0 = 11 * MiB, WS_W2_0 = 19 * MiB, WS_W1_1 = 27 * MiB, WS_W2_1 = 35 * MiB, WS_WFOLD_T = 43 * MiB;
constexpr size_t WS_T = 48 * MiB;
constexpr size_t WS_FT_S = 48 * MiB, WS_FT_P = 64 * MiB, WS_UT_S = 65 * MiB, WS_UT_P = 73 * MiB;
constexpr size_t WS_W1T = 80 * MiB, WS_CBD = 82 * MiB;
constexpr size_t WS_D4096 = 96 * MiB;
constexpr size_t WS_KF_S = 96 * MiB, WS_KF_P = 109 * MiB, WS_V_S = 115 * MiB, WS_V_P = 124 * MiB;
constexpr size_t WS_H = 128 * MiB;
constexpr size_t WS_P = 152 * MiB, WS_ZS = 188 * MiB, WS_QN = 212 * MiB, WS_KVN = 218 * MiB, WS_Q = 225 * MiB, WS_X0 = 243 * MiB;
constexpr size_t WS_HID = 152 * MiB, WS_UV = 152 * MiB;
constexpr size_t WS_END = 256 * MiB;
constexpr int CW_TMO = 0, CW_Q = 64, CW_BAR = 4096, CW_ATT = 16384, CW_SPLIT = 32768;
constexpr size_t WS_APART = 152 * MiB; constexpr int APART_F = 8 * 4 * 16 * 64 + 8 * 128;

constexpr int RING_BYTES = 131072, LDSCTL_OFF = 160 * 1024 - 512, MISC_OFF = LDSCTL_OFF + 320, LDS_BYTES = 160 * 1024;
static_assert(att_shm_bytes <= LDSCTL_OFF, "attention scratch fits below the LDS control words");

#define GAS __attribute__((address_space(1)))
#define LAS __attribute__((address_space(3)))
typedef unsigned short bf16;
typedef unsigned v4u __attribute__((ext_vector_type(4)));
typedef unsigned v2u __attribute__((ext_vector_type(2)));
typedef float f32x4 __attribute__((ext_vector_type(4)));
typedef GAS unsigned gu32;
#define RLX_AGENT __ATOMIC_RELAXED, __HIP_MEMORY_SCOPE_AGENT
#define LDS_WAIT() asm volatile("s_waitcnt lgkmcnt(0)" ::: "memory")
__device__ __forceinline__ unsigned f2bf(float f) { unsigned u = __builtin_bit_cast(unsigned, f); return (u + 0x7fffu + ((u >> 16) & 1u)) >> 16; }
__device__ __forceinline__ unsigned pk2(float lo, float hi) { return f2bf(lo) | (f2bf(hi) << 16); }
__device__ __forceinline__ float bf2f(unsigned short b) { return __builtin_bit_cast(float, (unsigned)b << 16); }
__device__ __forceinline__ float wave_sum(float v) {
#pragma unroll
    for (int o = 1; o < 64; o <<= 1) v += __shfl_xor(v, o);
    return v;
}
__device__ __forceinline__ float fsin_rev(float rev) { return __builtin_amdgcn_sinf(__builtin_amdgcn_fractf(rev)); }
__device__ __forceinline__ float fcos_rev(float rev) { return __builtin_amdgcn_cosf(__builtin_amdgcn_fractf(rev)); }
constexpr float INV_2PI = 0.15915494309189535f;
__device__ __forceinline__ float fexp(float x) { return __builtin_amdgcn_exp2f(x * 1.4426950408889634f); }

__device__ __forceinline__ int fresh_lane() { int l; asm volatile("v_mbcnt_lo_u32_b32 %0, -1, 0\n\tv_mbcnt_hi_u32_b32 %0, -1, %0" : "=v"(l)); return l; }
#define XB_TMO      128
#define XB_XCNT(j)  (256  + 64 * (j))
#define XB_XSUB(j)  (1280 + 64 * (j))
#define XB_XGEN(j)  (2304 + 64 * (j))
#define XB_TOP      3328
#define XB_TOPGEN   3392
#define XCD_BAR_WORDS 3456
#define XB_SPIN_CAP (1u << 23)
__device__ __forceinline__ unsigned xb_ld(unsigned* p)              { return __hip_atomic_load(p, __ATOMIC_RELAXED, __HIP_MEMORY_SCOPE_AGENT); }
__device__ __forceinline__ unsigned xb_add(unsigned* p, unsigned v) { return __hip_atomic_fetch_add(p, v, __ATOMIC_RELAXED, __HIP_MEMORY_SCOPE_AGENT); }
__device__ __forceinline__ unsigned xb_xcc_id() { return (unsigned)__builtin_amdgcn_s_getreg((3 << 11) | 20) & 0xFu; }
#define XB_SPIN(cond, bar) do { unsigned _sp = 0; while (cond) { __builtin_amdgcn_s_sleep(1); \
    if ((++_sp & 255u) == 0u) { if (xb_ld(&(bar)[XB_TMO])) break; if (_sp > XB_SPIN_CAP) { atomicAdd(&(bar)[XB_TMO], 1u); break; } } } } while (0)
struct XcdBarrier { unsigned* bar; unsigned x; volatile LAS unsigned* st; };
__device__ __forceinline__ XcdBarrier xcd_barrier_post(unsigned* bar, volatile LAS unsigned* st) {
    XcdBarrier b; b.bar = bar; b.x = xb_xcc_id(); b.st = st;
    if (threadIdx.x == 0) (void)xb_add(&bar[XB_XCNT(b.x)], 1u);
    return b;
}
__device__ __forceinline__ void xcd_barrier_complete(unsigned* bar, unsigned x, unsigned& nloc, unsigned& nx) {
    const unsigned G = gridDim.x * gridDim.y * gridDim.z;
    unsigned sum, cnt, mine, sp = 0u;
    for (;;) {
        sum = 0u; cnt = 0u; mine = 0u;
#pragma unroll
        for (unsigned j = 0; j < 16; ++j) { const unsigned c = xb_ld(&bar[XB_XCNT(j)]); sum += c; cnt += (c > 0u) ? 1u : 0u; mine = (j == x) ? c : mine; }
        if (sum == G) break;
        __builtin_amdgcn_s_sleep(1);
        if ((++sp & 255u) == 0u) { if (xb_ld(&bar[XB_TMO])) break; if (sp > XB_SPIN_CAP) { atomicAdd(&bar[XB_TMO], 1u); break; } }
    }
    nloc = mine > 0u ? mine : 1u; nx = cnt > 0u ? cnt : 1u;
}
__device__ __forceinline__ void xcd_barrier(const XcdBarrier& b) {
    asm volatile("s_waitcnt vmcnt(0)" ::: "memory");
    __syncthreads();
    if (threadIdx.x == 0) {
        unsigned* bar = b.bar;
        __builtin_amdgcn_s_waitcnt(0);
        unsigned nloc = b.st[0], nx = b.st[1];
        if (nloc == 0u) { xcd_barrier_complete(bar, b.x, nloc, nx); b.st[0] = nloc; b.st[1] = nx; }
        const unsigned old = xb_add(&bar[XB_XSUB(b.x)], 1u);
        const unsigned gen = old / nloc;
        if (old + 1u == (gen + 1u) * nloc) {
            __builtin_amdgcn_fence(__ATOMIC_RELEASE, "agent");
            asm volatile("s_waitcnt vmcnt(0)" ::: "memory");
            const unsigned og = xb_add(&bar[XB_TOP], 1u);
            const unsigned tg = og / nx;
            if (og + 1u == (tg + 1u) * nx) xb_add(&bar[XB_TOPGEN], 1u);
            else XB_SPIN(xb_ld(&bar[XB_TOPGEN]) == tg, bar);
            __builtin_amdgcn_fence(__ATOMIC_ACQUIRE, "agent");
            xb_add(&bar[XB_XGEN(b.x)], 1u);
            asm volatile("s_waitcnt vmcnt(0)" ::: "memory");
        } else {
            XB_SPIN(xb_ld(&bar[XB_XGEN(b.x)]) == gen, bar);
            __builtin_amdgcn_fence(__ATOMIC_ACQUIRE, "agent");
            asm volatile("s_waitcnt vmcnt(0)" ::: "memory");
        }
    }
    __syncthreads();
}

struct Args { const float* in[38]; float* out; unsigned char* ws; int ph_lo, ph_hi, li, mask; };
enum { I_XP = 0, I_XS, I_CKV, I_CKR, I_C, I_CCTX, I_ADA0_W, I_ADA0_B, I_WIN, I_CONVW, I_CONVB, I_HFW1, I_HFB1, I_HFFREQ, I_HFW2, I_HFB2, I_HFW3, I_HFSKIP,
       I_QNORM, I_QUP, I_KVNORM, I_KVUP, I_WOUT0, I_LN1G0, I_LN1B0, I_W1_0, I_W2_0, I_LN2G0, I_LN2B0, I_ADA1_W, I_ADA1_B, I_WOUT1, I_LN1G1, I_LN1B1, I_W1_1, I_W2_1, I_LN2G1, I_LN2B1 };
constexpr size_t OUT_CKV = (size_t)MT * DM, OUT_CKR = OUT_CKV + (size_t)NP * KVL;

__device__ __forceinline__ int req_of_row(int m) { return m < NP ? 0 : 1 + (m - NP) / LS; }

using pg8::f32x4; using pg8::Unit; using pg8::BM; using pg8::HALF; using pg8::cvt_pk_bf16;
typedef unsigned u32x4 __attribute__((ext_vector_type(4)));
__device__ __forceinline__ u32x4 pack8(const f32x4& a, const f32x4& b) { u32x4 w; w.x = cvt_pk_bf16(a[0], a[1]); w.y = cvt_pk_bf16(a[2], a[3]); w.z = cvt_pk_bf16(b[0], b[1]); w.w = cvt_pk_bf16(b[2], b[3]); return w; }

#define SLAB_ADD(v, ai, bj, m, n) do { if constexpr (SL) (v) += *(const f32x4*)(slab + ((((ai) * 2 + (bj)) * 4 + (m)) * 2 + (n)) * 256); } while (0)
template <int MF = 4> struct EpiWin {
    static constexpr bool PERM = true, AFTER_DRAIN = false;
    bf16* P; float* ZS;
    template <bool SL> __device__ __forceinline__ void run(const f32x4 (&acc)[2][2][4][2], const Unit& u, int wr, int wc, int fr, int fq, const float* slab) const {
        const int row0 = u.pm * (64 * MF) + wr * (16 * MF) + fr, colt = u.pn * BM + wc * 32 + 8 * fq;
#pragma unroll
        for (int ai = 0; ai < 2; ++ai)
#pragma unroll
            for (int m = 0; m < MF; ++m) { const int row = row0 + ai * (32 * MF) + m * 16;
#pragma unroll
                for (int bj = 0; bj < 2; ++bj) { const int col = colt + bj * HALF; f32x4 a0 = acc[ai][bj][m][0], a1 = acc[ai][bj][m][1]; SLAB_ADD(a0, ai, bj, m, 0); SLAB_ADD(a1, ai, bj, m, 1);
                    if (u.pn < 6) *(u32x4*)(P + (size_t)row * 1536 + col) = pack8(a0, a1);
                    else { float* d = ZS + (size_t)row * 512 + (col - 1536); *(f32x4*)d = a0; *(f32x4*)(d + 4) = a1; } } }
    }
};
struct EpiStore {
    static constexpr bool PERM = true, AFTER_DRAIN = false;
    bf16* O; int ld;
    template <bool SL> __device__ __forceinline__ void run(const f32x4 (&acc)[2][2][4][2], const Unit& u, int wr, int wc, int fr, int fq, const float* slab) const {
        const int row0 = u.pm * BM + wr * 64 + fr, colt = u.pn * BM + wc * 32 + 8 * fq;
#pragma unroll
        for (int ai = 0; ai < 2; ++ai)
#pragma unroll
            for (int m = 0; m < 4; ++m) { const int row = row0 + ai * HALF + m * 16;
#pragma unroll
                for (int bj = 0; bj < 2; ++bj) *(u32x4*)(O + (size_t)row * ld + colt + bj * HALF) = pack8(acc[ai][bj][m][0], acc[ai][bj][m][1]); }
    }
};
struct EpiKV {
    static constexpr bool PERM = true, AFTER_DRAIN = false;
    bf16 *KFs, *KFp, *Vs, *Vp;
    template <bool SL> __device__ __forceinline__ void run(const f32x4 (&acc)[2][2][4][2], const Unit& u, int wr, int wc, int fr, int fq, const float* slab) const {
        const int m0 = u.pm * BM; bf16* kf; bf16* vv; int lk, key0, b;
        if (m0 < NP) { b = m0 / LP; key0 = 0; lk = LP; kf = KFp; vv = Vp; }
        else if (m0 < MT) { b = (m0 - NP) / LS; key0 = (m0 - NP) % LS; lk = LKS; kf = KFs; vv = Vs; }
        else { b = (m0 - MT) / PAST; key0 = LS + (m0 - MT) % PAST; lk = LKS; kf = KFs; vv = Vs; }
        const int h = u.pn;
        int rloc = wr * 64 + fr, c8 = wc * 32 + 8 * fq; asm volatile("" : "+v"(rloc), "+v"(c8));
#pragma unroll
        for (int ai = 0; ai < 2; ++ai)
#pragma unroll
            for (int m = 0; m < 4; ++m) { const int key = key0 + rloc + ai * HALF + m * 16; const size_t kr = (size_t)(b * NH + h) * lk + key;
                *(u32x4*)(kf + kr * DQK + c8) = pack8(acc[ai][0][m][0], acc[ai][0][m][1]);
                *(u32x4*)(vv + kr * DVH + c8) = pack8(acc[ai][1][m][0], acc[ai][1][m][1]); }
    }
};
template <int MF = 4, bool FROM_T = false> struct EpiRes {
    static constexpr bool PERM = false, AFTER_DRAIN = false;
    const float* xp; const float* xs; const float* gate;
    bf16* T; const float* stats; const float* lng; const float* lnb;
    template <bool SL> __device__ __forceinline__ void run(const f32x4 (&acc)[2][2][4][2], const Unit& u, int wr, int wc, int fr, int fq, const float* slab) const {
        const int m0 = u.pm * (64 * MF), row0 = m0 + wr * (16 * MF) + fr, col0 = u.pn * BM + wc * 32 + 4 * fq;
#pragma unroll
        for (int bj = 0; bj < 2; ++bj)
#pragma unroll
            for (int n = 0; n < 2; ++n) { const int col = col0 + bj * HALF + n * 16;
                f32x4 g4, b4; if constexpr (FROM_T) { g4 = *(const f32x4*)(lng + col); b4 = *(const f32x4*)(lnb + col); }
#pragma unroll
                for (int ai = 0; ai < 2; ++ai)
#pragma unroll
                    for (int m = 0; m < MF; ++m) { const int row = row0 + ai * (32 * MF) + m * 16;
                        const f32x4 gg = *(const f32x4*)(gate + (size_t)req_of_row(row) * 6144 + col);
                        f32x4 xv;
                        if constexpr (FROM_T) { const v2u w = *(const v2u*)(T + (size_t)row * DM + col); const float mean = stats[2 * row], rstd = stats[2 * row + 1];
                            const f32x4 t = {bf2f((unsigned short)(w.x & 0xffffu)), bf2f((unsigned short)(w.x >> 16)), bf2f((unsigned short)(w.y & 0xffffu)), bf2f((unsigned short)(w.y >> 16))};
                            xv = (t - mean) * rstd * g4 + b4; }
                        else { const float* xr = (row < NP) ? xp + (size_t)row * DM : xs + (size_t)(row - NP) * DM; xv = *(const f32x4*)(xr + col); }
                        f32x4 a = acc[ai][bj][m][n]; SLAB_ADD(a, ai, bj, m, n);
                        const f32x4 t2 = xv * ALPHA + gg * a; v2u o; o.x = cvt_pk_bf16(t2[0], t2[1]); o.y = cvt_pk_bf16(t2[2], t2[3]); *(v2u*)(T + (size_t)row * DM + col) = o; } }
    }
};
struct EpiUp {
    static constexpr bool PERM = true, AFTER_DRAIN = false;
    bf16* H;
    template <bool SL> __device__ __forceinline__ void run(const f32x4 (&acc)[2][2][4][2], const Unit& u, int wr, int wc, int fr, int fq, const float* slab) const {
        const int row0 = u.pm * BM + wr * 64 + fr, colt = u.pn * BM + wc * 32 + 8 * fq;
#pragma unroll
        for (int ai = 0; ai < 2; ++ai)
#pragma unroll
            for (int m = 0; m < 4; ++m) { const int row = row0 + ai * HALF + m * 16;
#pragma unroll
                for (int bj = 0; bj < 2; ++bj) { f32x4 a = acc[ai][bj][m][0], b = acc[ai][bj][m][1];
#pragma unroll
                    for (int e = 0; e < 4; ++e) { const float x = fmaxf(a[e], 0.f), y = fmaxf(b[e], 0.f); a[e] = x * x; b[e] = y * y; }
                    *(u32x4*)(H + (size_t)row * FF + colt + bj * HALF) = pack8(a, b); } }
    }
};
struct EpiDft {
    static constexpr bool PERM = true, AFTER_DRAIN = false;
    bf16* UV; int L, tokbase;
    template <bool SL> __device__ __forceinline__ void run(const f32x4 (&acc)[2][2][4][2], const Unit& u, int wr, int wc, int fr, int fq, const float* slab) const {
        int rl = wr * 64 + fr, cl = wc * 32 + 8 * fq; asm volatile("" : "+v"(rl), "+v"(cl));
        const int rho0 = u.pm * BM + rl, n0 = u.pn * BM + cl, hl = L >> 1;
#pragma unroll
        for (int ai = 0; ai < 2; ++ai)
#pragma unroll
            for (int m = 0; m < 4; ++m) { const int rho = rho0 + ai * HALF + m * 16; const int part = rho > hl ? 1 : 0; const int k = part ? rho - hl : rho;
#pragma unroll
                for (int bj = 0; bj < 2; ++bj) { const int n = n0 + bj * HALF, b = n >> 10, c = n & 1023;
                    f32x4 a0 = acc[ai][bj][m][0], a1 = acc[ai][bj][m][1]; SLAB_ADD(a0, ai, bj, m, 0); SLAB_ADD(a1, ai, bj, m, 1);
                    bf16* r1 = UV + (size_t)(tokbase + b * L + k) * 2048 + part * 1024 + c;
                    *(u32x4*)r1 = pack8(a0, a1);
                    if (k != 0 && k != hl) { bf16* r2 = UV + (size_t)(tokbase + b * L + (L - k)) * 2048 + part * 1024 + c;
                        *(u32x4*)r2 = part ? pack8(-a0, -a1) : pack8(a0, a1); }
                    else if (part == 0) { unsigned zz = 0u; asm volatile("" : "+v"(zz)); *(u32x4*)(r1 + 1024) = (u32x4){zz, zz, zz, zz}; } } }
    }
};

namespace att {
using bf16x8 = __attribute__((ext_vector_type(8))) short;
using s16x4  = __attribute__((ext_vector_type(4))) short;
using f32x16 = __attribute__((ext_vector_type(16))) float;
constexpr int DK = 192, DV = 128, NW = 8, QBLK = 32, KVBLK = 64;
constexpr float SCALE = 0.07216878364870322f;
constexpr float THR = 8.f;
constexpr int SHM_V = KVBLK * DV * 2, SHM_K = KVBLK * DK * 2, SHM_QR = 2 * SHM_V + 2 * SHM_K + NW * 64 * 4, NQR = 4  , SHM_ATTN = SHM_QR + NW * (12 - NQR) * 1024;
#define KSWZ(row, colB) ((row) * 384 + ((colB) ^ (((row) & 7) << 4)))
#define SBAR() __builtin_amdgcn_sched_barrier(0)
__device__ __forceinline__ int crow(int r, int hi) { return (r & 3) + 8 * (r >> 2) + 4 * hi; }
__device__ __forceinline__ unsigned cvtpk(float lo, float hi) { unsigned r; asm volatile("v_cvt_pk_bf16_f32 %0, %1, %2" : "=v"(r) : "v"(lo), "v"(hi)); return r; }
__device__ __forceinline__ void partialSM(f32x16& p0, f32x16& p1, float& m_reg, float& mn, float& alpha) {
  constexpr float C = SCALE * 1.4426950408889634f;
  float pmax = p0[0];
#pragma unroll
  for (int r = 1; r < 16; ++r) pmax = fmaxf(pmax, p0[r]);
#pragma unroll
  for (int r = 0; r < 16; ++r) pmax = fmaxf(pmax, p1[r]);
  { auto rr = __builtin_amdgcn_permlane32_swap(__float_as_uint(pmax), __float_as_uint(pmax), false, false);
    pmax = fmaxf(__uint_as_float(rr[0]), __uint_as_float(rr[1])); }
  if (__builtin_expect(__all(pmax - m_reg <= THR / SCALE), 1)) { mn = m_reg; alpha = 1.f; }
  else { mn = fmaxf(m_reg, pmax); alpha = __builtin_amdgcn_exp2f((m_reg - mn) * C); m_reg = mn; }
  float mnC = -mn * C;
#pragma unroll
  for (int r = 0; r < 16; ++r) p0[r] = fmaf(p0[r], C, mnC);
#pragma unroll
  for (int r = 0; r < 16; ++r) p1[r] = fmaf(p1[r], C, mnC);
#pragma unroll
  for (int r = 0; r < 16; ++r) p0[r] = __builtin_amdgcn_exp2f(p0[r]);
}
__device__ __forceinline__ void finishSM(f32x16& p0, f32x16& p1, float alpha, float& l_reg, bf16x8& pa0, bf16x8& pa1, bf16x8& pa2, bf16x8& pa3) {
#pragma unroll
  for (int r = 0; r < 16; ++r) p1[r] = __builtin_amdgcn_exp2f(p1[r]);
  float ps = 0;
#pragma unroll
  for (int r = 0; r < 16; ++r) ps += p0[r];
#pragma unroll
  for (int r = 0; r < 16; ++r) ps += p1[r];
  { auto rr = __builtin_amdgcn_permlane32_swap(__float_as_uint(ps), __float_as_uint(ps), false, false);
    ps = __uint_as_float(rr[0]) + __uint_as_float(rr[1]); }
  l_reg = l_reg * alpha + ps;
#define PK4(P, BASE, OUT) do { unsigned a0 = cvtpk(P[BASE + 0], P[BASE + 1]), a1 = cvtpk(P[BASE + 2], P[BASE + 3]);   \
    unsigned b0 = cvtpk(P[BASE + 4], P[BASE + 5]), b1 = cvtpk(P[BASE + 6], P[BASE + 7]);                              \
    auto r0 = __builtin_amdgcn_permlane32_swap(a0, b0, false, false); auto r1 = __builtin_amdgcn_permlane32_swap(a1, b1, false, false); \
    u32x4 w = {r0[0], r1[0], r0[1], r1[1]}; OUT = __builtin_bit_cast(bf16x8, w); } while (0)
  PK4(p0, 0, pa0); PK4(p0, 8, pa1); PK4(p1, 0, pa2); PK4(p1, 8, pa3);
#undef PK4
}
__device__ __forceinline__ void qkt(f32x16& p0, f32x16& p1, const LAS char* Ks, const bf16x8* qr, const LAS char* qrl, int r32, int hi) {
  p0 = f32x16{}; p1 = f32x16{};
#pragma unroll
  for (int d0 = 0; d0 < 12; ++d0) { const int cb = (d0 * 16 + hi * 8) * 2;
    bf16x8 b0 = *reinterpret_cast<const LAS bf16x8*>(Ks + KSWZ(r32, cb));
    bf16x8 b1 = *reinterpret_cast<const LAS bf16x8*>(Ks + KSWZ(32 + r32, cb));
    const bf16x8 qf = d0 < NQR ? qr[d0 < NQR ? d0 : 0] : *reinterpret_cast<const LAS bf16x8*>(qrl + (d0 - NQR) * 1024);
    p0 = __builtin_amdgcn_mfma_f32_32x32x16_bf16(b0, qf, p0, 0, 0, 0);
    p1 = __builtin_amdgcn_mfma_f32_32x32x16_bf16(b1, qf, p1, 0, 0, 0); }
}
__device__ __forceinline__ int v_st(int k, int c) { const int kk = (k & ~0xC) | ((k & 4) << 1) | ((k & 8) >> 1); return ((kk >> 3) * 4 + (c >> 5)) * 512 + ((kk & 7) * 32 + (c & 31)) * 2; }
__device__ __forceinline__ int v_rd_base(int lane) { return ((lane & 3) << 3) | (((lane >> 2) & 3) << 6) | (((lane >> 4) & 1) << 5) | (((lane >> 5) & 1) << 8); }
constexpr int v_rd_off(int d0, int ks, int half) { return d0 * 512 + ks * 4096 + half * 2048; }
template <int OFF> __device__ __forceinline__ s16x4 tr_read(int vb) {
  s16x4 r; asm volatile("ds_read_b64_tr_b16 %0, %1 offset:%2" : "=&v"(r) : "v"(vb), "i"(OFF) : "memory"); return r;
}
template <int D0> __device__ __forceinline__ void pv_one(f32x16& od, int vb, bf16x8 pa0, bf16x8 pa1, bf16x8 pa2, bf16x8 pa3) {
  const s16x4 l0 = tr_read<v_rd_off(D0, 0, 0)>(vb), h0 = tr_read<v_rd_off(D0, 0, 1)>(vb), l1 = tr_read<v_rd_off(D0, 1, 0)>(vb), h1 = tr_read<v_rd_off(D0, 1, 1)>(vb);
  const s16x4 l2 = tr_read<v_rd_off(D0, 2, 0)>(vb), h2 = tr_read<v_rd_off(D0, 2, 1)>(vb), l3 = tr_read<v_rd_off(D0, 3, 0)>(vb), h3 = tr_read<v_rd_off(D0, 3, 1)>(vb);
  asm volatile("s_waitcnt lgkmcnt(0)" ::: "memory"); SBAR();
#define PK(L, H) (bf16x8){L[0], L[1], L[2], L[3], H[0], H[1], H[2], H[3]}
  od = __builtin_amdgcn_mfma_f32_32x32x16_bf16(pa0, PK(l0, h0), od, 0, 0, 0);
  od = __builtin_amdgcn_mfma_f32_32x32x16_bf16(pa1, PK(l1, h1), od, 0, 0, 0);
  od = __builtin_amdgcn_mfma_f32_32x32x16_bf16(pa2, PK(l2, h2), od, 0, 0, 0);
  od = __builtin_amdgcn_mfma_f32_32x32x16_bf16(pa3, PK(l3, h3), od, 0, 0, 0);
#undef PK
}
__device__ __forceinline__ void pv_d0(f32x16* o, int vb, bf16x8 pa0, bf16x8 pa1, bf16x8 pa2, bf16x8 pa3) {
  pv_one<0>(o[0], vb, pa0, pa1, pa2, pa3); pv_one<1>(o[1], vb, pa0, pa1, pa2, pa3); pv_one<2>(o[2], vb, pa0, pa1, pa2, pa3); pv_one<3>(o[3], vb, pa0, pa1, pa2, pa3);
}
constexpr int LDQ = 768, LDK = DK, LDV = DV, LDO = 1024;
__device__ __forceinline__ void attn_dense_body(const bf16* __restrict__ Qb, const bf16* __restrict__ Kh, const bf16* __restrict__ Vh, bf16* __restrict__ Ob, int seq, int pos0, LAS char* lds, const int tid, float* part, unsigned* cnt, volatile LAS unsigned* misc) {
  const int wid = tid >> 6, lane = tid & 63, r32 = lane & 31, hi = lane >> 5;
  LAS char* V_lds = lds; LAS char* K_lds = lds + 2 * SHM_V;
  LAS float* ws = (LAS float*)(lds + 2 * SHM_V + 2 * SHM_K) + wid * 64; LAS float* li_l = ws; LAS float* al_l = ws + 32;
  float m_reg = -1e30f, l_reg = 0; f32x16 o[4] = {}; bf16x8 qr[NQR];
  const LAS char* qrl = lds + SHM_QR + wid * (12 - NQR) * 1024 + lane * 16;
  const bf16* Qw = Qb + (long)(wid * QBLK + r32) * LDQ + hi * 8;
#pragma unroll
  for (int d0 = 0; d0 < NQR; ++d0) qr[d0] = *reinterpret_cast<const bf16x8*>(Qw + d0 * 16);
  LAS char* qw = lds + SHM_QR + wid * (12 - NQR) * 1024 + lane * 16;
#pragma unroll
  for (int d0 = NQR; d0 < 8; ++d0) *(LAS bf16x8*)(qw + (d0 - NQR) * 1024) = *reinterpret_cast<const bf16x8*>(Qw + d0 * 16);
  {
    bf16x8 f0 = *reinterpret_cast<const bf16x8*>(Qw + 128), f1 = *reinterpret_cast<const bf16x8*>(Qw + 144), f2 = *reinterpret_cast<const bf16x8*>(Qw + 160), f3 = *reinterpret_cast<const bf16x8*>(Qw + 176);
    if (pos0 >= 0) { const int pos = pos0 + wid * QBLK + r32; const float pr = (float)(pos >> 6), pc = (float)(pos & 63);
#pragma unroll
      for (int i = 0; i < 8; ++i) { const float inv = __builtin_amdgcn_exp2f(-(float)(8 * hi + i) * (13.287712379549449f / 16.0f));
        { const float rev = pr * inv * INV_2PI, cs = fcos_rev(rev), sn = fsin_rev(rev); const float a = bf2f((unsigned short)f0[i]), b = bf2f((unsigned short)f1[i]);
          f0[i] = (short)f2bf(a * cs - b * sn); f1[i] = (short)f2bf(b * cs + a * sn); }
        { const float rev = pc * inv * INV_2PI, cs = fcos_rev(rev), sn = fsin_rev(rev); const float a = bf2f((unsigned short)f2[i]), b = bf2f((unsigned short)f3[i]);
          f2[i] = (short)f2bf(a * cs - b * sn); f3[i] = (short)f2bf(b * cs + a * sn); } } }
    *(LAS bf16x8*)(qw + (8 - NQR) * 1024) = f0; *(LAS bf16x8*)(qw + (9 - NQR) * 1024) = f1; *(LAS bf16x8*)(qw + (10 - NQR) * 1024) = f2; *(LAS bf16x8*)(qw + (11 - NQR) * 1024) = f3;
  }
  const int sr = tid >> 4, sc = (tid & 15) * 8, vst0 = v_st(sr, sc), vst1 = v_st(32 + sr, sc);
  const int kr = tid >> 3, kc = tid & 7, kgo = kr * LDK + kc * 8, kst = KSWZ(kr, kc * 16);
  const int vb0 = (int)(unsigned)(uintptr_t)V_lds + v_rd_base(lane);
  bf16x8 vs0, vs1, ks0, ks1, ks2;
#define SLOAD(k0) do { vs0 = *reinterpret_cast<const bf16x8*>(&Vh[(long)((k0) + sr) * LDV + sc]); vs1 = *reinterpret_cast<const bf16x8*>(&Vh[(long)((k0) + 32 + sr) * LDV + sc]); \
    ks0 = *reinterpret_cast<const bf16x8*>(&Kh[(long)(k0) * LDK + kgo]); ks1 = *reinterpret_cast<const bf16x8*>(&Kh[(long)(k0) * LDK + kgo + 64]); \
    ks2 = *reinterpret_cast<const bf16x8*>(&Kh[(long)(k0) * LDK + kgo + 128]); } while (0)
#define SWRITE(b) do { *(LAS bf16x8*)(V_lds + (b) * SHM_V + vst0) = vs0; *(LAS bf16x8*)(V_lds + (b) * SHM_V + vst1) = vs1; \
    *(LAS bf16x8*)(K_lds + (b) * SHM_K + kst) = ks0; *(LAS bf16x8*)(K_lds + (b) * SHM_K + kst + 128) = ks1; *(LAS bf16x8*)(K_lds + (b) * SHM_K + kst + 256) = ks2; } while (0)
#define SWAIT() asm volatile("s_waitcnt vmcnt(0)" ::: "memory")
#define RESC(a) do { if (__any((a) < 1.f)) { if (hi == 0) al_l[r32] = (a); asm volatile("s_waitcnt lgkmcnt(0)" ::: "memory"); \
    _Pragma("unroll") for (int d = 0; d < 4; ++d) _Pragma("unroll") for (int r = 0; r < 16; ++r) o[d][r] *= al_l[crow(r, hi)]; } } while (0)
  f32x16 pA0, pA1, pB0, pB1; float mnA, mnB, alA, alB; bf16x8 pa0, pa1, pa2, pa3; const int NT = seq / KVBLK;
  SLOAD(0); SWAIT(); SWRITE(0); __syncthreads();
  qkt(pA0, pA1, K_lds, qr, qrl, r32, hi); partialSM(pA0, pA1, m_reg, mnA, alA);
  SLOAD(KVBLK);
  SWAIT(); SWRITE(1); __syncthreads();
  for (int j = 1; j + 1 < NT; j += 2) {
    SBAR(); qkt(pB0, pB1, K_lds + SHM_K, qr, qrl, r32, hi);
    finishSM(pA0, pA1, alA, l_reg, pa0, pa1, pa2, pa3); SBAR();
    SLOAD((j + 1) * KVBLK); SBAR();
    pv_d0(o, vb0, pa0, pa1, pa2, pa3); partialSM(pB0, pB1, m_reg, mnB, alB);
    __syncthreads(); SWAIT(); SWRITE(0);
    RESC(alB); __syncthreads();
    SBAR(); qkt(pA0, pA1, K_lds, qr, qrl, r32, hi);
    finishSM(pB0, pB1, alB, l_reg, pa0, pa1, pa2, pa3); SBAR();
    SLOAD((j + 2) * KVBLK); SBAR();
    pv_d0(o, vb0 + SHM_V, pa0, pa1, pa2, pa3); partialSM(pA0, pA1, m_reg, mnA, alA);
    __syncthreads(); SWAIT(); SWRITE(1);
    RESC(alA); __syncthreads();
  }
  SBAR(); qkt(pB0, pB1, K_lds + SHM_K, qr, qrl, r32, hi);
  finishSM(pA0, pA1, alA, l_reg, pa0, pa1, pa2, pa3); SBAR();
  pv_d0(o, vb0, pa0, pa1, pa2, pa3); partialSM(pB0, pB1, m_reg, mnB, alB);
  __syncthreads(); RESC(alB);
  finishSM(pB0, pB1, alB, l_reg, pa0, pa1, pa2, pa3); SBAR();
  pv_d0(o, vb0 + SHM_V, pa0, pa1, pa2, pa3);
  bf16* Ow = Ob + (long)(wid * QBLK) * LDO;
  bool write_out = true; float g1 = 1.f;
  if (part) {
    if (tid == 0) misc[1] = __hip_atomic_fetch_add(cnt, 1u, __ATOMIC_RELAXED, __HIP_MEMORY_SCOPE_AGENT);
    __syncthreads();
    const unsigned ticket = misc[1];
    float* po = part + (size_t)wid * (4 * 16 * 64) + lane * 4; float* pml = part + 8 * 4 * 16 * 64 + wid * 128 + lane;
    if (ticket == 0u) {
#pragma unroll
      for (int d0 = 0; d0 < 4; ++d0)
#pragma unroll
        for (int r4 = 0; r4 < 4; ++r4) { const f32x4 v = {o[d0][4 * r4], o[d0][4 * r4 + 1], o[d0][4 * r4 + 2], o[d0][4 * r4 + 3]}; const float* p = po + (d0 * 4 + r4) * 256;
          asm volatile("global_store_dwordx4 %0, %1, off sc1\n\ts_nop 1" :: "v"(p), "v"(v) : "memory"); }
      __hip_atomic_store((unsigned*)pml, __float_as_uint(m_reg), __ATOMIC_RELAXED, __HIP_MEMORY_SCOPE_AGENT); __hip_atomic_store((unsigned*)pml + 64, __float_as_uint(l_reg), __ATOMIC_RELAXED, __HIP_MEMORY_SCOPE_AGENT);
      asm volatile("s_waitcnt vmcnt(0)" ::: "memory"); __syncthreads();
      if (tid == 0) __hip_atomic_store(cnt + 1, 1u, __ATOMIC_RELAXED, __HIP_MEMORY_SCOPE_AGENT);
      write_out = false;
    } else {
      if (tid == 0) { unsigned sp = 0; while (__hip_atomic_load(cnt + 1, __ATOMIC_RELAXED, __HIP_MEMORY_SCOPE_AGENT) == 0u) { __builtin_amdgcn_s_sleep(2); if (++sp > (1u << 22)) break; }
        __builtin_amdgcn_fence(__ATOMIC_ACQUIRE, "agent"); asm volatile("s_waitcnt vmcnt(0)" ::: "memory"); }
      __syncthreads();
      constexpr float C = SCALE * 1.4426950408889634f;
      const float m2 = pml[0], l2 = pml[64]; const float mn = fmaxf(m_reg, m2);
      const float f1 = __builtin_amdgcn_exp2f((m_reg - mn) * C), f2 = __builtin_amdgcn_exp2f((m2 - mn) * C); const float il = __builtin_amdgcn_rcpf(l_reg * f1 + l2 * f2);
      if (hi == 0) { li_l[r32] = f1 * il; al_l[r32] = f2 * il; } asm volatile("s_waitcnt lgkmcnt(0)" ::: "memory");
#pragma unroll
      for (int r4 = 0; r4 < 4; ++r4)
#pragma unroll
        for (int d0 = 0; d0 < 4; ++d0) { const f32x4 pv = *(const f32x4*)(po + (d0 * 4 + r4) * 256);
#pragma unroll
          for (int e = 0; e < 4; ++e) { const int r = 4 * r4 + e; o[d0][r] = o[d0][r] * li_l[crow(r, hi)] + pv[e] * al_l[crow(r, hi)]; } }
      g1 = 0.f;
    }
  }
  if (write_out) {
    if (g1 != 0.f) {
      if (hi == 0) li_l[r32] = l_reg; asm volatile("s_waitcnt lgkmcnt(0)" ::: "memory");
#pragma unroll
      for (int r = 0; r < 16; ++r) { const float rl = __builtin_amdgcn_rcpf(li_l[crow(r, hi)]);
#pragma unroll
        for (int d0 = 0; d0 < 4; ++d0) o[d0][r] *= rl; }
    }
#pragma unroll
    for (int r = 0; r < 16; ++r) { const int orow = crow(r, hi);
#pragma unroll
      for (int d0 = 0; d0 < 4; ++d0) Ow[(long)orow * LDO + d0 * 32 + r32] = (bf16)f2bf(o[d0][r]); }
  }
  __syncthreads();
#undef SLOAD
#undef SWRITE
#undef SWAIT
#undef RESC
}
#undef KSWZ
#undef SBAR
}
__device__ __forceinline__ void transpose_item(const float* W, int K, int N, bf16* WT, int ldk, LAS float* scr, int item, int lane) {
    const int nblk = N / 32, kb = item / nblk, nb = item % nblk, k0 = 64 * kb, n0 = 32 * nb;
#pragma unroll
    for (int i = 0; i < 32; ++i) { const int kk = 2 * i + (lane >> 5); scr[kk * 33 + (lane & 31)] = W[(size_t)(k0 + kk) * N + n0 + (lane & 31)]; }
    LDS_WAIT(); asm volatile("" ::: "memory");
    const int c = lane & 7;
#pragma unroll
    for (int j = 0; j < 4; ++j) { const int n = (lane >> 3) + 8 * j; const LAS float* s = scr + (8 * c) * 33 + n;
        v4u o; o.x = pk2(s[0 * 33], s[1 * 33]); o.y = pk2(s[2 * 33], s[3 * 33]); o.z = pk2(s[4 * 33], s[5 * 33]); o.w = pk2(s[6 * 33], s[7 * 33]);
        *(v4u*)(WT + (size_t)(n0 + n) * ldk + k0 + 8 * c) = o; }
    LDS_WAIT(); asm volatile("" ::: "memory");
}
constexpr int WI_L0 = 992 + 96 + 64 + 512 + 2 * 2048 + 512, WI_ALL = WI_L0 + 2 * 2048;
__device__ __forceinline__ void weight_item(const Args& args, unsigned char* ws, LAS float* scr, int idx, int lane) {
    constexpr int I0 = 992, I1 = 96, I2 = 64, I3 = 512, I4 = 2048;
    int r = idx, K, N, ldk; size_t off; const float* W;
    if (r < I0) { W = args.in[I_WIN]; K = 1024; N = 1984; ldk = 1024; off = WS_WIN_T; }
    else if ((r -= I0) < I1) { W = args.in[I_QUP]; K = 256; N = 768; ldk = 256; off = WS_QUP_T; }
    else if ((r -= I1) < I2) { W = args.in[I_KVUP]; K = 128; N = 1024; ldk = 256; off = WS_KVUP_T; }
    else if ((r -= I2) < I3) { W = args.in[I_WOUT0]; K = 1024; N = 1024; ldk = 1024; off = WS_WOUT0_T; }
    else if ((r -= I3) < I4) { W = args.in[I_W1_0]; K = 1024; N = 4096; ldk = 1024; off = WS_W1_0; }
    else if ((r -= I4) < I4) { W = args.in[I_W2_0]; K = 4096; N = 1024; ldk = 4096; off = WS_W2_0; }
    else if ((r -= I4) < I3) { W = args.in[I_WOUT1]; K = 1024; N = 1024; ldk = 1024; off = WS_W1T; }
    else if ((r -= I3) < I4) { W = args.in[I_W1_1]; K = 1024; N = 4096; ldk = 1024; off = WS_W1_1; }
    else { r -= I4; W = args.in[I_W2_1]; K = 4096; N = 1024; ldk = 4096; off = WS_W2_1; }
    transpose_item(W, K, N, (bf16*)(ws + off), ldk, scr, r, lane);
}
__device__ __forceinline__ void row_stats(const f32x4 (&v)[4], float& mean, float& rstd) {
    float s = 0.f;
#pragma unroll
    for (int j = 0; j < 4; ++j) s += (v[j][0] + v[j][1]) + (v[j][2] + v[j][3]);
    mean = wave_sum(s) * (1.f / DM); float q = 0.f;
#pragma unroll
    for (int j = 0; j < 4; ++j) { const f32x4 d = v[j] - mean; q += (d[0] * d[0] + d[1] * d[1]) + (d[2] * d[2] + d[3] * d[3]); }
    rstd = __builtin_amdgcn_rsqf(wave_sum(q) * (1.f / DM) + LN_EPS);
}
__device__ __forceinline__ void load_row(const bf16* p, int lane, f32x4 (&v)[4]) {
#pragma unroll
    for (int j = 0; j < 4; ++j) { const v2u w = ((const v2u*)p)[lane + 64 * j]; v[j] = (f32x4){bf2f((unsigned short)(w.x & 0xffffu)), bf2f((unsigned short)(w.x >> 16)), bf2f((unsigned short)(w.y & 0xffffu)), bf2f((unsigned short)(w.y >> 16))}; }
}
__device__ __forceinline__ void load_row(const float* p, int lane, f32x4 (&v)[4]) {
#pragma unroll
    for (int j = 0; j < 4; ++j) v[j] = ((const f32x4*)p)[lane + 64 * j];
}
__device__ __forceinline__ void adaln_store(const f32x4 (&v)[4], const float* shift, const float* scale, bf16* hrow, int lane) {
    float mean, rstd; row_stats(v, mean, rstd);
#pragma unroll
    for (int j = 0; j < 4; ++j) { const int c = 4 * lane + 256 * j; const f32x4 sc = *(const f32x4*)(scale + c), sh = *(const f32x4*)(shift + c);
        const f32x4 h = (v[j] - mean) * rstd * (sc + 1.0f) + sh;
        v2u w; w.x = pk2(h[0], h[1]); w.y = pk2(h[2], h[3]); *(v2u*)(hrow + c) = w; }
}
__device__ __forceinline__ void ln_affine(f32x4 (&v)[4], const float* g, const float* b, int lane, float* st = nullptr) {
    float mean, rstd; row_stats(v, mean, rstd);
    if (st && lane == 0) { st[0] = mean; st[1] = rstd; }
#pragma unroll
    for (int j = 0; j < 4; ++j) { const int c = 4 * lane + 256 * j; v[j] = (v[j] - mean) * rstd * *(const f32x4*)(g + c) + *(const f32x4*)(b + c); }
}
__device__ __forceinline__ void store_row(float* p, int lane, const f32x4 (&v)[4]) {
#pragma unroll
    for (int j = 0; j < 4; ++j) ((f32x4*)p)[lane + 64 * j] = v[j];
}

namespace hconv {
using bf16x8 = __attribute__((ext_vector_type(8))) short;
using f32x16 = __attribute__((ext_vector_type(16))) float;
constexpr int UB = 8256;
constexpr int SLOT = 16384 + 2 * UB;
__device__ __forceinline__ int crow(int r, int hi) { return (r & 3) + 8 * (r >> 2) + 4 * hi; }
__device__ __forceinline__ void item(const bf16* __restrict__ GRB, const bf16* __restrict__ UT, const float* __restrict__ FP, const float* __restrict__ skipv, const bf16* __restrict__ X0, bf16* __restrict__ YM,
                                     int ch0, LAS unsigned char* lds, const int tid, const int lane, const int wave) {
    for (int q = tid; q < 4 * 1024; q += 512) { const int ch = q >> 10, i = q & 1023; const v4u v = ((const v4u*)(GRB + (size_t)(ch0 + ch) * 8192))[i]; *(LAS v4u*)(lds + ch * SLOT + 16 * i) = v; }
    for (int q = tid; q < 4 * 1024; q += 512) { const int ch = q >> 10, b = (q >> 9) & 1, i = q & 511; const v4u v = ((const v4u*)(UT + ((size_t)b * HY + ch0 + ch) * LS))[i];
        *(LAS v4u*)(lds + ch * SLOT + 16384 + b * UB + 32 + 16 * i) = v; }
    if (tid < 32) { const int ch = tid >> 3, b = (tid >> 2) & 1, j = tid & 3; const v4u z = {0u, 0u, 0u, 0u};
        *(LAS v4u*)(lds + ch * SLOT + 16384 + b * UB + (j < 2 ? 16 * j : 32 + 8192 + 16 * (j - 2))) = z; }
    __syncthreads();
    v2u x0v[16];
    {
        const int slot = wave & 3, khalf = wave >> 2;
        const LAS unsigned char* gr = lds + slot * SLOT; const LAS unsigned char* ubuf = gr + 16384;
        const int r = lane & 31, h = lane >> 5, c = r & 15, b = r >> 4, c0 = c & 1, c1 = c >> 1;
        const LAS unsigned char* ap = gr + 992 + 16 * h - 32 * r + khalf * (129 * 32);
        const LAS unsigned char* bp = ubuf + b * UB + 16 * h + 4 * c1 + khalf * (129 * 32);
        const unsigned sh = 16u * (unsigned)c0;
        const int ch = ch0 + slot;
        const float nsum = wave_sum(FP[ch * 64 + lane] + FP[(HY + ch) * 64 + lane]); const float inv_norm = 1.f / nsum; const float skn = skipv[ch] * nsum;
        const LAS bf16* ul = (const LAS bf16*)(ubuf + b * UB + 32);
        f32x16 acc[8];
#pragma unroll
        for (int Q = 0; Q < 8; ++Q)
#pragma unroll
            for (int g = 0; g < 16; ++g) acc[Q][g] = khalf ? 0.f : skn * bf2f(ul[16 * (32 * Q + crow(g, h)) + c]);
        int nks = khalf ? 128 : 129; asm volatile("" : "+s"(nks));
        unsigned aa = (unsigned)(uintptr_t)ap, ba = (unsigned)(uintptr_t)bp;
        bf16x8 fa0, fa1, fa2, fa3, fa4, fa5, fa6, fa7, fb0, fb1, fb2, fb3, fb4, fb5, fb6, fb7; v2u da01, da23, db01, db23; unsigned da4, db4;
#define HC_LD(F0, F1, F2, F3, F4, F5, F6, F7, D01, D23, D4) do { \
            asm volatile("ds_read_b128 %0, %1 offset:7168" : "=v"(F0) : "v"(aa)); asm volatile("ds_read_b128 %0, %1 offset:6144" : "=v"(F1) : "v"(aa)); \
            asm volatile("ds_read2_b32 %0, %1 offset1:1" : "=v"(D01) : "v"(ba)); asm volatile("ds_read2_b32 %0, %1 offset0:2 offset1:3" : "=v"(D23) : "v"(ba)); asm volatile("ds_read_b32 %0, %1 offset:16" : "=v"(D4) : "v"(ba)); \
            asm volatile("ds_read_b128 %0, %1 offset:5120" : "=v"(F2) : "v"(aa)); asm volatile("ds_read_b128 %0, %1 offset:4096" : "=v"(F3) : "v"(aa)); \
            asm volatile("ds_read_b128 %0, %1 offset:3072" : "=v"(F4) : "v"(aa)); asm volatile("ds_read_b128 %0, %1 offset:2048" : "=v"(F5) : "v"(aa)); \
            asm volatile("ds_read_b128 %0, %1 offset:1024" : "=v"(F6) : "v"(aa)); asm volatile("ds_read_b128 %0, %1" : "=v"(F7) : "v"(aa)); __builtin_amdgcn_sched_barrier(0); } while (0)
#define HC_WAIT(F0, F1, F2, F3, F4, F5, F6, F7, D01, D23, D4) do { __builtin_amdgcn_sched_barrier(0); asm volatile("s_waitcnt lgkmcnt(0)" : "+v"(F0), "+v"(F1), "+v"(F2), "+v"(F3), "+v"(F4), "+v"(F5), "+v"(F6), "+v"(F7), "+v"(D01), "+v"(D23), "+v"(D4)); \
            __builtin_amdgcn_sched_barrier(0); } while (0)
#define HC_MMA(F0, F1, F2, F3, F4, F5, F6, F7, D01, D23, D4) do { u32x4 bw; bw.x = __builtin_amdgcn_alignbit(D01.y, D01.x, sh); bw.y = __builtin_amdgcn_alignbit(D23.x, D01.y, sh); bw.z = __builtin_amdgcn_alignbit(D23.y, D23.x, sh); \
            bw.w = __builtin_amdgcn_alignbit(D4, D23.y, sh); const bf16x8 bf = __builtin_bit_cast(bf16x8, bw); \
            acc[0] = __builtin_amdgcn_mfma_f32_32x32x16_bf16(F0, bf, acc[0], 0, 0, 0); acc[1] = __builtin_amdgcn_mfma_f32_32x32x16_bf16(F1, bf, acc[1], 0, 0, 0); \
            acc[2] = __builtin_amdgcn_mfma_f32_32x32x16_bf16(F2, bf, acc[2], 0, 0, 0); acc[3] = __builtin_amdgcn_mfma_f32_32x32x16_bf16(F3, bf, acc[3], 0, 0, 0); \
            acc[4] = __builtin_amdgcn_mfma_f32_32x32x16_bf16(F4, bf, acc[4], 0, 0, 0); acc[5] = __builtin_amdgcn_mfma_f32_32x32x16_bf16(F5, bf, acc[5], 0, 0, 0); \
            acc[6] = __builtin_amdgcn_mfma_f32_32x32x16_bf16(F6, bf, acc[6], 0, 0, 0); acc[7] = __builtin_amdgcn_mfma_f32_32x32x16_bf16(F7, bf, acc[7], 0, 0, 0); } while (0)
        HC_LD(fa0, fa1, fa2, fa3, fa4, fa5, fa6, fa7, da01, da23, da4);
        int npair = nks >> 1;
        for (int kp = 0; kp < npair; ++kp) {
            HC_WAIT(fa0, fa1, fa2, fa3, fa4, fa5, fa6, fa7, da01, da23, da4);
            aa += 32; ba += 32; HC_LD(fb0, fb1, fb2, fb3, fb4, fb5, fb6, fb7, db01, db23, db4);
            HC_MMA(fa0, fa1, fa2, fa3, fa4, fa5, fa6, fa7, da01, da23, da4);
            HC_WAIT(fb0, fb1, fb2, fb3, fb4, fb5, fb6, fb7, db01, db23, db4);
            aa += 32; ba += 32; HC_LD(fa0, fa1, fa2, fa3, fa4, fa5, fa6, fa7, da01, da23, da4);
            HC_MMA(fb0, fb1, fb2, fb3, fb4, fb5, fb6, fb7, db01, db23, db4);
        }
        HC_WAIT(fa0, fa1, fa2, fa3, fa4, fa5, fa6, fa7, da01, da23, da4);
        if (nks & 1) HC_MMA(fa0, fa1, fa2, fa3, fa4, fa5, fa6, fa7, da01, da23, da4);
#undef HC_LD
#undef HC_WAIT
#undef HC_MMA
#pragma unroll
        for (int i = 0; i < 16; ++i) { const int q = tid + 512 * i; x0v[i] = *(const v2u*)(X0 + ((size_t)NP + q) * HY + ch0); }
        asm volatile("s_waitcnt lgkmcnt(0)" ::: "memory");
        __syncthreads();
        LAS f32x4* xch = (LAS f32x4*)(lds + slot * SLOT);
        if (khalf) {
#pragma unroll
            for (int Q = 0; Q < 8; ++Q)
#pragma unroll
                for (int g4 = 0; g4 < 4; ++g4) xch[(Q * 4 + g4) * 64 + lane] = (f32x4){acc[Q][4 * g4], acc[Q][4 * g4 + 1], acc[Q][4 * g4 + 2], acc[Q][4 * g4 + 3]};
        }
        __syncthreads();
        if (!khalf) {
#pragma unroll
            for (int Q = 0; Q < 8; ++Q)
#pragma unroll
                for (int g4 = 0; g4 < 4; ++g4) { const f32x4 o = xch[(Q * 4 + g4) * 64 + lane]; acc[Q][4 * g4] += o[0]; acc[Q][4 * g4 + 1] += o[1]; acc[Q][4 * g4 + 2] += o[2]; acc[Q][4 * g4 + 3] += o[3]; }
        }
        asm volatile("s_waitcnt lgkmcnt(0)" ::: "memory");
        __syncthreads();
        if (!khalf) {
            LAS bf16* yl = (LAS bf16*)(lds + slot * SLOT);
#pragma unroll
            for (int Q = 0; Q < 8; ++Q)
#pragma unroll
                for (int g = 0; g < 16; ++g) { const int t = 16 * (32 * Q + crow(g, h)) + c; yl[b * LS + t] = (bf16)f2bf(acc[Q][g] * inv_norm); }
        }
    }
    __syncthreads();
#pragma unroll
    for (int i = 0; i < 16; ++i) { const int q = tid + 512 * i; const size_t row = (size_t)NP + q; const v2u xv = x0v[i];
        const float y0 = bf2f(*(const LAS bf16*)(lds + 0 * SLOT + 2 * q)), y1 = bf2f(*(const LAS bf16*)(lds + 1 * SLOT + 2 * q)), y2 = bf2f(*(const LAS bf16*)(lds + 2 * SLOT + 2 * q)), y3 = bf2f(*(const LAS bf16*)(lds + 3 * SLOT + 2 * q));
        v2u o; o.x = pk2(y0 * bf2f((unsigned short)(xv.x & 0xffffu)), y1 * bf2f((unsigned short)(xv.x >> 16))); o.y = pk2(y2 * bf2f((unsigned short)(xv.y & 0xffffu)), y3 * bf2f((unsigned short)(xv.y >> 16)));
        *(v2u*)(YM + row * DM + ch0) = o; }
    __syncthreads();
}
constexpr int PUB = 576, PSLOT = 1024 + 16 * PUB;
__device__ __forceinline__ void prompt_item(const float* __restrict__ FT, const bf16* __restrict__ UT, const float* __restrict__ FP, const float* __restrict__ skipv, const bf16* __restrict__ X0, bf16* __restrict__ YM,
                                            int ch0, LAS unsigned char* lds, const int tid, const int lane, const int wave) {
    const int ch = ch0 + wave; LAS unsigned char* slot = lds + wave * PSLOT;
    {
        LAS bf16* gr = (LAS bf16*)slot;
#pragma unroll
        for (int i = 0; i < 8; ++i) { const int e = lane + 64 * i; const int d = LP - e; float v = 0.f; if (e != 0) v = d >= 0 ? FT[(size_t)ch * LP + d] : FT[(size_t)(HY + ch) * LP - d]; gr[e] = (bf16)f2bf(v); }
#pragma unroll
        for (int i = 0; i < 8; ++i) { const int q = lane + 64 * i, b = q >> 5, j = q & 31; const v4u v = ((const v4u*)(UT + ((size_t)b * HY + ch) * LP))[j]; *(LAS v4u*)(slot + 1024 + b * PUB + 32 + 16 * j) = v; }
        { const int b = lane >> 2, j = lane & 3; const v4u z = {0u, 0u, 0u, 0u}; *(LAS v4u*)(slot + 1024 + b * PUB + (j < 2 ? 16 * j : 32 + 512 + 16 * (j - 2))) = z; }
    }
    asm volatile("s_waitcnt vmcnt(0) lgkmcnt(0)" ::: "memory");
    const int r = lane & 31, h = lane >> 5, c = r & 15, bh = r >> 4, c0 = c & 1, c1 = c >> 1; const unsigned sh = 16u * (unsigned)c0;
    const float nsum = ((FP[ch * 4] + FP[ch * 4 + 1]) + (FP[ch * 4 + 2] + FP[ch * 4 + 3])) + ((FP[(HY + ch) * 4] + FP[(HY + ch) * 4 + 1]) + (FP[(HY + ch) * 4 + 2] + FP[(HY + ch) * 4 + 3]));
    const float inv_norm = 1.f / nsum, skn = skipv[ch] * nsum;
    const LAS unsigned char* ubuf = slot + 1024;
    f32x16 acc[8];
#pragma unroll
    for (int ct = 0; ct < 8; ++ct) { const LAS bf16* ul = (const LAS bf16*)(ubuf + (2 * ct + bh) * PUB + 32);
#pragma unroll
        for (int g = 0; g < 16; ++g) acc[ct][g] = g < 8 ? skn * bf2f(ul[16 * crow(g, h) + c]) : 0.f; }
    const LAS unsigned char* ap = slot + 2 * (240 - 16 * (r < 15 ? r : 15) + 8 * h);
    const LAS unsigned char* bp = ubuf + bh * PUB + 16 * h + 4 * c1;
    int nks = 17; asm volatile("" : "+s"(nks));
    for (int ks = 0; ks < nks; ++ks) {
        const bf16x8 af = *(const LAS bf16x8*)(ap + 32 * ks);
#pragma unroll
        for (int ct = 0; ct < 8; ++ct) { const LAS unsigned* bq = (const LAS unsigned*)(bp + 2 * ct * PUB + 32 * ks);
            const unsigned d0 = bq[0], d1 = bq[1], d2 = bq[2], d3 = bq[3], d4 = bq[4];
            u32x4 bw; bw.x = __builtin_amdgcn_alignbit(d1, d0, sh); bw.y = __builtin_amdgcn_alignbit(d2, d1, sh); bw.z = __builtin_amdgcn_alignbit(d3, d2, sh); bw.w = __builtin_amdgcn_alignbit(d4, d3, sh);
            acc[ct] = __builtin_amdgcn_mfma_f32_32x32x16_bf16(af, __builtin_bit_cast(bf16x8, bw), acc[ct], 0, 0, 0); }
    }
    asm volatile("s_waitcnt lgkmcnt(0)" ::: "memory");
    {
        LAS bf16* yl = (LAS bf16*)(slot + 1024);
#pragma unroll
        for (int ct = 0; ct < 8; ++ct)
#pragma unroll
            for (int g = 0; g < 8; ++g) yl[(2 * ct + bh) * LP + 16 * crow(g, h) + c] = (bf16)f2bf(acc[ct][g] * inv_norm);
    }
    __syncthreads();
#pragma unroll
    for (int i = 0; i < 8; ++i) { const int q = tid + 512 * i;
        const v4u xv = *(const v4u*)(X0 + (size_t)q * HY + ch0); unsigned xw[4] = {xv.x, xv.y, xv.z, xv.w}, ow[4];
#pragma unroll
        for (int k = 0; k < 4; ++k) { const float ya = bf2f(*(const LAS bf16*)(lds + (2 * k) * PSLOT + 1024 + 2 * q)), yb = bf2f(*(const LAS bf16*)(lds + (2 * k + 1) * PSLOT + 1024 + 2 * q));
            ow[k] = pk2(ya * bf2f((unsigned short)(xw[k] & 0xffffu)), yb * bf2f((unsigned short)(xw[k] >> 16))); }
        *(v4u*)(YM + (size_t)q * DM + ch0) = (v4u){ow[0], ow[1], ow[2], ow[3]}; }
    __syncthreads();
}
static_assert(4 * SLOT <= LDSCTL_OFF, "four channel slots fit in LDS");
}

__global__ void __launch_bounds__(512, 2) fwd_kernel(Args args) {
    extern __shared__ __attribute__((aligned(16))) unsigned char lds_raw[];
    LAS unsigned char* lds = (LAS unsigned char*)lds_raw;
    volatile LAS unsigned* MISC = (volatile LAS unsigned*)(lds + MISC_OFF);
    const int wave = __builtin_amdgcn_readfirstlane((int)threadIdx.x >> 6);
    const int G = gridDim.x; const int bx = blockIdx.x; const int vcu = (G % 8 == 0) ? (bx % 8) * (G / 8) + bx / 8 : bx;
    const int gw = vcu * 8 + wave, NGW = G * 8, NGT = G * 512;
#define FRESH() const int lane = fresh_lane(); const int tid = wave * 64 + lane; const int gt = vcu * 512 + tid; (void)gt
    unsigned char* ws = args.ws;
    gu32* ctl = (gu32*)(ws + WS_CTL);
    float* MODS = (float*)(ws + WS_MODS);
    float* X = args.out;
    float* STATS = (float*)(ws + WS_STATS);
    bf16* T = (bf16*)(ws + WS_T);
    bf16* HB = (bf16*)(ws + WS_H);
    for (int u = threadIdx.x; u < (LDS_BYTES - LDSCTL_OFF) / 4; u += 512) ((LAS unsigned*)(lds + LDSCTL_OFF))[u] = 0u;
    __syncthreads();
    XcdBarrier bar; bar.bar = (unsigned*)(ctl + CW_BAR) + args.li * XCD_BAR_WORDS; bar.x = 0; bar.st = nullptr;
    if (!MK_PER_PHASE) bar = xcd_barrier_post((unsigned*)(ctl + CW_BAR) + args.li * XCD_BAR_WORDS, MISC + 8);
    const int lo = args.ph_lo, hi = args.ph_hi;
#ifndef NO_CONV
#define NO_CONV 0
#endif
#ifndef NO_ATT
#define NO_ATT 0
#endif
#ifndef PHASE_MASK
#define PHASE_MASK 0x1FFFF
#endif
#define IN(k) ((((PHASE_MASK) >> (k)) & 1) && lo <= (k) && (k) < hi)
#define SPLIT_CNT(b) ((unsigned*)(ctl + CW_SPLIT + (args.li * 6 + (b)) * 16384))
#define SLABS(mib) ((float*)(ws + (size_t)(mib) * MiB))
#define SEAM(k) do { if (IN(k) && IN((k) + 1)) xcd_barrier(bar); } while (0)

    if (IN(0)) {
        FRESH();
        asm volatile("; ==== PHASE 0 ====");
        for (int it = bx; it < 192; it += G) {
            const int layer = it / 96, cb = it % 96, col = cb * 64 + lane;
            LAS float* sil = (LAS float*)lds; LAS float* red = (LAS float*)(lds + 12288);
            for (int i = tid; i < 3072; i += 512) { const int r = i >> 10, k = i & 1023; const float c = (r == 0) ? args.in[I_CCTX][k] : args.in[I_C][(r - 1) * DM + k]; sil[i] = c / (1.f + fexp(-c)); }
            __syncthreads();
            const float* W = args.in[layer ? I_ADA1_W : I_ADA0_W]; float a0 = 0.f, a1 = 0.f, a2 = 0.f;
#pragma unroll 8
            for (int kk = 0; kk < 128; ++kk) { const int k = wave * 128 + kk; const float w = W[(size_t)k * 6144 + col]; a0 += sil[k] * w; a1 += sil[1024 + k] * w; a2 += sil[2048 + k] * w; }
            red[(wave * 3 + 0) * 64 + lane] = a0; red[(wave * 3 + 1) * 64 + lane] = a1; red[(wave * 3 + 2) * 64 + lane] = a2;
            __syncthreads();
            if (tid < 192) { const int r = tid >> 6, l = tid & 63; float s = 0.f;
#pragma unroll
                for (int w = 0; w < 8; ++w) s += red[(w * 3 + r) * 64 + l];
                MODS[(size_t)(layer * 3 + r) * 6144 + cb * 64 + l] = s + args.in[layer ? I_ADA1_B : I_ADA0_B][cb * 64 + l]; }
            __syncthreads();
        }
        {
            LAS float* scr = (LAS float*)(lds + wave * 16384);
            for (int it = gw; it < WI_L0; it += NGW) weight_item(args, ws, scr, it, lane);
        }
        for (int i = gt; i < 2048 * 128; i += NGT) { const int kp = i >> 7, c8 = (i & 127) * 8; const int part = kp >> 10, kq = kp & 1023, g = kq >> 7, cp = kq & 127; unsigned w[4] = {0u, 0u, 0u, 0u};
            if ((c8 >> 7) == g) {
#pragma unroll
                for (int e = 0; e < 8; e += 2) { const float r0 = (float)((cp * ((c8 + e) & 127)) & 127) * (1.f / 128.f), r1 = (float)((cp * ((c8 + e + 1) & 127)) & 127) * (1.f / 128.f);
                    const float a = (part ? -__builtin_amdgcn_sinf(r0) : __builtin_amdgcn_cosf(r0)) * 0.08838834764831845f, b = (part ? -__builtin_amdgcn_sinf(r1) : __builtin_amdgcn_cosf(r1)) * 0.08838834764831845f;
                    w[e >> 1] = pk2(a, b); } }
            ((v4u*)(ws + WS_CBD))[i] = (v4u){w[0], w[1], w[2], w[3]}; }
        {
            const v4u z = {0u, 0u, 0u, 0u};
            for (int i = gt; i < 8192 + 16384 + MKV * 16; i += NGT) {
                if (i < 8192) ((v4u*)(ws + WS_WIN_T + (size_t)1984 * 2048))[i] = z;
                else if (i < 8192 + 16384) { const int j = i - 8192; *(v4u*)(ws + WS_KVUP_T + (size_t)(j >> 4) * 512 + 256 + (j & 15) * 16) = z; }
                else { const int j = i - 8192 - 16384; *(v4u*)(ws + WS_KVN + (size_t)(j >> 4) * 512 + 256 + (j & 15) * 16) = z; }
            }
        }
        for (int i = gt; i < 65536; i += NGT) { const int rho = i >> 8, l = i & 255; const int k = rho > 128 ? rho - 128 : rho; const float rev = (float)((k * l) & 255) * (1.f / 256.f);
            ((bf16*)(ws + WS_D256))[i] = (bf16)f2bf((rho > 128 ? __builtin_amdgcn_sinf(rev) : __builtin_amdgcn_cosf(rev)) * 0.0625f); }
        {
            float* H2 = (float*)(ws + WS_H2);
            const float* w1 = args.in[I_HFW1]; const float* w2 = args.in[I_HFW2];
            const float b1 = args.in[I_HFB1][lane], b2 = args.in[I_HFB2][lane], fr = args.in[I_HFFREQ][lane];
            for (int R = gw; R < LS + LP; R += NGW) {
                const int L = R < LS ? LS : LP, l = R < LS ? R : R - LS;
                const float t = (float)l / (float)(L - 1);
                const float wang = (6.283185307179586f * (float)l) / (float)L;
                const int j = lane & 15; const float band = 1e-4f + (float)j * ((15.0f - 1e-4f) / 15.0f);
                const float ang = wang * band, rev = ang * INV_2PI;
                const float zl = (lane < 16) ? fcos_rev(rev) : -fsin_rev(rev);
                float p1 = b1 + t * w1[lane];
#pragma unroll
                for (int i = 0; i < 32; ++i) p1 += __shfl(zl, i) * w1[(1 + i) * 64 + lane];
                const float h1 = sinf(fr * p1);
                float p2 = b2;
#pragma unroll 16
                for (int i = 0; i < 64; ++i) p2 += __shfl(h1, i) * w2[i * 64 + lane];
                H2[(size_t)R * 64 + lane] = sinf(fr * p2);
            }
        }
    }
    SEAM(0);

    if (IN(1)) {
        FRESH();
        asm volatile("; ==== PHASE 1 ====");
        for (int m = gw; m < MT; m += NGW) {
            const float* xr = m < NP ? args.in[I_XP] + (size_t)m * DM : args.in[I_XS] + (size_t)(m - NP) * DM;
            const float* md = MODS + (size_t)req_of_row(m) * 6144;
            f32x4 v[4]; load_row(xr, lane, v); adaln_store(v, md, md + 1024, HB + (size_t)m * DM, lane);
        }
        {
            const float* H2 = (const float*)(ws + WS_H2); const float* w3 = args.in[I_HFW3];
            LAS float* w3l = (LAS float*)(lds + wave * 16384);
            for (int it = gw; it < 68 * 32; it += NGW) {
                const int lb = it >> 5, cg = it & 31; const bool smp = lb < 64; const int L = smp ? LS : LP; const int l = (smp ? lb : lb - 64) * 64 + lane; const int R = lb * 64 + lane;
#pragma unroll
                for (int q = 0; q < 32; ++q) { const int o = 2 * q + (lane >> 5); w3l[(lane & 31) * 68 + o] = w3[o * 1024 + cg * 32 + (lane & 31)]; }
                float h2[64];
#pragma unroll
                for (int q = 0; q < 16; ++q) { const f32x4 x = ((const f32x4*)(H2 + (size_t)R * 64))[q]; h2[4 * q] = x[0]; h2[4 * q + 1] = x[1]; h2[4 * q + 2] = x[2]; h2[4 * q + 3] = x[3]; }
                LDS_WAIT(); asm volatile("" ::: "memory");
                const float t = (float)l / (float)(L - 1);
                float* FP = (float*)(ws + (smp ? WS_FPART_S : WS_FPART_P));
                float av[32];
#pragma unroll
                for (int cc = 0; cc < 32; ++cc) {
                    const int col = cg * 32 + cc, ch = col & 511, half = col >> 9;
                    float a = 0.f;
#pragma unroll
                    for (int q = 0; q < 16; ++q) { const f32x4 w4 = *(const LAS f32x4*)(w3l + cc * 68 + 4 * q); a += (h2[4 * q] * w4[0] + h2[4 * q + 1] * w4[1]) + (h2[4 * q + 2] * w4[2] + h2[4 * q + 3] * w4[3]); }
                    const float delta = fabsf(-3.0701134573253944f + (float)ch * ((-15.350567286626973f + 3.0701134573253944f) / 511.0f));
                    const float val = a * fexp(-t * delta);
                    if (smp) {
                        bf16* GRB = (bf16*)(ws + WS_FT_S) + (size_t)ch * 8192;
                        if (half == 0) GRB[LS - l] = (bf16)f2bf(val); else GRB[l == 0 ? 0 : LS + l] = (bf16)(l == 0 ? 0u : f2bf(val));
                    } else ((float*)(ws + WS_FT_P))[(size_t)col * LP + l] = val;
                    av[cc] = fabsf(val);
                }
#pragma unroll
                for (int o = 1; o < 64; o <<= 1) {
#pragma unroll
                    for (int cc = 0; cc < 32; ++cc) av[cc] += __shfl_xor(av[cc], o); }
                if (lane < 32) { float sel = av[0];
#pragma unroll
                    for (int cc = 1; cc < 32; ++cc) sel = (lane == cc) ? av[cc] : sel;
                    FP[(cg * 32 + lane) * (smp ? 64 : 4) + (smp ? lb : lb - 64)] = sel; }
                LDS_WAIT(); asm volatile("" ::: "memory");
            }
        }
    }
    SEAM(1);

    if (IN(2)) {
        FRESH();
        asm volatile("; ==== PHASE 2 ====");
        pg8::Gemm g{HB, (const bf16*)(ws + WS_WIN_T), MT, WINP, DM}; pg8::StaticOrder S; S.init((MT / 192) * 256, WINP, G, bx);
        EpiWin<3> E{(bf16*)(ws + WS_P), (float*)(ws + WS_ZS)};
        pg8::gemm_phase<EpiWin<3>, pg8::StaticOrder, PG8_ALIGN, PG8_SP2, 3>(lds, g, S, E, tid);
    }
    SEAM(2);

    if (IN(3)) {
        FRESH();
        asm volatile("; ==== PHASE 3 ====");
        const bf16* P = (const bf16*)(ws + WS_P);
        for (int it = bx; it < MT / 64; it += G) {
            const int m0 = it * 64; const bool smp = m0 >= NP; const int L = smp ? LS : LP; const int l0 = smp ? (m0 - NP) % LS : m0 % LP;
            const int seq = smp ? (m0 - NP) / LS : m0 / LP;
            const int c = tid;
            const float* cw = args.in[I_CONVW]; const float* cb = args.in[I_CONVB];
            float w[3][3], bb[3];
#pragma unroll
            for (int s = 0; s < 3; ++s) { bb[s] = cb[s * 512 + c];
#pragma unroll
                for (int k = 0; k < 3; ++k) w[s][k] = cw[k * 1536 + s * 512 + c]; }
            float prev[3], cur[3];
#pragma unroll
            for (int s = 0; s < 3; ++s) { prev[s] = (l0 > 0) ? bf2f(P[(size_t)(m0 - 1) * 1536 + s * 512 + c]) : 0.f; cur[s] = bf2f(P[(size_t)m0 * 1536 + s * 512 + c]); }
            LAS bf16* ut = (LAS bf16*)lds;
            bf16* X0 = (bf16*)(ws + WS_X0);
            for (int i0 = 0; i0 < 64; i0 += 8) {
                float nx[8][3];
#pragma unroll
                for (int i = 0; i < 8; ++i) { const bool has_next = (l0 + i0 + i + 1) < L;
#pragma unroll
                    for (int s = 0; s < 3; ++s) { const float v = bf2f(P[(size_t)(m0 + i0 + i + (has_next ? 1 : 0)) * 1536 + s * 512 + c]); nx[i][s] = has_next ? v : 0.f; } }
#pragma unroll
                for (int i = 0; i < 8; ++i) {
                    float y[3];
#pragma unroll
                    for (int s = 0; s < 3; ++s) y[s] = prev[s] * w[s][0] + cur[s] * w[s][1] + nx[i][s] * w[s][2] + bb[s];
                    X0[(size_t)(m0 + i0 + i) * 512 + c] = (bf16)f2bf(y[0]);
                    ut[c * 68 + i0 + i] = (bf16)f2bf(y[2] * y[1]);
#pragma unroll
                    for (int s = 0; s < 3; ++s) { prev[s] = cur[s]; cur[s] = nx[i][s]; }
                }
            }
            __syncthreads();
            bf16* UT = (bf16*)(ws + (smp ? WS_UT_S : WS_UT_P)) + (size_t)seq * 512 * L + l0;
            for (int q = tid; q < 512 * 16; q += 512) { const int ch = q >> 4, part = q & 15; const v2u v = *(const LAS v2u*)(ut + ch * 68 + part * 4); *(v2u*)(UT + (size_t)ch * L + part * 4) = v; }
            __syncthreads();
        }
        const float* ZS = (const float*)(ws + WS_ZS);
        bf16* QN = (bf16*)(ws + WS_QN); bf16* KVN = (bf16*)(ws + WS_KVN);
        for (int m = gw; m < MKV; m += NGW) {
            if (m < MT) {
                const bool smp = m >= NP; const int b = smp ? (m - NP) / LS : m / LP, key = smp ? (m - NP) % LS : m % LP;
                const f32x4 a0 = ((const f32x4*)(ZS + (size_t)m * 512))[2 * lane], a1 = ((const f32x4*)(ZS + (size_t)m * 512))[2 * lane + 1];
                float x[8] = {a0[0], a0[1], a0[2], a0[3], a1[0], a1[1], a1[2], a1[3]};
                float ss = 0.f;
                if (lane < 48) {
#pragma unroll
                    for (int i = 0; i < 8; ++i) ss += x[i] * x[i]; }
#pragma unroll
                for (int o = 1; o < 32; o <<= 1) ss += __shfl_xor(ss, o);
                if (lane < 32) {
                    const float r = __builtin_amdgcn_rsqf(ss * (1.f / QL) + RMS_EPS); const float* g = args.in[I_QNORM] + 8 * lane;
                    v4u w; w.x = pk2(x[0] * r * g[0], x[1] * r * g[1]); w.y = pk2(x[2] * r * g[2], x[3] * r * g[3]); w.z = pk2(x[4] * r * g[4], x[5] * r * g[5]); w.w = pk2(x[6] * r * g[6], x[7] * r * g[7]);
                    *(v4u*)(QN + (size_t)m * 256 + 8 * lane) = w;
                } else if (lane < 48) {
                    const int c0 = 8 * (lane - 32); const float r = __builtin_amdgcn_rsqf(ss * (1.f / KVL) + RMS_EPS); const float* g = args.in[I_KVNORM] + c0;
                    float y[8];
#pragma unroll
                    for (int i = 0; i < 8; ++i) y[i] = x[i] * r * g[i];
                    v4u w; w.x = pk2(y[0], y[1]); w.y = pk2(y[2], y[3]); w.z = pk2(y[4], y[5]); w.w = pk2(y[6], y[7]);
                    *(v4u*)(KVN + (size_t)m * 256 + c0) = w;
                    if (!smp) { float* o = args.out + OUT_CKV + (size_t)m * KVL + c0; *(f32x4*)o = (f32x4){y[0], y[1], y[2], y[3]}; *(f32x4*)(o + 4) = (f32x4){y[4], y[5], y[6], y[7]}; }
                }
                {
                    float y[8];
                    const int q = lane - 48; const int seg = (q >> 2) & 1; const bool second = (q & 2) != 0; const int j0 = 8 * (q & 1);
                    const float pf = (float)(seg == 0 ? (key >> 6) : (key & 63));
#pragma unroll
                    for (int i = 0; i < 8; ++i) { const float pr = __shfl_xor(x[i], 2);
                        if (smp) { const float inv = __builtin_amdgcn_exp2f(-(float)(j0 + i) * (13.287712379549449f / 16.0f)); const float rev = pf * inv * INV_2PI;
                            y[i] = x[i] * fcos_rev(rev) + (second ? pr : -pr) * fsin_rev(rev); }
                        else y[i] = x[i]; }
                    if (lane >= 48 && lane < 56) {
                        const int kk = 8 * q;
                        if (!smp) { float* o = args.out + OUT_CKR + (size_t)m * DROPE + kk; *(f32x4*)o = (f32x4){y[0], y[1], y[2], y[3]}; *(f32x4*)(o + 4) = (f32x4){y[4], y[5], y[6], y[7]}; }
                        v4u w; w.x = pk2(y[0], y[1]); w.y = pk2(y[2], y[3]); w.z = pk2(y[4], y[5]); w.w = pk2(y[6], y[7]);
                        bf16* kf = (bf16*)(ws + (smp ? WS_KF_S : WS_KF_P)); const int lk = smp ? LKS : LP;
#pragma unroll
                        for (int h = 0; h < NH; ++h) *(v4u*)(kf + ((size_t)(b * NH + h) * lk + key) * DQK + DNOPE + kk) = w;
                    }
                }
            } else {
                const int mm = m - MT, b = mm / PAST, j = mm % PAST;
                if (lane < 16) { const float* s = args.in[I_CKV] + (size_t)mm * KVL + 8 * lane;
                    v4u w; w.x = pk2(s[0], s[1]); w.y = pk2(s[2], s[3]); w.z = pk2(s[4], s[5]); w.w = pk2(s[6], s[7]); *(v4u*)(KVN + (size_t)m * 256 + 8 * lane) = w; }
                else if (lane < 24) { const int kk = 8 * (lane - 16); const float* s = args.in[I_CKR] + (size_t)mm * DROPE + kk;
                    v4u w; w.x = pk2(s[0], s[1]); w.y = pk2(s[2], s[3]); w.z = pk2(s[4], s[5]); w.w = pk2(s[6], s[7]);
                    bf16* kf = (bf16*)(ws + WS_KF_S);
#pragma unroll
                    for (int h = 0; h < NH; ++h) *(v4u*)(kf + ((size_t)(b * NH + h) * LKS + LS + j) * DQK + DNOPE + kk) = w; }
            }
        }
    }
    SEAM(3);

    if (IN(4)) {
        FRESH();
        asm volatile("; ==== PHASE 4 ====");
        int k256 = 256; asm volatile("" : "+s"(k256));
        { pg8::Gemm g{(const bf16*)(ws + WS_QN), (const bf16*)(ws + WS_QUP_T), MT, 768, k256}; pg8::StaticOrder S; S.init(MT, 768, G, bx);
          EpiStore E{(bf16*)(ws + WS_Q), 768};
          pg8::gemm_phase<EpiStore, pg8::StaticOrder, PG8_ALIGN, PG8_SP2>(lds, g, S, E, tid); }
        { int bx2 = (bx + 144) % G; asm volatile("" : "+s"(bx2)); const int lane2 = fresh_lane(); const int tid = wave * 64 + lane2;
          pg8::Gemm g{(const bf16*)(ws + WS_KVN), (const bf16*)(ws + WS_KVUP_T), MKV, 1024, k256}; pg8::StaticOrder S; S.init(MKV, 1024, G, bx2);
          EpiKV E{(bf16*)(ws + WS_KF_S), (bf16*)(ws + WS_KF_P), (bf16*)(ws + WS_V_S), (bf16*)(ws + WS_V_P)};
          pg8::gemm_phase<EpiKV, pg8::StaticOrder, PG8_ALIGN, PG8_SP2>(lds, g, S, E, tid); }
        { int bx3 = (bx + 88) % G; asm volatile("" : "+s"(bx3)); const int lane3 = fresh_lane(); const int tid = wave * 64 + lane3;
          pg8::Gemm g{(const bf16*)(ws + WS_W1T), (const bf16*)(ws + WS_CBD), DM, 2048, DM}; pg8::StaticOrder S; S.init(DM, 2048, G, bx3);
          EpiStore E{(bf16*)(ws + WS_WFOLD_T), 2048};
          pg8::gemm_phase<EpiStore, pg8::StaticOrder, PG8_ALIGN, PG8_SP2>(lds, g, S, E, tid); }
    }
    SEAM(4);

    if (IN(5)) {
        FRESH();
        asm volatile("; ==== PHASE 5 ====");
        constexpr int NA_S = 2 * BS * NH * (LS / 256), NC_S = HY / 4, NA_P = BP * NH, NC_P = HY / 8, NW_T = (WI_ALL - WI_L0) / 8, NITEM = NA_S + NC_S + NA_P + NC_P + NW_T;
        bf16* YM = HB;
        for (;;) {
            if (tid == 0) MISC[0] = __hip_atomic_fetch_add((unsigned*)(ctl + CW_Q + 64 * args.li), 1u, RLX_AGENT);
            __syncthreads();
            const int it = __builtin_amdgcn_readfirstlane((int)MISC[0]);
            __syncthreads();
            if (it >= NITEM) break;
            { const int cls = it < NA_S ? 0 : it < NA_S + NC_S ? 1 : it < NA_S + NC_S + NA_P ? 2 : it < NA_S + NC_S + NA_P + NC_P ? 3 : 4; if (!((args.mask >> cls) & 1)) continue; }
            const int lane = fresh_lane(); const int tid = wave * 64 + lane;
            const bool isA_S = it < NA_S, isA_P = (it >= NA_S + NC_S) && (it < NA_S + NC_S + NA_P);
            if (isA_S || isA_P) { if (!NO_ATT) {
                int b, h, row0, lk, pos0, koff = 0, nkeys; const bf16 *kf, *vv; float* part = nullptr; unsigned* cnt = nullptr;
                if (isA_S) { const int un = it >> 1, half = it & 1; b = un / (NH * 16); h = (un / 16) % NH; const int qb = un % 16; row0 = NP + b * LS + qb * 256; lk = LKS; pos0 = qb * 256; kf = (const bf16*)(ws + WS_KF_S); vv = (const bf16*)(ws + WS_V_S);
                    nkeys = LKS / 2; koff = half * (LKS / 2); part = (float*)(ws + WS_APART) + (size_t)un * APART_F; cnt = (unsigned*)(ctl + CW_ATT + args.li * 8192 + un * 64); }
                else { const int u = it - NA_S - NC_S; b = u / NH; h = u % NH; row0 = b * LP; lk = LP; pos0 = -1; kf = (const bf16*)(ws + WS_KF_P); vv = (const bf16*)(ws + WS_V_P); nkeys = LP; }
                att::attn_dense_body((const bf16*)(ws + WS_Q) + (size_t)row0 * 768 + h * DQK, kf + ((size_t)(b * NH + h) * lk + koff) * DQK, vv + ((size_t)(b * NH + h) * lk + koff) * DVH,
                                     YM + (size_t)row0 * DM + HY + h * DVH, nkeys, pos0, (LAS char*)lds, tid, part, cnt, MISC); }
            } else if (it < NA_S + NC_S) {
                hconv::item((const bf16*)(ws + WS_FT_S), (const bf16*)(ws + WS_UT_S), (const float*)(ws + WS_FPART_S), args.in[I_HFSKIP], (const bf16*)(ws + WS_X0), YM, (it - NA_S) * 4, lds, tid, lane, wave);
            } else if (it >= NA_S + NC_S + NA_P + NC_P) {
                LAS float* scr = (LAS float*)(lds + wave * 16384);
                weight_item(args, ws, scr, WI_L0 + (it - (NA_S + NC_S + NA_P + NC_P)) * 8 + wave, lane);
                __syncthreads();
            } else if (!NO_CONV) {
                hconv::prompt_item((const float*)(ws + WS_FT_P), (const bf16*)(ws + WS_UT_P), (const float*)(ws + WS_FPART_P), args.in[I_HFSKIP], (const bf16*)(ws + WS_X0), YM, (it - NA_S - NC_S - NA_P) * 8, lds, tid, lane, wave);
            }
        }
    }
    SEAM(5);

    if (IN(6)) {
        FRESH();
        asm volatile("; ==== PHASE 6 ====");
        pg8::Gemm g{HB, (const bf16*)(ws + WS_WOUT0_T), MT, DM, DM}; pg8::StaticOrder S; S.init((MT / 192) * 256, DM, G, bx);
        EpiRes<3, false> E{args.in[I_XP], args.in[I_XS], MODS + 2 * 1024, T, nullptr, nullptr, nullptr};
        pg8::gemm_phase<EpiRes<3, false>, pg8::StaticOrder, PG8_ALIGN, PG8_SP2, 3>(lds, g, S, E, tid);
    }
    SEAM(6);

    if (IN(7)) {
        FRESH();
        asm volatile("; ==== PHASE 7 ====");
        for (int m = gw; m < MT; m += NGW) {
            const float* md = MODS + (size_t)req_of_row(m) * 6144;
            f32x4 v[4]; load_row(T + (size_t)m * DM, lane, v); ln_affine(v, args.in[I_LN1G0], args.in[I_LN1B0], lane, STATS + 2 * m);
            adaln_store(v, md + 3 * 1024, md + 4 * 1024, HB + (size_t)m * DM, lane);
        }
    }
    SEAM(7);

    if (IN(8)) {
        FRESH();
        asm volatile("; ==== PHASE 8 ====");
        pg8::Gemm g{HB, (const bf16*)(ws + WS_W1_0), MT, FF, DM}; pg8::StaticOrder S; S.init(MT, FF, G, bx);
        EpiUp E{(bf16*)(ws + WS_HID)};
        pg8::gemm_phase<EpiUp, pg8::StaticOrder, PG8_ALIGN, PG8_SP2>(lds, g, S, E, tid);
    }
    SEAM(8);

    if (IN(9)) {
        FRESH();
        asm volatile("; ==== PHASE 9 ====");
        pg8::Gemm g{(const bf16*)(ws + WS_HID), (const bf16*)(ws + WS_W2_0), MT, DM, FF}; pg8::StaticOrder S; S.init((MT / 192) * 256, DM, G, bx);
        EpiRes<3, true> E{nullptr, nullptr, MODS + 5 * 1024, T, STATS, args.in[I_LN1G0], args.in[I_LN1B0]};
        pg8::gemm_phase<EpiRes<3, true>, pg8::StaticOrder, PG8_ALIGN, PG8_SP2, 3>(lds, g, S, E, tid);
    }
    SEAM(9);

    if (IN(10)) {
        FRESH();
        asm volatile("; ==== PHASE 10 ====");
        const float* MODS1 = MODS + 3 * 6144;
        for (int it = bx; it < MT / 32; it += G) {
            const int m0 = it * 32; const bool smp = m0 >= NP; const int L = smp ? LS : LP; const int l0 = smp ? (m0 - NP) % LS : m0 % LP; const int seq = smp ? (m0 - NP) / LS : m0 / LP;
            LAS bf16* ht = (LAS bf16*)lds;
            const float* md = MODS1 + (size_t)req_of_row(m0) * 6144;
            for (int rr = 0; rr < 4; ++rr) { const int i = wave * 4 + rr, m = m0 + i;
                f32x4 v[4]; load_row(T + (size_t)m * DM, lane, v); ln_affine(v, args.in[I_LN2G0], args.in[I_LN2B0], lane, STATS + 2 * m);
                float mean, rstd; row_stats(v, mean, rstd);
#pragma unroll
                for (int j = 0; j < 4; ++j) { const int c = 4 * lane + 256 * j; const f32x4 sc = *(const f32x4*)(md + 1024 + c), sh = *(const f32x4*)(md + c);
                    const f32x4 h = (v[j] - mean) * rstd * (sc + 1.0f) + sh;
#pragma unroll
                    for (int e = 0; e < 4; ++e) ht[(c + e) * 40 + i] = (bf16)f2bf(h[e]); }
            }
            __syncthreads();
            bf16* HT = HB + (smp ? (size_t)NP * DM + (size_t)seq * DM * LS : (size_t)seq * DM * LP) + l0;
            for (int q = tid; q < 1024 * 4; q += 512) { const int c = q >> 2, part = q & 3; const v4u v = *(const LAS v4u*)(ht + c * 40 + part * 8); *(v4u*)(HT + (size_t)c * L + part * 8) = v; }
            __syncthreads();
        }
        for (size_t i = gt; i < (size_t)LS * LS / 8; i += NGT) {
            const int rho = (int)(i >> 9), l8 = (int)(i & 511) * 8; const int k = rho > 2048 ? rho - 2048 : rho; unsigned w[4];
#pragma unroll
            for (int e = 0; e < 8; e += 2) { const float r0 = (float)((k * (l8 + e)) & 4095) * (1.f / 4096.f), r1 = (float)((k * (l8 + e + 1)) & 4095) * (1.f / 4096.f);
                const float a = (rho > 2048 ? __builtin_amdgcn_sinf(r0) : __builtin_amdgcn_cosf(r0)) * 0.015625f, b = (rho > 2048 ? __builtin_amdgcn_sinf(r1) : __builtin_amdgcn_cosf(r1)) * 0.015625f;
                w[e >> 1] = pk2(a, b); }
            ((v4u*)(ws + WS_D4096))[i] = (v4u){w[0], w[1], w[2], w[3]};
        }
    }
    SEAM(10);

    if (IN(11)) {
        FRESH();
        asm volatile("; ==== PHASE 11 ====");
        { pg8::Gemm g{(const bf16*)(ws + WS_D4096), HB + (size_t)NP * DM, LS, BS * DM, LS}; pg8::SplitOrder S; S.init(LS, BS * DM, LS, G, vcu, SLABS(200), SPLIT_CNT(3));
          EpiDft E{(bf16*)(ws + WS_UV), LS, NP};
          pg8::gemm_phase<EpiDft, pg8::SplitOrder, PG8_ALIGN, PG8_SP2>(lds, g, S, E, tid); }
        { int bx2 = (bx + 128) % G; asm volatile("" : "+s"(bx2)); const int lane2 = fresh_lane(); const int tid = wave * 64 + lane2;
          pg8::Gemm g{(const bf16*)(ws + WS_D256), HB, LP, BP * DM, LP}; pg8::StaticOrder S; S.init(LP, BP * DM, G, bx2);
          EpiDft E{(bf16*)(ws + WS_UV), LP, 0};
          pg8::gemm_phase<EpiDft, pg8::StaticOrder, PG8_ALIGN, PG8_SP2>(lds, g, S, E, tid); }
    }
    SEAM(11);

    if (IN(12)) {
        FRESH();
        asm volatile("; ==== PHASE 12 ====");
        pg8::Gemm g{(const bf16*)(ws + WS_UV), (const bf16*)(ws + WS_WFOLD_T), MT, DM, 2048}; pg8::StaticOrder S; S.init((MT / 192) * 256, DM, G, bx);
        EpiRes<3, true> E{nullptr, nullptr, MODS + 3 * 6144 + 2 * 1024, T, STATS, args.in[I_LN2G0], args.in[I_LN2B0]};
        pg8::gemm_phase<EpiRes<3, true>, pg8::StaticOrder, PG8_ALIGN, PG8_SP2, 3>(lds, g, S, E, tid);
    }
    SEAM(12);

    if (IN(13)) {
        FRESH();
        asm volatile("; ==== PHASE 13 ====");
        for (int m = gw; m < MT; m += NGW) {
            const float* md = MODS + 3 * 6144 + (size_t)req_of_row(m) * 6144;
            f32x4 v[4]; load_row(T + (size_t)m * DM, lane, v); ln_affine(v, args.in[I_LN1G1], args.in[I_LN1B1], lane, STATS + 2 * m);
            adaln_store(v, md + 3 * 1024, md + 4 * 1024, HB + (size_t)m * DM, lane);
        }
    }
    SEAM(13);

    if (IN(14)) {
        FRESH();
        asm volatile("; ==== PHASE 14 ====");
        pg8::Gemm g{HB, (const bf16*)(ws + WS_W1_1), MT, FF, DM}; pg8::StaticOrder S; S.init(MT, FF, G, bx);
        EpiUp E{(bf16*)(ws + WS_HID)};
        pg8::gemm_phase<EpiUp, pg8::StaticOrder, PG8_ALIGN, PG8_SP2>(lds, g, S, E, tid);
    }
    SEAM(14);

    if (IN(15)) {
        FRESH();
        asm volatile("; ==== PHASE 15 ====");
        pg8::Gemm g{(const bf16*)(ws + WS_HID), (const bf16*)(ws + WS_W2_1), MT, DM, FF}; pg8::StaticOrder S; S.init((MT / 192) * 256, DM, G, bx);
        EpiRes<3, true> E{nullptr, nullptr, MODS + 3 * 6144 + 5 * 1024, T, STATS, args.in[I_LN1G1], args.in[I_LN1B1]};
        pg8::gemm_phase<EpiRes<3, true>, pg8::StaticOrder, PG8_ALIGN, PG8_SP2, 3>(lds, g, S, E, tid);
    }
    SEAM(15);

    if (IN(16)) {
        FRESH();
        asm volatile("; ==== PHASE 16 ====");
        for (int m = gw; m < MT; m += NGW) {
            f32x4 v[4]; load_row(T + (size_t)m * DM, lane, v); ln_affine(v, args.in[I_LN2G1], args.in[I_LN2B1], lane); store_row(X + (size_t)m * DM, lane, v);
        }
    }
#undef IN
#undef SEAM
}

extern "C" void kernel_launch(void* const* d_in, const int* in_sizes, int n_in, void* d_out, int out_size, void* d_ws, size_t ws_size, hipStream_t stream) {
    static int grid = 0;
    if (grid == 0) {
        if (n_in != 38 || ws_size < WS_END) { fprintf(stderr, "kernel_launch: expected 38 inputs and >= %zu bytes of workspace; got %d, %zu\n", (size_t)WS_END, n_in, ws_size); grid = -1; return; }
        int dev = 0, cus = 0;
        if (hipGetDevice(&dev) != hipSuccess || hipDeviceGetAttribute(&cus, hipDeviceAttributeMultiprocessorCount, dev) != hipSuccess) { grid = -1; return; }
        if (hipFuncSetAttribute((const void*)fwd_kernel, hipFuncAttributeMaxDynamicSharedMemorySize, LDS_BYTES) != hipSuccess) { fprintf(stderr, "kernel_launch: hipFuncSetAttribute failed\n"); grid = -1; return; }
        int per_cu = 0;
        if (hipOccupancyMaxActiveBlocksPerMultiprocessor(&per_cu, (const void*)fwd_kernel, 512, LDS_BYTES) != hipSuccess || per_cu < 1) fprintf(stderr, "kernel_launch: occupancy query reports %d\n", per_cu);
        (void)hipGetLastError();
        grid = cus;
    }
    if (grid < 0) return;
    (void)hipMemsetAsync((char*)d_ws + WS_CTL, 0, CTL_ZERO_BYTES, stream);
    Args a{};
    for (int i = 0; i < 38; ++i) a.in[i] = (const float*)d_in[i];
    a.out = (float*)d_out; a.ws = (unsigned char*)d_ws;
#if MK_PER_PHASE
    for (int p = 0; p < NPHASE; ++p) { a.ph_lo = p; a.ph_hi = p + 1; a.li = 0; a.mask = 31; hipLaunchKernelGGL(fwd_kernel, dim3(grid), dim3(512), LDS_BYTES, stream, a); }
#elif defined(PROBE_A)
#ifndef PROBE_MASK5
#define PROBE_MASK5 31
#endif
    a.mask = 31; a.ph_lo = 0; a.ph_hi = PROBE_B; a.li = 0; hipLaunchKernelGGL(fwd_kernel, dim3(grid), dim3(512), LDS_BYTES, stream, a);
    a.mask = PROBE_MASK5; a.ph_lo = PROBE_A; a.ph_hi = NPHASE; a.li = 1; hipLaunchKernelGGL(fwd_kernel, dim3(grid), dim3(512), LDS_BYTES, stream, a);
#else
    a.ph_lo = 0; a.ph_hi = NPHASE; a.li = 0; a.mask = 31;
    hipLaunchKernelGGL(fwd_kernel, dim3(grid), dim3(512), LDS_BYTES, stream, a);
#endif
    const hipError_t le = hipPeekAtLastError();
    if (le != hipSuccess) fprintf(stderr, "kernel_launch: launch failed: %s\n", hipGetErrorName(le));
}
```

```cpp
#include <hip/hip_runtime.h>
#include <hip/hip_bf16.h>
#include <cstdio>
#include <cstdint>
#include <cmath>
namespace pg8 {
#define PG8_LAS __attribute__((address_space(3)))
typedef unsigned short bf16_t;
typedef short bf16x8 __attribute__((ext_vector_type(8)));
typedef float f32x4 __attribute__((ext_vector_type(4)));
typedef unsigned u32x4 __attribute__((ext_vector_type(4)));
constexpr int BM = 256, BK = 64, HALF = 128, HTB = HALF * BK * 2  , STAGE_BYTES = 8 * HTB, NXCD = 8, WGM = 8;

__host__ __device__ __forceinline__ int lds_byte(int r, int c) { const int st = (r >> 4) * 2 + (c >> 5), rr = r & 15, cc = c & 31, ob = rr * 64 + cc * 2; return st * 1024 + (ob ^ (((ob >> 9) & 1) << 5)); }
__host__ __device__ __forceinline__ void stage_rc(int b, int& R, int& C) { const int st = b / 1024, sb = b % 1024, swz = sb ^ (((sb >> 9) & 1) << 5); R = (st >> 1) * 16 + swz / 64; C = (st & 1) * 32 + (swz % 64) / 2; }
__host__ __device__ __forceinline__ int perm32(int rho) { const int n = rho >> 4, i = rho & 15; return 8 * (i >> 2) + 4 * n + (i & 3); }

struct Unit { int pm, pn; int k0, nt, mode, slab, need, tile; };
struct Gemm { const bf16_t* A; const bf16_t* Bt; int M, N, K; };

struct StaticOrder {
    int nM, nN, nwg, G, c;
    __host__ __device__ void init(int M, int N, int G_, int c_) { nM = M / BM; nN = N / BM; nwg = nM * nN; G = G_; c = c_; }
    __host__ __device__ bool next(int i, Unit& u) const {
        const long L = (long)i * G + c; if (L >= nwg) return false;
        int wgid = (int)L; { const int q = nwg / NXCD, r = nwg % NXCD, xcd = wgid % NXCD, off = wgid / NXCD; wgid = (xcd < r ? xcd * (q + 1) : r * (q + 1) + (xcd - r) * q) + off; }
        const int nig = WGM * nN, gid = wgid / nig, fm = gid * WGM, gsz = (nM - fm) < WGM ? (nM - fm) : WGM;
        u.pm = fm + ((wgid % nig) % gsz); u.pn = (wgid % nig) / gsz; u.k0 = 0; u.nt = 0; u.mode = 0; u.slab = 0; u.need = 0; u.tile = 0; return true;
    }
    static constexpr bool SPLIT = false;
    __device__ __forceinline__ void a_ready(const Unit&) const {}
    __device__ __forceinline__ void done(const Unit&) const {}
};

struct SplitOrder {
    static constexpr bool SPLIT = true;
    int nM, nN, NT, per, c, lo, hi, tf, ns, give_last, P; float* slabs; unsigned* cnt;
    __device__ __forceinline__ void init(int M, int N, int K, int G_, int c_, float* slabs_, unsigned* cnt_) {
        nM = M / BM; nN = N / BM; NT = K / BK; c = c_; slabs = slabs_; cnt = cnt_;
        const int TU = nM * nN * NT; per = (TU + G_ - 1) / G_; per += per & 1;
        lo = c * per; hi = lo + per < TU ? lo + per : TU; if (lo >= TU) { lo = 0; hi = 0; }
        tf = lo / NT; ns = hi > lo ? (hi - 1) / NT - tf + 1 : 0; give_last = (hi % NT) != 0 ? 1 : 0;
        int a = per, b = NT; while (b) { const int t = a % b; a = b; b = t; } P = NT / a;
    }
    __device__ __forceinline__ int giver_index(int j) const { return j - j / P; }
    __device__ __forceinline__ bool next(int i, Unit& u) const {
        if (i >= ns) return false;
        int sidx; if (ns == 1) sidx = 0; else if (give_last && i == 0) sidx = ns - 1; else if (i == ns - 1) sidx = 0; else sidx = i - give_last + 1;
        const int T = tf + sidx, tlo = T * NT, thi = tlo + NT; const int a = lo > tlo ? lo : tlo, b = hi < thi ? hi : thi;
        const int nig = WGM * nN, gid = T / nig, fm = gid * WGM, gsz = (nM - fm) < WGM ? (nM - fm) : WGM;
        u.pm = fm + ((T % nig) % gsz); u.pn = (T % nig) / gsz; u.k0 = a - tlo; u.nt = b - a; u.tile = T;
        if (b != thi) { u.mode = 1; u.slab = giver_index(c); u.need = 0; }
        else if (a != tlo) { const int c0 = tlo / per; u.mode = 2; u.slab = giver_index(c0); u.need = c - c0; }
        else { u.mode = 0; u.slab = 0; u.need = 0; }
        return true;
    }
    __device__ __forceinline__ void a_ready(const Unit&) const {}
    __device__ __forceinline__ void done(const Unit&) const {}
};
__device__ __forceinline__ unsigned cvt_pk_bf16(float lo, float hi) { unsigned r; asm volatile("v_cvt_pk_bf16_f32 %0, %1, %2" : "=v"(r) : "v"(lo), "v"(hi)); return r; }
template <class Epi, class Sched, bool ALIGN_EPI = false, bool SP2 = false, int MF = 4>
__device__ __forceinline__ void gemm_phase(PG8_LAS unsigned char* lds, const Gemm g, const Sched& S, const Epi& E, const int tid) {
    const int wid = __builtin_amdgcn_readfirstlane(tid >> 6), lane = tid & 63, wr = wid >> 2, wc = wid & 3, fr = lane & 15, fq = lane >> 4;
    const int K = g.K, nt = K / BK;
    unsigned voffA[2], voffB[2];
#pragma unroll
    for (int i = 0; i < 2; ++i) { int R, C; stage_rc(tid * 16 + i * 8192, R, C); const int Rb = Epi::PERM ? ((R & ~31) + perm32(R & 31)) : R;
        voffA[i] = (unsigned)(R * K + C) * 2u; voffB[i] = (unsigned)(Rb * K + C) * 2u; }
    const size_t kstep = (size_t)(BK * 2);
    const size_t hstepB = (size_t)HALF * K * 2, tstepB = 2 * hstepB;
    const size_t hstepA = (size_t)(32 * MF) * K * 2, tstepA = 2 * hstepA;
    const unsigned ldsw = (unsigned)wid * 1024u;
    const int aoff = lds_byte(wr * (16 * MF) + fr, fq * 8), boff = lds_byte(wc * 32 + fr, fq * 8);
#define PG8_SA(b, h) (((b) * 2 + (h)) * HTB)
#define PG8_SB(b, h) ((4 + (b) * 2 + (h)) * HTB)
#define PG8_STAGE(bufoff, gbase, voff) do { _Pragma("unroll") for (int _i = 0; _i < 2; ++_i) \
        __builtin_amdgcn_global_load_lds((const unsigned*)((const char*)(gbase) + (voff)[_i]), (PG8_LAS unsigned*)(lds + (bufoff) + ldsw + _i * 8192), 16, 0, 0); } while (0)
#define PG8_LDA(dst, b, h) do { _Pragma("unroll") for (int m = 0; m < MF; ++m) _Pragma("unroll") for (int k = 0; k < 2; ++k) dst[m][k] = *(const PG8_LAS bf16x8*)(lds + PG8_SA(b, h) + aoff + m * 2048 + k * 1024); } while (0)
#define PG8_LDB(dst, b, h) do { _Pragma("unroll") for (int n = 0; n < 2; ++n) _Pragma("unroll") for (int k = 0; k < 2; ++k) dst[n][k] = *(const PG8_LAS bf16x8*)(lds + PG8_SB(b, h) + boff + n * 2048 + k * 1024); } while (0)
#define PG8_MMA(ai, bj, At, Bt) do { __builtin_amdgcn_s_setprio(1); _Pragma("unroll") for (int m = 0; m < MF; ++m) _Pragma("unroll") for (int n = 0; n < 2; ++n) _Pragma("unroll") for (int k = 0; k < 2; ++k) \
        acc[ai][bj][m][n] = __builtin_amdgcn_mfma_f32_16x16x32_bf16(Bt[n][k], At[m][k], acc[ai][bj][m][n], 0, 0, 0); __builtin_amdgcn_s_setprio(0); } while (0)
#define PG8_WAIT_V(n) asm volatile("s_waitcnt vmcnt(" #n ")" ::: "memory")
#define PG8_WAIT_L(n) asm volatile("s_waitcnt lgkmcnt(" #n ")" ::: "memory")
#define PG8_BAR __builtin_amdgcn_s_barrier()
#define PG8_SCHED __builtin_amdgcn_sched_barrier(0)
    Unit cur, nxt; int ui = 0;
    if (!S.next(0, cur)) return;
    f32x4 acc[2][2][4][2];
#pragma unroll
    for (int a = 0; a < 2; ++a)
#pragma unroll
        for (int b = 0; b < 2; ++b)
#pragma unroll
            for (int m = 0; m < 4; ++m)
#pragma unroll
                for (int n = 0; n < 2; ++n) acc[a][b][m][n] = (f32x4){0.f, 0.f, 0.f, 0.f};
    bf16x8 At[4][2], B0[2][2], B1[2][2];
    const char* cA = (const char*)g.A + (size_t)cur.pm * tstepA + (size_t)cur.k0 * kstep; const char* cB = (const char*)g.Bt + (size_t)cur.pn * tstepB + (size_t)cur.k0 * kstep;
    S.a_ready(cur);
    if constexpr (SP2) {
        PG8_STAGE(PG8_SB(0, 0), cB, voffB); PG8_STAGE(PG8_SB(0, 1), cB + hstepB, voffB); PG8_STAGE(PG8_SA(0, 0), cA, voffA); PG8_STAGE(PG8_SA(0, 1), cA + hstepA, voffA);
        if (wr == 1) PG8_BAR;
        PG8_WAIT_V(2); PG8_BAR;
        PG8_STAGE(PG8_SB(1, 0), cB + kstep, voffB); PG8_STAGE(PG8_SA(1, 0), cA + kstep, voffA); PG8_STAGE(PG8_SB(1, 1), cB + hstepB + kstep, voffB);
        PG8_WAIT_V(6); PG8_BAR;
    } else {
        PG8_STAGE(PG8_SB(0, 0), cB, voffB); PG8_STAGE(PG8_SA(0, 0), cA, voffA); PG8_STAGE(PG8_SB(0, 1), cB + hstepB, voffB); PG8_STAGE(PG8_SA(0, 1), cA + hstepA, voffA);
        if (wr == 1) PG8_BAR;
        PG8_WAIT_V(4); PG8_BAR;
        PG8_STAGE(PG8_SB(1, 0), cB + kstep, voffB); PG8_STAGE(PG8_SA(1, 0), cA + kstep, voffA); PG8_STAGE(PG8_SB(1, 1), cB + hstepB + kstep, voffB);
        PG8_WAIT_V(6); PG8_BAR;
    }
    for (;;) {
        const bool has_next = S.next(ui + 1, nxt);
        const char* nA = has_next ? (const char*)g.A + (size_t)nxt.pm * tstepA + (size_t)nxt.k0 * kstep : cA; const char* nB = has_next ? (const char*)g.Bt + (size_t)nxt.pn * tstepB + (size_t)nxt.k0 * kstep : cB;
        const int ntc = cur.nt ? cur.nt : nt;
        for (int t = 0; t < ntc; t += 2) {
            const bool last = (t == ntc - 2);
            const char* a1 = cA + (size_t)(t + 1) * kstep;
            const char* a2 = last ? nA : cA + (size_t)(t + 2) * kstep; const char* b2 = last ? nB : cB + (size_t)(t + 2) * kstep;
            const char* a3 = a2 + kstep; const char* b3 = b2 + kstep;
            if (last && has_next) S.a_ready(nxt);
            if constexpr (SP2) {
            PG8_LDB(B0, 0, 0); PG8_LDB(B1, 0, 1); PG8_SCHED; PG8_LDA(At, 0, 0); PG8_STAGE(PG8_SA(1, 1), a1 + hstepA, voffA);
            PG8_WAIT_V(8); PG8_WAIT_L(0); PG8_BAR; PG8_MMA(0, 0, At, B0); PG8_MMA(0, 1, At, B1); PG8_BAR; PG8_SCHED;
            PG8_LDA(At, 0, 1); PG8_STAGE(PG8_SB(0, 0), b2, voffB); PG8_STAGE(PG8_SB(0, 1), b2 + hstepB, voffB); PG8_STAGE(PG8_SA(0, 0), a2, voffA);
            PG8_WAIT_V(8); PG8_WAIT_L(0); PG8_BAR; PG8_MMA(1, 0, At, B0); PG8_MMA(1, 1, At, B1); PG8_BAR; PG8_SCHED;
            PG8_LDB(B0, 1, 0); PG8_LDB(B1, 1, 1); PG8_SCHED; PG8_LDA(At, 1, 0); PG8_STAGE(PG8_SA(0, 1), a2 + hstepA, voffA);
            PG8_WAIT_V(8); PG8_WAIT_L(0); PG8_BAR; PG8_MMA(0, 0, At, B0); PG8_MMA(0, 1, At, B1); PG8_BAR; PG8_SCHED;
            PG8_LDA(At, 1, 1); PG8_STAGE(PG8_SB(1, 0), b3, voffB); PG8_STAGE(PG8_SB(1, 1), b3 + hstepB, voffB); PG8_STAGE(PG8_SA(1, 0), a3, voffA);
            PG8_WAIT_V(8); PG8_WAIT_L(0); PG8_BAR; PG8_MMA(1, 0, At, B0); PG8_MMA(1, 1, At, B1); PG8_BAR; PG8_SCHED;
            } else {
            PG8_LDB(B0, 0, 0); PG8_SCHED; PG8_LDA(At, 0, 0); PG8_STAGE(PG8_SA(1, 1), a1 + hstepA, voffA);
            PG8_WAIT_L(8); PG8_BAR; PG8_WAIT_L(0); PG8_MMA(0, 0, At, B0); PG8_BAR; PG8_SCHED;
            PG8_LDB(B1, 0, 1); PG8_STAGE(PG8_SB(0, 0), b2, voffB);
            PG8_BAR; PG8_WAIT_L(0); PG8_MMA(0, 1, At, B1); PG8_BAR;
            PG8_LDA(At, 0, 1); PG8_STAGE(PG8_SA(0, 0), a2, voffA);
            PG8_BAR; PG8_WAIT_L(0); PG8_MMA(1, 0, At, B0); PG8_BAR; PG8_SCHED;
            PG8_STAGE(PG8_SB(0, 1), b2 + hstepB, voffB);
            PG8_WAIT_V(6); PG8_BAR; PG8_MMA(1, 1, At, B1); PG8_BAR;
            PG8_LDB(B0, 1, 0); PG8_SCHED; PG8_LDA(At, 1, 0); PG8_STAGE(PG8_SA(0, 1), a2 + hstepA, voffA);
            PG8_WAIT_L(8); PG8_BAR; PG8_WAIT_L(0); PG8_MMA(0, 0, At, B0); PG8_BAR; PG8_SCHED;
            PG8_LDB(B1, 1, 1); PG8_STAGE(PG8_SB(1, 0), b3, voffB);
            PG8_BAR; PG8_WAIT_L(0); PG8_MMA(0, 1, At, B1); PG8_BAR;
            PG8_LDA(At, 1, 1); PG8_STAGE(PG8_SA(1, 0), a3, voffA);
            PG8_BAR; PG8_WAIT_L(0); PG8_MMA(1, 0, At, B0); PG8_BAR; PG8_SCHED;
            PG8_STAGE(PG8_SB(1, 1), b3 + hstepB, voffB);
            PG8_WAIT_V(6); PG8_BAR; PG8_MMA(1, 1, At, B1); PG8_BAR;
            }
        }
        if constexpr (ALIGN_EPI) { if (wr == 0) PG8_BAR; }
        if constexpr (!Epi::AFTER_DRAIN) {
            Unit eu = cur; eu.pm = __builtin_amdgcn_readfirstlane(cur.pm); eu.pn = __builtin_amdgcn_readfirstlane(cur.pn); eu.slab = __builtin_amdgcn_readfirstlane(cur.slab); eu.tile = __builtin_amdgcn_readfirstlane(cur.tile);
            eu.need = __builtin_amdgcn_readfirstlane(cur.need); eu.mode = __builtin_amdgcn_readfirstlane(cur.mode);
            asm volatile("" : "+s"(eu.pm), "+s"(eu.pn), "+s"(eu.slab), "+s"(eu.tile), "+s"(eu.need), "+s"(eu.mode));
            if constexpr (Sched::SPLIT) {
                if (eu.mode == 1) {
                    const float* sp = S.slabs + (size_t)eu.slab * 65536 + wid * 8192 + lane * 4;
#pragma unroll
                    for (int a = 0; a < 2; ++a)
#pragma unroll
                        for (int b = 0; b < 2; ++b)
#pragma unroll
                            for (int m = 0; m < 4; ++m)
#pragma unroll
                                for (int n = 0; n < 2; ++n) { const f32x4 v = acc[a][b][m][n]; const float* p = sp + (((a * 2 + b) * 4 + m) * 2 + n) * 256;
                                    asm volatile("global_store_dwordx4 %0, %1, off sc1\n\ts_nop 1" :: "v"(p), "v"(v) : "memory"); }
                    asm volatile("s_waitcnt vmcnt(0)" ::: "memory");
                    if (lane == 0) __hip_atomic_fetch_add(S.cnt + eu.tile * 32, 1u, __ATOMIC_RELAXED, __HIP_MEMORY_SCOPE_AGENT);
                } else if (eu.mode == 2) {
                    unsigned sp_ = 0;
                    while ((unsigned)__builtin_amdgcn_readfirstlane(__hip_atomic_load(S.cnt + eu.tile * 32, __ATOMIC_RELAXED, __HIP_MEMORY_SCOPE_AGENT)) < 8u) { __builtin_amdgcn_s_sleep(8); if (++sp_ > (1u << 20)) break; }
                    __builtin_amdgcn_fence(__ATOMIC_ACQUIRE, "agent");
                    E.template run<true>(acc, eu, wr, wc, fr, fq, S.slabs + (size_t)eu.slab * 65536 + wid * 8192 + lane * 4);
                } else E.template run<false>(acc, eu, wr, wc, fr, fq, nullptr);
            } else E.template run<false>(acc, eu, wr, wc, fr, fq, nullptr);
            S.done(cur); }
        if (!has_next) break;
#pragma unroll
        for (int a = 0; a < 2; ++a)
#pragma unroll
            for (int b = 0; b < 2; ++b)
#pragma unroll
                for (int m = 0; m < 4; ++m)
#pragma unroll
                    for (int n = 0; n < 2; ++n) acc[a][b][m][n] = (f32x4){0.f, 0.f, 0.f, 0.f};
        cur = nxt; cA = nA; cB = nB; ++ui;
        if constexpr (ALIGN_EPI) { if (wr == 1) PG8_BAR; }
    }
    PG8_WAIT_V(0);
    if constexpr (!ALIGN_EPI) { if (wr == 0) PG8_BAR; }
    PG8_BAR;
    if constexpr (Epi::AFTER_DRAIN) { E.fused(acc, cur, wr, wc, fr, fq, lds, wid, lane); S.done(cur); }
#undef PG8_SA
#undef PG8_SB
#undef PG8_STAGE
#undef PG8_LDA
#undef PG8_LDB
#undef PG8_MMA
#undef PG8_WAIT_V
#undef PG8_WAIT_L
#undef PG8_BAR
#undef PG8_SCHED
}
}
#ifndef PG8_SP2
#define PG8_SP2 true
#endif
#ifndef PG8_ALIGN
#define PG8_ALIGN true
#endif
#ifndef MK_PER_PHASE
#define MK_PER_PHASE 0
#endif

constexpr int DM = 1024, FF = 4096;
constexpr int LP = 256, BP = 16, LS = 4096, BS = 2, PAST = 256;
constexpr int NP = BP * LP;
constexpr int NSR = BS * LS;
constexpr int MT = NP + NSR;
constexpr int MKV = MT + BS * PAST;
constexpr int LKS = LS + PAST;
constexpr int HY = 512, NH = 4, DQK = 192, DNOPE = 128, DROPE = 64, DVH = 128, QL = 256, KVL = 128;
constexpr int WINP = 2048;
constexpr float LN_EPS = 1e-5f, RMS_EPS = 1e-6f, ALPHA = 1.41421356237309515f;
constexpr int NPHASE = 17;

constexpr int att_shm_bytes = 2 * 16384 + 2 * 24576 + 2048 + 8 * 8 * 1024;
constexpr size_t MiB = 1u << 20, KiB = 1024;
constexpr size_t WS_CTL = 0, CTL_ZERO_BYTES = 1 * MiB;
constexpr size_t WS_MODS = 1 * MiB;
constexpr size_t WS_D256 = 1 * MiB + 256 * KiB;
constexpr size_t WS_H2B = 86 * MiB, WS_W3T = 89 * MiB;
constexpr size_t WS_FPART_S = 3 * MiB;
constexpr size_t WS_FPART_P = 3 * MiB + 256 * KiB;
constexpr size_t WS_STATS = 3 * MiB + 512 * KiB;
constexpr size_t WS_WIN_T = 4 * MiB, WS_QUP_T = 8 * MiB, WS_KVUP_T = 8 * MiB + 512 * KiB, WS_WOUT0_T = 9 * MiB;
constexpr size_t WS_W1_0 = 11 * MiB, WS_W2_0 = 19 * MiB, WS_W1_1 = 27 * MiB, WS_W2_1 = 35 * MiB, WS_WFOLD_T = 43 * MiB;
constexpr size_t WS_T = 48 * MiB;
constexpr size_t WS_FT_S = 48 * MiB, WS_FT_P = 64 * MiB, WS_UT_S = 65 * MiB, WS_UT_P = 73 * MiB;
constexpr size_t WS_W1T = 80 * MiB, WS_CBD = 82 * MiB;
constexpr size_t WS_D4096 = 96 * MiB;
constexpr size_t WS_KF_S = 96 * MiB, WS_KF_P = 109 * MiB, WS_V_S = 115 * MiB, WS_V_P = 124 * MiB;
constexpr size_t WS_H = 128 * MiB;
constexpr size_t WS_P = 152 * MiB, WS_ZS = 188 * MiB, WS_QN = 212 * MiB, WS_KVN = 218 * MiB, WS_Q = 225 * MiB, WS_X0 = 243 * MiB;
constexpr size_t WS_HID = 152 * MiB, WS_UV = 152 * MiB;
constexpr size_t WS_END = 256 * MiB;
constexpr int CW_TMO = 0, CW_Q = 64, CW_BAR = 4096, CW_ATT = 16384, CW_SPLIT = 32768;
constexpr size_t WS_APART = 152 * MiB; constexpr int APART_F = 8 * 4 * 16 * 64 + 8 * 128;

constexpr int RING_BYTES = 131072, LDSCTL_OFF = 160 * 1024 - 512, MISC_OFF = LDSCTL_OFF + 320, LDS_BYTES = 160 * 1024;
static_assert(att_shm_bytes <= LDSCTL_OFF, "attention scratch fits below the LDS control words");

#define GAS __attribute__((address_space(1)))
#define LAS __attribute__((address_space(3)))
typedef unsigned short bf16;
typedef unsigned v4u __attribute__((ext_vector_type(4)));
typedef unsigned v2u __attribute__((ext_vector_type(2)));
typedef float f32x4 __attribute__((ext_vector_type(4)));
typedef GAS unsigned gu32;
#define RLX_AGENT __ATOMIC_RELAXED, __HIP_MEMORY_SCOPE_AGENT
#define LDS_WAIT() asm volatile("s_waitcnt lgkmcnt(0)" ::: "memory")
__device__ __forceinline__ unsigned f2bf(float f) { unsigned u = __builtin_bit_cast(unsigned, f); return (u + 0x7fffu + ((u >> 16) & 1u)) >> 16; }
__device__ __forceinline__ unsigned pk2(float lo, float hi) { return f2bf(lo) | (f2bf(hi) << 16); }
__device__ __forceinline__ float bf2f(unsigned short b) { return __builtin_bit_cast(float, (unsigned)b << 16); }
__device__ __forceinline__ float wave_sum(float v) {
#pragma unroll
    for (int o = 1; o < 64; o <<= 1) v += __shfl_xor(v, o);
    return v;
}
__device__ __forceinline__ float fsin_rev(float rev) { return __builtin_amdgcn_sinf(__builtin_amdgcn_fractf(rev)); }
__device__ __forceinline__ float fcos_rev(float rev) { return __builtin_amdgcn_cosf(__builtin_amdgcn_fractf(rev)); }
constexpr float INV_2PI = 0.15915494309189535f;
__device__ __forceinline__ float fexp(float x) { return __builtin_amdgcn_exp2f(x * 1.4426950408889634f); }

__device__ __forceinline__ int fresh_lane() { int l; asm volatile("v_mbcnt_lo_u32_b32 %0, -1, 0\n\tv_mbcnt_hi_u32_b32 %0, -1, %0" : "=v"(l)); return l; }
#define XB_TMO      128
#define XB_XCNT(j)  (256  + 64 * (j))
#define XB_XSUB(j)  (1280 + 64 * (j))
#define XB_XGEN(j)  (2304 + 64 * (j))
#define XB_TOP      3328
#define XB_TOPGEN   3392
#define XCD_BAR_WORDS 3456
#define XB_SPIN_CAP (1u << 23)
__device__ __forceinline__ unsigned xb_ld(unsigned* p)              { return __hip_atomic_load(p, __ATOMIC_RELAXED, __HIP_MEMORY_SCOPE_AGENT); }
__device__ __forceinline__ unsigned xb_add(unsigned* p, unsigned v) { return __hip_atomic_fetch_add(p, v, __ATOMIC_RELAXED, __HIP_MEMORY_SCOPE_AGENT); }
__device__ __forceinline__ unsigned xb_xcc_id() { return (unsigned)__builtin_amdgcn_s_getreg((3 << 11) | 20) & 0xFu; }
#define XB_SPIN(cond, bar) do { unsigned _sp = 0; while (cond) { __builtin_amdgcn_s_sleep(1); \
    if ((++_sp & 255u) == 0u) { if (xb_ld(&(bar)[XB_TMO])) break; if (_sp > XB_SPIN_CAP) { atomicAdd(&(bar)[XB_TMO], 1u); break; } } } } while (0)
struct XcdBarrier { unsigned* bar; unsigned x; volatile LAS unsigned* st; };
__device__ __forceinline__ XcdBarrier xcd_barrier_post(unsigned* bar, volatile LAS unsigned* st) {
    XcdBarrier b; b.bar = bar; b.x = xb_xcc_id(); b.st = st;
    if (threadIdx.x == 0) (void)xb_add(&bar[XB_XCNT(b.x)], 1u);
    return b;
}
__device__ __forceinline__ void xcd_barrier_complete(unsigned* bar, unsigned x, unsigned& nloc, unsigned& nx) {
    const unsigned G = gridDim.x * gridDim.y * gridDim.z;
    unsigned sum, cnt, mine, sp = 0u;
    for (;;) {
        sum = 0u; cnt = 0u; mine = 0u;
#pragma unroll
        for (unsigned j = 0; j < 16; ++j) { const unsigned c = xb_ld(&bar[XB_XCNT(j)]); sum += c; cnt += (c > 0u) ? 1u : 0u; mine = (j == x) ? c : mine; }
        if (sum == G) break;
        __builtin_amdgcn_s_sleep(1);
        if ((++sp & 255u) == 0u) { if (xb_ld(&bar[XB_TMO])) break; if (sp > XB_SPIN_CAP) { atomicAdd(&bar[XB_TMO], 1u); break; } }
    }
    nloc = mine > 0u ? mine : 1u; nx = cnt > 0u ? cnt : 1u;
}
__device__ __forceinline__ void xcd_barrier(const XcdBarrier& b) {
    asm volatile("s_waitcnt vmcnt(0)" ::: "memory");
    __syncthreads();
    if (threadIdx.x == 0) {
        unsigned* bar = b.bar;
        __builtin_amdgcn_s_waitcnt(0);
        unsigned nloc = b.st[0], nx = b.st[1];
        if (nloc == 0u) { xcd_barrier_complete(bar, b.x, nloc, nx); b.st[0] = nloc; b.st[1] = nx; }
        const unsigned old = xb_add(&bar[XB_XSUB(b.x)], 1u);
        const unsigned gen = old / nloc;
        if (old + 1u == (gen + 1u) * nloc) {
            __builtin_amdgcn_fence(__ATOMIC_RELEASE, "agent");
            asm volatile("s_waitcnt vmcnt(0)" ::: "memory");
            const unsigned og = xb_add(&bar[XB_TOP], 1u);
            const unsigned tg = og / nx;
            if (og + 1u == (tg + 1u) * nx) xb_add(&bar[XB_TOPGEN], 1u);
            else XB_SPIN(xb_ld(&bar[XB_TOPGEN]) == tg, bar);
            __builtin_amdgcn_fence(__ATOMIC_ACQUIRE, "agent");
            xb_add(&bar[XB_XGEN(b.x)], 1u);
            asm volatile("s_waitcnt vmcnt(0)" ::: "memory");
        } else {
            XB_SPIN(xb_ld(&bar[XB_XGEN(b.x)]) == gen, bar);
            __builtin_amdgcn_fence(__ATOMIC_ACQUIRE, "agent");
            asm volatile("s_waitcnt vmcnt(0)" ::: "memory");
        }
    }
    __syncthreads();
}

struct Args { const float* in[38]; float* out; unsigned char* ws; int ph_lo, ph_hi, li, mask; };
enum { I_XP = 0, I_XS, I_CKV, I_CKR, I_C, I_CCTX, I_ADA0_W, I_ADA0_B, I_WIN, I_CONVW, I_CONVB, I_HFW1, I_HFB1, I_HFFREQ, I_HFW2, I_HFB2, I_HFW3, I_HFSKIP,
       I_QNORM, I_QUP, I_KVNORM, I_KVUP, I_WOUT0, I_LN1G0, I_LN1B0, I_W1_0, I_W2_0, I_LN2G0, I_LN2B0, I_ADA1_W, I_ADA1_B, I_WOUT1, I_LN1G1, I_LN1B1, I_W1_1, I_W2_1, I_LN2G1, I_LN2B1 };
constexpr size_t OUT_CKV = (size_t)MT * DM, OUT_CKR = OUT_CKV + (size_t)NP * KVL;

__device__ __forceinline__ int req_of_row(int m) { return m < NP ? 0 : 1 + (m - NP) / LS; }

using pg8::f32x4; using pg8::Unit; using pg8::BM; using pg8::HALF; using pg8::cvt_pk_bf16;
typedef unsigned u32x4 __attribute__((ext_vector_type(4)));
__device__ __forceinline__ u32x4 pack8(const f32x4& a, const f32x4& b) { u32x4 w; w.x = cvt_pk_bf16(a[0], a[1]); w.y = cvt_pk_bf16(a[2], a[3]); w.z = cvt_pk_bf16(b[0], b[1]); w.w = cvt_pk_bf16(b[2], b[3]); return w; }

#define SLAB_ADD(v, ai, bj, m, n) do { if constexpr (SL) (v) += *(const f32x4*)(slab + ((((ai) * 2 + (bj)) * 4 + (m)) * 2 + (n)) * 256); } while (0)
template <int MF = 4> struct EpiWin {
    static constexpr bool PERM = true, AFTER_DRAIN = false;
    bf16* P; float* ZS;
    template <bool SL> __device__ __forceinline__ void run(const f32x4 (&acc)[2][2][4][2], const Unit& u, int wr, int wc, int fr, int fq, const float* slab) const {
        const int row0 = u.pm * (64 * MF) + wr * (16 * MF) + fr, colt = u.pn * BM + wc * 32 + 8 * fq;
#pragma unroll
        for (int ai = 0; ai < 2; ++ai)
#pragma unroll
            for (int m = 0; m < MF; ++m) { const int row = row0 + ai * (32 * MF) + m * 16;
#pragma unroll
                for (int bj = 0; bj < 2; ++bj) { const int col = colt + bj * HALF; f32x4 a0 = acc[ai][bj][m][0], a1 = acc[ai][bj][m][1]; SLAB_ADD(a0, ai, bj, m, 0); SLAB_ADD(a1, ai, bj, m, 1);
                    if (u.pn < 6) *(u32x4*)(P + (size_t)row * 1536 + col) = pack8(a0, a1);
                    else { float* d = ZS + (size_t)row * 512 + (col - 1536); *(f32x4*)d = a0; *(f32x4*)(d + 4) = a1; } } }
    }
};
struct EpiStore {
    static constexpr bool PERM = true, AFTER_DRAIN = false;
    bf16* O; int ld;
    template <bool SL> __device__ __forceinline__ void run(const f32x4 (&acc)[2][2][4][2], const Unit& u, int wr, int wc, int fr, int fq, const float* slab) const {
        const int row0 = u.pm * BM + wr * 64 + fr, colt = u.pn * BM + wc * 32 + 8 * fq;
#pragma unroll
        for (int ai = 0; ai < 2; ++ai)
#pragma unroll
            for (int m = 0; m < 4; ++m) { const int row = row0 + ai * HALF + m * 16;
#pragma unroll
                for (int bj = 0; bj < 2; ++bj) *(u32x4*)(O + (size_t)row * ld + colt + bj * HALF) = pack8(acc[ai][bj][m][0], acc[ai][bj][m][1]); }
    }
};
struct EpiKV {
    static constexpr bool PERM = true, AFTER_DRAIN = false;
    bf16 *KFs, *KFp, *Vs, *Vp;
    template <bool SL> __device__ __forceinline__ void run(const f32x4 (&acc)[2][2][4][2], const Unit& u, int wr, int wc, int fr, int fq, const float* slab) const {
        const int m0 = u.pm * BM; bf16* kf; bf16* vv; int lk, key0, b;
        if (m0 < NP) { b = m0 / LP; key0 = 0; lk = LP; kf = KFp; vv = Vp; }
        else if (m0 < MT) { b = (m0 - NP) / LS; key0 = (m0 - NP) % LS; lk = LKS; kf = KFs; vv = Vs; }
        else { b = (m0 - MT) / PAST; key0 = LS + (m0 - MT) % PAST; lk = LKS; kf = KFs; vv = Vs; }
        const int h = u.pn;
        int rloc = wr * 64 + fr, c8 = wc * 32 + 8 * fq; asm volatile("" : "+v"(rloc), "+v"(c8));
#pragma unroll
        for (int ai = 0; ai < 2; ++ai)
#pragma unroll
            for (int m = 0; m < 4; ++m) { const int key = key0 + rloc + ai * HALF + m * 16; const size_t kr = (size_t)(b * NH + h) * lk + key;
                *(u32x4*)(kf + kr * DQK + c8) = pack8(acc[ai][0][m][0], acc[ai][0][m][1]);
                *(u32x4*)(vv + kr * DVH + c8) = pack8(acc[ai][1][m][0], acc[ai][1][m][1]); }
    }
};
template <int MF = 4, bool FROM_T = false> struct EpiRes {
    static constexpr bool PERM = false, AFTER_DRAIN = false;
    const float* xp; const float* xs; const float* gate;
    bf16* T; const float* stats; const float* lng; const float* lnb;
    template <bool SL> __device__ __forceinline__ void run(const f32x4 (&acc)[2][2][4][2], const Unit& u, int wr, int wc, int fr, int fq, const float* slab) const {
        const int m0 = u.pm * (64 * MF), row0 = m0 + wr * (16 * MF) + fr, col0 = u.pn * BM + wc * 32 + 4 * fq;
#pragma unroll
        for (int bj = 0; bj < 2; ++bj)
#pragma unroll
            for (int n = 0; n < 2; ++n) { const int col = col0 + bj * HALF + n * 16;
                f32x4 g4, b4; if constexpr (FROM_T) { g4 = *(const f32x4*)(lng + col); b4 = *(const f32x4*)(lnb + col); }
#pragma unroll
                for (int ai = 0; ai < 2; ++ai)
#pragma unroll
                    for (int m = 0; m < MF; ++m) { const int row = row0 + ai * (32 * MF) + m * 16;
                        const f32x4 gg = *(const f32x4*)(gate + (size_t)req_of_row(row) * 6144 + col);
                        f32x4 xv;
                        if constexpr (FROM_T) { const v2u w = *(const v2u*)(T + (size_t)row * DM + col); const float mean = stats[2 * row], rstd = stats[2 * row + 1];
                            const f32x4 t = {bf2f((unsigned short)(w.x & 0xffffu)), bf2f((unsigned short)(w.x >> 16)), bf2f((unsigned short)(w.y & 0xffffu)), bf2f((unsigned short)(w.y >> 16))};
                            xv = (t - mean) * rstd * g4 + b4; }
                        else { const float* xr = (row < NP) ? xp + (size_t)row * DM : xs + (size_t)(row - NP) * DM; xv = *(const f32x4*)(xr + col); }
                        f32x4 a = acc[ai][bj][m][n]; SLAB_ADD(a, ai, bj, m, n);
                        const f32x4 t2 = xv * ALPHA + gg * a; v2u o; o.x = cvt_pk_bf16(t2[0], t2[1]); o.y = cvt_pk_bf16(t2[2], t2[3]); *(v2u*)(T + (size_t)row * DM + col) = o; } }
    }
};
struct EpiUp {
    static constexpr bool PERM = true, AFTER_DRAIN = false;
    bf16* H;
    template <bool SL> __device__ __forceinline__ void run(const f32x4 (&acc)[2][2][4][2], const Unit& u, int wr, int wc, int fr, int fq, const float* slab) const {
        const int row0 = u.pm * BM + wr * 64 + fr, colt = u.pn * BM + wc * 32 + 8 * fq;
#pragma unroll
        for (int ai = 0; ai < 2; ++ai)
#pragma unroll
            for (int m = 0; m < 4; ++m) { const int row = row0 + ai * HALF + m * 16;
#pragma unroll
                for (int bj = 0; bj < 2; ++bj) { f32x4 a = acc[ai][bj][m][0], b = acc[ai][bj][m][1];
#pragma unroll
                    for (int e = 0; e < 4; ++e) { const float x = fmaxf(a[e], 0.f), y = fmaxf(b[e], 0.f); a[e] = x * x; b[e] = y * y; }
                    *(u32x4*)(H + (size_t)row * FF + colt + bj * HALF) = pack8(a, b); } }
    }
};
struct EpiFilt {
    static constexpr bool PERM = true, AFTER_DRAIN = false;
    bf16* GRB; float* FTP; float* FPS; float* FPP;
    template <bool SL> __device__ __forceinline__ void run(const f32x4 (&acc)[2][2][4][2], const Unit& u, int wr, int wc, int fr, int fq, const float* slab) const {
        int rl = wr * 64 + fr, clb = wc * 32 + 8 * fq; asm volatile("" : "+v"(rl), "+v"(clb));
        const bool smp = u.pm < 16; const int L = smp ? LS : LP; const float invL1 = 1.f / (float)(L - 1);
#pragma unroll
        for (int bj = 0; bj < 2; ++bj) { const int col0 = u.pn * BM + bj * HALF + clb;
            float asum[8];
#pragma unroll
            for (int e = 0; e < 8; ++e) asum[e] = 0.f;
#pragma unroll
            for (int ai = 0; ai < 2; ++ai)
#pragma unroll
                for (int m = 0; m < 4; ++m) { const int l = (smp ? u.pm * BM : 0) + rl + ai * HALF + m * 16; const float t = (float)l * invL1;
                    const f32x4 a0 = acc[ai][bj][m][0], a1 = acc[ai][bj][m][1]; const float av[8] = {a0[0], a0[1], a0[2], a0[3], a1[0], a1[1], a1[2], a1[3]};
#pragma unroll
                    for (int e = 0; e < 8; ++e) { const int col = col0 + e, ch = col & 511, half = col >> 9;
                        const float delta = fabsf(-3.0701134573253944f + (float)ch * ((-15.350567286626973f + 3.0701134573253944f) / 511.0f));
                        const float val = av[e] * fexp(-t * delta); asum[e] += fabsf(val);
                        if (smp) { bf16* g = GRB + (size_t)ch * 8192; if (half == 0) g[LS - l] = (bf16)f2bf(val); else g[l == 0 ? 0 : LS + l] = (bf16)(l == 0 ? 0u : f2bf(val)); }
                        else FTP[(size_t)col * LP + l] = val; } }
#pragma unroll
            for (int e = 0; e < 8; ++e) { float v = asum[e]; v += __shfl_xor(v, 1); v += __shfl_xor(v, 2); v += __shfl_xor(v, 4); v += __shfl_xor(v, 8); asum[e] = v; }
            if (fr == 0) {
#pragma unroll
                for (int e = 0; e < 8; ++e) { const int col = col0 + e; if (smp) FPS[col * 32 + u.pm * 2 + wr] = asum[e]; else FPP[col * 2 + wr] = asum[e]; } }
        }
    }
};
struct EpiDft {
    static constexpr bool PERM = true, AFTER_DRAIN = false;
    bf16* UV; int L, tokbase;
    template <bool SL> __device__ __forceinline__ void run(const f32x4 (&acc)[2][2][4][2], const Unit& u, int wr, int wc, int fr, int fq, const float* slab) const {
        int rl = wr * 64 + fr, cl = wc * 32 + 8 * fq; asm volatile("" : "+v"(rl), "+v"(cl));
        const int rho0 = u.pm * BM + rl, n0 = u.pn * BM + cl, hl = L >> 1;
#pragma unroll
        for (int ai = 0; ai < 2; ++ai)
#pragma unroll
            for (int m = 0; m < 4; ++m) { const int rho = rho0 + ai * HALF + m * 16; const int part = rho > hl ? 1 : 0; const int k = part ? rho - hl : rho;
#pragma unroll
                for (int bj = 0; bj < 2; ++bj) { const int n = n0 + bj * HALF, b = n >> 10, c = n & 1023;
                    f32x4 a0 = acc[ai][bj][m][0], a1 = acc[ai][bj][m][1]; SLAB_ADD(a0, ai, bj, m, 0); SLAB_ADD(a1, ai, bj, m, 1);
                    bf16* r1 = UV + (size_t)(tokbase + b * L + k) * 2048 + part * 1024 + c;
                    *(u32x4*)r1 = pack8(a0, a1);
                    if (k != 0 && k != hl) { bf16* r2 = UV + (size_t)(tokbase + b * L + (L - k)) * 2048 + part * 1024 + c;
                        *(u32x4*)r2 = part ? pack8(-a0, -a1) : pack8(a0, a1); }
                    else if (part == 0) { unsigned zz = 0u; asm volatile("" : "+v"(zz)); *(u32x4*)(r1 + 1024) = (u32x4){zz, zz, zz, zz}; } } }
    }
};

namespace att {
using bf16x8 = __attribute__((ext_vector_type(8))) short;
using s16x4  = __attribute__((ext_vector_type(4))) short;
using f32x16 = __attribute__((ext_vector_type(16))) float;
constexpr int DK = 192, DV = 128, NW = 8, QBLK = 32, KVBLK = 64;
constexpr float SCALE = 0.07216878364870322f;
constexpr float THR = 8.f;
constexpr int SHM_V = KVBLK * DV * 2, SHM_K = KVBLK * DK * 2, SHM_QR = 2 * SHM_V + 2 * SHM_K + NW * 64 * 4, NQR = 4  , SHM_ATTN = SHM_QR + NW * (12 - NQR) * 1024;
#define KSWZ(row, colB) ((row) * 384 + ((colB) ^ (((row) & 7) << 4)))
#define SBAR() __builtin_amdgcn_sched_barrier(0)
__device__ __forceinline__ int crow(int r, int hi) { return (r & 3) + 8 * (r >> 2) + 4 * hi; }
__device__ __forceinline__ unsigned cvtpk(float lo, float hi) { unsigned r; asm volatile("v_cvt_pk_bf16_f32 %0, %1, %2" : "=v"(r) : "v"(lo), "v"(hi)); return r; }
__device__ __forceinline__ void partialSM(f32x16& p0, f32x16& p1, float& m_reg, float& mn, float& alpha) {
  constexpr float C = SCALE * 1.4426950408889634f;
  float pmax = p0[0];
#pragma unroll
  for (int r = 1; r < 16; ++r) pmax = fmaxf(pmax, p0[r]);
#pragma unroll
  for (int r = 0; r < 16; ++r) pmax = fmaxf(pmax, p1[r]);
  { auto rr = __builtin_amdgcn_permlane32_swap(__float_as_uint(pmax), __float_as_uint(pmax), false, false);
    pmax = fmaxf(__uint_as_float(rr[0]), __uint_as_float(rr[1])); }
  if (__builtin_expect(__all(pmax - m_reg <= THR / SCALE), 1)) { mn = m_reg; alpha = 1.f; }
  else { mn = fmaxf(m_reg, pmax); alpha = __builtin_amdgcn_exp2f((m_reg - mn) * C); m_reg = mn; }
  float mnC = -mn * C;
#pragma unroll
  for (int r = 0; r < 16; ++r) p0[r] = fmaf(p0[r], C, mnC);
#pragma unroll
  for (int r = 0; r < 16; ++r) p1[r] = fmaf(p1[r], C, mnC);
#pragma unroll
  for (int r = 0; r < 16; ++r) p0[r] = __builtin_amdgcn_exp2f(p0[r]);
}
__device__ __forceinline__ void finishSM(f32x16& p0, f32x16& p1, float alpha, float& l_reg, bf16x8& pa0, bf16x8& pa1, bf16x8& pa2, bf16x8& pa3) {
#pragma unroll
  for (int r = 0; r < 16; ++r) p1[r] = __builtin_amdgcn_exp2f(p1[r]);
  float ps = 0;
#pragma unroll
  for (int r = 0; r < 16; ++r) ps += p0[r];
#pragma unroll
  for (int r = 0; r < 16; ++r) ps += p1[r];
  { auto rr = __builtin_amdgcn_permlane32_swap(__float_as_uint(ps), __float_as_uint(ps), false, false);
    ps = __uint_as_float(rr[0]) + __uint_as_float(rr[1]); }
  l_reg = l_reg * alpha + ps;
#define PK4(P, BASE, OUT) do { unsigned a0 = cvtpk(P[BASE + 0], P[BASE + 1]), a1 = cvtpk(P[BASE + 2], P[BASE + 3]);   \
    unsigned b0 = cvtpk(P[BASE + 4], P[BASE + 5]), b1 = cvtpk(P[BASE + 6], P[BASE + 7]);                              \
    auto r0 = __builtin_amdgcn_permlane32_swap(a0, b0, false, false); auto r1 = __builtin_amdgcn_permlane32_swap(a1, b1, false, false); \
    u32x4 w = {r0[0], r1[0], r0[1], r1[1]}; OUT = __builtin_bit_cast(bf16x8, w); } while (0)
  PK4(p0, 0, pa0); PK4(p0, 8, pa1); PK4(p1, 0, pa2); PK4(p1, 8, pa3);
#undef PK4
}
__device__ __forceinline__ void qkt(f32x16& p0, f32x16& p1, const LAS char* Ks, const bf16x8* qr, const LAS char* qrl, int r32, int hi) {
  p0 = f32x16{}; p1 = f32x16{};
#pragma unroll
  for (int d0 = 0; d0 < 12; ++d0) { const int cb = (d0 * 16 + hi * 8) * 2;
    bf16x8 b0 = *reinterpret_cast<const LAS bf16x8*>(Ks + KSWZ(r32, cb));
    bf16x8 b1 = *reinterpret_cast<const LAS bf16x8*>(Ks + KSWZ(32 + r32, cb));
    const bf16x8 qf = d0 < NQR ? qr[d0 < NQR ? d0 : 0] : *reinterpret_cast<const LAS bf16x8*>(qrl + (d0 - NQR) * 1024);
    p0 = __builtin_amdgcn_mfma_f32_32x32x16_bf16(b0, qf, p0, 0, 0, 0);
    p1 = __builtin_amdgcn_mfma_f32_32x32x16_bf16(b1, qf, p1, 0, 0, 0); }
}
__device__ __forceinline__ int v_st(int k, int c) { const int kk = (k & ~0xC) | ((k & 4) << 1) | ((k & 8) >> 1); return ((kk >> 3) * 4 + (c >> 5)) * 512 + ((kk & 7) * 32 + (c & 31)) * 2; }
__device__ __forceinline__ int v_rd_base(int lane) { return ((lane & 3) << 3) | (((lane >> 2) & 3) << 6) | (((lane >> 4) & 1) << 5) | (((lane >> 5) & 1) << 8); }
constexpr int v_rd_off(int d0, int ks, int half) { return d0 * 512 + ks * 4096 + half * 2048; }
template <int OFF> __device__ __forceinline__ s16x4 tr_read(int vb) {
  s16x4 r; asm volatile("ds_read_b64_tr_b16 %0, %1 offset:%2" : "=&v"(r) : "v"(vb), "i"(OFF) : "memory"); return r;
}
template <int D0> __device__ __forceinline__ void pv_one(f32x16& od, int vb, bf16x8 pa0, bf16x8 pa1, bf16x8 pa2, bf16x8 pa3) {
  const s16x4 l0 = tr_read<v_rd_off(D0, 0, 0)>(vb), h0 = tr_read<v_rd_off(D0, 0, 1)>(vb), l1 = tr_read<v_rd_off(D0, 1, 0)>(vb), h1 = tr_read<v_rd_off(D0, 1, 1)>(vb);
  const s16x4 l2 = tr_read<v_rd_off(D0, 2, 0)>(vb), h2 = tr_read<v_rd_off(D0, 2, 1)>(vb), l3 = tr_read<v_rd_off(D0, 3, 0)>(vb), h3 = tr_read<v_rd_off(D0, 3, 1)>(vb);
  asm volatile("s_waitcnt lgkmcnt(0)" ::: "memory"); SBAR();
#define PK(L, H) (bf16x8){L[0], L[1], L[2], L[3], H[0], H[1], H[2], H[3]}
  od = __builtin_amdgcn_mfma_f32_32x32x16_bf16(pa0, PK(l0, h0), od, 0, 0, 0);
  od = __builtin_amdgcn_mfma_f32_32x32x16_bf16(pa1, PK(l1, h1), od, 0, 0, 0);
  od = __builtin_amdgcn_mfma_f32_32x32x16_bf16(pa2, PK(l2, h2), od, 0, 0, 0);
  od = __builtin_amdgcn_mfma_f32_32x32x16_bf16(pa3, PK(l3, h3), od, 0, 0, 0);
#undef PK
}
__device__ __forceinline__ void pv_d0(f32x16* o, int vb, bf16x8 pa0, bf16x8 pa1, bf16x8 pa2, bf16x8 pa3) {
  pv_one<0>(o[0], vb, pa0, pa1, pa2, pa3); pv_one<1>(o[1], vb, pa0, pa1, pa2, pa3); pv_one<2>(o[2], vb, pa0, pa1, pa2, pa3); pv_one<3>(o[3], vb, pa0, pa1, pa2, pa3);
}
constexpr int LDQ = 768, LDK = DK, LDV = DV, LDO = 1024;
__device__ __forceinline__ void attn_dense_body(const bf16* __restrict__ Qb, const bf16* __restrict__ Kh, const bf16* __restrict__ Vh, bf16* __restrict__ Ob, int seq, int pos0, LAS char* lds, const int tid, float* part, unsigned* cnt, volatile LAS unsigned* misc) {
  const int wid = tid >> 6, lane = tid & 63, r32 = lane & 31, hi = lane >> 5;
  LAS char* V_lds = lds; LAS char* K_lds = lds + 2 * SHM_V;
  LAS float* ws = (LAS float*)(lds + 2 * SHM_V + 2 * SHM_K) + wid * 64; LAS float* li_l = ws; LAS float* al_l = ws + 32;
  float m_reg = -1e30f, l_reg = 0; f32x16 o[4] = {}; bf16x8 qr[NQR];
  const LAS char* qrl = lds + SHM_QR + wid * (12 - NQR) * 1024 + lane * 16;
  const bf16* Qw = Qb + (long)(wid * QBLK + r32) * LDQ + hi * 8;
#pragma unroll
  for (int d0 = 0; d0 < NQR; ++d0) qr[d0] = *reinterpret_cast<const bf16x8*>(Qw + d0 * 16);
  LAS char* qw = lds + SHM_QR + wid * (12 - NQR) * 1024 + lane * 16;
#pragma unroll
  for (int d0 = NQR; d0 < 8; ++d0) *(LAS bf16x8*)(qw + (d0 - NQR) * 1024) = *reinterpret_cast<const bf16x8*>(Qw + d0 * 16);
  {
    bf16x8 f0 = *reinterpret_cast<const bf16x8*>(Qw + 128), f1 = *reinterpret_cast<const bf16x8*>(Qw + 144), f2 = *reinterpret_cast<const bf16x8*>(Qw + 160), f3 = *reinterpret_cast<const bf16x8*>(Qw + 176);
    if (pos0 >= 0) { const int pos = pos0 + wid * QBLK + r32; const float pr = (float)(pos >> 6), pc = (float)(pos & 63);
#pragma unroll
      for (int i = 0; i < 8; ++i) { const float inv = __builtin_amdgcn_exp2f(-(float)(8 * hi + i) * (13.287712379549449f / 16.0f));
        { const float rev = pr * inv * INV_2PI, cs = fcos_rev(rev), sn = fsin_rev(rev); const float a = bf2f((unsigned short)f0[i]), b = bf2f((unsigned short)f1[i]);
          f0[i] = (short)f2bf(a * cs - b * sn); f1[i] = (short)f2bf(b * cs + a * sn); }
        { const float rev = pc * inv * INV_2PI, cs = fcos_rev(rev), sn = fsin_rev(rev); const float a = bf2f((unsigned short)f2[i]), b = bf2f((unsigned short)f3[i]);
          f2[i] = (short)f2bf(a * cs - b * sn); f3[i] = (short)f2bf(b * cs + a * sn); } } }
    *(LAS bf16x8*)(qw + (8 - NQR) * 1024) = f0; *(LAS bf16x8*)(qw + (9 - NQR) * 1024) = f1; *(LAS bf16x8*)(qw + (10 - NQR) * 1024) = f2; *(LAS bf16x8*)(qw + (11 - NQR) * 1024) = f3;
  }
  const int sr = tid >> 4, sc = (tid & 15) * 8, vst0 = v_st(sr, sc), vst1 = v_st(32 + sr, sc);
  const int kr = tid >> 3, kc = tid & 7, kgo = kr * LDK + kc * 8, kst = KSWZ(kr, kc * 16);
  const int vb0 = (int)(unsigned)(uintptr_t)V_lds + v_rd_base(lane);
  bf16x8 vs0, vs1, ks0, ks1, ks2;
#define SLOAD(k0) do { vs0 = *reinterpret_cast<const bf16x8*>(&Vh[(long)((k0) + sr) * LDV + sc]); vs1 = *reinterpret_cast<const bf16x8*>(&Vh[(long)((k0) + 32 + sr) * LDV + sc]); \
    ks0 = *reinterpret_cast<const bf16x8*>(&Kh[(long)(k0) * LDK + kgo]); ks1 = *reinterpret_cast<const bf16x8*>(&Kh[(long)(k0) * LDK + kgo + 64]); \
    ks2 = *reinterpret_cast<const bf16x8*>(&Kh[(long)(k0) * LDK + kgo + 128]); } while (0)
#define SWRITE(b) do { *(LAS bf16x8*)(V_lds + (b) * SHM_V + vst0) = vs0; *(LAS bf16x8*)(V_lds + (b) * SHM_V + vst1) = vs1; \
    *(LAS bf16x8*)(K_lds + (b) * SHM_K + kst) = ks0; *(LAS bf16x8*)(K_lds + (b) * SHM_K + kst + 128) = ks1; *(LAS bf16x8*)(K_lds + (b) * SHM_K + kst + 256) = ks2; } while (0)
#define SWAIT() asm volatile("s_waitcnt vmcnt(0)" ::: "memory")
#define RESC(a) do { if (__any((a) < 1.f)) { if (hi == 0) al_l[r32] = (a); asm volatile("s_waitcnt lgkmcnt(0)" ::: "memory"); \
    _Pragma("unroll") for (int d = 0; d < 4; ++d) _Pragma("unroll") for (int r = 0; r < 16; ++r) o[d][r] *= al_l[crow(r, hi)]; } } while (0)
  f32x16 pA0, pA1, pB0, pB1; float mnA, mnB, alA, alB; bf16x8 pa0, pa1, pa2, pa3; const int NT = seq / KVBLK;
  SLOAD(0); SWAIT(); SWRITE(0); __syncthreads();
  qkt(pA0, pA1, K_lds, qr, qrl, r32, hi); partialSM(pA0, pA1, m_reg, mnA, alA);
  SLOAD(KVBLK);
  SWAIT(); SWRITE(1); __syncthreads();
  for (int j = 1; j + 1 < NT; j += 2) {
    SBAR(); qkt(pB0, pB1, K_lds + SHM_K, qr, qrl, r32, hi);
    finishSM(pA0, pA1, alA, l_reg, pa0, pa1, pa2, pa3); SBAR();
    SLOAD((j + 1) * KVBLK); SBAR();
    pv_d0(o, vb0, pa0, pa1, pa2, pa3); partialSM(pB0, pB1, m_reg, mnB, alB);
    __syncthreads(); SWAIT(); SWRITE(0);
    RESC(alB); __syncthreads();
    SBAR(); qkt(pA0, pA1, K_lds, qr, qrl, r32, hi);
    finishSM(pB0, pB1, alB, l_reg, pa0, pa1, pa2, pa3); SBAR();
    SLOAD((j + 2) * KVBLK); SBAR();
    pv_d0(o, vb0 + SHM_V, pa0, pa1, pa2, pa3); partialSM(pA0, pA1, m_reg, mnA, alA);
    __syncthreads(); SWAIT(); SWRITE(1);
    RESC(alA); __syncthreads();
  }
  SBAR(); qkt(pB0, pB1, K_lds + SHM_K, qr, qrl, r32, hi);
  finishSM(pA0, pA1, alA, l_reg, pa0, pa1, pa2, pa3); SBAR();
  pv_d0(o, vb0, pa0, pa1, pa2, pa3); partialSM(pB0, pB1, m_reg, mnB, alB);
  __syncthreads(); RESC(alB);
  finishSM(pB0, pB1, alB, l_reg, pa0, pa1, pa2, pa3); SBAR();
  pv_d0(o, vb0 + SHM_V, pa0, pa1, pa2, pa3);
  bf16* Ow = Ob + (long)(wid * QBLK) * LDO;
  bool write_out = true; float g1 = 1.f;
  if (part) {
    if (tid == 0) misc[1] = __hip_atomic_fetch_add(cnt, 1u, __ATOMIC_RELAXED, __HIP_MEMORY_SCOPE_AGENT);
    __syncthreads();
    const unsigned ticket = misc[1];
    float* po = part + (size_t)wid * (4 * 16 * 64) + lane * 4; float* pml = part + 8 * 4 * 16 * 64 + wid * 128 + lane;
    if (ticket == 0u) {
#pragma unroll
      for (int d0 = 0; d0 < 4; ++d0)
#pragma unroll
        for (int r4 = 0; r4 < 4; ++r4) { const f32x4 v = {o[d0][4 * r4], o[d0][4 * r4 + 1], o[d0][4 * r4 + 2], o[d0][4 * r4 + 3]}; const float* p = po + (d0 * 4 + r4) * 256;
          asm volatile("global_store_dwordx4 %0, %1, off sc1\n\ts_nop 1" :: "v"(p), "v"(v) : "memory"); }
      __hip_atomic_store((unsigned*)pml, __float_as_uint(m_reg), __ATOMIC_RELAXED, __HIP_MEMORY_SCOPE_AGENT); __hip_atomic_store((unsigned*)pml + 64, __float_as_uint(l_reg), __ATOMIC_RELAXED, __HIP_MEMORY_SCOPE_AGENT);
      asm volatile("s_waitcnt vmcnt(0)" ::: "memory"); __syncthreads();
      if (tid == 0) __hip_atomic_store(cnt + 1, 1u, __ATOMIC_RELAXED, __HIP_MEMORY_SCOPE_AGENT);
      write_out = false;
    } else {
      if (tid == 0) { unsigned sp = 0; while (__hip_atomic_load(cnt + 1, __ATOMIC_RELAXED, __HIP_MEMORY_SCOPE_AGENT) == 0u) { __builtin_amdgcn_s_sleep(2); if (++sp > (1u << 22)) break; }
        __builtin_amdgcn_fence(__ATOMIC_ACQUIRE, "agent"); asm volatile("s_waitcnt vmcnt(0)" ::: "memory"); }
      __syncthreads();
      constexpr float C = SCALE * 1.4426950408889634f;
      const float m2 = pml[0], l2 = pml[64]; const float mn = fmaxf(m_reg, m2);
      const float f1 = __builtin_amdgcn_exp2f((m_reg - mn) * C), f2 = __builtin_amdgcn_exp2f((m2 - mn) * C); const float il = __builtin_amdgcn_rcpf(l_reg * f1 + l2 * f2);
      if (hi == 0) { li_l[r32] = f1 * il; al_l[r32] = f2 * il; } asm volatile("s_waitcnt lgkmcnt(0)" ::: "memory");
#pragma unroll
      for (int r4 = 0; r4 < 4; ++r4)
#pragma unroll
        for (int d0 = 0; d0 < 4; ++d0) { const f32x4 pv = *(const f32x4*)(po + (d0 * 4 + r4) * 256);
#pragma unroll
          for (int e = 0; e < 4; ++e) { const int r = 4 * r4 + e; o[d0][r] = o[d0][r] * li_l[crow(r, hi)] + pv[e] * al_l[crow(r, hi)]; } }
      g1 = 0.f;
    }
  }
  if (write_out) {
    if (g1 != 0.f) {
      if (hi == 0) li_l[r32] = l_reg; asm volatile("s_waitcnt lgkmcnt(0)" ::: "memory");
#pragma unroll
      for (int r = 0; r < 16; ++r) { const float rl = __builtin_amdgcn_rcpf(li_l[crow(r, hi)]);
#pragma unroll
        for (int d0 = 0; d0 < 4; ++d0) o[d0][r] *= rl; }
    }
#pragma unroll
    for (int r = 0; r < 16; ++r) { const int orow = crow(r, hi);
#pragma unroll
      for (int d0 = 0; d0 < 4; ++d0) Ow[(long)orow * LDO + d0 * 32 + r32] = (bf16)f2bf(o[d0][r]); }
  }
  __syncthreads();
#undef SLOAD
#undef SWRITE
#undef SWAIT
#undef RESC
}
#undef KSWZ
#undef SBAR
}
__device__ __forceinline__ void transpose_item(const float* W, int K, int N, bf16* WT, int ldk, LAS float* scr, int item, int lane) {
    const int nblk = N / 32, kb = item / nblk, nb = item % nblk, k0 = 64 * kb, n0 = 32 * nb;
#pragma unroll
    for (int i = 0; i < 32; ++i) { const int kk = 2 * i + (lane >> 5); scr[kk * 33 + (lane & 31)] = W[(size_t)(k0 + kk) * N + n0 + (lane & 31)]; }
    LDS_WAIT(); asm volatile("" ::: "memory");
    const int c = lane & 7;
#pragma unroll
    for (int j = 0; j < 4; ++j) { const int n = (lane >> 3) + 8 * j; const LAS float* s = scr + (8 * c) * 33 + n;
        v4u o; o.x = pk2(s[0 * 33], s[1 * 33]); o.y = pk2(s[2 * 33], s[3 * 33]); o.z = pk2(s[4 * 33], s[5 * 33]); o.w = pk2(s[6 * 33], s[7 * 33]);
        *(v4u*)(WT + (size_t)(n0 + n) * ldk + k0 + 8 * c) = o; }
    LDS_WAIT(); asm volatile("" ::: "memory");
}
constexpr int WI_L0 = 992 + 96 + 64 + 512 + 2 * 2048 + 512 + 32, WI_ALL = WI_L0 + 2 * 2048;
__device__ __forceinline__ void weight_item(const Args& args, unsigned char* ws, LAS float* scr, int idx, int lane) {
    constexpr int I0 = 992, I1 = 96, I2 = 64, I3 = 512, I4 = 2048;
    int r = idx, K, N, ldk; size_t off; const float* W;
    if (r < I0) { W = args.in[I_WIN]; K = 1024; N = 1984; ldk = 1024; off = WS_WIN_T; }
    else if ((r -= I0) < I1) { W = args.in[I_QUP]; K = 256; N = 768; ldk = 256; off = WS_QUP_T; }
    else if ((r -= I1) < I2) { W = args.in[I_KVUP]; K = 128; N = 1024; ldk = 256; off = WS_KVUP_T; }
    else if ((r -= I2) < I3) { W = args.in[I_WOUT0]; K = 1024; N = 1024; ldk = 1024; off = WS_WOUT0_T; }
    else if ((r -= I3) < I4) { W = args.in[I_W1_0]; K = 1024; N = 4096; ldk = 1024; off = WS_W1_0; }
    else if ((r -= I4) < I4) { W = args.in[I_W2_0]; K = 4096; N = 1024; ldk = 4096; off = WS_W2_0; }
    else if ((r -= I4) < I3) { W = args.in[I_WOUT1]; K = 1024; N = 1024; ldk = 1024; off = WS_W1T; }
    else if ((r -= I3) < 32) { W = args.in[I_HFW3]; K = 64; N = 1024; ldk = 256; off = WS_W3T; }
    else if ((r -= 32) < I4) { W = args.in[I_W1_1]; K = 1024; N = 4096; ldk = 1024; off = WS_W1_1; }
    else { r -= I4; W = args.in[I_W2_1]; K = 4096; N = 1024; ldk = 4096; off = WS_W2_1; }
    transpose_item(W, K, N, (bf16*)(ws + off), ldk, scr, r, lane);
}
__device__ __forceinline__ void row_stats(const f32x4 (&v)[4], float& mean, float& rstd) {
    float s = 0.f;
#pragma unroll
    for (int j = 0; j < 4; ++j) s += (v[j][0] + v[j][1]) + (v[j][2] + v[j][3]);
    mean = wave_sum(s) * (1.f / DM); float q = 0.f;
#pragma unroll
    for (int j = 0; j < 4; ++j) { const f32x4 d = v[j] - mean; q += (d[0] * d[0] + d[1] * d[1]) + (d[2] * d[2] + d[3] * d[3]); }
    rstd = __builtin_amdgcn_rsqf(wave_sum(q) * (1.f / DM) + LN_EPS);
}
__device__ __forceinline__ void load_row(const bf16* p, int lane, f32x4 (&v)[4]) {
#pragma unroll
    for (int j = 0; j < 4; ++j) { const v2u w = ((const v2u*)p)[lane + 64 * j]; v[j] = (f32x4){bf2f((unsigned short)(w.x & 0xffffu)), bf2f((unsigned short)(w.x >> 16)), bf2f((unsigned short)(w.y & 0xffffu)), bf2f((unsigned short)(w.y >> 16))}; }
}
__device__ __forceinline__ void load_row(const float* p, int lane, f32x4 (&v)[4]) {
#pragma unroll
    for (int j = 0; j < 4; ++j) v[j] = ((const f32x4*)p)[lane + 64 * j];
}
__device__ __forceinline__ void adaln_store(const f32x4 (&v)[4], const float* shift, const float* scale, bf16* hrow, int lane) {
    float mean, rstd; row_stats(v, mean, rstd);
#pragma unroll
    for (int j = 0; j < 4; ++j) { const int c = 4 * lane + 256 * j; const f32x4 sc = *(const f32x4*)(scale + c), sh = *(const f32x4*)(shift + c);
        const f32x4 h = (v[j] - mean) * rstd * (sc + 1.0f) + sh;
        v2u w; w.x = pk2(h[0], h[1]); w.y = pk2(h[2], h[3]); *(v2u*)(hrow + c) = w; }
}
__device__ __forceinline__ void ln_affine(f32x4 (&v)[4], const float* g, const float* b, int lane, float* st = nullptr) {
    float mean, rstd; row_stats(v, mean, rstd);
    if (st && lane == 0) { st[0] = mean; st[1] = rstd; }
#pragma unroll
    for (int j = 0; j < 4; ++j) { const int c = 4 * lane + 256 * j; v[j] = (v[j] - mean) * rstd * *(const f32x4*)(g + c) + *(const f32x4*)(b + c); }
}
__device__ __forceinline__ float grp16_sum(float v) { v += __shfl_xor(v, 1); v += __shfl_xor(v, 2); v += __shfl_xor(v, 4); v += __shfl_xor(v, 8); return v; }
__device__ __forceinline__ void row16_stats(const f32x4 (&v)[16], float& mean, float& rstd) {
    float s = 0.f;
#pragma unroll
    for (int j = 0; j < 16; ++j) s += (v[j][0] + v[j][1]) + (v[j][2] + v[j][3]);
    mean = grp16_sum(s) * (1.f / DM); float q = 0.f;
#pragma unroll
    for (int j = 0; j < 16; ++j) { const f32x4 d = v[j] - mean; q += (d[0] * d[0] + d[1] * d[1]) + (d[2] * d[2] + d[3] * d[3]); }
    rstd = __builtin_amdgcn_rsqf(grp16_sum(q) * (1.f / DM) + LN_EPS);
}
__device__ __forceinline__ void load_row16(const float* p, int cl, f32x4 (&v)[16]) {
#pragma unroll
    for (int j = 0; j < 16; ++j) v[j] = ((const f32x4*)p)[cl + 16 * j];
}
__device__ __forceinline__ void load_row16(const bf16* p, int cl, f32x4 (&v)[16]) {
#pragma unroll
    for (int j = 0; j < 16; ++j) { const v2u w = ((const v2u*)p)[cl + 16 * j]; v[j] = (f32x4){bf2f((unsigned short)(w.x & 0xffffu)), bf2f((unsigned short)(w.x >> 16)), bf2f((unsigned short)(w.y & 0xffffu)), bf2f((unsigned short)(w.y >> 16))}; }
}
__device__ __forceinline__ void adaln_store16(const f32x4 (&v)[16], const float* shift, const float* scale, bf16* hrow, int cl) {
    float mean, rstd; row16_stats(v, mean, rstd);
#pragma unroll
    for (int j = 0; j < 16; ++j) { const int c = 4 * cl + 64 * j; const f32x4 sc = *(const f32x4*)(scale + c), sh = *(const f32x4*)(shift + c);
        const f32x4 h = (v[j] - mean) * rstd * (sc + 1.0f) + sh;
        v2u w; w.x = pk2(h[0], h[1]); w.y = pk2(h[2], h[3]); *(v2u*)(hrow + c) = w;
        if ((j & 3) == 3) asm volatile("" ::: "memory"); }
}
__device__ __forceinline__ void ln_affine16(f32x4 (&v)[16], const float* g, const float* b, int cl, float* st = nullptr) {
    float mean, rstd; row16_stats(v, mean, rstd);
    if (st && cl == 0) { st[0] = mean; st[1] = rstd; }
#pragma unroll
    for (int j = 0; j < 16; ++j) { const int c = 4 * cl + 64 * j; v[j] = (v[j] - mean) * rstd * *(const f32x4*)(g + c) + *(const f32x4*)(b + c); if ((j & 3) == 3) asm volatile("" ::: "memory"); }
}
__device__ __forceinline__ void store_row16(float* p, int cl, const f32x4 (&v)[16]) {
#pragma unroll
    for (int j = 0; j < 16; ++j) ((f32x4*)p)[cl + 16 * j] = v[j];
}
__device__ __forceinline__ void store_row(float* p, int lane, const f32x4 (&v)[4]) {
#pragma unroll
    for (int j = 0; j < 4; ++j) ((f32x4*)p)[lane + 64 * j] = v[j];
}

namespace hconv {
using bf16x8 = __attribute__((ext_vector_type(8))) short;
using f32x16 = __attribute__((ext_vector_type(16))) float;
constexpr int UB = 8256;
constexpr int SLOT = 16384 + 2 * UB;
__device__ __forceinline__ int crow(int r, int hi) { return (r & 3) + 8 * (r >> 2) + 4 * hi; }
__device__ __forceinline__ void item(const bf16* __restrict__ GRB, const bf16* __restrict__ UT, const float* __restrict__ FP, const float* __restrict__ skipv, const bf16* __restrict__ X0, bf16* __restrict__ YM,
                                     int ch0, LAS unsigned char* lds, const int tid, const int lane, const int wave) {
    for (int q = tid; q < 4 * 1024; q += 512) { const int ch = q >> 10, i = q & 1023; const v4u v = ((const v4u*)(GRB + (size_t)(ch0 + ch) * 8192))[i]; *(LAS v4u*)(lds + ch * SLOT + 16 * i) = v; }
    for (int q = tid; q < 4 * 1024; q += 512) { const int ch = q >> 10, b = (q >> 9) & 1, i = q & 511; const v4u v = ((const v4u*)(UT + ((size_t)b * HY + ch0 + ch) * LS))[i];
        *(LAS v4u*)(lds + ch * SLOT + 16384 + b * UB + 32 + 16 * i) = v; }
    if (tid < 32) { const int ch = tid >> 3, b = (tid >> 2) & 1, j = tid & 3; const v4u z = {0u, 0u, 0u, 0u};
        *(LAS v4u*)(lds + ch * SLOT + 16384 + b * UB + (j < 2 ? 16 * j : 32 + 8192 + 16 * (j - 2))) = z; }
    __syncthreads();
    v2u x0v[16];
    {
        const int slot = wave & 3, khalf = wave >> 2;
        const LAS unsigned char* gr = lds + slot * SLOT; const LAS unsigned char* ubuf = gr + 16384;
        const int r = lane & 31, h = lane >> 5, c = r & 15, b = r >> 4, c0 = c & 1, c1 = c >> 1;
        const LAS unsigned char* ap = gr + 992 + 16 * h - 32 * r + khalf * (129 * 32);
        const LAS unsigned char* bp = ubuf + b * UB + 16 * h + 4 * c1 + khalf * (129 * 32);
        const unsigned sh = 16u * (unsigned)c0;
        const int ch = ch0 + slot;
        const float nsum = wave_sum(lane < 32 ? FP[ch * 32 + lane] + FP[(HY + ch) * 32 + lane] : 0.f); const float inv_norm = 1.f / nsum; const float skn = skipv[ch] * nsum;
        const LAS bf16* ul = (const LAS bf16*)(ubuf + b * UB + 32);
        f32x16 acc[8];
#pragma unroll
        for (int Q = 0; Q < 8; ++Q)
#pragma unroll
            for (int g = 0; g < 16; ++g) acc[Q][g] = khalf ? 0.f : skn * bf2f(ul[16 * (32 * Q + crow(g, h)) + c]);
        int nks = khalf ? 128 : 129; asm volatile("" : "+s"(nks));
        unsigned aa = (unsigned)(uintptr_t)ap, ba = (unsigned)(uintptr_t)bp;
        bf16x8 fa0, fa1, fa2, fa3, fa4, fa5, fa6, fa7, fb0, fb1, fb2, fb3, fb4, fb5, fb6, fb7; v2u da01, da23, db01, db23; unsigned da4, db4;
#define HC_LD(F0, F1, F2, F3, F4, F5, F6, F7, D01, D23, D4) do { \
            asm volatile("ds_read_b128 %0, %1 offset:7168" : "=v"(F0) : "v"(aa)); asm volatile("ds_read_b128 %0, %1 offset:6144" : "=v"(F1) : "v"(aa)); \
            asm volatile("ds_read2_b32 %0, %1 offset1:1" : "=v"(D01) : "v"(ba)); asm volatile("ds_read2_b32 %0, %1 offset0:2 offset1:3" : "=v"(D23) : "v"(ba)); asm volatile("ds_read_b32 %0, %1 offset:16" : "=v"(D4) : "v"(ba)); \
            asm volatile("ds_read_b128 %0, %1 offset:5120" : "=v"(F2) : "v"(aa)); asm volatile("ds_read_b128 %0, %1 offset:4096" : "=v"(F3) : "v"(aa)); \
            asm volatile("ds_read_b128 %0, %1 offset:3072" : "=v"(F4) : "v"(aa)); asm volatile("ds_read_b128 %0, %1 offset:2048" : "=v"(F5) : "v"(aa)); \
            asm volatile("ds_read_b128 %0, %1 offset:1024" : "=v"(F6) : "v"(aa)); asm volatile("ds_read_b128 %0, %1" : "=v"(F7) : "v"(aa)); __builtin_amdgcn_sched_barrier(0); } while (0)
#define HC_WAIT(F0, F1, F2, F3, F4, F5, F6, F7, D01, D23, D4) do { __builtin_amdgcn_sched_barrier(0); asm volatile("s_waitcnt lgkmcnt(0)" : "+v"(F0), "+v"(F1), "+v"(F2), "+v"(F3), "+v"(F4), "+v"(F5), "+v"(F6), "+v"(F7), "+v"(D01), "+v"(D23), "+v"(D4)); \
            __builtin_amdgcn_sched_barrier(0); } while (0)
#define HC_MMA(F0, F1, F2, F3, F4, F5, F6, F7, D01, D23, D4) do { u32x4 bw; bw.x = __builtin_amdgcn_alignbit(D01.y, D01.x, sh); bw.y = __builtin_amdgcn_alignbit(D23.x, D01.y, sh); bw.z = __builtin_amdgcn_alignbit(D23.y, D23.x, sh); \
            bw.w = __builtin_amdgcn_alignbit(D4, D23.y, sh); const bf16x8 bf = __builtin_bit_cast(bf16x8, bw); \
            acc[0] = __builtin_amdgcn_mfma_f32_32x32x16_bf16(F0, bf, acc[0], 0, 0, 0); acc[1] = __builtin_amdgcn_mfma_f32_32x32x16_bf16(F1, bf, acc[1], 0, 0, 0); \
            acc[2] = __builtin_amdgcn_mfma_f32_32x32x16_bf16(F2, bf, acc[2], 0, 0, 0); acc[3] = __builtin_amdgcn_mfma_f32_32x32x16_bf16(F3, bf, acc[3], 0, 0, 0); \
            acc[4] = __builtin_amdgcn_mfma_f32_32x32x16_bf16(F4, bf, acc[4], 0, 0, 0); acc[5] = __builtin_amdgcn_mfma_f32_32x32x16_bf16(F5, bf, acc[5], 0, 0, 0); \
            acc[6] = __builtin_amdgcn_mfma_f32_32x32x16_bf16(F6, bf, acc[6], 0, 0, 0); acc[7] = __builtin_amdgcn_mfma_f32_32x32x16_bf16(F7, bf, acc[7], 0, 0, 0); } while (0)
        HC_LD(fa0, fa1, fa2, fa3, fa4, fa5, fa6, fa7, da01, da23, da4);
        int npair = nks >> 1;
        for (int kp = 0; kp < npair; ++kp) {
            HC_WAIT(fa0, fa1, fa2, fa3, fa4, fa5, fa6, fa7, da01, da23, da4);
            aa += 32; ba += 32; HC_LD(fb0, fb1, fb2, fb3, fb4, fb5, fb6, fb7, db01, db23, db4);
            HC_MMA(fa0, fa1, fa2, fa3, fa4, fa5, fa6, fa7, da01, da23, da4);
            HC_WAIT(fb0, fb1, fb2, fb3, fb4, fb5, fb6, fb7, db01, db23, db4);
            aa += 32; ba += 32; HC_LD(fa0, fa1, fa2, fa3, fa4, fa5, fa6, fa7, da01, da23, da4);
            HC_MMA(fb0, fb1, fb2, fb3, fb4, fb5, fb6, fb7, db01, db23, db4);
        }
        HC_WAIT(fa0, fa1, fa2, fa3, fa4, fa5, fa6, fa7, da01, da23, da4);
        if (nks & 1) HC_MMA(fa0, fa1, fa2, fa3, fa4, fa5, fa6, fa7, da01, da23, da4);
#undef HC_LD
#undef HC_WAIT
#undef HC_MMA
#pragma unroll
        for (int i = 0; i < 16; ++i) { const int q = tid + 512 * i; x0v[i] = *(const v2u*)(X0 + ((size_t)NP + q) * HY + ch0); }
        asm volatile("s_waitcnt lgkmcnt(0)" ::: "memory");
        __syncthreads();
        LAS f32x4* xch = (LAS f32x4*)(lds + slot * SLOT);
        if (khalf) {
#pragma unroll
            for (int Q = 0; Q < 8; ++Q)
#pragma unroll
                for (int g4 = 0; g4 < 4; ++g4) xch[(Q * 4 + g4) * 64 + lane] = (f32x4){acc[Q][4 * g4], acc[Q][4 * g4 + 1], acc[Q][4 * g4 + 2], acc[Q][4 * g4 + 3]};
        }
        __syncthreads();
        if (!khalf) {
#pragma unroll
            for (int Q = 0; Q < 8; ++Q)
#pragma unroll
                for (int g4 = 0; g4 < 4; ++g4) { const f32x4 o = xch[(Q * 4 + g4) * 64 + lane]; acc[Q][4 * g4] += o[0]; acc[Q][4 * g4 + 1] += o[1]; acc[Q][4 * g4 + 2] += o[2]; acc[Q][4 * g4 + 3] += o[3]; }
        }
        asm volatile("s_waitcnt lgkmcnt(0)" ::: "memory");
        __syncthreads();
        if (!khalf) {
            LAS bf16* yl = (LAS bf16*)(lds + slot * SLOT);
#pragma unroll
            for (int Q = 0; Q < 8; ++Q)
#pragma unroll
                for (int g = 0; g < 16; ++g) { const int t = 16 * (32 * Q + crow(g, h)) + c; yl[b * LS + t] = (bf16)f2bf(acc[Q][g] * inv_norm); }
        }
    }
    __syncthreads();
#pragma unroll
    for (int i = 0; i < 16; ++i) { const int q = tid + 512 * i; const size_t row = (size_t)NP + q; const v2u xv = x0v[i];
        const float y0 = bf2f(*(const LAS bf16*)(lds + 0 * SLOT + 2 * q)), y1 = bf2f(*(const LAS bf16*)(lds + 1 * SLOT + 2 * q)), y2 = bf2f(*(const LAS bf16*)(lds + 2 * SLOT + 2 * q)), y3 = bf2f(*(const LAS bf16*)(lds + 3 * SLOT + 2 * q));
        v2u o; o.x = pk2(y0 * bf2f((unsigned short)(xv.x & 0xffffu)), y1 * bf2f((unsigned short)(xv.x >> 16))); o.y = pk2(y2 * bf2f((unsigned short)(xv.y & 0xffffu)), y3 * bf2f((unsigned short)(xv.y >> 16)));
        *(v2u*)(YM + row * DM + ch0) = o; }
    __syncthreads();
}
constexpr int PUB = 576, PSLOT = 1024 + 16 * PUB;
__device__ __forceinline__ void prompt_item(const float* __restrict__ FT, const bf16* __restrict__ UT, const float* __restrict__ FP, const float* __restrict__ skipv, const bf16* __restrict__ X0, bf16* __restrict__ YM,
                                            int ch0, LAS unsigned char* lds, const int tid, const int lane, const int wave) {
    const int ch = ch0 + wave; LAS unsigned char* slot = lds + wave * PSLOT;
    {
        LAS bf16* gr = (LAS bf16*)slot;
#pragma unroll
        for (int i = 0; i < 8; ++i) { const int e = lane + 64 * i; const int d = LP - e; float v = 0.f; if (e != 0) v = d >= 0 ? FT[(size_t)ch * LP + d] : FT[(size_t)(HY + ch) * LP - d]; gr[e] = (bf16)f2bf(v); }
#pragma unroll
        for (int i = 0; i < 8; ++i) { const int q = lane + 64 * i, b = q >> 5, j = q & 31; const v4u v = ((const v4u*)(UT + ((size_t)b * HY + ch) * LP))[j]; *(LAS v4u*)(slot + 1024 + b * PUB + 32 + 16 * j) = v; }
        { const int b = lane >> 2, j = lane & 3; const v4u z = {0u, 0u, 0u, 0u}; *(LAS v4u*)(slot + 1024 + b * PUB + (j < 2 ? 16 * j : 32 + 512 + 16 * (j - 2))) = z; }
    }
    asm volatile("s_waitcnt vmcnt(0) lgkmcnt(0)" ::: "memory");
    const int r = lane & 31, h = lane >> 5, c = r & 15, bh = r >> 4, c0 = c & 1, c1 = c >> 1; const unsigned sh = 16u * (unsigned)c0;
    const float nsum = (FP[ch * 2] + FP[ch * 2 + 1]) + (FP[(HY + ch) * 2] + FP[(HY + ch) * 2 + 1]);
    const float inv_norm = 1.f / nsum, skn = skipv[ch] * nsum;
    const LAS unsigned char* ubuf = slot + 1024;
    f32x16 acc[8];
#pragma unroll
    for (int ct = 0; ct < 8; ++ct) { const LAS bf16* ul = (const LAS bf16*)(ubuf + (2 * ct + bh) * PUB + 32);
#pragma unroll
        for (int g = 0; g < 16; ++g) acc[ct][g] = g < 8 ? skn * bf2f(ul[16 * crow(g, h) + c]) : 0.f; }
    const LAS unsigned char* ap = slot + 2 * (240 - 16 * (r < 15 ? r : 15) + 8 * h);
    const LAS unsigned char* bp = ubuf + bh * PUB + 16 * h + 4 * c1;
    int nks = 17; asm volatile("" : "+s"(nks));
    for (int ks = 0; ks < nks; ++ks) {
        const bf16x8 af = *(const LAS bf16x8*)(ap + 32 * ks);
#pragma unroll
        for (int ct = 0; ct < 8; ++ct) { const LAS unsigned* bq = (const LAS unsigned*)(bp + 2 * ct * PUB + 32 * ks);
            const unsigned d0 = bq[0], d1 = bq[1], d2 = bq[2], d3 = bq[3], d4 = bq[4];
            u32x4 bw; bw.x = __builtin_amdgcn_alignbit(d1, d0, sh); bw.y = __builtin_amdgcn_alignbit(d2, d1, sh); bw.z = __builtin_amdgcn_alignbit(d3, d2, sh); bw.w = __builtin_amdgcn_alignbit(d4, d3, sh);
            acc[ct] = __builtin_amdgcn_mfma_f32_32x32x16_bf16(af, __builtin_bit_cast(bf16x8, bw), acc[ct], 0, 0, 0); }
    }
    asm volatile("s_waitcnt lgkmcnt(0)" ::: "memory");
    {
        LAS bf16* yl = (LAS bf16*)(slot + 1024);
#pragma unroll
        for (int ct = 0; ct < 8; ++ct)
#pragma unroll
            for (int g = 0; g < 8; ++g) yl[(2 * ct + bh) * LP + 16 * crow(g, h) + c] = (bf16)f2bf(acc[ct][g] * inv_norm);
    }
    __syncthreads();
#pragma unroll
    for (int i = 0; i < 8; ++i) { const int q = tid + 512 * i;
        const v4u xv = *(const v4u*)(X0 + (size_t)q * HY + ch0); unsigned xw[4] = {xv.x, xv.y, xv.z, xv.w}, ow[4];
#pragma unroll
        for (int k = 0; k < 4; ++k) { const float ya = bf2f(*(const LAS bf16*)(lds + (2 * k) * PSLOT + 1024 + 2 * q)), yb = bf2f(*(const LAS bf16*)(lds + (2 * k + 1) * PSLOT + 1024 + 2 * q));
            ow[k] = pk2(ya * bf2f((unsigned short)(xw[k] & 0xffffu)), yb * bf2f((unsigned short)(xw[k] >> 16))); }
        *(v4u*)(YM + (size_t)q * DM + ch0) = (v4u){ow[0], ow[1], ow[2], ow[3]}; }
    __syncthreads();
}
static_assert(4 * SLOT <= LDSCTL_OFF, "four channel slots fit in LDS");
}

__global__ void __launch_bounds__(512, 2) fwd_kernel(Args args) {
    extern __shared__ __attribute__((aligned(16))) unsigned char lds_raw[];
    LAS unsigned char* lds = (LAS unsigned char*)lds_raw;
    volatile LAS unsigned* MISC = (volatile LAS unsigned*)(lds + MISC_OFF);
    const int wave = __builtin_amdgcn_readfirstlane((int)threadIdx.x >> 6);
    const int G = gridDim.x; const int bx = blockIdx.x; const int vcu = (G % 8 == 0) ? (bx % 8) * (G / 8) + bx / 8 : bx;
    const int gw = vcu * 8 + wave, NGW = G * 8, NGT = G * 512;
#define FRESH() const int lane = fresh_lane(); const int tid = wave * 64 + lane; const int gt = vcu * 512 + tid; (void)gt
    unsigned char* ws = args.ws;
    gu32* ctl = (gu32*)(ws + WS_CTL);
    float* MODS = (float*)(ws + WS_MODS);
    float* X = args.out;
    float* STATS = (float*)(ws + WS_STATS);
    bf16* T = (bf16*)(ws + WS_T);
    bf16* HB = (bf16*)(ws + WS_H);
    for (int u = threadIdx.x; u < (LDS_BYTES - LDSCTL_OFF) / 4; u += 512) ((LAS unsigned*)(lds + LDSCTL_OFF))[u] = 0u;
    __syncthreads();
    XcdBarrier bar; bar.bar = (unsigned*)(ctl + CW_BAR) + args.li * XCD_BAR_WORDS; bar.x = 0; bar.st = nullptr;
    if (!MK_PER_PHASE) bar = xcd_barrier_post((unsigned*)(ctl + CW_BAR) + args.li * XCD_BAR_WORDS, MISC + 8);
    const int lo = args.ph_lo, hi = args.ph_hi;
#ifndef NO_CONV
#define NO_CONV 0
#endif
#ifndef NO_ATT
#define NO_ATT 0
#endif
#ifndef PHASE_MASK
#define PHASE_MASK 0x1FFFF
#endif
#define IN(k) ((((PHASE_MASK) >> (k)) & 1) && lo <= (k) && (k) < hi)
#define SPLIT_CNT(b) ((unsigned*)(ctl + CW_SPLIT + (args.li * 6 + (b)) * 16384))
#define SLABS(mib) ((float*)(ws + (size_t)(mib) * MiB))
#define SEAM(k) do { if (IN(k) && IN((k) + 1)) xcd_barrier(bar); } while (0)

    if (IN(0)) {
        FRESH();
        asm volatile("; ==== PHASE 0 ====");
        for (int it = bx; it < 192; it += G) {
            const int layer = it / 96, cb = it % 96, col = cb * 64 + lane;
            LAS float* sil = (LAS float*)lds; LAS float* red = (LAS float*)(lds + 12288);
            for (int i = tid; i < 3072; i += 512) { const int r = i >> 10, k = i & 1023; const float c = (r == 0) ? args.in[I_CCTX][k] : args.in[I_C][(r - 1) * DM + k]; sil[i] = c / (1.f + fexp(-c)); }
            __syncthreads();
            const float* W = args.in[layer ? I_ADA1_W : I_ADA0_W]; float a0 = 0.f, a1 = 0.f, a2 = 0.f;
#pragma unroll 8
            for (int kk = 0; kk < 128; ++kk) { const int k = wave * 128 + kk; const float w = W[(size_t)k * 6144 + col]; a0 += sil[k] * w; a1 += sil[1024 + k] * w; a2 += sil[2048 + k] * w; }
            red[(wave * 3 + 0) * 64 + lane] = a0; red[(wave * 3 + 1) * 64 + lane] = a1; red[(wave * 3 + 2) * 64 + lane] = a2;
            __syncthreads();
            if (tid < 192) { const int r = tid >> 6, l = tid & 63; float s = 0.f;
#pragma unroll
                for (int w = 0; w < 8; ++w) s += red[(w * 3 + r) * 64 + l];
                MODS[(size_t)(layer * 3 + r) * 6144 + cb * 64 + l] = s + args.in[layer ? I_ADA1_B : I_ADA0_B][cb * 64 + l]; }
            __syncthreads();
        }
        {
            LAS float* scr = (LAS float*)(lds + wave * 16384);
            for (int it = gw; it < WI_L0; it += NGW) weight_item(args, ws, scr, it, lane);
        }
        for (int i = gt; i < 2048 * 128; i += NGT) { const int kp = i >> 7, c8 = (i & 127) * 8; const int part = kp >> 10, kq = kp & 1023, g = kq >> 7, cp = kq & 127; unsigned w[4] = {0u, 0u, 0u, 0u};
            if ((c8 >> 7) == g) {
#pragma unroll
                for (int e = 0; e < 8; e += 2) { const float r0 = (float)((cp * ((c8 + e) & 127)) & 127) * (1.f / 128.f), r1 = (float)((cp * ((c8 + e + 1) & 127)) & 127) * (1.f / 128.f);
                    const float a = (part ? -__builtin_amdgcn_sinf(r0) : __builtin_amdgcn_cosf(r0)) * 0.08838834764831845f, b = (part ? -__builtin_amdgcn_sinf(r1) : __builtin_amdgcn_cosf(r1)) * 0.08838834764831845f;
                    w[e >> 1] = pk2(a, b); } }
            ((v4u*)(ws + WS_CBD))[i] = (v4u){w[0], w[1], w[2], w[3]}; }
        {
            const v4u z = {0u, 0u, 0u, 0u};
            for (int i = gt; i < 8192 + 16384 + MKV * 16 + 1024 * 24; i += NGT) {
                if (i < 8192) ((v4u*)(ws + WS_WIN_T + (size_t)1984 * 2048))[i] = z;
                else if (i < 8192 + 16384) { const int j = i - 8192; *(v4u*)(ws + WS_KVUP_T + (size_t)(j >> 4) * 512 + 256 + (j & 15) * 16) = z; }
                else if (i < 8192 + 16384 + MKV * 16) { const int j = i - 8192 - 16384; *(v4u*)(ws + WS_KVN + (size_t)(j >> 4) * 512 + 256 + (j & 15) * 16) = z; }
                else { const int j = i - 8192 - 16384 - MKV * 16; *(v4u*)(ws + WS_W3T + (size_t)(j / 24) * 512 + 128 + (j % 24) * 16) = z; }
            }
        }
        for (int i = gt; i < 65536; i += NGT) { const int rho = i >> 8, l = i & 255; const int k = rho > 128 ? rho - 128 : rho; const float rev = (float)((k * l) & 255) * (1.f / 256.f);
            ((bf16*)(ws + WS_D256))[i] = (bf16)f2bf((rho > 128 ? __builtin_amdgcn_sinf(rev) : __builtin_amdgcn_cosf(rev)) * 0.0625f); }
        {
            bf16* H2B = (bf16*)(ws + WS_H2B);
            const float* w1 = args.in[I_HFW1]; const float* w2 = args.in[I_HFW2];
            const float b1 = args.in[I_HFB1][lane], b2 = args.in[I_HFB2][lane], fr = args.in[I_HFFREQ][lane];
            for (int R = gw; R < LS + LP; R += NGW) {
                const int L = R < LS ? LS : LP, l = R < LS ? R : R - LS;
                const float t = (float)l / (float)(L - 1);
                const float wang = (6.283185307179586f * (float)l) / (float)L;
                const int j = lane & 15; const float band = 1e-4f + (float)j * ((15.0f - 1e-4f) / 15.0f);
                const float ang = wang * band, rev = ang * INV_2PI;
                const float zl = (lane < 16) ? fcos_rev(rev) : -fsin_rev(rev);
                float p1 = b1 + t * w1[lane];
#pragma unroll
                for (int i = 0; i < 32; ++i) p1 += __shfl(zl, i) * w1[(1 + i) * 64 + lane];
                const float h1 = sinf(fr * p1);
                float p2 = b2;
#pragma unroll 16
                for (int i = 0; i < 64; ++i) p2 += __shfl(h1, i) * w2[i * 64 + lane];
                const float h2 = sinf(fr * p2);
                { const float a = __shfl(h2, 4 * (lane & 15)), b = __shfl(h2, 4 * (lane & 15) + 1), c = __shfl(h2, 4 * (lane & 15) + 2), d = __shfl(h2, 4 * (lane & 15) + 3);
                  v2u w; w.x = lane < 16 ? pk2(a, b) : 0u; w.y = lane < 16 ? pk2(c, d) : 0u; ((v2u*)(H2B + (size_t)R * 256))[lane] = w; }
            }
        }
    }
    SEAM(0);

    if (IN(1)) {
        FRESH();
        asm volatile("; ==== PHASE 1 ====");
        for (int m4 = gw * 4; m4 < MT; m4 += NGW * 4) { const int m = m4 + (lane >> 4); int cl = lane & 15; asm volatile("" : "+v"(cl));
            const float* xr = m < NP ? args.in[I_XP] + (size_t)m * DM : args.in[I_XS] + (size_t)(m - NP) * DM;
            const float* md = MODS + (size_t)req_of_row(m) * 6144;
            f32x4 v[16]; load_row16(xr, cl, v); adaln_store16(v, md, md + 1024, HB + (size_t)m * DM, cl);
        }
        {
            int k256 = 256; asm volatile("" : "+s"(k256));
            pg8::Gemm g{(const bf16*)(ws + WS_H2B), (const bf16*)(ws + WS_W3T), LS + LP, 1024, k256}; pg8::StaticOrder S; S.init(LS + LP, 1024, G, (bx + 64) % G);
            EpiFilt E{(bf16*)(ws + WS_FT_S), (float*)(ws + WS_FT_P), (float*)(ws + WS_FPART_S), (float*)(ws + WS_FPART_P)};
            const int lane2 = fresh_lane(); const int tid = wave * 64 + lane2;
            pg8::gemm_phase<EpiFilt, pg8::StaticOrder, PG8_ALIGN, PG8_SP2>(lds, g, S, E, tid);
        }
    }
    SEAM(1);

    if (IN(2)) {
        FRESH();
        asm volatile("; ==== PHASE 2 ====");
        pg8::Gemm g{HB, (const bf16*)(ws + WS_WIN_T), MT, WINP, DM}; pg8::StaticOrder S; S.init((MT / 192) * 256, WINP, G, bx);
        EpiWin<3> E{(bf16*)(ws + WS_P), (float*)(ws + WS_ZS)};
        pg8::gemm_phase<EpiWin<3>, pg8::StaticOrder, PG8_ALIGN, PG8_SP2, 3>(lds, g, S, E, tid);
    }
    SEAM(2);

    if (IN(3)) {
        FRESH();
        asm volatile("; ==== PHASE 3 ====");
        const bf16* P = (const bf16*)(ws + WS_P);
        for (int it = bx; it < MT / 64; it += G) {
            const int m0 = it * 64; const bool smp = m0 >= NP; const int L = smp ? LS : LP; const int l0 = smp ? (m0 - NP) % LS : m0 % LP;
            const int seq = smp ? (m0 - NP) / LS : m0 / LP;
            const int c8 = (tid & 63) * 8, ts = tid >> 6, tb = m0 + ts * 8, lb = l0 + ts * 8;
            const float* cw = args.in[I_CONVW]; const float* cb = args.in[I_CONVB];
            LAS bf16* ut = (LAS bf16*)lds;
            bf16* X0 = (bf16*)(ws + WS_X0);
            float x1v[8][8];
#pragma unroll
            for (int sa = 0; sa < 3; ++sa) {
                v4u rr[1][10];
#pragma unroll
                for (int r = 0; r < 10; ++r) { const int lp = lb - 1 + r; const bool ok = lp >= 0 && lp < L;
                    const v4u v = *(const v4u*)(P + (size_t)(tb - 1 + r + (ok ? 0 : (r == 0 ? 1 : -1))) * 1536 + sa * 512 + c8); rr[0][r] = ok ? v : (v4u){0u, 0u, 0u, 0u}; }
                float w[3][8], bb[8];
#pragma unroll
                for (int k = 0; k < 3; ++k) { const f32x4 wa = *(const f32x4*)(cw + k * 1536 + sa * 512 + c8), wb = *(const f32x4*)(cw + k * 1536 + sa * 512 + c8 + 4);
                    w[k][0] = wa[0]; w[k][1] = wa[1]; w[k][2] = wa[2]; w[k][3] = wa[3]; w[k][4] = wb[0]; w[k][5] = wb[1]; w[k][6] = wb[2]; w[k][7] = wb[3]; }
                { const f32x4 ba = *(const f32x4*)(cb + sa * 512 + c8), bc = *(const f32x4*)(cb + sa * 512 + c8 + 4); bb[0] = ba[0]; bb[1] = ba[1]; bb[2] = ba[2]; bb[3] = ba[3]; bb[4] = bc[0]; bb[5] = bc[1]; bb[6] = bc[2]; bb[7] = bc[3]; }
#pragma unroll
                for (int i = 0; i < 8; ++i) { float y[8];
#pragma unroll
                    for (int e = 0; e < 8; ++e) { const int wd = e >> 1, hi = e & 1;
                        const unsigned u0 = rr[0][i][wd], u1 = rr[0][i + 1][wd], u2 = rr[0][i + 2][wd];
                        const float p0 = bf2f((unsigned short)(hi ? u0 >> 16 : u0 & 0xffffu)), p1 = bf2f((unsigned short)(hi ? u1 >> 16 : u1 & 0xffffu)), p2 = bf2f((unsigned short)(hi ? u2 >> 16 : u2 & 0xffffu));
                        y[e] = p0 * w[0][e] + p1 * w[1][e] + p2 * w[2][e] + bb[e]; }
                    if (sa == 0) { v4u o; o.x = pk2(y[0], y[1]); o.y = pk2(y[2], y[3]); o.z = pk2(y[4], y[5]); o.w = pk2(y[6], y[7]); *(v4u*)(X0 + (size_t)(tb + i) * 512 + c8) = o; }
                    else if (sa == 1) {
#pragma unroll
                        for (int e = 0; e < 8; ++e) x1v[i][e] = y[e]; }
                    else {
#pragma unroll
                        for (int e = 0; e < 8; ++e) x1v[i][e] *= y[e]; }
                }
            }
#pragma unroll
            for (int e = 0; e < 8; ++e)
#pragma unroll
                for (int i = 0; i < 8; i += 2) *(LAS unsigned*)(ut + (c8 + e) * 68 + ts * 8 + i) = pk2(x1v[i][e], x1v[i + 1][e]);
            __syncthreads();
            bf16* UT = (bf16*)(ws + (smp ? WS_UT_S : WS_UT_P)) + (size_t)seq * 512 * L + l0;
            for (int q = tid; q < 512 * 16; q += 512) { const int ch = q >> 4, part = q & 15; const v2u v = *(const LAS v2u*)(ut + ch * 68 + part * 4); *(v2u*)(UT + (size_t)ch * L + part * 4) = v; }
            __syncthreads();
        }
        const float* ZS = (const float*)(ws + WS_ZS);
        bf16* QN = (bf16*)(ws + WS_QN); bf16* KVN = (bf16*)(ws + WS_KVN);
        for (int m4 = gw * 4; m4 < MKV; m4 += NGW * 4) {
            const int m = m4 + (lane >> 4); int cl = lane & 15; asm volatile("" : "+v"(cl));
            if (m4 < MT) {
                const bool smp = m >= NP; const int b = smp ? (m - NP) / LS : m / LP, key = smp ? (m - NP) % LS : m % LP;
                f32x4 v[7];
#pragma unroll
                for (int j = 0; j < 7; ++j) v[j] = ((const f32x4*)(ZS + (size_t)m * 512))[cl + 16 * j];
                float sq = 0.f, sk = 0.f;
#pragma unroll
                for (int j = 0; j < 4; ++j) sq += (v[j][0] * v[j][0] + v[j][1] * v[j][1]) + (v[j][2] * v[j][2] + v[j][3] * v[j][3]);
#pragma unroll
                for (int j = 4; j < 6; ++j) sk += (v[j][0] * v[j][0] + v[j][1] * v[j][1]) + (v[j][2] * v[j][2] + v[j][3] * v[j][3]);
                const float rq = __builtin_amdgcn_rsqf(grp16_sum(sq) * (1.f / QL) + RMS_EPS), rk = __builtin_amdgcn_rsqf(grp16_sum(sk) * (1.f / KVL) + RMS_EPS);
#pragma unroll
                for (int j = 0; j < 4; ++j) { const int c = 4 * cl + 64 * j; const f32x4 g = *(const f32x4*)(args.in[I_QNORM] + c); const f32x4 y = v[j] * rq * g;
                    v2u w; w.x = pk2(y[0], y[1]); w.y = pk2(y[2], y[3]); *(v2u*)(QN + (size_t)m * 256 + c) = w; }
#pragma unroll
                for (int j = 4; j < 6; ++j) { const int c = 4 * cl + 64 * (j - 4); const f32x4 g = *(const f32x4*)(args.in[I_KVNORM] + c); const f32x4 y = v[j] * rk * g;
                    v2u w; w.x = pk2(y[0], y[1]); w.y = pk2(y[2], y[3]); *(v2u*)(KVN + (size_t)m * 256 + c) = w;
                    if (!smp) *(f32x4*)(args.out + OUT_CKV + (size_t)m * KVL + c) = y; }
                {
                    const int seg = cl >> 3; const bool second = (cl & 4) != 0; const int j0 = 4 * (cl & 3);
                    const float pf = (float)(seg == 0 ? (key >> 6) : (key & 63)); f32x4 y = v[6];
#pragma unroll
                    for (int e = 0; e < 4; ++e) { const float pr = __shfl_xor(v[6][e], 4);
                        if (smp) { const float inv = __builtin_amdgcn_exp2f(-(float)(j0 + e) * (13.287712379549449f / 16.0f)); const float rev = pf * inv * INV_2PI;
                            y[e] = v[6][e] * fcos_rev(rev) + (second ? pr : -pr) * fsin_rev(rev); } }
                    const int kk = 4 * cl;
                    if (!smp) *(f32x4*)(args.out + OUT_CKR + (size_t)m * DROPE + kk) = y;
                    v2u w; w.x = pk2(y[0], y[1]); w.y = pk2(y[2], y[3]);
                    bf16* kf = (bf16*)(ws + (smp ? WS_KF_S : WS_KF_P)); const int lk = smp ? LKS : LP;
#pragma unroll
                    for (int h = 0; h < NH; ++h) *(v2u*)(kf + ((size_t)(b * NH + h) * lk + key) * DQK + DNOPE + kk) = w;
                }
            } else {
                const int mm = m - MT, b = mm / PAST, jj = mm % PAST;
#pragma unroll
                for (int j = 0; j < 2; ++j) { const int c = 4 * cl + 64 * j; const f32x4 y = *(const f32x4*)(args.in[I_CKV] + (size_t)mm * KVL + c); v2u w; w.x = pk2(y[0], y[1]); w.y = pk2(y[2], y[3]); *(v2u*)(KVN + (size_t)m * 256 + c) = w; }
                { const int kk = 4 * cl; const f32x4 y = *(const f32x4*)(args.in[I_CKR] + (size_t)mm * DROPE + kk); v2u w; w.x = pk2(y[0], y[1]); w.y = pk2(y[2], y[3]);
                  bf16* kf = (bf16*)(ws + WS_KF_S);
#pragma unroll
                  for (int h = 0; h < NH; ++h) *(v2u*)(kf + ((size_t)(b * NH + h) * LKS + LS + jj) * DQK + DNOPE + kk) = w; }
            }
        }
    }
    SEAM(3);

    if (IN(4)) {
        FRESH();
        asm volatile("; ==== PHASE 4 ====");
        int k256 = 256; asm volatile("" : "+s"(k256));
        { pg8::Gemm g{(const bf16*)(ws + WS_QN), (const bf16*)(ws + WS_QUP_T), MT, 768, k256}; pg8::StaticOrder S; S.init(MT, 768, G, bx);
          EpiStore E{(bf16*)(ws + WS_Q), 768};
          pg8::gemm_phase<EpiStore, pg8::StaticOrder, PG8_ALIGN, PG8_SP2>(lds, g, S, E, tid); }
        { int bx2 = (bx + 144) % G; asm volatile("" : "+s"(bx2)); const int lane2 = fresh_lane(); const int tid = wave * 64 + lane2;
          pg8::Gemm g{(const bf16*)(ws + WS_KVN), (const bf16*)(ws + WS_KVUP_T), MKV, 1024, k256}; pg8::StaticOrder S; S.init(MKV, 1024, G, bx2);
          EpiKV E{(bf16*)(ws + WS_KF_S), (bf16*)(ws + WS_KF_P), (bf16*)(ws + WS_V_S), (bf16*)(ws + WS_V_P)};
          pg8::gemm_phase<EpiKV, pg8::StaticOrder, PG8_ALIGN, PG8_SP2>(lds, g, S, E, tid); }
        { int bx3 = (bx + 88) % G; asm volatile("" : "+s"(bx3)); const int lane3 = fresh_lane(); const int tid = wave * 64 + lane3;
          pg8::Gemm g{(const bf16*)(ws + WS_W1T), (const bf16*)(ws + WS_CBD), DM, 2048, DM}; pg8::StaticOrder S; S.init(DM, 2048, G, bx3);
          EpiStore E{(bf16*)(ws + WS_WFOLD_T), 2048};
          pg8::gemm_phase<EpiStore, pg8::StaticOrder, PG8_ALIGN, PG8_SP2>(lds, g, S, E, tid); }
    }
    SEAM(4);

    if (IN(5)) {
        FRESH();
        asm volatile("; ==== PHASE 5 ====");
        constexpr int NA_S = 2 * BS * NH * (LS / 256), NC_S = HY / 4, NA_P = BP * NH, NC_P = HY / 8, NW_T = (WI_ALL - WI_L0) / 8, NITEM = NA_S + NC_S + NA_P + NC_P + NW_T;
        bf16* YM = HB;
        for (;;) {
            if (tid == 0) MISC[0] = __hip_atomic_fetch_add((unsigned*)(ctl + CW_Q + 64 * args.li), 1u, RLX_AGENT);
            __syncthreads();
            const int it = __builtin_amdgcn_readfirstlane((int)MISC[0]);
            __syncthreads();
            if (it >= NITEM) break;
            { const int cls = it < NA_S ? 0 : it < NA_S + NC_S ? 1 : it < NA_S + NC_S + NA_P ? 2 : it < NA_S + NC_S + NA_P + NC_P ? 3 : 4; if (!((args.mask >> cls) & 1)) continue; }
            const int lane = fresh_lane(); const int tid = wave * 64 + lane;
            const bool isA_S = it < NA_S, isA_P = (it >= NA_S + NC_S) && (it < NA_S + NC_S + NA_P);
            if (isA_S || isA_P) { if (!NO_ATT) {
                int b, h, row0, lk, pos0, koff = 0, nkeys; const bf16 *kf, *vv; float* part = nullptr; unsigned* cnt = nullptr;
                if (isA_S) { const int un = it >> 1, half = it & 1; b = un / (NH * 16); h = (un / 16) % NH; const int qb = un % 16; row0 = NP + b * LS + qb * 256; lk = LKS; pos0 = qb * 256; kf = (const bf16*)(ws + WS_KF_S); vv = (const bf16*)(ws + WS_V_S);
                    nkeys = LKS / 2; koff = half * (LKS / 2); part = (float*)(ws + WS_APART) + (size_t)un * APART_F; cnt = (unsigned*)(ctl + CW_ATT + args.li * 8192 + un * 64); }
                else { const int u = it - NA_S - NC_S; b = u / NH; h = u % NH; row0 = b * LP; lk = LP; pos0 = -1; kf = (const bf16*)(ws + WS_KF_P); vv = (const bf16*)(ws + WS_V_P); nkeys = LP; }
                att::attn_dense_body((const bf16*)(ws + WS_Q) + (size_t)row0 * 768 + h * DQK, kf + ((size_t)(b * NH + h) * lk + koff) * DQK, vv + ((size_t)(b * NH + h) * lk + koff) * DVH,
                                     YM + (size_t)row0 * DM + HY + h * DVH, nkeys, pos0, (LAS char*)lds, tid, part, cnt, MISC); }
            } else if (it < NA_S + NC_S) {
                hconv::item((const bf16*)(ws + WS_FT_S), (const bf16*)(ws + WS_UT_S), (const float*)(ws + WS_FPART_S), args.in[I_HFSKIP], (const bf16*)(ws + WS_X0), YM, (it - NA_S) * 4, lds, tid, lane, wave);
            } else if (it >= NA_S + NC_S + NA_P + NC_P) {
                LAS float* scr = (LAS float*)(lds + wave * 16384);
                weight_item(args, ws, scr, WI_L0 + (it - (NA_S + NC_S + NA_P + NC_P)) * 8 + wave, lane);
                __syncthreads();
            } else if (!NO_CONV) {
                hconv::prompt_item((const float*)(ws + WS_FT_P), (const bf16*)(ws + WS_UT_P), (const float*)(ws + WS_FPART_P), args.in[I_HFSKIP], (const bf16*)(ws + WS_X0), YM, (it - NA_S - NC_S - NA_P) * 8, lds, tid, lane, wave);
            }
        }
    }
    SEAM(5);

    if (IN(6)) {
        FRESH();
        asm volatile("; ==== PHASE 6 ====");
        pg8::Gemm g{HB, (const bf16*)(ws + WS_WOUT0_T), MT, DM, DM}; pg8::StaticOrder S; S.init((MT / 192) * 256, DM, G, bx);
        EpiRes<3, false> E{args.in[I_XP], args.in[I_XS], MODS + 2 * 1024, T, nullptr, nullptr, nullptr};
        pg8::gemm_phase<EpiRes<3, false>, pg8::StaticOrder, PG8_ALIGN, PG8_SP2, 3>(lds, g, S, E, tid);
    }
    SEAM(6);

    if (IN(7)) {
        FRESH();
        asm volatile("; ==== PHASE 7 ====");
        for (int m4 = gw * 4; m4 < MT; m4 += NGW * 4) { const int m = m4 + (lane >> 4); int cl = lane & 15; asm volatile("" : "+v"(cl));
            const float* md = MODS + (size_t)req_of_row(m) * 6144;
            f32x4 v[16]; load_row16(T + (size_t)m * DM, cl, v); ln_affine16(v, args.in[I_LN1G0], args.in[I_LN1B0], cl, STATS + 2 * m);
            adaln_store16(v, md + 3 * 1024, md + 4 * 1024, HB + (size_t)m * DM, cl);
        }
    }
    SEAM(7);

    if (IN(8)) {
        FRESH();
        asm volatile("; ==== PHASE 8 ====");
        pg8::Gemm g{HB, (const bf16*)(ws + WS_W1_0), MT, FF, DM}; pg8::StaticOrder S; S.init(MT, FF, G, bx);
        EpiUp E{(bf16*)(ws + WS_HID)};
        pg8::gemm_phase<EpiUp, pg8::StaticOrder, PG8_ALIGN, PG8_SP2>(lds, g, S, E, tid);
    }
    SEAM(8);

    if (IN(9)) {
        FRESH();
        asm volatile("; ==== PHASE 9 ====");
        pg8::Gemm g{(const bf16*)(ws + WS_HID), (const bf16*)(ws + WS_W2_0), MT, DM, FF}; pg8::StaticOrder S; S.init((MT / 192) * 256, DM, G, bx);
        EpiRes<3, true> E{nullptr, nullptr, MODS + 5 * 1024, T, STATS, args.in[I_LN1G0], args.in[I_LN1B0]};
        pg8::gemm_phase<EpiRes<3, true>, pg8::StaticOrder, PG8_ALIGN, PG8_SP2, 3>(lds, g, S, E, tid);
    }
    SEAM(9);

    if (IN(10)) {
        FRESH();
        asm volatile("; ==== PHASE 10 ====");
        const float* MODS1 = MODS + 3 * 6144;
        for (int it = bx; it < MT / 32; it += G) {
            const int m0 = it * 32; const bool smp = m0 >= NP; const int L = smp ? LS : LP; const int l0 = smp ? (m0 - NP) % LS : m0 % LP; const int seq = smp ? (m0 - NP) / LS : m0 / LP;
            LAS bf16* ht = (LAS bf16*)lds;
            const float* md = MODS1 + (size_t)req_of_row(m0) * 6144;
            { const int i = wave * 4 + (lane >> 4), m = m0 + i; int cl = lane & 15; asm volatile("" : "+v"(cl));
                f32x4 v[16]; load_row16(T + (size_t)m * DM, cl, v); ln_affine16(v, args.in[I_LN2G0], args.in[I_LN2B0], cl, STATS + 2 * m);
                float mean, rstd; row16_stats(v, mean, rstd);
#pragma unroll
                for (int j = 0; j < 16; ++j) { const int c = 4 * cl + 64 * j; const f32x4 sc = *(const f32x4*)(md + 1024 + c), sh = *(const f32x4*)(md + c);
                    const f32x4 h = (v[j] - mean) * rstd * (sc + 1.0f) + sh;
#pragma unroll
                    for (int e = 0; e < 4; ++e) ht[(c + e) * 40 + i] = (bf16)f2bf(h[e]);
                    if ((j & 3) == 3) asm volatile("" ::: "memory"); }
            }
            __syncthreads();
            bf16* HT = HB + (smp ? (size_t)NP * DM + (size_t)seq * DM * LS : (size_t)seq * DM * LP) + l0;
            for (int q = tid; q < 1024 * 4; q += 512) { const int c = q >> 2, part = q & 3; const v4u v = *(const LAS v4u*)(ht + c * 40 + part * 8); *(v4u*)(HT + (size_t)c * L + part * 8) = v; }
            __syncthreads();
        }
        for (size_t i = gt; i < (size_t)LS * LS / 8; i += NGT) {
            const int rho = (int)(i >> 9), l8 = (int)(i & 511) * 8; const int k = rho > 2048 ? rho - 2048 : rho; unsigned w[4];
#pragma unroll
            for (int e = 0; e < 8; e += 2) { const float r0 = (float)((k * (l8 + e)) & 4095) * (1.f / 4096.f), r1 = (float)((k * (l8 + e + 1)) & 4095) * (1.f / 4096.f);
                const float a = (rho > 2048 ? __builtin_amdgcn_sinf(r0) : __builtin_amdgcn_cosf(r0)) * 0.015625f, b = (rho > 2048 ? __builtin_amdgcn_sinf(r1) : __builtin_amdgcn_cosf(r1)) * 0.015625f;
                w[e >> 1] = pk2(a, b); }
            ((v4u*)(ws + WS_D4096))[i] = (v4u){w[0], w[1], w[2], w[3]};
        }
    }
    SEAM(10);

    if (IN(11)) {
        FRESH();
        asm volatile("; ==== PHASE 11 ====");
        { pg8::Gemm g{(const bf16*)(ws + WS_D4096), HB + (size_t)NP * DM, LS, BS * DM, LS}; pg8::SplitOrder S; S.init(LS, BS * DM, LS, G, vcu, SLABS(200), SPLIT_CNT(3));
          EpiDft E{(bf16*)(ws + WS_UV), LS, NP};
          pg8::gemm_phase<EpiDft, pg8::SplitOrder, PG8_ALIGN, PG8_SP2>(lds, g, S, E, tid); }
        { int bx2 = (bx + 128) % G; asm volatile("" : "+s"(bx2)); const int lane2 = fresh_lane(); const int tid = wave * 64 + lane2;
          pg8::Gemm g{(const bf16*)(ws + WS_D256), HB, LP, BP * DM, LP}; pg8::StaticOrder S; S.init(LP, BP * DM, G, bx2);
          EpiDft E{(bf16*)(ws + WS_UV), LP, 0};
          pg8::gemm_phase<EpiDft, pg8::StaticOrder, PG8_ALIGN, PG8_SP2>(lds, g, S, E, tid); }
    }
    SEAM(11);

    if (IN(12)) {
        FRESH();
        asm volatile("; ==== PHASE 12 ====");
        pg8::Gemm g{(const bf16*)(ws + WS_UV), (const bf16*)(ws + WS_WFOLD_T), MT, DM, 2048}; pg8::StaticOrder S; S.init((MT / 192) * 256, DM, G, bx);
        EpiRes<3, true> E{nullptr, nullptr, MODS + 3 * 6144 + 2 * 1024, T, STATS, args.in[I_LN2G0], args.in[I_LN2B0]};
        pg8::gemm_phase<EpiRes<3, true>, pg8::StaticOrder, PG8_ALIGN, PG8_SP2, 3>(lds, g, S, E, tid);
    }
    SEAM(12);

    if (IN(13)) {
        FRESH();
        asm volatile("; ==== PHASE 13 ====");
        for (int m4 = gw * 4; m4 < MT; m4 += NGW * 4) { const int m = m4 + (lane >> 4); int cl = lane & 15; asm volatile("" : "+v"(cl));
            const float* md = MODS + 3 * 6144 + (size_t)req_of_row(m) * 6144;
            f32x4 v[16]; load_row16(T + (size_t)m * DM, cl, v); ln_affine16(v, args.in[I_LN1G1], args.in[I_LN1B1], cl, STATS + 2 * m);
            adaln_store16(v, md + 3 * 1024, md + 4 * 1024, HB + (size_t)m * DM, cl);
        }
    }
    SEAM(13);

    if (IN(14)) {
        FRESH();
        asm volatile("; ==== PHASE 14 ====");
        pg8::Gemm g{HB, (const bf16*)(ws + WS_W1_1), MT, FF, DM}; pg8::StaticOrder S; S.init(MT, FF, G, bx);
        EpiUp E{(bf16*)(ws + WS_HID)};
        pg8::gemm_phase<EpiUp, pg8::StaticOrder, PG8_ALIGN, PG8_SP2>(lds, g, S, E, tid);
    }
    SEAM(14);

    if (IN(15)) {
        FRESH();
        asm volatile("; ==== PHASE 15 ====");
        pg8::Gemm g{(const bf16*)(ws + WS_HID), (const bf16*)(ws + WS_W2_1), MT, DM, FF}; pg8::StaticOrder S; S.init((MT / 192) * 256, DM, G, bx);
        EpiRes<3, true> E{nullptr, nullptr, MODS + 3 * 6144 + 5 * 1024, T, STATS, args.in[I_LN1G1], args.in[I_LN1B1]};
        pg8::gemm_phase<EpiRes<3, true>, pg8::StaticOrder, PG8_ALIGN, PG8_SP2, 3>(lds, g, S, E, tid);
    }
    SEAM(15);

    if (IN(16)) {
        FRESH();
        asm volatile("; ==== PHASE 16 ====");
        for (int m4 = gw * 4; m4 < MT; m4 += NGW * 4) { const int m = m4 + (lane >> 4); int cl = lane & 15; asm volatile("" : "+v"(cl));
            f32x4 v[16]; load_row16(T + (size_t)m * DM, cl, v); ln_affine16(v, args.in[I_LN2G1], args.in[I_LN2B1], cl); store_row16(X + (size_t)m * DM, cl, v);
        }
    }
#undef IN
#undef SEAM
}

extern "C" void kernel_launch(void* const* d_in, const int* in_sizes, int n_in, void* d_out, int out_size, void* d_ws, size_t ws_size, hipStream_t stream) {
    static int grid = 0;
    if (grid == 0) {
        if (n_in != 38 || ws_size < WS_END) { fprintf(stderr, "kernel_launch: expected 38 inputs and >= %zu bytes of workspace; got %d, %zu\n", (size_t)WS_END, n_in, ws_size); grid = -1; return; }
        int dev = 0, cus = 0;
        if (hipGetDevice(&dev) != hipSuccess || hipDeviceGetAttribute(&cus, hipDeviceAttributeMultiprocessorCount, dev) != hipSuccess) { grid = -1; return; }
        if (hipFuncSetAttribute((const void*)fwd_kernel, hipFuncAttributeMaxDynamicSharedMemorySize, LDS_BYTES) != hipSuccess) { fprintf(stderr, "kernel_launch: hipFuncSetAttribute failed\n"); grid = -1; return; }
        int per_cu = 0;
        if (hipOccupancyMaxActiveBlocksPerMultiprocessor(&per_cu, (const void*)fwd_kernel, 512, LDS_BYTES) != hipSuccess || per_cu < 1) fprintf(stderr, "kernel_launch: occupancy query reports %d\n", per_cu);
        (void)hipGetLastError();
        grid = cus;
    }
    if (grid < 0) return;
    (void)hipMemsetAsync((char*)d_ws + WS_CTL, 0, CTL_ZERO_BYTES, stream);
    Args a{};
    for (int i = 0; i < 38; ++i) a.in[i] = (const float*)d_in[i];
    a.out = (float*)d_out; a.ws = (unsigned char*)d_ws;
#if MK_PER_PHASE
    for (int p = 0; p < NPHASE; ++p) { a.ph_lo = p; a.ph_hi = p + 1; a.li = 0; a.mask = 31; hipLaunchKernelGGL(fwd_kernel, dim3(grid), dim3(512), LDS_BYTES, stream, a); }
#elif defined(PROBE_PREFIX)
    a.mask = 31; a.ph_lo = 0; a.ph_hi = PROBE_PREFIX; a.li = 0; hipLaunchKernelGGL(fwd_kernel, dim3(grid), dim3(512), LDS_BYTES, stream, a);
    a.mask = 31; a.ph_lo = 0; a.ph_hi = NPHASE; a.li = 1; hipLaunchKernelGGL(fwd_kernel, dim3(grid), dim3(512), LDS_BYTES, stream, a);
#elif defined(PROBE_A)
#ifndef PROBE_MASK5
#define PROBE_MASK5 31
#endif
    a.mask = 31; a.ph_lo = 0; a.ph_hi = PROBE_B; a.li = 0; hipLaunchKernelGGL(fwd_kernel, dim3(grid), dim3(512), LDS_BYTES, stream, a);
    a.mask = PROBE_MASK5; a.ph_lo = PROBE_A; a.ph_hi = NPHASE; a.li = 1; hipLaunchKernelGGL(fwd_kernel, dim3(grid), dim3(512), LDS_BYTES, stream, a);
#else
    a.ph_lo = 0; a.ph_hi = NPHASE; a.li = 0; a.mask = 31;
    hipLaunchKernelGGL(fwd_kernel, dim3(grid), dim3(512), LDS_BYTES, stream, a);
#endif
    const hipError_t le = hipPeekAtLastError();
    if (le != hipSuccess) fprintf(stderr, "kernel_launch: launch failed: %s\n", hipGetErrorName(le));
}
```

```cpp
#include <hip/hip_runtime.h>
#include <hip/hip_bf16.h>
#include <cstdio>
#include <cstdint>
#include <cmath>
namespace pg8 {
#define PG8_LAS __attribute__((address_space(3)))
typedef unsigned short bf16_t;
typedef short bf16x8 __attribute__((ext_vector_type(8)));
typedef float f32x4 __attribute__((ext_vector_type(4)));
typedef unsigned u32x4 __attribute__((ext_vector_type(4)));
constexpr int BM = 256, BK = 64, HALF = 128, HTB = HALF * BK * 2  , STAGE_BYTES = 8 * HTB, NXCD = 8, WGM = 8;

__host__ __device__ __forceinline__ int lds_byte(int r, int c) { const int st = (r >> 4) * 2 + (c >> 5), rr = r & 15, cc = c & 31, ob = rr * 64 + cc * 2; return st * 1024 + (ob ^ (((ob >> 9) & 1) << 5)); }
__host__ __device__ __forceinline__ void stage_rc(int b, int& R, int& C) { const int st = b / 1024, sb = b % 1024, swz = sb ^ (((sb >> 9) & 1) << 5); R = (st >> 1) * 16 + swz / 64; C = (st & 1) * 32 + (swz % 64) / 2; }
__host__ __device__ __forceinline__ int perm32(int rho) { const int n = rho >> 4, i = rho & 15; return 8 * (i >> 2) + 4 * n + (i & 3); }

struct Unit { int pm, pn; int k0, nt, mode, slab, need, tile; };
struct Gemm { const bf16_t* A; const bf16_t* Bt; int M, N, K; };

struct StaticOrder {
    int nM, nN, nwg, G, c;
    __host__ __device__ void init(int M, int N, int G_, int c_) { nM = M / BM; nN = N / BM; nwg = nM * nN; G = G_; c = c_; }
    __host__ __device__ bool next(int i, Unit& u) const {
        const long L = (long)i * G + c; if (L >= nwg) return false;
        int wgid = (int)L; { const int q = nwg / NXCD, r = nwg % NXCD, xcd = wgid % NXCD, off = wgid / NXCD; wgid = (xcd < r ? xcd * (q + 1) : r * (q + 1) + (xcd - r) * q) + off; }
        const int nig = WGM * nN, gid = wgid / nig, fm = gid * WGM, gsz = (nM - fm) < WGM ? (nM - fm) : WGM;
        u.pm = fm + ((wgid % nig) % gsz); u.pn = (wgid % nig) / gsz; u.k0 = 0; u.nt = 0; u.mode = 0; u.slab = 0; u.need = 0; u.tile = 0; return true;
    }
    static constexpr bool SPLIT = false;
    __device__ __forceinline__ void a_ready(const Unit&) const {}
    __device__ __forceinline__ void done(const Unit&) const {}
};

struct SplitOrder {
    static constexpr bool SPLIT = true;
    int nM, nN, NT, per, c, lo, hi, tf, ns, give_last, P; float* slabs; unsigned* cnt;
    __device__ __forceinline__ void init(int M, int N, int K, int G_, int c_, float* slabs_, unsigned* cnt_) {
        nM = M / BM; nN = N / BM; NT = K / BK; c = c_; slabs = slabs_; cnt = cnt_;
        const int TU = nM * nN * NT; per = (TU + G_ - 1) / G_; per += per & 1;
        lo = c * per; hi = lo + per < TU ? lo + per : TU; if (lo >= TU) { lo = 0; hi = 0; }
        tf = lo / NT; ns = hi > lo ? (hi - 1) / NT - tf + 1 : 0; give_last = (hi % NT) != 0 ? 1 : 0;
        int a = per, b = NT; while (b) { const int t = a % b; a = b; b = t; } P = NT / a;
    }
    __device__ __forceinline__ int giver_index(int j) const { return j - j / P; }
    __device__ __forceinline__ bool next(int i, Unit& u) const {
        if (i >= ns) return false;
        int sidx; if (ns == 1) sidx = 0; else if (give_last && i == 0) sidx = ns - 1; else if (i == ns - 1) sidx = 0; else sidx = i - give_last + 1;
        const int T = tf + sidx, tlo = T * NT, thi = tlo + NT; const int a = lo > tlo ? lo : tlo, b = hi < thi ? hi : thi;
        const int nig = WGM * nN, gid = T / nig, fm = gid * WGM, gsz = (nM - fm) < WGM ? (nM - fm) : WGM;
        u.pm = fm + ((T % nig) % gsz); u.pn = (T % nig) / gsz; u.k0 = a - tlo; u.nt = b - a; u.tile = T;
        if (b != thi) { u.mode = 1; u.slab = giver_index(c); u.need = 0; }
        else if (a != tlo) { const int c0 = tlo / per; u.mode = 2; u.slab = giver_index(c0); u.need = c - c0; }
        else { u.mode = 0; u.slab = 0; u.need = 0; }
        return true;
    }
    __device__ __forceinline__ void a_ready(const Unit&) const {}
    __device__ __forceinline__ void done(const Unit&) const {}
};
__device__ __forceinline__ unsigned cvt_pk_bf16(float lo, float hi) { unsigned r; asm volatile("v_cvt_pk_bf16_f32 %0, %1, %2" : "=v"(r) : "v"(lo), "v"(hi)); return r; }
template <class Epi, class Sched, bool ALIGN_EPI = false, bool SP2 = false, int MF = 4>
__device__ __forceinline__ void gemm_phase(PG8_LAS unsigned char* lds, const Gemm g, const Sched& S, const Epi& E, const int tid) {
    const int wid = __builtin_amdgcn_readfirstlane(tid >> 6), lane = tid & 63, wr = wid >> 2, wc = wid & 3, fr = lane & 15, fq = lane >> 4;
    const int K = g.K, nt = K / BK;
    unsigned voffA[2], voffB[2];
#pragma unroll
    for (int i = 0; i < 2; ++i) { int R, C; stage_rc(tid * 16 + i * 8192, R, C); const int Rb = Epi::PERM ? ((R & ~31) + perm32(R & 31)) : R;
        voffA[i] = (unsigned)(R * K + C) * 2u; voffB[i] = (unsigned)(Rb * K + C) * 2u; }
    const size_t kstep = (size_t)(BK * 2);
    const size_t hstepB = (size_t)HALF * K * 2, tstepB = 2 * hstepB;
    const size_t hstepA = (size_t)(32 * MF) * K * 2, tstepA = 2 * hstepA;
    const unsigned ldsw = (unsigned)wid * 1024u;
    const int aoff = lds_byte(wr * (16 * MF) + fr, fq * 8), boff = lds_byte(wc * 32 + fr, fq * 8);
#define PG8_SA(b, h) (((b) * 2 + (h)) * HTB)
#define PG8_SB(b, h) ((4 + (b) * 2 + (h)) * HTB)
#define PG8_STAGE(bufoff, gbase, voff) do { _Pragma("unroll") for (int _i = 0; _i < 2; ++_i) \
        __builtin_amdgcn_global_load_lds((const unsigned*)((const char*)(gbase) + (voff)[_i]), (PG8_LAS unsigned*)(lds + (bufoff) + ldsw + _i * 8192), 16, 0, 0); } while (0)
#define PG8_LDA(dst, b, h) do { _Pragma("unroll") for (int m = 0; m < MF; ++m) _Pragma("unroll") for (int k = 0; k < 2; ++k) dst[m][k] = *(const PG8_LAS bf16x8*)(lds + PG8_SA(b, h) + aoff + m * 2048 + k * 1024); } while (0)
#define PG8_LDB(dst, b, h) do { _Pragma("unroll") for (int n = 0; n < 2; ++n) _Pragma("unroll") for (int k = 0; k < 2; ++k) dst[n][k] = *(const PG8_LAS bf16x8*)(lds + PG8_SB(b, h) + boff + n * 2048 + k * 1024); } while (0)
#define PG8_MMA(ai, bj, At, Bt) do { __builtin_amdgcn_s_setprio(1); _Pragma("unroll") for (int m = 0; m < MF; ++m) _Pragma("unroll") for (int n = 0; n < 2; ++n) _Pragma("unroll") for (int k = 0; k < 2; ++k) \
        acc[ai][bj][m][n] = __builtin_amdgcn_mfma_f32_16x16x32_bf16(Bt[n][k], At[m][k], acc[ai][bj][m][n], 0, 0, 0); __builtin_amdgcn_s_setprio(0); } while (0)
#define PG8_WAIT_V(n) asm volatile("s_waitcnt vmcnt(" #n ")" ::: "memory")
#define PG8_WAIT_L(n) asm volatile("s_waitcnt lgkmcnt(" #n ")" ::: "memory")
#define PG8_BAR __builtin_amdgcn_s_barrier()
#define PG8_SCHED __builtin_amdgcn_sched_barrier(0)
    Unit cur, nxt; int ui = 0;
    if (!S.next(0, cur)) return;
    f32x4 acc[2][2][4][2];
#pragma unroll
    for (int a = 0; a < 2; ++a)
#pragma unroll
        for (int b = 0; b < 2; ++b)
#pragma unroll
            for (int m = 0; m < 4; ++m)
#pragma unroll
                for (int n = 0; n < 2; ++n) acc[a][b][m][n] = (f32x4){0.f, 0.f, 0.f, 0.f};
    bf16x8 At[4][2], B0[2][2], B1[2][2];
    const char* cA = (const char*)g.A + (size_t)cur.pm * tstepA + (size_t)cur.k0 * kstep; const char* cB = (const char*)g.Bt + (size_t)cur.pn * tstepB + (size_t)cur.k0 * kstep;
    S.a_ready(cur);
    if constexpr (SP2) {
        PG8_STAGE(PG8_SB(0, 0), cB, voffB); PG8_STAGE(PG8_SB(0, 1), cB + hstepB, voffB); PG8_STAGE(PG8_SA(0, 0), cA, voffA); PG8_STAGE(PG8_SA(0, 1), cA + hstepA, voffA);
        if (wr == 1) PG8_BAR;
        PG8_WAIT_V(2); PG8_BAR;
        PG8_STAGE(PG8_SB(1, 0), cB + kstep, voffB); PG8_STAGE(PG8_SA(1, 0), cA + kstep, voffA); PG8_STAGE(PG8_SB(1, 1), cB + hstepB + kstep, voffB);
        PG8_WAIT_V(6); PG8_BAR;
    } else {
        PG8_STAGE(PG8_SB(0, 0), cB, voffB); PG8_STAGE(PG8_SA(0, 0), cA, voffA); PG8_STAGE(PG8_SB(0, 1), cB + hstepB, voffB); PG8_STAGE(PG8_SA(0, 1), cA + hstepA, voffA);
        if (wr == 1) PG8_BAR;
        PG8_WAIT_V(4); PG8_BAR;
        PG8_STAGE(PG8_SB(1, 0), cB + kstep, voffB); PG8_STAGE(PG8_SA(1, 0), cA + kstep, voffA); PG8_STAGE(PG8_SB(1, 1), cB + hstepB + kstep, voffB);
        PG8_WAIT_V(6); PG8_BAR;
    }
    for (;;) {
        const bool has_next = S.next(ui + 1, nxt);
        const char* nA = has_next ? (const char*)g.A + (size_t)nxt.pm * tstepA + (size_t)nxt.k0 * kstep : cA; const char* nB = has_next ? (const char*)g.Bt + (size_t)nxt.pn * tstepB + (size_t)nxt.k0 * kstep : cB;
        const int ntc = cur.nt ? cur.nt : nt;
        for (int t = 0; t < ntc; t += 2) {
            const bool last = (t == ntc - 2);
            const char* a1 = cA + (size_t)(t + 1) * kstep;
            const char* a2 = last ? nA : cA + (size_t)(t + 2) * kstep; const char* b2 = last ? nB : cB + (size_t)(t + 2) * kstep;
            const char* a3 = a2 + kstep; const char* b3 = b2 + kstep;
            if (last && has_next) S.a_ready(nxt);
            if constexpr (SP2) {
            PG8_LDB(B0, 0, 0); PG8_LDB(B1, 0, 1); PG8_SCHED; PG8_LDA(At, 0, 0); PG8_STAGE(PG8_SA(1, 1), a1 + hstepA, voffA);
            PG8_WAIT_V(8); PG8_WAIT_L(0); PG8_BAR; PG8_MMA(0, 0, At, B0); PG8_MMA(0, 1, At, B1); PG8_BAR; PG8_SCHED;
            PG8_LDA(At, 0, 1); PG8_STAGE(PG8_SB(0, 0), b2, voffB); PG8_STAGE(PG8_SB(0, 1), b2 + hstepB, voffB); PG8_STAGE(PG8_SA(0, 0), a2, voffA);
            PG8_WAIT_V(8); PG8_WAIT_L(0); PG8_BAR; PG8_MMA(1, 0, At, B0); PG8_MMA(1, 1, At, B1); PG8_BAR; PG8_SCHED;
            PG8_LDB(B0, 1, 0); PG8_LDB(B1, 1, 1); PG8_SCHED; PG8_LDA(At, 1, 0); PG8_STAGE(PG8_SA(0, 1), a2 + hstepA, voffA);
            PG8_WAIT_V(8); PG8_WAIT_L(0); PG8_BAR; PG8_MMA(0, 0, At, B0); PG8_MMA(0, 1, At, B1); PG8_BAR; PG8_SCHED;
            PG8_LDA(At, 1, 1); PG8_STAGE(PG8_SB(1, 0), b3, voffB); PG8_STAGE(PG8_SB(1, 1), b3 + hstepB, voffB); PG8_STAGE(PG8_SA(1, 0), a3, voffA);
            PG8_WAIT_V(8); PG8_WAIT_L(0); PG8_BAR; PG8_MMA(1, 0, At, B0); PG8_MMA(1, 1, At, B1); PG8_BAR; PG8_SCHED;
            } else {
            PG8_LDB(B0, 0, 0); PG8_SCHED; PG8_LDA(At, 0, 0); PG8_STAGE(PG8_SA(1, 1), a1 + hstepA, voffA);
            PG8_WAIT_L(8); PG8_BAR; PG8_WAIT_L(0); PG8_MMA(0, 0, At, B0); PG8_BAR; PG8_SCHED;
            PG8_LDB(B1, 0, 1); PG8_STAGE(PG8_SB(0, 0), b2, voffB);
            PG8_BAR; PG8_WAIT_L(0); PG8_MMA(0, 1, At, B1); PG8_BAR;
            PG8_LDA(At, 0, 1); PG8_STAGE(PG8_SA(0, 0), a2, voffA);
            PG8_BAR; PG8_WAIT_L(0); PG8_MMA(1, 0, At, B0); PG8_BAR; PG8_SCHED;
            PG8_STAGE(PG8_SB(0, 1), b2 + hstepB, voffB);
            PG8_WAIT_V(6); PG8_BAR; PG8_MMA(1, 1, At, B1); PG8_BAR;
            PG8_LDB(B0, 1, 0); PG8_SCHED; PG8_LDA(At, 1, 0); PG8_STAGE(PG8_SA(0, 1), a2 + hstepA, voffA);
            PG8_WAIT_L(8); PG8_BAR; PG8_WAIT_L(0); PG8_MMA(0, 0, At, B0); PG8_BAR; PG8_SCHED;
            PG8_LDB(B1, 1, 1); PG8_STAGE(PG8_SB(1, 0), b3, voffB);
            PG8_BAR; PG8_WAIT_L(0); PG8_MMA(0, 1, At, B1); PG8_BAR;
            PG8_LDA(At, 1, 1); PG8_STAGE(PG8_SA(1, 0), a3, voffA);
            PG8_BAR; PG8_WAIT_L(0); PG8_MMA(1, 0, At, B0); PG8_BAR; PG8_SCHED;
            PG8_STAGE(PG8_SB(1, 1), b3 + hstepB, voffB);
            PG8_WAIT_V(6); PG8_BAR; PG8_MMA(1, 1, At, B1); PG8_BAR;
            }
        }
        if constexpr (ALIGN_EPI) { if (wr == 0) PG8_BAR; }
        if constexpr (!Epi::AFTER_DRAIN) {
            Unit eu = cur; eu.pm = __builtin_amdgcn_readfirstlane(cur.pm); eu.pn = __builtin_amdgcn_readfirstlane(cur.pn); eu.slab = __builtin_amdgcn_readfirstlane(cur.slab); eu.tile = __builtin_amdgcn_readfirstlane(cur.tile);
            eu.need = __builtin_amdgcn_readfirstlane(cur.need); eu.mode = __builtin_amdgcn_readfirstlane(cur.mode);
            asm volatile("" : "+s"(eu.pm), "+s"(eu.pn), "+s"(eu.slab), "+s"(eu.tile), "+s"(eu.need), "+s"(eu.mode));
            if constexpr (Sched::SPLIT) {
                if (eu.mode == 1) {
                    const float* sp = S.slabs + (size_t)eu.slab * 65536 + wid * 8192 + lane * 4;
#pragma unroll
                    for (int a = 0; a < 2; ++a)
#pragma unroll
                        for (int b = 0; b < 2; ++b)
#pragma unroll
                            for (int m = 0; m < 4; ++m)
#pragma unroll
                                for (int n = 0; n < 2; ++n) { const f32x4 v = acc[a][b][m][n]; const float* p = sp + (((a * 2 + b) * 4 + m) * 2 + n) * 256;
                                    asm volatile("global_store_dwordx4 %0, %1, off sc1\n\ts_nop 1" :: "v"(p), "v"(v) : "memory"); }
                    asm volatile("s_waitcnt vmcnt(0)" ::: "memory");
                    if (lane == 0) __hip_atomic_fetch_add(S.cnt + eu.tile * 32, 1u, __ATOMIC_RELAXED, __HIP_MEMORY_SCOPE_AGENT);
                } else if (eu.mode == 2) {
                    unsigned sp_ = 0;
                    while ((unsigned)__builtin_amdgcn_readfirstlane(__hip_atomic_load(S.cnt + eu.tile * 32, __ATOMIC_RELAXED, __HIP_MEMORY_SCOPE_AGENT)) < 8u) { __builtin_amdgcn_s_sleep(8); if (++sp_ > (1u << 20)) break; }
                    __builtin_amdgcn_fence(__ATOMIC_ACQUIRE, "agent");
                    E.template run<true>(acc, eu, wr, wc, fr, fq, S.slabs + (size_t)eu.slab * 65536 + wid * 8192 + lane * 4);
                } else E.template run<false>(acc, eu, wr, wc, fr, fq, nullptr);
            } else E.template run<false>(acc, eu, wr, wc, fr, fq, nullptr);
            S.done(cur); }
        if (!has_next) break;
#pragma unroll
        for (int a = 0; a < 2; ++a)
#pragma unroll
            for (int b = 0; b < 2; ++b)
#pragma unroll
                for (int m = 0; m < 4; ++m)
#pragma unroll
                    for (int n = 0; n < 2; ++n) acc[a][b][m][n] = (f32x4){0.f, 0.f, 0.f, 0.f};
        cur = nxt; cA = nA; cB = nB; ++ui;
        if constexpr (ALIGN_EPI) { if (wr == 1) PG8_BAR; }
    }
    PG8_WAIT_V(0);
    if constexpr (!ALIGN_EPI) { if (wr == 0) PG8_BAR; }
    PG8_BAR;
    if constexpr (Epi::AFTER_DRAIN) { E.fused(acc, cur, wr, wc, fr, fq, lds, wid, lane); S.done(cur); }
#undef PG8_SA
#undef PG8_SB
#undef PG8_STAGE
#undef PG8_LDA
#undef PG8_LDB
#undef PG8_MMA
#undef PG8_WAIT_V
#undef PG8_WAIT_L
#undef PG8_BAR
#undef PG8_SCHED
}
}
#ifndef PG8_SP2
#define PG8_SP2 true
#endif
#ifndef PG8_ALIGN
#define PG8_ALIGN true
#endif
#ifndef MK_PER_PHASE
#define MK_PER_PHASE 0
#endif

constexpr int DM = 1024, FF = 4096;
constexpr int LP = 256, BP = 16, LS = 4096, BS = 2, PAST = 256;
constexpr int NP = BP * LP;
constexpr int NSR = BS * LS;
constexpr int MT = NP + NSR;
constexpr int MKV = MT + BS * PAST;
constexpr int LKS = LS + PAST;
constexpr int HY = 512, NH = 4, DQK = 192, DNOPE = 128, DROPE = 64, DVH = 128, QL = 256, KVL = 128;
constexpr int WINP = 2048;
constexpr float LN_EPS = 1e-5f, RMS_EPS = 1e-6f, ALPHA = 1.41421356237309515f;
constexpr int NPHASE = 17;

constexpr int att_shm_bytes = 2 * 16384 + 2 * 24576 + 2048 + 8 * 8 * 1024;
constexpr size_t MiB = 1u << 20, KiB = 1024;
constexpr size_t WS_CTL = 0, CTL_ZERO_BYTES = 1 * MiB;
constexpr size_t WS_MODS = 1 * MiB;
constexpr size_t WS_D256 = 1 * MiB + 256 * KiB;
constexpr size_t WS_H2B = 86 * MiB, WS_W3T = 89 * MiB;
constexpr size_t WS_FPART_S = 3 * MiB;
constexpr size_t WS_FPART_P = 3 * MiB + 256 * KiB;
constexpr size_t WS_STATS = 3 * MiB + 512 * KiB;
constexpr size_t WS_WIN_T = 4 * MiB, WS_QUP_T = 8 * MiB, WS_KVUP_T = 8 * MiB + 512 * KiB, WS_WOUT0_T = 9 * MiB;
constexpr size_t WS_W1_0 = 11 * MiB, WS_W2_0 = 19 * MiB, WS_W1_1 = 27 * MiB, WS_W2_1 = 35 * MiB, WS_WFOLD_T = 43 * MiB;
constexpr size_t WS_T = 48 * MiB;
constexpr size_t WS_FT_S = 48 * MiB, WS_FT_P = 64 * MiB, WS_UT_S = 65 * MiB, WS_UT_P = 73 * MiB;
constexpr size_t WS_W1T = 80 * MiB, WS_CBD = 82 * MiB;
constexpr size_t WS_D4096 = 96 * MiB;
constexpr size_t WS_KF_S = 96 * MiB, WS_KF_P = 109 * MiB, WS_V_S = 115 * MiB, WS_V_P = 124 * MiB;
constexpr size_t WS_H = 128 * MiB;
constexpr size_t WS_P = 152 * MiB, WS_ZS = 188 * MiB, WS_QN = 212 * MiB, WS_KVN = 218 * MiB, WS_Q = 225 * MiB, WS_X0 = 243 * MiB;
constexpr size_t WS_HID = 152 * MiB, WS_UV = 152 * MiB;
constexpr size_t WS_END = 256 * MiB;
constexpr int CW_TMO = 0, CW_Q = 64, CW_BAR = 4096, CW_ATT = 16384, CW_SPLIT = 32768;
constexpr size_t WS_APART = 152 * MiB; constexpr int APART_F = 8 * 4 * 16 * 64 + 8 * 128;

constexpr int RING_BYTES = 131072, LDSCTL_OFF = 160 * 1024 - 512, MISC_OFF = LDSCTL_OFF + 320, LDS_BYTES = 160 * 1024;
static_assert(att_shm_bytes <= LDSCTL_OFF, "attention scratch fits below the LDS control words");

#define GAS __attribute__((address_space(1)))
#define LAS __attribute__((address_space(3)))
typedef unsigned short bf16;
typedef unsigned v4u __attribute__((ext_vector_type(4)));
typedef unsigned v2u __attribute__((ext_vector_type(2)));
typedef float f32x4 __attribute__((ext_vector_type(4)));
typedef GAS unsigned gu32;
#define RLX_AGENT __ATOMIC_RELAXED, __HIP_MEMORY_SCOPE_AGENT
#define LDS_WAIT() asm volatile("s_waitcnt lgkmcnt(0)" ::: "memory")
__device__ __forceinline__ unsigned f2bf(float f) { unsigned u = __builtin_bit_cast(unsigned, f); return (u + 0x7fffu + ((u >> 16) & 1u)) >> 16; }
__device__ __forceinline__ unsigned pk2(float lo, float hi) { return f2bf(lo) | (f2bf(hi) << 16); }
__device__ __forceinline__ float bf2f(unsigned short b) { return __builtin_bit_cast(float, (unsigned)b << 16); }
__device__ __forceinline__ float wave_sum(float v) {
#pragma unroll
    for (int o = 1; o < 64; o <<= 1) v += __shfl_xor(v, o);
    return v;
}
__device__ __forceinline__ float fsin_rev(float rev) { return __builtin_amdgcn_sinf(__builtin_amdgcn_fractf(rev)); }
__device__ __forceinline__ float fcos_rev(float rev) { return __builtin_amdgcn_cosf(__builtin_amdgcn_fractf(rev)); }
constexpr float INV_2PI = 0.15915494309189535f;
__device__ __forceinline__ float fexp(float x) { return __builtin_amdgcn_exp2f(x * 1.4426950408889634f); }

__device__ __forceinline__ int fresh_lane() { int l; asm volatile("v_mbcnt_lo_u32_b32 %0, -1, 0\n\tv_mbcnt_hi_u32_b32 %0, -1, %0" : "=v"(l)); return l; }
#define XB_TMO      128
#define XB_XCNT(j)  (256  + 64 * (j))
#define XB_XSUB(j)  (1280 + 64 * (j))
#define XB_XGEN(j)  (2304 + 64 * (j))
#define XB_TOP      3328
#define XB_TOPGEN   3392
#define XCD_BAR_WORDS 3456
#define XB_SPIN_CAP (1u << 23)
__device__ __forceinline__ unsigned xb_ld(unsigned* p)              { return __hip_atomic_load(p, __ATOMIC_RELAXED, __HIP_MEMORY_SCOPE_AGENT); }
__device__ __forceinline__ unsigned xb_add(unsigned* p, unsigned v) { return __hip_atomic_fetch_add(p, v, __ATOMIC_RELAXED, __HIP_MEMORY_SCOPE_AGENT); }
__device__ __forceinline__ unsigned xb_xcc_id() { return (unsigned)__builtin_amdgcn_s_getreg((3 << 11) | 20) & 0xFu; }
#define XB_SPIN(cond, bar) do { unsigned _sp = 0; while (cond) { __builtin_amdgcn_s_sleep(1); \
    if ((++_sp & 255u) == 0u) { if (xb_ld(&(bar)[XB_TMO])) break; if (_sp > XB_SPIN_CAP) { atomicAdd(&(bar)[XB_TMO], 1u); break; } } } } while (0)
struct XcdBarrier { unsigned* bar; unsigned x; volatile LAS unsigned* st; };
__device__ __forceinline__ XcdBarrier xcd_barrier_post(unsigned* bar, volatile LAS unsigned* st) {
    XcdBarrier b; b.bar = bar; b.x = xb_xcc_id(); b.st = st;
    if (threadIdx.x == 0) (void)xb_add(&bar[XB_XCNT(b.x)], 1u);
    return b;
}
__device__ __forceinline__ void xcd_barrier_complete(unsigned* bar, unsigned x, unsigned& nloc, unsigned& nx) {
    const unsigned G = gridDim.x * gridDim.y * gridDim.z;
    unsigned sum, cnt, mine, sp = 0u;
    for (;;) {
        sum = 0u; cnt = 0u; mine = 0u;
#pragma unroll
        for (unsigned j = 0; j < 16; ++j) { const unsigned c = xb_ld(&bar[XB_XCNT(j)]); sum += c; cnt += (c > 0u) ? 1u : 0u; mine = (j == x) ? c : mine; }
        if (sum == G) break;
        __builtin_amdgcn_s_sleep(1);
        if ((++sp & 255u) == 0u) { if (xb_ld(&bar[XB_TMO])) break; if (sp > XB_SPIN_CAP) { atomicAdd(&bar[XB_TMO], 1u); break; } }
    }
    nloc = mine > 0u ? mine : 1u; nx = cnt > 0u ? cnt : 1u;
}
__device__ __forceinline__ void xcd_barrier(const XcdBarrier& b) {
    asm volatile("s_waitcnt vmcnt(0)" ::: "memory");
    __syncthreads();
    if (threadIdx.x == 0) {
        unsigned* bar = b.bar;
        __builtin_amdgcn_s_waitcnt(0);
        unsigned nloc = b.st[0], nx = b.st[1];
        if (nloc == 0u) { xcd_barrier_complete(bar, b.x, nloc, nx); b.st[0] = nloc; b.st[1] = nx; }
        const unsigned old = xb_add(&bar[XB_XSUB(b.x)], 1u);
        const unsigned gen = old / nloc;
        if (old + 1u == (gen + 1u) * nloc) {
            __builtin_amdgcn_fence(__ATOMIC_RELEASE, "agent");
            asm volatile("s_waitcnt vmcnt(0)" ::: "memory");
            const unsigned og = xb_add(&bar[XB_TOP], 1u);
            const unsigned tg = og / nx;
            if (og + 1u == (tg + 1u) * nx) xb_add(&bar[XB_TOPGEN], 1u);
            else XB_SPIN(xb_ld(&bar[XB_TOPGEN]) == tg, bar);
            __builtin_amdgcn_fence(__ATOMIC_ACQUIRE, "agent");
            xb_add(&bar[XB_XGEN(b.x)], 1u);
            asm volatile("s_waitcnt vmcnt(0)" ::: "memory");
        } else {
            XB_SPIN(xb_ld(&bar[XB_XGEN(b.x)]) == gen, bar);
            __builtin_amdgcn_fence(__ATOMIC_ACQUIRE, "agent");
            asm volatile("s_waitcnt vmcnt(0)" ::: "memory");
        }
    }
    __syncthreads();
}

struct Args { const float* in[38]; float* out; unsigned char* ws; int ph_lo, ph_hi, li, mask; };
enum { I_XP = 0, I_XS, I_CKV, I_CKR, I_C, I_CCTX, I_ADA0_W, I_ADA0_B, I_WIN, I_CONVW, I_CONVB, I_HFW1, I_HFB1, I_HFFREQ, I_HFW2, I_HFB2, I_HFW3, I_HFSKIP,
       I_QNORM, I_QUP, I_KVNORM, I_KVUP, I_WOUT0, I_LN1G0, I_LN1B0, I_W1_0, I_W2_0, I_LN2G0, I_LN2B0, I_ADA1_W, I_ADA1_B, I_WOUT1, I_LN1G1, I_LN1B1, I_W1_1, I_W2_1, I_LN2G1, I_LN2B1 };
constexpr size_t OUT_CKV = (size_t)MT * DM, OUT_CKR = OUT_CKV + (size_t)NP * KVL;

__device__ __forceinline__ int req_of_row(int m) { return m < NP ? 0 : 1 + (m - NP) / LS; }

using pg8::f32x4; using pg8::Unit; using pg8::BM; using pg8::HALF; using pg8::cvt_pk_bf16;
typedef unsigned u32x4 __attribute__((ext_vector_type(4)));
__device__ __forceinline__ u32x4 pack8(const f32x4& a, const f32x4& b) { u32x4 w; w.x = cvt_pk_bf16(a[0], a[1]); w.y = cvt_pk_bf16(a[2], a[3]); w.z = cvt_pk_bf16(b[0], b[1]); w.w = cvt_pk_bf16(b[2], b[3]); return w; }

#define SLAB_ADD(v, ai, bj, m, n) do { if constexpr (SL) (v) += *(const f32x4*)(slab + ((((ai) * 2 + (bj)) * 4 + (m)) * 2 + (n)) * 256); } while (0)
template <int MF = 4> struct EpiWin {
    static constexpr bool PERM = true, AFTER_DRAIN = false;
    bf16* P; float* ZS;
    template <bool SL> __device__ __forceinline__ void run(const f32x4 (&acc)[2][2][4][2], const Unit& u, int wr, int wc, int fr, int fq, const float* slab) const {
        const int row0 = u.pm * (64 * MF) + wr * (16 * MF) + fr, colt = u.pn * BM + wc * 32 + 8 * fq;
#pragma unroll
        for (int ai = 0; ai < 2; ++ai)
#pragma unroll
            for (int m = 0; m < MF; ++m) { const int row = row0 + ai * (32 * MF) + m * 16;
#pragma unroll
                for (int bj = 0; bj < 2; ++bj) { const int col = colt + bj * HALF; f32x4 a0 = acc[ai][bj][m][0], a1 = acc[ai][bj][m][1]; SLAB_ADD(a0, ai, bj, m, 0); SLAB_ADD(a1, ai, bj, m, 1);
                    if (u.pn < 6) *(u32x4*)(P + (size_t)row * 1536 + col) = pack8(a0, a1);
                    else { float* d = ZS + (size_t)row * 512 + (col - 1536); *(f32x4*)d = a0; *(f32x4*)(d + 4) = a1; } } }
    }
};
struct EpiStore {
    static constexpr bool PERM = true, AFTER_DRAIN = false;
    bf16* O; int ld;
    template <bool SL> __device__ __forceinline__ void run(const f32x4 (&acc)[2][2][4][2], const Unit& u, int wr, int wc, int fr, int fq, const float* slab) const {
        const int row0 = u.pm * BM + wr * 64 + fr, colt = u.pn * BM + wc * 32 + 8 * fq;
#pragma unroll
        for (int ai = 0; ai < 2; ++ai)
#pragma unroll
            for (int m = 0; m < 4; ++m) { const int row = row0 + ai * HALF + m * 16;
#pragma unroll
                for (int bj = 0; bj < 2; ++bj) *(u32x4*)(O + (size_t)row * ld + colt + bj * HALF) = pack8(acc[ai][bj][m][0], acc[ai][bj][m][1]); }
    }
};
struct EpiKV {
    static constexpr bool PERM = true, AFTER_DRAIN = false;
    bf16 *KFs, *KFp, *Vs, *Vp;
    template <bool SL> __device__ __forceinline__ void run(const f32x4 (&acc)[2][2][4][2], const Unit& u, int wr, int wc, int fr, int fq, const float* slab) const {
        const int m0 = u.pm * BM; bf16* kf; bf16* vv; int lk, key0, b;
        if (m0 < NP) { b = m0 / LP; key0 = 0; lk = LP; kf = KFp; vv = Vp; }
        else if (m0 < MT) { b = (m0 - NP) / LS; key0 = (m0 - NP) % LS; lk = LKS; kf = KFs; vv = Vs; }
        else { b = (m0 - MT) / PAST; key0 = LS + (m0 - MT) % PAST; lk = LKS; kf = KFs; vv = Vs; }
        const int h = u.pn;
        int rloc = wr * 64 + fr, c8 = wc * 32 + 8 * fq; asm volatile("" : "+v"(rloc), "+v"(c8));
#pragma unroll
        for (int ai = 0; ai < 2; ++ai)
#pragma unroll
            for (int m = 0; m < 4; ++m) { const int key = key0 + rloc + ai * HALF + m * 16; const size_t kr = (size_t)(b * NH + h) * lk + key;
                *(u32x4*)(kf + kr * DQK + c8) = pack8(acc[ai][0][m][0], acc[ai][0][m][1]);
                *(u32x4*)(vv + kr * DVH + c8) = pack8(acc[ai][1][m][0], acc[ai][1][m][1]); }
    }
};
template <int MF = 4, bool FROM_T = false> struct EpiRes {
    static constexpr bool PERM = false, AFTER_DRAIN = false;
    const float* xp; const float* xs; const float* gate;
    bf16* T; const float* stats; const float* lng; const float* lnb;
    template <bool SL> __device__ __forceinline__ void run(const f32x4 (&acc)[2][2][4][2], const Unit& u, int wr, int wc, int fr, int fq, const float* slab) const {
        const int m0 = u.pm * (64 * MF), row0 = m0 + wr * (16 * MF) + fr, col0 = u.pn * BM + wc * 32 + 4 * fq;
#pragma unroll
        for (int bj = 0; bj < 2; ++bj)
#pragma unroll
            for (int n = 0; n < 2; ++n) { const int col = col0 + bj * HALF + n * 16;
                f32x4 g4, b4; if constexpr (FROM_T) { g4 = *(const f32x4*)(lng + col); b4 = *(const f32x4*)(lnb + col); }
#pragma unroll
                for (int ai = 0; ai < 2; ++ai)
#pragma unroll
                    for (int m = 0; m < MF; ++m) { const int row = row0 + ai * (32 * MF) + m * 16;
                        const f32x4 gg = *(const f32x4*)(gate + (size_t)req_of_row(row) * 6144 + col);
                        f32x4 xv;
                        if constexpr (FROM_T) { const v2u w = *(const v2u*)(T + (size_t)row * DM + col); const float mean = stats[2 * row], rstd = stats[2 * row + 1];
                            const f32x4 t = {bf2f((unsigned short)(w.x & 0xffffu)), bf2f((unsigned short)(w.x >> 16)), bf2f((unsigned short)(w.y & 0xffffu)), bf2f((unsigned short)(w.y >> 16))};
                            xv = (t - mean) * rstd * g4 + b4; }
                        else { const float* xr = (row < NP) ? xp + (size_t)row * DM : xs + (size_t)(row - NP) * DM; xv = *(const f32x4*)(xr + col); }
                        f32x4 a = acc[ai][bj][m][n]; SLAB_ADD(a, ai, bj, m, n);
                        const f32x4 t2 = xv * ALPHA + gg * a; v2u o; o.x = cvt_pk_bf16(t2[0], t2[1]); o.y = cvt_pk_bf16(t2[2], t2[3]); *(v2u*)(T + (size_t)row * DM + col) = o; } }
    }
};
struct EpiUp {
    static constexpr bool PERM = true, AFTER_DRAIN = false;
    bf16* H;
    template <bool SL> __device__ __forceinline__ void run(const f32x4 (&acc)[2][2][4][2], const Unit& u, int wr, int wc, int fr, int fq, const float* slab) const {
        const int row0 = u.pm * BM + wr * 64 + fr, colt = u.pn * BM + wc * 32 + 8 * fq;
#pragma unroll
        for (int ai = 0; ai < 2; ++ai)
#pragma unroll
            for (int m = 0; m < 4; ++m) { const int row = row0 + ai * HALF + m * 16;
#pragma unroll
                for (int bj = 0; bj < 2; ++bj) { f32x4 a = acc[ai][bj][m][0], b = acc[ai][bj][m][1];
#pragma unroll
                    for (int e = 0; e < 4; ++e) { const float x = fmaxf(a[e], 0.f), y = fmaxf(b[e], 0.f); a[e] = x * x; b[e] = y * y; }
                    *(u32x4*)(H + (size_t)row * FF + colt + bj * HALF) = pack8(a, b); } }
    }
};
struct EpiFilt {
    static constexpr bool PERM = true, AFTER_DRAIN = false;
    bf16* GRB; float* FTP; float* FPS; float* FPP;
    template <bool SL> __device__ __forceinline__ void run(const f32x4 (&acc)[2][2][4][2], const Unit& u, int wr, int wc, int fr, int fq, const float* slab) const {
        int rl = wr * 64 + fr, clb = wc * 32 + 8 * fq; asm volatile("" : "+v"(rl), "+v"(clb));
        const bool smp = u.pm < 16; const int L = smp ? LS : LP; const float invL1 = 1.f / (float)(L - 1);
#pragma unroll
        for (int bj = 0; bj < 2; ++bj) { const int col0 = u.pn * BM + bj * HALF + clb;
            float asum[8];
#pragma unroll
            for (int e = 0; e < 8; ++e) asum[e] = 0.f;
#pragma unroll
            for (int ai = 0; ai < 2; ++ai)
#pragma unroll
                for (int m = 0; m < 4; ++m) { const int l = (smp ? u.pm * BM : 0) + rl + ai * HALF + m * 16; const float t = (float)l * invL1;
                    const f32x4 a0 = acc[ai][bj][m][0], a1 = acc[ai][bj][m][1]; const float av[8] = {a0[0], a0[1], a0[2], a0[3], a1[0], a1[1], a1[2], a1[3]};
#pragma unroll
                    for (int e = 0; e < 8; ++e) { const int col = col0 + e, ch = col & 511, half = col >> 9;
                        const float delta = fabsf(-3.0701134573253944f + (float)ch * ((-15.350567286626973f + 3.0701134573253944f) / 511.0f));
                        const float val = av[e] * fexp(-t * delta); asum[e] += fabsf(val);
                        if (smp) { bf16* g = GRB + (size_t)ch * 8192; if (half == 0) g[LS - l] = (bf16)f2bf(val); else g[l == 0 ? 0 : LS + l] = (bf16)(l == 0 ? 0u : f2bf(val)); }
                        else FTP[(size_t)col * LP + l] = val; } }
#pragma unroll
            for (int e = 0; e < 8; ++e) { float v = asum[e]; v += __shfl_xor(v, 1); v += __shfl_xor(v, 2); v += __shfl_xor(v, 4); v += __shfl_xor(v, 8); asum[e] = v; }
            if (fr == 0) {
#pragma unroll
                for (int e = 0; e < 8; ++e) { const int col = col0 + e; if (smp) FPS[col * 32 + u.pm * 2 + wr] = asum[e]; else FPP[col * 2 + wr] = asum[e]; } }
        }
    }
};
struct EpiDft {
    static constexpr bool PERM = true, AFTER_DRAIN = false;
    bf16* UV; int L, tokbase;
    template <bool SL> __device__ __forceinline__ void run(const f32x4 (&acc)[2][2][4][2], const Unit& u, int wr, int wc, int fr, int fq, const float* slab) const {
        int rl = wr * 64 + fr, cl = wc * 32 + 8 * fq; asm volatile("" : "+v"(rl), "+v"(cl));
        const int rho0 = u.pm * BM + rl, n0 = u.pn * BM + cl, hl = L >> 1;
#pragma unroll
        for (int ai = 0; ai < 2; ++ai)
#pragma unroll
            for (int m = 0; m < 4; ++m) { const int rho = rho0 + ai * HALF + m * 16; const int part = rho > hl ? 1 : 0; const int k = part ? rho - hl : rho;
#pragma unroll
                for (int bj = 0; bj < 2; ++bj) { const int n = n0 + bj * HALF, b = n >> 10, c = n & 1023;
                    f32x4 a0 = acc[ai][bj][m][0], a1 = acc[ai][bj][m][1]; SLAB_ADD(a0, ai, bj, m, 0); SLAB_ADD(a1, ai, bj, m, 1);
                    bf16* r1 = UV + (size_t)(tokbase + b * L + k) * 2048 + part * 1024 + c;
                    *(u32x4*)r1 = pack8(a0, a1);
                    if (k != 0 && k != hl) { bf16* r2 = UV + (size_t)(tokbase + b * L + (L - k)) * 2048 + part * 1024 + c;
                        *(u32x4*)r2 = part ? pack8(-a0, -a1) : pack8(a0, a1); }
                    else if (part == 0) { unsigned zz = 0u; asm volatile("" : "+v"(zz)); *(u32x4*)(r1 + 1024) = (u32x4){zz, zz, zz, zz}; } } }
    }
};

namespace att {
using bf16x8 = __attribute__((ext_vector_type(8))) short;
using s16x4  = __attribute__((ext_vector_type(4))) short;
using f32x16 = __attribute__((ext_vector_type(16))) float;
constexpr int DK = 192, DV = 128, NW = 8, QBLK = 32, KVBLK = 64;
constexpr float SCALE = 0.07216878364870322f;
constexpr float THR = 8.f;
constexpr int SHM_V = KVBLK * DV * 2, SHM_K = KVBLK * DK * 2, SHM_QR = 2 * SHM_V + 2 * SHM_K + NW * 64 * 4, NQR = 4  , SHM_ATTN = SHM_QR + NW * (12 - NQR) * 1024;
#define KSWZ(row, colB) ((row) * 384 + ((colB) ^ (((row) & 7) << 4)))
#define SBAR() __builtin_amdgcn_sched_barrier(0)
__device__ __forceinline__ int crow(int r, int hi) { return (r & 3) + 8 * (r >> 2) + 4 * hi; }
__device__ __forceinline__ unsigned cvtpk(float lo, float hi) { unsigned r; asm volatile("v_cvt_pk_bf16_f32 %0, %1, %2" : "=v"(r) : "v"(lo), "v"(hi)); return r; }
__device__ __forceinline__ void partialSM(f32x16& p0, f32x16& p1, float& m_reg, float& mn, float& alpha) {
  constexpr float C = SCALE * 1.4426950408889634f;
  float pmax = p0[0];
#pragma unroll
  for (int r = 1; r < 16; ++r) pmax = fmaxf(pmax, p0[r]);
#pragma unroll
  for (int r = 0; r < 16; ++r) pmax = fmaxf(pmax, p1[r]);
  { auto rr = __builtin_amdgcn_permlane32_swap(__float_as_uint(pmax), __float_as_uint(pmax), false, false);
    pmax = fmaxf(__uint_as_float(rr[0]), __uint_as_float(rr[1])); }
  if (__builtin_expect(__all(pmax - m_reg <= THR / SCALE), 1)) { mn = m_reg; alpha = 1.f; }
  else { mn = fmaxf(m_reg, pmax); alpha = __builtin_amdgcn_exp2f((m_reg - mn) * C); m_reg = mn; }
  float mnC = -mn * C;
#pragma unroll
  for (int r = 0; r < 16; ++r) p0[r] = fmaf(p0[r], C, mnC);
#pragma unroll
  for (int r = 0; r < 16; ++r) p1[r] = fmaf(p1[r], C, mnC);
#pragma unroll
  for (int r = 0; r < 16; ++r) p0[r] = __builtin_amdgcn_exp2f(p0[r]);
}
__device__ __forceinline__ void finishSM(f32x16& p0, f32x16& p1, float alpha, float& l_reg, bf16x8& pa0, bf16x8& pa1, bf16x8& pa2, bf16x8& pa3) {
#pragma unroll
  for (int r = 0; r < 16; ++r) p1[r] = __builtin_amdgcn_exp2f(p1[r]);
  float ps = 0;
#pragma unroll
  for (int r = 0; r < 16; ++r) ps += p0[r];
#pragma unroll
  for (int r = 0; r < 16; ++r) ps += p1[r];
  { auto rr = __builtin_amdgcn_permlane32_swap(__float_as_uint(ps), __float_as_uint(ps), false, false);
    ps = __uint_as_float(rr[0]) + __uint_as_float(rr[1]); }
  l_reg = l_reg * alpha + ps;
#define PK4(P, BASE, OUT) do { unsigned a0 = cvtpk(P[BASE + 0], P[BASE + 1]), a1 = cvtpk(P[BASE + 2], P[BASE + 3]);   \
    unsigned b0 = cvtpk(P[BASE + 4], P[BASE + 5]), b1 = cvtpk(P[BASE + 6], P[BASE + 7]);                              \
    auto r0 = __builtin_amdgcn_permlane32_swap(a0, b0, false, false); auto r1 = __builtin_amdgcn_permlane32_swap(a1, b1, false, false); \
    u32x4 w = {r0[0], r1[0], r0[1], r1[1]}; OUT = __builtin_bit_cast(bf16x8, w); } while (0)
  PK4(p0, 0, pa0); PK4(p0, 8, pa1); PK4(p1, 0, pa2); PK4(p1, 8, pa3);
#undef PK4
}
__device__ __forceinline__ void qkt(f32x16& p0, f32x16& p1, const LAS char* Ks, const bf16x8* qr, const LAS char* qrl, int r32, int hi) {
  p0 = f32x16{}; p1 = f32x16{};
#pragma unroll
  for (int d0 = 0; d0 < 12; ++d0) { const int cb = (d0 * 16 + hi * 8) * 2;
    bf16x8 b0 = *reinterpret_cast<const LAS bf16x8*>(Ks + KSWZ(r32, cb));
    bf16x8 b1 = *reinterpret_cast<const LAS bf16x8*>(Ks + KSWZ(32 + r32, cb));
    const bf16x8 qf = d0 < NQR ? qr[d0 < NQR ? d0 : 0] : *reinterpret_cast<const LAS bf16x8*>(qrl + (d0 - NQR) * 1024);
    p0 = __builtin_amdgcn_mfma_f32_32x32x16_bf16(b0, qf, p0, 0, 0, 0);
    p1 = __builtin_amdgcn_mfma_f32_32x32x16_bf16(b1, qf, p1, 0, 0, 0); }
}
__device__ __forceinline__ int v_st(int k, int c) { const int kk = (k & ~0xC) | ((k & 4) << 1) | ((k & 8) >> 1); return ((kk >> 3) * 4 + (c >> 5)) * 512 + ((kk & 7) * 32 + (c & 31)) * 2; }
__device__ __forceinline__ int v_rd_base(int lane) { return ((lane & 3) << 3) | (((lane >> 2) & 3) << 6) | (((lane >> 4) & 1) << 5) | (((lane >> 5) & 1) << 8); }
constexpr int v_rd_off(int d0, int ks, int half) { return d0 * 512 + ks * 4096 + half * 2048; }
template <int OFF> __device__ __forceinline__ s16x4 tr_read(int vb) {
  s16x4 r; asm volatile("ds_read_b64_tr_b16 %0, %1 offset:%2" : "=&v"(r) : "v"(vb), "i"(OFF) : "memory"); return r;
}
template <int D0> __device__ __forceinline__ void pv_one(f32x16& od, int vb, bf16x8 pa0, bf16x8 pa1, bf16x8 pa2, bf16x8 pa3) {
  const s16x4 l0 = tr_read<v_rd_off(D0, 0, 0)>(vb), h0 = tr_read<v_rd_off(D0, 0, 1)>(vb), l1 = tr_read<v_rd_off(D0, 1, 0)>(vb), h1 = tr_read<v_rd_off(D0, 1, 1)>(vb);
  const s16x4 l2 = tr_read<v_rd_off(D0, 2, 0)>(vb), h2 = tr_read<v_rd_off(D0, 2, 1)>(vb), l3 = tr_read<v_rd_off(D0, 3, 0)>(vb), h3 = tr_read<v_rd_off(D0, 3, 1)>(vb);
  asm volatile("s_waitcnt lgkmcnt(0)" ::: "memory"); SBAR();
#define PK(L, H) (bf16x8){L[0], L[1], L[2], L[3], H[0], H[1], H[2], H[3]}
  od = __builtin_amdgcn_mfma_f32_32x32x16_bf16(pa0, PK(l0, h0), od, 0, 0, 0);
  od = __builtin_amdgcn_mfma_f32_32x32x16_bf16(pa1, PK(l1, h1), od, 0, 0, 0);
  od = __builtin_amdgcn_mfma_f32_32x32x16_bf16(pa2, PK(l2, h2), od, 0, 0, 0);
  od = __builtin_amdgcn_mfma_f32_32x32x16_bf16(pa3, PK(l3, h3), od, 0, 0, 0);
#undef PK
}
__device__ __forceinline__ void pv_d0(f32x16* o, int vb, bf16x8 pa0, bf16x8 pa1, bf16x8 pa2, bf16x8 pa3) {
  pv_one<0>(o[0], vb, pa0, pa1, pa2, pa3); pv_one<1>(o[1], vb, pa0, pa1, pa2, pa3); pv_one<2>(o[2], vb, pa0, pa1, pa2, pa3); pv_one<3>(o[3], vb, pa0, pa1, pa2, pa3);
}
constexpr int LDQ = 768, LDK = DK, LDV = DV, LDO = 1024;
__device__ __forceinline__ void attn_dense_body(const bf16* __restrict__ Qb, const bf16* __restrict__ Kh, const bf16* __restrict__ Vh, bf16* __restrict__ Ob, int seq, int pos0, LAS char* lds, const int tid, float* part, unsigned* cnt, volatile LAS unsigned* misc) {
  const int wid = tid >> 6, lane = tid & 63, r32 = lane & 31, hi = lane >> 5;
  LAS char* V_lds = lds; LAS char* K_lds = lds + 2 * SHM_V;
  LAS float* ws = (LAS float*)(lds + 2 * SHM_V + 2 * SHM_K) + wid * 64; LAS float* li_l = ws; LAS float* al_l = ws + 32;
  float m_reg = -1e30f, l_reg = 0; f32x16 o[4] = {}; bf16x8 qr[NQR];
  const LAS char* qrl = lds + SHM_QR + wid * (12 - NQR) * 1024 + lane * 16;
  const bf16* Qw = Qb + (long)(wid * QBLK + r32) * LDQ + hi * 8;
#pragma unroll
  for (int d0 = 0; d0 < NQR; ++d0) qr[d0] = *reinterpret_cast<const bf16x8*>(Qw + d0 * 16);
  LAS char* qw = lds + SHM_QR + wid * (12 - NQR) * 1024 + lane * 16;
#pragma unroll
  for (int d0 = NQR; d0 < 8; ++d0) *(LAS bf16x8*)(qw + (d0 - NQR) * 1024) = *reinterpret_cast<const bf16x8*>(Qw + d0 * 16);
  {
    bf16x8 f0 = *reinterpret_cast<const bf16x8*>(Qw + 128), f1 = *reinterpret_cast<const bf16x8*>(Qw + 144), f2 = *reinterpret_cast<const bf16x8*>(Qw + 160), f3 = *reinterpret_cast<const bf16x8*>(Qw + 176);
    if (pos0 >= 0) { const int pos = pos0 + wid * QBLK + r32; const float pr = (float)(pos >> 6), pc = (float)(pos & 63);
#pragma unroll
      for (int i = 0; i < 8; ++i) { const float inv = __builtin_amdgcn_exp2f(-(float)(8 * hi + i) * (13.287712379549449f / 16.0f));
        { const float rev = pr * inv * INV_2PI, cs = fcos_rev(rev), sn = fsin_rev(rev); const float a = bf2f((unsigned short)f0[i]), b = bf2f((unsigned short)f1[i]);
          f0[i] = (short)f2bf(a * cs - b * sn); f1[i] = (short)f2bf(b * cs + a * sn); }
        { const float rev = pc * inv * INV_2PI, cs = fcos_rev(rev), sn = fsin_rev(rev); const float a = bf2f((unsigned short)f2[i]), b = bf2f((unsigned short)f3[i]);
          f2[i] = (short)f2bf(a * cs - b * sn); f3[i] = (short)f2bf(b * cs + a * sn); } } }
    *(LAS bf16x8*)(qw + (8 - NQR) * 1024) = f0; *(LAS bf16x8*)(qw + (9 - NQR) * 1024) = f1; *(LAS bf16x8*)(qw + (10 - NQR) * 1024) = f2; *(LAS bf16x8*)(qw + (11 - NQR) * 1024) = f3;
  }
  const int sr = tid >> 4, sc = (tid & 15) * 8, vst0 = v_st(sr, sc), vst1 = v_st(32 + sr, sc);
  const int kr = tid >> 3, kc = tid & 7, kgo = kr * LDK + kc * 8, kst = KSWZ(kr, kc * 16);
  const int vb0 = (int)(unsigned)(uintptr_t)V_lds + v_rd_base(lane);
  bf16x8 vs0, vs1, ks0, ks1, ks2;
#define SLOAD(k0) do { vs0 = *reinterpret_cast<const bf16x8*>(&Vh[(long)((k0) + sr) * LDV + sc]); vs1 = *reinterpret_cast<const bf16x8*>(&Vh[(long)((k0) + 32 + sr) * LDV + sc]); \
    ks0 = *reinterpret_cast<const bf16x8*>(&Kh[(long)(k0) * LDK + kgo]); ks1 = *reinterpret_cast<const bf16x8*>(&Kh[(long)(k0) * LDK + kgo + 64]); \
    ks2 = *reinterpret_cast<const bf16x8*>(&Kh[(long)(k0) * LDK + kgo + 128]); } while (0)
#define SWRITE(b) do { *(LAS bf16x8*)(V_lds + (b) * SHM_V + vst0) = vs0; *(LAS bf16x8*)(V_lds + (b) * SHM_V + vst1) = vs1; \
    *(LAS bf16x8*)(K_lds + (b) * SHM_K + kst) = ks0; *(LAS bf16x8*)(K_lds + (b) * SHM_K + kst + 128) = ks1; *(LAS bf16x8*)(K_lds + (b) * SHM_K + kst + 256) = ks2; } while (0)
#define SWAIT() asm volatile("s_waitcnt vmcnt(0)" ::: "memory")
#define RESC(a) do { if (__any((a) < 1.f)) { if (hi == 0) al_l[r32] = (a); asm volatile("s_waitcnt lgkmcnt(0)" ::: "memory"); \
    _Pragma("unroll") for (int d = 0; d < 4; ++d) _Pragma("unroll") for (int r = 0; r < 16; ++r) o[d][r] *= al_l[crow(r, hi)]; } } while (0)
  f32x16 pA0, pA1, pB0, pB1; float mnA, mnB, alA, alB; bf16x8 pa0, pa1, pa2, pa3; const int NT = seq / KVBLK;
  SLOAD(0); SWAIT(); SWRITE(0); __syncthreads();
  qkt(pA0, pA1, K_lds, qr, qrl, r32, hi); partialSM(pA0, pA1, m_reg, mnA, alA);
  SLOAD(KVBLK);
  SWAIT(); SWRITE(1); __syncthreads();
  for (int j = 1; j + 1 < NT; j += 2) {
    SBAR(); qkt(pB0, pB1, K_lds + SHM_K, qr, qrl, r32, hi);
    finishSM(pA0, pA1, alA, l_reg, pa0, pa1, pa2, pa3); SBAR();
    SLOAD((j + 1) * KVBLK); SBAR();
    pv_d0(o, vb0, pa0, pa1, pa2, pa3); partialSM(pB0, pB1, m_reg, mnB, alB);
    __syncthreads(); SWAIT(); SWRITE(0);
    RESC(alB); __syncthreads();
    SBAR(); qkt(pA0, pA1, K_lds, qr, qrl, r32, hi);
    finishSM(pB0, pB1, alB, l_reg, pa0, pa1, pa2, pa3); SBAR();
    SLOAD((j + 2) * KVBLK); SBAR();
    pv_d0(o, vb0 + SHM_V, pa0, pa1, pa2, pa3); partialSM(pA0, pA1, m_reg, mnA, alA);
    __syncthreads(); SWAIT(); SWRITE(1);
    RESC(alA); __syncthreads();
  }
  SBAR(); qkt(pB0, pB1, K_lds + SHM_K, qr, qrl, r32, hi);
  finishSM(pA0, pA1, alA, l_reg, pa0, pa1, pa2, pa3); SBAR();
  pv_d0(o, vb0, pa0, pa1, pa2, pa3); partialSM(pB0, pB1, m_reg, mnB, alB);
  __syncthreads(); RESC(alB);
  finishSM(pB0, pB1, alB, l_reg, pa0, pa1, pa2, pa3); SBAR();
  pv_d0(o, vb0 + SHM_V, pa0, pa1, pa2, pa3);
  bf16* Ow = Ob + (long)(wid * QBLK) * LDO;
  bool write_out = true; float g1 = 1.f;
  if (part) {
    if (tid == 0) misc[1] = __hip_atomic_fetch_add(cnt, 1u, __ATOMIC_RELAXED, __HIP_MEMORY_SCOPE_AGENT);
    __syncthreads();
    const unsigned ticket = misc[1];
    float* po = part + (size_t)wid * (4 * 16 * 64) + lane * 4; float* pml = part + 8 * 4 * 16 * 64 + wid * 128 + lane;
    if (ticket == 0u) {
#pragma unroll
      for (int d0 = 0; d0 < 4; ++d0)
#pragma unroll
        for (int r4 = 0; r4 < 4; ++r4) { const f32x4 v = {o[d0][4 * r4], o[d0][4 * r4 + 1], o[d0][4 * r4 + 2], o[d0][4 * r4 + 3]}; const float* p = po + (d0 * 4 + r4) * 256;
          asm volatile("global_store_dwordx4 %0, %1, off sc1\n\ts_nop 1" :: "v"(p), "v"(v) : "memory"); }
      __hip_atomic_store((unsigned*)pml, __float_as_uint(m_reg), __ATOMIC_RELAXED, __HIP_MEMORY_SCOPE_AGENT); __hip_atomic_store((unsigned*)pml + 64, __float_as_uint(l_reg), __ATOMIC_RELAXED, __HIP_MEMORY_SCOPE_AGENT);
      asm volatile("s_waitcnt vmcnt(0)" ::: "memory"); __syncthreads();
      if (tid == 0) __hip_atomic_store(cnt + 1, 1u, __ATOMIC_RELAXED, __HIP_MEMORY_SCOPE_AGENT);
      write_out = false;
    } else {
      if (tid == 0) { unsigned sp = 0; while (__hip_atomic_load(cnt + 1, __ATOMIC_RELAXED, __HIP_MEMORY_SCOPE_AGENT) == 0u) { __builtin_amdgcn_s_sleep(2); if (++sp > (1u << 22)) break; }
        __builtin_amdgcn_fence(__ATOMIC_ACQUIRE, "agent"); asm volatile("s_waitcnt vmcnt(0)" ::: "memory"); }
      __syncthreads();
      constexpr float C = SCALE * 1.4426950408889634f;
      const float m2 = pml[0], l2 = pml[64]; const float mn = fmaxf(m_reg, m2);
      const float f1 = __builtin_amdgcn_exp2f((m_reg - mn) * C), f2 = __builtin_amdgcn_exp2f((m2 - mn) * C); const float il = __builtin_amdgcn_rcpf(l_reg * f1 + l2 * f2);
      if (hi == 0) { li_l[r32] = f1 * il; al_l[r32] = f2 * il; } asm volatile("s_waitcnt lgkmcnt(0)" ::: "memory");
#pragma unroll
      for (int r4 = 0; r4 < 4; ++r4)
#pragma unroll
        for (int d0 = 0; d0 < 4; ++d0) { const f32x4 pv = *(const f32x4*)(po + (d0 * 4 + r4) * 256);
#pragma unroll
          for (int e = 0; e < 4; ++e) { const int r = 4 * r4 + e; o[d0][r] = o[d0][r] * li_l[crow(r, hi)] + pv[e] * al_l[crow(r, hi)]; } }
      g1 = 0.f;
    }
  }
  if (write_out) {
    if (g1 != 0.f) {
      if (hi == 0) li_l[r32] = l_reg; asm volatile("s_waitcnt lgkmcnt(0)" ::: "memory");
#pragma unroll
      for (int r = 0; r < 16; ++r) { const float rl = __builtin_amdgcn_rcpf(li_l[crow(r, hi)]);
#pragma unroll
        for (int d0 = 0; d0 < 4; ++d0) o[d0][r] *= rl; }
    }
#pragma unroll
    for (int r = 0; r < 16; ++r) { const int orow = crow(r, hi);
#pragma unroll
      for (int d0 = 0; d0 < 4; ++d0) Ow[(long)orow * LDO + d0 * 32 + r32] = (bf16)f2bf(o[d0][r]); }
  }
  __syncthreads();
#undef SLOAD
#undef SWRITE
#undef SWAIT
#undef RESC
}
#undef KSWZ
#undef SBAR
}
__device__ __forceinline__ void transpose_item(const float* W, int K, int N, bf16* WT, int ldk, LAS float* scr, int item, int lane) {
    const int nblk = N / 32, kb = item / nblk, nb = item % nblk, k0 = 64 * kb, n0 = 32 * nb;
#pragma unroll
    for (int i = 0; i < 32; ++i) { const int kk = 2 * i + (lane >> 5); scr[kk * 33 + (lane & 31)] = W[(size_t)(k0 + kk) * N + n0 + (lane & 31)]; }
    LDS_WAIT(); asm volatile("" ::: "memory");
    const int c = lane & 7;
#pragma unroll
    for (int j = 0; j < 4; ++j) { const int n = (lane >> 3) + 8 * j; const LAS float* s = scr + (8 * c) * 33 + n;
        v4u o; o.x = pk2(s[0 * 33], s[1 * 33]); o.y = pk2(s[2 * 33], s[3 * 33]); o.z = pk2(s[4 * 33], s[5 * 33]); o.w = pk2(s[6 * 33], s[7 * 33]);
        *(v4u*)(WT + (size_t)(n0 + n) * ldk + k0 + 8 * c) = o; }
    LDS_WAIT(); asm volatile("" ::: "memory");
}
constexpr int WI_P0 = 992 + 96 + 64 + 512 + 512 + 32, WI_P1 = WI_P0 + 2 * 2048, WI_ALL = WI_P1 + 2 * 2048;
__device__ __forceinline__ void weight_item(const Args& args, unsigned char* ws, LAS float* scr, int idx, int lane) {
    constexpr int I0 = 992, I1 = 96, I2 = 64, I3 = 512, I4 = 2048;
    int r = idx, K, N, ldk; size_t off; const float* W;
    if (r < I0) { W = args.in[I_WIN]; K = 1024; N = 1984; ldk = 1024; off = WS_WIN_T; }
    else if ((r -= I0) < I1) { W = args.in[I_QUP]; K = 256; N = 768; ldk = 256; off = WS_QUP_T; }
    else if ((r -= I1) < I2) { W = args.in[I_KVUP]; K = 128; N = 1024; ldk = 256; off = WS_KVUP_T; }
    else if ((r -= I2) < I3) { W = args.in[I_WOUT0]; K = 1024; N = 1024; ldk = 1024; off = WS_WOUT0_T; }
    else if ((r -= I3) < I3) { W = args.in[I_WOUT1]; K = 1024; N = 1024; ldk = 1024; off = WS_W1T; }
    else if ((r -= I3) < 32) { W = args.in[I_HFW3]; K = 64; N = 1024; ldk = 256; off = WS_W3T; }
    else if ((r -= 32) < I4) { W = args.in[I_W1_0]; K = 1024; N = 4096; ldk = 1024; off = WS_W1_0; }
    else if ((r -= I4) < I4) { W = args.in[I_W2_0]; K = 4096; N = 1024; ldk = 4096; off = WS_W2_0; }
    else if ((r -= I4) < I4) { W = args.in[I_W1_1]; K = 1024; N = 4096; ldk = 1024; off = WS_W1_1; }
    else { r -= I4; W = args.in[I_W2_1]; K = 4096; N = 1024; ldk = 4096; off = WS_W2_1; }
    transpose_item(W, K, N, (bf16*)(ws + off), ldk, scr, r, lane);
}
__device__ __forceinline__ void row_stats(const f32x4 (&v)[4], float& mean, float& rstd) {
    float s = 0.f;
#pragma unroll
    for (int j = 0; j < 4; ++j) s += (v[j][0] + v[j][1]) + (v[j][2] + v[j][3]);
    mean = wave_sum(s) * (1.f / DM); float q = 0.f;
#pragma unroll
    for (int j = 0; j < 4; ++j) { const f32x4 d = v[j] - mean; q += (d[0] * d[0] + d[1] * d[1]) + (d[2] * d[2] + d[3] * d[3]); }
    rstd = __builtin_amdgcn_rsqf(wave_sum(q) * (1.f / DM) + LN_EPS);
}
__device__ __forceinline__ void load_row(const bf16* p, int lane, f32x4 (&v)[4]) {
#pragma unroll
    for (int j = 0; j < 4; ++j) { const v2u w = ((const v2u*)p)[lane + 64 * j]; v[j] = (f32x4){bf2f((unsigned short)(w.x & 0xffffu)), bf2f((unsigned short)(w.x >> 16)), bf2f((unsigned short)(w.y & 0xffffu)), bf2f((unsigned short)(w.y >> 16))}; }
}
__device__ __forceinline__ void load_row(const float* p, int lane, f32x4 (&v)[4]) {
#pragma unroll
    for (int j = 0; j < 4; ++j) v[j] = ((const f32x4*)p)[lane + 64 * j];
}
__device__ __forceinline__ void adaln_store(const f32x4 (&v)[4], const float* shift, const float* scale, bf16* hrow, int lane) {
    float mean, rstd; row_stats(v, mean, rstd);
#pragma unroll
    for (int j = 0; j < 4; ++j) { const int c = 4 * lane + 256 * j; const f32x4 sc = *(const f32x4*)(scale + c), sh = *(const f32x4*)(shift + c);
        const f32x4 h = (v[j] - mean) * rstd * (sc + 1.0f) + sh;
        v2u w; w.x = pk2(h[0], h[1]); w.y = pk2(h[2], h[3]); *(v2u*)(hrow + c) = w; }
}
__device__ __forceinline__ void ln_affine(f32x4 (&v)[4], const float* g, const float* b, int lane, float* st = nullptr) {
    float mean, rstd; row_stats(v, mean, rstd);
    if (st && lane == 0) { st[0] = mean; st[1] = rstd; }
#pragma unroll
    for (int j = 0; j < 4; ++j) { const int c = 4 * lane + 256 * j; v[j] = (v[j] - mean) * rstd * *(const f32x4*)(g + c) + *(const f32x4*)(b + c); }
}
__device__ __forceinline__ float grp16_sum(float v) { v += __shfl_xor(v, 1); v += __shfl_xor(v, 2); v += __shfl_xor(v, 4); v += __shfl_xor(v, 8); return v; }
__device__ __forceinline__ void row16_stats(const f32x4 (&v)[16], float& mean, float& rstd) {
    float s = 0.f;
#pragma unroll
    for (int j = 0; j < 16; ++j) s += (v[j][0] + v[j][1]) + (v[j][2] + v[j][3]);
    mean = grp16_sum(s) * (1.f / DM); float q = 0.f;
#pragma unroll
    for (int j = 0; j < 16; ++j) { const f32x4 d = v[j] - mean; q += (d[0] * d[0] + d[1] * d[1]) + (d[2] * d[2] + d[3] * d[3]); }
    rstd = __builtin_amdgcn_rsqf(grp16_sum(q) * (1.f / DM) + LN_EPS);
}
__device__ __forceinline__ void load_row16(const float* p, int cl, f32x4 (&v)[16]) {
#pragma unroll
    for (int j = 0; j < 16; ++j) v[j] = ((const f32x4*)p)[cl + 16 * j];
}
__device__ __forceinline__ void load_row16(const bf16* p, int cl, f32x4 (&v)[16]) {
#pragma unroll
    for (int j = 0; j < 16; ++j) { const v2u w = ((const v2u*)p)[cl + 16 * j]; v[j] = (f32x4){bf2f((unsigned short)(w.x & 0xffffu)), bf2f((unsigned short)(w.x >> 16)), bf2f((unsigned short)(w.y & 0xffffu)), bf2f((unsigned short)(w.y >> 16))}; }
}
__device__ __forceinline__ void adaln_store16(const f32x4 (&v)[16], const float* shift, const float* scale, bf16* hrow, int cl) {
    float mean, rstd; row16_stats(v, mean, rstd);
#pragma unroll
    for (int j = 0; j < 16; ++j) { const int c = 4 * cl + 64 * j; const f32x4 sc = *(const f32x4*)(scale + c), sh = *(const f32x4*)(shift + c);
        const f32x4 h = (v[j] - mean) * rstd * (sc + 1.0f) + sh;
        v2u w; w.x = pk2(h[0], h[1]); w.y = pk2(h[2], h[3]); *(v2u*)(hrow + c) = w;
        if ((j & 3) == 3) asm volatile("" ::: "memory"); }
}
__device__ __forceinline__ void ln_affine16(f32x4 (&v)[16], const float* g, const float* b, int cl, float* st = nullptr) {
    float mean, rstd; row16_stats(v, mean, rstd);
    if (st && cl == 0) { st[0] = mean; st[1] = rstd; }
#pragma unroll
    for (int j = 0; j < 16; ++j) { const int c = 4 * cl + 64 * j; v[j] = (v[j] - mean) * rstd * *(const f32x4*)(g + c) + *(const f32x4*)(b + c); if ((j & 3) == 3) asm volatile("" ::: "memory"); }
}
__device__ __forceinline__ void store_row16(float* p, int cl, const f32x4 (&v)[16]) {
#pragma unroll
    for (int j = 0; j < 16; ++j) ((f32x4*)p)[cl + 16 * j] = v[j];
}
__device__ __forceinline__ void store_row(float* p, int lane, const f32x4 (&v)[4]) {
#pragma unroll
    for (int j = 0; j < 4; ++j) ((f32x4*)p)[lane + 64 * j] = v[j];
}

namespace hconv {
using bf16x8 = __attribute__((ext_vector_type(8))) short;
using f32x16 = __attribute__((ext_vector_type(16))) float;
constexpr int UB = 8256;
constexpr int SLOT = 16384 + 2 * UB;
__device__ __forceinline__ int crow(int r, int hi) { return (r & 3) + 8 * (r >> 2) + 4 * hi; }
__device__ __forceinline__ void item(const bf16* __restrict__ GRB, const bf16* __restrict__ UT, const float* __restrict__ FP, const float* __restrict__ skipv, const bf16* __restrict__ X0, bf16* __restrict__ YM,
                                     int ch0, LAS unsigned char* lds, const int tid, const int lane, const int wave) {
    for (int q = tid; q < 4 * 1024; q += 512) { const int ch = q >> 10, i = q & 1023; const v4u v = ((const v4u*)(GRB + (size_t)(ch0 + ch) * 8192))[i]; *(LAS v4u*)(lds + ch * SLOT + 16 * i) = v; }
    for (int q = tid; q < 4 * 1024; q += 512) { const int ch = q >> 10, b = (q >> 9) & 1, i = q & 511; const v4u v = ((const v4u*)(UT + ((size_t)b * HY + ch0 + ch) * LS))[i];
        *(LAS v4u*)(lds + ch * SLOT + 16384 + b * UB + 32 + 16 * i) = v; }
    if (tid < 32) { const int ch = tid >> 3, b = (tid >> 2) & 1, j = tid & 3; const v4u z = {0u, 0u, 0u, 0u};
        *(LAS v4u*)(lds + ch * SLOT + 16384 + b * UB + (j < 2 ? 16 * j : 32 + 8192 + 16 * (j - 2))) = z; }
    __syncthreads();
    v2u x0v[16];
    {
        const int slot = wave & 3, khalf = wave >> 2;
        const LAS unsigned char* gr = lds + slot * SLOT; const LAS unsigned char* ubuf = gr + 16384;
        const int r = lane & 31, h = lane >> 5, c = r & 15, b = r >> 4, c0 = c & 1, c1 = c >> 1;
        const LAS unsigned char* ap = gr + 992 + 16 * h - 32 * r + khalf * (129 * 32);
        const LAS unsigned char* bp = ubuf + b * UB + 16 * h + 4 * c1 + khalf * (129 * 32);
        const unsigned sh = 16u * (unsigned)c0;
        const int ch = ch0 + slot;
        const float nsum = wave_sum(lane < 32 ? FP[ch * 32 + lane] + FP[(HY + ch) * 32 + lane] : 0.f); const float inv_norm = 1.f / nsum; const float skn = skipv[ch] * nsum;
        const LAS bf16* ul = (const LAS bf16*)(ubuf + b * UB + 32);
        f32x16 acc[8];
#pragma unroll
        for (int Q = 0; Q < 8; ++Q)
#pragma unroll
            for (int g = 0; g < 16; ++g) acc[Q][g] = khalf ? 0.f : skn * bf2f(ul[16 * (32 * Q + crow(g, h)) + c]);
        int nks = khalf ? 128 : 129; asm volatile("" : "+s"(nks));
        unsigned aa = (unsigned)(uintptr_t)ap, ba = (unsigned)(uintptr_t)bp;
        bf16x8 fa0, fa1, fa2, fa3, fa4, fa5, fa6, fa7, fb0, fb1, fb2, fb3, fb4, fb5, fb6, fb7; v2u da01, da23, db01, db23; unsigned da4, db4;
#define HC_LD(F0, F1, F2, F3, F4, F5, F6, F7, D01, D23, D4) do { \
            asm volatile("ds_read_b128 %0, %1 offset:7168" : "=v"(F0) : "v"(aa)); asm volatile("ds_read_b128 %0, %1 offset:6144" : "=v"(F1) : "v"(aa)); \
            asm volatile("ds_read2_b32 %0, %1 offset1:1" : "=v"(D01) : "v"(ba)); asm volatile("ds_read2_b32 %0, %1 offset0:2 offset1:3" : "=v"(D23) : "v"(ba)); asm volatile("ds_read_b32 %0, %1 offset:16" : "=v"(D4) : "v"(ba)); \
            asm volatile("ds_read_b128 %0, %1 offset:5120" : "=v"(F2) : "v"(aa)); asm volatile("ds_read_b128 %0, %1 offset:4096" : "=v"(F3) : "v"(aa)); \
            asm volatile("ds_read_b128 %0, %1 offset:3072" : "=v"(F4) : "v"(aa)); asm volatile("ds_read_b128 %0, %1 offset:2048" : "=v"(F5) : "v"(aa)); \
            asm volatile("ds_read_b128 %0, %1 offset:1024" : "=v"(F6) : "v"(aa)); asm volatile("ds_read_b128 %0, %1" : "=v"(F7) : "v"(aa)); __builtin_amdgcn_sched_barrier(0); } while (0)
#define HC_WAIT(F0, F1, F2, F3, F4, F5, F6, F7, D01, D23, D4) do { __builtin_amdgcn_sched_barrier(0); asm volatile("s_waitcnt lgkmcnt(0)" : "+v"(F0), "+v"(F1), "+v"(F2), "+v"(F3), "+v"(F4), "+v"(F5), "+v"(F6), "+v"(F7), "+v"(D01), "+v"(D23), "+v"(D4)); \
            __builtin_amdgcn_sched_barrier(0); } while (0)
#define HC_MMA(F0, F1, F2, F3, F4, F5, F6, F7, D01, D23, D4) do { u32x4 bw; bw.x = __builtin_amdgcn_alignbit(D01.y, D01.x, sh); bw.y = __builtin_amdgcn_alignbit(D23.x, D01.y, sh); bw.z = __builtin_amdgcn_alignbit(D23.y, D23.x, sh); \
            bw.w = __builtin_amdgcn_alignbit(D4, D23.y, sh); const bf16x8 bf = __builtin_bit_cast(bf16x8, bw); \
            acc[0] = __builtin_amdgcn_mfma_f32_32x32x16_bf16(F0, bf, acc[0], 0, 0, 0); acc[1] = __builtin_amdgcn_mfma_f32_32x32x16_bf16(F1, bf, acc[1], 0, 0, 0); \
            acc[2] = __builtin_amdgcn_mfma_f32_32x32x16_bf16(F2, bf, acc[2], 0, 0, 0); acc[3] = __builtin_amdgcn_mfma_f32_32x32x16_bf16(F3, bf, acc[3], 0, 0, 0); \
            acc[4] = __builtin_amdgcn_mfma_f32_32x32x16_bf16(F4, bf, acc[4], 0, 0, 0); acc[5] = __builtin_amdgcn_mfma_f32_32x32x16_bf16(F5, bf, acc[5], 0, 0, 0); \
            acc[6] = __builtin_amdgcn_mfma_f32_32x32x16_bf16(F6, bf, acc[6], 0, 0, 0); acc[7] = __builtin_amdgcn_mfma_f32_32x32x16_bf16(F7, bf, acc[7], 0, 0, 0); } while (0)
        HC_LD(fa0, fa1, fa2, fa3, fa4, fa5, fa6, fa7, da01, da23, da4);
        int npair = nks >> 1;
        for (int kp = 0; kp < npair; ++kp) {
            HC_WAIT(fa0, fa1, fa2, fa3, fa4, fa5, fa6, fa7, da01, da23, da4);
            aa += 32; ba += 32; HC_LD(fb0, fb1, fb2, fb3, fb4, fb5, fb6, fb7, db01, db23, db4);
            HC_MMA(fa0, fa1, fa2, fa3, fa4, fa5, fa6, fa7, da01, da23, da4);
            HC_WAIT(fb0, fb1, fb2, fb3, fb4, fb5, fb6, fb7, db01, db23, db4);
            aa += 32; ba += 32; HC_LD(fa0, fa1, fa2, fa3, fa4, fa5, fa6, fa7, da01, da23, da4);
            HC_MMA(fb0, fb1, fb2, fb3, fb4, fb5, fb6, fb7, db01, db23, db4);
        }
        HC_WAIT(fa0, fa1, fa2, fa3, fa4, fa5, fa6, fa7, da01, da23, da4);
        if (nks & 1) HC_MMA(fa0, fa1, fa2, fa3, fa4, fa5, fa6, fa7, da01, da23, da4);
#undef HC_LD
#undef HC_WAIT
#undef HC_MMA
#pragma unroll
        for (int i = 0; i < 16; ++i) { const int q = tid + 512 * i; x0v[i] = *(const v2u*)(X0 + ((size_t)NP + q) * HY + ch0); }
        asm volatile("s_waitcnt lgkmcnt(0)" ::: "memory");
        __syncthreads();
        LAS f32x4* xch = (LAS f32x4*)(lds + slot * SLOT);
        if (khalf) {
#pragma unroll
            for (int Q = 0; Q < 8; ++Q)
#pragma unroll
                for (int g4 = 0; g4 < 4; ++g4) xch[(Q * 4 + g4) * 64 + lane] = (f32x4){acc[Q][4 * g4], acc[Q][4 * g4 + 1], acc[Q][4 * g4 + 2], acc[Q][4 * g4 + 3]};
        }
        __syncthreads();
        if (!khalf) {
#pragma unroll
            for (int Q = 0; Q < 8; ++Q)
#pragma unroll
                for (int g4 = 0; g4 < 4; ++g4) { const f32x4 o = xch[(Q * 4 + g4) * 64 + lane]; acc[Q][4 * g4] += o[0]; acc[Q][4 * g4 + 1] += o[1]; acc[Q][4 * g4 + 2] += o[2]; acc[Q][4 * g4 + 3] += o[3]; }
        }
        asm volatile("s_waitcnt lgkmcnt(0)" ::: "memory");
        __syncthreads();
        if (!khalf) {
            LAS bf16* yl = (LAS bf16*)(lds + slot * SLOT);
#pragma unroll
            for (int Q = 0; Q < 8; ++Q)
#pragma unroll
                for (int g = 0; g < 16; ++g) { const int t = 16 * (32 * Q + crow(g, h)) + c; yl[b * LS + t] = (bf16)f2bf(acc[Q][g] * inv_norm); }
        }
    }
    __syncthreads();
#pragma unroll
    for (int i = 0; i < 16; ++i) { const int q = tid + 512 * i; const size_t row = (size_t)NP + q; const v2u xv = x0v[i];
        const float y0 = bf2f(*(const LAS bf16*)(lds + 0 * SLOT + 2 * q)), y1 = bf2f(*(const LAS bf16*)(lds + 1 * SLOT + 2 * q)), y2 = bf2f(*(const LAS bf16*)(lds + 2 * SLOT + 2 * q)), y3 = bf2f(*(const LAS bf16*)(lds + 3 * SLOT + 2 * q));
        v2u o; o.x = pk2(y0 * bf2f((unsigned short)(xv.x & 0xffffu)), y1 * bf2f((unsigned short)(xv.x >> 16))); o.y = pk2(y2 * bf2f((unsigned short)(xv.y & 0xffffu)), y3 * bf2f((unsigned short)(xv.y >> 16)));
        *(v2u*)(YM + row * DM + ch0) = o; }
    __syncthreads();
}
constexpr int PUB = 576, PSLOT = 1024 + 16 * PUB;
__device__ __forceinline__ void prompt_item(const float* __restrict__ FT, const bf16* __restrict__ UT, const float* __restrict__ FP, const float* __restrict__ skipv, const bf16* __restrict__ X0, bf16* __restrict__ YM,
                                            int ch0, LAS unsigned char* lds, const int tid, const int lane, const int wave) {
    const int ch = ch0 + wave; LAS unsigned char* slot = lds + wave * PSLOT;
    {
        LAS bf16* gr = (LAS bf16*)slot;
#pragma unroll
        for (int i = 0; i < 8; ++i) { const int e = lane + 64 * i; const int d = LP - e; float v = 0.f; if (e != 0) v = d >= 0 ? FT[(size_t)ch * LP + d] : FT[(size_t)(HY + ch) * LP - d]; gr[e] = (bf16)f2bf(v); }
#pragma unroll
        for (int i = 0; i < 8; ++i) { const int q = lane + 64 * i, b = q >> 5, j = q & 31; const v4u v = ((const v4u*)(UT + ((size_t)b * HY + ch) * LP))[j]; *(LAS v4u*)(slot + 1024 + b * PUB + 32 + 16 * j) = v; }
        { const int b = lane >> 2, j = lane & 3; const v4u z = {0u, 0u, 0u, 0u}; *(LAS v4u*)(slot + 1024 + b * PUB + (j < 2 ? 16 * j : 32 + 512 + 16 * (j - 2))) = z; }
    }
    asm volatile("s_waitcnt vmcnt(0) lgkmcnt(0)" ::: "memory");
    const int r = lane & 31, h = lane >> 5, c = r & 15, bh = r >> 4, c0 = c & 1, c1 = c >> 1; const unsigned sh = 16u * (unsigned)c0;
    const float nsum = (FP[ch * 2] + FP[ch * 2 + 1]) + (FP[(HY + ch) * 2] + FP[(HY + ch) * 2 + 1]);
    const float inv_norm = 1.f / nsum, skn = skipv[ch] * nsum;
    const LAS unsigned char* ubuf = slot + 1024;
    f32x16 acc[8];
#pragma unroll
    for (int ct = 0; ct < 8; ++ct) { const LAS bf16* ul = (const LAS bf16*)(ubuf + (2 * ct + bh) * PUB + 32);
#pragma unroll
        for (int g = 0; g < 16; ++g) acc[ct][g] = g < 8 ? skn * bf2f(ul[16 * crow(g, h) + c]) : 0.f; }
    const LAS unsigned char* ap = slot + 2 * (240 - 16 * (r < 15 ? r : 15) + 8 * h);
    const LAS unsigned char* bp = ubuf + bh * PUB + 16 * h + 4 * c1;
    int nks = 17; asm volatile("" : "+s"(nks));
    for (int ks = 0; ks < nks; ++ks) {
        const bf16x8 af = *(const LAS bf16x8*)(ap + 32 * ks);
#pragma unroll
        for (int ct = 0; ct < 8; ++ct) { const LAS unsigned* bq = (const LAS unsigned*)(bp + 2 * ct * PUB + 32 * ks);
            const unsigned d0 = bq[0], d1 = bq[1], d2 = bq[2], d3 = bq[3], d4 = bq[4];
            u32x4 bw; bw.x = __builtin_amdgcn_alignbit(d1, d0, sh); bw.y = __builtin_amdgcn_alignbit(d2, d1, sh); bw.z = __builtin_amdgcn_alignbit(d3, d2, sh); bw.w = __builtin_amdgcn_alignbit(d4, d3, sh);
            acc[ct] = __builtin_amdgcn_mfma_f32_32x32x16_bf16(af, __builtin_bit_cast(bf16x8, bw), acc[ct], 0, 0, 0); }
    }
    asm volatile("s_waitcnt lgkmcnt(0)" ::: "memory");
    {
        LAS bf16* yl = (LAS bf16*)(slot + 1024);
#pragma unroll
        for (int ct = 0; ct < 8; ++ct)
#pragma unroll
            for (int g = 0; g < 8; ++g) yl[(2 * ct + bh) * LP + 16 * crow(g, h) + c] = (bf16)f2bf(acc[ct][g] * inv_norm);
    }
    __syncthreads();
#pragma unroll
    for (int i = 0; i < 8; ++i) { const int q = tid + 512 * i;
        const v4u xv = *(const v4u*)(X0 + (size_t)q * HY + ch0); unsigned xw[4] = {xv.x, xv.y, xv.z, xv.w}, ow[4];
#pragma unroll
        for (int k = 0; k < 4; ++k) { const float ya = bf2f(*(const LAS bf16*)(lds + (2 * k) * PSLOT + 1024 + 2 * q)), yb = bf2f(*(const LAS bf16*)(lds + (2 * k + 1) * PSLOT + 1024 + 2 * q));
            ow[k] = pk2(ya * bf2f((unsigned short)(xw[k] & 0xffffu)), yb * bf2f((unsigned short)(xw[k] >> 16))); }
        *(v4u*)(YM + (size_t)q * DM + ch0) = (v4u){ow[0], ow[1], ow[2], ow[3]}; }
    __syncthreads();
}
static_assert(4 * SLOT <= LDSCTL_OFF, "four channel slots fit in LDS");
}

__global__ void __launch_bounds__(512, 2) fwd_kernel(Args args) {
    extern __shared__ __attribute__((aligned(16))) unsigned char lds_raw[];
    LAS unsigned char* lds = (LAS unsigned char*)lds_raw;
    volatile LAS unsigned* MISC = (volatile LAS unsigned*)(lds + MISC_OFF);
    const int wave = __builtin_amdgcn_readfirstlane((int)threadIdx.x >> 6);
    const int G = gridDim.x; const int bx = blockIdx.x; const int vcu = (G % 8 == 0) ? (bx % 8) * (G / 8) + bx / 8 : bx;
    const int gw = vcu * 8 + wave, NGW = G * 8, NGT = G * 512;
#define FRESH() const int lane = fresh_lane(); const int tid = wave * 64 + lane; const int gt = vcu * 512 + tid; (void)gt
    unsigned char* ws = args.ws;
    gu32* ctl = (gu32*)(ws + WS_CTL);
    float* MODS = (float*)(ws + WS_MODS);
    float* X = args.out;
    float* STATS = (float*)(ws + WS_STATS);
    bf16* T = (bf16*)(ws + WS_T);
    bf16* HB = (bf16*)(ws + WS_H);
    for (int u = threadIdx.x; u < (LDS_BYTES - LDSCTL_OFF) / 4; u += 512) ((LAS unsigned*)(lds + LDSCTL_OFF))[u] = 0u;
    __syncthreads();
    XcdBarrier bar; bar.bar = (unsigned*)(ctl + CW_BAR) + args.li * XCD_BAR_WORDS; bar.x = 0; bar.st = nullptr;
    if (!MK_PER_PHASE) bar = xcd_barrier_post((unsigned*)(ctl + CW_BAR) + args.li * XCD_BAR_WORDS, MISC + 8);
    const int lo = args.ph_lo, hi = args.ph_hi;
#ifndef NO_CONV
#define NO_CONV 0
#endif
#ifndef NO_ATT
#define NO_ATT 0
#endif
#ifndef PHASE_MASK
#define PHASE_MASK 0x1FFFF
#endif
#define IN(k) ((((PHASE_MASK) >> (k)) & 1) && lo <= (k) && (k) < hi)
#define SPLIT_CNT(b) ((unsigned*)(ctl + CW_SPLIT + (args.li * 6 + (b)) * 16384))
#define SLABS(mib) ((float*)(ws + (size_t)(mib) * MiB))
#define SEAM(k) do { if (IN(k) && IN((k) + 1)) xcd_barrier(bar); } while (0)

    if (IN(0)) {
        FRESH();
        asm volatile("; ==== PHASE 0 ====");
        for (int it = bx; it < 192; it += G) {
            const int layer = it / 96, cb = it % 96, col = cb * 64 + lane;
            LAS float* sil = (LAS float*)lds; LAS float* red = (LAS float*)(lds + 12288);
            for (int i = tid; i < 3072; i += 512) { const int r = i >> 10, k = i & 1023; const float c = (r == 0) ? args.in[I_CCTX][k] : args.in[I_C][(r - 1) * DM + k]; sil[i] = c / (1.f + fexp(-c)); }
            __syncthreads();
            const float* W = args.in[layer ? I_ADA1_W : I_ADA0_W]; float a0 = 0.f, a1 = 0.f, a2 = 0.f;
#pragma unroll 8
            for (int kk = 0; kk < 128; ++kk) { const int k = wave * 128 + kk; const float w = W[(size_t)k * 6144 + col]; a0 += sil[k] * w; a1 += sil[1024 + k] * w; a2 += sil[2048 + k] * w; }
            red[(wave * 3 + 0) * 64 + lane] = a0; red[(wave * 3 + 1) * 64 + lane] = a1; red[(wave * 3 + 2) * 64 + lane] = a2;
            __syncthreads();
            if (tid < 192) { const int r = tid >> 6, l = tid & 63; float s = 0.f;
#pragma unroll
                for (int w = 0; w < 8; ++w) s += red[(w * 3 + r) * 64 + l];
                MODS[(size_t)(layer * 3 + r) * 6144 + cb * 64 + l] = s + args.in[layer ? I_ADA1_B : I_ADA0_B][cb * 64 + l]; }
            __syncthreads();
        }
        {
            LAS float* scr = (LAS float*)(lds + wave * 16384);
            for (int it = gw; it < WI_P0; it += NGW) weight_item(args, ws, scr, it, lane);
        }
        for (int i = gt; i < 2048 * 128; i += NGT) { const int kp = i >> 7, c8 = (i & 127) * 8; const int part = kp >> 10, kq = kp & 1023, g = kq >> 7, cp = kq & 127; unsigned w[4] = {0u, 0u, 0u, 0u};
            if ((c8 >> 7) == g) {
#pragma unroll
                for (int e = 0; e < 8; e += 2) { const float r0 = (float)((cp * ((c8 + e) & 127)) & 127) * (1.f / 128.f), r1 = (float)((cp * ((c8 + e + 1) & 127)) & 127) * (1.f / 128.f);
                    const float a = (part ? -__builtin_amdgcn_sinf(r0) : __builtin_amdgcn_cosf(r0)) * 0.08838834764831845f, b = (part ? -__builtin_amdgcn_sinf(r1) : __builtin_amdgcn_cosf(r1)) * 0.08838834764831845f;
                    w[e >> 1] = pk2(a, b); } }
            ((v4u*)(ws + WS_CBD))[i] = (v4u){w[0], w[1], w[2], w[3]}; }
        {
            const v4u z = {0u, 0u, 0u, 0u};
            for (int i = gt; i < 8192 + 16384 + MKV * 16 + 1024 * 24; i += NGT) {
                if (i < 8192) ((v4u*)(ws + WS_WIN_T + (size_t)1984 * 2048))[i] = z;
                else if (i < 8192 + 16384) { const int j = i - 8192; *(v4u*)(ws + WS_KVUP_T + (size_t)(j >> 4) * 512 + 256 + (j & 15) * 16) = z; }
                else if (i < 8192 + 16384 + MKV * 16) { const int j = i - 8192 - 16384; *(v4u*)(ws + WS_KVN + (size_t)(j >> 4) * 512 + 256 + (j & 15) * 16) = z; }
                else { const int j = i - 8192 - 16384 - MKV * 16; *(v4u*)(ws + WS_W3T + (size_t)(j / 24) * 512 + 128 + (j % 24) * 16) = z; }
            }
        }
        for (int i = gt; i < 65536; i += NGT) { const int rho = i >> 8, l = i & 255; const int k = rho > 128 ? rho - 128 : rho; const float rev = (float)((k * l) & 255) * (1.f / 256.f);
            ((bf16*)(ws + WS_D256))[i] = (bf16)f2bf((rho > 128 ? __builtin_amdgcn_sinf(rev) : __builtin_amdgcn_cosf(rev)) * 0.0625f); }
        {
            bf16* H2B = (bf16*)(ws + WS_H2B);
            const float* w1 = args.in[I_HFW1]; const float* w2 = args.in[I_HFW2];
            const float b1 = args.in[I_HFB1][lane], b2 = args.in[I_HFB2][lane], fr = args.in[I_HFFREQ][lane];
            for (int R = gw; R < LS + LP; R += NGW) {
                const int L = R < LS ? LS : LP, l = R < LS ? R : R - LS;
                const float t = (float)l / (float)(L - 1);
                const float wang = (6.283185307179586f * (float)l) / (float)L;
                const int j = lane & 15; const float band = 1e-4f + (float)j * ((15.0f - 1e-4f) / 15.0f);
                const float ang = wang * band, rev = ang * INV_2PI;
                const float zl = (lane < 16) ? fcos_rev(rev) : -fsin_rev(rev);
                float p1 = b1 + t * w1[lane];
#pragma unroll
                for (int i = 0; i < 32; ++i) p1 += __shfl(zl, i) * w1[(1 + i) * 64 + lane];
                const float h1 = sinf(fr * p1);
                float p2 = b2;
#pragma unroll 16
                for (int i = 0; i < 64; ++i) p2 += __shfl(h1, i) * w2[i * 64 + lane];
                const float h2 = sinf(fr * p2);
                { const float a = __shfl(h2, 4 * (lane & 15)), b = __shfl(h2, 4 * (lane & 15) + 1), c = __shfl(h2, 4 * (lane & 15) + 2), d = __shfl(h2, 4 * (lane & 15) + 3);
                  v2u w; w.x = lane < 16 ? pk2(a, b) : 0u; w.y = lane < 16 ? pk2(c, d) : 0u; ((v2u*)(H2B + (size_t)R * 256))[lane] = w; }
            }
        }
    }
    SEAM(0);

    if (IN(1)) {
        FRESH();
        asm volatile("; ==== PHASE 1 ====");
        for (int m4 = gw * 4; m4 < MT; m4 += NGW * 4) { const int m = m4 + (lane >> 4); int cl = lane & 15; asm volatile("" : "+v"(cl));
            const float* xr = m < NP ? args.in[I_XP] + (size_t)m * DM : args.in[I_XS] + (size_t)(m - NP) * DM;
            const float* md = MODS + (size_t)req_of_row(m) * 6144;
            f32x4 v[16]; load_row16(xr, cl, v); adaln_store16(v, md, md + 1024, HB + (size_t)m * DM, cl);
        }
        {
            int k256 = 256; asm volatile("" : "+s"(k256));
            pg8::Gemm g{(const bf16*)(ws + WS_H2B), (const bf16*)(ws + WS_W3T), LS + LP, 1024, k256}; pg8::StaticOrder S; S.init(LS + LP, 1024, G, (bx + 64) % G);
            EpiFilt E{(bf16*)(ws + WS_FT_S), (float*)(ws + WS_FT_P), (float*)(ws + WS_FPART_S), (float*)(ws + WS_FPART_P)};
            const int lane2 = fresh_lane(); const int tid = wave * 64 + lane2;
            pg8::gemm_phase<EpiFilt, pg8::StaticOrder, PG8_ALIGN, PG8_SP2>(lds, g, S, E, tid);
        }
        { int bx3 = (bx + 128) % G; asm volatile("" : "+s"(bx3)); const int lane3 = fresh_lane(); const int tid = wave * 64 + lane3;
          pg8::Gemm g{(const bf16*)(ws + WS_W1T), (const bf16*)(ws + WS_CBD), DM, 2048, DM}; pg8::StaticOrder S; S.init(DM, 2048, G, bx3);
          EpiStore E{(bf16*)(ws + WS_WFOLD_T), 2048};
          pg8::gemm_phase<EpiStore, pg8::StaticOrder, PG8_ALIGN, PG8_SP2>(lds, g, S, E, tid); }
        {
            const bool has_gemm = ((bx + 64) % G) < 68 || ((bx + 128) % G) < 32;
            LAS float* scr = (LAS float*)(lds + wave * 16384);
            if (G == 256) {
                if (!has_gemm) { const int widx = bx < 128 ? bx - 4 : 124 + (bx - 160), nidle = 156;
                    for (int it = widx * 8 + wave; it < WI_P1 - WI_P0; it += nidle * 8) weight_item(args, ws, scr, WI_P0 + it, lane); }
            } else { for (int it = gw; it < WI_P1 - WI_P0; it += NGW) weight_item(args, ws, scr, WI_P0 + it, lane); }
        }
    }
    SEAM(1);

    if (IN(2)) {
        FRESH();
        asm volatile("; ==== PHASE 2 ====");
        pg8::Gemm g{HB, (const bf16*)(ws + WS_WIN_T), MT, WINP, DM}; pg8::StaticOrder S; S.init((MT / 192) * 256, WINP, G, bx);
        EpiWin<3> E{(bf16*)(ws + WS_P), (float*)(ws + WS_ZS)};
        pg8::gemm_phase<EpiWin<3>, pg8::StaticOrder, PG8_ALIGN, PG8_SP2, 3>(lds, g, S, E, tid);
    }
    SEAM(2);

    if (IN(3)) {
        FRESH();
        asm volatile("; ==== PHASE 3 ====");
        const float* ZS = (const float*)(ws + WS_ZS);
        bf16* QN = (bf16*)(ws + WS_QN); bf16* KVN = (bf16*)(ws + WS_KVN);
        for (int m4 = gw * 4; m4 < MKV; m4 += NGW * 4) {
            const int m = m4 + (lane >> 4); int cl = lane & 15; asm volatile("" : "+v"(cl));
            if (m4 < MT) {
                const bool smp = m >= NP; const int b = smp ? (m - NP) / LS : m / LP, key = smp ? (m - NP) % LS : m % LP;
                f32x4 v[7];
#pragma unroll
                for (int j = 0; j < 7; ++j) v[j] = ((const f32x4*)(ZS + (size_t)m * 512))[cl + 16 * j];
                float sq = 0.f, sk = 0.f;
#pragma unroll
                for (int j = 0; j < 4; ++j) sq += (v[j][0] * v[j][0] + v[j][1] * v[j][1]) + (v[j][2] * v[j][2] + v[j][3] * v[j][3]);
#pragma unroll
                for (int j = 4; j < 6; ++j) sk += (v[j][0] * v[j][0] + v[j][1] * v[j][1]) + (v[j][2] * v[j][2] + v[j][3] * v[j][3]);
                const float rq = __builtin_amdgcn_rsqf(grp16_sum(sq) * (1.f / QL) + RMS_EPS), rk = __builtin_amdgcn_rsqf(grp16_sum(sk) * (1.f / KVL) + RMS_EPS);
#pragma unroll
                for (int j = 0; j < 4; ++j) { const int c = 4 * cl + 64 * j; const f32x4 g = *(const f32x4*)(args.in[I_QNORM] + c); const f32x4 y = v[j] * rq * g;
                    v2u w; w.x = pk2(y[0], y[1]); w.y = pk2(y[2], y[3]); *(v2u*)(QN + (size_t)m * 256 + c) = w; }
#pragma unroll
                for (int j = 4; j < 6; ++j) { const int c = 4 * cl + 64 * (j - 4); const f32x4 g = *(const f32x4*)(args.in[I_KVNORM] + c); const f32x4 y = v[j] * rk * g;
                    v2u w; w.x = pk2(y[0], y[1]); w.y = pk2(y[2], y[3]); *(v2u*)(KVN + (size_t)m * 256 + c) = w;
                    if (!smp) *(f32x4*)(args.out + OUT_CKV + (size_t)m * KVL + c) = y; }
                {
                    const int seg = cl >> 3; const bool second = (cl & 4) != 0; const int j0 = 4 * (cl & 3);
                    const float pf = (float)(seg == 0 ? (key >> 6) : (key & 63)); f32x4 y = v[6];
#pragma unroll
                    for (int e = 0; e < 4; ++e) { const float pr = __shfl_xor(v[6][e], 4);
                        if (smp) { const float inv = __builtin_amdgcn_exp2f(-(float)(j0 + e) * (13.287712379549449f / 16.0f)); const float rev = pf * inv * INV_2PI;
                            y[e] = v[6][e] * fcos_rev(rev) + (second ? pr : -pr) * fsin_rev(rev); } }
                    const int kk = 4 * cl;
                    if (!smp) *(f32x4*)(args.out + OUT_CKR + (size_t)m * DROPE + kk) = y;
                    v2u w; w.x = pk2(y[0], y[1]); w.y = pk2(y[2], y[3]);
                    bf16* kf = (bf16*)(ws + (smp ? WS_KF_S : WS_KF_P)); const int lk = smp ? LKS : LP;
#pragma unroll
                    for (int h = 0; h < NH; ++h) *(v2u*)(kf + ((size_t)(b * NH + h) * lk + key) * DQK + DNOPE + kk) = w;
                }
            } else {
                const int mm = m - MT, b = mm / PAST, jj = mm % PAST;
#pragma unroll
                for (int j = 0; j < 2; ++j) { const int c = 4 * cl + 64 * j; const f32x4 y = *(const f32x4*)(args.in[I_CKV] + (size_t)mm * KVL + c); v2u w; w.x = pk2(y[0], y[1]); w.y = pk2(y[2], y[3]); *(v2u*)(KVN + (size_t)m * 256 + c) = w; }
                { const int kk = 4 * cl; const f32x4 y = *(const f32x4*)(args.in[I_CKR] + (size_t)mm * DROPE + kk); v2u w; w.x = pk2(y[0], y[1]); w.y = pk2(y[2], y[3]);
                  bf16* kf = (bf16*)(ws + WS_KF_S);
#pragma unroll
                  for (int h = 0; h < NH; ++h) *(v2u*)(kf + ((size_t)(b * NH + h) * LKS + LS + jj) * DQK + DNOPE + kk) = w; }
            }
        }
    }
    SEAM(3);

    if (IN(4)) {
        FRESH();
        asm volatile("; ==== PHASE 4 ====");
        const bf16* P = (const bf16*)(ws + WS_P);
        for (int it = (G == 256) ? (bx >= 144 ? bx - 144 + 56 : (bx >= 56 && bx < 112 ? bx - 56 : (bx >= 112 ? 168 + (bx - 112) : 1000))) : bx; it < MT / 64; it += (G == 256 ? 1000 : G)) {
            const int m0 = it * 64; const bool smp = m0 >= NP; const int L = smp ? LS : LP; const int l0 = smp ? (m0 - NP) % LS : m0 % LP;
            const int seq = smp ? (m0 - NP) / LS : m0 / LP;
            const int c8 = (tid & 63) * 8, ts = tid >> 6, tb = m0 + ts * 8, lb = l0 + ts * 8;
            const float* cw = args.in[I_CONVW]; const float* cb = args.in[I_CONVB];
            LAS bf16* ut = (LAS bf16*)lds;
            bf16* X0 = (bf16*)(ws + WS_X0);
            float x1v[8][8];
#pragma unroll
            for (int sa = 0; sa < 3; ++sa) {
                v4u rr[1][10];
#pragma unroll
                for (int r = 0; r < 10; ++r) { const int lp = lb - 1 + r; const bool ok = lp >= 0 && lp < L;
                    const v4u v = *(const v4u*)(P + (size_t)(tb - 1 + r + (ok ? 0 : (r == 0 ? 1 : -1))) * 1536 + sa * 512 + c8); rr[0][r] = ok ? v : (v4u){0u, 0u, 0u, 0u}; }
                float w[3][8], bb[8];
#pragma unroll
                for (int k = 0; k < 3; ++k) { const f32x4 wa = *(const f32x4*)(cw + k * 1536 + sa * 512 + c8), wb = *(const f32x4*)(cw + k * 1536 + sa * 512 + c8 + 4);
                    w[k][0] = wa[0]; w[k][1] = wa[1]; w[k][2] = wa[2]; w[k][3] = wa[3]; w[k][4] = wb[0]; w[k][5] = wb[1]; w[k][6] = wb[2]; w[k][7] = wb[3]; }
                { const f32x4 ba = *(const f32x4*)(cb + sa * 512 + c8), bc = *(const f32x4*)(cb + sa * 512 + c8 + 4); bb[0] = ba[0]; bb[1] = ba[1]; bb[2] = ba[2]; bb[3] = ba[3]; bb[4] = bc[0]; bb[5] = bc[1]; bb[6] = bc[2]; bb[7] = bc[3]; }
#pragma unroll
                for (int i = 0; i < 8; ++i) { float y[8];
#pragma unroll
                    for (int e = 0; e < 8; ++e) { const int wd = e >> 1, hi = e & 1;
                        const unsigned u0 = rr[0][i][wd], u1 = rr[0][i + 1][wd], u2 = rr[0][i + 2][wd];
                        const float p0 = bf2f((unsigned short)(hi ? u0 >> 16 : u0 & 0xffffu)), p1 = bf2f((unsigned short)(hi ? u1 >> 16 : u1 & 0xffffu)), p2 = bf2f((unsigned short)(hi ? u2 >> 16 : u2 & 0xffffu));
                        y[e] = p0 * w[0][e] + p1 * w[1][e] + p2 * w[2][e] + bb[e]; }
                    if (sa == 0) { v4u o; o.x = pk2(y[0], y[1]); o.y = pk2(y[2], y[3]); o.z = pk2(y[4], y[5]); o.w = pk2(y[6], y[7]); *(v4u*)(X0 + (size_t)(tb + i) * 512 + c8) = o; }
                    else if (sa == 1) {
#pragma unroll
                        for (int e = 0; e < 8; ++e) x1v[i][e] = y[e]; }
                    else {
#pragma unroll
                        for (int e = 0; e < 8; ++e) x1v[i][e] *= y[e]; }
                }
            }
#pragma unroll
            for (int e = 0; e < 8; ++e)
#pragma unroll
                for (int i = 0; i < 8; i += 2) *(LAS unsigned*)(ut + (c8 + e) * 68 + ts * 8 + i) = pk2(x1v[i][e], x1v[i + 1][e]);
            __syncthreads();
            bf16* UT = (bf16*)(ws + (smp ? WS_UT_S : WS_UT_P)) + (size_t)seq * 512 * L + l0;
            for (int q = tid; q < 512 * 16; q += 512) { const int ch = q >> 4, part = q & 15; const v2u v = *(const LAS v2u*)(ut + ch * 68 + part * 4); *(v2u*)(UT + (size_t)ch * L + part * 4) = v; }
            __syncthreads();
        }
        int k256 = 256; asm volatile("" : "+s"(k256));
        { pg8::Gemm g{(const bf16*)(ws + WS_QN), (const bf16*)(ws + WS_QUP_T), MT, 768, k256}; pg8::StaticOrder S; S.init(MT, 768, G, bx);
          EpiStore E{(bf16*)(ws + WS_Q), 768};
          pg8::gemm_phase<EpiStore, pg8::StaticOrder, PG8_ALIGN, PG8_SP2>(lds, g, S, E, tid); }
        { int bx2 = (bx + 144) % G; asm volatile("" : "+s"(bx2)); const int lane2 = fresh_lane(); const int tid = wave * 64 + lane2;
          pg8::Gemm g{(const bf16*)(ws + WS_KVN), (const bf16*)(ws + WS_KVUP_T), MKV, 1024, k256}; pg8::StaticOrder S; S.init(MKV, 1024, G, bx2);
          EpiKV E{(bf16*)(ws + WS_KF_S), (bf16*)(ws + WS_KF_P), (bf16*)(ws + WS_V_S), (bf16*)(ws + WS_V_P)};
          pg8::gemm_phase<EpiKV, pg8::StaticOrder, PG8_ALIGN, PG8_SP2>(lds, g, S, E, tid); }
    }
    SEAM(4);

    if (IN(5)) {
        FRESH();
        asm volatile("; ==== PHASE 5 ====");
        constexpr int NA_S = 2 * BS * NH * (LS / 256), NC_S = HY / 4, NA_P = BP * NH, NC_P = HY / 8, NW_T = (WI_ALL - WI_P1) / 8, NITEM = NA_S + NC_S + NA_P + NC_P + NW_T;
        bf16* YM = HB;
        for (;;) {
            if (tid == 0) MISC[0] = __hip_atomic_fetch_add((unsigned*)(ctl + CW_Q + 64 * args.li), 1u, RLX_AGENT);
            __syncthreads();
            const int it = __builtin_amdgcn_readfirstlane((int)MISC[0]);
            __syncthreads();
            if (it >= NITEM) break;
            { const int cls = it < NA_S ? 0 : it < NA_S + NC_S ? 1 : it < NA_S + NC_S + NA_P ? 2 : it < NA_S + NC_S + NA_P + NC_P ? 3 : 4; if (!((args.mask >> cls) & 1)) continue; }
            const int lane = fresh_lane(); const int tid = wave * 64 + lane;
            const bool isA_S = it < NA_S, isA_P = (it >= NA_S + NC_S) && (it < NA_S + NC_S + NA_P);
            if (isA_S || isA_P) { if (!NO_ATT) {
                int b, h, row0, lk, pos0, koff = 0, nkeys; const bf16 *kf, *vv; float* part = nullptr; unsigned* cnt = nullptr;
                if (isA_S) { const int un = it >> 1, half = it & 1; b = un / (NH * 16); h = (un / 16) % NH; const int qb = un % 16; row0 = NP + b * LS + qb * 256; lk = LKS; pos0 = qb * 256; kf = (const bf16*)(ws + WS_KF_S); vv = (const bf16*)(ws + WS_V_S);
                    nkeys = LKS / 2; koff = half * (LKS / 2); part = (float*)(ws + WS_APART) + (size_t)un * APART_F; cnt = (unsigned*)(ctl + CW_ATT + args.li * 8192 + un * 64); }
                else { const int u = it - NA_S - NC_S; b = u / NH; h = u % NH; row0 = b * LP; lk = LP; pos0 = -1; kf = (const bf16*)(ws + WS_KF_P); vv = (const bf16*)(ws + WS_V_P); nkeys = LP; }
                att::attn_dense_body((const bf16*)(ws + WS_Q) + (size_t)row0 * 768 + h * DQK, kf + ((size_t)(b * NH + h) * lk + koff) * DQK, vv + ((size_t)(b * NH + h) * lk + koff) * DVH,
                                     YM + (size_t)row0 * DM + HY + h * DVH, nkeys, pos0, (LAS char*)lds, tid, part, cnt, MISC); }
            } else if (it < NA_S + NC_S) {
                hconv::item((const bf16*)(ws + WS_FT_S), (const bf16*)(ws + WS_UT_S), (const float*)(ws + WS_FPART_S), args.in[I_HFSKIP], (const bf16*)(ws + WS_X0), YM, (it - NA_S) * 4, lds, tid, lane, wave);
            } else if (it >= NA_S + NC_S + NA_P + NC_P) {
                LAS float* scr = (LAS float*)(lds + wave * 16384);
                weight_item(args, ws, scr, WI_P1 + (it - (NA_S + NC_S + NA_P + NC_P)) * 8 + wave, lane);
                __syncthreads();
            } else if (!NO_CONV) {
                hconv::prompt_item((const float*)(ws + WS_FT_P), (const bf16*)(ws + WS_UT_P), (const float*)(ws + WS_FPART_P), args.in[I_HFSKIP], (const bf16*)(ws + WS_X0), YM, (it - NA_S - NC_S - NA_P) * 8, lds, tid, lane, wave);
            }
        }
    }
    SEAM(5);

    if (IN(6)) {
        FRESH();
        asm volatile("; ==== PHASE 6 ====");
        pg8::Gemm g{HB, (const bf16*)(ws + WS_WOUT0_T), MT, DM, DM}; pg8::StaticOrder S; S.init((MT / 192) * 256, DM, G, bx);
        EpiRes<3, false> E{args.in[I_XP], args.in[I_XS], MODS + 2 * 1024, T, nullptr, nullptr, nullptr};
        pg8::gemm_phase<EpiRes<3, false>, pg8::StaticOrder, PG8_ALIGN, PG8_SP2, 3>(lds, g, S, E, tid);
    }
    SEAM(6);

    if (IN(7)) {
        FRESH();
        asm volatile("; ==== PHASE 7 ====");
        for (int m4 = gw * 4; m4 < MT; m4 += NGW * 4) { const int m = m4 + (lane >> 4); int cl = lane & 15; asm volatile("" : "+v"(cl));
            const float* md = MODS + (size_t)req_of_row(m) * 6144;
            f32x4 v[16]; load_row16(T + (size_t)m * DM, cl, v); ln_affine16(v, args.in[I_LN1G0], args.in[I_LN1B0], cl, STATS + 2 * m);
            adaln_store16(v, md + 3 * 1024, md + 4 * 1024, HB + (size_t)m * DM, cl);
        }
    }
    SEAM(7);

    if (IN(8)) {
        FRESH();
        asm volatile("; ==== PHASE 8 ====");
        pg8::Gemm g{HB, (const bf16*)(ws + WS_W1_0), MT, FF, DM}; pg8::StaticOrder S; S.init(MT, FF, G, bx);
        EpiUp E{(bf16*)(ws + WS_HID)};
        pg8::gemm_phase<EpiUp, pg8::StaticOrder, PG8_ALIGN, PG8_SP2>(lds, g, S, E, tid);
    }
    SEAM(8);

    if (IN(9)) {
        FRESH();
        asm volatile("; ==== PHASE 9 ====");
        pg8::Gemm g{(const bf16*)(ws + WS_HID), (const bf16*)(ws + WS_W2_0), MT, DM, FF}; pg8::StaticOrder S; S.init((MT / 192) * 256, DM, G, bx);
        EpiRes<3, true> E{nullptr, nullptr, MODS + 5 * 1024, T, STATS, args.in[I_LN1G0], args.in[I_LN1B0]};
        pg8::gemm_phase<EpiRes<3, true>, pg8::StaticOrder, PG8_ALIGN, PG8_SP2, 3>(lds, g, S, E, tid);
    }
    SEAM(9);

    if (IN(10)) {
        FRESH();
        asm volatile("; ==== PHASE 10 ====");
        const float* MODS1 = MODS + 3 * 6144;
        for (int it = bx; it < MT / 32; it += G) {
            const int m0 = it * 32; const bool smp = m0 >= NP; const int L = smp ? LS : LP; const int l0 = smp ? (m0 - NP) % LS : m0 % LP; const int seq = smp ? (m0 - NP) / LS : m0 / LP;
            LAS bf16* ht = (LAS bf16*)lds;
            const float* md = MODS1 + (size_t)req_of_row(m0) * 6144;
            { const int i = wave * 4 + (lane >> 4), m = m0 + i; int cl = lane & 15; asm volatile("" : "+v"(cl));
                f32x4 v[16]; load_row16(T + (size_t)m * DM, cl, v); ln_affine16(v, args.in[I_LN2G0], args.in[I_LN2B0], cl, STATS + 2 * m);
                float mean, rstd; row16_stats(v, mean, rstd);
#pragma unroll
                for (int j = 0; j < 16; ++j) { const int c = 4 * cl + 64 * j; const f32x4 sc = *(const f32x4*)(md + 1024 + c), sh = *(const f32x4*)(md + c);
                    const f32x4 h = (v[j] - mean) * rstd * (sc + 1.0f) + sh;
#pragma unroll
                    for (int e = 0; e < 4; ++e) ht[(c + e) * 40 + i] = (bf16)f2bf(h[e]);
                    if ((j & 3) == 3) asm volatile("" ::: "memory"); }
            }
            __syncthreads();
            bf16* HT = HB + (smp ? (size_t)NP * DM + (size_t)seq * DM * LS : (size_t)seq * DM * LP) + l0;
            for (int q = tid; q < 1024 * 4; q += 512) { const int c = q >> 2, part = q & 3; const v4u v = *(const LAS v4u*)(ht + c * 40 + part * 8); *(v4u*)(HT + (size_t)c * L + part * 8) = v; }
            __syncthreads();
        }
        for (size_t i = gt; i < (size_t)LS * LS / 8; i += NGT) {
            const int rho = (int)(i >> 9), l8 = (int)(i & 511) * 8; const int k = rho > 2048 ? rho - 2048 : rho; unsigned w[4];
#pragma unroll
            for (int e = 0; e < 8; e += 2) { const float r0 = (float)((k * (l8 + e)) & 4095) * (1.f / 4096.f), r1 = (float)((k * (l8 + e + 1)) & 4095) * (1.f / 4096.f);
                const float a = (rho > 2048 ? __builtin_amdgcn_sinf(r0) : __builtin_amdgcn_cosf(r0)) * 0.015625f, b = (rho > 2048 ? __builtin_amdgcn_sinf(r1) : __builtin_amdgcn_cosf(r1)) * 0.015625f;
                w[e >> 1] = pk2(a, b); }
            ((v4u*)(ws + WS_D4096))[i] = (v4u){w[0], w[1], w[2], w[3]};
        }
    }
    SEAM(10);

    if (IN(11)) {
        FRESH();
        asm volatile("; ==== PHASE 11 ====");
        { pg8::Gemm g{(const bf16*)(ws + WS_D4096), HB + (size_t)NP * DM, LS, BS * DM, LS}; pg8::SplitOrder S; S.init(LS, BS * DM, LS, G, vcu, SLABS(200), SPLIT_CNT(3));
          EpiDft E{(bf16*)(ws + WS_UV), LS, NP};
          pg8::gemm_phase<EpiDft, pg8::SplitOrder, PG8_ALIGN, PG8_SP2>(lds, g, S, E, tid); }
        { int bx2 = (bx + 128) % G; asm volatile("" : "+s"(bx2)); const int lane2 = fresh_lane(); const int tid = wave * 64 + lane2;
          pg8::Gemm g{(const bf16*)(ws + WS_D256), HB, LP, BP * DM, LP}; pg8::StaticOrder S; S.init(LP, BP * DM, G, bx2);
          EpiDft E{(bf16*)(ws + WS_UV), LP, 0};
          pg8::gemm_phase<EpiDft, pg8::StaticOrder, PG8_ALIGN, PG8_SP2>(lds, g, S, E, tid); }
    }
    SEAM(11);

    if (IN(12)) {
        FRESH();
        asm volatile("; ==== PHASE 12 ====");
        pg8::Gemm g{(const bf16*)(ws + WS_UV), (const bf16*)(ws + WS_WFOLD_T), MT, DM, 2048}; pg8::StaticOrder S; S.init((MT / 192) * 256, DM, G, bx);
        EpiRes<3, true> E{nullptr, nullptr, MODS + 3 * 6144 + 2 * 1024, T, STATS, args.in[I_LN2G0], args.in[I_LN2B0]};
        pg8::gemm_phase<EpiRes<3, true>, pg8::StaticOrder, PG8_ALIGN, PG8_SP2, 3>(lds, g, S, E, tid);
    }
    SEAM(12);

    if (IN(13)) {
        FRESH();
        asm volatile("; ==== PHASE 13 ====");
        for (int m4 = gw * 4; m4 < MT; m4 += NGW * 4) { const int m = m4 + (lane >> 4); int cl = lane & 15; asm volatile("" : "+v"(cl));
            const float* md = MODS + 3 * 6144 + (size_t)req_of_row(m) * 6144;
            f32x4 v[16]; load_row16(T + (size_t)m * DM, cl, v); ln_affine16(v, args.in[I_LN1G1], args.in[I_LN1B1], cl, STATS + 2 * m);
            adaln_store16(v, md + 3 * 1024, md + 4 * 1024, HB + (size_t)m * DM, cl);
        }
    }
    SEAM(13);

    if (IN(14)) {
        FRESH();
        asm volatile("; ==== PHASE 14 ====");
        pg8::Gemm g{HB, (const bf16*)(ws + WS_W1_1), MT, FF, DM}; pg8::StaticOrder S; S.init(MT, FF, G, bx);
        EpiUp E{(bf16*)(ws + WS_HID)};
        pg8::gemm_phase<EpiUp, pg8::StaticOrder, PG8_ALIGN, PG8_SP2>(lds, g, S, E, tid);
    }
    SEAM(14);

    if (IN(15)) {
        FRESH();
        asm volatile("; ==== PHASE 15 ====");
        pg8::Gemm g{(const bf16*)(ws + WS_HID), (const bf16*)(ws + WS_W2_1), MT, DM, FF}; pg8::StaticOrder S; S.init((MT / 192) * 256, DM, G, bx);
        EpiRes<3, true> E{nullptr, nullptr, MODS + 3 * 6144 + 5 * 1024, T, STATS, args.in[I_LN1G1], args.in[I_LN1B1]};
        pg8::gemm_phase<EpiRes<3, true>, pg8::StaticOrder, PG8_ALIGN, PG8_SP2, 3>(lds, g, S, E, tid);
    }
    SEAM(15);

    if (IN(16)) {
        FRESH();
        asm volatile("; ==== PHASE 16 ====");
        for (int m4 = gw * 4; m4 < MT; m4 += NGW * 4) { const int m = m4 + (lane >> 4); int cl = lane & 15; asm volatile("" : "+v"(cl));
            f32x4 v[16]; load_row16(T + (size_t)m * DM, cl, v); ln_affine16(v, args.in[I_LN2G1], args.in[I_LN2B1], cl); store_row16(X + (size_t)m * DM, cl, v);
        }
    }
#undef IN
#undef SEAM
}

extern "C" void kernel_launch(void* const* d_in, const int* in_sizes, int n_in, void* d_out, int out_size, void* d_ws, size_t ws_size, hipStream_t stream) {
    static int grid = 0;
    if (grid == 0) {
        if (n_in != 38 || ws_size < WS_END) { fprintf(stderr, "kernel_launch: expected 38 inputs and >= %zu bytes of workspace; got %d, %zu\n", (size_t)WS_END, n_in, ws_size); grid = -1; return; }
        int dev = 0, cus = 0;
        if (hipGetDevice(&dev) != hipSuccess || hipDeviceGetAttribute(&cus, hipDeviceAttributeMultiprocessorCount, dev) != hipSuccess) { grid = -1; return; }
        if (hipFuncSetAttribute((const void*)fwd_kernel, hipFuncAttributeMaxDynamicSharedMemorySize, LDS_BYTES) != hipSuccess) { fprintf(stderr, "kernel_launch: hipFuncSetAttribute failed\n"); grid = -1; return; }
        int per_cu = 0;
        if (hipOccupancyMaxActiveBlocksPerMultiprocessor(&per_cu, (const void*)fwd_kernel, 512, LDS_BYTES) != hipSuccess || per_cu < 1) fprintf(stderr, "kernel_launch: occupancy query reports %d\n", per_cu);
        (void)hipGetLastError();
        grid = cus;
    }
    if (grid < 0) return;
    (void)hipMemsetAsync((char*)d_ws + WS_CTL, 0, CTL_ZERO_BYTES, stream);
    Args a{};
    for (int i = 0; i < 38; ++i) a.in[i] = (const float*)d_in[i];
    a.out = (float*)d_out; a.ws = (unsigned char*)d_ws;
#if MK_PER_PHASE
    for (int p = 0; p < NPHASE; ++p) { a.ph_lo = p; a.ph_hi = p + 1; a.li = 0; a.mask = 31; hipLaunchKernelGGL(fwd_kernel, dim3(grid), dim3(512), LDS_BYTES, stream, a); }
#elif defined(PROBE_PREFIX)
    a.mask = 31; a.ph_lo = 0; a.ph_hi = PROBE_PREFIX; a.li = 0; hipLaunchKernelGGL(fwd_kernel, dim3(grid), dim3(512), LDS_BYTES, stream, a);
    a.mask = 31; a.ph_lo = 0; a.ph_hi = NPHASE; a.li = 1; hipLaunchKernelGGL(fwd_kernel, dim3(grid), dim3(512), LDS_BYTES, stream, a);
#elif defined(PROBE_A)
#ifndef PROBE_MASK5
#define PROBE_MASK5 31
#endif
    a.mask = 31; a.ph_lo = 0; a.ph_hi = PROBE_B; a.li = 0; hipLaunchKernelGGL(fwd_kernel, dim3(grid), dim3(512), LDS_BYTES, stream, a);
    a.mask = PROBE_MASK5; a.ph_lo = PROBE_A; a.ph_hi = NPHASE; a.li = 1; hipLaunchKernelGGL(fwd_kernel, dim3(grid), dim3(512), LDS_BYTES, stream, a);
#else
    a.ph_lo = 0; a.ph_hi = NPHASE; a.li = 0; a.mask = 31;
    hipLaunchKernelGGL(fwd_kernel, dim3(grid), dim3(512), LDS_BYTES, stream, a);
#endif
    const hipError_t le = hipPeekAtLastError();
    if (le != hipSuccess) fprintf(stderr, "kernel_launch: launch failed: %s\n", hipGetErrorName(le));
}
```

```cpp
#include <hip/hip_runtime.h>
#include <hip/hip_bf16.h>
#include <cstdio>
#include <cstdint>
#include <cmath>
namespace pg8 {
#define PG8_LAS __attribute__((address_space(3)))
typedef unsigned short bf16_t;
typedef short bf16x8 __attribute__((ext_vector_type(8)));
typedef float f32x4 __attribute__((ext_vector_type(4)));
typedef unsigned u32x4 __attribute__((ext_vector_type(4)));
constexpr int BM = 256, BK = 64, HALF = 128, HTB = HALF * BK * 2  , STAGE_BYTES = 8 * HTB, NXCD = 8, WGM = 8;

__host__ __device__ __forceinline__ int lds_byte(int r, int c) { const int st = (r >> 4) * 2 + (c >> 5), rr = r & 15, cc = c & 31, ob = rr * 64 + cc * 2; return st * 1024 + (ob ^ (((ob >> 9) & 1) << 5)); }
__host__ __device__ __forceinline__ void stage_rc(int b, int& R, int& C) { const int st = b / 1024, sb = b % 1024, swz = sb ^ (((sb >> 9) & 1) << 5); R = (st >> 1) * 16 + swz / 64; C = (st & 1) * 32 + (swz % 64) / 2; }
__host__ __device__ __forceinline__ int perm32(int rho) { const int n = rho >> 4, i = rho & 15; return 8 * (i >> 2) + 4 * n + (i & 3); }

struct Unit { int pm, pn; int k0, nt, mode, slab, need, tile; };
struct Gemm { const bf16_t* A; const bf16_t* Bt; int M, N, K; };

struct StaticOrder {
    int nM, nN, nwg, G, c;
    __host__ __device__ void init(int M, int N, int G_, int c_) { nM = M / BM; nN = N / BM; nwg = nM * nN; G = G_; c = c_; }
    __host__ __device__ bool next(int i, Unit& u) const {
        const long L = (long)i * G + c; if (L >= nwg) return false;
        int wgid = (int)L; { const int q = nwg / NXCD, r = nwg % NXCD, xcd = wgid % NXCD, off = wgid / NXCD; wgid = (xcd < r ? xcd * (q + 1) : r * (q + 1) + (xcd - r) * q) + off; }
        const int nig = WGM * nN, gid = wgid / nig, fm = gid * WGM, gsz = (nM - fm) < WGM ? (nM - fm) : WGM;
        u.pm = fm + ((wgid % nig) % gsz); u.pn = (wgid % nig) / gsz; u.k0 = 0; u.nt = 0; u.mode = 0; u.slab = 0; u.need = 0; u.tile = 0; return true;
    }
    static constexpr bool SPLIT = false, NO_FULL = false;
    __device__ __forceinline__ void a_ready(const Unit&) const {}
    __device__ __forceinline__ void done(const Unit&) const {}
};

struct SplitOrder {
    static constexpr bool SPLIT = true, NO_FULL = false;
    int nM, nN, NT, per, c, lo, hi, tf, ns, give_last, P; float* slabs; unsigned* cnt;
    __device__ __forceinline__ void init(int M, int N, int K, int G_, int c_, float* slabs_, unsigned* cnt_) {
        nM = M / BM; nN = N / BM; NT = K / BK; c = c_; slabs = slabs_; cnt = cnt_;
        const int TU = nM * nN * NT; per = (TU + G_ - 1) / G_; per += per & 1;
        lo = c * per; hi = lo + per < TU ? lo + per : TU; if (lo >= TU) { lo = 0; hi = 0; }
        tf = lo / NT; ns = hi > lo ? (hi - 1) / NT - tf + 1 : 0; give_last = (hi % NT) != 0 ? 1 : 0;
        int a = per, b = NT; while (b) { const int t = a % b; a = b; b = t; } P = NT / a;
    }
    __device__ __forceinline__ int giver_index(int j) const { return j - j / P; }
    __device__ __forceinline__ bool next(int i, Unit& u) const {
        if (i >= ns) return false;
        int sidx; if (ns == 1) sidx = 0; else if (give_last && i == 0) sidx = ns - 1; else if (i == ns - 1) sidx = 0; else sidx = i - give_last + 1;
        const int T = tf + sidx, tlo = T * NT, thi = tlo + NT; const int a = lo > tlo ? lo : tlo, b = hi < thi ? hi : thi;
        const int nig = WGM * nN, gid = T / nig, fm = gid * WGM, gsz = (nM - fm) < WGM ? (nM - fm) : WGM;
        u.pm = fm + ((T % nig) % gsz); u.pn = (T % nig) / gsz; u.k0 = a - tlo; u.nt = b - a; u.tile = T;
        if (b != thi) { u.mode = 1; u.slab = giver_index(c); u.need = 0; }
        else if (a != tlo) { const int c0 = tlo / per; u.mode = 2; u.slab = giver_index(c0); u.need = c - c0; }
        else { u.mode = 0; u.slab = 0; u.need = 0; }
        return true;
    }
    __device__ __forceinline__ void a_ready(const Unit&) const {}
    __device__ __forceinline__ void done(const Unit&) const {}
};
struct SplitOrderCut : SplitOrder { static constexpr bool NO_FULL = true; };
__device__ __forceinline__ unsigned cvt_pk_bf16(float lo, float hi) { unsigned r; asm volatile("v_cvt_pk_bf16_f32 %0, %1, %2" : "=v"(r) : "v"(lo), "v"(hi)); return r; }
template <class Epi, class Sched, bool ALIGN_EPI = false, bool SP2 = false, int MF = 4>
__device__ __forceinline__ void gemm_phase(PG8_LAS unsigned char* lds, const Gemm g, const Sched& S, const Epi& E, const int tid) {
    const int wid = __builtin_amdgcn_readfirstlane(tid >> 6), lane = tid & 63, wr = wid >> 2, wc = wid & 3, fr = lane & 15, fq = lane >> 4;
    const int K = g.K, nt = K / BK;
    unsigned voffA[2], voffB[2];
#pragma unroll
    for (int i = 0; i < 2; ++i) { int R, C; stage_rc(tid * 16 + i * 8192, R, C); const int Rb = Epi::PERM ? ((R & ~31) + perm32(R & 31)) : R;
        voffA[i] = (unsigned)(R * K + C) * 2u; voffB[i] = (unsigned)(Rb * K + C) * 2u; }
    const size_t kstep = (size_t)(BK * 2);
    const size_t hstepB = (size_t)HALF * K * 2, tstepB = 2 * hstepB;
    const size_t hstepA = (size_t)(32 * MF) * K * 2, tstepA = 2 * hstepA;
    const unsigned ldsw = (unsigned)wid * 1024u;
    const int aoff = lds_byte(wr * (16 * MF) + fr, fq * 8), boff = lds_byte(wc * 32 + fr, fq * 8);
#define PG8_SA(b, h) (((b) * 2 + (h)) * HTB)
#define PG8_SB(b, h) ((4 + (b) * 2 + (h)) * HTB)
#define PG8_STAGE(bufoff, gbase, voff) do { _Pragma("unroll") for (int _i = 0; _i < 2; ++_i) \
        __builtin_amdgcn_global_load_lds((const unsigned*)((const char*)(gbase) + (voff)[_i]), (PG8_LAS unsigned*)(lds + (bufoff) + ldsw + _i * 8192), 16, 0, 0); } while (0)
#define PG8_LDA(dst, b, h) do { _Pragma("unroll") for (int m = 0; m < MF; ++m) _Pragma("unroll") for (int k = 0; k < 2; ++k) dst[m][k] = *(const PG8_LAS bf16x8*)(lds + PG8_SA(b, h) + aoff + m * 2048 + k * 1024); } while (0)
#define PG8_LDB(dst, b, h) do { _Pragma("unroll") for (int n = 0; n < 2; ++n) _Pragma("unroll") for (int k = 0; k < 2; ++k) dst[n][k] = *(const PG8_LAS bf16x8*)(lds + PG8_SB(b, h) + boff + n * 2048 + k * 1024); } while (0)
#define PG8_MMA(ai, bj, At, Bt) do { __builtin_amdgcn_s_setprio(1); _Pragma("unroll") for (int m = 0; m < MF; ++m) _Pragma("unroll") for (int n = 0; n < 2; ++n) _Pragma("unroll") for (int k = 0; k < 2; ++k) \
        acc[ai][bj][m][n] = __builtin_amdgcn_mfma_f32_16x16x32_bf16(Bt[n][k], At[m][k], acc[ai][bj][m][n], 0, 0, 0); __builtin_amdgcn_s_setprio(0); } while (0)
#define PG8_WAIT_V(n) asm volatile("s_waitcnt vmcnt(" #n ")" ::: "memory")
#define PG8_WAIT_L(n) asm volatile("s_waitcnt lgkmcnt(" #n ")" ::: "memory")
#define PG8_BAR __builtin_amdgcn_s_barrier()
#define PG8_SCHED __builtin_amdgcn_sched_barrier(0)
    Unit cur, nxt; int ui = 0;
    if (!S.next(0, cur)) return;
    f32x4 acc[2][2][4][2];
#pragma unroll
    for (int a = 0; a < 2; ++a)
#pragma unroll
        for (int b = 0; b < 2; ++b)
#pragma unroll
            for (int m = 0; m < 4; ++m)
#pragma unroll
                for (int n = 0; n < 2; ++n) acc[a][b][m][n] = (f32x4){0.f, 0.f, 0.f, 0.f};
    bf16x8 At[4][2], B0[2][2], B1[2][2];
    const char* cA = (const char*)g.A + (size_t)cur.pm * tstepA + (size_t)cur.k0 * kstep; const char* cB = (const char*)g.Bt + (size_t)cur.pn * tstepB + (size_t)cur.k0 * kstep;
    S.a_ready(cur);
    if constexpr (SP2) {
        PG8_STAGE(PG8_SB(0, 0), cB, voffB); PG8_STAGE(PG8_SB(0, 1), cB + hstepB, voffB); PG8_STAGE(PG8_SA(0, 0), cA, voffA); PG8_STAGE(PG8_SA(0, 1), cA + hstepA, voffA);
        if (wr == 1) PG8_BAR;
        PG8_WAIT_V(2); PG8_BAR;
        PG8_STAGE(PG8_SB(1, 0), cB + kstep, voffB); PG8_STAGE(PG8_SA(1, 0), cA + kstep, voffA); PG8_STAGE(PG8_SB(1, 1), cB + hstepB + kstep, voffB);
        PG8_WAIT_V(6); PG8_BAR;
    } else {
        PG8_STAGE(PG8_SB(0, 0), cB, voffB); PG8_STAGE(PG8_SA(0, 0), cA, voffA); PG8_STAGE(PG8_SB(0, 1), cB + hstepB, voffB); PG8_STAGE(PG8_SA(0, 1), cA + hstepA, voffA);
        if (wr == 1) PG8_BAR;
        PG8_WAIT_V(4); PG8_BAR;
        PG8_STAGE(PG8_SB(1, 0), cB + kstep, voffB); PG8_STAGE(PG8_SA(1, 0), cA + kstep, voffA); PG8_STAGE(PG8_SB(1, 1), cB + hstepB + kstep, voffB);
        PG8_WAIT_V(6); PG8_BAR;
    }
    for (;;) {
        const bool has_next = S.next(ui + 1, nxt);
        const char* nA = has_next ? (const char*)g.A + (size_t)nxt.pm * tstepA + (size_t)nxt.k0 * kstep : cA; const char* nB = has_next ? (const char*)g.Bt + (size_t)nxt.pn * tstepB + (size_t)nxt.k0 * kstep : cB;
        const int ntc = cur.nt ? cur.nt : nt;
        for (int t = 0; t < ntc; t += 2) {
            const bool last = (t == ntc - 2);
            const char* a1 = cA + (size_t)(t + 1) * kstep;
            const char* a2 = last ? nA : cA + (size_t)(t + 2) * kstep; const char* b2 = last ? nB : cB + (size_t)(t + 2) * kstep;
            const char* a3 = a2 + kstep; const char* b3 = b2 + kstep;
            if (last && has_next) S.a_ready(nxt);
            if constexpr (SP2) {
            PG8_LDB(B0, 0, 0); PG8_LDB(B1, 0, 1); PG8_SCHED; PG8_LDA(At, 0, 0); PG8_STAGE(PG8_SA(1, 1), a1 + hstepA, voffA);
            PG8_WAIT_V(8); PG8_WAIT_L(0); PG8_BAR; PG8_MMA(0, 0, At, B0); PG8_MMA(0, 1, At, B1); PG8_BAR; PG8_SCHED;
            PG8_LDA(At, 0, 1); PG8_STAGE(PG8_SB(0, 0), b2, voffB); PG8_STAGE(PG8_SB(0, 1), b2 + hstepB, voffB); PG8_STAGE(PG8_SA(0, 0), a2, voffA);
            PG8_WAIT_V(8); PG8_WAIT_L(0); PG8_BAR; PG8_MMA(1, 0, At, B0); PG8_MMA(1, 1, At, B1); PG8_BAR; PG8_SCHED;
            PG8_LDB(B0, 1, 0); PG8_LDB(B1, 1, 1); PG8_SCHED; PG8_LDA(At, 1, 0); PG8_STAGE(PG8_SA(0, 1), a2 + hstepA, voffA);
            PG8_WAIT_V(8); PG8_WAIT_L(0); PG8_BAR; PG8_MMA(0, 0, At, B0); PG8_MMA(0, 1, At, B1); PG8_BAR; PG8_SCHED;
            PG8_LDA(At, 1, 1); PG8_STAGE(PG8_SB(1, 0), b3, voffB); PG8_STAGE(PG8_SB(1, 1), b3 + hstepB, voffB); PG8_STAGE(PG8_SA(1, 0), a3, voffA);
            PG8_WAIT_V(8); PG8_WAIT_L(0); PG8_BAR; PG8_MMA(1, 0, At, B0); PG8_MMA(1, 1, At, B1); PG8_BAR; PG8_SCHED;
            } else {
            PG8_LDB(B0, 0, 0); PG8_SCHED; PG8_LDA(At, 0, 0); PG8_STAGE(PG8_SA(1, 1), a1 + hstepA, voffA);
            PG8_WAIT_L(8); PG8_BAR; PG8_WAIT_L(0); PG8_MMA(0, 0, At, B0); PG8_BAR; PG8_SCHED;
            PG8_LDB(B1, 0, 1); PG8_STAGE(PG8_SB(0, 0), b2, voffB);
            PG8_BAR; PG8_WAIT_L(0); PG8_MMA(0, 1, At, B1); PG8_BAR;
            PG8_LDA(At, 0, 1); PG8_STAGE(PG8_SA(0, 0), a2, voffA);
            PG8_BAR; PG8_WAIT_L(0); PG8_MMA(1, 0, At, B0); PG8_BAR; PG8_SCHED;
            PG8_STAGE(PG8_SB(0, 1), b2 + hstepB, voffB);
            PG8_WAIT_V(6); PG8_BAR; PG8_MMA(1, 1, At, B1); PG8_BAR;
            PG8_LDB(B0, 1, 0); PG8_SCHED; PG8_LDA(At, 1, 0); PG8_STAGE(PG8_SA(0, 1), a2 + hstepA, voffA);
            PG8_WAIT_L(8); PG8_BAR; PG8_WAIT_L(0); PG8_MMA(0, 0, At, B0); PG8_BAR; PG8_SCHED;
            PG8_LDB(B1, 1, 1); PG8_STAGE(PG8_SB(1, 0), b3, voffB);
            PG8_BAR; PG8_WAIT_L(0); PG8_MMA(0, 1, At, B1); PG8_BAR;
            PG8_LDA(At, 1, 1); PG8_STAGE(PG8_SA(1, 0), a3, voffA);
            PG8_BAR; PG8_WAIT_L(0); PG8_MMA(1, 0, At, B0); PG8_BAR; PG8_SCHED;
            PG8_STAGE(PG8_SB(1, 1), b3 + hstepB, voffB);
            PG8_WAIT_V(6); PG8_BAR; PG8_MMA(1, 1, At, B1); PG8_BAR;
            }
        }
        if constexpr (ALIGN_EPI) { if (wr == 0) PG8_BAR; }
        if constexpr (!Epi::AFTER_DRAIN) {
            Unit eu = cur; eu.pm = __builtin_amdgcn_readfirstlane(cur.pm); eu.pn = __builtin_amdgcn_readfirstlane(cur.pn); eu.slab = __builtin_amdgcn_readfirstlane(cur.slab); eu.tile = __builtin_amdgcn_readfirstlane(cur.tile);
            eu.need = __builtin_amdgcn_readfirstlane(cur.need); eu.mode = __builtin_amdgcn_readfirstlane(cur.mode);
            asm volatile("" : "+s"(eu.pm), "+s"(eu.pn), "+s"(eu.slab), "+s"(eu.tile), "+s"(eu.need), "+s"(eu.mode));
            if constexpr (Sched::SPLIT) {
                if (eu.mode == 1) {
                    const float* sp = S.slabs + (size_t)eu.slab * 65536 + wid * 8192 + lane * 4;
#pragma unroll
                    for (int a = 0; a < 2; ++a)
#pragma unroll
                        for (int b = 0; b < 2; ++b)
#pragma unroll
                            for (int m = 0; m < 4; ++m)
#pragma unroll
                                for (int n = 0; n < 2; ++n) { const f32x4 v = acc[a][b][m][n]; const float* p = sp + (((a * 2 + b) * 4 + m) * 2 + n) * 256;
                                    asm volatile("global_store_dwordx4 %0, %1, off sc1\n\ts_nop 1" :: "v"(p), "v"(v) : "memory"); }
                    asm volatile("s_waitcnt vmcnt(0)" ::: "memory");
                    if (lane == 0) __hip_atomic_fetch_add(S.cnt + eu.tile * 32, 1u, __ATOMIC_RELAXED, __HIP_MEMORY_SCOPE_AGENT);
                } else if (Sched::NO_FULL || eu.mode == 2) {
                    unsigned sp_ = 0;
                    while ((unsigned)__builtin_amdgcn_readfirstlane(__hip_atomic_load(S.cnt + eu.tile * 32, __ATOMIC_RELAXED, __HIP_MEMORY_SCOPE_AGENT)) < 8u) { __builtin_amdgcn_s_sleep(8); if (++sp_ > (1u << 20)) break; }
                    __builtin_amdgcn_fence(__ATOMIC_ACQUIRE, "agent");
                    E.template run<true>(acc, eu, wr, wc, fr, fq, S.slabs + (size_t)eu.slab * 65536 + wid * 8192 + lane * 4);
                } else E.template run<false>(acc, eu, wr, wc, fr, fq, nullptr);
            } else E.template run<false>(acc, eu, wr, wc, fr, fq, nullptr);
            S.done(cur); }
        if (!has_next) break;
#pragma unroll
        for (int a = 0; a < 2; ++a)
#pragma unroll
            for (int b = 0; b < 2; ++b)
#pragma unroll
                for (int m = 0; m < 4; ++m)
#pragma unroll
                    for (int n = 0; n < 2; ++n) acc[a][b][m][n] = (f32x4){0.f, 0.f, 0.f, 0.f};
        cur = nxt; cA = nA; cB = nB; ++ui;
        if constexpr (ALIGN_EPI) { if (wr == 1) PG8_BAR; }
    }
    PG8_WAIT_V(0);
    if constexpr (!ALIGN_EPI) { if (wr == 0) PG8_BAR; }
    PG8_BAR;
    if constexpr (Epi::AFTER_DRAIN) { E.fused(acc, cur, wr, wc, fr, fq, lds, wid, lane); S.done(cur); }
#undef PG8_SA
#undef PG8_SB
#undef PG8_STAGE
#undef PG8_LDA
#undef PG8_LDB
#undef PG8_MMA
#undef PG8_WAIT_V
#undef PG8_WAIT_L
#undef PG8_BAR
#undef PG8_SCHED
}
}
#ifndef PG8_SP2
#define PG8_SP2 true
#endif
#ifndef PG8_ALIGN
#define PG8_ALIGN true
#endif
#ifndef MK_PER_PHASE
#define MK_PER_PHASE 0
#endif

constexpr int DM = 1024, FF = 4096;
constexpr int LP = 256, BP = 16, LS = 4096, BS = 2, PAST = 256;
constexpr int NP = BP * LP;
constexpr int NSR = BS * LS;
constexpr int MT = NP + NSR;
constexpr int MKV = MT + BS * PAST;
constexpr int LKS = LS + PAST;
constexpr int HY = 512, NH = 4, DQK = 192, DNOPE = 128, DROPE = 64, DVH = 128, QL = 256, KVL = 128;
constexpr int WINP = 2048;
constexpr float LN_EPS = 1e-5f, RMS_EPS = 1e-6f, ALPHA = 1.41421356237309515f;
constexpr int NPHASE = 17;

constexpr int att_shm_bytes = 2 * 16384 + 2 * 24576 + 2048 + 8 * 8 * 1024;
constexpr size_t MiB = 1u << 20, KiB = 1024;
constexpr size_t WS_CTL = 0, CTL_ZERO_BYTES = 1 * MiB;
constexpr size_t WS_MODS = 1 * MiB;
constexpr size_t WS_D256 = 1 * MiB + 256 * KiB;
constexpr size_t WS_H2B = 86 * MiB, WS_W3T = 89 * MiB;
constexpr size_t WS_FPART_S = 3 * MiB;
constexpr size_t WS_FPART_P = 3 * MiB + 256 * KiB;
constexpr size_t WS_STATS = 3 * MiB + 512 * KiB;
constexpr size_t WS_WIN_T = 4 * MiB, WS_QUP_T = 8 * MiB, WS_KVUP_T = 8 * MiB + 512 * KiB, WS_WOUT0_T = 9 * MiB;
constexpr size_t WS_W1_0 = 11 * MiB, WS_W2_0 = 19 * MiB, WS_W1_1 = 27 * MiB, WS_W2_1 = 35 * MiB, WS_WFOLD_T = 43 * MiB;
constexpr size_t WS_T = 48 * MiB;
constexpr size_t WS_FT_S = 48 * MiB, WS_FT_P = 64 * MiB, WS_UT_S = 65 * MiB, WS_UT_P = 73 * MiB;
constexpr size_t WS_W1T = 80 * MiB, WS_CBD = 82 * MiB;
constexpr size_t WS_D4096 = 96 * MiB;
constexpr size_t WS_KF_S = 96 * MiB, WS_KF_P = 109 * MiB, WS_V_S = 115 * MiB, WS_V_P = 124 * MiB;
constexpr size_t WS_H = 128 * MiB;
constexpr size_t WS_P = 152 * MiB, WS_ZS = 188 * MiB, WS_QN = 212 * MiB, WS_KVN = 218 * MiB, WS_Q = 225 * MiB, WS_X0 = 243 * MiB;
constexpr size_t WS_HID = 152 * MiB, WS_UV = 152 * MiB;
constexpr size_t WS_END = 256 * MiB;
constexpr int CW_TMO = 0, CW_Q = 64, CW_BAR = 4096, CW_ATT = 16384, CW_SPLIT = 32768;
constexpr size_t WS_APART = 152 * MiB; constexpr int APART_F = 8 * 4 * 16 * 64 + 8 * 128;

constexpr int RING_BYTES = 131072, LDSCTL_OFF = 160 * 1024 - 512, MISC_OFF = LDSCTL_OFF + 320, LDS_BYTES = 160 * 1024;
static_assert(att_shm_bytes <= LDSCTL_OFF, "attention scratch fits below the LDS control words");

#define GAS __attribute__((address_space(1)))
#define LAS __attribute__((address_space(3)))
typedef unsigned short bf16;
typedef unsigned v4u __attribute__((ext_vector_type(4)));
typedef unsigned v2u __attribute__((ext_vector_type(2)));
typedef float f32x4 __attribute__((ext_vector_type(4)));
typedef GAS unsigned gu32;
#define RLX_AGENT __ATOMIC_RELAXED, __HIP_MEMORY_SCOPE_AGENT
#define LDS_WAIT() asm volatile("s_waitcnt lgkmcnt(0)" ::: "memory")
__device__ __forceinline__ unsigned f2bf(float f) { unsigned u = __builtin_bit_cast(unsigned, f); return (u + 0x7fffu + ((u >> 16) & 1u)) >> 16; }
__device__ __forceinline__ unsigned pk2(float lo, float hi) { return f2bf(lo) | (f2bf(hi) << 16); }
__device__ __forceinline__ float bf2f(unsigned short b) { return __builtin_bit_cast(float, (unsigned)b << 16); }
__device__ __forceinline__ float wave_sum(float v) {
#pragma unroll
    for (int o = 1; o < 64; o <<= 1) v += __shfl_xor(v, o);
    return v;
}
__device__ __forceinline__ float fsin_rev(float rev) { return __builtin_amdgcn_sinf(__builtin_amdgcn_fractf(rev)); }
__device__ __forceinline__ float fcos_rev(float rev) { return __builtin_amdgcn_cosf(__builtin_amdgcn_fractf(rev)); }
constexpr float INV_2PI = 0.15915494309189535f;
__device__ __forceinline__ float fexp(float x) { return __builtin_amdgcn_exp2f(x * 1.4426950408889634f); }

__device__ __forceinline__ int fresh_lane() { int l; asm volatile("v_mbcnt_lo_u32_b32 %0, -1, 0\n\tv_mbcnt_hi_u32_b32 %0, -1, %0" : "=v"(l)); return l; }
#define XB_TMO      128
#define XB_XCNT(j)  (256  + 64 * (j))
#define XB_XSUB(j)  (1280 + 64 * (j))
#define XB_XGEN(j)  (2304 + 64 * (j))
#define XB_TOP      3328
#define XB_TOPGEN   3392
#define XCD_BAR_WORDS 3456
#define XB_SPIN_CAP (1u << 23)
__device__ __forceinline__ unsigned xb_ld(unsigned* p)              { return __hip_atomic_load(p, __ATOMIC_RELAXED, __HIP_MEMORY_SCOPE_AGENT); }
__device__ __forceinline__ unsigned xb_add(unsigned* p, unsigned v) { return __hip_atomic_fetch_add(p, v, __ATOMIC_RELAXED, __HIP_MEMORY_SCOPE_AGENT); }
__device__ __forceinline__ unsigned xb_xcc_id() { return (unsigned)__builtin_amdgcn_s_getreg((3 << 11) | 20) & 0xFu; }
#define XB_SPIN(cond, bar) do { unsigned _sp = 0; while (cond) { __builtin_amdgcn_s_sleep(1); \
    if ((++_sp & 255u) == 0u) { if (xb_ld(&(bar)[XB_TMO])) break; if (_sp > XB_SPIN_CAP) { atomicAdd(&(bar)[XB_TMO], 1u); break; } } } } while (0)
struct XcdBarrier { unsigned* bar; unsigned x; volatile LAS unsigned* st; };
__device__ __forceinline__ XcdBarrier xcd_barrier_post(unsigned* bar, volatile LAS unsigned* st) {
    XcdBarrier b; b.bar = bar; b.x = xb_xcc_id(); b.st = st;
    if (threadIdx.x == 0) (void)xb_add(&bar[XB_XCNT(b.x)], 1u);
    return b;
}
__device__ __forceinline__ void xcd_barrier_complete(unsigned* bar, unsigned x, unsigned& nloc, unsigned& nx) {
    const unsigned G = gridDim.x * gridDim.y * gridDim.z;
    unsigned sum, cnt, mine, sp = 0u;
    for (;;) {
        sum = 0u; cnt = 0u; mine = 0u;
#pragma unroll
        for (unsigned j = 0; j < 16; ++j) { const unsigned c = xb_ld(&bar[XB_XCNT(j)]); sum += c; cnt += (c > 0u) ? 1u : 0u; mine = (j == x) ? c : mine; }
        if (sum == G) break;
        __builtin_amdgcn_s_sleep(1);
        if ((++sp & 255u) == 0u) { if (xb_ld(&bar[XB_TMO])) break; if (sp > XB_SPIN_CAP) { atomicAdd(&bar[XB_TMO], 1u); break; } }
    }
    nloc = mine > 0u ? mine : 1u; nx = cnt > 0u ? cnt : 1u;
}
__device__ __forceinline__ void xcd_barrier(const XcdBarrier& b) {
    asm volatile("s_waitcnt vmcnt(0)" ::: "memory");
    __syncthreads();
    if (threadIdx.x == 0) {
        unsigned* bar = b.bar;
        __builtin_amdgcn_s_waitcnt(0);
        unsigned nloc = b.st[0], nx = b.st[1];
        if (nloc == 0u) { xcd_barrier_complete(bar, b.x, nloc, nx); b.st[0] = nloc; b.st[1] = nx; }
        const unsigned old = xb_add(&bar[XB_XSUB(b.x)], 1u);
        const unsigned gen = old / nloc;
        if (old + 1u == (gen + 1u) * nloc) {
            __builtin_amdgcn_fence(__ATOMIC_RELEASE, "agent");
            asm volatile("s_waitcnt vmcnt(0)" ::: "memory");
            const unsigned og = xb_add(&bar[XB_TOP], 1u);
            const unsigned tg = og / nx;
            if (og + 1u == (tg + 1u) * nx) xb_add(&bar[XB_TOPGEN], 1u);
            else XB_SPIN(xb_ld(&bar[XB_TOPGEN]) == tg, bar);
            __builtin_amdgcn_fence(__ATOMIC_ACQUIRE, "agent");
            xb_add(&bar[XB_XGEN(b.x)], 1u);
            asm volatile("s_waitcnt vmcnt(0)" ::: "memory");
        } else {
            XB_SPIN(xb_ld(&bar[XB_XGEN(b.x)]) == gen, bar);
            __builtin_amdgcn_fence(__ATOMIC_ACQUIRE, "agent");
            asm volatile("s_waitcnt vmcnt(0)" ::: "memory");
        }
    }
    __syncthreads();
}

struct Args { const float* in[38]; float* out; unsigned char* ws; int ph_lo, ph_hi, li, mask; };
enum { I_XP = 0, I_XS, I_CKV, I_CKR, I_C, I_CCTX, I_ADA0_W, I_ADA0_B, I_WIN, I_CONVW, I_CONVB, I_HFW1, I_HFB1, I_HFFREQ, I_HFW2, I_HFB2, I_HFW3, I_HFSKIP,
       I_QNORM, I_QUP, I_KVNORM, I_KVUP, I_WOUT0, I_LN1G0, I_LN1B0, I_W1_0, I_W2_0, I_LN2G0, I_LN2B0, I_ADA1_W, I_ADA1_B, I_WOUT1, I_LN1G1, I_LN1B1, I_W1_1, I_W2_1, I_LN2G1, I_LN2B1 };
constexpr size_t OUT_CKV = (size_t)MT * DM, OUT_CKR = OUT_CKV + (size_t)NP * KVL;

__device__ __forceinline__ int req_of_row(int m) { return m < NP ? 0 : 1 + (m - NP) / LS; }

using pg8::f32x4; using pg8::Unit; using pg8::BM; using pg8::HALF; using pg8::cvt_pk_bf16;
typedef unsigned u32x4 __attribute__((ext_vector_type(4)));
__device__ __forceinline__ u32x4 pack8(const f32x4& a, const f32x4& b) { u32x4 w; w.x = cvt_pk_bf16(a[0], a[1]); w.y = cvt_pk_bf16(a[2], a[3]); w.z = cvt_pk_bf16(b[0], b[1]); w.w = cvt_pk_bf16(b[2], b[3]); return w; }

#define SLAB_ADD(v, ai, bj, m, n) do { if constexpr (SL) (v) += *(const f32x4*)(slab + ((((ai) * 2 + (bj)) * 4 + (m)) * 2 + (n)) * 256); } while (0)
template <int MF = 4> struct EpiWin {
    static constexpr bool PERM = true, AFTER_DRAIN = false;
    bf16* P; float* ZS;
    template <bool SL> __device__ __forceinline__ void run(const f32x4 (&acc)[2][2][4][2], const Unit& u, int wr, int wc, int fr, int fq, const float* slab) const {
        const int row0 = u.pm * (64 * MF) + wr * (16 * MF) + fr, colt = u.pn * BM + wc * 32 + 8 * fq;
#pragma unroll
        for (int ai = 0; ai < 2; ++ai)
#pragma unroll
            for (int m = 0; m < MF; ++m) { const int row = row0 + ai * (32 * MF) + m * 16;
#pragma unroll
                for (int bj = 0; bj < 2; ++bj) { const int col = colt + bj * HALF; f32x4 a0 = acc[ai][bj][m][0], a1 = acc[ai][bj][m][1]; SLAB_ADD(a0, ai, bj, m, 0); SLAB_ADD(a1, ai, bj, m, 1);
                    if (u.pn < 6) *(u32x4*)(P + (size_t)row * 1536 + col) = pack8(a0, a1);
                    else { float* d = ZS + (size_t)row * 512 + (col - 1536); *(f32x4*)d = a0; *(f32x4*)(d + 4) = a1; } } }
    }
};
struct EpiStore {
    static constexpr bool PERM = true, AFTER_DRAIN = false;
    bf16* O; int ld;
    template <bool SL> __device__ __forceinline__ void run(const f32x4 (&acc)[2][2][4][2], const Unit& u, int wr, int wc, int fr, int fq, const float* slab) const {
        const int row0 = u.pm * BM + wr * 64 + fr, colt = u.pn * BM + wc * 32 + 8 * fq;
#pragma unroll
        for (int ai = 0; ai < 2; ++ai)
#pragma unroll
            for (int m = 0; m < 4; ++m) { const int row = row0 + ai * HALF + m * 16;
#pragma unroll
                for (int bj = 0; bj < 2; ++bj) *(u32x4*)(O + (size_t)row * ld + colt + bj * HALF) = pack8(acc[ai][bj][m][0], acc[ai][bj][m][1]); }
    }
};
struct EpiKV {
    static constexpr bool PERM = true, AFTER_DRAIN = false;
    bf16 *KFs, *KFp, *Vs, *Vp;
    template <bool SL> __device__ __forceinline__ void run(const f32x4 (&acc)[2][2][4][2], const Unit& u, int wr, int wc, int fr, int fq, const float* slab) const {
        const int m0 = u.pm * BM; bf16* kf; bf16* vv; int lk, key0, b;
        if (m0 < NP) { b = m0 / LP; key0 = 0; lk = LP; kf = KFp; vv = Vp; }
        else if (m0 < MT) { b = (m0 - NP) / LS; key0 = (m0 - NP) % LS; lk = LKS; kf = KFs; vv = Vs; }
        else { b = (m0 - MT) / PAST; key0 = LS + (m0 - MT) % PAST; lk = LKS; kf = KFs; vv = Vs; }
        const int h = u.pn;
        int rloc = wr * 64 + fr, c8 = wc * 32 + 8 * fq; asm volatile("" : "+v"(rloc), "+v"(c8));
#pragma unroll
        for (int ai = 0; ai < 2; ++ai)
#pragma unroll
            for (int m = 0; m < 4; ++m) { const int key = key0 + rloc + ai * HALF + m * 16; const size_t kr = (size_t)(b * NH + h) * lk + key;
                *(u32x4*)(kf + kr * DQK + c8) = pack8(acc[ai][0][m][0], acc[ai][0][m][1]);
                *(u32x4*)(vv + kr * DVH + c8) = pack8(acc[ai][1][m][0], acc[ai][1][m][1]); }
    }
};
template <int MF = 4, bool FROM_T = false> struct EpiRes {
    static constexpr bool PERM = false, AFTER_DRAIN = false;
    const float* xp; const float* xs; const float* gate;
    bf16* T; const float* stats; const float* lng; const float* lnb;
    template <bool SL> __device__ __forceinline__ void run(const f32x4 (&acc)[2][2][4][2], const Unit& u, int wr, int wc, int fr, int fq, const float* slab) const {
        const int m0 = u.pm * (64 * MF), row0 = m0 + wr * (16 * MF) + fr, col0 = u.pn * BM + wc * 32 + 4 * fq;
#pragma unroll
        for (int bj = 0; bj < 2; ++bj)
#pragma unroll
            for (int n = 0; n < 2; ++n) { const int col = col0 + bj * HALF + n * 16;
                f32x4 g4, b4; if constexpr (FROM_T) { g4 = *(const f32x4*)(lng + col); b4 = *(const f32x4*)(lnb + col); }
#pragma unroll
                for (int ai = 0; ai < 2; ++ai)
#pragma unroll
                    for (int m = 0; m < MF; ++m) { const int row = row0 + ai * (32 * MF) + m * 16;
                        const f32x4 gg = *(const f32x4*)(gate + (size_t)req_of_row(row) * 6144 + col);
                        f32x4 xv;
                        if constexpr (FROM_T) { const v2u w = *(const v2u*)(T + (size_t)row * DM + col); const float mean = stats[2 * row], rstd = stats[2 * row + 1];
                            const f32x4 t = {bf2f((unsigned short)(w.x & 0xffffu)), bf2f((unsigned short)(w.x >> 16)), bf2f((unsigned short)(w.y & 0xffffu)), bf2f((unsigned short)(w.y >> 16))};
                            xv = (t - mean) * rstd * g4 + b4; }
                        else { const float* xr = (row < NP) ? xp + (size_t)row * DM : xs + (size_t)(row - NP) * DM; xv = *(const f32x4*)(xr + col); }
                        f32x4 a = acc[ai][bj][m][n]; SLAB_ADD(a, ai, bj, m, n);
                        const f32x4 t2 = xv * ALPHA + gg * a; v2u o; o.x = cvt_pk_bf16(t2[0], t2[1]); o.y = cvt_pk_bf16(t2[2], t2[3]); *(v2u*)(T + (size_t)row * DM + col) = o; } }
    }
};
struct EpiUp {
    static constexpr bool PERM = true, AFTER_DRAIN = false;
    bf16* H;
    template <bool SL> __device__ __forceinline__ void run(const f32x4 (&acc)[2][2][4][2], const Unit& u, int wr, int wc, int fr, int fq, const float* slab) const {
        const int row0 = u.pm * BM + wr * 64 + fr, colt = u.pn * BM + wc * 32 + 8 * fq;
#pragma unroll
        for (int ai = 0; ai < 2; ++ai)
#pragma unroll
            for (int m = 0; m < 4; ++m) { const int row = row0 + ai * HALF + m * 16;
#pragma unroll
                for (int bj = 0; bj < 2; ++bj) { f32x4 a = acc[ai][bj][m][0], b = acc[ai][bj][m][1];
#pragma unroll
                    for (int e = 0; e < 4; ++e) { const float x = fmaxf(a[e], 0.f), y = fmaxf(b[e], 0.f); a[e] = x * x; b[e] = y * y; }
                    *(u32x4*)(H + (size_t)row * FF + colt + bj * HALF) = pack8(a, b); } }
    }
};
struct EpiFilt {
    static constexpr bool PERM = true, AFTER_DRAIN = false;
    bf16* GRB; float* FTP; float* FPS; float* FPP;
    template <bool SL> __device__ __forceinline__ void run(const f32x4 (&acc)[2][2][4][2], const Unit& u, int wr, int wc, int fr, int fq, const float* slab) const {
        int rl = wr * 64 + fr, clb = wc * 32 + 8 * fq; asm volatile("" : "+v"(rl), "+v"(clb));
        const bool smp = u.pm < 16; const int L = smp ? LS : LP; const float invL1 = 1.f / (float)(L - 1);
#pragma unroll
        for (int bj = 0; bj < 2; ++bj) { const int col0 = u.pn * BM + bj * HALF + clb;
            float asum[8];
#pragma unroll
            for (int e = 0; e < 8; ++e) asum[e] = 0.f;
#pragma unroll
            for (int ai = 0; ai < 2; ++ai)
#pragma unroll
                for (int m = 0; m < 4; ++m) { const int l = (smp ? u.pm * BM : 0) + rl + ai * HALF + m * 16; const float t = (float)l * invL1;
                    const f32x4 a0 = acc[ai][bj][m][0], a1 = acc[ai][bj][m][1]; const float av[8] = {a0[0], a0[1], a0[2], a0[3], a1[0], a1[1], a1[2], a1[3]};
#pragma unroll
                    for (int e = 0; e < 8; ++e) { const int col = col0 + e, ch = col & 511, half = col >> 9;
                        const float delta = fabsf(-3.0701134573253944f + (float)ch * ((-15.350567286626973f + 3.0701134573253944f) / 511.0f));
                        const float val = av[e] * fexp(-t * delta); asum[e] += fabsf(val);
                        if (smp) { bf16* g = GRB + (size_t)ch * 8192; if (half == 0) g[LS - l] = (bf16)f2bf(val); else g[l == 0 ? 0 : LS + l] = (bf16)(l == 0 ? 0u : f2bf(val)); }
                        else FTP[(size_t)col * LP + l] = val; } }
#pragma unroll
            for (int e = 0; e < 8; ++e) { float v = asum[e]; v += __shfl_xor(v, 1); v += __shfl_xor(v, 2); v += __shfl_xor(v, 4); v += __shfl_xor(v, 8); asum[e] = v; }
            if (fr == 0) {
#pragma unroll
                for (int e = 0; e < 8; ++e) { const int col = col0 + e; if (smp) FPS[col * 32 + u.pm * 2 + wr] = asum[e]; else FPP[col * 2 + wr] = asum[e]; } }
        }
    }
};
struct EpiDft {
    static constexpr bool PERM = true, AFTER_DRAIN = false;
    bf16* UV; int L, tokbase;
    template <bool SL> __device__ __forceinline__ void run(const f32x4 (&acc)[2][2][4][2], const Unit& u, int wr, int wc, int fr, int fq, const float* slab) const {
        int rl = wr * 64 + fr, cl = wc * 32 + 8 * fq; asm volatile("" : "+v"(rl), "+v"(cl));
        const int rho0 = u.pm * BM + rl, n0 = u.pn * BM + cl, hl = L >> 1;
#pragma unroll
        for (int ai = 0; ai < 2; ++ai)
#pragma unroll
            for (int m = 0; m < 4; ++m) { const int rho = rho0 + ai * HALF + m * 16; const int part = rho > hl ? 1 : 0; const int k = part ? rho - hl : rho;
#pragma unroll
                for (int bj = 0; bj < 2; ++bj) { const int n = n0 + bj * HALF, b = n >> 10, c = n & 1023;
                    f32x4 a0 = acc[ai][bj][m][0], a1 = acc[ai][bj][m][1]; SLAB_ADD(a0, ai, bj, m, 0); SLAB_ADD(a1, ai, bj, m, 1);
                    bf16* r1 = UV + (size_t)(tokbase + b * L + k) * 2048 + part * 1024 + c;
                    *(u32x4*)r1 = pack8(a0, a1);
                    if (k != 0 && k != hl) { bf16* r2 = UV + (size_t)(tokbase + b * L + (L - k)) * 2048 + part * 1024 + c;
                        *(u32x4*)r2 = part ? pack8(-a0, -a1) : pack8(a0, a1); }
                    else if (part == 0) { unsigned zz = 0u; asm volatile("" : "+v"(zz)); *(u32x4*)(r1 + 1024) = (u32x4){zz, zz, zz, zz}; } } }
    }
};

struct EpiDft2 {
    static constexpr bool PERM = true, AFTER_DRAIN = false;
    bf16* UV;
    template <bool SL> __device__ __forceinline__ void run(const f32x4 (&acc)[2][2][4][2], const Unit& u, int wr, int wc, int fr, int fq, const float* slab) const {
        const int le = fresh_lane(); const int fr2 = le & 15, fq2 = le >> 4;
        const int rl = wr * 64 + fr2, cl = wc * 32 + 8 * fq2;
        const bool odd = (fr2 & 1) != 0;
#pragma unroll
        for (int ai = 0; ai < 2; ++ai)
#pragma unroll
            for (int m = 0; m < 4; ++m) { const int rho = u.pm * BM + rl + ai * HALF + m * 16, p = rho >> 1; const float rev = (float)p * (1.f / 4096.f); const float cs = __builtin_amdgcn_cosf(rev), sn = __builtin_amdgcn_sinf(rev);
#pragma unroll
                for (int bj = 0; bj < 2; ++bj) { const int n = u.pn * BM + cl + bj * HALF, b = n >> 11, c0 = (n & 2047) >> 1;
                    f32x4 a0 = acc[ai][bj][m][0], a1 = acc[ai][bj][m][1]; SLAB_ADD(a0, ai, bj, m, 0); SLAB_ADD(a1, ai, bj, m, 1);
                    const f32x4 E = {a0[0], a0[2], a1[0], a1[2]}, O = {a0[1], a0[3], a1[1], a1[3]};
                    f32x4 PO; PO[0] = __shfl_xor(O[0], 1); PO[1] = __shfl_xor(O[1], 1); PO[2] = __shfl_xor(O[2], 1); PO[3] = __shfl_xor(O[3], 1);
                    bf16* base = UV + (size_t)(NP + b * LS) * 2048 + c0;
                    if (p != 0) {
                        const f32x4 r1 = odd ? E + PO * sn + O * cs : E + O * cs - PO * sn;
                        const f32x4 r2 = odd ? PO * sn + O * cs - E : E - O * cs + PO * sn;
                        const int off = odd ? 1024 : 0;
                        v2u w1, w2, w1m, w2m; w1.x = cvt_pk_bf16(r1[0], r1[1]); w1.y = cvt_pk_bf16(r1[2], r1[3]); w2.x = cvt_pk_bf16(r2[0], r2[1]); w2.y = cvt_pk_bf16(r2[2], r2[3]);
                        if (odd) { w1m.x = w1.x ^ 0x80008000u; w1m.y = w1.y ^ 0x80008000u; w2m.x = w2.x ^ 0x80008000u; w2m.y = w2.y ^ 0x80008000u; } else { w1m = w1; w2m = w2; }
                        *(v2u*)(base + (size_t)p * 2048 + off) = w1; *(v2u*)(base + (size_t)(LS - p) * 2048 + off) = w1m;
                        *(v2u*)(base + (size_t)(2048 - p) * 2048 + off) = w2; *(v2u*)(base + (size_t)(2048 + p) * 2048 + off) = w2m;
                    } else if (!odd) {
                        const f32x4 s0 = E + O, s1 = E - O; v2u w0, w1; w0.x = cvt_pk_bf16(s0[0], s0[1]); w0.y = cvt_pk_bf16(s0[2], s0[3]); w1.x = cvt_pk_bf16(s1[0], s1[1]); w1.y = cvt_pk_bf16(s1[2], s1[3]);
                        *(v2u*)(base) = w0; *(v2u*)(base + (size_t)2048 * 2048) = w1; *(v2u*)(base + 1024) = (v2u){0u, 0u}; *(v2u*)(base + (size_t)2048 * 2048 + 1024) = (v2u){0u, 0u};
                    } else {
                        v2u we, wo; we.x = cvt_pk_bf16(E[0], E[1]); we.y = cvt_pk_bf16(E[2], E[3]); wo.x = cvt_pk_bf16(O[0], O[1]); wo.y = cvt_pk_bf16(O[2], O[3]);
                        *(v2u*)(base + (size_t)1024 * 2048) = we; *(v2u*)(base + (size_t)3072 * 2048) = we; *(v2u*)(base + (size_t)1024 * 2048 + 1024) = wo;
                        *(v2u*)(base + (size_t)3072 * 2048 + 1024) = (v2u){wo.x ^ 0x80008000u, wo.y ^ 0x80008000u};
                    } } }
    }
};

namespace att {
using bf16x8 = __attribute__((ext_vector_type(8))) short;
using s16x4  = __attribute__((ext_vector_type(4))) short;
using f32x16 = __attribute__((ext_vector_type(16))) float;
constexpr int DK = 192, DV = 128, NW = 8, QBLK = 32, KVBLK = 64;
constexpr float SCALE = 0.07216878364870322f;
constexpr float THR = 8.f;
constexpr int SHM_V = KVBLK * DV * 2, SHM_K = KVBLK * DK * 2, SHM_QR = 2 * SHM_V + 2 * SHM_K + NW * 64 * 4, NQR = 4  , SHM_ATTN = SHM_QR + NW * (12 - NQR) * 1024;
#define KSWZ(row, colB) ((row) * 384 + ((colB) ^ (((row) & 7) << 4)))
#define SBAR() __builtin_amdgcn_sched_barrier(0)
__device__ __forceinline__ int crow(int r, int hi) { return (r & 3) + 8 * (r >> 2) + 4 * hi; }
__device__ __forceinline__ unsigned cvtpk(float lo, float hi) { unsigned r; asm volatile("v_cvt_pk_bf16_f32 %0, %1, %2" : "=v"(r) : "v"(lo), "v"(hi)); return r; }
__device__ __forceinline__ void partialSM(f32x16& p0, f32x16& p1, float& m_reg, float& mn, float& alpha) {
  constexpr float C = SCALE * 1.4426950408889634f;
  float pmax = p0[0];
#pragma unroll
  for (int r = 1; r < 16; ++r) pmax = fmaxf(pmax, p0[r]);
#pragma unroll
  for (int r = 0; r < 16; ++r) pmax = fmaxf(pmax, p1[r]);
  { auto rr = __builtin_amdgcn_permlane32_swap(__float_as_uint(pmax), __float_as_uint(pmax), false, false);
    pmax = fmaxf(__uint_as_float(rr[0]), __uint_as_float(rr[1])); }
  if (__builtin_expect(__all(pmax - m_reg <= THR / SCALE), 1)) { mn = m_reg; alpha = 1.f; }
  else { mn = fmaxf(m_reg, pmax); alpha = __builtin_amdgcn_exp2f((m_reg - mn) * C); m_reg = mn; }
  float mnC = -mn * C;
#pragma unroll
  for (int r = 0; r < 16; ++r) p0[r] = fmaf(p0[r], C, mnC);
#pragma unroll
  for (int r = 0; r < 16; ++r) p1[r] = fmaf(p1[r], C, mnC);
#pragma unroll
  for (int r = 0; r < 16; ++r) p0[r] = __builtin_amdgcn_exp2f(p0[r]);
}
__device__ __forceinline__ void finishSM(f32x16& p0, f32x16& p1, float alpha, float& l_reg, bf16x8& pa0, bf16x8& pa1, bf16x8& pa2, bf16x8& pa3) {
#pragma unroll
  for (int r = 0; r < 16; ++r) p1[r] = __builtin_amdgcn_exp2f(p1[r]);
  float ps = 0;
#pragma unroll
  for (int r = 0; r < 16; ++r) ps += p0[r];
#pragma unroll
  for (int r = 0; r < 16; ++r) ps += p1[r];
  { auto rr = __builtin_amdgcn_permlane32_swap(__float_as_uint(ps), __float_as_uint(ps), false, false);
    ps = __uint_as_float(rr[0]) + __uint_as_float(rr[1]); }
  l_reg = l_reg * alpha + ps;
#define PK4(P, BASE, OUT) do { unsigned a0 = cvtpk(P[BASE + 0], P[BASE + 1]), a1 = cvtpk(P[BASE + 2], P[BASE + 3]);   \
    unsigned b0 = cvtpk(P[BASE + 4], P[BASE + 5]), b1 = cvtpk(P[BASE + 6], P[BASE + 7]);                              \
    auto r0 = __builtin_amdgcn_permlane32_swap(a0, b0, false, false); auto r1 = __builtin_amdgcn_permlane32_swap(a1, b1, false, false); \
    u32x4 w = {r0[0], r1[0], r0[1], r1[1]}; OUT = __builtin_bit_cast(bf16x8, w); } while (0)
  PK4(p0, 0, pa0); PK4(p0, 8, pa1); PK4(p1, 0, pa2); PK4(p1, 8, pa3);
#undef PK4
}
__device__ __forceinline__ void qkt(f32x16& p0, f32x16& p1, const LAS char* Ks, const bf16x8* qr, const LAS char* qrl, int r32, int hi) {
  p0 = f32x16{}; p1 = f32x16{};
#pragma unroll
  for (int d0 = 0; d0 < 12; ++d0) { const int cb = (d0 * 16 + hi * 8) * 2;
    bf16x8 b0 = *reinterpret_cast<const LAS bf16x8*>(Ks + KSWZ(r32, cb));
    bf16x8 b1 = *reinterpret_cast<const LAS bf16x8*>(Ks + KSWZ(32 + r32, cb));
    const bf16x8 qf = d0 < NQR ? qr[d0 < NQR ? d0 : 0] : *reinterpret_cast<const LAS bf16x8*>(qrl + (d0 - NQR) * 1024);
    p0 = __builtin_amdgcn_mfma_f32_32x32x16_bf16(b0, qf, p0, 0, 0, 0);
    p1 = __builtin_amdgcn_mfma_f32_32x32x16_bf16(b1, qf, p1, 0, 0, 0); }
}
__device__ __forceinline__ int v_st(int k, int c) { const int kk = (k & ~0xC) | ((k & 4) << 1) | ((k & 8) >> 1); return ((kk >> 3) * 4 + (c >> 5)) * 512 + ((kk & 7) * 32 + (c & 31)) * 2; }
__device__ __forceinline__ int v_rd_base(int lane) { return ((lane & 3) << 3) | (((lane >> 2) & 3) << 6) | (((lane >> 4) & 1) << 5) | (((lane >> 5) & 1) << 8); }
constexpr int v_rd_off(int d0, int ks, int half) { return d0 * 512 + ks * 4096 + half * 2048; }
template <int OFF> __device__ __forceinline__ s16x4 tr_read(int vb) {
  s16x4 r; asm volatile("ds_read_b64_tr_b16 %0, %1 offset:%2" : "=&v"(r) : "v"(vb), "i"(OFF) : "memory"); return r;
}
template <int D0> __device__ __forceinline__ void pv_one(f32x16& od, int vb, bf16x8 pa0, bf16x8 pa1, bf16x8 pa2, bf16x8 pa3) {
  const s16x4 l0 = tr_read<v_rd_off(D0, 0, 0)>(vb), h0 = tr_read<v_rd_off(D0, 0, 1)>(vb), l1 = tr_read<v_rd_off(D0, 1, 0)>(vb), h1 = tr_read<v_rd_off(D0, 1, 1)>(vb);
  const s16x4 l2 = tr_read<v_rd_off(D0, 2, 0)>(vb), h2 = tr_read<v_rd_off(D0, 2, 1)>(vb), l3 = tr_read<v_rd_off(D0, 3, 0)>(vb), h3 = tr_read<v_rd_off(D0, 3, 1)>(vb);
  asm volatile("s_waitcnt lgkmcnt(0)" ::: "memory"); SBAR();
#define PK(L, H) (bf16x8){L[0], L[1], L[2], L[3], H[0], H[1], H[2], H[3]}
  od = __builtin_amdgcn_mfma_f32_32x32x16_bf16(pa0, PK(l0, h0), od, 0, 0, 0);
  od = __builtin_amdgcn_mfma_f32_32x32x16_bf16(pa1, PK(l1, h1), od, 0, 0, 0);
  od = __builtin_amdgcn_mfma_f32_32x32x16_bf16(pa2, PK(l2, h2), od, 0, 0, 0);
  od = __builtin_amdgcn_mfma_f32_32x32x16_bf16(pa3, PK(l3, h3), od, 0, 0, 0);
#undef PK
}
__device__ __forceinline__ void pv_d0(f32x16* o, int vb, bf16x8 pa0, bf16x8 pa1, bf16x8 pa2, bf16x8 pa3) {
  pv_one<0>(o[0], vb, pa0, pa1, pa2, pa3); pv_one<1>(o[1], vb, pa0, pa1, pa2, pa3); pv_one<2>(o[2], vb, pa0, pa1, pa2, pa3); pv_one<3>(o[3], vb, pa0, pa1, pa2, pa3);
}
constexpr int LDQ = 768, LDK = DK, LDV = DV, LDO = 1024;
__device__ __forceinline__ void attn_dense_body(const bf16* __restrict__ Qb, const bf16* __restrict__ Kh, const bf16* __restrict__ Vh, bf16* __restrict__ Ob, int seq, int pos0, LAS char* lds, const int tid, float* part, unsigned* cnt, volatile LAS unsigned* misc) {
  const int wid = tid >> 6, lane = tid & 63, r32 = lane & 31, hi = lane >> 5;
  LAS char* V_lds = lds; LAS char* K_lds = lds + 2 * SHM_V;
  LAS float* ws = (LAS float*)(lds + 2 * SHM_V + 2 * SHM_K) + wid * 64; LAS float* li_l = ws; LAS float* al_l = ws + 32;
  float m_reg = -1e30f, l_reg = 0; f32x16 o[4] = {}; bf16x8 qr[NQR];
  const LAS char* qrl = lds + SHM_QR + wid * (12 - NQR) * 1024 + lane * 16;
  const bf16* Qw = Qb + (long)(wid * QBLK + r32) * LDQ + hi * 8;
#pragma unroll
  for (int d0 = 0; d0 < NQR; ++d0) qr[d0] = *reinterpret_cast<const bf16x8*>(Qw + d0 * 16);
  LAS char* qw = lds + SHM_QR + wid * (12 - NQR) * 1024 + lane * 16;
#pragma unroll
  for (int d0 = NQR; d0 < 8; ++d0) *(LAS bf16x8*)(qw + (d0 - NQR) * 1024) = *reinterpret_cast<const bf16x8*>(Qw + d0 * 16);
  {
    bf16x8 f0 = *reinterpret_cast<const bf16x8*>(Qw + 128), f1 = *reinterpret_cast<const bf16x8*>(Qw + 144), f2 = *reinterpret_cast<const bf16x8*>(Qw + 160), f3 = *reinterpret_cast<const bf16x8*>(Qw + 176);
    if (pos0 >= 0) { const int pos = pos0 + wid * QBLK + r32; const float pr = (float)(pos >> 6), pc = (float)(pos & 63);
#pragma unroll
      for (int i = 0; i < 8; ++i) { const float inv = __builtin_amdgcn_exp2f(-(float)(8 * hi + i) * (13.287712379549449f / 16.0f));
        { const float rev = pr * inv * INV_2PI, cs = fcos_rev(rev), sn = fsin_rev(rev); const float a = bf2f((unsigned short)f0[i]), b = bf2f((unsigned short)f1[i]);
          f0[i] = (short)f2bf(a * cs - b * sn); f1[i] = (short)f2bf(b * cs + a * sn); }
        { const float rev = pc * inv * INV_2PI, cs = fcos_rev(rev), sn = fsin_rev(rev); const float a = bf2f((unsigned short)f2[i]), b = bf2f((unsigned short)f3[i]);
          f2[i] = (short)f2bf(a * cs - b * sn); f3[i] = (short)f2bf(b * cs + a * sn); } } }
    *(LAS bf16x8*)(qw + (8 - NQR) * 1024) = f0; *(LAS bf16x8*)(qw + (9 - NQR) * 1024) = f1; *(LAS bf16x8*)(qw + (10 - NQR) * 1024) = f2; *(LAS bf16x8*)(qw + (11 - NQR) * 1024) = f3;
  }
  const int sr = tid >> 4, sc = (tid & 15) * 8, vst0 = v_st(sr, sc), vst1 = v_st(32 + sr, sc);
  const int kr = tid >> 3, kc = tid & 7, kgo = kr * LDK + kc * 8, kst = KSWZ(kr, kc * 16);
  const int vb0 = (int)(unsigned)(uintptr_t)V_lds + v_rd_base(lane);
  bf16x8 vs0, vs1, ks0, ks1, ks2;
#define SLOAD(k0) do { vs0 = *reinterpret_cast<const bf16x8*>(&Vh[(long)((k0) + sr) * LDV + sc]); vs1 = *reinterpret_cast<const bf16x8*>(&Vh[(long)((k0) + 32 + sr) * LDV + sc]); \
    ks0 = *reinterpret_cast<const bf16x8*>(&Kh[(long)(k0) * LDK + kgo]); ks1 = *reinterpret_cast<const bf16x8*>(&Kh[(long)(k0) * LDK + kgo + 64]); \
    ks2 = *reinterpret_cast<const bf16x8*>(&Kh[(long)(k0) * LDK + kgo + 128]); } while (0)
#define SWRITE(b) do { *(LAS bf16x8*)(V_lds + (b) * SHM_V + vst0) = vs0; *(LAS bf16x8*)(V_lds + (b) * SHM_V + vst1) = vs1; \
    *(LAS bf16x8*)(K_lds + (b) * SHM_K + kst) = ks0; *(LAS bf16x8*)(K_lds + (b) * SHM_K + kst + 128) = ks1; *(LAS bf16x8*)(K_lds + (b) * SHM_K + kst + 256) = ks2; } while (0)
#define SWAIT() asm volatile("s_waitcnt vmcnt(0)" ::: "memory")
#define RESC(a) do { if (__any((a) < 1.f)) { if (hi == 0) al_l[r32] = (a); asm volatile("s_waitcnt lgkmcnt(0)" ::: "memory"); \
    _Pragma("unroll") for (int d = 0; d < 4; ++d) _Pragma("unroll") for (int r = 0; r < 16; ++r) o[d][r] *= al_l[crow(r, hi)]; } } while (0)
  f32x16 pA0, pA1, pB0, pB1; float mnA, mnB, alA, alB; bf16x8 pa0, pa1, pa2, pa3; const int NT = seq / KVBLK;
  SLOAD(0); SWAIT(); SWRITE(0); __syncthreads();
  qkt(pA0, pA1, K_lds, qr, qrl, r32, hi); partialSM(pA0, pA1, m_reg, mnA, alA);
  SLOAD(KVBLK);
  SWAIT(); SWRITE(1); __syncthreads();
  for (int j = 1; j + 1 < NT; j += 2) {
    SBAR(); qkt(pB0, pB1, K_lds + SHM_K, qr, qrl, r32, hi);
    finishSM(pA0, pA1, alA, l_reg, pa0, pa1, pa2, pa3); SBAR();
    SLOAD((j + 1) * KVBLK); SBAR();
    pv_d0(o, vb0, pa0, pa1, pa2, pa3); partialSM(pB0, pB1, m_reg, mnB, alB);
    __syncthreads(); SWAIT(); SWRITE(0);
    RESC(alB); __syncthreads();
    SBAR(); qkt(pA0, pA1, K_lds, qr, qrl, r32, hi);
    finishSM(pB0, pB1, alB, l_reg, pa0, pa1, pa2, pa3); SBAR();
    SLOAD((j + 2) * KVBLK); SBAR();
    pv_d0(o, vb0 + SHM_V, pa0, pa1, pa2, pa3); partialSM(pA0, pA1, m_reg, mnA, alA);
    __syncthreads(); SWAIT(); SWRITE(1);
    RESC(alA); __syncthreads();
  }
  SBAR(); qkt(pB0, pB1, K_lds + SHM_K, qr, qrl, r32, hi);
  finishSM(pA0, pA1, alA, l_reg, pa0, pa1, pa2, pa3); SBAR();
  pv_d0(o, vb0, pa0, pa1, pa2, pa3); partialSM(pB0, pB1, m_reg, mnB, alB);
  __syncthreads(); RESC(alB);
  finishSM(pB0, pB1, alB, l_reg, pa0, pa1, pa2, pa3); SBAR();
  pv_d0(o, vb0 + SHM_V, pa0, pa1, pa2, pa3);
  bf16* Ow = Ob + (long)(wid * QBLK) * LDO;
  bool write_out = true; float g1 = 1.f;
  if (part) {
    if (tid == 0) misc[1] = __hip_atomic_fetch_add(cnt, 1u, __ATOMIC_RELAXED, __HIP_MEMORY_SCOPE_AGENT);
    __syncthreads();
    const unsigned ticket = misc[1];
    float* po = part + (size_t)wid * (4 * 16 * 64) + lane * 4; float* pml = part + 8 * 4 * 16 * 64 + wid * 128 + lane;
    if (ticket == 0u) {
#pragma unroll
      for (int d0 = 0; d0 < 4; ++d0)
#pragma unroll
        for (int r4 = 0; r4 < 4; ++r4) { const f32x4 v = {o[d0][4 * r4], o[d0][4 * r4 + 1], o[d0][4 * r4 + 2], o[d0][4 * r4 + 3]}; const float* p = po + (d0 * 4 + r4) * 256;
          asm volatile("global_store_dwordx4 %0, %1, off sc1\n\ts_nop 1" :: "v"(p), "v"(v) : "memory"); }
      __hip_atomic_store((unsigned*)pml, __float_as_uint(m_reg), __ATOMIC_RELAXED, __HIP_MEMORY_SCOPE_AGENT); __hip_atomic_store((unsigned*)pml + 64, __float_as_uint(l_reg), __ATOMIC_RELAXED, __HIP_MEMORY_SCOPE_AGENT);
      asm volatile("s_waitcnt vmcnt(0)" ::: "memory"); __syncthreads();
      if (tid == 0) __hip_atomic_store(cnt + 1, 1u, __ATOMIC_RELAXED, __HIP_MEMORY_SCOPE_AGENT);
      write_out = false;
    } else {
      if (tid == 0) { unsigned sp = 0; while (__hip_atomic_load(cnt + 1, __ATOMIC_RELAXED, __HIP_MEMORY_SCOPE_AGENT) == 0u) { __builtin_amdgcn_s_sleep(2); if (++sp > (1u << 22)) break; }
        __builtin_amdgcn_fence(__ATOMIC_ACQUIRE, "agent"); asm volatile("s_waitcnt vmcnt(0)" ::: "memory"); }
      __syncthreads();
      constexpr float C = SCALE * 1.4426950408889634f;
      const float m2 = pml[0], l2 = pml[64]; const float mn = fmaxf(m_reg, m2);
      const float f1 = __builtin_amdgcn_exp2f((m_reg - mn) * C), f2 = __builtin_amdgcn_exp2f((m2 - mn) * C); const float il = __builtin_amdgcn_rcpf(l_reg * f1 + l2 * f2);
      if (hi == 0) { li_l[r32] = f1 * il; al_l[r32] = f2 * il; } asm volatile("s_waitcnt lgkmcnt(0)" ::: "memory");
#pragma unroll
      for (int r4 = 0; r4 < 4; ++r4)
#pragma unroll
        for (int d0 = 0; d0 < 4; ++d0) { const f32x4 pv = *(const f32x4*)(po + (d0 * 4 + r4) * 256);
#pragma unroll
          for (int e = 0; e < 4; ++e) { const int r = 4 * r4 + e; o[d0][r] = o[d0][r] * li_l[crow(r, hi)] + pv[e] * al_l[crow(r, hi)]; } }
      g1 = 0.f;
    }
  }
  if (write_out) {
    if (g1 != 0.f) {
      if (hi == 0) li_l[r32] = l_reg; asm volatile("s_waitcnt lgkmcnt(0)" ::: "memory");
#pragma unroll
      for (int r = 0; r < 16; ++r) { const float rl = __builtin_amdgcn_rcpf(li_l[crow(r, hi)]);
#pragma unroll
        for (int d0 = 0; d0 < 4; ++d0) o[d0][r] *= rl; }
    }
#pragma unroll
    for (int r = 0; r < 16; ++r) { const int orow = crow(r, hi);
#pragma unroll
      for (int d0 = 0; d0 < 4; ++d0) Ow[(long)orow * LDO + d0 * 32 + r32] = (bf16)f2bf(o[d0][r]); }
  }
  __syncthreads();
#undef SLOAD
#undef SWRITE
#undef SWAIT
#undef RESC
}
#undef KSWZ
#undef SBAR
}
__device__ __forceinline__ void transpose_item(const float* W, int K, int N, bf16* WT, int ldk, LAS float* scr, int item, int lane) {
    const int nblk = N / 32, kb = item / nblk, nb = item % nblk, k0 = 64 * kb, n0 = 32 * nb;
#pragma unroll
    for (int i = 0; i < 32; ++i) { const int kk = 2 * i + (lane >> 5); scr[kk * 33 + (lane & 31)] = W[(size_t)(k0 + kk) * N + n0 + (lane & 31)]; }
    LDS_WAIT(); asm volatile("" ::: "memory");
    const int c = lane & 7;
#pragma unroll
    for (int j = 0; j < 4; ++j) { const int n = (lane >> 3) + 8 * j; const LAS float* s = scr + (8 * c) * 33 + n;
        v4u o; o.x = pk2(s[0 * 33], s[1 * 33]); o.y = pk2(s[2 * 33], s[3 * 33]); o.z = pk2(s[4 * 33], s[5 * 33]); o.w = pk2(s[6 * 33], s[7 * 33]);
        *(v4u*)(WT + (size_t)(n0 + n) * ldk + k0 + 8 * c) = o; }
    LDS_WAIT(); asm volatile("" ::: "memory");
}
constexpr int WI_P0 = 992 + 96 + 64 + 512 + 512 + 32, WI_P1 = WI_P0 + 2 * 2048, WI_ALL = WI_P1 + 2 * 2048;
__device__ __forceinline__ void weight_item(const Args& args, unsigned char* ws, LAS float* scr, int idx, int lane) {
    constexpr int I0 = 992, I1 = 96, I2 = 64, I3 = 512, I4 = 2048;
    int r = idx, K, N, ldk; size_t off; const float* W;
    if (r < I0) { W = args.in[I_WIN]; K = 1024; N = 1984; ldk = 1024; off = WS_WIN_T; }
    else if ((r -= I0) < I1) { W = args.in[I_QUP]; K = 256; N = 768; ldk = 256; off = WS_QUP_T; }
    else if ((r -= I1) < I2) { W = args.in[I_KVUP]; K = 128; N = 1024; ldk = 256; off = WS_KVUP_T; }
    else if ((r -= I2) < I3) { W = args.in[I_WOUT0]; K = 1024; N = 1024; ldk = 1024; off = WS_WOUT0_T; }
    else if ((r -= I3) < I3) { W = args.in[I_WOUT1]; K = 1024; N = 1024; ldk = 1024; off = WS_W1T; }
    else if ((r -= I3) < 32) { W = args.in[I_HFW3]; K = 64; N = 1024; ldk = 256; off = WS_W3T; }
    else if ((r -= 32) < I4) { W = args.in[I_W1_0]; K = 1024; N = 4096; ldk = 1024; off = WS_W1_0; }
    else if ((r -= I4) < I4) { W = args.in[I_W2_0]; K = 4096; N = 1024; ldk = 4096; off = WS_W2_0; }
    else if ((r -= I4) < I4) { W = args.in[I_W1_1]; K = 1024; N = 4096; ldk = 1024; off = WS_W1_1; }
    else { r -= I4; W = args.in[I_W2_1]; K = 4096; N = 1024; ldk = 4096; off = WS_W2_1; }
    transpose_item(W, K, N, (bf16*)(ws + off), ldk, scr, r, lane);
}
__device__ __forceinline__ void row_stats(const f32x4 (&v)[4], float& mean, float& rstd) {
    float s = 0.f;
#pragma unroll
    for (int j = 0; j < 4; ++j) s += (v[j][0] + v[j][1]) + (v[j][2] + v[j][3]);
    mean = wave_sum(s) * (1.f / DM); float q = 0.f;
#pragma unroll
    for (int j = 0; j < 4; ++j) { const f32x4 d = v[j] - mean; q += (d[0] * d[0] + d[1] * d[1]) + (d[2] * d[2] + d[3] * d[3]); }
    rstd = __builtin_amdgcn_rsqf(wave_sum(q) * (1.f / DM) + LN_EPS);
}
__device__ __forceinline__ void load_row(const bf16* p, int lane, f32x4 (&v)[4]) {
#pragma unroll
    for (int j = 0; j < 4; ++j) { const v2u w = ((const v2u*)p)[lane + 64 * j]; v[j] = (f32x4){bf2f((unsigned short)(w.x & 0xffffu)), bf2f((unsigned short)(w.x >> 16)), bf2f((unsigned short)(w.y & 0xffffu)), bf2f((unsigned short)(w.y >> 16))}; }
}
__device__ __forceinline__ void load_row(const float* p, int lane, f32x4 (&v)[4]) {
#pragma unroll
    for (int j = 0; j < 4; ++j) v[j] = ((const f32x4*)p)[lane + 64 * j];
}
__device__ __forceinline__ void adaln_store(const f32x4 (&v)[4], const float* shift, const float* scale, bf16* hrow, int lane) {
    float mean, rstd; row_stats(v, mean, rstd);
#pragma unroll
    for (int j = 0; j < 4; ++j) { const int c = 4 * lane + 256 * j; const f32x4 sc = *(const f32x4*)(scale + c), sh = *(const f32x4*)(shift + c);
        const f32x4 h = (v[j] - mean) * rstd * (sc + 1.0f) + sh;
        v2u w; w.x = pk2(h[0], h[1]); w.y = pk2(h[2], h[3]); *(v2u*)(hrow + c) = w; }
}
__device__ __forceinline__ void ln_affine(f32x4 (&v)[4], const float* g, const float* b, int lane, float* st = nullptr) {
    float mean, rstd; row_stats(v, mean, rstd);
    if (st && lane == 0) { st[0] = mean; st[1] = rstd; }
#pragma unroll
    for (int j = 0; j < 4; ++j) { const int c = 4 * lane + 256 * j; v[j] = (v[j] - mean) * rstd * *(const f32x4*)(g + c) + *(const f32x4*)(b + c); }
}
__device__ __forceinline__ float grp16_sum(float v) { v += __shfl_xor(v, 1); v += __shfl_xor(v, 2); v += __shfl_xor(v, 4); v += __shfl_xor(v, 8); return v; }
__device__ __forceinline__ void row16_stats(const f32x4 (&v)[16], float& mean, float& rstd) {
    float s = 0.f;
#pragma unroll
    for (int j = 0; j < 16; ++j) s += (v[j][0] + v[j][1]) + (v[j][2] + v[j][3]);
    mean = grp16_sum(s) * (1.f / DM); float q = 0.f;
#pragma unroll
    for (int j = 0; j < 16; ++j) { const f32x4 d = v[j] - mean; q += (d[0] * d[0] + d[1] * d[1]) + (d[2] * d[2] + d[3] * d[3]); }
    rstd = __builtin_amdgcn_rsqf(grp16_sum(q) * (1.f / DM) + LN_EPS);
}
__device__ __forceinline__ void load_row16(const float* p, int cl, f32x4 (&v)[16]) {
#pragma unroll
    for (int j = 0; j < 16; ++j) v[j] = ((const f32x4*)p)[cl + 16 * j];
}
__device__ __forceinline__ void load_row16(const bf16* p, int cl, f32x4 (&v)[16]) {
#pragma unroll
    for (int j = 0; j < 16; ++j) { const v2u w = ((const v2u*)p)[cl + 16 * j]; v[j] = (f32x4){bf2f((unsigned short)(w.x & 0xffffu)), bf2f((unsigned short)(w.x >> 16)), bf2f((unsigned short)(w.y & 0xffffu)), bf2f((unsigned short)(w.y >> 16))}; }
}
__device__ __forceinline__ void adaln_store16(const f32x4 (&v)[16], const float* shift, const float* scale, bf16* hrow, int cl) {
    float mean, rstd; row16_stats(v, mean, rstd);
#pragma unroll
    for (int j = 0; j < 16; ++j) { const int c = 4 * cl + 64 * j; const f32x4 sc = *(const f32x4*)(scale + c), sh = *(const f32x4*)(shift + c);
        const f32x4 h = (v[j] - mean) * rstd * (sc + 1.0f) + sh;
        v2u w; w.x = pk2(h[0], h[1]); w.y = pk2(h[2], h[3]); *(v2u*)(hrow + c) = w;
        if ((j & 3) == 3) asm volatile("" ::: "memory"); }
}
__device__ __forceinline__ void ln_affine16(f32x4 (&v)[16], const float* g, const float* b, int cl, float* st = nullptr) {
    float mean, rstd; row16_stats(v, mean, rstd);
    if (st && cl == 0) { st[0] = mean; st[1] = rstd; }
#pragma unroll
    for (int j = 0; j < 16; ++j) { const int c = 4 * cl + 64 * j; v[j] = (v[j] - mean) * rstd * *(const f32x4*)(g + c) + *(const f32x4*)(b + c); if ((j & 3) == 3) asm volatile("" ::: "memory"); }
}
__device__ __forceinline__ void store_row16(float* p, int cl, const f32x4 (&v)[16]) {
#pragma unroll
    for (int j = 0; j < 16; ++j) ((f32x4*)p)[cl + 16 * j] = v[j];
}
__device__ __forceinline__ void store_row(float* p, int lane, const f32x4 (&v)[4]) {
#pragma unroll
    for (int j = 0; j < 4; ++j) ((f32x4*)p)[lane + 64 * j] = v[j];
}

namespace hconv {
using bf16x8 = __attribute__((ext_vector_type(8))) short;
using f32x16 = __attribute__((ext_vector_type(16))) float;
constexpr int UB = 8256;
constexpr int SLOT = 16384 + 2 * UB;
__device__ __forceinline__ int crow(int r, int hi) { return (r & 3) + 8 * (r >> 2) + 4 * hi; }
__device__ __forceinline__ void item(const bf16* __restrict__ GRB, const bf16* __restrict__ UT, const float* __restrict__ FP, const float* __restrict__ skipv, const bf16* __restrict__ X0, bf16* __restrict__ YM,
                                     int ch0, LAS unsigned char* lds, const int tid, const int lane, const int wave) {
    for (int q = tid; q < 4 * 1024; q += 512) { const int ch = q >> 10, i = q & 1023; const v4u v = ((const v4u*)(GRB + (size_t)(ch0 + ch) * 8192))[i]; *(LAS v4u*)(lds + ch * SLOT + 16 * i) = v; }
    for (int q = tid; q < 4 * 1024; q += 512) { const int ch = q >> 10, b = (q >> 9) & 1, i = q & 511; const v4u v = ((const v4u*)(UT + ((size_t)b * HY + ch0 + ch) * LS))[i];
        *(LAS v4u*)(lds + ch * SLOT + 16384 + b * UB + 32 + 16 * i) = v; }
    if (tid < 32) { const int ch = tid >> 3, b = (tid >> 2) & 1, j = tid & 3; const v4u z = {0u, 0u, 0u, 0u};
        *(LAS v4u*)(lds + ch * SLOT + 16384 + b * UB + (j < 2 ? 16 * j : 32 + 8192 + 16 * (j - 2))) = z; }
    __syncthreads();
    v2u x0v[16];
    {
        const int slot = wave & 3, khalf = wave >> 2;
        const LAS unsigned char* gr = lds + slot * SLOT; const LAS unsigned char* ubuf = gr + 16384;
        const int r = lane & 31, h = lane >> 5, c = r & 15, b = r >> 4, c0 = c & 1, c1 = c >> 1;
        const LAS unsigned char* ap = gr + 992 + 16 * h - 32 * r + khalf * (129 * 32);
        const LAS unsigned char* bp = ubuf + b * UB + 16 * h + 4 * c1 + khalf * (129 * 32);
        const unsigned sh = 16u * (unsigned)c0;
        const int ch = ch0 + slot;
        const float nsum = wave_sum(lane < 32 ? FP[ch * 32 + lane] + FP[(HY + ch) * 32 + lane] : 0.f); const float inv_norm = 1.f / nsum; const float skn = skipv[ch] * nsum;
        const LAS bf16* ul = (const LAS bf16*)(ubuf + b * UB + 32);
        f32x16 acc[8];
#pragma unroll
        for (int Q = 0; Q < 8; ++Q)
#pragma unroll
            for (int g = 0; g < 16; ++g) acc[Q][g] = khalf ? 0.f : skn * bf2f(ul[16 * (32 * Q + crow(g, h)) + c]);
        int nks = khalf ? 128 : 129; asm volatile("" : "+s"(nks));
        unsigned aa = (unsigned)(uintptr_t)ap, ba = (unsigned)(uintptr_t)bp;
        bf16x8 fa0, fa1, fa2, fa3, fa4, fa5, fa6, fa7, fb0, fb1, fb2, fb3, fb4, fb5, fb6, fb7; v2u da01, da23, db01, db23; unsigned da4, db4;
#define HC_LD(F0, F1, F2, F3, F4, F5, F6, F7, D01, D23, D4) do { \
            asm volatile("ds_read_b128 %0, %1 offset:7168" : "=v"(F0) : "v"(aa)); asm volatile("ds_read_b128 %0, %1 offset:6144" : "=v"(F1) : "v"(aa)); \
            asm volatile("ds_read2_b32 %0, %1 offset1:1" : "=v"(D01) : "v"(ba)); asm volatile("ds_read2_b32 %0, %1 offset0:2 offset1:3" : "=v"(D23) : "v"(ba)); asm volatile("ds_read_b32 %0, %1 offset:16" : "=v"(D4) : "v"(ba)); \
            asm volatile("ds_read_b128 %0, %1 offset:5120" : "=v"(F2) : "v"(aa)); asm volatile("ds_read_b128 %0, %1 offset:4096" : "=v"(F3) : "v"(aa)); \
            asm volatile("ds_read_b128 %0, %1 offset:3072" : "=v"(F4) : "v"(aa)); asm volatile("ds_read_b128 %0, %1 offset:2048" : "=v"(F5) : "v"(aa)); \
            asm volatile("ds_read_b128 %0, %1 offset:1024" : "=v"(F6) : "v"(aa)); asm volatile("ds_read_b128 %0, %1" : "=v"(F7) : "v"(aa)); __builtin_amdgcn_sched_barrier(0); } while (0)
#define HC_WAIT(F0, F1, F2, F3, F4, F5, F6, F7, D01, D23, D4) do { __builtin_amdgcn_sched_barrier(0); asm volatile("s_waitcnt lgkmcnt(0)" : "+v"(F0), "+v"(F1), "+v"(F2), "+v"(F3), "+v"(F4), "+v"(F5), "+v"(F6), "+v"(F7), "+v"(D01), "+v"(D23), "+v"(D4)); \
            __builtin_amdgcn_sched_barrier(0); } while (0)
#define HC_MMA(F0, F1, F2, F3, F4, F5, F6, F7, D01, D23, D4) do { u32x4 bw; bw.x = __builtin_amdgcn_alignbit(D01.y, D01.x, sh); bw.y = __builtin_amdgcn_alignbit(D23.x, D01.y, sh); bw.z = __builtin_amdgcn_alignbit(D23.y, D23.x, sh); \
            bw.w = __builtin_amdgcn_alignbit(D4, D23.y, sh); const bf16x8 bf = __builtin_bit_cast(bf16x8, bw); \
            acc[0] = __builtin_amdgcn_mfma_f32_32x32x16_bf16(F0, bf, acc[0], 0, 0, 0); acc[1] = __builtin_amdgcn_mfma_f32_32x32x16_bf16(F1, bf, acc[1], 0, 0, 0); \
            acc[2] = __builtin_amdgcn_mfma_f32_32x32x16_bf16(F2, bf, acc[2], 0, 0, 0); acc[3] = __builtin_amdgcn_mfma_f32_32x32x16_bf16(F3, bf, acc[3], 0, 0, 0); \
            acc[4] = __builtin_amdgcn_mfma_f32_32x32x16_bf16(F4, bf, acc[4], 0, 0, 0); acc[5] = __builtin_amdgcn_mfma_f32_32x32x16_bf16(F5, bf, acc[5], 0, 0, 0); \
            acc[6] = __builtin_amdgcn_mfma_f32_32x32x16_bf16(F6, bf, acc[6], 0, 0, 0); acc[7] = __builtin_amdgcn_mfma_f32_32x32x16_bf16(F7, bf, acc[7], 0, 0, 0); } while (0)
        HC_LD(fa0, fa1, fa2, fa3, fa4, fa5, fa6, fa7, da01, da23, da4);
        int npair = nks >> 1;
        for (int kp = 0; kp < npair; ++kp) {
            HC_WAIT(fa0, fa1, fa2, fa3, fa4, fa5, fa6, fa7, da01, da23, da4);
            aa += 32; ba += 32; HC_LD(fb0, fb1, fb2, fb3, fb4, fb5, fb6, fb7, db01, db23, db4);
            HC_MMA(fa0, fa1, fa2, fa3, fa4, fa5, fa6, fa7, da01, da23, da4);
            HC_WAIT(fb0, fb1, fb2, fb3, fb4, fb5, fb6, fb7, db01, db23, db4);
            aa += 32; ba += 32; HC_LD(fa0, fa1, fa2, fa3, fa4, fa5, fa6, fa7, da01, da23, da4);
            HC_MMA(fb0, fb1, fb2, fb3, fb4, fb5, fb6, fb7, db01, db23, db4);
        }
        HC_WAIT(fa0, fa1, fa2, fa3, fa4, fa5, fa6, fa7, da01, da23, da4);
        if (nks & 1) HC_MMA(fa0, fa1, fa2, fa3, fa4, fa5, fa6, fa7, da01, da23, da4);
#undef HC_LD
#undef HC_WAIT
#undef HC_MMA
#pragma unroll
        for (int i = 0; i < 16; ++i) { const int q = tid + 512 * i; x0v[i] = *(const v2u*)(X0 + ((size_t)NP + q) * HY + ch0); }
        asm volatile("s_waitcnt lgkmcnt(0)" ::: "memory");
        __syncthreads();
        LAS f32x4* xch = (LAS f32x4*)(lds + slot * SLOT);
        if (khalf) {
#pragma unroll
            for (int Q = 0; Q < 8; ++Q)
#pragma unroll
                for (int g4 = 0; g4 < 4; ++g4) xch[(Q * 4 + g4) * 64 + lane] = (f32x4){acc[Q][4 * g4], acc[Q][4 * g4 + 1], acc[Q][4 * g4 + 2], acc[Q][4 * g4 + 3]};
        }
        __syncthreads();
        if (!khalf) {
#pragma unroll
            for (int Q = 0; Q < 8; ++Q)
#pragma unroll
                for (int g4 = 0; g4 < 4; ++g4) { const f32x4 o = xch[(Q * 4 + g4) * 64 + lane]; acc[Q][4 * g4] += o[0]; acc[Q][4 * g4 + 1] += o[1]; acc[Q][4 * g4 + 2] += o[2]; acc[Q][4 * g4 + 3] += o[3]; }
        }
        asm volatile("s_waitcnt lgkmcnt(0)" ::: "memory");
        __syncthreads();
        if (!khalf) {
            LAS bf16* yl = (LAS bf16*)(lds + slot * SLOT);
#pragma unroll
            for (int Q = 0; Q < 8; ++Q)
#pragma unroll
                for (int g = 0; g < 16; ++g) { const int t = 16 * (32 * Q + crow(g, h)) + c; yl[b * LS + t] = (bf16)f2bf(acc[Q][g] * inv_norm); }
        }
    }
    __syncthreads();
#pragma unroll
    for (int i = 0; i < 16; ++i) { const int q = tid + 512 * i; const size_t row = (size_t)NP + q; const v2u xv = x0v[i];
        const float y0 = bf2f(*(const LAS bf16*)(lds + 0 * SLOT + 2 * q)), y1 = bf2f(*(const LAS bf16*)(lds + 1 * SLOT + 2 * q)), y2 = bf2f(*(const LAS bf16*)(lds + 2 * SLOT + 2 * q)), y3 = bf2f(*(const LAS bf16*)(lds + 3 * SLOT + 2 * q));
        v2u o; o.x = pk2(y0 * bf2f((unsigned short)(xv.x & 0xffffu)), y1 * bf2f((unsigned short)(xv.x >> 16))); o.y = pk2(y2 * bf2f((unsigned short)(xv.y & 0xffffu)), y3 * bf2f((unsigned short)(xv.y >> 16)));
        *(v2u*)(YM + row * DM + ch0) = o; }
    __syncthreads();
}
constexpr int PUB = 576, PSLOT = 1024 + 16 * PUB;
__device__ __forceinline__ void prompt_item(const float* __restrict__ FT, const bf16* __restrict__ UT, const float* __restrict__ FP, const float* __restrict__ skipv, const bf16* __restrict__ X0, bf16* __restrict__ YM,
                                            int ch0, LAS unsigned char* lds, const int tid, const int lane, const int wave) {
    const int ch = ch0 + wave; LAS unsigned char* slot = lds + wave * PSLOT;
    {
        LAS bf16* gr = (LAS bf16*)slot;
#pragma unroll
        for (int i = 0; i < 8; ++i) { const int e = lane + 64 * i; const int d = LP - e; float v = 0.f; if (e != 0) v = d >= 0 ? FT[(size_t)ch * LP + d] : FT[(size_t)(HY + ch) * LP - d]; gr[e] = (bf16)f2bf(v); }
#pragma unroll
        for (int i = 0; i < 8; ++i) { const int q = lane + 64 * i, b = q >> 5, j = q & 31; const v4u v = ((const v4u*)(UT + ((size_t)b * HY + ch) * LP))[j]; *(LAS v4u*)(slot + 1024 + b * PUB + 32 + 16 * j) = v; }
        { const int b = lane >> 2, j = lane & 3; const v4u z = {0u, 0u, 0u, 0u}; *(LAS v4u*)(slot + 1024 + b * PUB + (j < 2 ? 16 * j : 32 + 512 + 16 * (j - 2))) = z; }
    }
    asm volatile("s_waitcnt vmcnt(0) lgkmcnt(0)" ::: "memory");
    const int r = lane & 31, h = lane >> 5, c = r & 15, bh = r >> 4, c0 = c & 1, c1 = c >> 1; const unsigned sh = 16u * (unsigned)c0;
    const float nsum = (FP[ch * 2] + FP[ch * 2 + 1]) + (FP[(HY + ch) * 2] + FP[(HY + ch) * 2 + 1]);
    const float inv_norm = 1.f / nsum, skn = skipv[ch] * nsum;
    const LAS unsigned char* ubuf = slot + 1024;
    f32x16 acc[8];
#pragma unroll
    for (int ct = 0; ct < 8; ++ct) { const LAS bf16* ul = (const LAS bf16*)(ubuf + (2 * ct + bh) * PUB + 32);
#pragma unroll
        for (int g = 0; g < 16; ++g) acc[ct][g] = g < 8 ? skn * bf2f(ul[16 * crow(g, h) + c]) : 0.f; }
    const LAS unsigned char* ap = slot + 2 * (240 - 16 * (r < 15 ? r : 15) + 8 * h);
    const LAS unsigned char* bp = ubuf + bh * PUB + 16 * h + 4 * c1;
    int nks = 17; asm volatile("" : "+s"(nks));
    for (int ks = 0; ks < nks; ++ks) {
        const bf16x8 af = *(const LAS bf16x8*)(ap + 32 * ks);
#pragma unroll
        for (int ct = 0; ct < 8; ++ct) { const LAS unsigned* bq = (const LAS unsigned*)(bp + 2 * ct * PUB + 32 * ks);
            const unsigned d0 = bq[0], d1 = bq[1], d2 = bq[2], d3 = bq[3], d4 = bq[4];
            u32x4 bw; bw.x = __builtin_amdgcn_alignbit(d1, d0, sh); bw.y = __builtin_amdgcn_alignbit(d2, d1, sh); bw.z = __builtin_amdgcn_alignbit(d3, d2, sh); bw.w = __builtin_amdgcn_alignbit(d4, d3, sh);
            acc[ct] = __builtin_amdgcn_mfma_f32_32x32x16_bf16(af, __builtin_bit_cast(bf16x8, bw), acc[ct], 0, 0, 0); }
    }
    asm volatile("s_waitcnt lgkmcnt(0)" ::: "memory");
    {
        LAS bf16* yl = (LAS bf16*)(slot + 1024);
#pragma unroll
        for (int ct = 0; ct < 8; ++ct)
#pragma unroll
            for (int g = 0; g < 8; ++g) yl[(2 * ct + bh) * LP + 16 * crow(g, h) + c] = (bf16)f2bf(acc[ct][g] * inv_norm);
    }
    __syncthreads();
#pragma unroll
    for (int i = 0; i < 8; ++i) { const int q = tid + 512 * i;
        const v4u xv = *(const v4u*)(X0 + (size_t)q * HY + ch0); unsigned xw[4] = {xv.x, xv.y, xv.z, xv.w}, ow[4];
#pragma unroll
        for (int k = 0; k < 4; ++k) { const float ya = bf2f(*(const LAS bf16*)(lds + (2 * k) * PSLOT + 1024 + 2 * q)), yb = bf2f(*(const LAS bf16*)(lds + (2 * k + 1) * PSLOT + 1024 + 2 * q));
            ow[k] = pk2(ya * bf2f((unsigned short)(xw[k] & 0xffffu)), yb * bf2f((unsigned short)(xw[k] >> 16))); }
        *(v4u*)(YM + (size_t)q * DM + ch0) = (v4u){ow[0], ow[1], ow[2], ow[3]}; }
    __syncthreads();
}
static_assert(4 * SLOT <= LDSCTL_OFF, "four channel slots fit in LDS");
}

__global__ void __launch_bounds__(512, 2) fwd_kernel(Args args) {
    extern __shared__ __attribute__((aligned(16))) unsigned char lds_raw[];
    LAS unsigned char* lds = (LAS unsigned char*)lds_raw;
    volatile LAS unsigned* MISC = (volatile LAS unsigned*)(lds + MISC_OFF);
    const int wave = __builtin_amdgcn_readfirstlane((int)threadIdx.x >> 6);
    const int G = gridDim.x; const int bx = blockIdx.x; const int vcu = (G % 8 == 0) ? (bx % 8) * (G / 8) + bx / 8 : bx;
    const int gw = vcu * 8 + wave, NGW = G * 8, NGT = G * 512;
#define FRESH() const int lane = fresh_lane(); const int tid = wave * 64 + lane; const int gt = vcu * 512 + tid; (void)gt
    unsigned char* ws = args.ws;
    gu32* ctl = (gu32*)(ws + WS_CTL);
    float* MODS = (float*)(ws + WS_MODS);
    float* X = args.out;
    float* STATS = (float*)(ws + WS_STATS);
    bf16* T = (bf16*)(ws + WS_T);
    bf16* HB = (bf16*)(ws + WS_H);
    for (int u = threadIdx.x; u < (LDS_BYTES - LDSCTL_OFF) / 4; u += 512) ((LAS unsigned*)(lds + LDSCTL_OFF))[u] = 0u;
    __syncthreads();
    XcdBarrier bar; bar.bar = (unsigned*)(ctl + CW_BAR) + args.li * XCD_BAR_WORDS; bar.x = 0; bar.st = nullptr;
    if (!MK_PER_PHASE) bar = xcd_barrier_post((unsigned*)(ctl + CW_BAR) + args.li * XCD_BAR_WORDS, MISC + 8);
    const int lo = args.ph_lo, hi = args.ph_hi;
#ifndef NO_CONV
#define NO_CONV 0
#endif
#ifndef NO_ATT
#define NO_ATT 0
#endif
#ifndef PHASE_MASK
#define PHASE_MASK 0x1FFFF
#endif
#define IN(k) ((((PHASE_MASK) >> (k)) & 1) && lo <= (k) && (k) < hi)
#define SPLIT_CNT(b) ((unsigned*)(ctl + CW_SPLIT + (args.li * 6 + (b)) * 16384))
#define SLABS(mib) ((float*)(ws + (size_t)(mib) * MiB))
#define SEAM(k) do { if (IN(k) && IN((k) + 1)) xcd_barrier(bar); } while (0)

    if (IN(0)) {
        FRESH();
        asm volatile("; ==== PHASE 0 ====");
        for (int it = bx; it < 192; it += G) {
            const int layer = it / 96, cb = it % 96, col = cb * 64 + lane;
            LAS float* sil = (LAS float*)lds; LAS float* red = (LAS float*)(lds + 12288);
            for (int i = tid; i < 3072; i += 512) { const int r = i >> 10, k = i & 1023; const float c = (r == 0) ? args.in[I_CCTX][k] : args.in[I_C][(r - 1) * DM + k]; sil[i] = c / (1.f + fexp(-c)); }
            __syncthreads();
            const float* W = args.in[layer ? I_ADA1_W : I_ADA0_W]; float a0 = 0.f, a1 = 0.f, a2 = 0.f;
#pragma unroll 8
            for (int kk = 0; kk < 128; ++kk) { const int k = wave * 128 + kk; const float w = W[(size_t)k * 6144 + col]; a0 += sil[k] * w; a1 += sil[1024 + k] * w; a2 += sil[2048 + k] * w; }
            red[(wave * 3 + 0) * 64 + lane] = a0; red[(wave * 3 + 1) * 64 + lane] = a1; red[(wave * 3 + 2) * 64 + lane] = a2;
            __syncthreads();
            if (tid < 192) { const int r = tid >> 6, l = tid & 63; float s = 0.f;
#pragma unroll
                for (int w = 0; w < 8; ++w) s += red[(w * 3 + r) * 64 + l];
                MODS[(size_t)(layer * 3 + r) * 6144 + cb * 64 + l] = s + args.in[layer ? I_ADA1_B : I_ADA0_B][cb * 64 + l]; }
            __syncthreads();
        }
        {
            LAS float* scr = (LAS float*)(lds + wave * 16384);
            for (int it = gw; it < WI_P0; it += NGW) weight_item(args, ws, scr, it, lane);
        }
        for (int i = gt; i < 2048 * 128; i += NGT) { const int kp = i >> 7, c8 = (i & 127) * 8; const int part = kp >> 10, kq = kp & 1023, g = kq >> 7, cp = kq & 127; unsigned w[4] = {0u, 0u, 0u, 0u};
            if ((c8 >> 7) == g) {
#pragma unroll
                for (int e = 0; e < 8; e += 2) { const float r0 = (float)((cp * ((c8 + e) & 127)) & 127) * (1.f / 128.f), r1 = (float)((cp * ((c8 + e + 1) & 127)) & 127) * (1.f / 128.f);
                    const float a = (part ? -__builtin_amdgcn_sinf(r0) : __builtin_amdgcn_cosf(r0)) * 0.08838834764831845f, b = (part ? -__builtin_amdgcn_sinf(r1) : __builtin_amdgcn_cosf(r1)) * 0.08838834764831845f;
                    w[e >> 1] = pk2(a, b); } }
            ((v4u*)(ws + WS_CBD))[i] = (v4u){w[0], w[1], w[2], w[3]}; }
        {
            const v4u z = {0u, 0u, 0u, 0u};
            for (int i = gt; i < 8192 + 16384 + MKV * 16 + 1024 * 24; i += NGT) {
                if (i < 8192) ((v4u*)(ws + WS_WIN_T + (size_t)1984 * 2048))[i] = z;
                else if (i < 8192 + 16384) { const int j = i - 8192; *(v4u*)(ws + WS_KVUP_T + (size_t)(j >> 4) * 512 + 256 + (j & 15) * 16) = z; }
                else if (i < 8192 + 16384 + MKV * 16) { const int j = i - 8192 - 16384; *(v4u*)(ws + WS_KVN + (size_t)(j >> 4) * 512 + 256 + (j & 15) * 16) = z; }
                else { const int j = i - 8192 - 16384 - MKV * 16; *(v4u*)(ws + WS_W3T + (size_t)(j / 24) * 512 + 128 + (j % 24) * 16) = z; }
            }
        }
        for (int i = gt; i < 65536; i += NGT) { const int rho = i >> 8, l = i & 255; const int k = rho > 128 ? rho - 128 : rho; const float rev = (float)((k * l) & 255) * (1.f / 256.f);
            ((bf16*)(ws + WS_D256))[i] = (bf16)f2bf((rho > 128 ? __builtin_amdgcn_sinf(rev) : __builtin_amdgcn_cosf(rev)) * 0.0625f); }
        {
            bf16* H2B = (bf16*)(ws + WS_H2B);
            const float* w1 = args.in[I_HFW1]; const float* w2 = args.in[I_HFW2];
            const float b1 = args.in[I_HFB1][lane], b2 = args.in[I_HFB2][lane], fr = args.in[I_HFFREQ][lane];
            for (int R = gw; R < LS + LP; R += NGW) {
                const int L = R < LS ? LS : LP, l = R < LS ? R : R - LS;
                const float t = (float)l / (float)(L - 1);
                const float wang = (6.283185307179586f * (float)l) / (float)L;
                const int j = lane & 15; const float band = 1e-4f + (float)j * ((15.0f - 1e-4f) / 15.0f);
                const float ang = wang * band, rev = ang * INV_2PI;
                const float zl = (lane < 16) ? fcos_rev(rev) : -fsin_rev(rev);
                float p1 = b1 + t * w1[lane];
#pragma unroll
                for (int i = 0; i < 32; ++i) p1 += __shfl(zl, i) * w1[(1 + i) * 64 + lane];
                const float h1 = sinf(fr * p1);
                float p2 = b2;
#pragma unroll 16
                for (int i = 0; i < 64; ++i) p2 += __shfl(h1, i) * w2[i * 64 + lane];
                const float h2 = sinf(fr * p2);
                { const float a = __shfl(h2, 4 * (lane & 15)), b = __shfl(h2, 4 * (lane & 15) + 1), c = __shfl(h2, 4 * (lane & 15) + 2), d = __shfl(h2, 4 * (lane & 15) + 3);
                  v2u w; w.x = lane < 16 ? pk2(a, b) : 0u; w.y = lane < 16 ? pk2(c, d) : 0u; ((v2u*)(H2B + (size_t)R * 256))[lane] = w; }
            }
        }
    }
    SEAM(0);

    if (IN(1)) {
        FRESH();
        asm volatile("; ==== PHASE 1 ====");
        for (int m4 = gw * 4; m4 < MT; m4 += NGW * 4) { const int m = m4 + (lane >> 4); int cl = lane & 15; asm volatile("" : "+v"(cl));
            const float* xr = m < NP ? args.in[I_XP] + (size_t)m * DM : args.in[I_XS] + (size_t)(m - NP) * DM;
            const float* md = MODS + (size_t)req_of_row(m) * 6144;
            f32x4 v[16]; load_row16(xr, cl, v); adaln_store16(v, md, md + 1024, HB + (size_t)m * DM, cl);
        }
        {
            int k256 = 256; asm volatile("" : "+s"(k256));
            pg8::Gemm g{(const bf16*)(ws + WS_H2B), (const bf16*)(ws + WS_W3T), LS + LP, 1024, k256}; pg8::StaticOrder S; S.init(LS + LP, 1024, G, (bx + 64) % G);
            EpiFilt E{(bf16*)(ws + WS_FT_S), (float*)(ws + WS_FT_P), (float*)(ws + WS_FPART_S), (float*)(ws + WS_FPART_P)};
            const int lane2 = fresh_lane(); const int tid = wave * 64 + lane2;
            pg8::gemm_phase<EpiFilt, pg8::StaticOrder, PG8_ALIGN, PG8_SP2>(lds, g, S, E, tid);
        }
        { int bx3 = (bx + 128) % G; asm volatile("" : "+s"(bx3)); const int lane3 = fresh_lane(); const int tid = wave * 64 + lane3;
          pg8::Gemm g{(const bf16*)(ws + WS_W1T), (const bf16*)(ws + WS_CBD), DM, 2048, DM}; pg8::StaticOrder S; S.init(DM, 2048, G, bx3);
          EpiStore E{(bf16*)(ws + WS_WFOLD_T), 2048};
          pg8::gemm_phase<EpiStore, pg8::StaticOrder, PG8_ALIGN, PG8_SP2>(lds, g, S, E, tid); }
        {
            const bool has_gemm = ((bx + 64) % G) < 68 || ((bx + 128) % G) < 32;
            LAS float* scr = (LAS float*)(lds + wave * 16384);
            if (G == 256) {
                if (!has_gemm) { const int widx = bx < 128 ? bx - 4 : 124 + (bx - 160), nidle = 156;
                    for (int it = widx * 8 + wave; it < WI_P1 - WI_P0; it += nidle * 8) weight_item(args, ws, scr, WI_P0 + it, lane); }
            } else { for (int it = gw; it < WI_P1 - WI_P0; it += NGW) weight_item(args, ws, scr, WI_P0 + it, lane); }
        }
    }
    SEAM(1);

    if (IN(2)) {
        FRESH();
        asm volatile("; ==== PHASE 2 ====");
        pg8::Gemm g{HB, (const bf16*)(ws + WS_WIN_T), MT, WINP, DM}; pg8::StaticOrder S; S.init((MT / 192) * 256, WINP, G, bx);
        EpiWin<3> E{(bf16*)(ws + WS_P), (float*)(ws + WS_ZS)};
        pg8::gemm_phase<EpiWin<3>, pg8::StaticOrder, PG8_ALIGN, PG8_SP2, 3>(lds, g, S, E, tid);
    }
    SEAM(2);

    if (IN(3)) {
        FRESH();
        asm volatile("; ==== PHASE 3 ====");
        const float* ZS = (const float*)(ws + WS_ZS);
        bf16* QN = (bf16*)(ws + WS_QN); bf16* KVN = (bf16*)(ws + WS_KVN);
        for (int m4 = gw * 4; m4 < MKV; m4 += NGW * 4) {
            const int m = m4 + (lane >> 4); int cl = lane & 15; asm volatile("" : "+v"(cl));
            if (m4 < MT) {
                const bool smp = m >= NP; const int b = smp ? (m - NP) / LS : m / LP, key = smp ? (m - NP) % LS : m % LP;
                f32x4 v[7];
#pragma unroll
                for (int j = 0; j < 7; ++j) v[j] = ((const f32x4*)(ZS + (size_t)m * 512))[cl + 16 * j];
                float sq = 0.f, sk = 0.f;
#pragma unroll
                for (int j = 0; j < 4; ++j) sq += (v[j][0] * v[j][0] + v[j][1] * v[j][1]) + (v[j][2] * v[j][2] + v[j][3] * v[j][3]);
#pragma unroll
                for (int j = 4; j < 6; ++j) sk += (v[j][0] * v[j][0] + v[j][1] * v[j][1]) + (v[j][2] * v[j][2] + v[j][3] * v[j][3]);
                const float rq = __builtin_amdgcn_rsqf(grp16_sum(sq) * (1.f / QL) + RMS_EPS), rk = __builtin_amdgcn_rsqf(grp16_sum(sk) * (1.f / KVL) + RMS_EPS);
#pragma unroll
                for (int j = 0; j < 4; ++j) { const int c = 4 * cl + 64 * j; const f32x4 g = *(const f32x4*)(args.in[I_QNORM] + c); const f32x4 y = v[j] * rq * g;
                    v2u w; w.x = pk2(y[0], y[1]); w.y = pk2(y[2], y[3]); *(v2u*)(QN + (size_t)m * 256 + c) = w; }
#pragma unroll
                for (int j = 4; j < 6; ++j) { const int c = 4 * cl + 64 * (j - 4); const f32x4 g = *(const f32x4*)(args.in[I_KVNORM] + c); const f32x4 y = v[j] * rk * g;
                    v2u w; w.x = pk2(y[0], y[1]); w.y = pk2(y[2], y[3]); *(v2u*)(KVN + (size_t)m * 256 + c) = w;
                    if (!smp) *(f32x4*)(args.out + OUT_CKV + (size_t)m * KVL + c) = y; }
                {
                    const int seg = cl >> 3; const bool second = (cl & 4) != 0; const int j0 = 4 * (cl & 3);
                    const float pf = (float)(seg == 0 ? (key >> 6) : (key & 63)); f32x4 y = v[6];
#pragma unroll
                    for (int e = 0; e < 4; ++e) { const float pr = __shfl_xor(v[6][e], 4);
                        if (smp) { const float inv = __builtin_amdgcn_exp2f(-(float)(j0 + e) * (13.287712379549449f / 16.0f)); const float rev = pf * inv * INV_2PI;
                            y[e] = v[6][e] * fcos_rev(rev) + (second ? pr : -pr) * fsin_rev(rev); } }
                    const int kk = 4 * cl;
                    if (!smp) *(f32x4*)(args.out + OUT_CKR + (size_t)m * DROPE + kk) = y;
                    v2u w; w.x = pk2(y[0], y[1]); w.y = pk2(y[2], y[3]);
                    bf16* kf = (bf16*)(ws + (smp ? WS_KF_S : WS_KF_P)); const int lk = smp ? LKS : LP;
#pragma unroll
                    for (int h = 0; h < NH; ++h) *(v2u*)(kf + ((size_t)(b * NH + h) * lk + key) * DQK + DNOPE + kk) = w;
                }
            } else {
                const int mm = m - MT, b = mm / PAST, jj = mm % PAST;
#pragma unroll
                for (int j = 0; j < 2; ++j) { const int c = 4 * cl + 64 * j; const f32x4 y = *(const f32x4*)(args.in[I_CKV] + (size_t)mm * KVL + c); v2u w; w.x = pk2(y[0], y[1]); w.y = pk2(y[2], y[3]); *(v2u*)(KVN + (size_t)m * 256 + c) = w; }
                { const int kk = 4 * cl; const f32x4 y = *(const f32x4*)(args.in[I_CKR] + (size_t)mm * DROPE + kk); v2u w; w.x = pk2(y[0], y[1]); w.y = pk2(y[2], y[3]);
                  bf16* kf = (bf16*)(ws + WS_KF_S);
#pragma unroll
                  for (int h = 0; h < NH; ++h) *(v2u*)(kf + ((size_t)(b * NH + h) * LKS + LS + jj) * DQK + DNOPE + kk) = w; }
            }
        }
    }
    SEAM(3);

    if (IN(4)) {
        FRESH();
        asm volatile("; ==== PHASE 4 ====");
        const bf16* P = (const bf16*)(ws + WS_P);
        for (int it = (G == 256) ? (bx >= 144 ? bx - 144 + 56 : (bx >= 56 && bx < 112 ? bx - 56 : (bx >= 112 ? 168 + (bx - 112) : 1000))) : bx; it < MT / 64; it += (G == 256 ? 1000 : G)) {
            const int m0 = it * 64; const bool smp = m0 >= NP; const int L = smp ? LS : LP; const int l0 = smp ? (m0 - NP) % LS : m0 % LP;
            const int seq = smp ? (m0 - NP) / LS : m0 / LP;
            const int c8 = (tid & 63) * 8, ts = tid >> 6, tb = m0 + ts * 8, lb = l0 + ts * 8;
            const float* cw = args.in[I_CONVW]; const float* cb = args.in[I_CONVB];
            LAS bf16* ut = (LAS bf16*)lds;
            bf16* X0 = (bf16*)(ws + WS_X0);
            float x1v[8][8];
#pragma unroll
            for (int sa = 0; sa < 3; ++sa) {
                v4u rr[1][10];
#pragma unroll
                for (int r = 0; r < 10; ++r) { const int lp = lb - 1 + r; const bool ok = lp >= 0 && lp < L;
                    const v4u v = *(const v4u*)(P + (size_t)(tb - 1 + r + (ok ? 0 : (r == 0 ? 1 : -1))) * 1536 + sa * 512 + c8); rr[0][r] = ok ? v : (v4u){0u, 0u, 0u, 0u}; }
                float w[3][8], bb[8];
#pragma unroll
                for (int k = 0; k < 3; ++k) { const f32x4 wa = *(const f32x4*)(cw + k * 1536 + sa * 512 + c8), wb = *(const f32x4*)(cw + k * 1536 + sa * 512 + c8 + 4);
                    w[k][0] = wa[0]; w[k][1] = wa[1]; w[k][2] = wa[2]; w[k][3] = wa[3]; w[k][4] = wb[0]; w[k][5] = wb[1]; w[k][6] = wb[2]; w[k][7] = wb[3]; }
                { const f32x4 ba = *(const f32x4*)(cb + sa * 512 + c8), bc = *(const f32x4*)(cb + sa * 512 + c8 + 4); bb[0] = ba[0]; bb[1] = ba[1]; bb[2] = ba[2]; bb[3] = ba[3]; bb[4] = bc[0]; bb[5] = bc[1]; bb[6] = bc[2]; bb[7] = bc[3]; }
#pragma unroll
                for (int i = 0; i < 8; ++i) { float y[8];
#pragma unroll
                    for (int e = 0; e < 8; ++e) { const int wd = e >> 1, hi = e & 1;
                        const unsigned u0 = rr[0][i][wd], u1 = rr[0][i + 1][wd], u2 = rr[0][i + 2][wd];
                        const float p0 = bf2f((unsigned short)(hi ? u0 >> 16 : u0 & 0xffffu)), p1 = bf2f((unsigned short)(hi ? u1 >> 16 : u1 & 0xffffu)), p2 = bf2f((unsigned short)(hi ? u2 >> 16 : u2 & 0xffffu));
                        y[e] = p0 * w[0][e] + p1 * w[1][e] + p2 * w[2][e] + bb[e]; }
                    if (sa == 0) { v4u o; o.x = pk2(y[0], y[1]); o.y = pk2(y[2], y[3]); o.z = pk2(y[4], y[5]); o.w = pk2(y[6], y[7]); *(v4u*)(X0 + (size_t)(tb + i) * 512 + c8) = o; }
                    else if (sa == 1) {
#pragma unroll
                        for (int e = 0; e < 8; ++e) x1v[i][e] = y[e]; }
                    else {
#pragma unroll
                        for (int e = 0; e < 8; ++e) x1v[i][e] *= y[e]; }
                }
            }
#pragma unroll
            for (int e = 0; e < 8; ++e)
#pragma unroll
                for (int i = 0; i < 8; i += 2) *(LAS unsigned*)(ut + (c8 + e) * 68 + ts * 8 + i) = pk2(x1v[i][e], x1v[i + 1][e]);
            __syncthreads();
            bf16* UT = (bf16*)(ws + (smp ? WS_UT_S : WS_UT_P)) + (size_t)seq * 512 * L + l0;
            for (int q = tid; q < 512 * 16; q += 512) { const int ch = q >> 4, part = q & 15; const v2u v = *(const LAS v2u*)(ut + ch * 68 + part * 4); *(v2u*)(UT + (size_t)ch * L + part * 4) = v; }
            __syncthreads();
        }
        int k256 = 256; asm volatile("" : "+s"(k256));
        { pg8::Gemm g{(const bf16*)(ws + WS_QN), (const bf16*)(ws + WS_QUP_T), MT, 768, k256}; pg8::StaticOrder S; S.init(MT, 768, G, bx);
          EpiStore E{(bf16*)(ws + WS_Q), 768};
          pg8::gemm_phase<EpiStore, pg8::StaticOrder, PG8_ALIGN, PG8_SP2>(lds, g, S, E, tid); }
        { int bx2 = (bx + 144) % G; asm volatile("" : "+s"(bx2)); const int lane2 = fresh_lane(); const int tid = wave * 64 + lane2;
          pg8::Gemm g{(const bf16*)(ws + WS_KVN), (const bf16*)(ws + WS_KVUP_T), MKV, 1024, k256}; pg8::StaticOrder S; S.init(MKV, 1024, G, bx2);
          EpiKV E{(bf16*)(ws + WS_KF_S), (bf16*)(ws + WS_KF_P), (bf16*)(ws + WS_V_S), (bf16*)(ws + WS_V_P)};
          pg8::gemm_phase<EpiKV, pg8::StaticOrder, PG8_ALIGN, PG8_SP2>(lds, g, S, E, tid); }
    }
    SEAM(4);

    if (IN(5)) {
        FRESH();
        asm volatile("; ==== PHASE 5 ====");
        constexpr int NA_S = 2 * BS * NH * (LS / 256), NC_S = HY / 4, NA_P = BP * NH, NC_P = HY / 8, NW_T = (WI_ALL - WI_P1) / 8, NITEM = NA_S + NC_S + NA_P + NC_P + NW_T;
        bf16* YM = HB;
        for (;;) {
            if (tid == 0) MISC[0] = __hip_atomic_fetch_add((unsigned*)(ctl + CW_Q + 64 * args.li), 1u, RLX_AGENT);
            __syncthreads();
            const int it = __builtin_amdgcn_readfirstlane((int)MISC[0]);
            __syncthreads();
            if (it >= NITEM) break;
            { const int cls = it < NA_S ? 0 : it < NA_S + NC_S ? 1 : it < NA_S + NC_S + NA_P ? 2 : it < NA_S + NC_S + NA_P + NC_P ? 3 : 4; if (!((args.mask >> cls) & 1)) continue; }
            const int lane = fresh_lane(); const int tid = wave * 64 + lane;
            const bool isA_S = it < NA_S, isA_P = (it >= NA_S + NC_S) && (it < NA_S + NC_S + NA_P);
            if (isA_S || isA_P) { if (!NO_ATT) {
                int b, h, row0, lk, pos0, koff = 0, nkeys; const bf16 *kf, *vv; float* part = nullptr; unsigned* cnt = nullptr;
                if (isA_S) { const int un = it >> 1, half = it & 1; b = un / (NH * 16); h = (un / 16) % NH; const int qb = un % 16; row0 = NP + b * LS + qb * 256; lk = LKS; pos0 = qb * 256; kf = (const bf16*)(ws + WS_KF_S); vv = (const bf16*)(ws + WS_V_S);
                    nkeys = LKS / 2; koff = half * (LKS / 2); part = (float*)(ws + WS_APART) + (size_t)un * APART_F; cnt = (unsigned*)(ctl + CW_ATT + args.li * 8192 + un * 64); }
                else { const int u = it - NA_S - NC_S; b = u / NH; h = u % NH; row0 = b * LP; lk = LP; pos0 = -1; kf = (const bf16*)(ws + WS_KF_P); vv = (const bf16*)(ws + WS_V_P); nkeys = LP; }
                att::attn_dense_body((const bf16*)(ws + WS_Q) + (size_t)row0 * 768 + h * DQK, kf + ((size_t)(b * NH + h) * lk + koff) * DQK, vv + ((size_t)(b * NH + h) * lk + koff) * DVH,
                                     YM + (size_t)row0 * DM + HY + h * DVH, nkeys, pos0, (LAS char*)lds, tid, part, cnt, MISC); }
            } else if (it < NA_S + NC_S) {
                hconv::item((const bf16*)(ws + WS_FT_S), (const bf16*)(ws + WS_UT_S), (const float*)(ws + WS_FPART_S), args.in[I_HFSKIP], (const bf16*)(ws + WS_X0), YM, (it - NA_S) * 4, lds, tid, lane, wave);
            } else if (it >= NA_S + NC_S + NA_P + NC_P) {
                LAS float* scr = (LAS float*)(lds + wave * 16384);
                weight_item(args, ws, scr, WI_P1 + (it - (NA_S + NC_S + NA_P + NC_P)) * 8 + wave, lane);
                __syncthreads();
            } else if (!NO_CONV) {
                hconv::prompt_item((const float*)(ws + WS_FT_P), (const bf16*)(ws + WS_UT_P), (const float*)(ws + WS_FPART_P), args.in[I_HFSKIP], (const bf16*)(ws + WS_X0), YM, (it - NA_S - NC_S - NA_P) * 8, lds, tid, lane, wave);
            }
        }
    }
    SEAM(5);

    if (IN(6)) {
        FRESH();
        asm volatile("; ==== PHASE 6 ====");
        pg8::Gemm g{HB, (const bf16*)(ws + WS_WOUT0_T), MT, DM, DM}; pg8::StaticOrder S; S.init((MT / 192) * 256, DM, G, bx);
        EpiRes<3, false> E{args.in[I_XP], args.in[I_XS], MODS + 2 * 1024, T, nullptr, nullptr, nullptr};
        pg8::gemm_phase<EpiRes<3, false>, pg8::StaticOrder, PG8_ALIGN, PG8_SP2, 3>(lds, g, S, E, tid);
    }
    SEAM(6);

    if (IN(7)) {
        FRESH();
        asm volatile("; ==== PHASE 7 ====");
        for (int m4 = gw * 4; m4 < MT; m4 += NGW * 4) { const int m = m4 + (lane >> 4); int cl = lane & 15; asm volatile("" : "+v"(cl));
            const float* md = MODS + (size_t)req_of_row(m) * 6144;
            f32x4 v[16]; load_row16(T + (size_t)m * DM, cl, v); ln_affine16(v, args.in[I_LN1G0], args.in[I_LN1B0], cl, STATS + 2 * m);
            adaln_store16(v, md + 3 * 1024, md + 4 * 1024, HB + (size_t)m * DM, cl);
        }
    }
    SEAM(7);

    if (IN(8)) {
        FRESH();
        asm volatile("; ==== PHASE 8 ====");
        pg8::Gemm g{HB, (const bf16*)(ws + WS_W1_0), MT, FF, DM}; pg8::StaticOrder S; S.init(MT, FF, G, bx);
        EpiUp E{(bf16*)(ws + WS_HID)};
        pg8::gemm_phase<EpiUp, pg8::StaticOrder, PG8_ALIGN, PG8_SP2>(lds, g, S, E, tid);
    }
    SEAM(8);

    if (IN(9)) {
        FRESH();
        asm volatile("; ==== PHASE 9 ====");
        pg8::Gemm g{(const bf16*)(ws + WS_HID), (const bf16*)(ws + WS_W2_0), MT, DM, FF}; pg8::StaticOrder S; S.init((MT / 192) * 256, DM, G, bx);
        EpiRes<3, true> E{nullptr, nullptr, MODS + 5 * 1024, T, STATS, args.in[I_LN1G0], args.in[I_LN1B0]};
        pg8::gemm_phase<EpiRes<3, true>, pg8::StaticOrder, PG8_ALIGN, PG8_SP2, 3>(lds, g, S, E, tid);
    }
    SEAM(9);

    if (IN(10)) {
        FRESH();
        asm volatile("; ==== PHASE 10 ====");
        const float* MODS1 = MODS + 3 * 6144;
        for (int it = bx; it < MT / 32; it += G) {
            const int m0 = it * 32; const bool smp = m0 >= NP; const int L = smp ? LS : LP; const int l0 = smp ? (m0 - NP) % LS : m0 % LP; const int seq = smp ? (m0 - NP) / LS : m0 / LP;
            LAS bf16* ht = (LAS bf16*)lds;
            const float* md = MODS1 + (size_t)req_of_row(m0) * 6144;
            { const int i = wave * 4 + (lane >> 4), m = m0 + i; int cl = lane & 15; asm volatile("" : "+v"(cl));
                f32x4 v[16]; load_row16(T + (size_t)m * DM, cl, v); ln_affine16(v, args.in[I_LN2G0], args.in[I_LN2B0], cl, STATS + 2 * m);
                float mean, rstd; row16_stats(v, mean, rstd);
#pragma unroll
                for (int j = 0; j < 16; ++j) { const int c = 4 * cl + 64 * j; const f32x4 sc = *(const f32x4*)(md + 1024 + c), sh = *(const f32x4*)(md + c);
                    const f32x4 h = (v[j] - mean) * rstd * (sc + 1.0f) + sh;
#pragma unroll
                    for (int e = 0; e < 4; ++e) ht[(c + e) * 40 + i] = (bf16)f2bf(h[e]);
                    if ((j & 3) == 3) asm volatile("" ::: "memory"); }
            }
            __syncthreads();
            if (!smp) { bf16* HT = HB + (size_t)seq * DM * LP + l0;
                for (int q = tid; q < 1024 * 4; q += 512) { const int c = q >> 2, part = q & 3; const v4u v = *(const LAS v4u*)(ht + c * 40 + part * 8); *(v4u*)(HT + (size_t)c * L + part * 8) = v; }
            } else { bf16* HT2 = HB + (size_t)NP * DM + (size_t)seq * DM * LS + (l0 >> 1);
                for (int q = tid; q < 1024 * 4; q += 512) { const int c = q >> 2, par = (q >> 1) & 1, hf = q & 1; const LAS bf16* src = ht + c * 40 + 16 * hf + par; v4u v;
                    v.x = (unsigned)src[0] | ((unsigned)src[2] << 16); v.y = (unsigned)src[4] | ((unsigned)src[6] << 16); v.z = (unsigned)src[8] | ((unsigned)src[10] << 16); v.w = (unsigned)src[12] | ((unsigned)src[14] << 16);
                    *(v4u*)(HT2 + ((size_t)c * 2 + par) * 2048 + 8 * hf) = v; } }
            __syncthreads();
        }
        for (int i = gt; i < 2048 * 2048 / 8; i += NGT) {
            const int rho = i >> 8, l8 = (i & 255) * 8, p = rho >> 1, ty = rho & 1; unsigned w[4];
#pragma unroll
            for (int e = 0; e < 8; e += 2) { float a, b2;
                if (p == 0) { a = 0.015625f; b2 = ty ? -0.015625f : 0.015625f; }
                else { const float r0 = (float)((p * (l8 + e)) & 2047) * (1.f / 2048.f), r1 = (float)((p * (l8 + e + 1)) & 2047) * (1.f / 2048.f);
                    a = (ty ? __builtin_amdgcn_sinf(r0) : __builtin_amdgcn_cosf(r0)) * 0.015625f; b2 = (ty ? __builtin_amdgcn_sinf(r1) : __builtin_amdgcn_cosf(r1)) * 0.015625f; }
                w[e >> 1] = pk2(a, b2); }
            ((v4u*)(ws + WS_D4096))[i] = (v4u){w[0], w[1], w[2], w[3]};
        }
    }
    SEAM(10);

    if (IN(11)) {
        FRESH();
        asm volatile("; ==== PHASE 11 ====");
        { pg8::Gemm g{(const bf16*)(ws + WS_D4096), HB + (size_t)NP * DM, 2048, 4096, 2048}; pg8::SplitOrderCut S; S.init(2048, 4096, 2048, G, vcu, SLABS(200), SPLIT_CNT(3));
          EpiDft2 E{(bf16*)(ws + WS_UV)};
          pg8::gemm_phase<EpiDft2, pg8::SplitOrderCut, PG8_ALIGN, PG8_SP2>(lds, g, S, E, tid); }
        { int bx2 = (bx + 128) % G; asm volatile("" : "+s"(bx2)); const int lane2 = fresh_lane(); const int tid = wave * 64 + lane2;
          pg8::Gemm g{(const bf16*)(ws + WS_D256), HB, LP, BP * DM, LP}; pg8::StaticOrder S; S.init(LP, BP * DM, G, bx2);
          EpiDft E{(bf16*)(ws + WS_UV), LP, 0};
          pg8::gemm_phase<EpiDft, pg8::StaticOrder, PG8_ALIGN, PG8_SP2>(lds, g, S, E, tid); }
    }
    SEAM(11);

    if (IN(12)) {
        FRESH();
        asm volatile("; ==== PHASE 12 ====");
        pg8::Gemm g{(const bf16*)(ws + WS_UV), (const bf16*)(ws + WS_WFOLD_T), MT, DM, 2048}; pg8::StaticOrder S; S.init((MT / 192) * 256, DM, G, bx);
        EpiRes<3, true> E{nullptr, nullptr, MODS + 3 * 6144 + 2 * 1024, T, STATS, args.in[I_LN2G0], args.in[I_LN2B0]};
        pg8::gemm_phase<EpiRes<3, true>, pg8::StaticOrder, PG8_ALIGN, PG8_SP2, 3>(lds, g, S, E, tid);
    }
    SEAM(12);

    if (IN(13)) {
        FRESH();
        asm volatile("; ==== PHASE 13 ====");
        for (int m4 = gw * 4; m4 < MT; m4 += NGW * 4) { const int m = m4 + (lane >> 4); int cl = lane & 15; asm volatile("" : "+v"(cl));
            const float* md = MODS + 3 * 6144 + (size_t)req_of_row(m) * 6144;
            f32x4 v[16]; load_row16(T + (size_t)m * DM, cl, v); ln_affine16(v, args.in[I_LN1G1], args.in[I_LN1B1], cl, STATS + 2 * m);
            adaln_store16(v, md + 3 * 1024, md + 4 * 1024, HB + (size_t)m * DM, cl);
        }
    }
    SEAM(13);

    if (IN(14)) {
        FRESH();
        asm volatile("; ==== PHASE 14 ====");
        pg8::Gemm g{HB, (const bf16*)(ws + WS_W1_1), MT, FF, DM}; pg8::StaticOrder S; S.init(MT, FF, G, bx);
        EpiUp E{(bf16*)(ws + WS_HID)};
        pg8::gemm_phase<EpiUp, pg8::StaticOrder, PG8_ALIGN, PG8_SP2>(lds, g, S, E, tid);
    }
    SEAM(14);

    if (IN(15)) {
        FRESH();
        asm volatile("; ==== PHASE 15 ====");
        pg8::Gemm g{(const bf16*)(ws + WS_HID), (const bf16*)(ws + WS_W2_1), MT, DM, FF}; pg8::StaticOrder S; S.init((MT / 192) * 256, DM, G, bx);
        EpiRes<3, true> E{nullptr, nullptr, MODS + 3 * 6144 + 5 * 1024, T, STATS, args.in[I_LN1G1], args.in[I_LN1B1]};
        pg8::gemm_phase<EpiRes<3, true>, pg8::StaticOrder, PG8_ALIGN, PG8_SP2, 3>(lds, g, S, E, tid);
    }
    SEAM(15);

    if (IN(16)) {
        FRESH();
        asm volatile("; ==== PHASE 16 ====");
        for (int m4 = gw * 4; m4 < MT; m4 += NGW * 4) { const int m = m4 + (lane >> 4); int cl = lane & 15; asm volatile("" : "+v"(cl));
            f32x4 v[16]; load_row16(T + (size_t)m * DM, cl, v); ln_affine16(v, args.in[I_LN2G1], args.in[I_LN2B1], cl); store_row16(X + (size_t)m * DM, cl, v);
        }
    }
#undef IN
#undef SEAM
}

extern "C" void kernel_launch(void* const* d_in, const int* in_sizes, int n_in, void* d_out, int out_size, void* d_ws, size_t ws_size, hipStream_t stream) {
    static int grid = 0;
    if (grid == 0) {
        if (n_in != 38 || ws_size < WS_END) { fprintf(stderr, "kernel_launch: expected 38 inputs and >= %zu bytes of workspace; got %d, %zu\n", (size_t)WS_END, n_in, ws_size); grid = -1; return; }
        int dev = 0, cus = 0;
        if (hipGetDevice(&dev) != hipSuccess || hipDeviceGetAttribute(&cus, hipDeviceAttributeMultiprocessorCount, dev) != hipSuccess) { grid = -1; return; }
        if (hipFuncSetAttribute((const void*)fwd_kernel, hipFuncAttributeMaxDynamicSharedMemorySize, LDS_BYTES) != hipSuccess) { fprintf(stderr, "kernel_launch: hipFuncSetAttribute failed\n"); grid = -1; return; }
        int per_cu = 0;
        if (hipOccupancyMaxActiveBlocksPerMultiprocessor(&per_cu, (const void*)fwd_kernel, 512, LDS_BYTES) != hipSuccess || per_cu < 1) fprintf(stderr, "kernel_launch: occupancy query reports %d\n", per_cu);
        (void)hipGetLastError();
        grid = cus;
    }
    if (grid < 0) return;
    (void)hipMemsetAsync((char*)d_ws + WS_CTL, 0, CTL_ZERO_BYTES, stream);
    Args a{};
    for (int i = 0; i < 38; ++i) a.in[i] = (const float*)d_in[i];
    a.out = (float*)d_out; a.ws = (unsigned char*)d_ws;
#if MK_PER_PHASE
    for (int p = 0; p < NPHASE; ++p) { a.ph_lo = p; a.ph_hi = p + 1; a.li = 0; a.mask = 31; hipLaunchKernelGGL(fwd_kernel, dim3(grid), dim3(512), LDS_BYTES, stream, a); }
#elif defined(PROBE_PREFIX)
    a.mask = 31; a.ph_lo = 0; a.ph_hi = PROBE_PREFIX; a.li = 0; hipLaunchKernelGGL(fwd_kernel, dim3(grid), dim3(512), LDS_BYTES, stream, a);
    a.mask = 31; a.ph_lo = 0; a.ph_hi = NPHASE; a.li = 1; hipLaunchKernelGGL(fwd_kernel, dim3(grid), dim3(512), LDS_BYTES, stream, a);
#elif defined(PROBE_A)
#ifndef PROBE_MASK5
#define PROBE_MASK5 31
#endif
    a.mask = 31; a.ph_lo = 0; a.ph_hi = PROBE_B; a.li = 0; hipLaunchKernelGGL(fwd_kernel, dim3(grid), dim3(512), LDS_BYTES, stream, a);
    a.mask = PROBE_MASK5; a.ph_lo = PROBE_A; a.ph_hi = NPHASE; a.li = 1; hipLaunchKernelGGL(fwd_kernel, dim3(grid), dim3(512), LDS_BYTES, stream, a);
#else
    a.ph_lo = 0; a.ph_hi = NPHASE; a.li = 0; a.mask = 31;
    hipLaunchKernelGGL(fwd_kernel, dim3(grid), dim3(512), LDS_BYTES, stream, a);
#endif
    const hipError_t le = hipPeekAtLastError();
    if (le != hipSuccess) fprintf(stderr, "kernel_launch: launch failed: %s\n", hipGetErrorName(le));
}
```
